# Optimizing an MI355X kernel written in HIP

```python
import math
import jax
import jax.numpy as jnp
from jax import lax
import numpy as np

D_MODEL = 1024
BATCH = 8
SEQ = 4096
DEPTH = 2

GRID_W = 64
CTX_LEN = 256
N_MIXERS = 2
RMS_EPS = 1e-6
HG_HEADS = 8
HG_KDIM = D_MODEL // HG_HEADS
HG_VDIM = D_MODEL // HG_HEADS
HG_CHUNK = 64
N_HG = (DEPTH + N_MIXERS - 1) // N_MIXERS
S5_GROUP = 16
S5_GROUPS = D_MODEL // S5_GROUP
S5_STATE = 64
S5_EIG_MAX = -1e-4
S5_DT_MIN = 1e-3
S5_DT_MAX = 1e-1
N_S5 = DEPTH // N_MIXERS
N_EXPERTS = 32
TOP_K = 4
D_FF = D_MODEL
SWIGLU_ALPHA = 1.702
SWIGLU_LIMIT = 7.0
MOE_BLOCK = 128

kernel_name = "hybrid_hgrn2_s5_moe_prefix_dit"

F32 = jnp.float32


def rmsnorm(x, g):
    xf = x.astype(F32)
    y = xf * lax.rsqrt(jnp.mean(xf * xf, axis=-1, keepdims=True) + RMS_EPS)
    return (y * g.astype(F32)).astype(x.dtype)


def modulate(h, shift, scale):
    return h * (1.0 + scale) + shift


def _ident(t):
    return t


def _flip_seq(t):
    return jnp.flip(t, axis=1)


def _flip0(t):
    return jnp.flip(t, axis=0)


def gla_chunked(q, k, v, log_f, s0):
    bsz, t_len, n_h, _ = q.shape
    vd = v.shape[-1]
    n = t_len // HG_CHUNK

    def chunks(t):
        return t.astype(F32).reshape(bsz, n, HG_CHUNK, n_h, t.shape[-1])

    q, k, v, log_f = chunks(q), chunks(k), chunks(v), chunks(log_f)
    b = jnp.cumsum(log_f, axis=2)
    b_ref = b[:, :, HG_CHUNK // 2 - 1:HG_CHUNK // 2]
    scores = jnp.einsum('bnthk,bnshk->bnhts', q * jnp.exp(b - b_ref), k * jnp.exp(b_ref - b))
    prefix = jnp.tril(jnp.ones((HG_CHUNK, HG_CHUNK), bool))
    o_intra = jnp.einsum('bnhts,bnshv->bnthv', jnp.where(prefix, scores, 0.0), v)
    b_last = b[:, :, -1]
    q_in = q * jnp.exp(b)
    k_out = k * jnp.exp(b_last[:, :, None] - b)

    def step(s, xs):
        qc, kc, vc, dc = xs
        o = jnp.einsum('bthk,bhkv->bthv', qc, s)
        s = s * jnp.exp(dc)[..., None] + jnp.einsum('bthk,bthv->bhkv', kc, vc)
        return s, o

    xs = tuple(jnp.moveaxis(t, 1, 0) for t in (q_in, k_out, v, b_last))
    s_fin, o_inter = lax.scan(step, s0.astype(F32), xs)
    o = o_intra + jnp.moveaxis(o_inter, 0, 1)
    return o.reshape(bsz, t_len, n_h, vd), s_fin


def hgrn2_mixer(a_ctx, a_lat, w_in, lb, norm_g, w_out, need_ctx):
    bsz = a_lat.shape[0]

    def heads(t):
        return t.reshape(t.shape[:-1] + (HG_HEADS, -1))

    def project(a):
        q, i, z_fwd, z_bwd, g = jnp.split(a @ w_in, 5, axis=-1)
        gates = []
        for d, z in enumerate((z_fwd, z_bwd)):
            f = lb[d] + (1.0 - lb[d]) * jax.nn.sigmoid(z.astype(F32))
            gates.append((heads(1.0 - f), heads(jnp.log(f))))
        return heads(jax.nn.silu(q)), heads(i), gates, g

    qc, vc, gates_c, gc = project(a_ctx)
    ql, vl, gates_l, gl = project(a_lat)
    s0 = jnp.zeros((bsz, HG_HEADS, HG_KDIM, HG_VDIM), F32)
    o_ctx = 0.0
    o_lat = 0.0
    for d, rev in enumerate((_ident, _flip_seq)):
        (kc, lfc), (kl, lfl) = gates_c[d], gates_l[d]
        oc, s_ctx = gla_chunked(rev(qc), rev(kc), rev(vc), rev(lfc), s0)
        ol, _ = gla_chunked(rev(ql), rev(kl), rev(vl), rev(lfl), s_ctx)
        o_lat = o_lat + rev(ol)
        if need_ctx:
            o_ctx = o_ctx + rev(oc)

    def readout(o, g):
        o = o * lax.rsqrt(jnp.mean(o * o, axis=-1, keepdims=True) + RMS_EPS)
        o = o * norm_g.astype(F32).reshape(HG_HEADS, HG_VDIM)
        o = o.reshape(o.shape[:2] + (D_MODEL,)).astype(g.dtype) * jax.nn.silu(g)
        return o @ w_out

    y_ctx = readout(o_ctx, gc) if need_ctx else None
    return y_ctx, readout(o_lat, gl)


def s5_discretise(a_re, a_im, log_dt, b_re, b_im):
    lam_re = jnp.minimum(a_re.astype(F32), S5_EIG_MAX)
    lam_im = a_im.astype(F32)
    dt = jnp.exp(log_dt.astype(F32))[:, None]
    mag = jnp.exp(lam_re * dt)
    ab_re = mag * jnp.cos(lam_im * dt)
    ab_im = mag * jnp.sin(lam_im * dt)
    den = lam_re * lam_re + lam_im * lam_im
    coef_re = ((ab_re - 1.0) * lam_re + ab_im * lam_im) / den
    coef_im = (ab_im * lam_re - (ab_re - 1.0) * lam_im) / den
    b_re = b_re.astype(F32)
    b_im = b_im.astype(F32)
    bb_re = coef_re[..., None] * b_re - coef_im[..., None] * b_im
    bb_im = coef_re[..., None] * b_im + coef_im[..., None] * b_re
    return ab_re, ab_im, bb_re, bb_im


def _cmul(ar, ai, br, bi):
    return ar * br - ai * bi, ar * bi + ai * br


def _lin_rec_op(e1, e2):
    a1r, a1i, b1r, b1i = e1
    a2r, a2i, b2r, b2i = e2
    ar, ai = _cmul(a2r, a2i, a1r, a1i)
    br, bi = _cmul(a2r, a2i, b1r, b1i)
    return ar, ai, br + b2r, bi + b2i


def complex_diag_scan(ab_re, ab_im, bu_re, bu_im, s0_re, s0_im):
    i_re, i_im = _cmul(ab_re, ab_im, s0_re, s0_im)
    bu_re = bu_re.at[0].add(i_re)
    bu_im = bu_im.at[0].add(i_im)
    a_re = jnp.broadcast_to(ab_re, bu_re.shape)
    a_im = jnp.broadcast_to(ab_im, bu_im.shape)
    _, _, s_re, s_im = lax.associative_scan(_lin_rec_op, (a_re, a_im, bu_re, bu_im), axis=0)
    return s_re, s_im


def s5_mixer(a_ctx, a_lat, a_re, a_im, log_dt, b_re, b_im, c_re, c_im, d_skip, w_glu, b_glu, need_ctx):
    bsz, t_len, _ = a_lat.shape
    rows = t_len // GRID_W
    to_cols = lambda t: t.reshape(bsz, rows, GRID_W, D_MODEL).transpose(0, 2, 1, 3).reshape(bsz, t_len, D_MODEL)
    to_rows = lambda t: t.reshape(bsz, GRID_W, rows, D_MODEL).transpose(0, 2, 1, 3).reshape(bsz, t_len, D_MODEL)
    u_lat = to_cols(a_lat)
    disc = [s5_discretise(a_re[d], a_im[d], log_dt[d], b_re, b_im) for d in range(2)]
    cr = c_re.astype(F32)
    ci = c_im.astype(F32)

    def per_sample(args):
        uc, ul = args
        ucg = uc.astype(F32).reshape(-1, S5_GROUPS, S5_GROUP)
        ulg = ul.astype(F32).reshape(-1, S5_GROUPS, S5_GROUP)
        zero = jnp.zeros((S5_GROUPS, S5_STATE), F32)
        yc = 0.0
        yl = 0.0
        for d, rev in enumerate((_ident, _flip0)):
            ab_re, ab_im, bb_re, bb_im = disc[d]
            drive = lambda u: (jnp.einsum('tgi,gpi->tgp', u, bb_re), jnp.einsum('tgi,gpi->tgp', u, bb_im))
            read = lambda s: jnp.einsum('tgp,gop->tgo', s[0], cr[d]) - jnp.einsum('tgp,gop->tgo', s[1], ci[d])
            sc = complex_diag_scan(ab_re, ab_im, *drive(rev(ucg)), zero, zero)
            sl = complex_diag_scan(ab_re, ab_im, *drive(rev(ulg)), sc[0][-1], sc[1][-1])
            yl = yl + rev(read(sl))
            if need_ctx:
                yc = yc + rev(read(sc))
        yl = yl.reshape(ul.shape)
        if need_ctx:
            return yc.reshape(uc.shape), yl
        return yl

    out = lax.map(per_sample, (a_ctx, u_lat))
    dsk = d_skip.astype(F32)

    def glu(y, u):
        y = (y + dsk * u.astype(F32)).astype(u.dtype)
        za, zb = jnp.split(jax.nn.gelu(y) @ w_glu + b_glu, 2, axis=-1)
        return za * jax.nn.sigmoid(zb)

    if need_ctx:
        y_ctx_raw, y_lat_raw = out
        return glu(y_ctx_raw, a_ctx), glu(to_rows(y_lat_raw), a_lat)
    return None, glu(to_rows(out), a_lat)


def moe(h, router_w, router_b, w1, b1, w2, b2):
    n_tok, d = h.shape
    logits = (h @ router_w + router_b).astype(F32)
    top_v, top_i = lax.top_k(logits, TOP_K)
    top_w = jax.nn.softmax(top_v, axis=-1)
    n_asg = n_tok * TOP_K
    flat_e = top_i.reshape(-1)
    flat_t = jnp.arange(n_asg, dtype=jnp.int32) // TOP_K
    flat_w = top_w.reshape(-1)
    order = jnp.argsort(flat_e)
    e_sorted = flat_e[order]
    counts = jnp.bincount(flat_e, length=N_EXPERTS)
    padded = (counts + MOE_BLOCK - 1) // MOE_BLOCK * MOE_BLOCK
    pad_end = jnp.cumsum(padded)
    pad_start = pad_end - padded
    start = jnp.cumsum(counts) - counts
    dest = pad_start[e_sorted] + jnp.arange(n_asg, dtype=jnp.int32) - start[e_sorted]
    n_blocks = -(-n_asg // MOE_BLOCK) + N_EXPERTS
    slot_tok = jnp.zeros((n_blocks * MOE_BLOCK,), jnp.int32).at[dest].set(flat_t[order])
    slot_w = jnp.zeros((n_blocks * MOE_BLOCK,), F32).at[dest].set(flat_w[order])
    block_pos = jnp.arange(n_blocks, dtype=jnp.int32) * MOE_BLOCK
    block_e = jnp.minimum(jnp.searchsorted(pad_end, block_pos, side='right'), N_EXPERTS - 1)

    def block_ffn(args):
        tok, e = args
        z = h[tok] @ w1[e] + b1[e]
        z_glu, z_lin = jnp.split(z, 2, axis=-1)
        z_glu = jnp.minimum(z_glu, SWIGLU_LIMIT)
        z_lin = jnp.clip(z_lin, -SWIGLU_LIMIT, SWIGLU_LIMIT)
        act = z_glu * jax.nn.sigmoid(SWIGLU_ALPHA * z_glu) * (z_lin + 1.0)
        return act @ w2[e] + b2[e]

    y = lax.map(block_ffn, (slot_tok.reshape(n_blocks, MOE_BLOCK), block_e))
    y = y.reshape(-1, d) * slot_w[:, None].astype(h.dtype)
    return jnp.zeros_like(h).at[slot_tok].add(y)


def setup_inputs(seed: int = 0) -> dict:
    key = jax.random.key(seed)
    keys = iter(jax.random.split(key, 40))

    def normal(shape, scale):
        return jax.random.normal(next(keys), shape, F32) * scale

    def gain(shape):
        return 1.0 + normal(shape, 0.02)

    d, g, p, gc = D_MODEL, S5_GROUPS, S5_STATE, S5_GROUP
    n_idx = jnp.arange(p, dtype=F32)
    return {
        "x": normal((BATCH, SEQ, d), 1.0),
        "c": normal((BATCH, d), 1.0),
        "ctx": normal((BATCH, CTX_LEN, d), 1.0),
        "c_ctx": normal((d,), 1.0),
        "mod_w": normal((DEPTH, d, 6 * d), d ** -0.5),
        "mod_b": normal((DEPTH, 6 * d), 0.02),
        "norm1_g": gain((DEPTH, d)),
        "norm2_g": gain((DEPTH, d)),
        "hg_w_in": normal((N_HG, d, 5 * d), d ** -0.5),
        "hg_lb_logits": normal((N_HG + 1, 2, d), 0.1),
        "hg_norm_g": gain((N_HG, d)),
        "hg_w_out": normal((N_HG, d, d), d ** -0.5),
        "s5_a_re": -0.5 + normal((N_S5, 2, g, p), 0.01),
        "s5_a_im": math.pi * n_idx + normal((N_S5, 2, g, p), 0.01),
        "s5_log_dt": jax.random.uniform(next(keys), (N_S5, 2, g), F32, math.log(S5_DT_MIN), math.log(S5_DT_MAX)),
        "s5_b_re": normal((N_S5, g, p, gc), (2 * gc) ** -0.5),
        "s5_b_im": normal((N_S5, g, p, gc), (2 * gc) ** -0.5),
        "s5_c_re": normal((N_S5, 2, g, gc, p), p ** -0.5),
        "s5_c_im": normal((N_S5, 2, g, gc, p), p ** -0.5),
        "s5_d": normal((N_S5, d), 1.0),
        "s5_w_glu": normal((N_S5, d, 2 * d), d ** -0.5),
        "s5_b_glu": normal((N_S5, 2 * d), 0.02),
        "router_w": normal((DEPTH, d, N_EXPERTS), d ** -0.5),
        "router_b": normal((DEPTH, N_EXPERTS), 0.01),
        "moe_w1": normal((DEPTH, N_EXPERTS, d, 2 * D_FF), d ** -0.5),
        "moe_b1": normal((DEPTH, N_EXPERTS, 2 * D_FF), 0.02),
        "moe_w2": normal((DEPTH, N_EXPERTS, D_FF, d), D_FF ** -0.5),
        "moe_b2": normal((DEPTH, N_EXPERTS, d), 0.02),
        "final_g": gain((d,)),
    }


def reference(x, c, ctx, c_ctx, mod_w, mod_b, norm1_g, norm2_g, hg_w_in, hg_lb_logits, hg_norm_g,
              hg_w_out, s5_a_re, s5_a_im, s5_log_dt, s5_b_re, s5_b_im, s5_c_re, s5_c_im, s5_d, s5_w_glu,
              s5_b_glu, router_w, router_b, moe_w1, moe_b1, moe_w2, moe_b2, final_g):
    d = x.shape[-1]
    lb_all = jnp.cumsum(jax.nn.softmax(hg_lb_logits.astype(F32), axis=0), axis=0)
    h_lat, h_ctx = x, ctx
    for i in range(DEPTH):
        last = i == DEPTH - 1
        j = i // N_MIXERS
        m_lat = (jax.nn.silu(c) @ mod_w[i] + mod_b[i])[:, None, :]
        m_ctx = jax.nn.silu(c_ctx) @ mod_w[i] + mod_b[i]
        sh1, sc1, g1, sh2, sc2, g2 = jnp.split(m_lat, 6, axis=-1)
        csh1, csc1, cg1, csh2, csc2, cg2 = jnp.split(m_ctx, 6, axis=-1)
        a_lat = modulate(rmsnorm(h_lat, norm1_g[i]), sh1, sc1)
        a_ctx = modulate(rmsnorm(h_ctx, norm1_g[i]), csh1, csc1)
        if i % N_MIXERS == 0:
            y_ctx, y_lat = hgrn2_mixer(a_ctx, a_lat, hg_w_in[j], lb_all[j], hg_norm_g[j], hg_w_out[j], not last)
        else:
            y_ctx, y_lat = s5_mixer(a_ctx, a_lat, s5_a_re[j], s5_a_im[j], s5_log_dt[j], s5_b_re[j], s5_b_im[j],
                                    s5_c_re[j], s5_c_im[j], s5_d[j], s5_w_glu[j], s5_b_glu[j], not last)
        h_lat = h_lat + g1 * y_lat
        f_lat = modulate(rmsnorm(h_lat, norm2_g[i]), sh2, sc2)
        if last:
            y = moe(f_lat.reshape(-1, d), router_w[i], router_b[i], moe_w1[i], moe_b1[i], moe_w2[i], moe_b2[i])
            h_lat = h_lat + g2 * y.reshape(h_lat.shape)
        else:
            h_ctx = h_ctx + cg1 * y_ctx
            f_ctx = modulate(rmsnorm(h_ctx, norm2_g[i]), csh2, csc2)
            tokens = jnp.concatenate([f_ctx.reshape(-1, d), f_lat.reshape(-1, d)], axis=0)
            y = moe(tokens, router_w[i], router_b[i], moe_w1[i], moe_b1[i], moe_w2[i], moe_b2[i])
            n_ctx = h_ctx.shape[0] * h_ctx.shape[1]
            h_ctx = h_ctx + cg2 * y[:n_ctx].reshape(h_ctx.shape)
            h_lat = h_lat + g2 * y[n_ctx:].reshape(h_lat.shape)
    return rmsnorm(h_lat, final_g)
```

```cpp
#include <hip/hip_runtime.h>
#include <hip/hip_cooperative_groups.h>
#include <cstdio>
#include <cstdint>
namespace cg = cooperative_groups;

#define LAS __attribute__((address_space(3)))
typedef unsigned short bf16_t;
typedef short bf16x8 __attribute__((ext_vector_type(8)));
typedef float f32x4 __attribute__((ext_vector_type(4)));
typedef unsigned u32x4 __attribute__((ext_vector_type(4)));
typedef unsigned u32x2 __attribute__((ext_vector_type(2)));
typedef float f32x2 __attribute__((ext_vector_type(2)));

constexpr int NTHREADS = 512;
constexpr int LDS_BYTES = 147456;
constexpr int D = 1024, NB = 8, SEQ = 4096, CTXL = 256;
constexpr int NCTX = NB * CTXL;
constexpr int NLAT = NB * SEQ;
constexpr int NTOK = NCTX + NLAT;
constexpr int NE = 32;
constexpr int MPAD = 147456;
constexpr float EPS = 1e-6f;

constexpr size_t MiB = 1u << 20;
constexpr size_t WS_CTL = 0;
constexpr size_t WS_MODV = 1 * MiB;
constexpr size_t WS_LBV = 1 * MiB + 512 * 1024;
constexpr size_t WS_WIN = 2 * MiB;
constexpr size_t WS_WOUT = 12 * MiB;
constexpr size_t WS_WGLU = 14 * MiB;
constexpr size_t WS_W1 = 18 * MiB;
constexpr size_t WS_W2 = 274 * MiB;
constexpr size_t WS_H = 402 * MiB;
constexpr size_t WS_A = 538 * MiB;
constexpr size_t WS_F = 606 * MiB;
constexpr size_t WS_TOKE = 674 * MiB;
constexpr size_t WS_TOKW = 674 * MiB + 640 * 1024;
constexpr size_t WS_TOKS = 674 * MiB + 1280 * 1024;
constexpr size_t WS_SLOTTOK = 256 * 1024;
constexpr size_t WS_BIG = 676 * MiB;
constexpr size_t WS_Q = WS_BIG, WS_V = WS_BIG + 68 * MiB, WS_G = WS_BIG + 136 * MiB;
constexpr size_t WS_LFF = WS_BIG + 204 * MiB, WS_LFB = WS_BIG + 340 * MiB;
constexpr size_t WS_OF = WS_BIG + 476 * MiB, WS_OB = WS_BIG + 612 * MiB;
constexpr size_t WS_OG = WS_BIG + 748 * MiB;
constexpr size_t WS_AG = WS_BIG, WS_ACT = WS_BIG + 288 * MiB, WS_YS = WS_BIG;
constexpr size_t WS_YF = WS_BIG, WS_YB = WS_BIG + 128 * MiB, WS_YG = WS_BIG + 256 * MiB;
constexpr size_t WS_END = WS_BIG + 816 * MiB;
constexpr int CW_CNT = 64;
constexpr int CW_CUR = 256;
constexpr int CW_CNTB = 8192;
constexpr int CW_BAR = 4096;
#ifndef REP_P0
#define REP_P0 1
#endif
#ifndef REP_GLA
#define REP_GLA 1
#endif
#ifndef REP_S5
#define REP_S5 1
#endif
#ifndef REP_P1
#define REP_P1 1
#endif
#ifndef REP_RO
#define REP_RO 1
#endif
#ifndef REP_POST
#define REP_POST 1
#endif
#ifndef REP_CMB1
#define REP_CMB1 1
#endif
#ifndef REP_OUT
#define REP_OUT 1
#endif
#ifndef REP_RT
#define REP_RT 1
#endif
#ifndef REP_AS
#define REP_AS 1
#endif
#ifndef REP_INP
#define REP_INP 1
#endif
#ifndef REP_M1
#define REP_M1 1
#endif
#ifndef REP_M2
#define REP_M2 1
#endif

struct Args {
    const float* in[29];
    float* out;
    unsigned char* ws;
    int stop_after, pad1;
};
enum { I_X = 0, I_C, I_CTX, I_CCTX, I_MODW, I_MODB, I_N1G, I_N2G, I_HGWIN, I_HGLB, I_HGNG, I_HGWOUT, I_S5ARE, I_S5AIM, I_S5LDT,
       I_S5BRE, I_S5BIM, I_S5CRE, I_S5CIM, I_S5D, I_S5WGLU, I_S5BGLU, I_RW, I_RB, I_W1, I_B1, I_W2, I_B2, I_FG };

__device__ __forceinline__ unsigned f2bf(float f) { unsigned u = __builtin_bit_cast(unsigned, f); return (u + 0x7fffu + ((u >> 16) & 1u)) >> 16; }
typedef __bf16 bf16x2_t __attribute__((ext_vector_type(2)));
__device__ __forceinline__ unsigned cvt_pk_bf16(float lo, float hi) { const bf16x2_t v = {(__bf16)lo, (__bf16)hi}; return __builtin_bit_cast(unsigned, v); }
__device__ __forceinline__ unsigned pk2(float lo, float hi) { return cvt_pk_bf16(lo, hi); }
__device__ __forceinline__ float bf2f(unsigned short b) { return __builtin_bit_cast(float, ((unsigned)b) << 16); }
__device__ __forceinline__ float bflo(unsigned w) { return __builtin_bit_cast(float, w << 16); }
__device__ __forceinline__ float bfhi(unsigned w) { return __builtin_bit_cast(float, w & 0xffff0000u); }
__device__ __forceinline__ float wave_sum(float v) {
#pragma unroll
    for (int o = 1; o < 64; o <<= 1) v += __shfl_xor(v, o);
    return v;
}
__device__ __forceinline__ float wave_max(float v) {
#pragma unroll
    for (int o = 1; o < 64; o <<= 1) v = fmaxf(v, __shfl_xor(v, o));
    return v;
}
__device__ __forceinline__ float sigmoid_f(float x) { return __builtin_amdgcn_rcpf(1.0f + __expf(-x)); }
__device__ __forceinline__ float silu_f(float x) { return x * __builtin_amdgcn_rcpf(1.0f + __expf(-x)); }
#define LDS_WAIT() asm volatile("s_waitcnt lgkmcnt(0)" ::: "memory")

namespace pg8 {
constexpr int BM = 256, BK = 64, HALF = 128, HTB = HALF * BK * 2, STAGE_BYTES = 8 * HTB, NXCD = 8, WGM = 8;
__host__ __device__ __forceinline__ int lds_byte(int r, int c) { const int st = (r >> 4) * 2 + (c >> 5), rr = r & 15, cc = c & 31, ob = rr * 64 + cc * 2; return st * 1024 + (ob ^ (((ob >> 9) & 1) << 5)); }
__host__ __device__ __forceinline__ void stage_rc(int b, int& R, int& C) { const int st = b / 1024, sb = b % 1024, swz = sb ^ (((sb >> 9) & 1) << 5); R = (st >> 1) * 16 + swz / 64; C = (st & 1) * 32 + (swz % 64) / 2; }
__host__ __device__ __forceinline__ int perm32(int rho) { const int n = rho >> 4, i = rho & 15; return 8 * (i >> 2) + 4 * n + (i & 3); }
struct Unit { int pm, pn; };
struct Gemm { const bf16_t* A; const bf16_t* Bt; int M, N, K; };
struct StaticOrder {
    int nM, nN, nwg, G, c;
    __device__ void init(int M, int N, int G_, int c_) { nM = M / BM; nN = N / BM; nwg = nM * nN; G = G_; c = c_; }
    __device__ bool next(int i, Unit& u) const {
        const long L = (long)i * G + c; if (L >= nwg) return false;
        int wgid = (int)L; { const int q = nwg / NXCD, r = nwg % NXCD, xcd = wgid % NXCD, off = wgid / NXCD; wgid = (xcd < r ? xcd * (q + 1) : r * (q + 1) + (xcd - r) * q) + off; }
        const int nig = WGM * nN, gid = wgid / nig, fm = gid * WGM, gsz = (nM - fm) < WGM ? (nM - fm) : WGM;
        u.pm = fm + ((wgid % nig) % gsz); u.pn = (wgid % nig) / gsz; return true;
    }
    __device__ __forceinline__ void a_ready(const Unit&) const {}
    __device__ __forceinline__ void done(const Unit&) const {}
};
struct MoeOrder {
    const LAS int* tile_e; int TT, sh, G, v;
    __device__ bool next(int i, Unit& u) const {
        const int per = G >> 3, x = v / per, j = v - x * per;
        const int t0 = (int)(((long)x * TT) >> 3), t1 = (int)(((long)(x + 1) * TT) >> 3);
        const int uu = i * per + j, rt = t0 + (uu >> sh), pnl = uu & ((1 << sh) - 1);
        if (rt >= t1) return false;
        u.pm = rt; u.pn = (tile_e[rt] << sh) + pnl; return true;
    }
    __device__ __forceinline__ void a_ready(const Unit&) const {}
    __device__ __forceinline__ void done(const Unit&) const {}
};

template <class Epi, class Sched, bool GATHER = false>
__device__ __forceinline__ void gemm_phase(LAS unsigned char* lds, const Gemm g, const Sched& S, const Epi& E, const int* rowidx = nullptr) {
    int tid_ = threadIdx.x; asm volatile("" : "+v"(tid_));
    const int tid = tid_, wid = __builtin_amdgcn_readfirstlane(tid >> 6), lane = tid & 63, wr = wid >> 2, wc = wid & 3, fr = lane & 15, fq = lane >> 4;
    const int K = g.K, nt = K / BK;
    unsigned voffA[2], voffB[2];
    int Rr[2], Cc2[2];
#pragma unroll
    for (int i = 0; i < 2; ++i) { int R, C; stage_rc(tid * 16 + i * 8192, R, C); voffA[i] = (unsigned)(R * K + C) * 2u; const int Rb = Epi::PERM ? ((R & ~31) + perm32(R & 31)) : R; voffB[i] = (unsigned)(Rb * K + C) * 2u; Rr[i] = R; Cc2[i] = C * 2; }
    unsigned gA0[2] = {0u, 0u}, gA1[2] = {0u, 0u}, nG0[2] = {0u, 0u}, nG1[2] = {0u, 0u};
#define PG8_ROWS(pm_, d0, d1) do { _Pragma("unroll") for (int _i = 0; _i < 2; ++_i) { d0[_i] = (unsigned)rowidx[(pm_) * BM + Rr[_i]] * (unsigned)(K * 2) + (unsigned)Cc2[_i]; d1[_i] = (unsigned)rowidx[(pm_) * BM + HALF + Rr[_i]] * (unsigned)(K * 2) + (unsigned)Cc2[_i]; } } while (0)
#define PG8_STAGE_A(bufoff, ptr, h, nx) do { if constexpr (GATHER) { unsigned _o[2]; _o[0] = (nx) ? ((h) ? nG1[0] : nG0[0]) : ((h) ? gA1[0] : gA0[0]); _o[1] = (nx) ? ((h) ? nG1[1] : nG0[1]) : ((h) ? gA1[1] : gA0[1]); PG8_STAGE(bufoff, ptr, _o); } \
        else { PG8_STAGE(bufoff, (ptr) + ((h) ? hstep : 0), voffA); } } while (0)
    const size_t kstep = (size_t)(BK * 2);
    const size_t hstep = (size_t)HALF * K * 2;
    const size_t tstep = 2 * hstep;
    const unsigned ldsw = (unsigned)wid * 1024u;
    const int aoff = lds_byte(wr * 64 + fr, fq * 8), boff = lds_byte(wc * 32 + fr, fq * 8);
#define PG8_SA(b, h) (((b) * 2 + (h)) * HTB)
#define PG8_SB(b, h) ((4 + (b) * 2 + (h)) * HTB)
#define PG8_STAGE(bufoff, gbase, voff) do { _Pragma("unroll") for (int _i = 0; _i < 2; ++_i) \
        __builtin_amdgcn_global_load_lds((const unsigned*)((const char*)(gbase) + (voff)[_i]), (LAS unsigned*)(lds + (bufoff) + ldsw + _i * 8192), 16, 0, 0); } while (0)
#define PG8_LDA(dst, b, h) do { _Pragma("unroll") for (int m = 0; m < 4; ++m) _Pragma("unroll") for (int k = 0; k < 2; ++k) dst[m][k] = *(const LAS bf16x8*)(lds + PG8_SA(b, h) + aoff + m * 2048 + k * 1024); } while (0)
#define PG8_LDB(dst, b, h) do { _Pragma("unroll") for (int n = 0; n < 2; ++n) _Pragma("unroll") for (int k = 0; k < 2; ++k) dst[n][k] = *(const LAS bf16x8*)(lds + PG8_SB(b, h) + boff + n * 2048 + k * 1024); } while (0)
#define PG8_MMA(ai, bj, At, Bt) do { __builtin_amdgcn_s_setprio(1); _Pragma("unroll") for (int m = 0; m < 4; ++m) _Pragma("unroll") for (int n = 0; n < 2; ++n) _Pragma("unroll") for (int k = 0; k < 2; ++k) \
        acc[ai][bj][m][n] = __builtin_amdgcn_mfma_f32_16x16x32_bf16(Bt[n][k], At[m][k], acc[ai][bj][m][n], 0, 0, 0); __builtin_amdgcn_s_setprio(0); } while (0)
#define PG8_WAIT_V(n) asm volatile("s_waitcnt vmcnt(" #n ")" ::: "memory")
#define PG8_WAIT_L(n) asm volatile("s_waitcnt lgkmcnt(" #n ")" ::: "memory")
#define PG8_BAR __builtin_amdgcn_s_barrier()
#define PG8_SCHED __builtin_amdgcn_sched_barrier(0)
    Unit cur, nxt; int ui = 0;
    if (!S.next(0, cur)) return;
    f32x4 acc[2][2][4][2];
#pragma unroll
    for (int a = 0; a < 2; ++a)
#pragma unroll
        for (int b = 0; b < 2; ++b)
#pragma unroll
            for (int m = 0; m < 4; ++m)
#pragma unroll
                for (int n = 0; n < 2; ++n) acc[a][b][m][n] = (f32x4){0.f, 0.f, 0.f, 0.f};
    bf16x8 At[4][2], B0[2][2], B1[2][2];
    const char* cA = GATHER ? (const char*)g.A : (const char*)g.A + (size_t)cur.pm * tstep; const char* cB = (const char*)g.Bt + (size_t)cur.pn * tstep;
    S.a_ready(cur);
    if constexpr (GATHER) PG8_ROWS(cur.pm, gA0, gA1);
    PG8_STAGE(PG8_SB(0, 0), cB, voffB); PG8_STAGE_A(PG8_SA(0, 0), cA, 0, false); PG8_STAGE(PG8_SB(0, 1), cB + hstep, voffB); PG8_STAGE_A(PG8_SA(0, 1), cA, 1, false);
    if (wr == 1) PG8_BAR;
    PG8_WAIT_V(4); PG8_BAR;
    PG8_STAGE(PG8_SB(1, 0), cB + kstep, voffB); PG8_STAGE_A(PG8_SA(1, 0), cA + kstep, 0, false); PG8_STAGE(PG8_SB(1, 1), cB + hstep + kstep, voffB);
    PG8_WAIT_V(6); PG8_BAR;
    for (;;) {
        const bool has_next = S.next(ui + 1, nxt);
        const char* nA = GATHER ? cA : (has_next ? (const char*)g.A + (size_t)nxt.pm * tstep : cA); const char* nB = has_next ? (const char*)g.Bt + (size_t)nxt.pn * tstep : cB;
        if constexpr (GATHER) { if (has_next) PG8_ROWS(nxt.pm, nG0, nG1); else { nG0[0] = gA0[0]; nG0[1] = gA0[1]; nG1[0] = gA1[0]; nG1[1] = gA1[1]; } }
        for (int t = 0; t < nt; t += 2) {
            const bool last = (t == nt - 2);
            const char* a1 = cA + (size_t)(t + 1) * kstep;
            const char* a2 = last ? nA : cA + (size_t)(t + 2) * kstep; const char* b2 = last ? nB : cB + (size_t)(t + 2) * kstep;
            const char* a3 = a2 + kstep; const char* b3 = b2 + kstep;
            if (last && has_next) S.a_ready(nxt);
            PG8_LDB(B0, 0, 0); PG8_SCHED; PG8_LDA(At, 0, 0); PG8_STAGE_A(PG8_SA(1, 1), a1, 1, false);
            PG8_WAIT_L(8); PG8_BAR; PG8_WAIT_L(0); PG8_MMA(0, 0, At, B0); PG8_BAR; PG8_SCHED;
            PG8_LDB(B1, 0, 1); PG8_STAGE(PG8_SB(0, 0), b2, voffB);
            PG8_BAR; PG8_WAIT_L(0); PG8_MMA(0, 1, At, B1); PG8_BAR;
            PG8_LDA(At, 0, 1); PG8_STAGE_A(PG8_SA(0, 0), a2, 0, last);
            PG8_BAR; PG8_WAIT_L(0); PG8_MMA(1, 0, At, B0); PG8_BAR; PG8_SCHED;
            PG8_STAGE(PG8_SB(0, 1), b2 + hstep, voffB);
            PG8_WAIT_V(6); PG8_BAR; PG8_MMA(1, 1, At, B1); PG8_BAR;
            PG8_LDB(B0, 1, 0); PG8_SCHED; PG8_LDA(At, 1, 0); PG8_STAGE_A(PG8_SA(0, 1), a2, 1, last);
            PG8_WAIT_L(8); PG8_BAR; PG8_WAIT_L(0); PG8_MMA(0, 0, At, B0); PG8_BAR; PG8_SCHED;
            PG8_LDB(B1, 1, 1); PG8_STAGE(PG8_SB(1, 0), b3, voffB);
            PG8_BAR; PG8_WAIT_L(0); PG8_MMA(0, 1, At, B1); PG8_BAR;
            PG8_LDA(At, 1, 1); PG8_STAGE_A(PG8_SA(1, 0), a3, 0, last);
            PG8_BAR; PG8_WAIT_L(0); PG8_MMA(1, 0, At, B0); PG8_BAR; PG8_SCHED;
            PG8_STAGE(PG8_SB(1, 1), b3 + hstep, voffB);
            PG8_WAIT_V(6); PG8_BAR; PG8_MMA(1, 1, At, B1); PG8_BAR;
        }
        E(acc, cur, wr, wc, fr, fq); S.done(cur);
        if (!has_next) break;
#pragma unroll
        for (int a = 0; a < 2; ++a)
#pragma unroll
            for (int b = 0; b < 2; ++b)
#pragma unroll
                for (int m = 0; m < 4; ++m)
#pragma unroll
                    for (int n = 0; n < 2; ++n) acc[a][b][m][n] = (f32x4){0.f, 0.f, 0.f, 0.f};
        cur = nxt; cA = nA; cB = nB; ++ui;
        if constexpr (GATHER) { gA0[0] = nG0[0]; gA0[1] = nG0[1]; gA1[0] = nG1[0]; gA1[1] = nG1[1]; }
    }
    PG8_WAIT_V(0);
    if (wr == 0) PG8_BAR;
    PG8_BAR;
#undef PG8_SA
#undef PG8_ROWS
#undef PG8_STAGE_A
#undef PG8_SB
#undef PG8_STAGE
#undef PG8_LDA
#undef PG8_LDB
#undef PG8_MMA
#undef PG8_WAIT_V
#undef PG8_WAIT_L
#undef PG8_BAR
#undef PG8_SCHED
}
}
using pg8::Unit;

__device__ __forceinline__ f32x4 ld_bf16x4(const bf16_t* p) { const u32x2 w = *(const u32x2*)p; return (f32x4){bflo(w.x), bfhi(w.x), bflo(w.y), bfhi(w.y)}; }
__device__ __forceinline__ void st_bf16x4(bf16_t* p, f32x4 v) { u32x2 w; w.x = pk2(v[0], v[1]); w.y = pk2(v[2], v[3]); *(u32x2*)p = w; }

struct EpiInProj {
    static constexpr bool PERM = true;
    bf16_t *Q, *V, *G; _Float16 *LFF, *LFB; const float* lbv;
    __device__ __forceinline__ void operator()(const f32x4 (&acc)[2][2][4][2], const Unit& u, int wr, int wc, int fr, int fq) const {
        const int seg = u.pn >> 2, cb = (u.pn & 3) * 256 + wc * 32 + 8 * fq, row0 = u.pm * 256 + wr * 64 + fr;
#pragma unroll
        for (int bj = 0; bj < 2; ++bj) {
            const int c = cb + bj * 128;
            f32x4 lb0 = (f32x4){0.f, 0.f, 0.f, 0.f}, lb1 = lb0;
            if (seg == 2 || seg == 3) { lb0 = *(const f32x4*)(lbv + (seg - 2) * D + c); lb1 = *(const f32x4*)(lbv + (seg - 2) * D + c + 4); }
#pragma unroll
            for (int ai = 0; ai < 2; ++ai)
#pragma unroll
                for (int m = 0; m < 4; ++m) {
                    const size_t ro = (size_t)(row0 + ai * 128 + m * 16) * D + c;
                    const f32x4 v0 = acc[ai][bj][m][0], v1 = acc[ai][bj][m][1];
                    if (seg == 0) { f32x4 o0, o1; for (int j = 0; j < 4; ++j) { o0[j] = silu_f(v0[j]); o1[j] = silu_f(v1[j]); }
                        *(u32x4*)(Q + ro) = (u32x4){pk2(o0[0], o0[1]), pk2(o0[2], o0[3]), pk2(o1[0], o1[1]), pk2(o1[2], o1[3])}; }
                    else if (seg == 1) { *(u32x4*)(V + ro) = (u32x4){pk2(v0[0], v0[1]), pk2(v0[2], v0[3]), pk2(v1[0], v1[1]), pk2(v1[2], v1[3])}; }
                    else if (seg == 4) { *(u32x4*)(G + ro) = (u32x4){pk2(v0[0], v0[1]), pk2(v0[2], v0[3]), pk2(v1[0], v1[1]), pk2(v1[2], v1[3])}; }
                    else {
                        f32x4 o0, o1;
                        for (int j = 0; j < 4; ++j) { o0[j] = __logf(lb0[j] + (1.0f - lb0[j]) * sigmoid_f(v0[j])); o1[j] = __logf(lb1[j] + (1.0f - lb1[j]) * sigmoid_f(v1[j])); }
                        u32x4 hw; hw.x = __builtin_bit_cast(unsigned, __builtin_amdgcn_cvt_pkrtz(o0[0], o0[1])); hw.y = __builtin_bit_cast(unsigned, __builtin_amdgcn_cvt_pkrtz(o0[2], o0[3]));
                        hw.z = __builtin_bit_cast(unsigned, __builtin_amdgcn_cvt_pkrtz(o1[0], o1[1])); hw.w = __builtin_bit_cast(unsigned, __builtin_amdgcn_cvt_pkrtz(o1[2], o1[3]));
                        *(u32x4*)((seg == 2 ? LFF : LFB) + ro) = hw;
                    }
                }
        }
    }
};
struct EpiResid {
    static constexpr bool PERM = true;
    const float* x; const float* ctx; const float* modv; bf16_t* H; int gate_off;
    __device__ __forceinline__ void operator()(const f32x4 (&acc)[2][2][4][2], const Unit& u, int wr, int wc, int fr, int fq) const {
        const int rt0 = u.pm * 256; const int mr = rt0 < NCTX ? 8 : ((rt0 - NCTX) >> 12);
        const float* src = rt0 < NCTX ? ctx + (size_t)rt0 * D : x + (size_t)(rt0 - NCTX) * D;
        const int cb = u.pn * 256 + wc * 32 + 8 * fq, rl0 = wr * 64 + fr;
        const float* gp = modv + mr * 6144 + gate_off;
#pragma unroll
        for (int bj = 0; bj < 2; ++bj) {
            const int c = cb + bj * 128; const f32x4 g0 = *(const f32x4*)(gp + c), g1 = *(const f32x4*)(gp + c + 4);
#pragma unroll
            for (int ai = 0; ai < 2; ++ai)
#pragma unroll
                for (int m = 0; m < 4; ++m) {
                    const int rl = rl0 + ai * 128 + m * 16; const float* hp = src + (size_t)rl * D + c; bf16_t* op = H + (size_t)(rt0 + rl) * D + c;
                    const f32x4 h0 = *(const f32x4*)hp, h1 = *(const f32x4*)(hp + 4);
                    const f32x4 o0 = h0 + g0 * acc[ai][bj][m][0], o1 = h1 + g1 * acc[ai][bj][m][1];
                    *(u32x4*)op = (u32x4){pk2(o0[0], o0[1]), pk2(o0[2], o0[3]), pk2(o1[0], o1[1]), pk2(o1[2], o1[3])};
                }
        }
    }
};

struct TrItem { const float* src; bf16_t* dst; int N; };
__device__ __forceinline__ void tr_load(const TrItem& t, f32x4 (&v)[16], int lane) {
    const float* p = t.src + (size_t)(2 * (lane >> 4)) * t.N + 4 * (lane & 15);
#pragma unroll
    for (int i = 0; i < 8; ++i) { v[2 * i] = *(const f32x4*)(p + (size_t)(8 * i) * t.N); v[2 * i + 1] = *(const f32x4*)(p + (size_t)(8 * i + 1) * t.N); }
}
__device__ __forceinline__ void tr_finish(const TrItem& t, const f32x4 (&v)[16], LAS unsigned* scr, int lane) {
#pragma unroll
    for (int i = 0; i < 8; ++i) {
        const int kp = 4 * i + (lane >> 4); LAS unsigned* s = scr + kp * 65 + 4 * (lane & 15);
        s[0] = cvt_pk_bf16(v[2 * i][0], v[2 * i + 1][0]); s[1] = cvt_pk_bf16(v[2 * i][1], v[2 * i + 1][1]); s[2] = cvt_pk_bf16(v[2 * i][2], v[2 * i + 1][2]); s[3] = cvt_pk_bf16(v[2 * i][3], v[2 * i + 1][3]);
    }
    LDS_WAIT();
    const int c = lane & 7;
#pragma unroll
    for (int j = 0; j < 8; ++j) {
        const int n = (lane >> 3) + 8 * j; const LAS unsigned* s = scr + (4 * c) * 65 + n;
        *(u32x4*)(t.dst + (size_t)n * 1024 + 8 * c) = (u32x4){s[0], s[65], s[130], s[195]};
    }
    LDS_WAIT();
}
__device__ __forceinline__ int ilv_row(int c) { const int bj = c >> 10, r = c & 1023; return (r >> 7) * 256 + bj * 128 + (r & 127); }

__device__ __forceinline__ TrItem moe_item(const Args& a, int r, int layer) {
    TrItem t;
    if (r < 32 * 512) { const int mat = layer * 32 + (r >> 9), sub = r & 511, kb = sub >> 5, nb = sub & 31;
        t.src = a.in[I_W1] + (size_t)mat * 1024 * 2048 + (size_t)(kb * 64) * 2048 + nb * 64; t.dst = (bf16_t*)(a.ws + WS_W1) + (size_t)mat * 2048 * 1024 + (size_t)ilv_row(nb * 64) * 1024 + kb * 64; t.N = 2048; }
    else { r -= 32 * 512; const int mat = layer * 32 + (r >> 8), sub = r & 255, kb = sub >> 4, nb = sub & 15;
        t.src = a.in[I_W2] + (size_t)mat * 1024 * 1024 + (size_t)(kb * 64) * 1024 + nb * 64; t.dst = (bf16_t*)(a.ws + WS_W2) + (size_t)mat * 1024 * 1024 + (size_t)(nb * 64) * 1024 + kb * 64; t.N = 1024; }
    return t;
}
constexpr int P0_NWIN = 16 * 80, P0_NWOUT = 16 * 16, P0_NWGLU = 16 * 32, P0_NITEMS = P0_NWIN + P0_NWOUT + P0_NWGLU + 32 * 512 + 32 * 256;
__device__ __forceinline__ TrItem p0_item(const Args& a, int r) {
    TrItem t;
    if (r < P0_NWIN) { const int kb = r / 80, nb = r % 80; t.src = a.in[I_HGWIN] + (size_t)(kb * 64) * 5120 + nb * 64; t.dst = (bf16_t*)(a.ws + WS_WIN) + (size_t)(nb * 64) * 1024 + kb * 64; t.N = 5120; return t; } r -= P0_NWIN;
    if (r < P0_NWOUT) { const int kb = r / 16, nb = r % 16; t.src = a.in[I_HGWOUT] + (size_t)(kb * 64) * 1024 + nb * 64; t.dst = (bf16_t*)(a.ws + WS_WOUT) + (size_t)(nb * 64) * 1024 + kb * 64; t.N = 1024; return t; } r -= P0_NWOUT;
    if (r < P0_NWGLU) { const int kb = r / 32, nb = r % 32; t.src = a.in[I_S5WGLU] + (size_t)(kb * 64) * 2048 + nb * 64; t.dst = (bf16_t*)(a.ws + WS_WGLU) + (size_t)ilv_row(nb * 64) * 1024 + kb * 64; t.N = 2048; return t; } r -= P0_NWGLU;
    return moe_item(a, r, 0);
}
#define TR_LOOP(first, stride, count, ITEM) do { int _it = (first); if (_it < (count)) { f32x4 _va[16], _vb[16]; TrItem _A = ITEM(_it), _B = _A; tr_load(_A, _va, lane); \
        for (;;) { const int _i2 = _it + (stride); const bool _h2 = _i2 < (count); if (_h2) { _B = ITEM(_i2); tr_load(_B, _vb, lane); } tr_finish(_A, _va, scr, lane); if (!_h2) break; \
                   _it = _i2 + (stride); const bool _h1 = _it < (count); if (_h1) { _A = ITEM(_it); tr_load(_A, _va, lane); } tr_finish(_B, _vb, scr, lane); if (!_h1) break; } } } while (0)
__device__ __forceinline__ void p0_phase(const Args& a, LAS unsigned char* lds, int tid, int gw, int NGW) {
    const int lane = tid & 63, wave = tid >> 6;
    unsigned char* ws = a.ws;
    float* modv = (float*)(ws + WS_MODV);
    if (blockIdx.x < 192) {
        LAS float* SC = (LAS float*)lds;
        LAS float* PART = (LAS float*)(lds + 40960);
        for (int i = tid; i < 9 * 1024; i += NTHREADS) { const int r = i >> 10, k = i & 1023; const float v = r < 8 ? a.in[I_C][r * 1024 + k] : a.in[I_CCTX][k]; SC[i] = silu_f(v); }
        __syncthreads();
        const int layer = blockIdx.x / 96, ng = blockIdx.x % 96;
        const float* W = a.in[I_MODW] + (size_t)layer * 1024 * 6144 + ng * 64 + lane;
        float acc[9];
#pragma unroll
        for (int r = 0; r < 9; ++r) acc[r] = 0.f;
#pragma unroll 8
        for (int kk = 0; kk < 128; ++kk) {
            const int k = wave * 128 + kk; const float w = W[(size_t)k * 6144];
#pragma unroll
            for (int r = 0; r < 9; ++r) acc[r] += SC[r * 1024 + k] * w;
        }
#pragma unroll
        for (int r = 0; r < 9; ++r) PART[(wave * 9 + r) * 64 + lane] = acc[r];
        __syncthreads();
        for (int i = tid; i < 9 * 64; i += NTHREADS) {
            const int r = i >> 6, l = i & 63; float s = a.in[I_MODB][layer * 6144 + ng * 64 + l];
#pragma unroll
            for (int w = 0; w < 8; ++w) s += PART[(w * 9 + r) * 64 + l];
            modv[(size_t)(layer * 9 + r) * 6144 + ng * 64 + l] = s;
        }
        __syncthreads();
    } else if (blockIdx.x == 192) {
        float* lbv = (float*)(ws + WS_LBV);
        for (int i = tid; i < 2048; i += NTHREADS) { const float l0 = a.in[I_HGLB][i], l1 = a.in[I_HGLB][2048 + i]; lbv[i] = 1.0f / (1.0f + __expf(l1 - l0)); }
    }
    LAS unsigned* scr = (LAS unsigned*)(lds + 59392 + wave * 8320);
#define P0_ITEM(i) p0_item(a, (i))
    TR_LOOP(gw, NGW, P0_NITEMS, P0_ITEM);
#undef P0_ITEM
}

__device__ __forceinline__ const float* hin_row(const Args& a, int row) { return row < NCTX ? a.in[I_CTX] + (size_t)row * D : a.in[I_X] + (size_t)(row - NCTX) * D; }
__device__ __forceinline__ int mod_row(int row) { return row < NCTX ? 8 : ((row - NCTX) >> 12); }
__device__ __forceinline__ float row_rstd(const f32x4 (&v)[4]) {
    float s = 0.f;
#pragma unroll
    for (int j = 0; j < 4; ++j) s += (v[j][0] * v[j][0] + v[j][1] * v[j][1]) + (v[j][2] * v[j][2] + v[j][3] * v[j][3]);
    return 1.0f / sqrtf(wave_sum(s) * (1.0f / D) + EPS);
}
__device__ __forceinline__ void norm_mod_store(const f32x4 (&v)[4], float rstd, const float* g, const float* sc, const float* sh, bf16_t* orow, int lane) {
#pragma unroll
    for (int j = 0; j < 4; ++j) {
        const int c = 4 * lane + 256 * j; const f32x4 gv = *(const f32x4*)(g + c), scv = *(const f32x4*)(sc + c), shv = *(const f32x4*)(sh + c);
        st_bf16x4(orow + c, v[j] * rstd * gv * (scv + 1.0f) + shv);
    }
}

__device__ __forceinline__ void p1_phase(const Args& a, int lane, int gw, int NGW) {
    const float* modv = (const float*)(a.ws + WS_MODV);
    bf16_t* A = (bf16_t*)(a.ws + WS_A);
    for (int row0 = gw * 4; row0 < NTOK; row0 += NGW * 4) {
        f32x4 v[4][4];
#pragma unroll
        for (int r = 0; r < 4; ++r) { const float* hr = hin_row(a, row0 + r);
#pragma unroll
            for (int j = 0; j < 4; ++j) v[r][j] = *(const f32x4*)(hr + 4 * lane + 256 * j); }
        const float* mv = modv + (size_t)mod_row(row0) * 6144;
#pragma unroll
        for (int r = 0; r < 4; ++r) { const float rstd = row_rstd(v[r]); norm_mod_store(v[r], rstd, a.in[I_N1G], mv + 1024, mv, A + (size_t)(row0 + r) * D, lane); }
    }
}

__device__ __forceinline__ int gla_row(int n, int t, int b, int dir) {
    const bool isctx = n < 4; const int cn = isctx ? n : n - 4, slen = isctx ? CTXL : SEQ, rbase = isctx ? b * CTXL : NCTX + b * SEQ;
    const int pos = cn * 64 + t; return rbase + (dir ? slen - 1 - pos : pos);
}
__device__ __forceinline__ void gla_phase(const Args& a, LAS unsigned char* lds, int tid) {
    const int lane = tid & 63, wave = tid >> 6, fr = lane & 15, fq = lane >> 4;
    LAS unsigned char* QS = lds;
    LAS unsigned char* KS = lds + 17408;
    LAS unsigned char* QIN = lds + 34816;
    LAS unsigned char* KOT = lds + 52224;
    LAS unsigned char* VT = lds + 70656;
    LAS unsigned char* ST0 = lds + 79872;
    LAS unsigned char* PPW = lds + 114688 + wave * 2304;
    LAS float* GT0 = (LAS float*)(lds + 133120);
    LAS float* BL = (LAS float*)(lds + 141312);
    const bf16_t* Qg = (const bf16_t*)(a.ws + WS_Q); const bf16_t* Vg = (const bf16_t*)(a.ws + WS_V);
    for (int item = blockIdx.x; item < 256; item += gridDim.x) {
        const int vs = item & 1, dir = (item >> 1) & 1, h = (item >> 2) & 7, b = item >> 5;
        const _Float16* LF = (const _Float16*)(a.ws + (dir ? WS_LFB : WS_LFF)); bf16_t* Og = (bf16_t*)(a.ws + (dir ? WS_OB : WS_OF));
        f32x4 Sacc[4];
#pragma unroll
        for (int i = 0; i < 4; ++i) Sacc[i] = (f32x4){0.f, 0.f, 0.f, 0.f};
        for (int i = tid; i < 2 * 17408 / 4; i += NTHREADS) ((LAS unsigned*)ST0)[i] = 0u;
        const int kc2 = (tid & 63) * 2, tg = tid >> 6, chq = h * 128 + kc2;
        const int vt_t = tid >> 3, vt_v8 = (tid & 7) * 8;
        unsigned lf2[8], q2[8]; u32x4 vv;
#define GLA_LOAD(n_) do { _Pragma("unroll") for (int i = 0; i < 8; ++i) { const size_t o = (size_t)gla_row(n_, tg * 8 + i, b, dir) * D + chq; lf2[i] = *(const unsigned*)(LF + o); q2[i] = *(const unsigned*)(Qg + o); } \
            vv = *(const u32x4*)(Vg + (size_t)gla_row(n_, vt_t, b, dir) * D + h * 128 + vs * 64 + vt_v8); } while (0)
        float fa[8], fb[8], bca[8], bcb[8];
#define GLA_CUMSUM(par_) do { float csa = 0.f, csb = 0.f; _Pragma("unroll") for (int i = 0; i < 8; ++i) { typedef _Float16 h2 __attribute__((ext_vector_type(2))); const h2 hv = __builtin_bit_cast(h2, lf2[i]); \
            const float la = (float)hv[0], lb_ = (float)hv[1]; fa[i] = __expf(la); fb[i] = __expf(lb_); csa += la; csb += lb_; bca[i] = csa; bcb[i] = csb; } \
            *(LAS f32x2*)(GT0 + (par_) * 1024 + tg * 128 + kc2) = (f32x2){csa, csb}; } while (0)
        GLA_LOAD(0);
        GLA_CUMSUM(0);
        __syncthreads();
        for (int n = 0; n < 68; ++n) {
            const int par = n & 1;
            LAS unsigned char* STc = ST0 + par * 17408; LAS unsigned char* STn = ST0 + (par ^ 1) * 17408;
            { const unsigned w[4] = {vv.x, vv.y, vv.z, vv.w};
#pragma unroll
              for (int i = 0; i < 4; ++i) { *(LAS bf16_t*)(VT + (vt_v8 + 2 * i) * 144 + vt_t * 2) = (bf16_t)(w[i] & 0xffffu); *(LAS bf16_t*)(VT + (vt_v8 + 2 * i + 1) * 144 + vt_t * 2) = (bf16_t)(w[i] >> 16); } }
#define GLA_OSTORE(n_) do { const u32x4 od = *(const LAS u32x4*)(PPW + (lane >> 2) * 144 + (lane & 3) * 16); \
                *(u32x4*)(Og + (size_t)gla_row(n_, (wave >> 1) * 16 + (lane >> 2), b, dir) * D + h * 128 + vs * 64 + (wave & 1) * 32 + (lane & 3) * 8) = od; } while (0)
            if (n > 0) GLA_OSTORE(n - 1);
            f32x2 pre = (f32x2){0.f, 0.f}, bref = (f32x2){0.f, 0.f}, blast = (f32x2){0.f, 0.f};
#pragma unroll
            for (int g8 = 0; g8 < 8; ++g8) { const f32x2 gv = *(const LAS f32x2*)(GT0 + par * 1024 + g8 * 128 + kc2); if (g8 < tg) pre += gv; if (g8 < 4) bref += gv; blast += gv; }
            const float era = __expf(bref.x), erb = __expf(bref.y), ela = __expf(blast.x - bref.x), elb = __expf(blast.y - bref.y);
            float e1a = __expf(pre.x - bref.x), e1b = __expf(pre.y - bref.y);
            unsigned kota[4], kotb[4];
#pragma unroll
            for (int i = 0; i < 8; ++i) {
                const int t = tg * 8 + i;
                const float qa = bflo(q2[i]), qb = bfhi(q2[i]);
                e1a *= fa[i]; e1b *= fb[i];
                const float ka = 1.0f - fa[i], kb = 1.0f - fb[i];
                const float e2a = __builtin_amdgcn_rcpf(e1a), e2b = __builtin_amdgcn_rcpf(e1b);
                const float qsa = qa * e1a, qsb = qb * e1b, ksa = ka * e2a, ksb = kb * e2b;
                *(LAS unsigned*)(QS + t * 272 + kc2 * 2) = cvt_pk_bf16(qsa, qsb);
                *(LAS unsigned*)(KS + t * 272 + kc2 * 2) = cvt_pk_bf16(ksa, ksb);
                *(LAS unsigned*)(QIN + t * 272 + kc2 * 2) = cvt_pk_bf16(qsa * era, qsb * erb);
                const unsigned ko = cvt_pk_bf16(ksa * ela, ksb * elb);
                if (i & 1) { kota[i >> 1] |= ko << 16; kotb[i >> 1] |= ko & 0xffff0000u; } else { kota[i >> 1] = ko & 0xffffu; kotb[i >> 1] = ko >> 16; }
            }
            *(LAS u32x4*)(KOT + kc2 * 144 + tg * 16) = (u32x4){kota[0], kota[1], kota[2], kota[3]};
            *(LAS u32x4*)(KOT + (kc2 + 1) * 144 + tg * 16) = (u32x4){kotb[0], kotb[1], kotb[2], kotb[3]};
            if (tg == 0) *(LAS f32x2*)(BL + kc2) = (f32x2){__expf(blast.x), __expf(blast.y)};
            if (n + 1 < 68) GLA_LOAD(n + 1);
            __syncthreads();
            const int tt = wave >> 1;
            bf16x8 aq[4];
#pragma unroll
            for (int kk = 0; kk < 4; ++kk) aq[kk] = *(const LAS bf16x8*)(QS + (tt * 16 + fr) * 272 + (kk * 32 + fq * 8) * 2);
#pragma unroll
            for (int st = 0; st < 4; ++st) {
                f32x4 acc = (f32x4){0.f, 0.f, 0.f, 0.f};
                if (st <= tt) {
#pragma unroll
                    for (int kk = 0; kk < 4; ++kk) {
                        const bf16x8 bv = *(const LAS bf16x8*)(KS + (st * 16 + fr) * 272 + (kk * 32 + fq * 8) * 2);
                        acc = __builtin_amdgcn_mfma_f32_16x16x32_bf16(aq[kk], bv, acc, 0, 0, 0);
                    }
                }
#pragma unroll
                for (int j = 0; j < 4; ++j) { const int tl = fq * 4 + j, s = st * 16 + fr; *(LAS bf16_t*)(PPW + tl * 144 + s * 2) = (bf16_t)f2bf(s <= tt * 16 + tl ? acc[j] : 0.f); }
            }
            LDS_WAIT();
            unsigned ow[2][2];
            bf16x8 ap[2], ai[4];
#pragma unroll
            for (int kk = 0; kk < 2; ++kk) ap[kk] = *(const LAS bf16x8*)(PPW + fr * 144 + (kk * 32 + fq * 8) * 2);
#pragma unroll
            for (int kk = 0; kk < 4; ++kk) ai[kk] = *(const LAS bf16x8*)(QIN + (tt * 16 + fr) * 272 + (kk * 32 + fq * 8) * 2);
#pragma unroll
            for (int vti = 0; vti < 2; ++vti) {
                const int vt = 2 * (wave & 1) + vti; f32x4 acc = (f32x4){0.f, 0.f, 0.f, 0.f};
#pragma unroll
                for (int kk = 0; kk < 2; ++kk) {
                    const bf16x8 bv = *(const LAS bf16x8*)(VT + (vt * 16 + fr) * 144 + (kk * 32 + fq * 8) * 2);
                    acc = __builtin_amdgcn_mfma_f32_16x16x32_bf16(ap[kk], bv, acc, 0, 0, 0);
                }
#pragma unroll
                for (int kk = 0; kk < 4; ++kk) {
                    const bf16x8 bv = *(const LAS bf16x8*)(STc + (vt * 16 + fr) * 272 + (kk * 32 + fq * 8) * 2);
                    acc = __builtin_amdgcn_mfma_f32_16x16x32_bf16(ai[kk], bv, acc, 0, 0, 0);
                }
                ow[vti][0] = cvt_pk_bf16(acc[0], acc[1]); ow[vti][1] = cvt_pk_bf16(acc[2], acc[3]);
            }
#pragma unroll
            for (int vti = 0; vti < 2; ++vti)
#pragma unroll
                for (int j = 0; j < 4; ++j) { const unsigned w = ow[vti][j >> 1]; *(LAS bf16_t*)(PPW + (fq * 4 + j) * 144 + (vti * 16 + fr) * 2) = (bf16_t)((j & 1) ? (w >> 16) : (w & 0xffffu)); }
            bf16x8 ak[2]; const f32x4 blv = *(const LAS f32x4*)(BL + wave * 16 + fq * 4);
#pragma unroll
            for (int kk = 0; kk < 2; ++kk) ak[kk] = *(const LAS bf16x8*)(KOT + (wave * 16 + fr) * 144 + (kk * 32 + fq * 8) * 2);
#pragma unroll
            for (int vt = 0; vt < 4; ++vt) {
                Sacc[vt] *= blv;
#pragma unroll
                for (int kk = 0; kk < 2; ++kk) {
                    const bf16x8 bv = *(const LAS bf16x8*)(VT + (vt * 16 + fr) * 144 + (kk * 32 + fq * 8) * 2);
                    Sacc[vt] = __builtin_amdgcn_mfma_f32_16x16x32_bf16(ak[kk], bv, Sacc[vt], 0, 0, 0);
                }
                *(LAS u32x2*)(STn + (vt * 16 + fr) * 272 + (wave * 16 + fq * 4) * 2) = (u32x2){pk2(Sacc[vt][0], Sacc[vt][1]), pk2(Sacc[vt][2], Sacc[vt][3])};
            }
            if (n + 1 < 68) GLA_CUMSUM(par ^ 1);
            __syncthreads();
        }
        GLA_OSTORE(67);
    }
}
#undef GLA_OSTORE
#undef GLA_CUMSUM
#undef GLA_LOAD
__device__ __forceinline__ void gla_readout_phase(const Args& a, int lane, int gw, int NGW) {
    const bf16_t* OF = (const bf16_t*)(a.ws + WS_OF); const bf16_t* OB = (const bf16_t*)(a.ws + WS_OB);
    const bf16_t* G = (const bf16_t*)(a.ws + WS_G); bf16_t* OG = (bf16_t*)(a.ws + WS_OG);
    f32x4 ng[4];
#pragma unroll
    for (int j = 0; j < 4; ++j) ng[j] = *(const f32x4*)(a.in[I_HGNG] + 16 * lane + 4 * j);
    for (int row0 = gw * 4; row0 < NTOK; row0 += NGW * 4) {
        u32x4 of[4][2], ob[4][2], gg[4][2];
#pragma unroll
        for (int r = 0; r < 4; ++r) { const size_t o = (size_t)(row0 + r) * D + 16 * lane;
            of[r][0] = *(const u32x4*)(OF + o); of[r][1] = *(const u32x4*)(OF + o + 8); ob[r][0] = *(const u32x4*)(OB + o); ob[r][1] = *(const u32x4*)(OB + o + 8);
            gg[r][0] = *(const u32x4*)(G + o); gg[r][1] = *(const u32x4*)(G + o + 8); }
#pragma unroll
        for (int r = 0; r < 4; ++r) {
            float v[16]; float s = 0.f;
#pragma unroll
            for (int q = 0; q < 8; ++q) { const unsigned wf = of[r][q >> 2][q & 3], wb = ob[r][q >> 2][q & 3]; v[2 * q] = bflo(wf) + bflo(wb); v[2 * q + 1] = bfhi(wf) + bfhi(wb); s += v[2 * q] * v[2 * q] + v[2 * q + 1] * v[2 * q + 1]; }
            s += __shfl_xor(s, 1); s += __shfl_xor(s, 2); s += __shfl_xor(s, 4);
            const float rstd = 1.0f / sqrtf(s * (1.0f / 128.0f) + EPS);
            unsigned ow[8];
#pragma unroll
            for (int q = 0; q < 8; ++q) { const unsigned wg = gg[r][q >> 2][q & 3];
                ow[q] = pk2(v[2 * q] * rstd * ng[q >> 1][(2 * q) & 3] * silu_f(bflo(wg)), v[2 * q + 1] * rstd * ng[q >> 1][(2 * q + 1) & 3] * silu_f(bfhi(wg))); }
            const size_t o = (size_t)(row0 + r) * D + 16 * lane;
            *(u32x4*)(OG + o) = (u32x4){ow[0], ow[1], ow[2], ow[3]}; *(u32x4*)(OG + o + 8) = (u32x4){ow[4], ow[5], ow[6], ow[7]};
        }
    }
}

struct EpiMoe1 {
    static constexpr bool PERM = true;
    const float* b1; bf16_t* ACT;
    __device__ __forceinline__ void operator()(const f32x4 (&acc)[2][2][4][2], const Unit& u, int wr, int wc, int fr, int fq) const {
        const int e = u.pn >> 3, pnl = u.pn & 7, cb = pnl * 128 + wc * 32 + 8 * fq, row0 = u.pm * 256 + wr * 64 + fr;
        const float* bg = b1 + (size_t)e * 2048;
        const f32x4 bg0 = *(const f32x4*)(bg + cb), bg1 = *(const f32x4*)(bg + cb + 4), bl0 = *(const f32x4*)(bg + 1024 + cb), bl1 = *(const f32x4*)(bg + 1024 + cb + 4);
#pragma unroll
        for (int ai = 0; ai < 2; ++ai)
#pragma unroll
            for (int m = 0; m < 4; ++m) {
                f32x4 o[2];
#pragma unroll
                for (int n = 0; n < 2; ++n) {
                    const f32x4 zg = acc[ai][0][m][n] + (n ? bg1 : bg0), zl = acc[ai][1][m][n] + (n ? bl1 : bl0);
#pragma unroll
                    for (int j = 0; j < 4; ++j) { const float g_ = fminf(zg[j], 7.0f), l_ = fminf(fmaxf(zl[j], -7.0f), 7.0f); o[n][j] = g_ * sigmoid_f(1.702f * g_) * (l_ + 1.0f); }
                }
                *(u32x4*)(ACT + (size_t)(row0 + ai * 128 + m * 16) * D + cb) = (u32x4){pk2(o[0][0], o[0][1]), pk2(o[0][2], o[0][3]), pk2(o[1][0], o[1][1]), pk2(o[1][2], o[1][3])};
            }
    }
};
struct EpiMoe2 {
    static constexpr bool PERM = true;
    const float* b2; bf16_t* YS;
    __device__ __forceinline__ void operator()(const f32x4 (&acc)[2][2][4][2], const Unit& u, int wr, int wc, int fr, int fq) const {
        const int e = u.pn >> 2, pnl = u.pn & 3, cb = pnl * 256 + wc * 32 + 8 * fq, row0 = u.pm * 256 + wr * 64 + fr;
        const float* bb = b2 + (size_t)e * 1024;
#pragma unroll
        for (int bj = 0; bj < 2; ++bj) {
            const int c = cb + bj * 128; const f32x4 bv0 = *(const f32x4*)(bb + c), bv1 = *(const f32x4*)(bb + c + 4);
#pragma unroll
            for (int ai = 0; ai < 2; ++ai)
#pragma unroll
                for (int m = 0; m < 4; ++m) {
                    const f32x4 v0 = acc[ai][bj][m][0] + bv0, v1 = acc[ai][bj][m][1] + bv1;
                    *(u32x4*)(YS + (size_t)(row0 + ai * 128 + m * 16) * D + c) = (u32x4){pk2(v0[0], v0[1]), pk2(v0[2], v0[3]), pk2(v1[0], v1[1]), pk2(v1[2], v1[3])};
                }
        }
    }
};

__device__ __forceinline__ void router_phase(const Args& a, LAS unsigned char* lds, int layer, int row_lo, int tid) {
    const int lane = tid & 63, wave = tid >> 6, fr = lane & 15, fq = lane >> 4;
    const bf16_t* H = (const bf16_t*)(a.ws + WS_H); bf16_t* F = (bf16_t*)(a.ws + WS_F);
    const float* modv = (const float*)(a.ws + WS_MODV) + (size_t)layer * 9 * 6144;
    int* TOKE = (int*)(a.ws + WS_TOKE); float* TOKW = (float*)(a.ws + WS_TOKW);
    unsigned* cntb = (unsigned*)(a.ws + WS_CTL) + CW_CNTB + layer * 8192;
    LAS float* FS = (LAS float*)lds;
    LAS float* PART = (LAS float*)(lds + 16 * 1028 * 4);
    LAS int* hist = (LAS int*)(lds + 16 * 1028 * 4 + 16384);
    if (tid < 32) hist[tid] = 0;
    const float* n2g = a.in[I_N2G] + layer * D; const float* rw = a.in[I_RW] + (size_t)layer * D * NE; const float* rb = a.in[I_RB] + layer * NE;
    float rwr[2][32];
#pragma unroll
    for (int s = 0; s < 32; ++s) { rwr[0][s] = rw[(size_t)(wave * 128 + 4 * s + fq) * NE + fr]; rwr[1][s] = rw[(size_t)(wave * 128 + 4 * s + fq) * NE + 16 + fr]; }
    const int ngroups = (NTOK - row_lo) >> 4;
    f32x4 vv[2][4];
#define RT_LOAD(gi_) do { _Pragma("unroll") for (int rr = 0; rr < 2; ++rr) _Pragma("unroll") for (int j = 0; j < 4; ++j) \
        vv[rr][j] = ld_bf16x4(H + (size_t)(row_lo + (gi_) * 16 + 2 * wave + rr) * D + 4 * lane + 256 * j); } while (0)
    if ((int)blockIdx.x < ngroups) RT_LOAD(blockIdx.x);
    for (int gi = blockIdx.x; gi < ngroups; gi += gridDim.x) {
        const int row0 = row_lo + gi * 16;
        __syncthreads();
#pragma unroll
        for (int rr = 0; rr < 2; ++rr) {
            const int rl = 2 * wave + rr, row = row0 + rl; const f32x4 (&v)[4] = vv[rr];
            const float rstd = row_rstd(v); const float* mv = modv + (size_t)mod_row(row) * 6144;
#pragma unroll
            for (int j = 0; j < 4; ++j) {
                const int c = 4 * lane + 256 * j; const f32x4 gv = *(const f32x4*)(n2g + c), scv = *(const f32x4*)(mv + 4096 + c), shv = *(const f32x4*)(mv + 3072 + c);
                const f32x4 f = v[j] * rstd * gv * (scv + 1.0f) + shv;
                st_bf16x4(F + (size_t)row * D + c, f);
                *(LAS f32x4*)(FS + rl * 1028 + c) = f;
            }
        }
        if (gi + (int)gridDim.x < ngroups) RT_LOAD(gi + gridDim.x);
        __syncthreads();
        f32x4 acc0 = (f32x4){0.f, 0.f, 0.f, 0.f}, acc1 = (f32x4){0.f, 0.f, 0.f, 0.f};
#pragma unroll
        for (int s = 0; s < 32; ++s) {
            const float av = FS[fr * 1028 + wave * 128 + 4 * s + fq];
            acc0 = __builtin_amdgcn_mfma_f32_16x16x4f32(av, rwr[0][s], acc0, 0, 0, 0);
            acc1 = __builtin_amdgcn_mfma_f32_16x16x4f32(av, rwr[1][s], acc1, 0, 0, 0);
        }
#pragma unroll
        for (int j = 0; j < 4; ++j) { PART[(wave * 16 + fq * 4 + j) * 32 + fr] = acc0[j]; PART[(wave * 16 + fq * 4 + j) * 32 + 16 + fr] = acc1[j]; }
        __syncthreads();
        {
            const int half = lane >> 5, e = lane & 31, rl = 2 * wave + half, row = row0 + rl;
            float lg = rb[e];
#pragma unroll
            for (int w = 0; w < 8; ++w) lg += PART[(w * 16 + rl) * 32 + e];
            float sv[4]; int si[4];
#pragma unroll
            for (int r = 0; r < 4; ++r) {
                float m = lg;
#pragma unroll
                for (int o = 1; o < 32; o <<= 1) m = fmaxf(m, __shfl_xor(m, o));
                const unsigned long long bal = __ballot(lg == m); const unsigned mine = (unsigned)(bal >> (32 * half));
                const int idx = __ffs((int)mine) - 1;
                sv[r] = m; si[r] = idx; if (e == idx) lg = -3.0e38f;
            }
            const float e1 = __expf(sv[1] - sv[0]), e2 = __expf(sv[2] - sv[0]), e3 = __expf(sv[3] - sv[0]); const float inv = 1.0f / (1.0f + e1 + e2 + e3);
            if (e < 4) {
                const int myi = e == 0 ? si[0] : (e == 1 ? si[1] : (e == 2 ? si[2] : si[3]));
                const float myw = (e == 0 ? 1.0f : (e == 1 ? e1 : (e == 2 ? e2 : e3))) * inv;
                TOKE[(size_t)row * 4 + e] = myi; TOKW[(size_t)row * 4 + e] = myw;
                atomicAdd((int*)hist + myi, 1);
            }
        }
    }
    __syncthreads();
    if (tid < 32) cntb[(size_t)blockIdx.x * 32 + tid] = (unsigned)hist[tid];
}
#undef RT_LOAD
__device__ __forceinline__ void assign_phase(const Args& a, LAS unsigned char* lds, int layer, int row_lo, int tid) {
    const int lane = tid & 63, wave = tid >> 6;
    const unsigned* cntb = (const unsigned*)(a.ws + WS_CTL) + CW_CNTB + layer * 8192; unsigned* gcnt = (unsigned*)(a.ws + WS_CTL) + CW_CNT + layer * 64;
    const bf16_t* F = (const bf16_t*)(a.ws + WS_F); bf16_t* AG = (bf16_t*)(a.ws + WS_AG);
    const int* TOKE = (const int*)(a.ws + WS_TOKE); int* TOKS = (int*)(a.ws + WS_TOKS);
    LAS int* off = (LAS int*)lds; LAS int* cnt = (LAS int*)(lds + 256); LAS int* base = (LAS int*)(lds + 512); LAS int* cur = (LAS int*)(lds + 768);
    LAS int* pa = (LAS int*)(lds + 1024); LAS int* pl = (LAS int*)(lds + 1024 + 2048);
    {
        const int e = tid & 31, part = tid >> 5; int s_all = 0, s_lt = 0;
        for (int bb = part; bb < (int)gridDim.x; bb += 16) { const int c = (int)cntb[(size_t)bb * 32 + e]; s_all += c; if (bb < (int)blockIdx.x) s_lt += c; }
        pa[part * 32 + e] = s_all; pl[part * 32 + e] = s_lt;
    }
    __syncthreads();
    if (tid < 32) { int s_all = 0, s_lt = 0; for (int p = 0; p < 16; ++p) { s_all += pa[p * 32 + tid]; s_lt += pl[p * 32 + tid]; } cnt[tid] = s_all; base[tid] = s_lt; cur[tid] = 0; if (blockIdx.x == 0) gcnt[tid] = (unsigned)s_all; }
    __syncthreads();
    if (tid == 0) { int o = 0; for (int e = 0; e < 32; ++e) { off[e] = o; o += ((cnt[e] + 255) >> 8) << 8; } }
    __syncthreads();
    if (tid < 32) base[tid] += off[tid];
    __syncthreads();
    const int gw = blockIdx.x * 8 + wave, NGW = gridDim.x * 8;
    int* SLOTTOK = (int*)(a.ws + WS_SLOTTOK);
    for (int idx = blockIdx.x * NTHREADS + tid; idx < 32 * 256; idx += gridDim.x * NTHREADS) {
        const int e = idx >> 8, c = cnt[e], r = c + (idx & 255), padded = ((c + 255) >> 8) << 8;
        if (r < padded) SLOTTOK[off[e] + r] = 0;
    }
    const int ngroups = (NTOK - row_lo) >> 4;
    for (int gi = blockIdx.x; gi < ngroups; gi += gridDim.x) {
        const int r0 = row_lo + gi * 16 + 2 * wave;
        if (lane < 8) { const int e = TOKE[(size_t)r0 * 4 + lane]; const int pos = atomicAdd((int*)cur + e, 1); const int slot = base[e] + pos; TOKS[(size_t)r0 * 4 + lane] = slot; SLOTTOK[slot] = r0 + (lane >> 2); }
    }
    (void)gw; (void)NGW; (void)F; (void)AG;
}
__device__ __forceinline__ int moe_tiles(const Args& a, LAS unsigned char* lds, int layer, int tid) {
    const unsigned* gcnt = (const unsigned*)(a.ws + WS_CTL) + CW_CNT + layer * 64;
    LAS int* tbl = (LAS int*)(lds + 131072 + 1024);
    if (tid == 0) { int t = 0; for (int e = 0; e < 32; ++e) { const int nt = ((int)gcnt[e] + 255) >> 8; for (int k = 0; k < nt; ++k) tbl[t++] = e; } tbl[1000] = t; }
    __syncthreads();
    return tbl[1000];
}
__device__ __forceinline__ void combine_phase(const Args& a, int layer, int row_lo, int lane, int gw, int NGW) {
    bf16_t* H = (bf16_t*)(a.ws + WS_H); const bf16_t* YS = (const bf16_t*)(a.ws + WS_YS);
    const int* TOKS = (const int*)(a.ws + WS_TOKS); const float* TOKW = (const float*)(a.ws + WS_TOKW);
    const float* modv = (const float*)(a.ws + WS_MODV);
    for (int row0 = row_lo + gw * 2; row0 < NTOK; row0 += NGW * 2) {
        const int mr = mod_row(row0);
        u32x4 sl[2]; f32x4 wv[2];
#pragma unroll
        for (int r = 0; r < 2; ++r) { sl[r] = *(const u32x4*)(TOKS + (size_t)(row0 + r) * 4); wv[r] = *(const f32x4*)(TOKW + (size_t)(row0 + r) * 4); }
        u32x2 ys[2][4][4]; f32x4 hv[2][4];
#pragma unroll
        for (int r = 0; r < 2; ++r)
#pragma unroll
            for (int j = 0; j < 4; ++j) {
                hv[r][j] = ld_bf16x4(H + (size_t)(row0 + r) * D + 4 * lane + 256 * j);
#pragma unroll
                for (int k = 0; k < 4; ++k) ys[r][k][j] = *(const u32x2*)(YS + (size_t)sl[r][k] * D + 4 * lane + 256 * j);
            }
        const float* g2 = modv + (size_t)(layer * 9 + mr) * 6144 + 5120;
#pragma unroll
        for (int r = 0; r < 2; ++r) {
            const int row = row0 + r; f32x4 v[4];
#pragma unroll
            for (int j = 0; j < 4; ++j) {
                const int c = 4 * lane + 256 * j; f32x4 y = (f32x4){0.f, 0.f, 0.f, 0.f};
#pragma unroll
                for (int k = 0; k < 4; ++k) { const u32x2 w = ys[r][k][j]; y += (f32x4){bflo(w.x), bfhi(w.x), bflo(w.y), bfhi(w.y)} * wv[r][k]; }
                v[j] = hv[r][j] + *(const f32x4*)(g2 + c) * y;
                if (layer == 0) st_bf16x4(H + (size_t)row * D + c, v[j]);
            }
            const float rstd = row_rstd(v);
            if (layer == 0) {
                const float* mv = modv + (size_t)(9 + mr) * 6144;
                int orow = row;
                if (row >= NCTX) { const int li = row - NCTX, b = li >> 12, t = li & 4095; orow = NCTX + b * SEQ + (t & 63) * 64 + (t >> 6); }
                norm_mod_store(v, rstd, a.in[I_N1G] + D, mv + 1024, mv, (bf16_t*)(a.ws + WS_A) + (size_t)orow * D, lane);
            } else {
#pragma unroll
                for (int j = 0; j < 4; ++j) { const int c = 4 * lane + 256 * j; *(f32x4*)(a.out + (size_t)(row - NCTX) * D + c) = v[j] * rstd * *(const f32x4*)(a.in[I_FG] + c); }
            }
        }
    }
}
__device__ __forceinline__ void moe_gemm1(const Args& a, LAS unsigned char* lds, int layer, int tid, int G, int vcu) {
    unsigned char* ws = a.ws;
    const int TT = moe_tiles(a, lds, layer, tid);
    const LAS int* tbl = (const LAS int*)(lds + 131072 + 1024);
    pg8::Gemm g{(const bf16_t*)(ws + WS_F), (const bf16_t*)(ws + WS_W1) + (size_t)layer * 32 * 2048 * 1024, MPAD, 32 * 2048, 1024};
    pg8::MoeOrder S{tbl, TT, 3, G, vcu};
    EpiMoe1 E{a.in[I_B1] + (size_t)layer * 32 * 2048, (bf16_t*)(ws + WS_ACT)};
    pg8::gemm_phase<EpiMoe1, pg8::MoeOrder, true>(lds, g, S, E, (const int*)(ws + WS_SLOTTOK));
}
__device__ __forceinline__ void moe_gemm2(const Args& a, LAS unsigned char* lds, int layer, int tid, int G, int vcu) {
    unsigned char* ws = a.ws;
    const int TT = moe_tiles(a, lds, layer, tid);
    const LAS int* tbl = (const LAS int*)(lds + 131072 + 1024);
    pg8::Gemm g{(const bf16_t*)(ws + WS_ACT), (const bf16_t*)(ws + WS_W2) + (size_t)layer * 32 * 1024 * 1024, MPAD, 32 * 1024, 1024};
    pg8::MoeOrder S{tbl, TT, 2, G, vcu};
    EpiMoe2 E{a.in[I_B2] + (size_t)layer * 32 * 1024, (bf16_t*)(ws + WS_YS)};
    pg8::gemm_phase<EpiMoe2, pg8::MoeOrder>(lds, g, S, E);
}


__device__ __forceinline__ void s5_disc(const Args& a, int d, int g, int p, float& ab_re, float& ab_im, float& co_re, float& co_im) {
    const float lam_re = fminf(a.in[I_S5ARE][(d * 64 + g) * 64 + p], -1e-4f), lam_im = a.in[I_S5AIM][(d * 64 + g) * 64 + p];
    const float dt = expf(a.in[I_S5LDT][d * 64 + g]);
    const float mag = expf(lam_re * dt), ang = lam_im * dt;
    ab_re = mag * cosf(ang); ab_im = mag * sinf(ang);
    const float den = lam_re * lam_re + lam_im * lam_im;
    co_re = ((ab_re - 1.0f) * lam_re + ab_im * lam_im) / den;
    co_im = (ab_im * lam_re - (ab_re - 1.0f) * lam_im) / den;
}
__device__ __forceinline__ void s5_phase(const Args& a, LAS unsigned char* lds, int tid) {
    const int lane = tid & 63, wave = tid >> 6, fr = lane & 15, fq = lane >> 4;
    if (wave >= 4) {
        LAS unsigned* scr = (LAS unsigned*)(lds + 102400 + (wave - 4) * 8320);
        const int cw = blockIdx.x * 4 + (wave - 4), NCW = gridDim.x * 4;
#define L1_ITEM(i) moe_item(a, (i), 1)
        TR_LOOP(cw, NCW, 32 * 512 + 32 * 256, L1_ITEM);
#undef L1_ITEM
        return;
    }
    LAS unsigned char* wl = lds + wave * 25600;
    const bf16_t* A1 = (const bf16_t*)(a.ws + WS_A);
    for (int item = blockIdx.x; item < 256; item += gridDim.x) {
        const int b = item >> 5, dir = (item >> 4) & 1, g = (item & 15) * 4 + wave;
        bf16_t* Y = (bf16_t*)(a.ws + (dir ? WS_YB : WS_YF));
        float ab_re, ab_im, cr_, ci_;
        s5_disc(a, dir, g, lane, ab_re, ab_im, cr_, ci_);
        bf16x8 Bd[8], Cf[4];
        {
            f32x4 cre[4], cim[4];
#pragma unroll
            for (int kk = 0; kk < 4; ++kk) { const size_t o = ((size_t)(dir * 64 + g) * 16 + fr) * 64 + kk * 16 + fq * 4; cre[kk] = *(const f32x4*)(a.in[I_S5CRE] + o); cim[kk] = *(const f32x4*)(a.in[I_S5CIM] + o); }
#pragma unroll
            for (int kk = 0; kk < 4; ++kk)
#pragma unroll
                for (int j = 0; j < 8; ++j) Cf[kk][j] = (short)f2bf((j & 1) ? -cim[kk][j >> 1] : cre[kk][j >> 1]);
#pragma unroll
            for (int hg = 0; hg < 2; ++hg) {
                f32x4 br0[4], br1[4], bi0[4], bi1[4];
#pragma unroll
                for (int q = 0; q < 4; ++q) {
                    const int pp = (hg * 4 + q) * 8 + (fr >> 1); const size_t o = (size_t)(g * 64 + pp) * 16 + (fq & 1) * 8;
                    br0[q] = *(const f32x4*)(a.in[I_S5BRE] + o); br1[q] = *(const f32x4*)(a.in[I_S5BRE] + o + 4); bi0[q] = *(const f32x4*)(a.in[I_S5BIM] + o); bi1[q] = *(const f32x4*)(a.in[I_S5BIM] + o + 4);
                }
#pragma unroll
                for (int q = 0; q < 4; ++q) {
                    const int pt = hg * 4 + q, pp = pt * 8 + (fr >> 1); const float qr = __shfl(cr_, pp), qi = __shfl(ci_, pp);
#pragma unroll
                    for (int j = 0; j < 8; ++j) {
                        const float br = j < 4 ? br0[q][j & 3] : br1[q][j & 3], bi = j < 4 ? bi0[q][j & 3] : bi1[q][j & 3];
                        float v = (fr & 1) ? (qr * bi + qi * br) : (qr * br - qi * bi);
                        if (fq >= 2) v = 0.f;
                        Bd[pt][j] = (short)f2bf(v);
                    }
                }
                asm volatile("" ::: "memory");
            }
        }
#define S5_POS(n_, t_) ((((n_) < 8) ? (n_) : (n_) - 8) * 32 + (t_))
#define S5_ROW(n_, t_) ((((n_) < 8) ? b * CTXL : NCTX + b * SEQ) + (dir ? (((n_) < 8) ? CTXL : SEQ) - 1 - S5_POS(n_, t_) : S5_POS(n_, t_)))
#define S5_LOADU(d0, d1, n_) do { d0 = (bf16x8){0, 0, 0, 0, 0, 0, 0, 0}; d1 = d0; if (fq < 2 && (n_) < 136) { d0 = *(const bf16x8*)(A1 + (size_t)S5_ROW(n_, fr) * D + g * 16 + fq * 8); d1 = *(const bf16x8*)(A1 + (size_t)S5_ROW(n_, 16 + fr) * D + g * 16 + fq * 8); } } while (0)
        LAS float* BUF = (LAS float*)wl; LAS unsigned* HW = (LAS unsigned*)(wl + 16896); const LAS unsigned char* HP = wl + 16896;
        bf16x8 ua0, ua1, ub0, ub1;
        S5_LOADU(ua0, ua1, 0);
        f32x2 s = (f32x2){0.f, 0.f};
        const f32x2 abr = (f32x2){ab_re, ab_re}, abi = (f32x2){-ab_im, ab_im};
        bf16_t* yp = Y + (size_t)(b * SEQ + (dir ? SEQ - 1 - fq * 4 : fq * 4)) * D + g * 16 + fr;
        const long ystep = dir ? -(long)D : (long)D;
        unsigned yw[4] = {0u, 0u, 0u, 0u};
#define S5_YSTORE() do { yp[0] = (bf16_t)(yw[0] & 0xffffu); yp[ystep] = (bf16_t)(yw[0] >> 16); yp[2 * ystep] = (bf16_t)(yw[1] & 0xffffu); yp[3 * ystep] = (bf16_t)(yw[1] >> 16); \
            yp[16 * ystep] = (bf16_t)(yw[2] & 0xffffu); yp[17 * ystep] = (bf16_t)(yw[2] >> 16); yp[18 * ystep] = (bf16_t)(yw[3] & 0xffffu); yp[19 * ystep] = (bf16_t)(yw[3] >> 16); yp += 32 * ystep; } while (0)
        for (int n = 0; n < 136; ++n) {
#pragma unroll
            for (int hf = 0; hf < 2; ++hf)
#pragma unroll
                for (int pt = 0; pt < 8; ++pt) {
                    const f32x4 z = (f32x4){0.f, 0.f, 0.f, 0.f};
                    const f32x4 d = __builtin_amdgcn_mfma_f32_16x16x32_bf16(hf ? ua1 : ua0, Bd[pt], z, 0, 0, 0);
#pragma unroll
                    for (int j = 0; j < 4; ++j) BUF[(hf * 16 + fq * 4 + j) * 132 + pt * 16 + fr] = d[j];
                }
            if (n >= 9) S5_YSTORE();
            S5_LOADU(ub0, ub1, n + 1);
            LDS_WAIT();
            {
                const bool hist = n >= 8;
                f32x2 bu[32];
#pragma unroll
                for (int j = 0; j < 32; ++j) bu[j] = *(const LAS f32x2*)(BUF + j * 132 + 2 * lane);
                unsigned hw[32];
#pragma unroll
                for (int j = 0; j < 32; ++j) { const f32x2 t1 = abr * s + bu[j]; s = abi * (f32x2){s.y, s.x} + t1; hw[j] = cvt_pk_bf16(s.x, s.y); }
                if (hist) {
#pragma unroll
                    for (int j = 0; j < 32; ++j) HW[j * 68 + lane] = hw[j];
                }
            }
            LDS_WAIT();
            if (n >= 8) {
                f32x4 y0 = (f32x4){0.f, 0.f, 0.f, 0.f}, y1 = (f32x4){0.f, 0.f, 0.f, 0.f};
                bf16x8 ha[2][4];
#pragma unroll
                for (int hf = 0; hf < 2; ++hf)
#pragma unroll
                    for (int kk = 0; kk < 4; ++kk) ha[hf][kk] = *(const LAS bf16x8*)(HP + (hf * 16 + fr) * 272 + (kk * 32 + fq * 8) * 2);
#pragma unroll
                for (int kk = 0; kk < 4; ++kk) { y0 = __builtin_amdgcn_mfma_f32_16x16x32_bf16(ha[0][kk], Cf[kk], y0, 0, 0, 0); y1 = __builtin_amdgcn_mfma_f32_16x16x32_bf16(ha[1][kk], Cf[kk], y1, 0, 0, 0); }
                yw[0] = cvt_pk_bf16(y0[0], y0[1]); yw[1] = cvt_pk_bf16(y0[2], y0[3]); yw[2] = cvt_pk_bf16(y1[0], y1[1]); yw[3] = cvt_pk_bf16(y1[2], y1[3]);
                LDS_WAIT();
            }
            ua0 = ub0; ua1 = ub1;
        }
        S5_YSTORE();
#undef S5_YSTORE
#undef S5_POS
#undef S5_ROW
#undef S5_LOADU
    }
}
__device__ __forceinline__ float gelu_tanh_f(float x) { const float z = 0.7978845608f * (x + 0.044715f * x * x * x); return x * (1.0f - __builtin_amdgcn_rcpf(1.0f + __expf(2.0f * z))); }
__device__ __forceinline__ void s5_post_phase(const Args& a, int lane, int gw, int NGW) {
    const bf16_t* YF = (const bf16_t*)(a.ws + WS_YF); const bf16_t* YB = (const bf16_t*)(a.ws + WS_YB);
    const bf16_t* A1 = (const bf16_t*)(a.ws + WS_A); bf16_t* YG = (bf16_t*)(a.ws + WS_YG);
    f32x4 dk[4];
#pragma unroll
    for (int j = 0; j < 4; ++j) dk[j] = *(const f32x4*)(a.in[I_S5D] + 4 * lane + 256 * j);
    for (int tok0 = gw * 4; tok0 < NLAT; tok0 += NGW * 4) {
        u32x2 yf[4][4], yb[4][4], uu[4][4];
#pragma unroll
        for (int r = 0; r < 4; ++r) { const int tok = tok0 + r, b = tok >> 12, t = tok & 4095, src = b * SEQ + (t & 63) * 64 + (t >> 6);
#pragma unroll
            for (int j = 0; j < 4; ++j) { const int c = 4 * lane + 256 * j; yf[r][j] = *(const u32x2*)(YF + (size_t)src * D + c); yb[r][j] = *(const u32x2*)(YB + (size_t)src * D + c); uu[r][j] = *(const u32x2*)(A1 + (size_t)(NCTX + src) * D + c); } }
#pragma unroll
        for (int r = 0; r < 4; ++r)
#pragma unroll
            for (int j = 0; j < 4; ++j) {
                const u32x2 f = yf[r][j], bk = yb[r][j], uw = uu[r][j];
                const f32x4 y = (f32x4){bflo(f.x) + bflo(bk.x), bfhi(f.x) + bfhi(bk.x), bflo(f.y) + bflo(bk.y), bfhi(f.y) + bfhi(bk.y)} + dk[j] * (f32x4){bflo(uw.x), bfhi(uw.x), bflo(uw.y), bfhi(uw.y)};
                f32x4 o;
#pragma unroll
                for (int i = 0; i < 4; ++i) o[i] = gelu_tanh_f(y[i]);
                st_bf16x4(YG + (size_t)(tok0 + r) * D + 4 * lane + 256 * j, o);
            }
    }
}
struct EpiGlu {
    static constexpr bool PERM = true;
    const float* bglu; const float* modv1; bf16_t* H;
    __device__ __forceinline__ void operator()(const f32x4 (&acc)[2][2][4][2], const Unit& u, int wr, int wc, int fr, int fq) const {
        const int rt0 = u.pm * 256, bidx = rt0 >> 12, cb = u.pn * 128 + wc * 32 + 8 * fq, rl0 = wr * 64 + fr;
        const float* gp = modv1 + bidx * 6144 + 2048;
        const f32x4 ba0 = *(const f32x4*)(bglu + cb), ba1 = *(const f32x4*)(bglu + cb + 4), bb0 = *(const f32x4*)(bglu + 1024 + cb), bb1 = *(const f32x4*)(bglu + 1024 + cb + 4);
        const f32x4 gv0 = *(const f32x4*)(gp + cb), gv1 = *(const f32x4*)(gp + cb + 4);
#pragma unroll
        for (int ai = 0; ai < 2; ++ai)
#pragma unroll
            for (int m = 0; m < 4; ++m) {
                bf16_t* hp = H + (size_t)(NCTX + rt0 + rl0 + ai * 128 + m * 16) * D + cb;
                const u32x4 hw = *(const u32x4*)hp; const f32x4 h0 = (f32x4){bflo(hw.x), bfhi(hw.x), bflo(hw.y), bfhi(hw.y)}, h1 = (f32x4){bflo(hw.z), bfhi(hw.z), bflo(hw.w), bfhi(hw.w)};
                const f32x4 za0 = acc[ai][0][m][0] + ba0, za1 = acc[ai][0][m][1] + ba1, zb0 = acc[ai][1][m][0] + bb0, zb1 = acc[ai][1][m][1] + bb1; f32x4 o0, o1;
#pragma unroll
                for (int j = 0; j < 4; ++j) { o0[j] = za0[j] * sigmoid_f(zb0[j]); o1[j] = za1[j] * sigmoid_f(zb1[j]); }
                const f32x4 r0 = h0 + gv0 * o0, r1 = h1 + gv1 * o1;
                *(u32x4*)hp = (u32x4){pk2(r0[0], r0[1]), pk2(r0[2], r0[3]), pk2(r1[0], r1[1]), pk2(r1[2], r1[3])};
            }
    }
};

#define XB_TMO      128
#define XB_XCNT(j)  (256  + 64 * (j))
#define XB_XSUB(j)  (1280 + 64 * (j))
#define XB_XGEN(j)  (2304 + 64 * (j))
#define XB_TOP      3328
#define XB_TOPGEN   3392
#define XCD_BAR_WORDS 3456
#define XB_SPIN_CAP (1u << 18)
__device__ __forceinline__ unsigned xb_ld(unsigned* p)              { return __hip_atomic_load(p, __ATOMIC_RELAXED, __HIP_MEMORY_SCOPE_AGENT); }
__device__ __forceinline__ unsigned xb_add(unsigned* p, unsigned v) { return __hip_atomic_fetch_add(p, v, __ATOMIC_RELAXED, __HIP_MEMORY_SCOPE_AGENT); }
__device__ __forceinline__ unsigned xb_xcc_id() { return (unsigned)__builtin_amdgcn_s_getreg((3 << 11) | 20) & 0xFu; }
#define XB_SPIN(cond, bar) do { unsigned _sp = 0; while (cond) { __builtin_amdgcn_s_sleep(1); \
    if ((++_sp & 255u) == 0u) { if (xb_ld(&(bar)[XB_TMO])) break; if (_sp > XB_SPIN_CAP) { atomicAdd(&(bar)[XB_TMO], 1u); break; } } } } while (0)
struct XcdBarrier { unsigned* bar; unsigned x; volatile LAS unsigned* st; };
__device__ __forceinline__ XcdBarrier xcd_barrier_post(unsigned* bar, volatile LAS unsigned* st) {
    XcdBarrier b; b.bar = bar; b.x = xb_xcc_id(); b.st = st;
    if (threadIdx.x == 0) (void)xb_add(&bar[XB_XCNT(b.x)], 1u);
    return b;
}
__device__ __forceinline__ void xcd_barrier_complete(unsigned* bar, unsigned x, unsigned& nloc, unsigned& nx) {
    const unsigned G = gridDim.x * gridDim.y * gridDim.z;
    unsigned sum, cnt, mine, sp = 0u;
    for (;;) {
        sum = 0u; cnt = 0u; mine = 0u;
#pragma unroll
        for (unsigned j = 0; j < 16; ++j) { const unsigned c = xb_ld(&bar[XB_XCNT(j)]); sum += c; cnt += (c > 0u) ? 1u : 0u; mine = (j == x) ? c : mine; }
        if (sum == G) break;
        __builtin_amdgcn_s_sleep(1);
        if ((++sp & 255u) == 0u) { if (xb_ld(&bar[XB_TMO])) break; if (sp > XB_SPIN_CAP) { atomicAdd(&bar[XB_TMO], 1u); break; } }
    }
    nloc = mine > 0u ? mine : 1u; nx = cnt > 0u ? cnt : 1u;
}
__device__ __forceinline__ void xcd_barrier(const XcdBarrier& b) {
    asm volatile("s_waitcnt vmcnt(0)" ::: "memory");
    __syncthreads();
    if (threadIdx.x == 0) {
        unsigned* bar = b.bar;
        __builtin_amdgcn_s_waitcnt(0);
        unsigned nloc = b.st[0], nx = b.st[1];
        if (nloc == 0u) { xcd_barrier_complete(bar, b.x, nloc, nx); b.st[0] = nloc; b.st[1] = nx; }
        const unsigned old = xb_add(&bar[XB_XSUB(b.x)], 1u);
        const unsigned gen = old / nloc;
        if (old + 1u == (gen + 1u) * nloc) {
            __builtin_amdgcn_fence(__ATOMIC_RELEASE, "agent");
            asm volatile("s_waitcnt vmcnt(0)" ::: "memory");
            const unsigned og = xb_add(&bar[XB_TOP], 1u);
            const unsigned tg = og / nx;
            if (og + 1u == (tg + 1u) * nx) xb_add(&bar[XB_TOPGEN], 1u);
            else XB_SPIN(xb_ld(&bar[XB_TOPGEN]) == tg, bar);
            __builtin_amdgcn_fence(__ATOMIC_ACQUIRE, "agent");
            xb_add(&bar[XB_XGEN(b.x)], 1u);
            asm volatile("s_waitcnt vmcnt(0)" ::: "memory");
        } else {
            XB_SPIN(xb_ld(&bar[XB_XGEN(b.x)]) == gen, bar);
            __builtin_amdgcn_fence(__ATOMIC_ACQUIRE, "agent");
            asm volatile("s_waitcnt vmcnt(0)" ::: "memory");
        }
    }
    __syncthreads();
}

__device__ __forceinline__ int opaque_tid() { int t = threadIdx.x; asm volatile("" : "+v"(t)); return t; }
#define PHASE_IDS() const int tid = opaque_tid(); const int lane = tid & 63, wave = tid >> 6; const int G = gridDim.x, gw = blockIdx.x * 8 + wave, NGW = G * 8; \
    const int vcu = (G % 8 == 0) ? (int)(blockIdx.x % 8) * (G / 8) + (int)(blockIdx.x / 8) : (int)blockIdx.x; (void)lane; (void)wave; (void)gw; (void)NGW; (void)vcu; (void)G
__global__ void __launch_bounds__(NTHREADS, 2) fwd_mega(Args a) {
    extern __shared__ __attribute__((aligned(16))) unsigned char lds_raw[];
    LAS unsigned char* lds = (LAS unsigned char*)lds_raw;
    cg::grid_group grid = cg::this_grid();
    unsigned char* ws = a.ws;
    if (threadIdx.x < 2) ((LAS unsigned*)(lds + LDS_BYTES - 16))[threadIdx.x] = 0u;
    __syncthreads();
    const XcdBarrier xbar = xcd_barrier_post((unsigned*)(ws + WS_CTL) + CW_BAR, (volatile LAS unsigned*)(lds + LDS_BYTES - 16));
#ifdef TS_SEL
    volatile LAS unsigned long long* tsbuf = (volatile LAS unsigned long long*)(lds + LDS_BYTES - 16 - 256);
    int tsn = 0;
#define TS_MARK() do { if (blockIdx.x == 0 && threadIdx.x == 0) tsbuf[tsn] = __builtin_amdgcn_s_memrealtime(); ++tsn; } while (0)
#else
#define TS_MARK() do { } while (0)
#endif
    TS_MARK();
#define GSYNC() do { xcd_barrier(xbar); TS_MARK(); } while (0)

    for (int rep = 0; rep < REP_P0; ++rep) { PHASE_IDS(); p0_phase(a, lds, tid, gw, NGW); if (REP_P0 > 1) __syncthreads(); }
    grid.sync();
    TS_MARK();
    for (int rep = 0; rep < REP_P1; ++rep) { PHASE_IDS(); p1_phase(a, lane, gw, NGW); }
    GSYNC();
    {
        PHASE_IDS();
        pg8::Gemm g{(const bf16_t*)(ws + WS_A), (const bf16_t*)(ws + WS_WIN), NTOK, 5120, 1024};
        pg8::StaticOrder S; S.init(NTOK, 5120, G, (int)blockIdx.x);
        EpiInProj E{(bf16_t*)(ws + WS_Q), (bf16_t*)(ws + WS_V), (bf16_t*)(ws + WS_G), (_Float16*)(ws + WS_LFF), (_Float16*)(ws + WS_LFB), (const float*)(ws + WS_LBV)};
        for (int rep = 0; rep < REP_INP; ++rep) pg8::gemm_phase<EpiInProj, pg8::StaticOrder>(lds, g, S, E);
    }
    GSYNC();
    for (int rep = 0; rep < REP_GLA; ++rep) { PHASE_IDS(); gla_phase(a, lds, tid); if (REP_GLA > 1) __syncthreads(); }
    GSYNC();
    for (int rep = 0; rep < REP_RO; ++rep) { PHASE_IDS(); gla_readout_phase(a, lane, gw, NGW); }
    GSYNC();
    {
        PHASE_IDS();
        pg8::Gemm g{(const bf16_t*)(ws + WS_OG), (const bf16_t*)(ws + WS_WOUT), NTOK, 1024, 1024};
        pg8::StaticOrder S; S.init(NTOK, 1024, G, (int)blockIdx.x);
        EpiResid E{a.in[I_X], a.in[I_CTX], (const float*)(ws + WS_MODV), (bf16_t*)(ws + WS_H), 2048};
        for (int rep = 0; rep < REP_OUT; ++rep) pg8::gemm_phase<EpiResid, pg8::StaticOrder>(lds, g, S, E);
    }
    GSYNC();
    for (int rep = 0; rep < REP_RT; ++rep) { PHASE_IDS(); router_phase(a, lds, 0, 0, tid); if (REP_RT > 1) __syncthreads(); }
    GSYNC();
    for (int rep = 0; rep < REP_AS; ++rep) { PHASE_IDS(); assign_phase(a, lds, 0, 0, tid); if (REP_AS > 1) __syncthreads(); }
    GSYNC();
    for (int rep = 0; rep < REP_M1; ++rep) { PHASE_IDS(); moe_gemm1(a, lds, 0, tid, G, vcu); }
    GSYNC();
    for (int rep = 0; rep < REP_M2; ++rep) { PHASE_IDS(); moe_gemm2(a, lds, 0, tid, G, vcu); }
    GSYNC();
    { PHASE_IDS(); combine_phase(a, 0, 0, lane, gw, NGW); }
    GSYNC();
    for (int rep = 0; rep < REP_S5; ++rep) { PHASE_IDS(); s5_phase(a, lds, tid); if (REP_S5 > 1) __syncthreads(); }
    GSYNC();
    for (int rep = 0; rep < REP_POST; ++rep) { PHASE_IDS(); s5_post_phase(a, lane, gw, NGW); }
    GSYNC();
    {
        PHASE_IDS();
        pg8::Gemm g{(const bf16_t*)(ws + WS_YG), (const bf16_t*)(ws + WS_WGLU), NLAT, 2048, 1024};
        pg8::StaticOrder S; S.init(NLAT, 2048, G, (int)blockIdx.x);
        EpiGlu E{a.in[I_S5BGLU], (const float*)(ws + WS_MODV) + 9 * 6144, (bf16_t*)(ws + WS_H)};
        pg8::gemm_phase<EpiGlu, pg8::StaticOrder>(lds, g, S, E);
    }
    GSYNC();
    { PHASE_IDS(); router_phase(a, lds, 1, NCTX, tid); }
    GSYNC();
    { PHASE_IDS(); assign_phase(a, lds, 1, NCTX, tid); }
    GSYNC();
    { PHASE_IDS(); moe_gemm1(a, lds, 1, tid, G, vcu); }
    GSYNC();
    { PHASE_IDS(); moe_gemm2(a, lds, 1, tid, G, vcu); }
    GSYNC();
    for (int rep = 0; rep < REP_CMB1; ++rep) { PHASE_IDS(); combine_phase(a, 1, NCTX, lane, gw, NGW); }
#ifdef TS_SEL
    TS_MARK();
    if (blockIdx.x == 0 && threadIdx.x == 0) {
        asm volatile("s_waitcnt vmcnt(0)" ::: "memory"); __threadfence();
        const unsigned long long dt = tsbuf[TS_SEL + 1] - tsbuf[TS_SEL];
        atomicAdd(a.out, (float)dt * 0.001f);
    }
#endif
}

extern "C" void kernel_launch(void* const* d_in, const int* in_sizes, int n_in, void* d_out, int out_size,
                              void* d_ws, size_t ws_size, hipStream_t stream) {
    static int grid_blocks = 0;
    if (!grid_blocks) {
        int dev = 0, cus = 0, per_cu = 0;
        (void)hipGetDevice(&dev);
        (void)hipDeviceGetAttribute(&cus, hipDeviceAttributeMultiprocessorCount, dev);
        (void)hipFuncSetAttribute((const void*)fwd_mega, hipFuncAttributeMaxDynamicSharedMemorySize, LDS_BYTES);
        (void)hipOccupancyMaxActiveBlocksPerMultiprocessor(&per_cu, (const void*)fwd_mega, NTHREADS, LDS_BYTES);
        if (per_cu < 1) { fprintf(stderr, "occupancy query says %d blocks/CU\n", per_cu); }
        grid_blocks = cus < 256 ? cus : 256;
        if (ws_size < WS_END) fprintf(stderr, "kernel_launch: workspace too small: %zu < %zu\n", ws_size, (size_t)WS_END);
    }
    (void)hipMemsetAsync((char*)d_ws + WS_CTL, 0, 1 * MiB, stream);
    Args a{};
    for (int i = 0; i < 29; ++i) a.in[i] = (const float*)d_in[i];
    a.out = (float*)d_out; a.ws = (unsigned char*)d_ws;
    void* kargs[] = {&a};
    hipError_t e = hipLaunchCooperativeKernel((const void*)fwd_mega, dim3(grid_blocks), dim3(NTHREADS), kargs, LDS_BYTES, stream);
    if (e != hipSuccess) fprintf(stderr, "cooperative launch failed: %s (grid %d)\n", hipGetErrorString(e), grid_blocks);
}
```

```cpp
#include <hip/hip_runtime.h>
#include <hip/hip_cooperative_groups.h>
#include <cstdio>
#include <cstdint>
namespace cg = cooperative_groups;

#define LAS __attribute__((address_space(3)))
typedef unsigned short bf16_t;
typedef short bf16x8 __attribute__((ext_vector_type(8)));
typedef float f32x4 __attribute__((ext_vector_type(4)));
typedef unsigned u32x4 __attribute__((ext_vector_type(4)));
typedef unsigned u32x2 __attribute__((ext_vector_type(2)));
typedef float f32x2 __attribute__((ext_vector_type(2)));

constexpr int NTHREADS = 512;
constexpr int LDS_BYTES = 147456;
constexpr int D = 1024, NB = 8, SEQ = 4096, CTXL = 256;
constexpr int NCTX = NB * CTXL;
constexpr int NLAT = NB * SEQ;
constexpr int NTOK = NCTX + NLAT;
constexpr int NE = 32;
constexpr int MPAD = 147456;
constexpr float EPS = 1e-6f;

constexpr size_t MiB = 1u << 20;
constexpr size_t WS_CTL = 0;
constexpr size_t WS_MODV = 1 * MiB;
constexpr size_t WS_LBV = 1 * MiB + 512 * 1024;
constexpr size_t WS_WIN = 2 * MiB;
constexpr size_t WS_WOUT = 12 * MiB;
constexpr size_t WS_WGLU = 14 * MiB;
constexpr size_t WS_W1 = 18 * MiB;
constexpr size_t WS_W2 = 274 * MiB;
constexpr size_t WS_H = 402 * MiB;
constexpr size_t WS_A = 538 * MiB;
constexpr size_t WS_F = 606 * MiB;
constexpr size_t WS_TOKE = 674 * MiB;
constexpr size_t WS_TOKW = 674 * MiB + 640 * 1024;
constexpr size_t WS_TOKS = 674 * MiB + 1280 * 1024;
constexpr size_t WS_SLOTTOK = 256 * 1024;
constexpr size_t WS_BIG = 676 * MiB;
constexpr size_t WS_Q = WS_BIG, WS_V = WS_BIG + 68 * MiB, WS_G = WS_BIG + 136 * MiB;
constexpr size_t WS_LFF = WS_BIG + 204 * MiB, WS_LFB = WS_BIG + 340 * MiB;
constexpr size_t WS_OF = WS_BIG + 476 * MiB, WS_OB = WS_BIG + 612 * MiB;
constexpr size_t WS_OG = WS_BIG + 748 * MiB;
constexpr size_t WS_AG = WS_BIG, WS_ACT = WS_BIG + 288 * MiB, WS_YS = WS_BIG;
constexpr size_t WS_YF = WS_BIG, WS_YB = WS_BIG + 128 * MiB, WS_YG = WS_BIG + 256 * MiB;
constexpr size_t WS_END = WS_BIG + 816 * MiB;
constexpr int CW_CNT = 64;
constexpr int CW_CUR = 256;
constexpr int CW_CNTB = 8192;
constexpr int CW_BAR = 4096;
#ifndef REP_P0
#define REP_P0 1
#endif
#ifndef REP_GLA
#define REP_GLA 1
#endif
#ifndef REP_S5
#define REP_S5 1
#endif
#ifndef REP_P1
#define REP_P1 1
#endif
#ifndef REP_RO
#define REP_RO 1
#endif
#ifndef REP_POST
#define REP_POST 1
#endif
#ifndef REP_CMB1
#define REP_CMB1 1
#endif
#ifndef REP_OUT
#define REP_OUT 1
#endif
#ifndef REP_RT
#define REP_RT 1
#endif
#ifndef REP_AS
#define REP_AS 1
#endif
#ifndef REP_INP
#define REP_INP 1
#endif
#ifndef REP_M1
#define REP_M1 1
#endif
#ifndef REP_M2
#define REP_M2 1
#endif

struct Args {
    const float* in[29];
    float* out;
    unsigned char* ws;
    int stop_after, pad1;
};
enum { I_X = 0, I_C, I_CTX, I_CCTX, I_MODW, I_MODB, I_N1G, I_N2G, I_HGWIN, I_HGLB, I_HGNG, I_HGWOUT, I_S5ARE, I_S5AIM, I_S5LDT,
       I_S5BRE, I_S5BIM, I_S5CRE, I_S5CIM, I_S5D, I_S5WGLU, I_S5BGLU, I_RW, I_RB, I_W1, I_B1, I_W2, I_B2, I_FG };

__device__ __forceinline__ unsigned f2bf(float f) { unsigned u = __builtin_bit_cast(unsigned, f); return (u + 0x7fffu + ((u >> 16) & 1u)) >> 16; }
typedef __bf16 bf16x2_t __attribute__((ext_vector_type(2)));
__device__ __forceinline__ unsigned cvt_pk_bf16(float lo, float hi) { const bf16x2_t v = {(__bf16)lo, (__bf16)hi}; return __builtin_bit_cast(unsigned, v); }
__device__ __forceinline__ unsigned pk2(float lo, float hi) { return cvt_pk_bf16(lo, hi); }
__device__ __forceinline__ float bf2f(unsigned short b) { return __builtin_bit_cast(float, ((unsigned)b) << 16); }
__device__ __forceinline__ float bflo(unsigned w) { return __builtin_bit_cast(float, w << 16); }
__device__ __forceinline__ float bfhi(unsigned w) { return __builtin_bit_cast(float, w & 0xffff0000u); }
__device__ __forceinline__ float wave_sum(float v) {
#pragma unroll
    for (int o = 1; o < 64; o <<= 1) v += __shfl_xor(v, o);
    return v;
}
__device__ __forceinline__ float wave_max(float v) {
#pragma unroll
    for (int o = 1; o < 64; o <<= 1) v = fmaxf(v, __shfl_xor(v, o));
    return v;
}
__device__ __forceinline__ float sigmoid_f(float x) { return __builtin_amdgcn_rcpf(1.0f + __expf(-x)); }
__device__ __forceinline__ float silu_f(float x) { return x * __builtin_amdgcn_rcpf(1.0f + __expf(-x)); }
#define LDS_WAIT() asm volatile("s_waitcnt lgkmcnt(0)" ::: "memory")

namespace pg8 {
constexpr int BM = 256, BK = 64, HALF = 128, HTB = HALF * BK * 2, STAGE_BYTES = 8 * HTB, NXCD = 8, WGM = 8;
__host__ __device__ __forceinline__ int lds_byte(int r, int c) { const int st = (r >> 4) * 2 + (c >> 5), rr = r & 15, cc = c & 31, ob = rr * 64 + cc * 2; return st * 1024 + (ob ^ (((ob >> 9) & 1) << 5)); }
__host__ __device__ __forceinline__ void stage_rc(int b, int& R, int& C) { const int st = b / 1024, sb = b % 1024, swz = sb ^ (((sb >> 9) & 1) << 5); R = (st >> 1) * 16 + swz / 64; C = (st & 1) * 32 + (swz % 64) / 2; }
__host__ __device__ __forceinline__ int perm32(int rho) { const int n = rho >> 4, i = rho & 15; return 8 * (i >> 2) + 4 * n + (i & 3); }
struct Unit { int pm, pn; };
struct Gemm { const bf16_t* A; const bf16_t* Bt; int M, N, K; };
struct StaticOrder {
    int nM, nN, nwg, G, c;
    __device__ void init(int M, int N, int G_, int c_) { nM = M / BM; nN = N / BM; nwg = nM * nN; G = G_; c = c_; }
    __device__ bool next(int i, Unit& u) const {
        const long L = (long)i * G + c; if (L >= nwg) return false;
        int wgid = (int)L; { const int q = nwg / NXCD, r = nwg % NXCD, xcd = wgid % NXCD, off = wgid / NXCD; wgid = (xcd < r ? xcd * (q + 1) : r * (q + 1) + (xcd - r) * q) + off; }
        const int nig = WGM * nN, gid = wgid / nig, fm = gid * WGM, gsz = (nM - fm) < WGM ? (nM - fm) : WGM;
        u.pm = fm + ((wgid % nig) % gsz); u.pn = (wgid % nig) / gsz; return true;
    }
    __device__ __forceinline__ void a_ready(const Unit&) const {}
    __device__ __forceinline__ void done(const Unit&) const {}
};
struct MoeOrder {
    const LAS int* tile_e; int TT, sh, G, v;
    __device__ bool next(int i, Unit& u) const {
        const int per = G >> 3, x = v / per, j = v - x * per;
        const int t0 = (int)(((long)x * TT) >> 3), t1 = (int)(((long)(x + 1) * TT) >> 3);
        const int uu = i * per + j, rt = t0 + (uu >> sh), pnl = uu & ((1 << sh) - 1);
        if (rt >= t1) return false;
        u.pm = rt; u.pn = (tile_e[rt] << sh) + pnl; return true;
    }
    __device__ __forceinline__ void a_ready(const Unit&) const {}
    __device__ __forceinline__ void done(const Unit&) const {}
};

template <class Epi, class Sched, bool GATHER = false>
__device__ __forceinline__ void gemm_phase(LAS unsigned char* lds, const Gemm g, const Sched& S, const Epi& E, const int* rowidx = nullptr) {
    int tid_ = threadIdx.x; asm volatile("" : "+v"(tid_));
    const int tid = tid_, wid = __builtin_amdgcn_readfirstlane(tid >> 6), lane = tid & 63, wr = wid >> 2, wc = wid & 3, fr = lane & 15, fq = lane >> 4;
    const int K = g.K, nt = K / BK;
    unsigned voffA[2], voffB[2];
    int Rr[2], Cc2[2];
#pragma unroll
    for (int i = 0; i < 2; ++i) { int R, C; stage_rc(tid * 16 + i * 8192, R, C); voffA[i] = (unsigned)(R * K + C) * 2u; const int Rb = Epi::PERM ? ((R & ~31) + perm32(R & 31)) : R; voffB[i] = (unsigned)(Rb * K + C) * 2u; Rr[i] = R; Cc2[i] = C * 2; }
    unsigned gA0[2] = {0u, 0u}, gA1[2] = {0u, 0u}, nG0[2] = {0u, 0u}, nG1[2] = {0u, 0u};
#define PG8_ROWS(pm_, d0, d1) do { _Pragma("unroll") for (int _i = 0; _i < 2; ++_i) { d0[_i] = (unsigned)rowidx[(pm_) * BM + Rr[_i]] * (unsigned)(K * 2) + (unsigned)Cc2[_i]; d1[_i] = (unsigned)rowidx[(pm_) * BM + HALF + Rr[_i]] * (unsigned)(K * 2) + (unsigned)Cc2[_i]; } } while (0)
#define PG8_STAGE_A(bufoff, ptr, h, nx) do { if constexpr (GATHER) { unsigned _o[2]; _o[0] = (nx) ? ((h) ? nG1[0] : nG0[0]) : ((h) ? gA1[0] : gA0[0]); _o[1] = (nx) ? ((h) ? nG1[1] : nG0[1]) : ((h) ? gA1[1] : gA0[1]); PG8_STAGE(bufoff, ptr, _o); } \
        else { PG8_STAGE(bufoff, (ptr) + ((h) ? hstep : 0), voffA); } } while (0)
    const size_t kstep = (size_t)(BK * 2);
    const size_t hstep = (size_t)HALF * K * 2;
    const size_t tstep = 2 * hstep;
    const unsigned ldsw = (unsigned)wid * 1024u;
    const int aoff = lds_byte(wr * 64 + fr, fq * 8), boff = lds_byte(wc * 32 + fr, fq * 8);
#define PG8_SA(b, h) (((b) * 2 + (h)) * HTB)
#define PG8_SB(b, h) ((4 + (b) * 2 + (h)) * HTB)
#define PG8_STAGE(bufoff, gbase, voff) do { _Pragma("unroll") for (int _i = 0; _i < 2; ++_i) \
        __builtin_amdgcn_global_load_lds((const unsigned*)((const char*)(gbase) + (voff)[_i]), (LAS unsigned*)(lds + (bufoff) + ldsw + _i * 8192), 16, 0, 0); } while (0)
#define PG8_LDA(dst, b, h) do { _Pragma("unroll") for (int m = 0; m < 4; ++m) _Pragma("unroll") for (int k = 0; k < 2; ++k) dst[m][k] = *(const LAS bf16x8*)(lds + PG8_SA(b, h) + aoff + m * 2048 + k * 1024); } while (0)
#define PG8_LDB(dst, b, h) do { _Pragma("unroll") for (int n = 0; n < 2; ++n) _Pragma("unroll") for (int k = 0; k < 2; ++k) dst[n][k] = *(const LAS bf16x8*)(lds + PG8_SB(b, h) + boff + n * 2048 + k * 1024); } while (0)
#define PG8_MMA(ai, bj, At, Bt) do { __builtin_amdgcn_s_setprio(1); _Pragma("unroll") for (int m = 0; m < 4; ++m) _Pragma("unroll") for (int n = 0; n < 2; ++n) _Pragma("unroll") for (int k = 0; k < 2; ++k) \
        acc[ai][bj][m][n] = __builtin_amdgcn_mfma_f32_16x16x32_bf16(Bt[n][k], At[m][k], acc[ai][bj][m][n], 0, 0, 0); __builtin_amdgcn_s_setprio(0); } while (0)
#define PG8_WAIT_V(n) asm volatile("s_waitcnt vmcnt(" #n ")" ::: "memory")
#define PG8_WAIT_L(n) asm volatile("s_waitcnt lgkmcnt(" #n ")" ::: "memory")
#define PG8_BAR __builtin_amdgcn_s_barrier()
#define PG8_SCHED __builtin_amdgcn_sched_barrier(0)
    Unit cur, nxt; int ui = 0;
    if (!S.next(0, cur)) return;
    f32x4 acc[2][2][4][2];
#pragma unroll
    for (int a = 0; a < 2; ++a)
#pragma unroll
        for (int b = 0; b < 2; ++b)
#pragma unroll
            for (int m = 0; m < 4; ++m)
#pragma unroll
                for (int n = 0; n < 2; ++n) acc[a][b][m][n] = (f32x4){0.f, 0.f, 0.f, 0.f};
    bf16x8 At[4][2], B0[2][2], B1[2][2];
    const char* cA = GATHER ? (const char*)g.A : (const char*)g.A + (size_t)cur.pm * tstep; const char* cB = (const char*)g.Bt + (size_t)cur.pn * tstep;
    S.a_ready(cur);
    if constexpr (GATHER) PG8_ROWS(cur.pm, gA0, gA1);
    PG8_STAGE(PG8_SB(0, 0), cB, voffB); PG8_STAGE_A(PG8_SA(0, 0), cA, 0, false); PG8_STAGE(PG8_SB(0, 1), cB + hstep, voffB); PG8_STAGE_A(PG8_SA(0, 1), cA, 1, false);
    if (wr == 1) PG8_BAR;
    PG8_WAIT_V(4); PG8_BAR;
    PG8_STAGE(PG8_SB(1, 0), cB + kstep, voffB); PG8_STAGE_A(PG8_SA(1, 0), cA + kstep, 0, false); PG8_STAGE(PG8_SB(1, 1), cB + hstep + kstep, voffB);
    PG8_WAIT_V(6); PG8_BAR;
    for (;;) {
        const bool has_next = S.next(ui + 1, nxt);
        const char* nA = GATHER ? cA : (has_next ? (const char*)g.A + (size_t)nxt.pm * tstep : cA); const char* nB = has_next ? (const char*)g.Bt + (size_t)nxt.pn * tstep : cB;
        if constexpr (GATHER) { if (has_next) PG8_ROWS(nxt.pm, nG0, nG1); else { nG0[0] = gA0[0]; nG0[1] = gA0[1]; nG1[0] = gA1[0]; nG1[1] = gA1[1]; } }
        for (int t = 0; t < nt; t += 2) {
            const bool last = (t == nt - 2);
            const char* a1 = cA + (size_t)(t + 1) * kstep;
            const char* a2 = last ? nA : cA + (size_t)(t + 2) * kstep; const char* b2 = last ? nB : cB + (size_t)(t + 2) * kstep;
            const char* a3 = a2 + kstep; const char* b3 = b2 + kstep;
            if (last && has_next) S.a_ready(nxt);
            PG8_LDB(B0, 0, 0); PG8_SCHED; PG8_LDA(At, 0, 0); PG8_STAGE_A(PG8_SA(1, 1), a1, 1, false);
            PG8_WAIT_L(8); PG8_BAR; PG8_WAIT_L(0); PG8_MMA(0, 0, At, B0); PG8_BAR; PG8_SCHED;
            PG8_LDB(B1, 0, 1); PG8_STAGE(PG8_SB(0, 0), b2, voffB);
            PG8_BAR; PG8_WAIT_L(0); PG8_MMA(0, 1, At, B1); PG8_BAR;
            PG8_LDA(At, 0, 1); PG8_STAGE_A(PG8_SA(0, 0), a2, 0, last);
            PG8_BAR; PG8_WAIT_L(0); PG8_MMA(1, 0, At, B0); PG8_BAR; PG8_SCHED;
            PG8_STAGE(PG8_SB(0, 1), b2 + hstep, voffB);
            PG8_WAIT_V(6); PG8_BAR; PG8_MMA(1, 1, At, B1); PG8_BAR;
            PG8_LDB(B0, 1, 0); PG8_SCHED; PG8_LDA(At, 1, 0); PG8_STAGE_A(PG8_SA(0, 1), a2, 1, last);
            PG8_WAIT_L(8); PG8_BAR; PG8_WAIT_L(0); PG8_MMA(0, 0, At, B0); PG8_BAR; PG8_SCHED;
            PG8_LDB(B1, 1, 1); PG8_STAGE(PG8_SB(1, 0), b3, voffB);
            PG8_BAR; PG8_WAIT_L(0); PG8_MMA(0, 1, At, B1); PG8_BAR;
            PG8_LDA(At, 1, 1); PG8_STAGE_A(PG8_SA(1, 0), a3, 0, last);
            PG8_BAR; PG8_WAIT_L(0); PG8_MMA(1, 0, At, B0); PG8_BAR; PG8_SCHED;
            PG8_STAGE(PG8_SB(1, 1), b3 + hstep, voffB);
            PG8_WAIT_V(6); PG8_BAR; PG8_MMA(1, 1, At, B1); PG8_BAR;
        }
        E(acc, cur, wr, wc, fr, fq); S.done(cur);
        if (!has_next) break;
#pragma unroll
        for (int a = 0; a < 2; ++a)
#pragma unroll
            for (int b = 0; b < 2; ++b)
#pragma unroll
                for (int m = 0; m < 4; ++m)
#pragma unroll
                    for (int n = 0; n < 2; ++n) acc[a][b][m][n] = (f32x4){0.f, 0.f, 0.f, 0.f};
        cur = nxt; cA = nA; cB = nB; ++ui;
        if constexpr (GATHER) { gA0[0] = nG0[0]; gA0[1] = nG0[1]; gA1[0] = nG1[0]; gA1[1] = nG1[1]; }
    }
    PG8_WAIT_V(0);
    if (wr == 0) PG8_BAR;
    PG8_BAR;
#undef PG8_SA
#undef PG8_ROWS
#undef PG8_STAGE_A
#undef PG8_SB
#undef PG8_STAGE
#undef PG8_LDA
#undef PG8_LDB
#undef PG8_MMA
#undef PG8_WAIT_V
#undef PG8_WAIT_L
#undef PG8_BAR
#undef PG8_SCHED
}
}
using pg8::Unit;

__device__ __forceinline__ f32x4 ld_bf16x4(const bf16_t* p) { const u32x2 w = *(const u32x2*)p; return (f32x4){bflo(w.x), bfhi(w.x), bflo(w.y), bfhi(w.y)}; }
__device__ __forceinline__ void st_bf16x4(bf16_t* p, f32x4 v) { u32x2 w; w.x = pk2(v[0], v[1]); w.y = pk2(v[2], v[3]); *(u32x2*)p = w; }

struct EpiInProj {
    static constexpr bool PERM = true;
    bf16_t *Q, *V, *G; _Float16 *LFF, *LFB; const float* lbv;
    __device__ __forceinline__ void operator()(const f32x4 (&acc)[2][2][4][2], const Unit& u, int wr, int wc, int fr, int fq) const {
        const int seg = u.pn >> 2, cb = (u.pn & 3) * 256 + wc * 32 + 8 * fq, row0 = u.pm * 256 + wr * 64 + fr;
#pragma unroll
        for (int bj = 0; bj < 2; ++bj) {
            const int c = cb + bj * 128;
            f32x4 lb0 = (f32x4){0.f, 0.f, 0.f, 0.f}, lb1 = lb0;
            if (seg == 2 || seg == 3) { lb0 = *(const f32x4*)(lbv + (seg - 2) * D + c); lb1 = *(const f32x4*)(lbv + (seg - 2) * D + c + 4); }
#pragma unroll
            for (int ai = 0; ai < 2; ++ai)
#pragma unroll
                for (int m = 0; m < 4; ++m) {
                    const size_t ro = (size_t)(row0 + ai * 128 + m * 16) * D + c;
                    const f32x4 v0 = acc[ai][bj][m][0], v1 = acc[ai][bj][m][1];
                    if (seg == 0) { f32x4 o0, o1; for (int j = 0; j < 4; ++j) { o0[j] = silu_f(v0[j]); o1[j] = silu_f(v1[j]); }
                        *(u32x4*)(Q + ro) = (u32x4){pk2(o0[0], o0[1]), pk2(o0[2], o0[3]), pk2(o1[0], o1[1]), pk2(o1[2], o1[3])}; }
                    else if (seg == 1) { *(u32x4*)(V + ro) = (u32x4){pk2(v0[0], v0[1]), pk2(v0[2], v0[3]), pk2(v1[0], v1[1]), pk2(v1[2], v1[3])}; }
                    else if (seg == 4) { *(u32x4*)(G + ro) = (u32x4){pk2(v0[0], v0[1]), pk2(v0[2], v0[3]), pk2(v1[0], v1[1]), pk2(v1[2], v1[3])}; }
                    else {
                        f32x4 o0, o1;
                        for (int j = 0; j < 4; ++j) { o0[j] = __logf(lb0[j] + (1.0f - lb0[j]) * sigmoid_f(v0[j])); o1[j] = __logf(lb1[j] + (1.0f - lb1[j]) * sigmoid_f(v1[j])); }
                        u32x4 hw; hw.x = __builtin_bit_cast(unsigned, __builtin_amdgcn_cvt_pkrtz(o0[0], o0[1])); hw.y = __builtin_bit_cast(unsigned, __builtin_amdgcn_cvt_pkrtz(o0[2], o0[3]));
                        hw.z = __builtin_bit_cast(unsigned, __builtin_amdgcn_cvt_pkrtz(o1[0], o1[1])); hw.w = __builtin_bit_cast(unsigned, __builtin_amdgcn_cvt_pkrtz(o1[2], o1[3]));
                        *(u32x4*)((seg == 2 ? LFF : LFB) + ro) = hw;
                    }
                }
        }
    }
};
struct EpiResid {
    static constexpr bool PERM = true;
    const float* x; const float* ctx; const float* modv; bf16_t* H; int gate_off;
    __device__ __forceinline__ void operator()(const f32x4 (&acc)[2][2][4][2], const Unit& u, int wr, int wc, int fr, int fq) const {
        const int rt0 = u.pm * 256; const int mr = rt0 < NCTX ? 8 : ((rt0 - NCTX) >> 12);
        const float* src = rt0 < NCTX ? ctx + (size_t)rt0 * D : x + (size_t)(rt0 - NCTX) * D;
        const int cb = u.pn * 256 + wc * 32 + 8 * fq, rl0 = wr * 64 + fr;
        const float* gp = modv + mr * 6144 + gate_off;
#pragma unroll
        for (int bj = 0; bj < 2; ++bj) {
            const int c = cb + bj * 128; const f32x4 g0 = *(const f32x4*)(gp + c), g1 = *(const f32x4*)(gp + c + 4);
#pragma unroll
            for (int ai = 0; ai < 2; ++ai)
#pragma unroll
                for (int m = 0; m < 4; ++m) {
                    const int rl = rl0 + ai * 128 + m * 16; const float* hp = src + (size_t)rl * D + c; bf16_t* op = H + (size_t)(rt0 + rl) * D + c;
                    const f32x4 h0 = *(const f32x4*)hp, h1 = *(const f32x4*)(hp + 4);
                    const f32x4 o0 = h0 + g0 * acc[ai][bj][m][0], o1 = h1 + g1 * acc[ai][bj][m][1];
                    *(u32x4*)op = (u32x4){pk2(o0[0], o0[1]), pk2(o0[2], o0[3]), pk2(o1[0], o1[1]), pk2(o1[2], o1[3])};
                }
        }
    }
};

struct TrItem { const float* src; bf16_t* dst; int N; };
__device__ __forceinline__ void tr_load(const TrItem& t, f32x4 (&v)[16], int lane) {
    const float* p = t.src + (size_t)(2 * (lane >> 4)) * t.N + 4 * (lane & 15);
#pragma unroll
    for (int i = 0; i < 8; ++i) { v[2 * i] = *(const f32x4*)(p + (size_t)(8 * i) * t.N); v[2 * i + 1] = *(const f32x4*)(p + (size_t)(8 * i + 1) * t.N); }
}
__device__ __forceinline__ void tr_finish(const TrItem& t, const f32x4 (&v)[16], LAS unsigned* scr, int lane) {
#pragma unroll
    for (int i = 0; i < 8; ++i) {
        const int kp = 4 * i + (lane >> 4); LAS unsigned* s = scr + kp * 65 + 4 * (lane & 15);
        s[0] = cvt_pk_bf16(v[2 * i][0], v[2 * i + 1][0]); s[1] = cvt_pk_bf16(v[2 * i][1], v[2 * i + 1][1]); s[2] = cvt_pk_bf16(v[2 * i][2], v[2 * i + 1][2]); s[3] = cvt_pk_bf16(v[2 * i][3], v[2 * i + 1][3]);
    }
    LDS_WAIT();
    const int c = lane & 7;
#pragma unroll
    for (int j = 0; j < 8; ++j) {
        const int n = (lane >> 3) + 8 * j; const LAS unsigned* s = scr + (4 * c) * 65 + n;
        *(u32x4*)(t.dst + (size_t)n * 1024 + 8 * c) = (u32x4){s[0], s[65], s[130], s[195]};
    }
    LDS_WAIT();
}
__device__ __forceinline__ int ilv_row(int c) { const int bj = c >> 10, r = c & 1023; return (r >> 7) * 256 + bj * 128 + (r & 127); }

__device__ __forceinline__ TrItem moe_item(const Args& a, int r, int layer) {
    TrItem t;
    if (r < 32 * 512) { const int mat = layer * 32 + (r >> 9), sub = r & 511, kb = sub >> 5, nb = sub & 31;
        t.src = a.in[I_W1] + (size_t)mat * 1024 * 2048 + (size_t)(kb * 64) * 2048 + nb * 64; t.dst = (bf16_t*)(a.ws + WS_W1) + (size_t)mat * 2048 * 1024 + (size_t)ilv_row(nb * 64) * 1024 + kb * 64; t.N = 2048; }
    else { r -= 32 * 512; const int mat = layer * 32 + (r >> 8), sub = r & 255, kb = sub >> 4, nb = sub & 15;
        t.src = a.in[I_W2] + (size_t)mat * 1024 * 1024 + (size_t)(kb * 64) * 1024 + nb * 64; t.dst = (bf16_t*)(a.ws + WS_W2) + (size_t)mat * 1024 * 1024 + (size_t)(nb * 64) * 1024 + kb * 64; t.N = 1024; }
    return t;
}
constexpr int P0_NWIN = 16 * 80, P0_NWOUT = 16 * 16, P0_NWGLU = 16 * 32, P0_NITEMS = P0_NWIN + P0_NWOUT + P0_NWGLU + 32 * 512 + 32 * 256;
__device__ __forceinline__ TrItem p0_item(const Args& a, int r) {
    TrItem t;
    if (r < P0_NWIN) { const int kb = r / 80, nb = r % 80; t.src = a.in[I_HGWIN] + (size_t)(kb * 64) * 5120 + nb * 64; t.dst = (bf16_t*)(a.ws + WS_WIN) + (size_t)(nb * 64) * 1024 + kb * 64; t.N = 5120; return t; } r -= P0_NWIN;
    if (r < P0_NWOUT) { const int kb = r / 16, nb = r % 16; t.src = a.in[I_HGWOUT] + (size_t)(kb * 64) * 1024 + nb * 64; t.dst = (bf16_t*)(a.ws + WS_WOUT) + (size_t)(nb * 64) * 1024 + kb * 64; t.N = 1024; return t; } r -= P0_NWOUT;
    if (r < P0_NWGLU) { const int kb = r / 32, nb = r % 32; t.src = a.in[I_S5WGLU] + (size_t)(kb * 64) * 2048 + nb * 64; t.dst = (bf16_t*)(a.ws + WS_WGLU) + (size_t)ilv_row(nb * 64) * 1024 + kb * 64; t.N = 2048; return t; } r -= P0_NWGLU;
    return moe_item(a, r, 0);
}
#define TR_LOOP(first, stride, count, ITEM) do { int _it = (first); if (_it < (count)) { f32x4 _va[16], _vb[16]; TrItem _A = ITEM(_it), _B = _A; tr_load(_A, _va, lane); \
        for (;;) { const int _i2 = _it + (stride); const bool _h2 = _i2 < (count); if (_h2) { _B = ITEM(_i2); tr_load(_B, _vb, lane); } tr_finish(_A, _va, scr, lane); if (!_h2) break; \
                   _it = _i2 + (stride); const bool _h1 = _it < (count); if (_h1) { _A = ITEM(_it); tr_load(_A, _va, lane); } tr_finish(_B, _vb, scr, lane); if (!_h1) break; } } } while (0)
__device__ __forceinline__ void p0_phase(const Args& a, LAS unsigned char* lds, int tid, int gw, int NGW) {
    const int lane = tid & 63, wave = tid >> 6;
    unsigned char* ws = a.ws;
    float* modv = (float*)(ws + WS_MODV);
    if (blockIdx.x < 192) {
        LAS float* SC = (LAS float*)lds;
        LAS float* PART = (LAS float*)(lds + 40960);
        for (int i = tid; i < 9 * 1024; i += NTHREADS) { const int r = i >> 10, k = i & 1023; const float v = r < 8 ? a.in[I_C][r * 1024 + k] : a.in[I_CCTX][k]; SC[i] = silu_f(v); }
        __syncthreads();
        const int layer = blockIdx.x / 96, ng = blockIdx.x % 96;
        const float* W = a.in[I_MODW] + (size_t)layer * 1024 * 6144 + ng * 64 + lane;
        float acc[9];
#pragma unroll
        for (int r = 0; r < 9; ++r) acc[r] = 0.f;
#pragma unroll 8
        for (int kk = 0; kk < 128; ++kk) {
            const int k = wave * 128 + kk; const float w = W[(size_t)k * 6144];
#pragma unroll
            for (int r = 0; r < 9; ++r) acc[r] += SC[r * 1024 + k] * w;
        }
#pragma unroll
        for (int r = 0; r < 9; ++r) PART[(wave * 9 + r) * 64 + lane] = acc[r];
        __syncthreads();
        for (int i = tid; i < 9 * 64; i += NTHREADS) {
            const int r = i >> 6, l = i & 63; float s = a.in[I_MODB][layer * 6144 + ng * 64 + l];
#pragma unroll
            for (int w = 0; w < 8; ++w) s += PART[(w * 9 + r) * 64 + l];
            modv[(size_t)(layer * 9 + r) * 6144 + ng * 64 + l] = s;
        }
        __syncthreads();
    } else if (blockIdx.x == 192) {
        float* lbv = (float*)(ws + WS_LBV);
        for (int i = tid; i < 2048; i += NTHREADS) { const float l0 = a.in[I_HGLB][i], l1 = a.in[I_HGLB][2048 + i]; lbv[i] = 1.0f / (1.0f + __expf(l1 - l0)); }
    }
    LAS unsigned* scr = (LAS unsigned*)(lds + 59392 + wave * 8320);
#define P0_ITEM(i) p0_item(a, (i))
    TR_LOOP(gw, NGW, P0_NITEMS, P0_ITEM);
#undef P0_ITEM
}

__device__ __forceinline__ const float* hin_row(const Args& a, int row) { return row < NCTX ? a.in[I_CTX] + (size_t)row * D : a.in[I_X] + (size_t)(row - NCTX) * D; }
__device__ __forceinline__ int mod_row(int row) { return row < NCTX ? 8 : ((row - NCTX) >> 12); }
__device__ __forceinline__ float row_rstd(const f32x4 (&v)[4]) {
    float s = 0.f;
#pragma unroll
    for (int j = 0; j < 4; ++j) s += (v[j][0] * v[j][0] + v[j][1] * v[j][1]) + (v[j][2] * v[j][2] + v[j][3] * v[j][3]);
    return 1.0f / sqrtf(wave_sum(s) * (1.0f / D) + EPS);
}
__device__ __forceinline__ void norm_mod_store(const f32x4 (&v)[4], float rstd, const float* g, const float* sc, const float* sh, bf16_t* orow, int lane) {
#pragma unroll
    for (int j = 0; j < 4; ++j) {
        const int c = 4 * lane + 256 * j; const f32x4 gv = *(const f32x4*)(g + c), scv = *(const f32x4*)(sc + c), shv = *(const f32x4*)(sh + c);
        st_bf16x4(orow + c, v[j] * rstd * gv * (scv + 1.0f) + shv);
    }
}

__device__ __forceinline__ void p1_phase(const Args& a, int lane, int gw, int NGW) {
    const float* modv = (const float*)(a.ws + WS_MODV);
    bf16_t* A = (bf16_t*)(a.ws + WS_A);
    for (int row0 = gw * 4; row0 < NTOK; row0 += NGW * 4) {
        f32x4 v[4][4];
#pragma unroll
        for (int r = 0; r < 4; ++r) { const float* hr = hin_row(a, row0 + r);
#pragma unroll
            for (int j = 0; j < 4; ++j) v[r][j] = *(const f32x4*)(hr + 4 * lane + 256 * j); }
        const float* mv = modv + (size_t)mod_row(row0) * 6144;
#pragma unroll
        for (int r = 0; r < 4; ++r) { const float rstd = row_rstd(v[r]); norm_mod_store(v[r], rstd, a.in[I_N1G], mv + 1024, mv, A + (size_t)(row0 + r) * D, lane); }
    }
}

__device__ __forceinline__ int gla_row(int n, int t, int b, int dir) {
    const bool isctx = n < 4; const int cn = isctx ? n : n - 4, slen = isctx ? CTXL : SEQ, rbase = isctx ? b * CTXL : NCTX + b * SEQ;
    const int pos = cn * 64 + t; return rbase + (dir ? slen - 1 - pos : pos);
}
__device__ __forceinline__ void gla_phase(const Args& a, LAS unsigned char* lds, int tid) {
    const int lane = tid & 63, wave = tid >> 6, fr = lane & 15, fq = lane >> 4;
    LAS unsigned char* QS = lds;
    LAS unsigned char* KS = lds + 17408;
    LAS unsigned char* QIN = lds + 34816;
    LAS unsigned char* KOT = lds + 52224;
    LAS unsigned char* VT = lds + 70656;
    LAS unsigned char* ST0 = lds + 79872;
    LAS unsigned char* PPW = lds + 114688 + wave * 2304;
    LAS float* GT0 = (LAS float*)(lds + 133120);
    LAS float* BL = (LAS float*)(lds + 141312);
    const bf16_t* Qg = (const bf16_t*)(a.ws + WS_Q); const bf16_t* Vg = (const bf16_t*)(a.ws + WS_V);
    for (int item = blockIdx.x; item < 256; item += gridDim.x) {
        const int vs = item & 1, dir = (item >> 1) & 1, h = (item >> 2) & 7, b = item >> 5;
        const _Float16* LF = (const _Float16*)(a.ws + (dir ? WS_LFB : WS_LFF)); bf16_t* Og = (bf16_t*)(a.ws + (dir ? WS_OB : WS_OF));
        f32x4 Sacc[4];
#pragma unroll
        for (int i = 0; i < 4; ++i) Sacc[i] = (f32x4){0.f, 0.f, 0.f, 0.f};
        for (int i = tid; i < 2 * 17408 / 4; i += NTHREADS) ((LAS unsigned*)ST0)[i] = 0u;
        const int kc2 = (tid & 63) * 2, tg = tid >> 6, chq = h * 128 + kc2;
        const int vt_t = tid >> 3, vt_v8 = (tid & 7) * 8;
        unsigned lf2[8], q2[8]; u32x4 vv;
#define GLA_LOAD(n_) do { _Pragma("unroll") for (int i = 0; i < 8; ++i) { const size_t o = (size_t)gla_row(n_, tg * 8 + i, b, dir) * D + chq; lf2[i] = *(const unsigned*)(LF + o); q2[i] = *(const unsigned*)(Qg + o); } \
            vv = *(const u32x4*)(Vg + (size_t)gla_row(n_, vt_t, b, dir) * D + h * 128 + vs * 64 + vt_v8); } while (0)
        float fa[8], fb[8], bca[8], bcb[8];
#define GLA_CUMSUM(par_) do { float csa = 0.f, csb = 0.f; _Pragma("unroll") for (int i = 0; i < 8; ++i) { typedef _Float16 h2 __attribute__((ext_vector_type(2))); const h2 hv = __builtin_bit_cast(h2, lf2[i]); \
            const float la = (float)hv[0], lb_ = (float)hv[1]; fa[i] = __expf(la); fb[i] = __expf(lb_); csa += la; csb += lb_; bca[i] = csa; bcb[i] = csb; } \
            *(LAS f32x2*)(GT0 + (par_) * 1024 + tg * 128 + kc2) = (f32x2){csa, csb}; } while (0)
        GLA_LOAD(0);
        GLA_CUMSUM(0);
        __syncthreads();
        for (int n = 0; n < 68; ++n) {
            const int par = n & 1;
            LAS unsigned char* STc = ST0 + par * 17408; LAS unsigned char* STn = ST0 + (par ^ 1) * 17408;
            { const unsigned w[4] = {vv.x, vv.y, vv.z, vv.w};
#pragma unroll
              for (int i = 0; i < 4; ++i) { *(LAS bf16_t*)(VT + (vt_v8 + 2 * i) * 144 + vt_t * 2) = (bf16_t)(w[i] & 0xffffu); *(LAS bf16_t*)(VT + (vt_v8 + 2 * i + 1) * 144 + vt_t * 2) = (bf16_t)(w[i] >> 16); } }
#define GLA_OSTORE(n_) do { const u32x4 od = *(const LAS u32x4*)(PPW + (lane >> 2) * 144 + (lane & 3) * 16); \
                *(u32x4*)(Og + (size_t)gla_row(n_, (wave >> 1) * 16 + (lane >> 2), b, dir) * D + h * 128 + vs * 64 + (wave & 1) * 32 + (lane & 3) * 8) = od; } while (0)
            if (n > 0) GLA_OSTORE(n - 1);
            f32x2 pre = (f32x2){0.f, 0.f}, bref = (f32x2){0.f, 0.f}, blast = (f32x2){0.f, 0.f};
#pragma unroll
            for (int g8 = 0; g8 < 8; ++g8) { const f32x2 gv = *(const LAS f32x2*)(GT0 + par * 1024 + g8 * 128 + kc2); if (g8 < tg) pre += gv; if (g8 < 4) bref += gv; blast += gv; }
            const float era = __expf(bref.x), erb = __expf(bref.y), ela = __expf(blast.x - bref.x), elb = __expf(blast.y - bref.y);
            float e1a = __expf(pre.x - bref.x), e1b = __expf(pre.y - bref.y);
            unsigned kota[4], kotb[4];
#pragma unroll
            for (int i = 0; i < 8; ++i) {
                const int t = tg * 8 + i;
                const float qa = bflo(q2[i]), qb = bfhi(q2[i]);
                e1a *= fa[i]; e1b *= fb[i];
                const float ka = 1.0f - fa[i], kb = 1.0f - fb[i];
                const float e2a = __builtin_amdgcn_rcpf(e1a), e2b = __builtin_amdgcn_rcpf(e1b);
                const float qsa = qa * e1a, qsb = qb * e1b, ksa = ka * e2a, ksb = kb * e2b;
                *(LAS unsigned*)(QS + t * 272 + kc2 * 2) = cvt_pk_bf16(qsa, qsb);
                *(LAS unsigned*)(KS + t * 272 + kc2 * 2) = cvt_pk_bf16(ksa, ksb);
                *(LAS unsigned*)(QIN + t * 272 + kc2 * 2) = cvt_pk_bf16(qsa * era, qsb * erb);
                const unsigned ko = cvt_pk_bf16(ksa * ela, ksb * elb);
                if (i & 1) { kota[i >> 1] |= ko << 16; kotb[i >> 1] |= ko & 0xffff0000u; } else { kota[i >> 1] = ko & 0xffffu; kotb[i >> 1] = ko >> 16; }
            }
            *(LAS u32x4*)(KOT + kc2 * 144 + tg * 16) = (u32x4){kota[0], kota[1], kota[2], kota[3]};
            *(LAS u32x4*)(KOT + (kc2 + 1) * 144 + tg * 16) = (u32x4){kotb[0], kotb[1], kotb[2], kotb[3]};
            if (tg == 0) *(LAS f32x2*)(BL + kc2) = (f32x2){__expf(blast.x), __expf(blast.y)};
            if (n + 1 < 68) GLA_LOAD(n + 1);
            __syncthreads();
            const int tt = wave >> 1;
            bf16x8 aq[4];
#pragma unroll
            for (int kk = 0; kk < 4; ++kk) aq[kk] = *(const LAS bf16x8*)(QS + (tt * 16 + fr) * 272 + (kk * 32 + fq * 8) * 2);
#pragma unroll
            for (int st = 0; st < 4; ++st) {
                f32x4 acc = (f32x4){0.f, 0.f, 0.f, 0.f};
                if (st <= tt) {
#pragma unroll
                    for (int kk = 0; kk < 4; ++kk) {
                        const bf16x8 bv = *(const LAS bf16x8*)(KS + (st * 16 + fr) * 272 + (kk * 32 + fq * 8) * 2);
                        acc = __builtin_amdgcn_mfma_f32_16x16x32_bf16(aq[kk], bv, acc, 0, 0, 0);
                    }
                }
#pragma unroll
                for (int j = 0; j < 4; ++j) { const int tl = fq * 4 + j, s = st * 16 + fr; *(LAS bf16_t*)(PPW + tl * 144 + s * 2) = (bf16_t)f2bf(s <= tt * 16 + tl ? acc[j] : 0.f); }
            }
            LDS_WAIT();
            unsigned ow[2][2];
            bf16x8 ap[2], ai[4];
#pragma unroll
            for (int kk = 0; kk < 2; ++kk) ap[kk] = *(const LAS bf16x8*)(PPW + fr * 144 + (kk * 32 + fq * 8) * 2);
#pragma unroll
            for (int kk = 0; kk < 4; ++kk) ai[kk] = *(const LAS bf16x8*)(QIN + (tt * 16 + fr) * 272 + (kk * 32 + fq * 8) * 2);
#pragma unroll
            for (int vti = 0; vti < 2; ++vti) {
                const int vt = 2 * (wave & 1) + vti; f32x4 acc = (f32x4){0.f, 0.f, 0.f, 0.f};
#pragma unroll
                for (int kk = 0; kk < 2; ++kk) {
                    const bf16x8 bv = *(const LAS bf16x8*)(VT + (vt * 16 + fr) * 144 + (kk * 32 + fq * 8) * 2);
                    acc = __builtin_amdgcn_mfma_f32_16x16x32_bf16(ap[kk], bv, acc, 0, 0, 0);
                }
#pragma unroll
                for (int kk = 0; kk < 4; ++kk) {
                    const bf16x8 bv = *(const LAS bf16x8*)(STc + (vt * 16 + fr) * 272 + (kk * 32 + fq * 8) * 2);
                    acc = __builtin_amdgcn_mfma_f32_16x16x32_bf16(ai[kk], bv, acc, 0, 0, 0);
                }
                ow[vti][0] = cvt_pk_bf16(acc[0], acc[1]); ow[vti][1] = cvt_pk_bf16(acc[2], acc[3]);
            }
#pragma unroll
            for (int vti = 0; vti < 2; ++vti)
#pragma unroll
                for (int j = 0; j < 4; ++j) { const unsigned w = ow[vti][j >> 1]; *(LAS bf16_t*)(PPW + (fq * 4 + j) * 144 + (vti * 16 + fr) * 2) = (bf16_t)((j & 1) ? (w >> 16) : (w & 0xffffu)); }
            bf16x8 ak[2]; const f32x4 blv = *(const LAS f32x4*)(BL + wave * 16 + fq * 4);
#pragma unroll
            for (int kk = 0; kk < 2; ++kk) ak[kk] = *(const LAS bf16x8*)(KOT + (wave * 16 + fr) * 144 + (kk * 32 + fq * 8) * 2);
#pragma unroll
            for (int vt = 0; vt < 4; ++vt) {
                Sacc[vt] *= blv;
#pragma unroll
                for (int kk = 0; kk < 2; ++kk) {
                    const bf16x8 bv = *(const LAS bf16x8*)(VT + (vt * 16 + fr) * 144 + (kk * 32 + fq * 8) * 2);
                    Sacc[vt] = __builtin_amdgcn_mfma_f32_16x16x32_bf16(ak[kk], bv, Sacc[vt], 0, 0, 0);
                }
                *(LAS u32x2*)(STn + (vt * 16 + fr) * 272 + (wave * 16 + fq * 4) * 2) = (u32x2){pk2(Sacc[vt][0], Sacc[vt][1]), pk2(Sacc[vt][2], Sacc[vt][3])};
            }
            if (n + 1 < 68) GLA_CUMSUM(par ^ 1);
            __syncthreads();
        }
        GLA_OSTORE(67);
    }
}
#undef GLA_OSTORE
#undef GLA_CUMSUM
#undef GLA_LOAD
__device__ __forceinline__ void gla_readout_phase(const Args& a, int lane, int gw, int NGW) {
    const bf16_t* OF = (const bf16_t*)(a.ws + WS_OF); const bf16_t* OB = (const bf16_t*)(a.ws + WS_OB);
    const bf16_t* G = (const bf16_t*)(a.ws + WS_G); bf16_t* OG = (bf16_t*)(a.ws + WS_OG);
    f32x4 ng[4];
#pragma unroll
    for (int j = 0; j < 4; ++j) ng[j] = *(const f32x4*)(a.in[I_HGNG] + 16 * lane + 4 * j);
    for (int row0 = gw * 4; row0 < NTOK; row0 += NGW * 4) {
        u32x4 of[4][2], ob[4][2], gg[4][2];
#pragma unroll
        for (int r = 0; r < 4; ++r) { const size_t o = (size_t)(row0 + r) * D + 16 * lane;
            of[r][0] = *(const u32x4*)(OF + o); of[r][1] = *(const u32x4*)(OF + o + 8); ob[r][0] = *(const u32x4*)(OB + o); ob[r][1] = *(const u32x4*)(OB + o + 8);
            gg[r][0] = *(const u32x4*)(G + o); gg[r][1] = *(const u32x4*)(G + o + 8); }
#pragma unroll
        for (int r = 0; r < 4; ++r) {
            float v[16]; float s = 0.f;
#pragma unroll
            for (int q = 0; q < 8; ++q) { const unsigned wf = of[r][q >> 2][q & 3], wb = ob[r][q >> 2][q & 3]; v[2 * q] = bflo(wf) + bflo(wb); v[2 * q + 1] = bfhi(wf) + bfhi(wb); s += v[2 * q] * v[2 * q] + v[2 * q + 1] * v[2 * q + 1]; }
            s += __shfl_xor(s, 1); s += __shfl_xor(s, 2); s += __shfl_xor(s, 4);
            const float rstd = 1.0f / sqrtf(s * (1.0f / 128.0f) + EPS);
            unsigned ow[8];
#pragma unroll
            for (int q = 0; q < 8; ++q) { const unsigned wg = gg[r][q >> 2][q & 3];
                ow[q] = pk2(v[2 * q] * rstd * ng[q >> 1][(2 * q) & 3] * silu_f(bflo(wg)), v[2 * q + 1] * rstd * ng[q >> 1][(2 * q + 1) & 3] * silu_f(bfhi(wg))); }
            const size_t o = (size_t)(row0 + r) * D + 16 * lane;
            *(u32x4*)(OG + o) = (u32x4){ow[0], ow[1], ow[2], ow[3]}; *(u32x4*)(OG + o + 8) = (u32x4){ow[4], ow[5], ow[6], ow[7]};
        }
    }
}

struct EpiMoe1 {
    static constexpr bool PERM = true;
    const float* b1; bf16_t* ACT;
    __device__ __forceinline__ void operator()(const f32x4 (&acc)[2][2][4][2], const Unit& u, int wr, int wc, int fr, int fq) const {
        const int e = u.pn >> 3, pnl = u.pn & 7, cb = pnl * 128 + wc * 32 + 8 * fq, row0 = u.pm * 256 + wr * 64 + fr;
        const float* bg = b1 + (size_t)e * 2048;
        const f32x4 bg0 = *(const f32x4*)(bg + cb), bg1 = *(const f32x4*)(bg + cb + 4), bl0 = *(const f32x4*)(bg + 1024 + cb), bl1 = *(const f32x4*)(bg + 1024 + cb + 4);
#pragma unroll
        for (int ai = 0; ai < 2; ++ai)
#pragma unroll
            for (int m = 0; m < 4; ++m) {
                f32x4 o[2];
#pragma unroll
                for (int n = 0; n < 2; ++n) {
                    const f32x4 zg = acc[ai][0][m][n] + (n ? bg1 : bg0), zl = acc[ai][1][m][n] + (n ? bl1 : bl0);
#pragma unroll
                    for (int j = 0; j < 4; ++j) { const float g_ = fminf(zg[j], 7.0f), l_ = fminf(fmaxf(zl[j], -7.0f), 7.0f); o[n][j] = g_ * sigmoid_f(1.702f * g_) * (l_ + 1.0f); }
                }
                *(u32x4*)(ACT + (size_t)(row0 + ai * 128 + m * 16) * D + cb) = (u32x4){pk2(o[0][0], o[0][1]), pk2(o[0][2], o[0][3]), pk2(o[1][0], o[1][1]), pk2(o[1][2], o[1][3])};
            }
    }
};
struct EpiMoe2 {
    static constexpr bool PERM = true;
    const float* b2; bf16_t* YS;
    __device__ __forceinline__ void operator()(const f32x4 (&acc)[2][2][4][2], const Unit& u, int wr, int wc, int fr, int fq) const {
        const int e = u.pn >> 2, pnl = u.pn & 3, cb = pnl * 256 + wc * 32 + 8 * fq, row0 = u.pm * 256 + wr * 64 + fr;
        const float* bb = b2 + (size_t)e * 1024;
#pragma unroll
        for (int bj = 0; bj < 2; ++bj) {
            const int c = cb + bj * 128; const f32x4 bv0 = *(const f32x4*)(bb + c), bv1 = *(const f32x4*)(bb + c + 4);
#pragma unroll
            for (int ai = 0; ai < 2; ++ai)
#pragma unroll
                for (int m = 0; m < 4; ++m) {
                    const f32x4 v0 = acc[ai][bj][m][0] + bv0, v1 = acc[ai][bj][m][1] + bv1;
                    *(u32x4*)(YS + (size_t)(row0 + ai * 128 + m * 16) * D + c) = (u32x4){pk2(v0[0], v0[1]), pk2(v0[2], v0[3]), pk2(v1[0], v1[1]), pk2(v1[2], v1[3])};
                }
        }
    }
};

__device__ __forceinline__ void router_phase(const Args& a, LAS unsigned char* lds, int layer, int row_lo, int tid) {
    const int lane = tid & 63, wave = tid >> 6, fr = lane & 15, fq = lane >> 4;
    const bf16_t* H = (const bf16_t*)(a.ws + WS_H); bf16_t* F = (bf16_t*)(a.ws + WS_F);
    const float* modv = (const float*)(a.ws + WS_MODV) + (size_t)layer * 9 * 6144;
    int* TOKE = (int*)(a.ws + WS_TOKE); float* TOKW = (float*)(a.ws + WS_TOKW);
    unsigned* cntb = (unsigned*)(a.ws + WS_CTL) + CW_CNTB + layer * 8192;
    LAS float* FS = (LAS float*)lds;
    LAS float* PART = (LAS float*)(lds + 16 * 1028 * 4);
    LAS int* hist = (LAS int*)(lds + 16 * 1028 * 4 + 16384);
    if (tid < 32) hist[tid] = 0;
    const float* n2g = a.in[I_N2G] + layer * D; const float* rw = a.in[I_RW] + (size_t)layer * D * NE; const float* rb = a.in[I_RB] + layer * NE;
    float rwr[2][32];
#pragma unroll
    for (int s = 0; s < 32; ++s) { rwr[0][s] = rw[(size_t)(wave * 128 + 4 * s + fq) * NE + fr]; rwr[1][s] = rw[(size_t)(wave * 128 + 4 * s + fq) * NE + 16 + fr]; }
    const int ngroups = (NTOK - row_lo) >> 4;
    f32x4 vv[2][4];
#define RT_LOAD(gi_) do { _Pragma("unroll") for (int rr = 0; rr < 2; ++rr) _Pragma("unroll") for (int j = 0; j < 4; ++j) \
        vv[rr][j] = ld_bf16x4(H + (size_t)(row_lo + (gi_) * 16 + 2 * wave + rr) * D + 4 * lane + 256 * j); } while (0)
    if ((int)blockIdx.x < ngroups) RT_LOAD(blockIdx.x);
    for (int gi = blockIdx.x; gi < ngroups; gi += gridDim.x) {
        const int row0 = row_lo + gi * 16;
        __syncthreads();
#pragma unroll
        for (int rr = 0; rr < 2; ++rr) {
            const int rl = 2 * wave + rr, row = row0 + rl; const f32x4 (&v)[4] = vv[rr];
            const float rstd = row_rstd(v); const float* mv = modv + (size_t)mod_row(row) * 6144;
#pragma unroll
            for (int j = 0; j < 4; ++j) {
                const int c = 4 * lane + 256 * j; const f32x4 gv = *(const f32x4*)(n2g + c), scv = *(const f32x4*)(mv + 4096 + c), shv = *(const f32x4*)(mv + 3072 + c);
                const f32x4 f = v[j] * rstd * gv * (scv + 1.0f) + shv;
                st_bf16x4(F + (size_t)row * D + c, f);
                *(LAS f32x4*)(FS + rl * 1028 + c) = f;
            }
        }
        if (gi + (int)gridDim.x < ngroups) RT_LOAD(gi + gridDim.x);
        __syncthreads();
        f32x4 acc0 = (f32x4){0.f, 0.f, 0.f, 0.f}, acc1 = (f32x4){0.f, 0.f, 0.f, 0.f};
#pragma unroll
        for (int s = 0; s < 32; ++s) {
            const float av = FS[fr * 1028 + wave * 128 + 4 * s + fq];
            acc0 = __builtin_amdgcn_mfma_f32_16x16x4f32(av, rwr[0][s], acc0, 0, 0, 0);
            acc1 = __builtin_amdgcn_mfma_f32_16x16x4f32(av, rwr[1][s], acc1, 0, 0, 0);
        }
#pragma unroll
        for (int j = 0; j < 4; ++j) { PART[(wave * 16 + fq * 4 + j) * 32 + fr] = acc0[j]; PART[(wave * 16 + fq * 4 + j) * 32 + 16 + fr] = acc1[j]; }
        __syncthreads();
        {
            const int half = lane >> 5, e = lane & 31, rl = 2 * wave + half, row = row0 + rl;
            float lg = rb[e];
#pragma unroll
            for (int w = 0; w < 8; ++w) lg += PART[(w * 16 + rl) * 32 + e];
            float sv[4]; int si[4];
#pragma unroll
            for (int r = 0; r < 4; ++r) {
                float m = lg;
#pragma unroll
                for (int o = 1; o < 32; o <<= 1) m = fmaxf(m, __shfl_xor(m, o));
                const unsigned long long bal = __ballot(lg == m); const unsigned mine = (unsigned)(bal >> (32 * half));
                const int idx = __ffs((int)mine) - 1;
                sv[r] = m; si[r] = idx; if (e == idx) lg = -3.0e38f;
            }
            const float e1 = __expf(sv[1] - sv[0]), e2 = __expf(sv[2] - sv[0]), e3 = __expf(sv[3] - sv[0]); const float inv = 1.0f / (1.0f + e1 + e2 + e3);
            if (e < 4) {
                const int myi = e == 0 ? si[0] : (e == 1 ? si[1] : (e == 2 ? si[2] : si[3]));
                const float myw = (e == 0 ? 1.0f : (e == 1 ? e1 : (e == 2 ? e2 : e3))) * inv;
                TOKE[(size_t)row * 4 + e] = myi; TOKW[(size_t)row * 4 + e] = myw;
                atomicAdd((int*)hist + myi, 1);
            }
        }
    }
    __syncthreads();
    if (tid < 32) cntb[(size_t)blockIdx.x * 32 + tid] = (unsigned)hist[tid];
}
#undef RT_LOAD
__device__ __forceinline__ void assign_phase(const Args& a, LAS unsigned char* lds, int layer, int row_lo, int tid) {
    const int lane = tid & 63, wave = tid >> 6;
    const unsigned* cntb = (const unsigned*)(a.ws + WS_CTL) + CW_CNTB + layer * 8192; unsigned* gcnt = (unsigned*)(a.ws + WS_CTL) + CW_CNT + layer * 64;
    const bf16_t* F = (const bf16_t*)(a.ws + WS_F); bf16_t* AG = (bf16_t*)(a.ws + WS_AG);
    const int* TOKE = (const int*)(a.ws + WS_TOKE); int* TOKS = (int*)(a.ws + WS_TOKS);
    LAS int* off = (LAS int*)lds; LAS int* cnt = (LAS int*)(lds + 256); LAS int* base = (LAS int*)(lds + 512); LAS int* cur = (LAS int*)(lds + 768);
    LAS int* pa = (LAS int*)(lds + 1024); LAS int* pl = (LAS int*)(lds + 1024 + 2048);
    {
        const int e = tid & 31, part = tid >> 5; int s_all = 0, s_lt = 0;
        for (int bb = part; bb < (int)gridDim.x; bb += 16) { const int c = (int)cntb[(size_t)bb * 32 + e]; s_all += c; if (bb < (int)blockIdx.x) s_lt += c; }
        pa[part * 32 + e] = s_all; pl[part * 32 + e] = s_lt;
    }
    __syncthreads();
    if (tid < 32) { int s_all = 0, s_lt = 0; for (int p = 0; p < 16; ++p) { s_all += pa[p * 32 + tid]; s_lt += pl[p * 32 + tid]; } cnt[tid] = s_all; base[tid] = s_lt; cur[tid] = 0; if (blockIdx.x == 0) gcnt[tid] = (unsigned)s_all; }
    __syncthreads();
    if (tid == 0) { int o = 0; for (int e = 0; e < 32; ++e) { off[e] = o; o += ((cnt[e] + 255) >> 8) << 8; } }
    __syncthreads();
    if (tid < 32) base[tid] += off[tid];
    __syncthreads();
    const int gw = blockIdx.x * 8 + wave, NGW = gridDim.x * 8;
    int* SLOTTOK = (int*)(a.ws + WS_SLOTTOK);
    for (int idx = blockIdx.x * NTHREADS + tid; idx < 32 * 256; idx += gridDim.x * NTHREADS) {
        const int e = idx >> 8, c = cnt[e], r = c + (idx & 255), padded = ((c + 255) >> 8) << 8;
        if (r < padded) SLOTTOK[off[e] + r] = 0;
    }
    const int ngroups = (NTOK - row_lo) >> 4;
    for (int gi = blockIdx.x; gi < ngroups; gi += gridDim.x) {
        const int r0 = row_lo + gi * 16 + 2 * wave;
        if (lane < 8) { const int e = TOKE[(size_t)r0 * 4 + lane]; const int pos = atomicAdd((int*)cur + e, 1); const int slot = base[e] + pos; TOKS[(size_t)r0 * 4 + lane] = slot; SLOTTOK[slot] = r0 + (lane >> 2); }
    }
    (void)gw; (void)NGW; (void)F; (void)AG;
}
__device__ __forceinline__ int moe_tiles(const Args& a, LAS unsigned char* lds, int layer, int tid) {
    const unsigned* gcnt = (const unsigned*)(a.ws + WS_CTL) + CW_CNT + layer * 64;
    LAS int* tbl = (LAS int*)(lds + 131072 + 1024);
    if (tid == 0) { int t = 0; for (int e = 0; e < 32; ++e) { const int nt = ((int)gcnt[e] + 255) >> 8; for (int k = 0; k < nt; ++k) tbl[t++] = e; } tbl[1000] = t; }
    __syncthreads();
    return tbl[1000];
}
__device__ __forceinline__ void combine_phase(const Args& a, int layer, int row_lo, int lane, int gw, int NGW) {
    bf16_t* H = (bf16_t*)(a.ws + WS_H); const bf16_t* YS = (const bf16_t*)(a.ws + WS_YS);
    const int* TOKS = (const int*)(a.ws + WS_TOKS); const float* TOKW = (const float*)(a.ws + WS_TOKW);
    const float* modv = (const float*)(a.ws + WS_MODV);
    for (int row0 = row_lo + gw * 2; row0 < NTOK; row0 += NGW * 2) {
        const int mr = mod_row(row0);
        u32x4 sl[2]; f32x4 wv[2];
#pragma unroll
        for (int r = 0; r < 2; ++r) { sl[r] = *(const u32x4*)(TOKS + (size_t)(row0 + r) * 4); wv[r] = *(const f32x4*)(TOKW + (size_t)(row0 + r) * 4); }
        u32x2 ys[2][4][4]; f32x4 hv[2][4];
#pragma unroll
        for (int r = 0; r < 2; ++r)
#pragma unroll
            for (int j = 0; j < 4; ++j) {
                hv[r][j] = ld_bf16x4(H + (size_t)(row0 + r) * D + 4 * lane + 256 * j);
#pragma unroll
                for (int k = 0; k < 4; ++k) ys[r][k][j] = *(const u32x2*)(YS + (size_t)sl[r][k] * D + 4 * lane + 256 * j);
            }
        const float* g2 = modv + (size_t)(layer * 9 + mr) * 6144 + 5120;
#pragma unroll
        for (int r = 0; r < 2; ++r) {
            const int row = row0 + r; f32x4 v[4];
#pragma unroll
            for (int j = 0; j < 4; ++j) {
                const int c = 4 * lane + 256 * j; f32x4 y = (f32x4){0.f, 0.f, 0.f, 0.f};
#pragma unroll
                for (int k = 0; k < 4; ++k) { const u32x2 w = ys[r][k][j]; y += (f32x4){bflo(w.x), bfhi(w.x), bflo(w.y), bfhi(w.y)} * wv[r][k]; }
                v[j] = hv[r][j] + *(const f32x4*)(g2 + c) * y;
                if (layer == 0) st_bf16x4(H + (size_t)row * D + c, v[j]);
            }
            const float rstd = row_rstd(v);
            if (layer == 0) {
                const float* mv = modv + (size_t)(9 + mr) * 6144;
                int orow = row;
                if (row >= NCTX) { const int li = row - NCTX, b = li >> 12, t = li & 4095; orow = NCTX + b * SEQ + (t & 63) * 64 + (t >> 6); }
                norm_mod_store(v, rstd, a.in[I_N1G] + D, mv + 1024, mv, (bf16_t*)(a.ws + WS_A) + (size_t)orow * D, lane);
            } else {
#pragma unroll
                for (int j = 0; j < 4; ++j) { const int c = 4 * lane + 256 * j; *(f32x4*)(a.out + (size_t)(row - NCTX) * D + c) = v[j] * rstd * *(const f32x4*)(a.in[I_FG] + c); }
            }
        }
    }
}
__device__ __forceinline__ void moe_gemm1(const Args& a, LAS unsigned char* lds, int layer, int tid, int G, int vcu) {
    unsigned char* ws = a.ws;
    const int TT = moe_tiles(a, lds, layer, tid);
    const LAS int* tbl = (const LAS int*)(lds + 131072 + 1024);
    pg8::Gemm g{(const bf16_t*)(ws + WS_F), (const bf16_t*)(ws + WS_W1) + (size_t)layer * 32 * 2048 * 1024, MPAD, 32 * 2048, 1024};
    pg8::MoeOrder S{tbl, TT, 3, G, vcu};
    EpiMoe1 E{a.in[I_B1] + (size_t)layer * 32 * 2048, (bf16_t*)(ws + WS_ACT)};
    pg8::gemm_phase<EpiMoe1, pg8::MoeOrder, true>(lds, g, S, E, (const int*)(ws + WS_SLOTTOK));
}
__device__ __forceinline__ void moe_gemm2(const Args& a, LAS unsigned char* lds, int layer, int tid, int G, int vcu) {
    unsigned char* ws = a.ws;
    const int TT = moe_tiles(a, lds, layer, tid);
    const LAS int* tbl = (const LAS int*)(lds + 131072 + 1024);
    pg8::Gemm g{(const bf16_t*)(ws + WS_ACT), (const bf16_t*)(ws + WS_W2) + (size_t)layer * 32 * 1024 * 1024, MPAD, 32 * 1024, 1024};
    pg8::MoeOrder S{tbl, TT, 2, G, vcu};
    EpiMoe2 E{a.in[I_B2] + (size_t)layer * 32 * 1024, (bf16_t*)(ws + WS_YS)};
    pg8::gemm_phase<EpiMoe2, pg8::MoeOrder>(lds, g, S, E);
}


__device__ __forceinline__ void s5_disc(const Args& a, int d, int g, int p, float& ab_re, float& ab_im, float& co_re, float& co_im) {
    const float lam_re = fminf(a.in[I_S5ARE][(d * 64 + g) * 64 + p], -1e-4f), lam_im = a.in[I_S5AIM][(d * 64 + g) * 64 + p];
    const float dt = expf(a.in[I_S5LDT][d * 64 + g]);
    const float mag = expf(lam_re * dt), ang = lam_im * dt;
    ab_re = mag * cosf(ang); ab_im = mag * sinf(ang);
    const float den = lam_re * lam_re + lam_im * lam_im;
    co_re = ((ab_re - 1.0f) * lam_re + ab_im * lam_im) / den;
    co_im = (ab_im * lam_re - (ab_re - 1.0f) * lam_im) / den;
}
__device__ __forceinline__ void s5_phase(const Args& a, LAS unsigned char* lds, int tid) {
    const int lane = tid & 63, wave = tid >> 6, fr = lane & 15, fq = lane >> 4;
    if (wave >= 4) {
        LAS unsigned* scr = (LAS unsigned*)(lds + 102400 + (wave - 4) * 8320);
        const int cw = blockIdx.x * 4 + (wave - 4), NCW = gridDim.x * 4;
#define L1_ITEM(i) moe_item(a, (i), 1)
        TR_LOOP(cw, NCW, 32 * 512 + 32 * 256, L1_ITEM);
#undef L1_ITEM
        return;
    }
    LAS unsigned char* wl = lds + wave * 25600;
    const bf16_t* A1 = (const bf16_t*)(a.ws + WS_A);
    for (int item = blockIdx.x; item < 256; item += gridDim.x) {
        const int b = item >> 5, dir = (item >> 4) & 1, g = (item & 15) * 4 + wave;
        bf16_t* Y = (bf16_t*)(a.ws + (dir ? WS_YB : WS_YF));
        float ab_re, ab_im, cr_, ci_;
        s5_disc(a, dir, g, lane, ab_re, ab_im, cr_, ci_);
        bf16x8 Bd[8], Cf[4];
        {
            f32x4 cre[4], cim[4];
#pragma unroll
            for (int kk = 0; kk < 4; ++kk) { const size_t o = ((size_t)(dir * 64 + g) * 16 + fr) * 64 + kk * 16 + fq * 4; cre[kk] = *(const f32x4*)(a.in[I_S5CRE] + o); cim[kk] = *(const f32x4*)(a.in[I_S5CIM] + o); }
#pragma unroll
            for (int kk = 0; kk < 4; ++kk)
#pragma unroll
                for (int j = 0; j < 8; ++j) Cf[kk][j] = (short)f2bf((j & 1) ? -cim[kk][j >> 1] : cre[kk][j >> 1]);
#pragma unroll
            for (int hg = 0; hg < 2; ++hg) {
                f32x4 br0[4], br1[4], bi0[4], bi1[4];
#pragma unroll
                for (int q = 0; q < 4; ++q) {
                    const int pp = (hg * 4 + q) * 8 + (fr >> 1); const size_t o = (size_t)(g * 64 + pp) * 16 + (fq & 1) * 8;
                    br0[q] = *(const f32x4*)(a.in[I_S5BRE] + o); br1[q] = *(const f32x4*)(a.in[I_S5BRE] + o + 4); bi0[q] = *(const f32x4*)(a.in[I_S5BIM] + o); bi1[q] = *(const f32x4*)(a.in[I_S5BIM] + o + 4);
                }
#pragma unroll
                for (int q = 0; q < 4; ++q) {
                    const int pt = hg * 4 + q, pp = pt * 8 + (fr >> 1); const float qr = __shfl(cr_, pp), qi = __shfl(ci_, pp);
#pragma unroll
                    for (int j = 0; j < 8; ++j) {
                        const float br = j < 4 ? br0[q][j & 3] : br1[q][j & 3], bi = j < 4 ? bi0[q][j & 3] : bi1[q][j & 3];
                        float v = (fr & 1) ? (qr * bi + qi * br) : (qr * br - qi * bi);
                        if (fq >= 2) v = 0.f;
                        Bd[pt][j] = (short)f2bf(v);
                    }
                }
                asm volatile("" ::: "memory");
            }
        }
#define S5_POS(n_, t_) ((((n_) < 8) ? (n_) : (n_) - 8) * 32 + (t_))
#define S5_ROW(n_, t_) ((((n_) < 8) ? b * CTXL : NCTX + b * SEQ) + (dir ? (((n_) < 8) ? CTXL : SEQ) - 1 - S5_POS(n_, t_) : S5_POS(n_, t_)))
#define S5_LOADU(d0, d1, n_) do { d0 = (bf16x8){0, 0, 0, 0, 0, 0, 0, 0}; d1 = d0; if (fq < 2 && (n_) < 136) { d0 = *(const bf16x8*)(A1 + (size_t)S5_ROW(n_, fr) * D + g * 16 + fq * 8); d1 = *(const bf16x8*)(A1 + (size_t)S5_ROW(n_, 16 + fr) * D + g * 16 + fq * 8); } } while (0)
        LAS float* BUF = (LAS float*)wl; LAS unsigned* HW = (LAS unsigned*)(wl + 16896); const LAS unsigned char* HP = wl + 16896;
        bf16x8 ua0, ua1, ub0, ub1;
        S5_LOADU(ua0, ua1, 0);
        f32x2 s = (f32x2){0.f, 0.f};
        const f32x2 abr = (f32x2){ab_re, ab_re}, abi = (f32x2){-ab_im, ab_im};
        bf16_t* yp = Y + (size_t)(b * SEQ + (dir ? SEQ - 1 - fq * 4 : fq * 4)) * D + g * 16 + fr;
        const long ystep = dir ? -(long)D : (long)D;
        unsigned yw[4] = {0u, 0u, 0u, 0u};
#define S5_YSTORE() do { yp[0] = (bf16_t)(yw[0] & 0xffffu); yp[ystep] = (bf16_t)(yw[0] >> 16); yp[2 * ystep] = (bf16_t)(yw[1] & 0xffffu); yp[3 * ystep] = (bf16_t)(yw[1] >> 16); \
            yp[16 * ystep] = (bf16_t)(yw[2] & 0xffffu); yp[17 * ystep] = (bf16_t)(yw[2] >> 16); yp[18 * ystep] = (bf16_t)(yw[3] & 0xffffu); yp[19 * ystep] = (bf16_t)(yw[3] >> 16); yp += 32 * ystep; } while (0)
        for (int n = 0; n < 136; ++n) {
#pragma unroll
            for (int hf = 0; hf < 2; ++hf)
#pragma unroll
                for (int pt = 0; pt < 8; ++pt) {
                    const f32x4 z = (f32x4){0.f, 0.f, 0.f, 0.f};
                    const f32x4 d = __builtin_amdgcn_mfma_f32_16x16x32_bf16(hf ? ua1 : ua0, Bd[pt], z, 0, 0, 0);
#pragma unroll
                    for (int j = 0; j < 4; ++j) BUF[(hf * 16 + fq * 4 + j) * 132 + pt * 16 + fr] = d[j];
                }
            if (n >= 9) S5_YSTORE();
            S5_LOADU(ub0, ub1, n + 1);
            LDS_WAIT();
            {
                const bool hist = n >= 8;
                f32x2 bu[32];
#pragma unroll
                for (int j = 0; j < 32; ++j) bu[j] = *(const LAS f32x2*)(BUF + j * 132 + 2 * lane);
                unsigned hw[32];
#pragma unroll
                for (int j = 0; j < 32; ++j) { const f32x2 t1 = abr * s + bu[j]; s = abi * (f32x2){s.y, s.x} + t1; hw[j] = cvt_pk_bf16(s.x, s.y); }
                if (hist) {
#pragma unroll
                    for (int j = 0; j < 32; ++j) HW[j * 68 + lane] = hw[j];
                }
            }
            LDS_WAIT();
            if (n >= 8) {
                f32x4 y0 = (f32x4){0.f, 0.f, 0.f, 0.f}, y1 = (f32x4){0.f, 0.f, 0.f, 0.f};
                bf16x8 ha[2][4];
#pragma unroll
                for (int hf = 0; hf < 2; ++hf)
#pragma unroll
                    for (int kk = 0; kk < 4; ++kk) ha[hf][kk] = *(const LAS bf16x8*)(HP + (hf * 16 + fr) * 272 + (kk * 32 + fq * 8) * 2);
#pragma unroll
                for (int kk = 0; kk < 4; ++kk) { y0 = __builtin_amdgcn_mfma_f32_16x16x32_bf16(ha[0][kk], Cf[kk], y0, 0, 0, 0); y1 = __builtin_amdgcn_mfma_f32_16x16x32_bf16(ha[1][kk], Cf[kk], y1, 0, 0, 0); }
                yw[0] = cvt_pk_bf16(y0[0], y0[1]); yw[1] = cvt_pk_bf16(y0[2], y0[3]); yw[2] = cvt_pk_bf16(y1[0], y1[1]); yw[3] = cvt_pk_bf16(y1[2], y1[3]);
                LDS_WAIT();
            }
            ua0 = ub0; ua1 = ub1;
        }
        S5_YSTORE();
#undef S5_YSTORE
#undef S5_POS
#undef S5_ROW
#undef S5_LOADU
    }
}
__device__ __forceinline__ float gelu_tanh_f(float x) { const float z = 0.7978845608f * (x + 0.044715f * x * x * x); return x * (1.0f - __builtin_amdgcn_rcpf(1.0f + __expf(2.0f * z))); }
__device__ __forceinline__ void s5_post_phase(const Args& a, int lane, int gw, int NGW) {
    const bf16_t* YF = (const bf16_t*)(a.ws + WS_YF); const bf16_t* YB = (const bf16_t*)(a.ws + WS_YB);
    const bf16_t* A1 = (const bf16_t*)(a.ws + WS_A); bf16_t* YG = (bf16_t*)(a.ws + WS_YG);
    f32x4 dk[4];
#pragma unroll
    for (int j = 0; j < 4; ++j) dk[j] = *(const f32x4*)(a.in[I_S5D] + 4 * lane + 256 * j);
    for (int tok0 = gw * 4; tok0 < NLAT; tok0 += NGW * 4) {
        u32x2 yf[4][4], yb[4][4], uu[4][4];
#pragma unroll
        for (int r = 0; r < 4; ++r) { const int tok = tok0 + r, b = tok >> 12, t = tok & 4095, src = b * SEQ + (t & 63) * 64 + (t >> 6);
#pragma unroll
            for (int j = 0; j < 4; ++j) { const int c = 4 * lane + 256 * j; yf[r][j] = *(const u32x2*)(YF + (size_t)src * D + c); yb[r][j] = *(const u32x2*)(YB + (size_t)src * D + c); uu[r][j] = *(const u32x2*)(A1 + (size_t)(NCTX + src) * D + c); } }
#pragma unroll
        for (int r = 0; r < 4; ++r)
#pragma unroll
            for (int j = 0; j < 4; ++j) {
                const u32x2 f = yf[r][j], bk = yb[r][j], uw = uu[r][j];
                const f32x4 y = (f32x4){bflo(f.x) + bflo(bk.x), bfhi(f.x) + bfhi(bk.x), bflo(f.y) + bflo(bk.y), bfhi(f.y) + bfhi(bk.y)} + dk[j] * (f32x4){bflo(uw.x), bfhi(uw.x), bflo(uw.y), bfhi(uw.y)};
                f32x4 o;
#pragma unroll
                for (int i = 0; i < 4; ++i) o[i] = gelu_tanh_f(y[i]);
                st_bf16x4(YG + (size_t)(tok0 + r) * D + 4 * lane + 256 * j, o);
            }
    }
}
struct EpiGlu {
    static constexpr bool PERM = true;
    const float* bglu; const float* modv1; bf16_t* H;
    __device__ __forceinline__ void operator()(const f32x4 (&acc)[2][2][4][2], const Unit& u, int wr, int wc, int fr, int fq) const {
        const int rt0 = u.pm * 256, bidx = rt0 >> 12, cb = u.pn * 128 + wc * 32 + 8 * fq, rl0 = wr * 64 + fr;
        const float* gp = modv1 + bidx * 6144 + 2048;
        const f32x4 ba0 = *(const f32x4*)(bglu + cb), ba1 = *(const f32x4*)(bglu + cb + 4), bb0 = *(const f32x4*)(bglu + 1024 + cb), bb1 = *(const f32x4*)(bglu + 1024 + cb + 4);
        const f32x4 gv0 = *(const f32x4*)(gp + cb), gv1 = *(const f32x4*)(gp + cb + 4);
#pragma unroll
        for (int ai = 0; ai < 2; ++ai)
#pragma unroll
            for (int m = 0; m < 4; ++m) {
                bf16_t* hp = H + (size_t)(NCTX + rt0 + rl0 + ai * 128 + m * 16) * D + cb;
                const u32x4 hw = *(const u32x4*)hp; const f32x4 h0 = (f32x4){bflo(hw.x), bfhi(hw.x), bflo(hw.y), bfhi(hw.y)}, h1 = (f32x4){bflo(hw.z), bfhi(hw.z), bflo(hw.w), bfhi(hw.w)};
                const f32x4 za0 = acc[ai][0][m][0] + ba0, za1 = acc[ai][0][m][1] + ba1, zb0 = acc[ai][1][m][0] + bb0, zb1 = acc[ai][1][m][1] + bb1; f32x4 o0, o1;
#pragma unroll
                for (int j = 0; j < 4; ++j) { o0[j] = za0[j] * sigmoid_f(zb0[j]); o1[j] = za1[j] * sigmoid_f(zb1[j]); }
                const f32x4 r0 = h0 + gv0 * o0, r1 = h1 + gv1 * o1;
                *(u32x4*)hp = (u32x4){pk2(r0[0], r0[1]), pk2(r0[2], r0[3]), pk2(r1[0], r1[1]), pk2(r1[2], r1[3])};
            }
    }
};

#define XB_TMO      128
#define XB_XCNT(j)  (256  + 64 * (j))
#define XB_XSUB(j)  (1280 + 64 * (j))
#define XB_XGEN(j)  (2304 + 64 * (j))
#define XB_TOP      3328
#define XB_TOPGEN   3392
#define XCD_BAR_WORDS 3456
#define XB_SPIN_CAP (1u << 18)
__device__ __forceinline__ unsigned xb_ld(unsigned* p)              { return __hip_atomic_load(p, __ATOMIC_RELAXED, __HIP_MEMORY_SCOPE_AGENT); }
__device__ __forceinline__ unsigned xb_add(unsigned* p, unsigned v) { return __hip_atomic_fetch_add(p, v, __ATOMIC_RELAXED, __HIP_MEMORY_SCOPE_AGENT); }
__device__ __forceinline__ unsigned xb_xcc_id() { return (unsigned)__builtin_amdgcn_s_getreg((3 << 11) | 20) & 0xFu; }
#define XB_SPIN(cond, bar) do { unsigned _sp = 0; while (cond) { __builtin_amdgcn_s_sleep(1); \
    if ((++_sp & 255u) == 0u) { if (xb_ld(&(bar)[XB_TMO])) break; if (_sp > XB_SPIN_CAP) { atomicAdd(&(bar)[XB_TMO], 1u); break; } } } } while (0)
struct XcdBarrier { unsigned* bar; unsigned x; volatile LAS unsigned* st; };
__device__ __forceinline__ XcdBarrier xcd_barrier_post(unsigned* bar, volatile LAS unsigned* st) {
    XcdBarrier b; b.bar = bar; b.x = xb_xcc_id(); b.st = st;
    if (threadIdx.x == 0) (void)xb_add(&bar[XB_XCNT(b.x)], 1u);
    return b;
}
__device__ __forceinline__ void xcd_barrier_complete(unsigned* bar, unsigned x, unsigned& nloc, unsigned& nx) {
    const unsigned G = gridDim.x * gridDim.y * gridDim.z;
    unsigned sum, cnt, mine, sp = 0u;
    for (;;) {
        sum = 0u; cnt = 0u; mine = 0u;
#pragma unroll
        for (unsigned j = 0; j < 16; ++j) { const unsigned c = xb_ld(&bar[XB_XCNT(j)]); sum += c; cnt += (c > 0u) ? 1u : 0u; mine = (j == x) ? c : mine; }
        if (sum == G) break;
        __builtin_amdgcn_s_sleep(1);
        if ((++sp & 255u) == 0u) { if (xb_ld(&bar[XB_TMO])) break; if (sp > XB_SPIN_CAP) { atomicAdd(&bar[XB_TMO], 1u); break; } }
    }
    nloc = mine > 0u ? mine : 1u; nx = cnt > 0u ? cnt : 1u;
}
__device__ __forceinline__ void xcd_barrier(const XcdBarrier& b) {
    asm volatile("s_waitcnt vmcnt(0)" ::: "memory");
    __syncthreads();
    if (threadIdx.x == 0) {
        unsigned* bar = b.bar;
        __builtin_amdgcn_s_waitcnt(0);
        unsigned nloc = b.st[0], nx = b.st[1];
        if (nloc == 0u) { xcd_barrier_complete(bar, b.x, nloc, nx); b.st[0] = nloc; b.st[1] = nx; }
        const unsigned old = xb_add(&bar[XB_XSUB(b.x)], 1u);
        const unsigned gen = old / nloc;
        if (old + 1u == (gen + 1u) * nloc) {
            __builtin_amdgcn_fence(__ATOMIC_RELEASE, "agent");
            asm volatile("s_waitcnt vmcnt(0)" ::: "memory");
            const unsigned og = xb_add(&bar[XB_TOP], 1u);
            const unsigned tg = og / nx;
            if (og + 1u == (tg + 1u) * nx) xb_add(&bar[XB_TOPGEN], 1u);
            else XB_SPIN(xb_ld(&bar[XB_TOPGEN]) == tg, bar);
            __builtin_amdgcn_fence(__ATOMIC_ACQUIRE, "agent");
            xb_add(&bar[XB_XGEN(b.x)], 1u);
            asm volatile("s_waitcnt vmcnt(0)" ::: "memory");
        } else {
            XB_SPIN(xb_ld(&bar[XB_XGEN(b.x)]) == gen, bar);
            __builtin_amdgcn_fence(__ATOMIC_ACQUIRE, "agent");
            asm volatile("s_waitcnt vmcnt(0)" ::: "memory");
        }
    }
    __syncthreads();
}

__device__ __forceinline__ int opaque_tid() { int t = threadIdx.x; asm volatile("" : "+v"(t)); return t; }
#define PHASE_IDS() const int tid = opaque_tid(); const int lane = tid & 63, wave = tid >> 6; const int G = gridDim.x, gw = blockIdx.x * 8 + wave, NGW = G * 8; \
    const int vcu = (G % 8 == 0) ? (int)(blockIdx.x % 8) * (G / 8) + (int)(blockIdx.x / 8) : (int)blockIdx.x; (void)lane; (void)wave; (void)gw; (void)NGW; (void)vcu; (void)G
__global__ void __launch_bounds__(NTHREADS, 2) fwd_mega(Args a) {
    extern __shared__ __attribute__((aligned(16))) unsigned char lds_raw[];
    LAS unsigned char* lds = (LAS unsigned char*)lds_raw;
    cg::grid_group grid = cg::this_grid();
    unsigned char* ws = a.ws;
    if (threadIdx.x < 2) ((LAS unsigned*)(lds + LDS_BYTES - 16))[threadIdx.x] = 0u;
    __syncthreads();
    const XcdBarrier xbar = xcd_barrier_post((unsigned*)(ws + WS_CTL) + CW_BAR, (volatile LAS unsigned*)(lds + LDS_BYTES - 16));
#ifdef TS_SEL
    volatile LAS unsigned long long* tsbuf = (volatile LAS unsigned long long*)(lds + LDS_BYTES - 16 - 256);
    int tsn = 0;
#define TS_MARK() do { if (blockIdx.x == 0 && threadIdx.x == 0) tsbuf[tsn] = __builtin_amdgcn_s_memrealtime(); ++tsn; } while (0)
#else
#define TS_MARK() do { } while (0)
#endif
    TS_MARK();
#define GSYNC() do { xcd_barrier(xbar); TS_MARK(); } while (0)

    for (int rep = 0; rep < REP_P0; ++rep) { PHASE_IDS(); p0_phase(a, lds, tid, gw, NGW); if (REP_P0 > 1) __syncthreads(); }
    if (a.pad1 != 0) grid.sync();
    GSYNC();
    for (int rep = 0; rep < REP_P1; ++rep) { PHASE_IDS(); p1_phase(a, lane, gw, NGW); }
    GSYNC();
    {
        PHASE_IDS();
        pg8::Gemm g{(const bf16_t*)(ws + WS_A), (const bf16_t*)(ws + WS_WIN), NTOK, 5120, 1024};
        pg8::StaticOrder S; S.init(NTOK, 5120, G, (int)blockIdx.x);
        EpiInProj E{(bf16_t*)(ws + WS_Q), (bf16_t*)(ws + WS_V), (bf16_t*)(ws + WS_G), (_Float16*)(ws + WS_LFF), (_Float16*)(ws + WS_LFB), (const float*)(ws + WS_LBV)};
        for (int rep = 0; rep < REP_INP; ++rep) pg8::gemm_phase<EpiInProj, pg8::StaticOrder>(lds, g, S, E);
    }
    GSYNC();
    for (int rep = 0; rep < REP_GLA; ++rep) { PHASE_IDS(); gla_phase(a, lds, tid); if (REP_GLA > 1) __syncthreads(); }
    GSYNC();
    for (int rep = 0; rep < REP_RO; ++rep) { PHASE_IDS(); gla_readout_phase(a, lane, gw, NGW); }
    GSYNC();
    {
        PHASE_IDS();
        pg8::Gemm g{(const bf16_t*)(ws + WS_OG), (const bf16_t*)(ws + WS_WOUT), NTOK, 1024, 1024};
        pg8::StaticOrder S; S.init(NTOK, 1024, G, (int)blockIdx.x);
        EpiResid E{a.in[I_X], a.in[I_CTX], (const float*)(ws + WS_MODV), (bf16_t*)(ws + WS_H), 2048};
        for (int rep = 0; rep < REP_OUT; ++rep) pg8::gemm_phase<EpiResid, pg8::StaticOrder>(lds, g, S, E);
    }
    GSYNC();
    for (int rep = 0; rep < REP_RT; ++rep) { PHASE_IDS(); router_phase(a, lds, 0, 0, tid); if (REP_RT > 1) __syncthreads(); }
    GSYNC();
    for (int rep = 0; rep < REP_AS; ++rep) { PHASE_IDS(); assign_phase(a, lds, 0, 0, tid); if (REP_AS > 1) __syncthreads(); }
    GSYNC();
    for (int rep = 0; rep < REP_M1; ++rep) { PHASE_IDS(); moe_gemm1(a, lds, 0, tid, G, vcu); }
    GSYNC();
    for (int rep = 0; rep < REP_M2; ++rep) { PHASE_IDS(); moe_gemm2(a, lds, 0, tid, G, vcu); }
    GSYNC();
    { PHASE_IDS(); combine_phase(a, 0, 0, lane, gw, NGW); }
    GSYNC();
    for (int rep = 0; rep < REP_S5; ++rep) { PHASE_IDS(); s5_phase(a, lds, tid); if (REP_S5 > 1) __syncthreads(); }
    GSYNC();
    for (int rep = 0; rep < REP_POST; ++rep) { PHASE_IDS(); s5_post_phase(a, lane, gw, NGW); }
    GSYNC();
    {
        PHASE_IDS();
        pg8::Gemm g{(const bf16_t*)(ws + WS_YG), (const bf16_t*)(ws + WS_WGLU), NLAT, 2048, 1024};
        pg8::StaticOrder S; S.init(NLAT, 2048, G, (int)blockIdx.x);
        EpiGlu E{a.in[I_S5BGLU], (const float*)(ws + WS_MODV) + 9 * 6144, (bf16_t*)(ws + WS_H)};
        pg8::gemm_phase<EpiGlu, pg8::StaticOrder>(lds, g, S, E);
    }
    GSYNC();
    { PHASE_IDS(); router_phase(a, lds, 1, NCTX, tid); }
    GSYNC();
    { PHASE_IDS(); assign_phase(a, lds, 1, NCTX, tid); }
    GSYNC();
    { PHASE_IDS(); moe_gemm1(a, lds, 1, tid, G, vcu); }
    GSYNC();
    { PHASE_IDS(); moe_gemm2(a, lds, 1, tid, G, vcu); }
    GSYNC();
    for (int rep = 0; rep < REP_CMB1; ++rep) { PHASE_IDS(); combine_phase(a, 1, NCTX, lane, gw, NGW); }
#ifdef TS_SEL
    TS_MARK();
    if (blockIdx.x == 0 && threadIdx.x == 0) {
        asm volatile("s_waitcnt vmcnt(0)" ::: "memory"); __threadfence();
        const unsigned long long dt = tsbuf[TS_SEL + 1] - tsbuf[TS_SEL];
        atomicAdd(a.out, (float)dt * 0.001f);
    }
#endif
}

extern "C" void kernel_launch(void* const* d_in, const int* in_sizes, int n_in, void* d_out, int out_size,
                              void* d_ws, size_t ws_size, hipStream_t stream) {
    static int grid_blocks = 0;
    if (!grid_blocks) {
        int dev = 0, cus = 0, per_cu = 0;
        (void)hipGetDevice(&dev);
        (void)hipDeviceGetAttribute(&cus, hipDeviceAttributeMultiprocessorCount, dev);
        (void)hipFuncSetAttribute((const void*)fwd_mega, hipFuncAttributeMaxDynamicSharedMemorySize, LDS_BYTES);
        (void)hipOccupancyMaxActiveBlocksPerMultiprocessor(&per_cu, (const void*)fwd_mega, NTHREADS, LDS_BYTES);
        if (per_cu < 1) { fprintf(stderr, "occupancy query says %d blocks/CU\n", per_cu); }
        grid_blocks = cus < 256 ? cus : 256;
        if (ws_size < WS_END) fprintf(stderr, "kernel_launch: workspace too small: %zu < %zu\n", ws_size, (size_t)WS_END);
    }
    (void)hipMemsetAsync((char*)d_ws + WS_CTL, 0, 1 * MiB, stream);
    Args a{};
    for (int i = 0; i < 29; ++i) a.in[i] = (const float*)d_in[i];
    a.out = (float*)d_out; a.ws = (unsigned char*)d_ws;
    void* kargs[] = {&a};
    hipError_t e = hipLaunchCooperativeKernel((const void*)fwd_mega, dim3(grid_blocks), dim3(NTHREADS), kargs, LDS_BYTES, stream);
    if (e != hipSuccess) fprintf(stderr, "cooperative launch failed: %s (grid %d)\n", hipGetErrorString(e), grid_blocks);
}
```

```cpp
#include <hip/hip_runtime.h>
#include <hip/hip_cooperative_groups.h>
#include <cstdio>
#include <cstdint>
namespace cg = cooperative_groups;

#define LAS __attribute__((address_space(3)))
typedef unsigned short bf16_t;
typedef short bf16x8 __attribute__((ext_vector_type(8)));
typedef float f32x4 __attribute__((ext_vector_type(4)));
typedef unsigned u32x4 __attribute__((ext_vector_type(4)));
typedef unsigned u32x2 __attribute__((ext_vector_type(2)));
typedef float f32x2 __attribute__((ext_vector_type(2)));

constexpr int NTHREADS = 512;
constexpr int LDS_BYTES = 147456;
constexpr int D = 1024, NB = 8, SEQ = 4096, CTXL = 256;
constexpr int NCTX = NB * CTXL;
constexpr int NLAT = NB * SEQ;
constexpr int NTOK = NCTX + NLAT;
constexpr int NE = 32;
constexpr int MPAD = 147456;
constexpr float EPS = 1e-6f;

constexpr size_t MiB = 1u << 20;
constexpr size_t WS_CTL = 0;
constexpr size_t WS_MODV = 1 * MiB;
constexpr size_t WS_LBV = 1 * MiB + 512 * 1024;
constexpr size_t WS_WIN = 2 * MiB;
constexpr size_t WS_WOUT = 12 * MiB;
constexpr size_t WS_WGLU = 14 * MiB;
constexpr size_t WS_W1 = 18 * MiB;
constexpr size_t WS_W2 = 274 * MiB;
constexpr size_t WS_H = 402 * MiB;
constexpr size_t WS_A = 538 * MiB;
constexpr size_t WS_F = 606 * MiB;
constexpr size_t WS_TOKE = 674 * MiB;
constexpr size_t WS_TOKW = 674 * MiB + 640 * 1024;
constexpr size_t WS_TOKS = 674 * MiB + 1280 * 1024;
constexpr size_t WS_SLOTTOK = 256 * 1024;
constexpr size_t WS_BIG = 676 * MiB;
constexpr size_t WS_Q = WS_BIG, WS_V = WS_BIG + 68 * MiB, WS_G = WS_BIG + 136 * MiB;
constexpr size_t WS_LFF = WS_BIG + 204 * MiB, WS_LFB = WS_BIG + 340 * MiB;
constexpr size_t WS_OF = WS_BIG + 476 * MiB, WS_OB = WS_BIG + 612 * MiB;
constexpr size_t WS_OG = WS_BIG + 748 * MiB;
constexpr size_t WS_AG = WS_BIG, WS_ACT = WS_BIG + 288 * MiB, WS_YS = WS_BIG;
constexpr size_t WS_YF = WS_BIG, WS_YB = WS_BIG + 128 * MiB, WS_YG = WS_BIG + 256 * MiB;
constexpr size_t WS_END = WS_BIG + 816 * MiB;
constexpr int CW_CNT = 64;
constexpr int CW_CUR = 256;
constexpr int CW_CNTB = 8192;
constexpr int CW_BAR = 4096;
#ifndef REP_P0
#define REP_P0 1
#endif
#ifndef REP_GLA
#define REP_GLA 1
#endif
#ifndef REP_S5
#define REP_S5 1
#endif
#ifndef REP_P1
#define REP_P1 1
#endif
#ifndef REP_RO
#define REP_RO 1
#endif
#ifndef REP_POST
#define REP_POST 1
#endif
#ifndef REP_CMB1
#define REP_CMB1 1
#endif
#ifndef REP_OUT
#define REP_OUT 1
#endif
#ifndef REP_RT
#define REP_RT 1
#endif
#ifndef REP_AS
#define REP_AS 1
#endif
#ifndef REP_INP
#define REP_INP 1
#endif
#ifndef REP_M1
#define REP_M1 1
#endif
#ifndef REP_M2
#define REP_M2 1
#endif

struct Args {
    const float* in[29];
    float* out;
    unsigned char* ws;
    int stop_after, pad1;
};
enum { I_X = 0, I_C, I_CTX, I_CCTX, I_MODW, I_MODB, I_N1G, I_N2G, I_HGWIN, I_HGLB, I_HGNG, I_HGWOUT, I_S5ARE, I_S5AIM, I_S5LDT,
       I_S5BRE, I_S5BIM, I_S5CRE, I_S5CIM, I_S5D, I_S5WGLU, I_S5BGLU, I_RW, I_RB, I_W1, I_B1, I_W2, I_B2, I_FG };

__device__ __forceinline__ unsigned f2bf(float f) { unsigned u = __builtin_bit_cast(unsigned, f); return (u + 0x7fffu + ((u >> 16) & 1u)) >> 16; }
typedef __bf16 bf16x2_t __attribute__((ext_vector_type(2)));
__device__ __forceinline__ unsigned cvt_pk_bf16(float lo, float hi) { const bf16x2_t v = {(__bf16)lo, (__bf16)hi}; return __builtin_bit_cast(unsigned, v); }
__device__ __forceinline__ unsigned pk2(float lo, float hi) { return cvt_pk_bf16(lo, hi); }
__device__ __forceinline__ float bf2f(unsigned short b) { return __builtin_bit_cast(float, ((unsigned)b) << 16); }
__device__ __forceinline__ float bflo(unsigned w) { return __builtin_bit_cast(float, w << 16); }
__device__ __forceinline__ float bfhi(unsigned w) { return __builtin_bit_cast(float, w & 0xffff0000u); }
__device__ __forceinline__ float wave_sum(float v) {
#pragma unroll
    for (int o = 1; o < 64; o <<= 1) v += __shfl_xor(v, o);
    return v;
}
__device__ __forceinline__ float wave_max(float v) {
#pragma unroll
    for (int o = 1; o < 64; o <<= 1) v = fmaxf(v, __shfl_xor(v, o));
    return v;
}
__device__ __forceinline__ float sigmoid_f(float x) { return __builtin_amdgcn_rcpf(1.0f + __expf(-x)); }
__device__ __forceinline__ float silu_f(float x) { return x * __builtin_amdgcn_rcpf(1.0f + __expf(-x)); }
#define LDS_WAIT() asm volatile("s_waitcnt lgkmcnt(0)" ::: "memory")

namespace pg8 {
constexpr int BM = 256, BK = 64, HALF = 128, HTB = HALF * BK * 2, STAGE_BYTES = 8 * HTB, NXCD = 8, WGM = 8;
__host__ __device__ __forceinline__ int lds_byte(int r, int c) { const int st = (r >> 4) * 2 + (c >> 5), rr = r & 15, cc = c & 31, ob = rr * 64 + cc * 2; return st * 1024 + (ob ^ (((ob >> 9) & 1) << 5)); }
__host__ __device__ __forceinline__ void stage_rc(int b, int& R, int& C) { const int st = b / 1024, sb = b % 1024, swz = sb ^ (((sb >> 9) & 1) << 5); R = (st >> 1) * 16 + swz / 64; C = (st & 1) * 32 + (swz % 64) / 2; }
__host__ __device__ __forceinline__ int perm32(int rho) { const int n = rho >> 4, i = rho & 15; return 8 * (i >> 2) + 4 * n + (i & 3); }
struct Unit { int pm, pn; };
struct Gemm { const bf16_t* A; const bf16_t* Bt; int M, N, K; };
struct StaticOrder {
    int nM, nN, nwg, G, c;
    __device__ void init(int M, int N, int G_, int c_) { nM = M / BM; nN = N / BM; nwg = nM * nN; G = G_; c = c_; }
    __device__ bool next(int i, Unit& u) const {
        const long L = (long)i * G + c; if (L >= nwg) return false;
        int wgid = (int)L; { const int q = nwg / NXCD, r = nwg % NXCD, xcd = wgid % NXCD, off = wgid / NXCD; wgid = (xcd < r ? xcd * (q + 1) : r * (q + 1) + (xcd - r) * q) + off; }
        const int nig = WGM * nN, gid = wgid / nig, fm = gid * WGM, gsz = (nM - fm) < WGM ? (nM - fm) : WGM;
        u.pm = fm + ((wgid % nig) % gsz); u.pn = (wgid % nig) / gsz; return true;
    }
    __device__ __forceinline__ void a_ready(const Unit&) const {}
    __device__ __forceinline__ void done(const Unit&) const {}
};
struct MoeOrder {
    const LAS int* tile_e; int TT, sh, G, v;
    __device__ bool next(int i, Unit& u) const {
        const int per = G >> 3, x = v / per, j = v - x * per;
        const int t0 = (int)(((long)x * TT) >> 3), t1 = (int)(((long)(x + 1) * TT) >> 3);
        const int uu = i * per + j, rt = t0 + (uu >> sh), pnl = uu & ((1 << sh) - 1);
        if (rt >= t1) return false;
        u.pm = rt; u.pn = (tile_e[rt] << sh) + pnl; return true;
    }
    __device__ __forceinline__ void a_ready(const Unit&) const {}
    __device__ __forceinline__ void done(const Unit&) const {}
};

template <class Epi, class Sched, bool GATHER = false>
__device__ __forceinline__ void gemm_phase(LAS unsigned char* lds, const Gemm g, const Sched& S, const Epi& E, const int* rowidx = nullptr) {
    int tid_ = threadIdx.x; asm volatile("" : "+v"(tid_));
    const int tid = tid_, wid = __builtin_amdgcn_readfirstlane(tid >> 6), lane = tid & 63, wr = wid >> 2, wc = wid & 3, fr = lane & 15, fq = lane >> 4;
    const int K = g.K, nt = K / BK;
    unsigned voffA[2], voffB[2];
    int Rr[2], Cc2[2];
#pragma unroll
    for (int i = 0; i < 2; ++i) { int R, C; stage_rc(tid * 16 + i * 8192, R, C); voffA[i] = (unsigned)(R * K + C) * 2u; const int Rb = Epi::PERM ? ((R & ~31) + perm32(R & 31)) : R; voffB[i] = (unsigned)(Rb * K + C) * 2u; Rr[i] = R; Cc2[i] = C * 2; }
    unsigned gA0[2] = {0u, 0u}, gA1[2] = {0u, 0u}, nG0[2] = {0u, 0u}, nG1[2] = {0u, 0u};
#define PG8_ROWS(pm_, d0, d1) do { _Pragma("unroll") for (int _i = 0; _i < 2; ++_i) { d0[_i] = (unsigned)rowidx[(pm_) * BM + Rr[_i]] * (unsigned)(K * 2) + (unsigned)Cc2[_i]; d1[_i] = (unsigned)rowidx[(pm_) * BM + HALF + Rr[_i]] * (unsigned)(K * 2) + (unsigned)Cc2[_i]; } } while (0)
#define PG8_STAGE_A(bufoff, ptr, h, nx) do { if constexpr (GATHER) { unsigned _o[2]; _o[0] = (nx) ? ((h) ? nG1[0] : nG0[0]) : ((h) ? gA1[0] : gA0[0]); _o[1] = (nx) ? ((h) ? nG1[1] : nG0[1]) : ((h) ? gA1[1] : gA0[1]); PG8_STAGE(bufoff, ptr, _o); } \
        else { PG8_STAGE(bufoff, (ptr) + ((h) ? hstep : 0), voffA); } } while (0)
    const size_t kstep = (size_t)(BK * 2);
    const size_t hstep = (size_t)HALF * K * 2;
    const size_t tstep = 2 * hstep;
    const unsigned ldsw = (unsigned)wid * 1024u;
    const int aoff = lds_byte(wr * 64 + fr, fq * 8), boff = lds_byte(wc * 32 + fr, fq * 8);
#define PG8_SA(b, h) (((b) * 2 + (h)) * HTB)
#define PG8_SB(b, h) ((4 + (b) * 2 + (h)) * HTB)
#define PG8_STAGE(bufoff, gbase, voff) do { _Pragma("unroll") for (int _i = 0; _i < 2; ++_i) \
        __builtin_amdgcn_global_load_lds((const unsigned*)((const char*)(gbase) + (voff)[_i]), (LAS unsigned*)(lds + (bufoff) + ldsw + _i * 8192), 16, 0, 0); } while (0)
#define PG8_LDA(dst, b, h) do { _Pragma("unroll") for (int m = 0; m < 4; ++m) _Pragma("unroll") for (int k = 0; k < 2; ++k) dst[m][k] = *(const LAS bf16x8*)(lds + PG8_SA(b, h) + aoff + m * 2048 + k * 1024); } while (0)
#define PG8_LDB(dst, b, h) do { _Pragma("unroll") for (int n = 0; n < 2; ++n) _Pragma("unroll") for (int k = 0; k < 2; ++k) dst[n][k] = *(const LAS bf16x8*)(lds + PG8_SB(b, h) + boff + n * 2048 + k * 1024); } while (0)
#define PG8_MMA(ai, bj, At, Bt) do { __builtin_amdgcn_s_setprio(1); _Pragma("unroll") for (int m = 0; m < 4; ++m) _Pragma("unroll") for (int n = 0; n < 2; ++n) _Pragma("unroll") for (int k = 0; k < 2; ++k) \
        acc[ai][bj][m][n] = __builtin_amdgcn_mfma_f32_16x16x32_bf16(Bt[n][k], At[m][k], acc[ai][bj][m][n], 0, 0, 0); __builtin_amdgcn_s_setprio(0); } while (0)
#define PG8_WAIT_V(n) asm volatile("s_waitcnt vmcnt(" #n ")" ::: "memory")
#define PG8_WAIT_L(n) asm volatile("s_waitcnt lgkmcnt(" #n ")" ::: "memory")
#define PG8_BAR __builtin_amdgcn_s_barrier()
#define PG8_SCHED __builtin_amdgcn_sched_barrier(0)
    Unit cur, nxt; int ui = 0;
    if (!S.next(0, cur)) return;
    f32x4 acc[2][2][4][2];
#pragma unroll
    for (int a = 0; a < 2; ++a)
#pragma unroll
        for (int b = 0; b < 2; ++b)
#pragma unroll
            for (int m = 0; m < 4; ++m)
#pragma unroll
                for (int n = 0; n < 2; ++n) acc[a][b][m][n] = (f32x4){0.f, 0.f, 0.f, 0.f};
    bf16x8 At[4][2], B0[2][2], B1[2][2];
    const char* cA = GATHER ? (const char*)g.A : (const char*)g.A + (size_t)cur.pm * tstep; const char* cB = (const char*)g.Bt + (size_t)cur.pn * tstep;
    S.a_ready(cur);
    if constexpr (GATHER) PG8_ROWS(cur.pm, gA0, gA1);
    PG8_STAGE(PG8_SB(0, 0), cB, voffB); PG8_STAGE_A(PG8_SA(0, 0), cA, 0, false); PG8_STAGE(PG8_SB(0, 1), cB + hstep, voffB); PG8_STAGE_A(PG8_SA(0, 1), cA, 1, false);
    if (wr == 1) PG8_BAR;
    PG8_WAIT_V(4); PG8_BAR;
    PG8_STAGE(PG8_SB(1, 0), cB + kstep, voffB); PG8_STAGE_A(PG8_SA(1, 0), cA + kstep, 0, false); PG8_STAGE(PG8_SB(1, 1), cB + hstep + kstep, voffB);
    PG8_WAIT_V(6); PG8_BAR;
    for (;;) {
        const bool has_next = S.next(ui + 1, nxt);
        const char* nA = GATHER ? cA : (has_next ? (const char*)g.A + (size_t)nxt.pm * tstep : cA); const char* nB = has_next ? (const char*)g.Bt + (size_t)nxt.pn * tstep : cB;
        if constexpr (GATHER) { if (has_next) PG8_ROWS(nxt.pm, nG0, nG1); else { nG0[0] = gA0[0]; nG0[1] = gA0[1]; nG1[0] = gA1[0]; nG1[1] = gA1[1]; } }
        for (int t = 0; t < nt; t += 2) {
            const bool last = (t == nt - 2);
            const char* a1 = cA + (size_t)(t + 1) * kstep;
            const char* a2 = last ? nA : cA + (size_t)(t + 2) * kstep; const char* b2 = last ? nB : cB + (size_t)(t + 2) * kstep;
            const char* a3 = a2 + kstep; const char* b3 = b2 + kstep;
            if (last && has_next) S.a_ready(nxt);
            PG8_LDB(B0, 0, 0); PG8_SCHED; PG8_LDA(At, 0, 0); PG8_STAGE_A(PG8_SA(1, 1), a1, 1, false);
            PG8_WAIT_L(8); PG8_BAR; PG8_WAIT_L(0); PG8_MMA(0, 0, At, B0); PG8_BAR; PG8_SCHED;
            PG8_LDB(B1, 0, 1); PG8_STAGE(PG8_SB(0, 0), b2, voffB);
            PG8_BAR; PG8_WAIT_L(0); PG8_MMA(0, 1, At, B1); PG8_BAR;
            PG8_LDA(At, 0, 1); PG8_STAGE_A(PG8_SA(0, 0), a2, 0, last);
            PG8_BAR; PG8_WAIT_L(0); PG8_MMA(1, 0, At, B0); PG8_BAR; PG8_SCHED;
            PG8_STAGE(PG8_SB(0, 1), b2 + hstep, voffB);
            PG8_WAIT_V(6); PG8_BAR; PG8_MMA(1, 1, At, B1); PG8_BAR;
            PG8_LDB(B0, 1, 0); PG8_SCHED; PG8_LDA(At, 1, 0); PG8_STAGE_A(PG8_SA(0, 1), a2, 1, last);
            PG8_WAIT_L(8); PG8_BAR; PG8_WAIT_L(0); PG8_MMA(0, 0, At, B0); PG8_BAR; PG8_SCHED;
            PG8_LDB(B1, 1, 1); PG8_STAGE(PG8_SB(1, 0), b3, voffB);
            PG8_BAR; PG8_WAIT_L(0); PG8_MMA(0, 1, At, B1); PG8_BAR;
            PG8_LDA(At, 1, 1); PG8_STAGE_A(PG8_SA(1, 0), a3, 0, last);
            PG8_BAR; PG8_WAIT_L(0); PG8_MMA(1, 0, At, B0); PG8_BAR; PG8_SCHED;
            PG8_STAGE(PG8_SB(1, 1), b3 + hstep, voffB);
            PG8_WAIT_V(6); PG8_BAR; PG8_MMA(1, 1, At, B1); PG8_BAR;
        }
        E(acc, cur, wr, wc, fr, fq); S.done(cur);
        if (!has_next) break;
#pragma unroll
        for (int a = 0; a < 2; ++a)
#pragma unroll
            for (int b = 0; b < 2; ++b)
#pragma unroll
                for (int m = 0; m < 4; ++m)
#pragma unroll
                    for (int n = 0; n < 2; ++n) acc[a][b][m][n] = (f32x4){0.f, 0.f, 0.f, 0.f};
        cur = nxt; cA = nA; cB = nB; ++ui;
        if constexpr (GATHER) { gA0[0] = nG0[0]; gA0[1] = nG0[1]; gA1[0] = nG1[0]; gA1[1] = nG1[1]; }
    }
    PG8_WAIT_V(0);
    if (wr == 0) PG8_BAR;
    PG8_BAR;
#undef PG8_SA
#undef PG8_ROWS
#undef PG8_STAGE_A
#undef PG8_SB
#undef PG8_STAGE
#undef PG8_LDA
#undef PG8_LDB
#undef PG8_MMA
#undef PG8_WAIT_V
#undef PG8_WAIT_L
#undef PG8_BAR
#undef PG8_SCHED
}
}
using pg8::Unit;

__device__ __forceinline__ f32x4 ld_bf16x4(const bf16_t* p) { const u32x2 w = *(const u32x2*)p; return (f32x4){bflo(w.x), bfhi(w.x), bflo(w.y), bfhi(w.y)}; }
__device__ __forceinline__ void st_bf16x4(bf16_t* p, f32x4 v) { u32x2 w; w.x = pk2(v[0], v[1]); w.y = pk2(v[2], v[3]); *(u32x2*)p = w; }

struct EpiInProj {
    static constexpr bool PERM = true;
    bf16_t *Q, *V, *G; _Float16 *LFF, *LFB; const float* lbv;
    __device__ __forceinline__ void operator()(const f32x4 (&acc)[2][2][4][2], const Unit& u, int wr, int wc, int fr, int fq) const {
        const int seg = u.pn >> 2, cb = (u.pn & 3) * 256 + wc * 32 + 8 * fq, row0 = u.pm * 256 + wr * 64 + fr;
#pragma unroll
        for (int bj = 0; bj < 2; ++bj) {
            const int c = cb + bj * 128;
            f32x4 lb0 = (f32x4){0.f, 0.f, 0.f, 0.f}, lb1 = lb0;
            if (seg == 2 || seg == 3) { lb0 = *(const f32x4*)(lbv + (seg - 2) * D + c); lb1 = *(const f32x4*)(lbv + (seg - 2) * D + c + 4); }
#pragma unroll
            for (int ai = 0; ai < 2; ++ai)
#pragma unroll
                for (int m = 0; m < 4; ++m) {
                    const size_t ro = (size_t)(row0 + ai * 128 + m * 16) * D + c;
                    const f32x4 v0 = acc[ai][bj][m][0], v1 = acc[ai][bj][m][1];
                    if (seg == 0) { f32x4 o0, o1; for (int j = 0; j < 4; ++j) { o0[j] = silu_f(v0[j]); o1[j] = silu_f(v1[j]); }
                        *(u32x4*)(Q + ro) = (u32x4){pk2(o0[0], o0[1]), pk2(o0[2], o0[3]), pk2(o1[0], o1[1]), pk2(o1[2], o1[3])}; }
                    else if (seg == 1) { *(u32x4*)(V + ro) = (u32x4){pk2(v0[0], v0[1]), pk2(v0[2], v0[3]), pk2(v1[0], v1[1]), pk2(v1[2], v1[3])}; }
                    else if (seg == 4) { *(u32x4*)(G + ro) = (u32x4){pk2(v0[0], v0[1]), pk2(v0[2], v0[3]), pk2(v1[0], v1[1]), pk2(v1[2], v1[3])}; }
                    else {
                        f32x4 o0, o1;
                        for (int j = 0; j < 4; ++j) { o0[j] = __logf(lb0[j] + (1.0f - lb0[j]) * sigmoid_f(v0[j])); o1[j] = __logf(lb1[j] + (1.0f - lb1[j]) * sigmoid_f(v1[j])); }
                        u32x4 hw; hw.x = __builtin_bit_cast(unsigned, __builtin_amdgcn_cvt_pkrtz(o0[0], o0[1])); hw.y = __builtin_bit_cast(unsigned, __builtin_amdgcn_cvt_pkrtz(o0[2], o0[3]));
                        hw.z = __builtin_bit_cast(unsigned, __builtin_amdgcn_cvt_pkrtz(o1[0], o1[1])); hw.w = __builtin_bit_cast(unsigned, __builtin_amdgcn_cvt_pkrtz(o1[2], o1[3]));
                        *(u32x4*)((seg == 2 ? LFF : LFB) + ro) = hw;
                    }
                }
        }
    }
};
struct EpiResid {
    static constexpr bool PERM = true;
    const float* x; const float* ctx; const float* modv; bf16_t* H; int gate_off;
    __device__ __forceinline__ void operator()(const f32x4 (&acc)[2][2][4][2], const Unit& u, int wr, int wc, int fr, int fq) const {
        const int rt0 = u.pm * 256; const int mr = rt0 < NCTX ? 8 : ((rt0 - NCTX) >> 12);
        const float* src = rt0 < NCTX ? ctx + (size_t)rt0 * D : x + (size_t)(rt0 - NCTX) * D;
        const int cb = u.pn * 256 + wc * 32 + 8 * fq, rl0 = wr * 64 + fr;
        const float* gp = modv + mr * 6144 + gate_off;
#pragma unroll
        for (int bj = 0; bj < 2; ++bj) {
            const int c = cb + bj * 128; const f32x4 g0 = *(const f32x4*)(gp + c), g1 = *(const f32x4*)(gp + c + 4);
#pragma unroll
            for (int ai = 0; ai < 2; ++ai)
#pragma unroll
                for (int m = 0; m < 4; ++m) {
                    const int rl = rl0 + ai * 128 + m * 16; const float* hp = src + (size_t)rl * D + c; bf16_t* op = H + (size_t)(rt0 + rl) * D + c;
                    const f32x4 h0 = *(const f32x4*)hp, h1 = *(const f32x4*)(hp + 4);
                    const f32x4 o0 = h0 + g0 * acc[ai][bj][m][0], o1 = h1 + g1 * acc[ai][bj][m][1];
                    *(u32x4*)op = (u32x4){pk2(o0[0], o0[1]), pk2(o0[2], o0[3]), pk2(o1[0], o1[1]), pk2(o1[2], o1[3])};
                }
        }
    }
};

struct TrItem { const float* src; bf16_t* dst; int N; };
__device__ __forceinline__ void tr_load(const TrItem& t, f32x4 (&v)[16], int lane) {
    const float* p = t.src + (size_t)(2 * (lane >> 4)) * t.N + 4 * (lane & 15);
#pragma unroll
    for (int i = 0; i < 8; ++i) { v[2 * i] = *(const f32x4*)(p + (size_t)(8 * i) * t.N); v[2 * i + 1] = *(const f32x4*)(p + (size_t)(8 * i + 1) * t.N); }
}
__device__ __forceinline__ void tr_finish(const TrItem& t, const f32x4 (&v)[16], LAS unsigned* scr, int lane) {
#pragma unroll
    for (int i = 0; i < 8; ++i) {
        const int kp = 4 * i + (lane >> 4); LAS unsigned* s = scr + kp * 65 + 4 * (lane & 15);
        s[0] = cvt_pk_bf16(v[2 * i][0], v[2 * i + 1][0]); s[1] = cvt_pk_bf16(v[2 * i][1], v[2 * i + 1][1]); s[2] = cvt_pk_bf16(v[2 * i][2], v[2 * i + 1][2]); s[3] = cvt_pk_bf16(v[2 * i][3], v[2 * i + 1][3]);
    }
    LDS_WAIT();
    const int c = lane & 7;
#pragma unroll
    for (int j = 0; j < 8; ++j) {
        const int n = (lane >> 3) + 8 * j; const LAS unsigned* s = scr + (4 * c) * 65 + n;
        *(u32x4*)(t.dst + (size_t)n * 1024 + 8 * c) = (u32x4){s[0], s[65], s[130], s[195]};
    }
    LDS_WAIT();
}
__device__ __forceinline__ int ilv_row(int c) { const int bj = c >> 10, r = c & 1023; return (r >> 7) * 256 + bj * 128 + (r & 127); }

__device__ __forceinline__ TrItem moe_item(const Args& a, int r, int layer) {
    TrItem t;
    if (r < 32 * 512) { const int mat = layer * 32 + (r >> 9), sub = r & 511, kb = sub >> 5, nb = sub & 31;
        t.src = a.in[I_W1] + (size_t)mat * 1024 * 2048 + (size_t)(kb * 64) * 2048 + nb * 64; t.dst = (bf16_t*)(a.ws + WS_W1) + (size_t)mat * 2048 * 1024 + (size_t)ilv_row(nb * 64) * 1024 + kb * 64; t.N = 2048; }
    else { r -= 32 * 512; const int mat = layer * 32 + (r >> 8), sub = r & 255, kb = sub >> 4, nb = sub & 15;
        t.src = a.in[I_W2] + (size_t)mat * 1024 * 1024 + (size_t)(kb * 64) * 1024 + nb * 64; t.dst = (bf16_t*)(a.ws + WS_W2) + (size_t)mat * 1024 * 1024 + (size_t)(nb * 64) * 1024 + kb * 64; t.N = 1024; }
    return t;
}
constexpr int P0_NWIN = 16 * 80, P0_NWOUT = 16 * 16, P0_NWGLU = 16 * 32, P0_NITEMS = P0_NWIN + P0_NWOUT + P0_NWGLU + 32 * 512 + 32 * 256;
__device__ __forceinline__ TrItem p0_item(const Args& a, int r) {
    TrItem t;
    if (r < P0_NWIN) { const int kb = r / 80, nb = r % 80; t.src = a.in[I_HGWIN] + (size_t)(kb * 64) * 5120 + nb * 64; t.dst = (bf16_t*)(a.ws + WS_WIN) + (size_t)(nb * 64) * 1024 + kb * 64; t.N = 5120; return t; } r -= P0_NWIN;
    if (r < P0_NWOUT) { const int kb = r / 16, nb = r % 16; t.src = a.in[I_HGWOUT] + (size_t)(kb * 64) * 1024 + nb * 64; t.dst = (bf16_t*)(a.ws + WS_WOUT) + (size_t)(nb * 64) * 1024 + kb * 64; t.N = 1024; return t; } r -= P0_NWOUT;
    if (r < P0_NWGLU) { const int kb = r / 32, nb = r % 32; t.src = a.in[I_S5WGLU] + (size_t)(kb * 64) * 2048 + nb * 64; t.dst = (bf16_t*)(a.ws + WS_WGLU) + (size_t)ilv_row(nb * 64) * 1024 + kb * 64; t.N = 2048; return t; } r -= P0_NWGLU;
    return moe_item(a, r, 0);
}
#define TR_LOOP(first, stride, count, ITEM) do { int _it = (first); if (_it < (count)) { f32x4 _va[16], _vb[16]; TrItem _A = ITEM(_it), _B = _A; tr_load(_A, _va, lane); \
        for (;;) { const int _i2 = _it + (stride); const bool _h2 = _i2 < (count); if (_h2) { _B = ITEM(_i2); tr_load(_B, _vb, lane); } tr_finish(_A, _va, scr, lane); if (!_h2) break; \
                   _it = _i2 + (stride); const bool _h1 = _it < (count); if (_h1) { _A = ITEM(_it); tr_load(_A, _va, lane); } tr_finish(_B, _vb, scr, lane); if (!_h1) break; } } } while (0)
__device__ __forceinline__ void p0_phase(const Args& a, LAS unsigned char* lds, int tid, int gw, int NGW) {
    const int lane = tid & 63, wave = tid >> 6;
    unsigned char* ws = a.ws;
    float* modv = (float*)(ws + WS_MODV);
    if (blockIdx.x < 192) {
        LAS float* SC = (LAS float*)lds;
        LAS float* PART = (LAS float*)(lds + 40960);
        for (int i = tid; i < 9 * 1024; i += NTHREADS) { const int r = i >> 10, k = i & 1023; const float v = r < 8 ? a.in[I_C][r * 1024 + k] : a.in[I_CCTX][k]; SC[i] = silu_f(v); }
        __syncthreads();
        const int layer = blockIdx.x / 96, ng = blockIdx.x % 96;
        const float* W = a.in[I_MODW] + (size_t)layer * 1024 * 6144 + ng * 64 + lane;
        float acc[9];
#pragma unroll
        for (int r = 0; r < 9; ++r) acc[r] = 0.f;
#pragma unroll 8
        for (int kk = 0; kk < 128; ++kk) {
            const int k = wave * 128 + kk; const float w = W[(size_t)k * 6144];
#pragma unroll
            for (int r = 0; r < 9; ++r) acc[r] += SC[r * 1024 + k] * w;
        }
#pragma unroll
        for (int r = 0; r < 9; ++r) PART[(wave * 9 + r) * 64 + lane] = acc[r];
        __syncthreads();
        for (int i = tid; i < 9 * 64; i += NTHREADS) {
            const int r = i >> 6, l = i & 63; float s = a.in[I_MODB][layer * 6144 + ng * 64 + l];
#pragma unroll
            for (int w = 0; w < 8; ++w) s += PART[(w * 9 + r) * 64 + l];
            modv[(size_t)(layer * 9 + r) * 6144 + ng * 64 + l] = s;
        }
        __syncthreads();
    } else if (blockIdx.x == 192) {
        float* lbv = (float*)(ws + WS_LBV);
        for (int i = tid; i < 2048; i += NTHREADS) { const float l0 = a.in[I_HGLB][i], l1 = a.in[I_HGLB][2048 + i]; lbv[i] = 1.0f / (1.0f + __expf(l1 - l0)); }
    }
    LAS unsigned* scr = (LAS unsigned*)(lds + 59392 + wave * 8320);
#define P0_ITEM(i) p0_item(a, (i))
    TR_LOOP(gw, NGW, P0_NITEMS, P0_ITEM);
#undef P0_ITEM
}

__device__ __forceinline__ const float* hin_row(const Args& a, int row) { return row < NCTX ? a.in[I_CTX] + (size_t)row * D : a.in[I_X] + (size_t)(row - NCTX) * D; }
__device__ __forceinline__ int mod_row(int row) { return row < NCTX ? 8 : ((row - NCTX) >> 12); }
__device__ __forceinline__ float row_rstd(const f32x4 (&v)[4]) {
    float s = 0.f;
#pragma unroll
    for (int j = 0; j < 4; ++j) s += (v[j][0] * v[j][0] + v[j][1] * v[j][1]) + (v[j][2] * v[j][2] + v[j][3] * v[j][3]);
    return 1.0f / sqrtf(wave_sum(s) * (1.0f / D) + EPS);
}
__device__ __forceinline__ void norm_mod_store(const f32x4 (&v)[4], float rstd, const float* g, const float* sc, const float* sh, bf16_t* orow, int lane) {
#pragma unroll
    for (int j = 0; j < 4; ++j) {
        const int c = 4 * lane + 256 * j; const f32x4 gv = *(const f32x4*)(g + c), scv = *(const f32x4*)(sc + c), shv = *(const f32x4*)(sh + c);
        st_bf16x4(orow + c, v[j] * rstd * gv * (scv + 1.0f) + shv);
    }
}

__device__ __forceinline__ void p1_phase(const Args& a, int lane, int gw, int NGW) {
    const float* modv = (const float*)(a.ws + WS_MODV);
    bf16_t* A = (bf16_t*)(a.ws + WS_A);
    for (int row0 = gw * 4; row0 < NTOK; row0 += NGW * 4) {
        f32x4 v[4][4];
#pragma unroll
        for (int r = 0; r < 4; ++r) { const float* hr = hin_row(a, row0 + r);
#pragma unroll
            for (int j = 0; j < 4; ++j) v[r][j] = *(const f32x4*)(hr + 4 * lane + 256 * j); }
        const float* mv = modv + (size_t)mod_row(row0) * 6144;
#pragma unroll
        for (int r = 0; r < 4; ++r) { const float rstd = row_rstd(v[r]); norm_mod_store(v[r], rstd, a.in[I_N1G], mv + 1024, mv, A + (size_t)(row0 + r) * D, lane); }
    }
}

__device__ __forceinline__ int gla_row(int n, int t, int b, int dir) {
    const bool isctx = n < 4; const int cn = isctx ? n : n - 4, slen = isctx ? CTXL : SEQ, rbase = isctx ? b * CTXL : NCTX + b * SEQ;
    const int pos = cn * 64 + t; return rbase + (dir ? slen - 1 - pos : pos);
}
__device__ __forceinline__ void gla_phase(const Args& a, LAS unsigned char* lds, int tid) {
    const int lane = tid & 63, wave = tid >> 6, fr = lane & 15, fq = lane >> 4;
    LAS unsigned char* QS = lds;
    LAS unsigned char* KS = lds + 17408;
    LAS unsigned char* QIN = lds + 34816;
    LAS unsigned char* KOT = lds + 52224;
    LAS unsigned char* VT = lds + 70656;
    LAS unsigned char* ST0 = lds + 79872;
    LAS unsigned char* PPW = lds + 114688 + wave * 2304;
    LAS float* GT0 = (LAS float*)(lds + 133120);
    LAS float* BL = (LAS float*)(lds + 141312);
    const bf16_t* Qg = (const bf16_t*)(a.ws + WS_Q); const bf16_t* Vg = (const bf16_t*)(a.ws + WS_V);
    for (int item = blockIdx.x; item < 256; item += gridDim.x) {
        const int vs = item & 1, dir = (item >> 1) & 1, h = (item >> 2) & 7, b = item >> 5;
        const _Float16* LF = (const _Float16*)(a.ws + (dir ? WS_LFB : WS_LFF)); bf16_t* Og = (bf16_t*)(a.ws + (dir ? WS_OB : WS_OF));
        f32x4 Sacc[4];
#pragma unroll
        for (int i = 0; i < 4; ++i) Sacc[i] = (f32x4){0.f, 0.f, 0.f, 0.f};
        for (int i = tid; i < 2 * 17408 / 4; i += NTHREADS) ((LAS unsigned*)ST0)[i] = 0u;
        const int kc2 = (tid & 63) * 2, tg = tid >> 6, chq = h * 128 + kc2;
        const int vt_t = tid & 63, vt_v8 = (tid >> 6) * 8;
        unsigned lf2[8], q2[8]; u32x4 vv;
#define GLA_LOAD(n_) do { _Pragma("unroll") for (int i = 0; i < 8; ++i) { const size_t o = (size_t)gla_row(n_, tg * 8 + i, b, dir) * D + chq; lf2[i] = *(const unsigned*)(LF + o); q2[i] = *(const unsigned*)(Qg + o); } \
            vv = *(const u32x4*)(Vg + (size_t)gla_row(n_, vt_t, b, dir) * D + h * 128 + vs * 64 + vt_v8); } while (0)
        float fa[8], fb[8], bca[8], bcb[8];
#define GLA_CUMSUM(par_) do { float csa = 0.f, csb = 0.f; _Pragma("unroll") for (int i = 0; i < 8; ++i) { typedef _Float16 h2 __attribute__((ext_vector_type(2))); const h2 hv = __builtin_bit_cast(h2, lf2[i]); \
            const float la = (float)hv[0], lb_ = (float)hv[1]; fa[i] = __expf(la); fb[i] = __expf(lb_); csa += la; csb += lb_; bca[i] = csa; bcb[i] = csb; } \
            *(LAS f32x2*)(GT0 + (par_) * 1024 + tg * 128 + kc2) = (f32x2){csa, csb}; } while (0)
        GLA_LOAD(0);
        GLA_CUMSUM(0);
        __syncthreads();
        for (int n = 0; n < 68; ++n) {
            const int par = n & 1;
            LAS unsigned char* STc = ST0 + par * 17408; LAS unsigned char* STn = ST0 + (par ^ 1) * 17408;
            { const unsigned w[4] = {vv.x, vv.y, vv.z, vv.w};
#pragma unroll
              for (int i = 0; i < 4; ++i) { *(LAS bf16_t*)(VT + (vt_v8 + 2 * i) * 144 + vt_t * 2) = (bf16_t)(w[i] & 0xffffu); *(LAS bf16_t*)(VT + (vt_v8 + 2 * i + 1) * 144 + vt_t * 2) = (bf16_t)(w[i] >> 16); } }
#define GLA_OSTORE(n_) do { const u32x4 od = *(const LAS u32x4*)(PPW + (lane >> 2) * 144 + (lane & 3) * 16); \
                *(u32x4*)(Og + (size_t)gla_row(n_, (wave >> 1) * 16 + (lane >> 2), b, dir) * D + h * 128 + vs * 64 + (wave & 1) * 32 + (lane & 3) * 8) = od; } while (0)
            if (n > 0) GLA_OSTORE(n - 1);
            f32x2 pre = (f32x2){0.f, 0.f}, bref = (f32x2){0.f, 0.f}, blast = (f32x2){0.f, 0.f};
#pragma unroll
            for (int g8 = 0; g8 < 8; ++g8) { const f32x2 gv = *(const LAS f32x2*)(GT0 + par * 1024 + g8 * 128 + kc2); if (g8 < tg) pre += gv; if (g8 < 4) bref += gv; blast += gv; }
            const float era = __expf(bref.x), erb = __expf(bref.y), ela = __expf(blast.x - bref.x), elb = __expf(blast.y - bref.y);
            float e1a = __expf(pre.x - bref.x), e1b = __expf(pre.y - bref.y);
            unsigned kota[4], kotb[4];
#pragma unroll
            for (int i = 0; i < 8; ++i) {
                const int t = tg * 8 + i;
                const float qa = bflo(q2[i]), qb = bfhi(q2[i]);
                e1a *= fa[i]; e1b *= fb[i];
                const float ka = 1.0f - fa[i], kb = 1.0f - fb[i];
                const float e2a = __builtin_amdgcn_rcpf(e1a), e2b = __builtin_amdgcn_rcpf(e1b);
                const float qsa = qa * e1a, qsb = qb * e1b, ksa = ka * e2a, ksb = kb * e2b;
                *(LAS unsigned*)(QS + t * 272 + kc2 * 2) = cvt_pk_bf16(qsa, qsb);
                *(LAS unsigned*)(KS + t * 272 + kc2 * 2) = cvt_pk_bf16(ksa, ksb);
                *(LAS unsigned*)(QIN + t * 272 + kc2 * 2) = cvt_pk_bf16(qsa * era, qsb * erb);
                const unsigned ko = cvt_pk_bf16(ksa * ela, ksb * elb);
                if (i & 1) { kota[i >> 1] |= ko << 16; kotb[i >> 1] |= ko & 0xffff0000u; } else { kota[i >> 1] = ko & 0xffffu; kotb[i >> 1] = ko >> 16; }
            }
            { const int rot = ((kc2 >> 4) + tg) & 7;
              *(LAS u32x4*)(KOT + kc2 * 144 + rot * 16) = (u32x4){kota[0], kota[1], kota[2], kota[3]};
              *(LAS u32x4*)(KOT + (kc2 + 1) * 144 + rot * 16) = (u32x4){kotb[0], kotb[1], kotb[2], kotb[3]}; }
            if (tg == 0) *(LAS f32x2*)(BL + kc2) = (f32x2){__expf(blast.x), __expf(blast.y)};
            if (n + 1 < 68) GLA_LOAD(n + 1);
            __syncthreads();
            const int tt = wave >> 1;
            bf16x8 aq[4];
#pragma unroll
            for (int kk = 0; kk < 4; ++kk) aq[kk] = *(const LAS bf16x8*)(QS + (tt * 16 + fr) * 272 + (kk * 32 + fq * 8) * 2);
#pragma unroll
            for (int st = 0; st < 4; ++st) {
                f32x4 acc = (f32x4){0.f, 0.f, 0.f, 0.f};
                if (st <= tt) {
#pragma unroll
                    for (int kk = 0; kk < 4; ++kk) {
                        const bf16x8 bv = *(const LAS bf16x8*)(KS + (st * 16 + fr) * 272 + (kk * 32 + fq * 8) * 2);
                        acc = __builtin_amdgcn_mfma_f32_16x16x32_bf16(aq[kk], bv, acc, 0, 0, 0);
                    }
                }
#pragma unroll
                for (int j = 0; j < 4; ++j) { const int tl = fq * 4 + j, s = st * 16 + fr; *(LAS bf16_t*)(PPW + tl * 144 + s * 2) = (bf16_t)f2bf(s <= tt * 16 + tl ? acc[j] : 0.f); }
            }
            LDS_WAIT();
            unsigned ow[2][2];
            bf16x8 ap[2], ai[4];
#pragma unroll
            for (int kk = 0; kk < 2; ++kk) ap[kk] = *(const LAS bf16x8*)(PPW + fr * 144 + (kk * 32 + fq * 8) * 2);
#pragma unroll
            for (int kk = 0; kk < 4; ++kk) ai[kk] = *(const LAS bf16x8*)(QIN + (tt * 16 + fr) * 272 + (kk * 32 + fq * 8) * 2);
#pragma unroll
            for (int vti = 0; vti < 2; ++vti) {
                const int vt = 2 * (wave & 1) + vti; f32x4 acc = (f32x4){0.f, 0.f, 0.f, 0.f};
#pragma unroll
                for (int kk = 0; kk < 2; ++kk) {
                    const bf16x8 bv = *(const LAS bf16x8*)(VT + (vt * 16 + fr) * 144 + (kk * 32 + fq * 8) * 2);
                    acc = __builtin_amdgcn_mfma_f32_16x16x32_bf16(ap[kk], bv, acc, 0, 0, 0);
                }
#pragma unroll
                for (int kk = 0; kk < 4; ++kk) {
                    const bf16x8 bv = *(const LAS bf16x8*)(STc + (vt * 16 + fr) * 272 + (kk * 32 + fq * 8) * 2);
                    acc = __builtin_amdgcn_mfma_f32_16x16x32_bf16(ai[kk], bv, acc, 0, 0, 0);
                }
                ow[vti][0] = cvt_pk_bf16(acc[0], acc[1]); ow[vti][1] = cvt_pk_bf16(acc[2], acc[3]);
            }
#pragma unroll
            for (int vti = 0; vti < 2; ++vti)
#pragma unroll
                for (int j = 0; j < 4; ++j) { const unsigned w = ow[vti][j >> 1]; *(LAS bf16_t*)(PPW + (fq * 4 + j) * 144 + (vti * 16 + fr) * 2) = (bf16_t)((j & 1) ? (w >> 16) : (w & 0xffffu)); }
            bf16x8 ak[2]; const f32x4 blv = *(const LAS f32x4*)(BL + wave * 16 + fq * 4);
#pragma unroll
            for (int kk = 0; kk < 2; ++kk) ak[kk] = *(const LAS bf16x8*)(KOT + (wave * 16 + fr) * 144 + (((kk * 4 + fq) + wave) & 7) * 16);
#pragma unroll
            for (int vt = 0; vt < 4; ++vt) {
                Sacc[vt] *= blv;
#pragma unroll
                for (int kk = 0; kk < 2; ++kk) {
                    const bf16x8 bv = *(const LAS bf16x8*)(VT + (vt * 16 + fr) * 144 + (kk * 32 + fq * 8) * 2);
                    Sacc[vt] = __builtin_amdgcn_mfma_f32_16x16x32_bf16(ak[kk], bv, Sacc[vt], 0, 0, 0);
                }
                *(LAS u32x2*)(STn + (vt * 16 + fr) * 272 + (wave * 16 + fq * 4) * 2) = (u32x2){pk2(Sacc[vt][0], Sacc[vt][1]), pk2(Sacc[vt][2], Sacc[vt][3])};
            }
            if (n + 1 < 68) GLA_CUMSUM(par ^ 1);
            __syncthreads();
        }
        GLA_OSTORE(67);
    }
}
#undef GLA_OSTORE
#undef GLA_CUMSUM
#undef GLA_LOAD
__device__ __forceinline__ void gla_readout_phase(const Args& a, int lane, int gw, int NGW) {
    const bf16_t* OF = (const bf16_t*)(a.ws + WS_OF); const bf16_t* OB = (const bf16_t*)(a.ws + WS_OB);
    const bf16_t* G = (const bf16_t*)(a.ws + WS_G); bf16_t* OG = (bf16_t*)(a.ws + WS_OG);
    f32x4 ng[4];
#pragma unroll
    for (int j = 0; j < 4; ++j) ng[j] = *(const f32x4*)(a.in[I_HGNG] + 16 * lane + 4 * j);
    for (int row0 = gw * 4; row0 < NTOK; row0 += NGW * 4) {
        u32x4 of[4][2], ob[4][2], gg[4][2];
#pragma unroll
        for (int r = 0; r < 4; ++r) { const size_t o = (size_t)(row0 + r) * D + 16 * lane;
            of[r][0] = *(const u32x4*)(OF + o); of[r][1] = *(const u32x4*)(OF + o + 8); ob[r][0] = *(const u32x4*)(OB + o); ob[r][1] = *(const u32x4*)(OB + o + 8);
            gg[r][0] = *(const u32x4*)(G + o); gg[r][1] = *(const u32x4*)(G + o + 8); }
#pragma unroll
        for (int r = 0; r < 4; ++r) {
            float v[16]; float s = 0.f;
#pragma unroll
            for (int q = 0; q < 8; ++q) { const unsigned wf = of[r][q >> 2][q & 3], wb = ob[r][q >> 2][q & 3]; v[2 * q] = bflo(wf) + bflo(wb); v[2 * q + 1] = bfhi(wf) + bfhi(wb); s += v[2 * q] * v[2 * q] + v[2 * q + 1] * v[2 * q + 1]; }
            s += __shfl_xor(s, 1); s += __shfl_xor(s, 2); s += __shfl_xor(s, 4);
            const float rstd = 1.0f / sqrtf(s * (1.0f / 128.0f) + EPS);
            unsigned ow[8];
#pragma unroll
            for (int q = 0; q < 8; ++q) { const unsigned wg = gg[r][q >> 2][q & 3];
                ow[q] = pk2(v[2 * q] * rstd * ng[q >> 1][(2 * q) & 3] * silu_f(bflo(wg)), v[2 * q + 1] * rstd * ng[q >> 1][(2 * q + 1) & 3] * silu_f(bfhi(wg))); }
            const size_t o = (size_t)(row0 + r) * D + 16 * lane;
            *(u32x4*)(OG + o) = (u32x4){ow[0], ow[1], ow[2], ow[3]}; *(u32x4*)(OG + o + 8) = (u32x4){ow[4], ow[5], ow[6], ow[7]};
        }
    }
}

struct EpiMoe1 {
    static constexpr bool PERM = true;
    const float* b1; bf16_t* ACT;
    __device__ __forceinline__ void operator()(const f32x4 (&acc)[2][2][4][2], const Unit& u, int wr, int wc, int fr, int fq) const {
        const int e = u.pn >> 3, pnl = u.pn & 7, cb = pnl * 128 + wc * 32 + 8 * fq, row0 = u.pm * 256 + wr * 64 + fr;
        const float* bg = b1 + (size_t)e * 2048;
        const f32x4 bg0 = *(const f32x4*)(bg + cb), bg1 = *(const f32x4*)(bg + cb + 4), bl0 = *(const f32x4*)(bg + 1024 + cb), bl1 = *(const f32x4*)(bg + 1024 + cb + 4);
#pragma unroll
        for (int ai = 0; ai < 2; ++ai)
#pragma unroll
            for (int m = 0; m < 4; ++m) {
                f32x4 o[2];
#pragma unroll
                for (int n = 0; n < 2; ++n) {
                    const f32x4 zg = acc[ai][0][m][n] + (n ? bg1 : bg0), zl = acc[ai][1][m][n] + (n ? bl1 : bl0);
#pragma unroll
                    for (int j = 0; j < 4; ++j) { const float g_ = fminf(zg[j], 7.0f), l_ = fminf(fmaxf(zl[j], -7.0f), 7.0f); o[n][j] = g_ * sigmoid_f(1.702f * g_) * (l_ + 1.0f); }
                }
                *(u32x4*)(ACT + (size_t)(row0 + ai * 128 + m * 16) * D + cb) = (u32x4){pk2(o[0][0], o[0][1]), pk2(o[0][2], o[0][3]), pk2(o[1][0], o[1][1]), pk2(o[1][2], o[1][3])};
            }
    }
};
struct EpiMoe2 {
    static constexpr bool PERM = true;
    const float* b2; bf16_t* YS;
    __device__ __forceinline__ void operator()(const f32x4 (&acc)[2][2][4][2], const Unit& u, int wr, int wc, int fr, int fq) const {
        const int e = u.pn >> 2, pnl = u.pn & 3, cb = pnl * 256 + wc * 32 + 8 * fq, row0 = u.pm * 256 + wr * 64 + fr;
        const float* bb = b2 + (size_t)e * 1024;
#pragma unroll
        for (int bj = 0; bj < 2; ++bj) {
            const int c = cb + bj * 128; const f32x4 bv0 = *(const f32x4*)(bb + c), bv1 = *(const f32x4*)(bb + c + 4);
#pragma unroll
            for (int ai = 0; ai < 2; ++ai)
#pragma unroll
                for (int m = 0; m < 4; ++m) {
                    const f32x4 v0 = acc[ai][bj][m][0] + bv0, v1 = acc[ai][bj][m][1] + bv1;
                    *(u32x4*)(YS + (size_t)(row0 + ai * 128 + m * 16) * D + c) = (u32x4){pk2(v0[0], v0[1]), pk2(v0[2], v0[3]), pk2(v1[0], v1[1]), pk2(v1[2], v1[3])};
                }
        }
    }
};

__device__ __forceinline__ void router_phase(const Args& a, LAS unsigned char* lds, int layer, int row_lo, int tid) {
    const int lane = tid & 63, wave = tid >> 6, fr = lane & 15, fq = lane >> 4;
    const bf16_t* H = (const bf16_t*)(a.ws + WS_H); bf16_t* F = (bf16_t*)(a.ws + WS_F);
    const float* modv = (const float*)(a.ws + WS_MODV) + (size_t)layer * 9 * 6144;
    int* TOKE = (int*)(a.ws + WS_TOKE); float* TOKW = (float*)(a.ws + WS_TOKW);
    unsigned* cntb = (unsigned*)(a.ws + WS_CTL) + CW_CNTB + layer * 8192;
    LAS float* FS = (LAS float*)lds;
    LAS float* PART = (LAS float*)(lds + 16 * 1028 * 4);
    LAS int* hist = (LAS int*)(lds + 16 * 1028 * 4 + 16384);
    if (tid < 32) hist[tid] = 0;
    const float* n2g = a.in[I_N2G] + layer * D; const float* rw = a.in[I_RW] + (size_t)layer * D * NE; const float* rb = a.in[I_RB] + layer * NE;
    float rwr[2][32];
#pragma unroll
    for (int s = 0; s < 32; ++s) { rwr[0][s] = rw[(size_t)(wave * 128 + 4 * s + fq) * NE + fr]; rwr[1][s] = rw[(size_t)(wave * 128 + 4 * s + fq) * NE + 16 + fr]; }
    const int ngroups = (NTOK - row_lo) >> 4;
    f32x4 vv[2][4];
#define RT_LOAD(gi_) do { _Pragma("unroll") for (int rr = 0; rr < 2; ++rr) _Pragma("unroll") for (int j = 0; j < 4; ++j) \
        vv[rr][j] = ld_bf16x4(H + (size_t)(row_lo + (gi_) * 16 + 2 * wave + rr) * D + 4 * lane + 256 * j); } while (0)
    if ((int)blockIdx.x < ngroups) RT_LOAD(blockIdx.x);
    for (int gi = blockIdx.x; gi < ngroups; gi += gridDim.x) {
        const int row0 = row_lo + gi * 16;
        __syncthreads();
#pragma unroll
        for (int rr = 0; rr < 2; ++rr) {
            const int rl = 2 * wave + rr, row = row0 + rl; const f32x4 (&v)[4] = vv[rr];
            const float rstd = row_rstd(v); const float* mv = modv + (size_t)mod_row(row) * 6144;
#pragma unroll
            for (int j = 0; j < 4; ++j) {
                const int c = 4 * lane + 256 * j; const f32x4 gv = *(const f32x4*)(n2g + c), scv = *(const f32x4*)(mv + 4096 + c), shv = *(const f32x4*)(mv + 3072 + c);
                const f32x4 f = v[j] * rstd * gv * (scv + 1.0f) + shv;
                st_bf16x4(F + (size_t)row * D + c, f);
                *(LAS f32x4*)(FS + rl * 1028 + c) = f;
            }
        }
        if (gi + (int)gridDim.x < ngroups) RT_LOAD(gi + gridDim.x);
        __syncthreads();
        f32x4 acc0 = (f32x4){0.f, 0.f, 0.f, 0.f}, acc1 = (f32x4){0.f, 0.f, 0.f, 0.f};
#pragma unroll
        for (int s = 0; s < 32; ++s) {
            const float av = FS[fr * 1028 + wave * 128 + 4 * s + fq];
            acc0 = __builtin_amdgcn_mfma_f32_16x16x4f32(av, rwr[0][s], acc0, 0, 0, 0);
            acc1 = __builtin_amdgcn_mfma_f32_16x16x4f32(av, rwr[1][s], acc1, 0, 0, 0);
        }
#pragma unroll
        for (int j = 0; j < 4; ++j) { PART[(wave * 16 + fq * 4 + j) * 32 + fr] = acc0[j]; PART[(wave * 16 + fq * 4 + j) * 32 + 16 + fr] = acc1[j]; }
        __syncthreads();
        {
            const int half = lane >> 5, e = lane & 31, rl = 2 * wave + half, row = row0 + rl;
            float lg = rb[e];
#pragma unroll
            for (int w = 0; w < 8; ++w) lg += PART[(w * 16 + rl) * 32 + e];
            float sv[4]; int si[4];
#pragma unroll
            for (int r = 0; r < 4; ++r) {
                float m = lg;
#pragma unroll
                for (int o = 1; o < 32; o <<= 1) m = fmaxf(m, __shfl_xor(m, o));
                const unsigned long long bal = __ballot(lg == m); const unsigned mine = (unsigned)(bal >> (32 * half));
                const int idx = __ffs((int)mine) - 1;
                sv[r] = m; si[r] = idx; if (e == idx) lg = -3.0e38f;
            }
            const float e1 = __expf(sv[1] - sv[0]), e2 = __expf(sv[2] - sv[0]), e3 = __expf(sv[3] - sv[0]); const float inv = 1.0f / (1.0f + e1 + e2 + e3);
            if (e < 4) {
                const int myi = e == 0 ? si[0] : (e == 1 ? si[1] : (e == 2 ? si[2] : si[3]));
                const float myw = (e == 0 ? 1.0f : (e == 1 ? e1 : (e == 2 ? e2 : e3))) * inv;
                TOKE[(size_t)row * 4 + e] = myi; TOKW[(size_t)row * 4 + e] = myw;
                atomicAdd((int*)hist + myi, 1);
            }
        }
    }
    __syncthreads();
    if (tid < 32) cntb[(size_t)blockIdx.x * 32 + tid] = (unsigned)hist[tid];
}
#undef RT_LOAD
__device__ __forceinline__ void assign_phase(const Args& a, LAS unsigned char* lds, int layer, int row_lo, int tid) {
    const int lane = tid & 63, wave = tid >> 6;
    const unsigned* cntb = (const unsigned*)(a.ws + WS_CTL) + CW_CNTB + layer * 8192; unsigned* gcnt = (unsigned*)(a.ws + WS_CTL) + CW_CNT + layer * 64;
    const bf16_t* F = (const bf16_t*)(a.ws + WS_F); bf16_t* AG = (bf16_t*)(a.ws + WS_AG);
    const int* TOKE = (const int*)(a.ws + WS_TOKE); int* TOKS = (int*)(a.ws + WS_TOKS);
    LAS int* off = (LAS int*)lds; LAS int* cnt = (LAS int*)(lds + 256); LAS int* base = (LAS int*)(lds + 512); LAS int* cur = (LAS int*)(lds + 768);
    LAS int* pa = (LAS int*)(lds + 1024); LAS int* pl = (LAS int*)(lds + 1024 + 2048);
    {
        const int e = tid & 31, part = tid >> 5; int s_all = 0, s_lt = 0;
        for (int bb = part; bb < (int)gridDim.x; bb += 16) { const int c = (int)cntb[(size_t)bb * 32 + e]; s_all += c; if (bb < (int)blockIdx.x) s_lt += c; }
        pa[part * 32 + e] = s_all; pl[part * 32 + e] = s_lt;
    }
    __syncthreads();
    if (tid < 32) { int s_all = 0, s_lt = 0; for (int p = 0; p < 16; ++p) { s_all += pa[p * 32 + tid]; s_lt += pl[p * 32 + tid]; } cnt[tid] = s_all; base[tid] = s_lt; cur[tid] = 0; if (blockIdx.x == 0) gcnt[tid] = (unsigned)s_all; }
    __syncthreads();
    if (tid == 0) { int o = 0; for (int e = 0; e < 32; ++e) { off[e] = o; o += ((cnt[e] + 255) >> 8) << 8; } }
    __syncthreads();
    if (tid < 32) base[tid] += off[tid];
    __syncthreads();
    const int gw = blockIdx.x * 8 + wave, NGW = gridDim.x * 8;
    int* SLOTTOK = (int*)(a.ws + WS_SLOTTOK);
    for (int idx = blockIdx.x * NTHREADS + tid; idx < 32 * 256; idx += gridDim.x * NTHREADS) {
        const int e = idx >> 8, c = cnt[e], r = c + (idx & 255), padded = ((c + 255) >> 8) << 8;
        if (r < padded) SLOTTOK[off[e] + r] = 0;
    }
    const int ngroups = (NTOK - row_lo) >> 4;
    for (int gi = blockIdx.x; gi < ngroups; gi += gridDim.x) {
        const int r0 = row_lo + gi * 16 + 2 * wave;
        if (lane < 8) { const int e = TOKE[(size_t)r0 * 4 + lane]; const int pos = atomicAdd((int*)cur + e, 1); const int slot = base[e] + pos; TOKS[(size_t)r0 * 4 + lane] = slot; SLOTTOK[slot] = r0 + (lane >> 2); }
    }
    (void)gw; (void)NGW; (void)F; (void)AG;
}
__device__ __forceinline__ int moe_tiles(const Args& a, LAS unsigned char* lds, int layer, int tid) {
    const unsigned* gcnt = (const unsigned*)(a.ws + WS_CTL) + CW_CNT + layer * 64;
    LAS int* tbl = (LAS int*)(lds + 131072 + 1024);
    if (tid == 0) { int t = 0; for (int e = 0; e < 32; ++e) { const int nt = ((int)gcnt[e] + 255) >> 8; for (int k = 0; k < nt; ++k) tbl[t++] = e; } tbl[1000] = t; }
    __syncthreads();
    return tbl[1000];
}
__device__ __forceinline__ void combine_phase(const Args& a, int layer, int row_lo, int lane, int gw, int NGW) {
    bf16_t* H = (bf16_t*)(a.ws + WS_H); const bf16_t* YS = (const bf16_t*)(a.ws + WS_YS);
    const int* TOKS = (const int*)(a.ws + WS_TOKS); const float* TOKW = (const float*)(a.ws + WS_TOKW);
    const float* modv = (const float*)(a.ws + WS_MODV);
    for (int row0 = row_lo + gw * 2; row0 < NTOK; row0 += NGW * 2) {
        const int mr = mod_row(row0);
        u32x4 sl[2]; f32x4 wv[2];
#pragma unroll
        for (int r = 0; r < 2; ++r) { sl[r] = *(const u32x4*)(TOKS + (size_t)(row0 + r) * 4); wv[r] = *(const f32x4*)(TOKW + (size_t)(row0 + r) * 4); }
        u32x2 ys[2][4][4]; f32x4 hv[2][4];
#pragma unroll
        for (int r = 0; r < 2; ++r)
#pragma unroll
            for (int j = 0; j < 4; ++j) {
                hv[r][j] = ld_bf16x4(H + (size_t)(row0 + r) * D + 4 * lane + 256 * j);
#pragma unroll
                for (int k = 0; k < 4; ++k) ys[r][k][j] = *(const u32x2*)(YS + (size_t)sl[r][k] * D + 4 * lane + 256 * j);
            }
        const float* g2 = modv + (size_t)(layer * 9 + mr) * 6144 + 5120;
#pragma unroll
        for (int r = 0; r < 2; ++r) {
            const int row = row0 + r; f32x4 v[4];
#pragma unroll
            for (int j = 0; j < 4; ++j) {
                const int c = 4 * lane + 256 * j; f32x4 y = (f32x4){0.f, 0.f, 0.f, 0.f};
#pragma unroll
                for (int k = 0; k < 4; ++k) { const u32x2 w = ys[r][k][j]; y += (f32x4){bflo(w.x), bfhi(w.x), bflo(w.y), bfhi(w.y)} * wv[r][k]; }
                v[j] = hv[r][j] + *(const f32x4*)(g2 + c) * y;
                if (layer == 0) st_bf16x4(H + (size_t)row * D + c, v[j]);
            }
            const float rstd = row_rstd(v);
            if (layer == 0) {
                const float* mv = modv + (size_t)(9 + mr) * 6144;
                int orow = row;
                if (row >= NCTX) { const int li = row - NCTX, b = li >> 12, t = li & 4095; orow = NCTX + b * SEQ + (t & 63) * 64 + (t >> 6); }
                norm_mod_store(v, rstd, a.in[I_N1G] + D, mv + 1024, mv, (bf16_t*)(a.ws + WS_A) + (size_t)orow * D, lane);
            } else {
#pragma unroll
                for (int j = 0; j < 4; ++j) { const int c = 4 * lane + 256 * j; *(f32x4*)(a.out + (size_t)(row - NCTX) * D + c) = v[j] * rstd * *(const f32x4*)(a.in[I_FG] + c); }
            }
        }
    }
}
__device__ __forceinline__ void moe_gemm1(const Args& a, LAS unsigned char* lds, int layer, int tid, int G, int vcu) {
    unsigned char* ws = a.ws;
    const int TT = moe_tiles(a, lds, layer, tid);
    const LAS int* tbl = (const LAS int*)(lds + 131072 + 1024);
    pg8::Gemm g{(const bf16_t*)(ws + WS_F), (const bf16_t*)(ws + WS_W1) + (size_t)layer * 32 * 2048 * 1024, MPAD, 32 * 2048, 1024};
    pg8::MoeOrder S{tbl, TT, 3, G, vcu};
    EpiMoe1 E{a.in[I_B1] + (size_t)layer * 32 * 2048, (bf16_t*)(ws + WS_ACT)};
    pg8::gemm_phase<EpiMoe1, pg8::MoeOrder, true>(lds, g, S, E, (const int*)(ws + WS_SLOTTOK));
}
__device__ __forceinline__ void moe_gemm2(const Args& a, LAS unsigned char* lds, int layer, int tid, int G, int vcu) {
    unsigned char* ws = a.ws;
    const int TT = moe_tiles(a, lds, layer, tid);
    const LAS int* tbl = (const LAS int*)(lds + 131072 + 1024);
    pg8::Gemm g{(const bf16_t*)(ws + WS_ACT), (const bf16_t*)(ws + WS_W2) + (size_t)layer * 32 * 1024 * 1024, MPAD, 32 * 1024, 1024};
    pg8::MoeOrder S{tbl, TT, 2, G, vcu};
    EpiMoe2 E{a.in[I_B2] + (size_t)layer * 32 * 1024, (bf16_t*)(ws + WS_YS)};
    pg8::gemm_phase<EpiMoe2, pg8::MoeOrder>(lds, g, S, E);
}


__device__ __forceinline__ void s5_disc(const Args& a, int d, int g, int p, float& ab_re, float& ab_im, float& co_re, float& co_im) {
    const float lam_re = fminf(a.in[I_S5ARE][(d * 64 + g) * 64 + p], -1e-4f), lam_im = a.in[I_S5AIM][(d * 64 + g) * 64 + p];
    const float dt = expf(a.in[I_S5LDT][d * 64 + g]);
    const float mag = expf(lam_re * dt), ang = lam_im * dt;
    ab_re = mag * cosf(ang); ab_im = mag * sinf(ang);
    const float den = lam_re * lam_re + lam_im * lam_im;
    co_re = ((ab_re - 1.0f) * lam_re + ab_im * lam_im) / den;
    co_im = (ab_im * lam_re - (ab_re - 1.0f) * lam_im) / den;
}
__device__ __forceinline__ void s5_phase(const Args& a, LAS unsigned char* lds, int tid) {
    const int lane = tid & 63, wave = tid >> 6, fr = lane & 15, fq = lane >> 4;
    if (wave >= 4) {
        LAS unsigned* scr = (LAS unsigned*)(lds + 102400 + (wave - 4) * 8320);
        const int cw = blockIdx.x * 4 + (wave - 4), NCW = gridDim.x * 4;
#define L1_ITEM(i) moe_item(a, (i), 1)
        TR_LOOP(cw, NCW, 32 * 512 + 32 * 256, L1_ITEM);
#undef L1_ITEM
        return;
    }
    LAS unsigned char* wl = lds + wave * 25600;
    const bf16_t* A1 = (const bf16_t*)(a.ws + WS_A);
    for (int item = blockIdx.x; item < 256; item += gridDim.x) {
        const int b = item >> 5, dir = (item >> 4) & 1, g = (item & 15) * 4 + wave;
        bf16_t* Y = (bf16_t*)(a.ws + (dir ? WS_YB : WS_YF));
        float ab_re, ab_im, cr_, ci_;
        s5_disc(a, dir, g, lane, ab_re, ab_im, cr_, ci_);
        bf16x8 Bd[8], Cf[4];
        {
            f32x4 cre[4], cim[4];
#pragma unroll
            for (int kk = 0; kk < 4; ++kk) { const size_t o = ((size_t)(dir * 64 + g) * 16 + fr) * 64 + kk * 16 + fq * 4; cre[kk] = *(const f32x4*)(a.in[I_S5CRE] + o); cim[kk] = *(const f32x4*)(a.in[I_S5CIM] + o); }
#pragma unroll
            for (int kk = 0; kk < 4; ++kk)
#pragma unroll
                for (int j = 0; j < 8; ++j) Cf[kk][j] = (short)f2bf((j & 1) ? -cim[kk][j >> 1] : cre[kk][j >> 1]);
#pragma unroll
            for (int hg = 0; hg < 2; ++hg) {
                f32x4 br0[4], br1[4], bi0[4], bi1[4];
#pragma unroll
                for (int q = 0; q < 4; ++q) {
                    const int pp = (hg * 4 + q) * 8 + (fr >> 1); const size_t o = (size_t)(g * 64 + pp) * 16 + (fq & 1) * 8;
                    br0[q] = *(const f32x4*)(a.in[I_S5BRE] + o); br1[q] = *(const f32x4*)(a.in[I_S5BRE] + o + 4); bi0[q] = *(const f32x4*)(a.in[I_S5BIM] + o); bi1[q] = *(const f32x4*)(a.in[I_S5BIM] + o + 4);
                }
#pragma unroll
                for (int q = 0; q < 4; ++q) {
                    const int pt = hg * 4 + q, pp = pt * 8 + (fr >> 1); const float qr = __shfl(cr_, pp), qi = __shfl(ci_, pp);
#pragma unroll
                    for (int j = 0; j < 8; ++j) {
                        const float br = j < 4 ? br0[q][j & 3] : br1[q][j & 3], bi = j < 4 ? bi0[q][j & 3] : bi1[q][j & 3];
                        float v = (fr & 1) ? (qr * bi + qi * br) : (qr * br - qi * bi);
                        if (fq >= 2) v = 0.f;
                        Bd[pt][j] = (short)f2bf(v);
                    }
                }
                asm volatile("" ::: "memory");
            }
        }
#define S5_POS(n_, t_) ((((n_) < 8) ? (n_) : (n_) - 8) * 32 + (t_))
#define S5_ROW(n_, t_) ((((n_) < 8) ? b * CTXL : NCTX + b * SEQ) + (dir ? (((n_) < 8) ? CTXL : SEQ) - 1 - S5_POS(n_, t_) : S5_POS(n_, t_)))
#define S5_LOADU(d0, d1, n_) do { d0 = (bf16x8){0, 0, 0, 0, 0, 0, 0, 0}; d1 = d0; if (fq < 2 && (n_) < 136) { d0 = *(const bf16x8*)(A1 + (size_t)S5_ROW(n_, fr) * D + g * 16 + fq * 8); d1 = *(const bf16x8*)(A1 + (size_t)S5_ROW(n_, 16 + fr) * D + g * 16 + fq * 8); } } while (0)
        LAS float* BUF = (LAS float*)wl; LAS unsigned* HW = (LAS unsigned*)(wl + 16896); const LAS unsigned char* HP = wl + 16896;
        bf16x8 ua0, ua1, ub0, ub1;
        S5_LOADU(ua0, ua1, 0);
        f32x2 s = (f32x2){0.f, 0.f};
        const f32x2 abr = (f32x2){ab_re, ab_re}, abi = (f32x2){-ab_im, ab_im};
        bf16_t* yp = Y + (size_t)(b * SEQ + (dir ? SEQ - 1 - fq * 4 : fq * 4)) * D + g * 16 + fr;
        const long ystep = dir ? -(long)D : (long)D;
        unsigned yw[4] = {0u, 0u, 0u, 0u};
#define S5_YSTORE() do { yp[0] = (bf16_t)(yw[0] & 0xffffu); yp[ystep] = (bf16_t)(yw[0] >> 16); yp[2 * ystep] = (bf16_t)(yw[1] & 0xffffu); yp[3 * ystep] = (bf16_t)(yw[1] >> 16); \
            yp[16 * ystep] = (bf16_t)(yw[2] & 0xffffu); yp[17 * ystep] = (bf16_t)(yw[2] >> 16); yp[18 * ystep] = (bf16_t)(yw[3] & 0xffffu); yp[19 * ystep] = (bf16_t)(yw[3] >> 16); yp += 32 * ystep; } while (0)
        for (int n = 0; n < 136; ++n) {
#pragma unroll
            for (int hf = 0; hf < 2; ++hf)
#pragma unroll
                for (int pt = 0; pt < 8; ++pt) {
                    const f32x4 z = (f32x4){0.f, 0.f, 0.f, 0.f};
                    const f32x4 d = __builtin_amdgcn_mfma_f32_16x16x32_bf16(hf ? ua1 : ua0, Bd[pt], z, 0, 0, 0);
#pragma unroll
                    for (int j = 0; j < 4; ++j) BUF[(hf * 16 + fq * 4 + j) * 132 + pt * 16 + fr] = d[j];
                }
            if (n >= 9) S5_YSTORE();
            S5_LOADU(ub0, ub1, n + 1);
            LDS_WAIT();
            {
                const bool hist = n >= 8;
                f32x2 bu[32];
#pragma unroll
                for (int j = 0; j < 32; ++j) bu[j] = *(const LAS f32x2*)(BUF + j * 132 + 2 * lane);
                unsigned hw[32];
#pragma unroll
                for (int j = 0; j < 32; ++j) { const f32x2 t1 = abr * s + bu[j]; s = abi * (f32x2){s.y, s.x} + t1; hw[j] = cvt_pk_bf16(s.x, s.y); }
                if (hist) {
#pragma unroll
                    for (int j = 0; j < 32; ++j) HW[j * 68 + lane] = hw[j];
                }
            }
            LDS_WAIT();
            if (n >= 8) {
                f32x4 y0 = (f32x4){0.f, 0.f, 0.f, 0.f}, y1 = (f32x4){0.f, 0.f, 0.f, 0.f};
                bf16x8 ha[2][4];
#pragma unroll
                for (int hf = 0; hf < 2; ++hf)
#pragma unroll
                    for (int kk = 0; kk < 4; ++kk) ha[hf][kk] = *(const LAS bf16x8*)(HP + (hf * 16 + fr) * 272 + (kk * 32 + fq * 8) * 2);
#pragma unroll
                for (int kk = 0; kk < 4; ++kk) { y0 = __builtin_amdgcn_mfma_f32_16x16x32_bf16(ha[0][kk], Cf[kk], y0, 0, 0, 0); y1 = __builtin_amdgcn_mfma_f32_16x16x32_bf16(ha[1][kk], Cf[kk], y1, 0, 0, 0); }
                yw[0] = cvt_pk_bf16(y0[0], y0[1]); yw[1] = cvt_pk_bf16(y0[2], y0[3]); yw[2] = cvt_pk_bf16(y1[0], y1[1]); yw[3] = cvt_pk_bf16(y1[2], y1[3]);
                LDS_WAIT();
            }
            ua0 = ub0; ua1 = ub1;
        }
        S5_YSTORE();
#undef S5_YSTORE
#undef S5_POS
#undef S5_ROW
#undef S5_LOADU
    }
}
__device__ __forceinline__ float gelu_tanh_f(float x) { const float z = 0.7978845608f * (x + 0.044715f * x * x * x); return x * (1.0f - __builtin_amdgcn_rcpf(1.0f + __expf(2.0f * z))); }
__device__ __forceinline__ void s5_post_phase(const Args& a, int lane, int gw, int NGW) {
    const bf16_t* YF = (const bf16_t*)(a.ws + WS_YF); const bf16_t* YB = (const bf16_t*)(a.ws + WS_YB);
    const bf16_t* A1 = (const bf16_t*)(a.ws + WS_A); bf16_t* YG = (bf16_t*)(a.ws + WS_YG);
    f32x4 dk[4];
#pragma unroll
    for (int j = 0; j < 4; ++j) dk[j] = *(const f32x4*)(a.in[I_S5D] + 4 * lane + 256 * j);
    for (int tok0 = gw * 4; tok0 < NLAT; tok0 += NGW * 4) {
        u32x2 yf[4][4], yb[4][4], uu[4][4];
#pragma unroll
        for (int r = 0; r < 4; ++r) { const int tok = tok0 + r, b = tok >> 12, t = tok & 4095, src = b * SEQ + (t & 63) * 64 + (t >> 6);
#pragma unroll
            for (int j = 0; j < 4; ++j) { const int c = 4 * lane + 256 * j; yf[r][j] = *(const u32x2*)(YF + (size_t)src * D + c); yb[r][j] = *(const u32x2*)(YB + (size_t)src * D + c); uu[r][j] = *(const u32x2*)(A1 + (size_t)(NCTX + src) * D + c); } }
#pragma unroll
        for (int r = 0; r < 4; ++r)
#pragma unroll
            for (int j = 0; j < 4; ++j) {
                const u32x2 f = yf[r][j], bk = yb[r][j], uw = uu[r][j];
                const f32x4 y = (f32x4){bflo(f.x) + bflo(bk.x), bfhi(f.x) + bfhi(bk.x), bflo(f.y) + bflo(bk.y), bfhi(f.y) + bfhi(bk.y)} + dk[j] * (f32x4){bflo(uw.x), bfhi(uw.x), bflo(uw.y), bfhi(uw.y)};
                f32x4 o;
#pragma unroll
                for (int i = 0; i < 4; ++i) o[i] = gelu_tanh_f(y[i]);
                st_bf16x4(YG + (size_t)(tok0 + r) * D + 4 * lane + 256 * j, o);
            }
    }
}
struct EpiGlu {
    static constexpr bool PERM = true;
    const float* bglu; const float* modv1; bf16_t* H;
    __device__ __forceinline__ void operator()(const f32x4 (&acc)[2][2][4][2], const Unit& u, int wr, int wc, int fr, int fq) const {
        const int rt0 = u.pm * 256, bidx = rt0 >> 12, cb = u.pn * 128 + wc * 32 + 8 * fq, rl0 = wr * 64 + fr;
        const float* gp = modv1 + bidx * 6144 + 2048;
        const f32x4 ba0 = *(const f32x4*)(bglu + cb), ba1 = *(const f32x4*)(bglu + cb + 4), bb0 = *(const f32x4*)(bglu + 1024 + cb), bb1 = *(const f32x4*)(bglu + 1024 + cb + 4);
        const f32x4 gv0 = *(const f32x4*)(gp + cb), gv1 = *(const f32x4*)(gp + cb + 4);
#pragma unroll
        for (int ai = 0; ai < 2; ++ai)
#pragma unroll
            for (int m = 0; m < 4; ++m) {
                bf16_t* hp = H + (size_t)(NCTX + rt0 + rl0 + ai * 128 + m * 16) * D + cb;
                const u32x4 hw = *(const u32x4*)hp; const f32x4 h0 = (f32x4){bflo(hw.x), bfhi(hw.x), bflo(hw.y), bfhi(hw.y)}, h1 = (f32x4){bflo(hw.z), bfhi(hw.z), bflo(hw.w), bfhi(hw.w)};
                const f32x4 za0 = acc[ai][0][m][0] + ba0, za1 = acc[ai][0][m][1] + ba1, zb0 = acc[ai][1][m][0] + bb0, zb1 = acc[ai][1][m][1] + bb1; f32x4 o0, o1;
#pragma unroll
                for (int j = 0; j < 4; ++j) { o0[j] = za0[j] * sigmoid_f(zb0[j]); o1[j] = za1[j] * sigmoid_f(zb1[j]); }
                const f32x4 r0 = h0 + gv0 * o0, r1 = h1 + gv1 * o1;
                *(u32x4*)hp = (u32x4){pk2(r0[0], r0[1]), pk2(r0[2], r0[3]), pk2(r1[0], r1[1]), pk2(r1[2], r1[3])};
            }
    }
};

#define XB_TMO      128
#define XB_XCNT(j)  (256  + 64 * (j))
#define XB_XSUB(j)  (1280 + 64 * (j))
#define XB_XGEN(j)  (2304 + 64 * (j))
#define XB_TOP      3328
#define XB_TOPGEN   3392
#define XCD_BAR_WORDS 3456
#define XB_SPIN_CAP (1u << 18)
__device__ __forceinline__ unsigned xb_ld(unsigned* p)              { return __hip_atomic_load(p, __ATOMIC_RELAXED, __HIP_MEMORY_SCOPE_AGENT); }
__device__ __forceinline__ unsigned xb_add(unsigned* p, unsigned v) { return __hip_atomic_fetch_add(p, v, __ATOMIC_RELAXED, __HIP_MEMORY_SCOPE_AGENT); }
__device__ __forceinline__ unsigned xb_xcc_id() { return (unsigned)__builtin_amdgcn_s_getreg((3 << 11) | 20) & 0xFu; }
#define XB_SPIN(cond, bar) do { unsigned _sp = 0; while (cond) { __builtin_amdgcn_s_sleep(1); \
    if ((++_sp & 255u) == 0u) { if (xb_ld(&(bar)[XB_TMO])) break; if (_sp > XB_SPIN_CAP) { atomicAdd(&(bar)[XB_TMO], 1u); break; } } } } while (0)
struct XcdBarrier { unsigned* bar; unsigned x; volatile LAS unsigned* st; };
__device__ __forceinline__ XcdBarrier xcd_barrier_post(unsigned* bar, volatile LAS unsigned* st) {
    XcdBarrier b; b.bar = bar; b.x = xb_xcc_id(); b.st = st;
    if (threadIdx.x == 0) (void)xb_add(&bar[XB_XCNT(b.x)], 1u);
    return b;
}
__device__ __forceinline__ void xcd_barrier_complete(unsigned* bar, unsigned x, unsigned& nloc, unsigned& nx) {
    const unsigned G = gridDim.x * gridDim.y * gridDim.z;
    unsigned sum, cnt, mine, sp = 0u;
    for (;;) {
        sum = 0u; cnt = 0u; mine = 0u;
#pragma unroll
        for (unsigned j = 0; j < 16; ++j) { const unsigned c = xb_ld(&bar[XB_XCNT(j)]); sum += c; cnt += (c > 0u) ? 1u : 0u; mine = (j == x) ? c : mine; }
        if (sum == G) break;
        __builtin_amdgcn_s_sleep(1);
        if ((++sp & 255u) == 0u) { if (xb_ld(&bar[XB_TMO])) break; if (sp > XB_SPIN_CAP) { atomicAdd(&bar[XB_TMO], 1u); break; } }
    }
    nloc = mine > 0u ? mine : 1u; nx = cnt > 0u ? cnt : 1u;
}
__device__ __forceinline__ void xcd_barrier(const XcdBarrier& b) {
    asm volatile("s_waitcnt vmcnt(0)" ::: "memory");
    __syncthreads();
    if (threadIdx.x == 0) {
        unsigned* bar = b.bar;
        __builtin_amdgcn_s_waitcnt(0);
        unsigned nloc = b.st[0], nx = b.st[1];
        if (nloc == 0u) { xcd_barrier_complete(bar, b.x, nloc, nx); b.st[0] = nloc; b.st[1] = nx; }
        const unsigned old = xb_add(&bar[XB_XSUB(b.x)], 1u);
        const unsigned gen = old / nloc;
        if (old + 1u == (gen + 1u) * nloc) {
            __builtin_amdgcn_fence(__ATOMIC_RELEASE, "agent");
            asm volatile("s_waitcnt vmcnt(0)" ::: "memory");
            const unsigned og = xb_add(&bar[XB_TOP], 1u);
            const unsigned tg = og / nx;
            if (og + 1u == (tg + 1u) * nx) xb_add(&bar[XB_TOPGEN], 1u);
            else XB_SPIN(xb_ld(&bar[XB_TOPGEN]) == tg, bar);
            __builtin_amdgcn_fence(__ATOMIC_ACQUIRE, "agent");
            xb_add(&bar[XB_XGEN(b.x)], 1u);
            asm volatile("s_waitcnt vmcnt(0)" ::: "memory");
        } else {
            XB_SPIN(xb_ld(&bar[XB_XGEN(b.x)]) == gen, bar);
            __builtin_amdgcn_fence(__ATOMIC_ACQUIRE, "agent");
            asm volatile("s_waitcnt vmcnt(0)" ::: "memory");
        }
    }
    __syncthreads();
}

__device__ __forceinline__ int opaque_tid() { int t = threadIdx.x; asm volatile("" : "+v"(t)); return t; }
#define PHASE_IDS() const int tid = opaque_tid(); const int lane = tid & 63, wave = tid >> 6; const int G = gridDim.x, gw = blockIdx.x * 8 + wave, NGW = G * 8; \
    const int vcu = (G % 8 == 0) ? (int)(blockIdx.x % 8) * (G / 8) + (int)(blockIdx.x / 8) : (int)blockIdx.x; (void)lane; (void)wave; (void)gw; (void)NGW; (void)vcu; (void)G
__global__ void __launch_bounds__(NTHREADS, 2) fwd_mega(Args a) {
    extern __shared__ __attribute__((aligned(16))) unsigned char lds_raw[];
    LAS unsigned char* lds = (LAS unsigned char*)lds_raw;
    cg::grid_group grid = cg::this_grid();
    unsigned char* ws = a.ws;
    if (threadIdx.x < 2) ((LAS unsigned*)(lds + LDS_BYTES - 16))[threadIdx.x] = 0u;
    __syncthreads();
    const XcdBarrier xbar = xcd_barrier_post((unsigned*)(ws + WS_CTL) + CW_BAR, (volatile LAS unsigned*)(lds + LDS_BYTES - 16));
#ifdef TS_SEL
    volatile LAS unsigned long long* tsbuf = (volatile LAS unsigned long long*)(lds + LDS_BYTES - 16 - 256);
    int tsn = 0;
#define TS_MARK() do { if (blockIdx.x == 0 && threadIdx.x == 0) tsbuf[tsn] = __builtin_amdgcn_s_memrealtime(); ++tsn; } while (0)
#else
#define TS_MARK() do { } while (0)
#endif
    TS_MARK();
#define GSYNC() do { xcd_barrier(xbar); TS_MARK(); } while (0)

    for (int rep = 0; rep < REP_P0; ++rep) { PHASE_IDS(); p0_phase(a, lds, tid, gw, NGW); if (REP_P0 > 1) __syncthreads(); }
    if (a.pad1 != 0) grid.sync();
    GSYNC();
    for (int rep = 0; rep < REP_P1; ++rep) { PHASE_IDS(); p1_phase(a, lane, gw, NGW); }
    GSYNC();
    {
        PHASE_IDS();
        pg8::Gemm g{(const bf16_t*)(ws + WS_A), (const bf16_t*)(ws + WS_WIN), NTOK, 5120, 1024};
        pg8::StaticOrder S; S.init(NTOK, 5120, G, (int)blockIdx.x);
        EpiInProj E{(bf16_t*)(ws + WS_Q), (bf16_t*)(ws + WS_V), (bf16_t*)(ws + WS_G), (_Float16*)(ws + WS_LFF), (_Float16*)(ws + WS_LFB), (const float*)(ws + WS_LBV)};
        for (int rep = 0; rep < REP_INP; ++rep) pg8::gemm_phase<EpiInProj, pg8::StaticOrder>(lds, g, S, E);
    }
    GSYNC();
    for (int rep = 0; rep < REP_GLA; ++rep) { PHASE_IDS(); gla_phase(a, lds, tid); if (REP_GLA > 1) __syncthreads(); }
    GSYNC();
    for (int rep = 0; rep < REP_RO; ++rep) { PHASE_IDS(); gla_readout_phase(a, lane, gw, NGW); }
    GSYNC();
    {
        PHASE_IDS();
        pg8::Gemm g{(const bf16_t*)(ws + WS_OG), (const bf16_t*)(ws + WS_WOUT), NTOK, 1024, 1024};
        pg8::StaticOrder S; S.init(NTOK, 1024, G, (int)blockIdx.x);
        EpiResid E{a.in[I_X], a.in[I_CTX], (const float*)(ws + WS_MODV), (bf16_t*)(ws + WS_H), 2048};
        for (int rep = 0; rep < REP_OUT; ++rep) pg8::gemm_phase<EpiResid, pg8::StaticOrder>(lds, g, S, E);
    }
    GSYNC();
    for (int rep = 0; rep < REP_RT; ++rep) { PHASE_IDS(); router_phase(a, lds, 0, 0, tid); if (REP_RT > 1) __syncthreads(); }
    GSYNC();
    for (int rep = 0; rep < REP_AS; ++rep) { PHASE_IDS(); assign_phase(a, lds, 0, 0, tid); if (REP_AS > 1) __syncthreads(); }
    GSYNC();
    for (int rep = 0; rep < REP_M1; ++rep) { PHASE_IDS(); moe_gemm1(a, lds, 0, tid, G, vcu); }
    GSYNC();
    for (int rep = 0; rep < REP_M2; ++rep) { PHASE_IDS(); moe_gemm2(a, lds, 0, tid, G, vcu); }
    GSYNC();
    { PHASE_IDS(); combine_phase(a, 0, 0, lane, gw, NGW); }
    GSYNC();
    for (int rep = 0; rep < REP_S5; ++rep) { PHASE_IDS(); s5_phase(a, lds, tid); if (REP_S5 > 1) __syncthreads(); }
    GSYNC();
    for (int rep = 0; rep < REP_POST; ++rep) { PHASE_IDS(); s5_post_phase(a, lane, gw, NGW); }
    GSYNC();
    {
        PHASE_IDS();
        pg8::Gemm g{(const bf16_t*)(ws + WS_YG), (const bf16_t*)(ws + WS_WGLU), NLAT, 2048, 1024};
        pg8::StaticOrder S; S.init(NLAT, 2048, G, (int)blockIdx.x);
        EpiGlu E{a.in[I_S5BGLU], (const float*)(ws + WS_MODV) + 9 * 6144, (bf16_t*)(ws + WS_H)};
        pg8::gemm_phase<EpiGlu, pg8::StaticOrder>(lds, g, S, E);
    }
    GSYNC();
    { PHASE_IDS(); router_phase(a, lds, 1, NCTX, tid); }
    GSYNC();
    { PHASE_IDS(); assign_phase(a, lds, 1, NCTX, tid); }
    GSYNC();
    { PHASE_IDS(); moe_gemm1(a, lds, 1, tid, G, vcu); }
    GSYNC();
    { PHASE_IDS(); moe_gemm2(a, lds, 1, tid, G, vcu); }
    GSYNC();
    for (int rep = 0; rep < REP_CMB1; ++rep) { PHASE_IDS(); combine_phase(a, 1, NCTX, lane, gw, NGW); }
#ifdef TS_SEL
    TS_MARK();
    if (blockIdx.x == 0 && threadIdx.x == 0) {
        asm volatile("s_waitcnt vmcnt(0)" ::: "memory"); __threadfence();
        const unsigned long long dt = tsbuf[TS_SEL + 1] - tsbuf[TS_SEL];
        atomicAdd(a.out, (float)dt * 0.001f);
    }
#endif
}

extern "C" void kernel_launch(void* const* d_in, const int* in_sizes, int n_in, void* d_out, int out_size,
                              void* d_ws, size_t ws_size, hipStream_t stream) {
    static int grid_blocks = 0;
    if (!grid_blocks) {
        int dev = 0, cus = 0, per_cu = 0;
        (void)hipGetDevice(&dev);
        (void)hipDeviceGetAttribute(&cus, hipDeviceAttributeMultiprocessorCount, dev);
        (void)hipFuncSetAttribute((const void*)fwd_mega, hipFuncAttributeMaxDynamicSharedMemorySize, LDS_BYTES);
        (void)hipOccupancyMaxActiveBlocksPerMultiprocessor(&per_cu, (const void*)fwd_mega, NTHREADS, LDS_BYTES);
        if (per_cu < 1) { fprintf(stderr, "occupancy query says %d blocks/CU\n", per_cu); }
        grid_blocks = cus < 256 ? cus : 256;
        if (ws_size < WS_END) fprintf(stderr, "kernel_launch: workspace too small: %zu < %zu\n", ws_size, (size_t)WS_END);
    }
    (void)hipMemsetAsync((char*)d_ws + WS_CTL, 0, 1 * MiB, stream);
    Args a{};
    for (int i = 0; i < 29; ++i) a.in[i] = (const float*)d_in[i];
    a.out = (float*)d_out; a.ws = (unsigned char*)d_ws;
    void* kargs[] = {&a};
    hipError_t e = hipLaunchCooperativeKernel((const void*)fwd_mega, dim3(grid_blocks), dim3(NTHREADS), kargs, LDS_BYTES, stream);
    if (e != hipSuccess) fprintf(stderr, "cooperative launch failed: %s (grid %d)\n", hipGetErrorString(e), grid_blocks);
}
```

```cpp
#include <hip/hip_runtime.h>
#include <hip/hip_cooperative_groups.h>
#include <cstdio>
#include <cstdint>
namespace cg = cooperative_groups;

#define LAS __attribute__((address_space(3)))
typedef unsigned short bf16_t;
typedef short bf16x8 __attribute__((ext_vector_type(8)));
typedef float f32x4 __attribute__((ext_vector_type(4)));
typedef unsigned u32x4 __attribute__((ext_vector_type(4)));
typedef unsigned u32x2 __attribute__((ext_vector_type(2)));
typedef float f32x2 __attribute__((ext_vector_type(2)));

constexpr int NTHREADS = 512;
constexpr int LDS_BYTES = 147456;
constexpr int D = 1024, NB = 8, SEQ = 4096, CTXL = 256;
constexpr int NCTX = NB * CTXL;
constexpr int NLAT = NB * SEQ;
constexpr int NTOK = NCTX + NLAT;
constexpr int NE = 32;
constexpr int MPAD = 147456;
constexpr float EPS = 1e-6f;

constexpr size_t MiB = 1u << 20;
constexpr size_t WS_CTL = 0;
constexpr size_t WS_MODV = 1 * MiB;
constexpr size_t WS_LBV = 1 * MiB + 512 * 1024;
constexpr size_t WS_WIN = 2 * MiB;
constexpr size_t WS_WOUT = 12 * MiB;
constexpr size_t WS_WGLU = 14 * MiB;
constexpr size_t WS_W1 = 18 * MiB;
constexpr size_t WS_W2 = 274 * MiB;
constexpr size_t WS_H = 402 * MiB;
constexpr size_t WS_A = 538 * MiB;
constexpr size_t WS_F = 606 * MiB;
constexpr size_t WS_TOKE = 674 * MiB;
constexpr size_t WS_TOKW = 674 * MiB + 640 * 1024;
constexpr size_t WS_TOKS = 674 * MiB + 1280 * 1024;
constexpr size_t WS_SLOTTOK = 256 * 1024;
constexpr size_t WS_BIG = 676 * MiB;
constexpr size_t WS_Q = WS_BIG, WS_V = WS_BIG + 68 * MiB, WS_G = WS_BIG + 136 * MiB;
constexpr size_t WS_LFF = WS_BIG + 204 * MiB, WS_LFB = WS_BIG + 340 * MiB;
constexpr size_t WS_OF = WS_BIG + 476 * MiB, WS_OB = WS_BIG + 612 * MiB;
constexpr size_t WS_OG = WS_BIG + 748 * MiB;
constexpr size_t WS_AG = WS_BIG, WS_ACT = WS_BIG + 288 * MiB, WS_YS = WS_BIG;
constexpr size_t WS_YF = WS_BIG, WS_YB = WS_BIG + 128 * MiB, WS_YG = WS_BIG + 256 * MiB;
constexpr size_t WS_END = WS_BIG + 816 * MiB;
constexpr int CW_CNT = 64;
constexpr int CW_CUR = 256;
constexpr int CW_CNTB = 8192;
constexpr int CW_BAR = 4096;
#ifndef REP_P0
#define REP_P0 1
#endif
#ifndef REP_GLA
#define REP_GLA 1
#endif
#ifndef REP_S5
#define REP_S5 1
#endif
#ifndef REP_P1
#define REP_P1 1
#endif
#ifndef REP_RO
#define REP_RO 1
#endif
#ifndef REP_POST
#define REP_POST 1
#endif
#ifndef REP_CMB1
#define REP_CMB1 1
#endif
#ifndef REP_OUT
#define REP_OUT 1
#endif
#ifndef REP_RT
#define REP_RT 1
#endif
#ifndef REP_AS
#define REP_AS 1
#endif
#ifndef REP_INP
#define REP_INP 1
#endif
#ifndef REP_M1
#define REP_M1 1
#endif
#ifndef REP_M2
#define REP_M2 1
#endif

struct Args {
    const float* in[29];
    float* out;
    unsigned char* ws;
    int stop_after, pad1;
};
enum { I_X = 0, I_C, I_CTX, I_CCTX, I_MODW, I_MODB, I_N1G, I_N2G, I_HGWIN, I_HGLB, I_HGNG, I_HGWOUT, I_S5ARE, I_S5AIM, I_S5LDT,
       I_S5BRE, I_S5BIM, I_S5CRE, I_S5CIM, I_S5D, I_S5WGLU, I_S5BGLU, I_RW, I_RB, I_W1, I_B1, I_W2, I_B2, I_FG };

__device__ __forceinline__ unsigned f2bf(float f) { unsigned u = __builtin_bit_cast(unsigned, f); return (u + 0x7fffu + ((u >> 16) & 1u)) >> 16; }
typedef __bf16 bf16x2_t __attribute__((ext_vector_type(2)));
__device__ __forceinline__ unsigned cvt_pk_bf16(float lo, float hi) { const bf16x2_t v = {(__bf16)lo, (__bf16)hi}; return __builtin_bit_cast(unsigned, v); }
__device__ __forceinline__ unsigned pk2(float lo, float hi) { return cvt_pk_bf16(lo, hi); }
__device__ __forceinline__ float bf2f(unsigned short b) { return __builtin_bit_cast(float, ((unsigned)b) << 16); }
__device__ __forceinline__ float bflo(unsigned w) { return __builtin_bit_cast(float, w << 16); }
__device__ __forceinline__ float bfhi(unsigned w) { return __builtin_bit_cast(float, w & 0xffff0000u); }
__device__ __forceinline__ float wave_sum(float v) {
#pragma unroll
    for (int o = 1; o < 64; o <<= 1) v += __shfl_xor(v, o);
    return v;
}
__device__ __forceinline__ float wave_max(float v) {
#pragma unroll
    for (int o = 1; o < 64; o <<= 1) v = fmaxf(v, __shfl_xor(v, o));
    return v;
}
__device__ __forceinline__ float sigmoid_f(float x) { return __builtin_amdgcn_rcpf(1.0f + __expf(-x)); }
__device__ __forceinline__ float silu_f(float x) { return x * __builtin_amdgcn_rcpf(1.0f + __expf(-x)); }
#define LDS_WAIT() asm volatile("s_waitcnt lgkmcnt(0)" ::: "memory")

namespace pg8 {
constexpr int BM = 256, BK = 64, HALF = 128, HTB = HALF * BK * 2, STAGE_BYTES = 8 * HTB, NXCD = 8, WGM = 8;
__host__ __device__ __forceinline__ int lds_byte(int r, int c) { const int st = (r >> 4) * 2 + (c >> 5), rr = r & 15, cc = c & 31, ob = rr * 64 + cc * 2; return st * 1024 + (ob ^ (((ob >> 9) & 1) << 5)); }
__host__ __device__ __forceinline__ void stage_rc(int b, int& R, int& C) { const int st = b / 1024, sb = b % 1024, swz = sb ^ (((sb >> 9) & 1) << 5); R = (st >> 1) * 16 + swz / 64; C = (st & 1) * 32 + (swz % 64) / 2; }
__host__ __device__ __forceinline__ int perm32(int rho) { const int n = rho >> 4, i = rho & 15; return 8 * (i >> 2) + 4 * n + (i & 3); }
struct Unit { int pm, pn; };
struct Gemm { const bf16_t* A; const bf16_t* Bt; int M, N, K; };
struct StaticOrder {
    int nM, nN, nwg, G, c;
    __device__ void init(int M, int N, int G_, int c_) { nM = M / BM; nN = N / BM; nwg = nM * nN; G = G_; c = c_; }
    __device__ bool next(int i, Unit& u) const {
        const long L = (long)i * G + c; if (L >= nwg) return false;
        int wgid = (int)L; { const int q = nwg / NXCD, r = nwg % NXCD, xcd = wgid % NXCD, off = wgid / NXCD; wgid = (xcd < r ? xcd * (q + 1) : r * (q + 1) + (xcd - r) * q) + off; }
        const int nig = WGM * nN, gid = wgid / nig, fm = gid * WGM, gsz = (nM - fm) < WGM ? (nM - fm) : WGM;
        u.pm = fm + ((wgid % nig) % gsz); u.pn = (wgid % nig) / gsz; return true;
    }
    __device__ __forceinline__ void a_ready(const Unit&) const {}
    __device__ __forceinline__ void done(const Unit&) const {}
};
struct MoeOrder {
    const LAS int* tile_e; int TT, sh, G, v;
    __device__ bool next(int i, Unit& u) const {
        const int per = G >> 3, x = v / per, j = v - x * per;
        const int t0 = (int)(((long)x * TT) >> 3), t1 = (int)(((long)(x + 1) * TT) >> 3);
        const int uu = i * per + j, rt = t0 + (uu >> sh), pnl = uu & ((1 << sh) - 1);
        if (rt >= t1) return false;
        u.pm = rt; u.pn = (tile_e[rt] << sh) + pnl; return true;
    }
    __device__ __forceinline__ void a_ready(const Unit&) const {}
    __device__ __forceinline__ void done(const Unit&) const {}
};

template <class Epi, class Sched, bool GATHER = false>
__device__ __forceinline__ void gemm_phase(LAS unsigned char* lds, const Gemm g, const Sched& S, const Epi& E, const int* rowidx = nullptr) {
    int tid_ = threadIdx.x; asm volatile("" : "+v"(tid_));
    const int tid = tid_, wid = __builtin_amdgcn_readfirstlane(tid >> 6), lane = tid & 63, wr = wid >> 2, wc = wid & 3, fr = lane & 15, fq = lane >> 4;
    const int K = g.K, nt = K / BK;
    unsigned voffA[2], voffB[2];
    int Rr[2], Cc2[2];
#pragma unroll
    for (int i = 0; i < 2; ++i) { int R, C; stage_rc(tid * 16 + i * 8192, R, C); voffA[i] = (unsigned)(R * K + C) * 2u; const int Rb = Epi::PERM ? ((R & ~31) + perm32(R & 31)) : R; voffB[i] = (unsigned)(Rb * K + C) * 2u; Rr[i] = R; Cc2[i] = C * 2; }
    unsigned gA0[2] = {0u, 0u}, gA1[2] = {0u, 0u}, nG0[2] = {0u, 0u}, nG1[2] = {0u, 0u};
#define PG8_ROWS(pm_, d0, d1) do { _Pragma("unroll") for (int _i = 0; _i < 2; ++_i) { d0[_i] = (unsigned)rowidx[(pm_) * BM + Rr[_i]] * (unsigned)(K * 2) + (unsigned)Cc2[_i]; d1[_i] = (unsigned)rowidx[(pm_) * BM + HALF + Rr[_i]] * (unsigned)(K * 2) + (unsigned)Cc2[_i]; } } while (0)
#define PG8_STAGE_A(bufoff, ptr, h, nx) do { if constexpr (GATHER) { unsigned _o[2]; _o[0] = (nx) ? ((h) ? nG1[0] : nG0[0]) : ((h) ? gA1[0] : gA0[0]); _o[1] = (nx) ? ((h) ? nG1[1] : nG0[1]) : ((h) ? gA1[1] : gA0[1]); PG8_STAGE(bufoff, ptr, _o); } \
        else { PG8_STAGE(bufoff, (ptr) + ((h) ? hstep : 0), voffA); } } while (0)
    const size_t kstep = (size_t)(BK * 2);
    const size_t hstep = (size_t)HALF * K * 2;
    const size_t tstep = 2 * hstep;
    const unsigned ldsw = (unsigned)wid * 1024u;
    const int aoff = lds_byte(wr * 64 + fr, fq * 8), boff = lds_byte(wc * 32 + fr, fq * 8);
#define PG8_SA(b, h) (((b) * 2 + (h)) * HTB)
#define PG8_SB(b, h) ((4 + (b) * 2 + (h)) * HTB)
#define PG8_STAGE(bufoff, gbase, voff) do { _Pragma("unroll") for (int _i = 0; _i < 2; ++_i) \
        __builtin_amdgcn_global_load_lds((const unsigned*)((const char*)(gbase) + (voff)[_i]), (LAS unsigned*)(lds + (bufoff) + ldsw + _i * 8192), 16, 0, 0); } while (0)
#define PG8_LDA(dst, b, h) do { _Pragma("unroll") for (int m = 0; m < 4; ++m) _Pragma("unroll") for (int k = 0; k < 2; ++k) dst[m][k] = *(const LAS bf16x8*)(lds + PG8_SA(b, h) + aoff + m * 2048 + k * 1024); } while (0)
#define PG8_LDB(dst, b, h) do { _Pragma("unroll") for (int n = 0; n < 2; ++n) _Pragma("unroll") for (int k = 0; k < 2; ++k) dst[n][k] = *(const LAS bf16x8*)(lds + PG8_SB(b, h) + boff + n * 2048 + k * 1024); } while (0)
#define PG8_MMA(ai, bj, At, Bt) do { __builtin_amdgcn_s_setprio(1); _Pragma("unroll") for (int m = 0; m < 4; ++m) _Pragma("unroll") for (int n = 0; n < 2; ++n) _Pragma("unroll") for (int k = 0; k < 2; ++k) \
        acc[ai][bj][m][n] = __builtin_amdgcn_mfma_f32_16x16x32_bf16(Bt[n][k], At[m][k], acc[ai][bj][m][n], 0, 0, 0); __builtin_amdgcn_s_setprio(0); } while (0)
#define PG8_WAIT_V(n) asm volatile("s_waitcnt vmcnt(" #n ")" ::: "memory")
#define PG8_WAIT_L(n) asm volatile("s_waitcnt lgkmcnt(" #n ")" ::: "memory")
#define PG8_BAR __builtin_amdgcn_s_barrier()
#define PG8_SCHED __builtin_amdgcn_sched_barrier(0)
    Unit cur, nxt; int ui = 0;
    if (!S.next(0, cur)) return;
    f32x4 acc[2][2][4][2];
#pragma unroll
    for (int a = 0; a < 2; ++a)
#pragma unroll
        for (int b = 0; b < 2; ++b)
#pragma unroll
            for (int m = 0; m < 4; ++m)
#pragma unroll
                for (int n = 0; n < 2; ++n) acc[a][b][m][n] = (f32x4){0.f, 0.f, 0.f, 0.f};
    bf16x8 At[4][2], B0[2][2], B1[2][2];
    const char* cA = GATHER ? (const char*)g.A : (const char*)g.A + (size_t)cur.pm * tstep; const char* cB = (const char*)g.Bt + (size_t)cur.pn * tstep;
    S.a_ready(cur);
    if constexpr (GATHER) PG8_ROWS(cur.pm, gA0, gA1);
    PG8_STAGE(PG8_SB(0, 0), cB, voffB); PG8_STAGE_A(PG8_SA(0, 0), cA, 0, false); PG8_STAGE(PG8_SB(0, 1), cB + hstep, voffB); PG8_STAGE_A(PG8_SA(0, 1), cA, 1, false);
    if (wr == 1) PG8_BAR;
    PG8_WAIT_V(4); PG8_BAR;
    PG8_STAGE(PG8_SB(1, 0), cB + kstep, voffB); PG8_STAGE_A(PG8_SA(1, 0), cA + kstep, 0, false); PG8_STAGE(PG8_SB(1, 1), cB + hstep + kstep, voffB);
    PG8_WAIT_V(6); PG8_BAR;
    for (;;) {
        const bool has_next = S.next(ui + 1, nxt);
        const char* nA = GATHER ? cA : (has_next ? (const char*)g.A + (size_t)nxt.pm * tstep : cA); const char* nB = has_next ? (const char*)g.Bt + (size_t)nxt.pn * tstep : cB;
        if constexpr (GATHER) { if (has_next) PG8_ROWS(nxt.pm, nG0, nG1); else { nG0[0] = gA0[0]; nG0[1] = gA0[1]; nG1[0] = gA1[0]; nG1[1] = gA1[1]; } }
        for (int t = 0; t < nt; t += 2) {
            const bool last = (t == nt - 2);
            const char* a1 = cA + (size_t)(t + 1) * kstep;
            const char* a2 = last ? nA : cA + (size_t)(t + 2) * kstep; const char* b2 = last ? nB : cB + (size_t)(t + 2) * kstep;
            const char* a3 = a2 + kstep; const char* b3 = b2 + kstep;
            if (last && has_next) S.a_ready(nxt);
            PG8_LDB(B0, 0, 0); PG8_SCHED; PG8_LDA(At, 0, 0); PG8_STAGE_A(PG8_SA(1, 1), a1, 1, false);
            PG8_WAIT_L(8); PG8_BAR; PG8_WAIT_L(0); PG8_MMA(0, 0, At, B0); PG8_BAR; PG8_SCHED;
            PG8_LDB(B1, 0, 1); PG8_STAGE(PG8_SB(0, 0), b2, voffB);
            PG8_BAR; PG8_WAIT_L(0); PG8_MMA(0, 1, At, B1); PG8_BAR;
            PG8_LDA(At, 0, 1); PG8_STAGE_A(PG8_SA(0, 0), a2, 0, last);
            PG8_BAR; PG8_WAIT_L(0); PG8_MMA(1, 0, At, B0); PG8_BAR; PG8_SCHED;
            PG8_STAGE(PG8_SB(0, 1), b2 + hstep, voffB);
            PG8_WAIT_V(6); PG8_BAR; PG8_MMA(1, 1, At, B1); PG8_BAR;
            PG8_LDB(B0, 1, 0); PG8_SCHED; PG8_LDA(At, 1, 0); PG8_STAGE_A(PG8_SA(0, 1), a2, 1, last);
            PG8_WAIT_L(8); PG8_BAR; PG8_WAIT_L(0); PG8_MMA(0, 0, At, B0); PG8_BAR; PG8_SCHED;
            PG8_LDB(B1, 1, 1); PG8_STAGE(PG8_SB(1, 0), b3, voffB);
            PG8_BAR; PG8_WAIT_L(0); PG8_MMA(0, 1, At, B1); PG8_BAR;
            PG8_LDA(At, 1, 1); PG8_STAGE_A(PG8_SA(1, 0), a3, 0, last);
            PG8_BAR; PG8_WAIT_L(0); PG8_MMA(1, 0, At, B0); PG8_BAR; PG8_SCHED;
            PG8_STAGE(PG8_SB(1, 1), b3 + hstep, voffB);
            PG8_WAIT_V(6); PG8_BAR; PG8_MMA(1, 1, At, B1); PG8_BAR;
        }
        E(acc, cur, wr, wc, fr, fq); S.done(cur);
        if (!has_next) break;
#pragma unroll
        for (int a = 0; a < 2; ++a)
#pragma unroll
            for (int b = 0; b < 2; ++b)
#pragma unroll
                for (int m = 0; m < 4; ++m)
#pragma unroll
                    for (int n = 0; n < 2; ++n) acc[a][b][m][n] = (f32x4){0.f, 0.f, 0.f, 0.f};
        cur = nxt; cA = nA; cB = nB; ++ui;
        if constexpr (GATHER) { gA0[0] = nG0[0]; gA0[1] = nG0[1]; gA1[0] = nG1[0]; gA1[1] = nG1[1]; }
    }
    PG8_WAIT_V(0);
    if (wr == 0) PG8_BAR;
    PG8_BAR;
#undef PG8_SA
#undef PG8_ROWS
#undef PG8_STAGE_A
#undef PG8_SB
#undef PG8_STAGE
#undef PG8_LDA
#undef PG8_LDB
#undef PG8_MMA
#undef PG8_WAIT_V
#undef PG8_WAIT_L
#undef PG8_BAR
#undef PG8_SCHED
}
}
using pg8::Unit;

__device__ __forceinline__ f32x4 ld_bf16x4(const bf16_t* p) { const u32x2 w = *(const u32x2*)p; return (f32x4){bflo(w.x), bfhi(w.x), bflo(w.y), bfhi(w.y)}; }
__device__ __forceinline__ void st_bf16x4(bf16_t* p, f32x4 v) { u32x2 w; w.x = pk2(v[0], v[1]); w.y = pk2(v[2], v[3]); *(u32x2*)p = w; }

struct EpiInProj {
    static constexpr bool PERM = true;
    bf16_t *Q, *V, *G; _Float16 *LFF, *LFB; const float* lbv;
    __device__ __forceinline__ void operator()(const f32x4 (&acc)[2][2][4][2], const Unit& u, int wr, int wc, int fr, int fq) const {
        const int seg = u.pn >> 2, cb = (u.pn & 3) * 256 + wc * 32 + 8 * fq, row0 = u.pm * 256 + wr * 64 + fr;
#pragma unroll
        for (int bj = 0; bj < 2; ++bj) {
            const int c = cb + bj * 128;
            f32x4 lb0 = (f32x4){0.f, 0.f, 0.f, 0.f}, lb1 = lb0;
            if (seg == 2 || seg == 3) { lb0 = *(const f32x4*)(lbv + (seg - 2) * D + c); lb1 = *(const f32x4*)(lbv + (seg - 2) * D + c + 4); }
#pragma unroll
            for (int ai = 0; ai < 2; ++ai)
#pragma unroll
                for (int m = 0; m < 4; ++m) {
                    const size_t ro = (size_t)(row0 + ai * 128 + m * 16) * D + c;
                    const f32x4 v0 = acc[ai][bj][m][0], v1 = acc[ai][bj][m][1];
                    if (seg == 0) { f32x4 o0, o1; for (int j = 0; j < 4; ++j) { o0[j] = silu_f(v0[j]); o1[j] = silu_f(v1[j]); }
                        *(u32x4*)(Q + ro) = (u32x4){pk2(o0[0], o0[1]), pk2(o0[2], o0[3]), pk2(o1[0], o1[1]), pk2(o1[2], o1[3])}; }
                    else if (seg == 1) { *(u32x4*)(V + ro) = (u32x4){pk2(v0[0], v0[1]), pk2(v0[2], v0[3]), pk2(v1[0], v1[1]), pk2(v1[2], v1[3])}; }
                    else if (seg == 4) { *(u32x4*)(G + ro) = (u32x4){pk2(v0[0], v0[1]), pk2(v0[2], v0[3]), pk2(v1[0], v1[1]), pk2(v1[2], v1[3])}; }
                    else {
                        f32x4 o0, o1;
                        for (int j = 0; j < 4; ++j) { o0[j] = __logf(lb0[j] + (1.0f - lb0[j]) * sigmoid_f(v0[j])); o1[j] = __logf(lb1[j] + (1.0f - lb1[j]) * sigmoid_f(v1[j])); }
                        u32x4 hw; hw.x = __builtin_bit_cast(unsigned, __builtin_amdgcn_cvt_pkrtz(o0[0], o0[1])); hw.y = __builtin_bit_cast(unsigned, __builtin_amdgcn_cvt_pkrtz(o0[2], o0[3]));
                        hw.z = __builtin_bit_cast(unsigned, __builtin_amdgcn_cvt_pkrtz(o1[0], o1[1])); hw.w = __builtin_bit_cast(unsigned, __builtin_amdgcn_cvt_pkrtz(o1[2], o1[3]));
                        *(u32x4*)((seg == 2 ? LFF : LFB) + ro) = hw;
                    }
                }
        }
    }
};
struct EpiResid {
    static constexpr bool PERM = true;
    const float* x; const float* ctx; const float* modv; bf16_t* H; int gate_off;
    __device__ __forceinline__ void operator()(const f32x4 (&acc)[2][2][4][2], const Unit& u, int wr, int wc, int fr, int fq) const {
        const int rt0 = u.pm * 256; const int mr = rt0 < NCTX ? 8 : ((rt0 - NCTX) >> 12);
        const float* src = rt0 < NCTX ? ctx + (size_t)rt0 * D : x + (size_t)(rt0 - NCTX) * D;
        const int cb = u.pn * 256 + wc * 32 + 8 * fq, rl0 = wr * 64 + fr;
        const float* gp = modv + mr * 6144 + gate_off;
        f32x4 gg[2][2];
#pragma unroll
        for (int bj = 0; bj < 2; ++bj) { gg[bj][0] = *(const f32x4*)(gp + cb + bj * 128); gg[bj][1] = *(const f32x4*)(gp + cb + bj * 128 + 4); }
#pragma unroll
        for (int bj = 0; bj < 2; ++bj)
#pragma unroll
            for (int ai = 0; ai < 2; ++ai) {
                const int c = cb + bj * 128; f32x4 h0[4], h1[4];
#pragma unroll
                for (int m = 0; m < 4; ++m) { const float* hp = src + (size_t)(rl0 + ai * 128 + m * 16) * D + c; h0[m] = *(const f32x4*)hp; h1[m] = *(const f32x4*)(hp + 4); }
#pragma unroll
                for (int m = 0; m < 4; ++m) {
                    const f32x4 o0 = h0[m] + gg[bj][0] * acc[ai][bj][m][0], o1 = h1[m] + gg[bj][1] * acc[ai][bj][m][1];
                    *(u32x4*)(H + (size_t)(rt0 + rl0 + ai * 128 + m * 16) * D + c) = (u32x4){pk2(o0[0], o0[1]), pk2(o0[2], o0[3]), pk2(o1[0], o1[1]), pk2(o1[2], o1[3])};
                }
                asm volatile("" ::: "memory");
            }
    }
};

struct TrItem { const float* src; bf16_t* dst; int N; };
__device__ __forceinline__ void tr_load(const TrItem& t, f32x4 (&v)[16], int lane) {
    const float* p = t.src + (size_t)(2 * (lane >> 4)) * t.N + 4 * (lane & 15);
#pragma unroll
    for (int i = 0; i < 8; ++i) { v[2 * i] = *(const f32x4*)(p + (size_t)(8 * i) * t.N); v[2 * i + 1] = *(const f32x4*)(p + (size_t)(8 * i + 1) * t.N); }
}
__device__ __forceinline__ void tr_finish(const TrItem& t, const f32x4 (&v)[16], LAS unsigned* scr, int lane) {
#pragma unroll
    for (int i = 0; i < 8; ++i) {
        const int kp = 4 * i + (lane >> 4); LAS unsigned* s = scr + kp * 65 + 4 * (lane & 15);
        s[0] = cvt_pk_bf16(v[2 * i][0], v[2 * i + 1][0]); s[1] = cvt_pk_bf16(v[2 * i][1], v[2 * i + 1][1]); s[2] = cvt_pk_bf16(v[2 * i][2], v[2 * i + 1][2]); s[3] = cvt_pk_bf16(v[2 * i][3], v[2 * i + 1][3]);
    }
    LDS_WAIT();
    const int c = lane & 7;
#pragma unroll
    for (int j = 0; j < 8; ++j) {
        const int n = (lane >> 3) + 8 * j; const LAS unsigned* s = scr + (4 * c) * 65 + n;
        *(u32x4*)(t.dst + (size_t)n * 1024 + 8 * c) = (u32x4){s[0], s[65], s[130], s[195]};
    }
    LDS_WAIT();
}
__device__ __forceinline__ int ilv_row(int c) { const int bj = c >> 10, r = c & 1023; return (r >> 7) * 256 + bj * 128 + (r & 127); }

__device__ __forceinline__ TrItem moe_item(const Args& a, int r, int layer) {
    TrItem t;
    if (r < 32 * 512) { const int mat = layer * 32 + (r >> 9), sub = r & 511, kb = sub >> 5, nb = sub & 31;
        t.src = a.in[I_W1] + (size_t)mat * 1024 * 2048 + (size_t)(kb * 64) * 2048 + nb * 64; t.dst = (bf16_t*)(a.ws + WS_W1) + (size_t)mat * 2048 * 1024 + (size_t)ilv_row(nb * 64) * 1024 + kb * 64; t.N = 2048; }
    else { r -= 32 * 512; const int mat = layer * 32 + (r >> 8), sub = r & 255, kb = sub >> 4, nb = sub & 15;
        t.src = a.in[I_W2] + (size_t)mat * 1024 * 1024 + (size_t)(kb * 64) * 1024 + nb * 64; t.dst = (bf16_t*)(a.ws + WS_W2) + (size_t)mat * 1024 * 1024 + (size_t)(nb * 64) * 1024 + kb * 64; t.N = 1024; }
    return t;
}
constexpr int P0_NWIN = 16 * 80, P0_NWOUT = 16 * 16, P0_NWGLU = 16 * 32, P0_NITEMS = P0_NWIN + P0_NWOUT + P0_NWGLU + 32 * 512 + 32 * 256;
__device__ __forceinline__ TrItem p0_item(const Args& a, int r) {
    TrItem t;
    if (r < P0_NWIN) { const int kb = r / 80, nb = r % 80; t.src = a.in[I_HGWIN] + (size_t)(kb * 64) * 5120 + nb * 64; t.dst = (bf16_t*)(a.ws + WS_WIN) + (size_t)(nb * 64) * 1024 + kb * 64; t.N = 5120; return t; } r -= P0_NWIN;
    if (r < P0_NWOUT) { const int kb = r / 16, nb = r % 16; t.src = a.in[I_HGWOUT] + (size_t)(kb * 64) * 1024 + nb * 64; t.dst = (bf16_t*)(a.ws + WS_WOUT) + (size_t)(nb * 64) * 1024 + kb * 64; t.N = 1024; return t; } r -= P0_NWOUT;
    if (r < P0_NWGLU) { const int kb = r / 32, nb = r % 32; t.src = a.in[I_S5WGLU] + (size_t)(kb * 64) * 2048 + nb * 64; t.dst = (bf16_t*)(a.ws + WS_WGLU) + (size_t)ilv_row(nb * 64) * 1024 + kb * 64; t.N = 2048; return t; } r -= P0_NWGLU;
    return moe_item(a, r, 0);
}
#define TR_LOOP(first, stride, count, ITEM) do { int _it = (first); if (_it < (count)) { f32x4 _va[16], _vb[16]; TrItem _A = ITEM(_it), _B = _A; tr_load(_A, _va, lane); \
        for (;;) { const int _i2 = _it + (stride); const bool _h2 = _i2 < (count); if (_h2) { _B = ITEM(_i2); tr_load(_B, _vb, lane); } tr_finish(_A, _va, scr, lane); if (!_h2) break; \
                   _it = _i2 + (stride); const bool _h1 = _it < (count); if (_h1) { _A = ITEM(_it); tr_load(_A, _va, lane); } tr_finish(_B, _vb, scr, lane); if (!_h1) break; } } } while (0)
__device__ __forceinline__ void p0_phase(const Args& a, LAS unsigned char* lds, int tid, int gw, int NGW) {
    const int lane = tid & 63, wave = tid >> 6;
    unsigned char* ws = a.ws;
    float* modv = (float*)(ws + WS_MODV);
    if (blockIdx.x < 192) {
        LAS float* SC = (LAS float*)lds;
        LAS float* PART = (LAS float*)(lds + 40960);
        for (int i = tid; i < 9 * 1024; i += NTHREADS) { const int r = i >> 10, k = i & 1023; const float v = r < 8 ? a.in[I_C][r * 1024 + k] : a.in[I_CCTX][k]; SC[i] = silu_f(v); }
        __syncthreads();
        const int layer = blockIdx.x / 96, ng = blockIdx.x % 96;
        const float* W = a.in[I_MODW] + (size_t)layer * 1024 * 6144 + ng * 64 + lane;
        float acc[9];
#pragma unroll
        for (int r = 0; r < 9; ++r) acc[r] = 0.f;
#pragma unroll 8
        for (int kk = 0; kk < 128; ++kk) {
            const int k = wave * 128 + kk; const float w = W[(size_t)k * 6144];
#pragma unroll
            for (int r = 0; r < 9; ++r) acc[r] += SC[r * 1024 + k] * w;
        }
#pragma unroll
        for (int r = 0; r < 9; ++r) PART[(wave * 9 + r) * 64 + lane] = acc[r];
        __syncthreads();
        for (int i = tid; i < 9 * 64; i += NTHREADS) {
            const int r = i >> 6, l = i & 63; float s = a.in[I_MODB][layer * 6144 + ng * 64 + l];
#pragma unroll
            for (int w = 0; w < 8; ++w) s += PART[(w * 9 + r) * 64 + l];
            modv[(size_t)(layer * 9 + r) * 6144 + ng * 64 + l] = s;
        }
        __syncthreads();
    } else if (blockIdx.x == 192) {
        float* lbv = (float*)(ws + WS_LBV);
        for (int i = tid; i < 2048; i += NTHREADS) { const float l0 = a.in[I_HGLB][i], l1 = a.in[I_HGLB][2048 + i]; lbv[i] = 1.0f / (1.0f + __expf(l1 - l0)); }
    }
    LAS unsigned* scr = (LAS unsigned*)(lds + 59392 + wave * 8320);
#define P0_ITEM(i) p0_item(a, (i))
    TR_LOOP(gw, NGW, P0_NITEMS, P0_ITEM);
#undef P0_ITEM
}

__device__ __forceinline__ const float* hin_row(const Args& a, int row) { return row < NCTX ? a.in[I_CTX] + (size_t)row * D : a.in[I_X] + (size_t)(row - NCTX) * D; }
__device__ __forceinline__ int mod_row(int row) { return row < NCTX ? 8 : ((row - NCTX) >> 12); }
__device__ __forceinline__ float row_rstd(const f32x4 (&v)[4]) {
    float s = 0.f;
#pragma unroll
    for (int j = 0; j < 4; ++j) s += (v[j][0] * v[j][0] + v[j][1] * v[j][1]) + (v[j][2] * v[j][2] + v[j][3] * v[j][3]);
    return 1.0f / sqrtf(wave_sum(s) * (1.0f / D) + EPS);
}
struct ModVec { f32x4 g[4], sc[4], sh[4]; };
__device__ __forceinline__ void modvec_load(ModVec& m, const float* g, const float* sc, const float* sh, int lane) {
#pragma unroll
    for (int j = 0; j < 4; ++j) { const int c = 4 * lane + 256 * j; m.g[j] = *(const f32x4*)(g + c); m.sc[j] = *(const f32x4*)(sc + c); m.sh[j] = *(const f32x4*)(sh + c); }
}
__device__ __forceinline__ void norm_mod_store(const f32x4 (&v)[4], float rstd, const ModVec& m, bf16_t* orow, int lane) {
#pragma unroll
    for (int j = 0; j < 4; ++j) st_bf16x4(orow + 4 * lane + 256 * j, v[j] * rstd * m.g[j] * (m.sc[j] + 1.0f) + m.sh[j]);
}

__device__ __forceinline__ void p1_phase(const Args& a, int lane, int gw, int NGW) {
    const float* modv = (const float*)(a.ws + WS_MODV);
    bf16_t* A = (bf16_t*)(a.ws + WS_A);
    for (int row0 = gw * 4; row0 < NTOK; row0 += NGW * 4) {
        f32x4 v[4][4];
#pragma unroll
        for (int r = 0; r < 4; ++r) { const float* hr = hin_row(a, row0 + r);
#pragma unroll
            for (int j = 0; j < 4; ++j) v[r][j] = *(const f32x4*)(hr + 4 * lane + 256 * j); }
        const float* mv = modv + (size_t)mod_row(row0) * 6144;
        ModVec m; modvec_load(m, a.in[I_N1G], mv + 1024, mv, lane);
#pragma unroll
        for (int r = 0; r < 4; ++r) { const float rstd = row_rstd(v[r]); norm_mod_store(v[r], rstd, m, A + (size_t)(row0 + r) * D, lane); }
    }
}

__device__ __forceinline__ int gla_row(int n, int t, int b, int dir) {
    const bool isctx = n < 4; const int cn = isctx ? n : n - 4, slen = isctx ? CTXL : SEQ, rbase = isctx ? b * CTXL : NCTX + b * SEQ;
    const int pos = cn * 64 + t; return rbase + (dir ? slen - 1 - pos : pos);
}
__device__ __forceinline__ void gla_phase(const Args& a, LAS unsigned char* lds, int tid) {
    const int lane = tid & 63, wave = tid >> 6, fr = lane & 15, fq = lane >> 4;
    LAS unsigned char* QS = lds;
    LAS unsigned char* KS = lds + 17408;
    LAS unsigned char* QIN = lds + 34816;
    LAS unsigned char* KOT = lds + 52224;
    LAS unsigned char* VT = lds + 70656;
    LAS unsigned char* ST0 = lds + 79872;
    LAS unsigned char* PPW = lds + 114688 + wave * 2304;
    LAS float* GT0 = (LAS float*)(lds + 133120);
    LAS float* BL = (LAS float*)(lds + 141312);
    const bf16_t* Qg = (const bf16_t*)(a.ws + WS_Q); const bf16_t* Vg = (const bf16_t*)(a.ws + WS_V);
    for (int item = blockIdx.x; item < 256; item += gridDim.x) {
        const int vs = item & 1, dir = (item >> 1) & 1, h = (item >> 2) & 7, b = item >> 5;
        const _Float16* LF = (const _Float16*)(a.ws + (dir ? WS_LFB : WS_LFF)); bf16_t* Og = (bf16_t*)(a.ws + (dir ? WS_OB : WS_OF));
        f32x4 Sacc[4];
#pragma unroll
        for (int i = 0; i < 4; ++i) Sacc[i] = (f32x4){0.f, 0.f, 0.f, 0.f};
        for (int i = tid; i < 2 * 17408 / 4; i += NTHREADS) ((LAS unsigned*)ST0)[i] = 0u;
        const int kc2 = (tid & 63) * 2, tg = tid >> 6, chq = h * 128 + kc2;
        const int vt_t = tid & 63, vt_v8 = (tid >> 6) * 8;
        unsigned lf2[8], q2[8]; u32x4 vv;
#define GLA_LOAD(n_) do { _Pragma("unroll") for (int i = 0; i < 8; ++i) { const size_t o = (size_t)gla_row(n_, tg * 8 + i, b, dir) * D + chq; lf2[i] = *(const unsigned*)(LF + o); q2[i] = *(const unsigned*)(Qg + o); } \
            vv = *(const u32x4*)(Vg + (size_t)gla_row(n_, vt_t, b, dir) * D + h * 128 + vs * 64 + vt_v8); } while (0)
        float fa[8], fb[8], bca[8], bcb[8];
#define GLA_CUMSUM(par_) do { float csa = 0.f, csb = 0.f; _Pragma("unroll") for (int i = 0; i < 8; ++i) { typedef _Float16 h2 __attribute__((ext_vector_type(2))); const h2 hv = __builtin_bit_cast(h2, lf2[i]); \
            const float la = (float)hv[0], lb_ = (float)hv[1]; fa[i] = __expf(la); fb[i] = __expf(lb_); csa += la; csb += lb_; bca[i] = csa; bcb[i] = csb; } \
            *(LAS f32x2*)(GT0 + (par_) * 1024 + tg * 128 + kc2) = (f32x2){csa, csb}; } while (0)
        GLA_LOAD(0);
        GLA_CUMSUM(0);
        __syncthreads();
        for (int n = 0; n < 68; ++n) {
            const int par = n & 1;
            LAS unsigned char* STc = ST0 + par * 17408; LAS unsigned char* STn = ST0 + (par ^ 1) * 17408;
            { const unsigned w[4] = {vv.x, vv.y, vv.z, vv.w};
#pragma unroll
              for (int i = 0; i < 4; ++i) { *(LAS bf16_t*)(VT + (vt_v8 + 2 * i) * 144 + vt_t * 2) = (bf16_t)(w[i] & 0xffffu); *(LAS bf16_t*)(VT + (vt_v8 + 2 * i + 1) * 144 + vt_t * 2) = (bf16_t)(w[i] >> 16); } }
#define GLA_OSTORE(n_) do { const u32x4 od = *(const LAS u32x4*)(PPW + (lane >> 2) * 144 + (lane & 3) * 16); \
                *(u32x4*)(Og + (size_t)gla_row(n_, (wave >> 1) * 16 + (lane >> 2), b, dir) * D + h * 128 + vs * 64 + (wave & 1) * 32 + (lane & 3) * 8) = od; } while (0)
            if (n > 0) GLA_OSTORE(n - 1);
            f32x2 pre = (f32x2){0.f, 0.f}, bref = (f32x2){0.f, 0.f}, blast = (f32x2){0.f, 0.f};
#pragma unroll
            for (int g8 = 0; g8 < 8; ++g8) { const f32x2 gv = *(const LAS f32x2*)(GT0 + par * 1024 + g8 * 128 + kc2); if (g8 < tg) pre += gv; if (g8 < 4) bref += gv; blast += gv; }
            const float era = __expf(bref.x), erb = __expf(bref.y), ela = __expf(blast.x - bref.x), elb = __expf(blast.y - bref.y);
            float e1a = __expf(pre.x - bref.x), e1b = __expf(pre.y - bref.y);
            unsigned kota[4], kotb[4];
#pragma unroll
            for (int i = 0; i < 8; ++i) {
                const int t = tg * 8 + i;
                const float qa = bflo(q2[i]), qb = bfhi(q2[i]);
                e1a *= fa[i]; e1b *= fb[i];
                const float ka = 1.0f - fa[i], kb = 1.0f - fb[i];
                const float e2a = __builtin_amdgcn_rcpf(e1a), e2b = __builtin_amdgcn_rcpf(e1b);
                const float qsa = qa * e1a, qsb = qb * e1b, ksa = ka * e2a, ksb = kb * e2b;
                *(LAS unsigned*)(QS + t * 272 + kc2 * 2) = cvt_pk_bf16(qsa, qsb);
                *(LAS unsigned*)(KS + t * 272 + kc2 * 2) = cvt_pk_bf16(ksa, ksb);
                *(LAS unsigned*)(QIN + t * 272 + kc2 * 2) = cvt_pk_bf16(qsa * era, qsb * erb);
                const unsigned ko = cvt_pk_bf16(ksa * ela, ksb * elb);
                if (i & 1) { kota[i >> 1] |= ko << 16; kotb[i >> 1] |= ko & 0xffff0000u; } else { kota[i >> 1] = ko & 0xffffu; kotb[i >> 1] = ko >> 16; }
            }
            { const int rot = ((kc2 >> 4) + tg) & 7;
              *(LAS u32x4*)(KOT + kc2 * 144 + rot * 16) = (u32x4){kota[0], kota[1], kota[2], kota[3]};
              *(LAS u32x4*)(KOT + (kc2 + 1) * 144 + rot * 16) = (u32x4){kotb[0], kotb[1], kotb[2], kotb[3]}; }
            if (tg == 0) *(LAS f32x2*)(BL + kc2) = (f32x2){__expf(blast.x), __expf(blast.y)};
            if (n + 1 < 68) GLA_LOAD(n + 1);
            __syncthreads();
            const int tt = wave >> 1;
            bf16x8 aq[4];
#pragma unroll
            for (int kk = 0; kk < 4; ++kk) aq[kk] = *(const LAS bf16x8*)(QS + (tt * 16 + fr) * 272 + (kk * 32 + fq * 8) * 2);
#pragma unroll
            for (int st = 0; st < 4; ++st) {
                f32x4 acc = (f32x4){0.f, 0.f, 0.f, 0.f};
                if (st <= tt) {
#pragma unroll
                    for (int kk = 0; kk < 4; ++kk) {
                        const bf16x8 bv = *(const LAS bf16x8*)(KS + (st * 16 + fr) * 272 + (kk * 32 + fq * 8) * 2);
                        acc = __builtin_amdgcn_mfma_f32_16x16x32_bf16(aq[kk], bv, acc, 0, 0, 0);
                    }
                }
#pragma unroll
                for (int j = 0; j < 4; ++j) { const int tl = fq * 4 + j, s = st * 16 + fr; *(LAS bf16_t*)(PPW + tl * 144 + s * 2) = (bf16_t)f2bf(s <= tt * 16 + tl ? acc[j] : 0.f); }
            }
            LDS_WAIT();
            unsigned ow[2][2];
            bf16x8 ap[2], ai[4];
#pragma unroll
            for (int kk = 0; kk < 2; ++kk) ap[kk] = *(const LAS bf16x8*)(PPW + fr * 144 + (kk * 32 + fq * 8) * 2);
#pragma unroll
            for (int kk = 0; kk < 4; ++kk) ai[kk] = *(const LAS bf16x8*)(QIN + (tt * 16 + fr) * 272 + (kk * 32 + fq * 8) * 2);
#pragma unroll
            for (int vti = 0; vti < 2; ++vti) {
                const int vt = 2 * (wave & 1) + vti; f32x4 acc = (f32x4){0.f, 0.f, 0.f, 0.f};
#pragma unroll
                for (int kk = 0; kk < 2; ++kk) {
                    const bf16x8 bv = *(const LAS bf16x8*)(VT + (vt * 16 + fr) * 144 + (kk * 32 + fq * 8) * 2);
                    acc = __builtin_amdgcn_mfma_f32_16x16x32_bf16(ap[kk], bv, acc, 0, 0, 0);
                }
#pragma unroll
                for (int kk = 0; kk < 4; ++kk) {
                    const bf16x8 bv = *(const LAS bf16x8*)(STc + (vt * 16 + fr) * 272 + (kk * 32 + fq * 8) * 2);
                    acc = __builtin_amdgcn_mfma_f32_16x16x32_bf16(ai[kk], bv, acc, 0, 0, 0);
                }
                ow[vti][0] = cvt_pk_bf16(acc[0], acc[1]); ow[vti][1] = cvt_pk_bf16(acc[2], acc[3]);
            }
#pragma unroll
            for (int vti = 0; vti < 2; ++vti)
#pragma unroll
                for (int j = 0; j < 4; ++j) { const unsigned w = ow[vti][j >> 1]; *(LAS bf16_t*)(PPW + (fq * 4 + j) * 144 + (vti * 16 + fr) * 2) = (bf16_t)((j & 1) ? (w >> 16) : (w & 0xffffu)); }
            bf16x8 ak[2]; const f32x4 blv = *(const LAS f32x4*)(BL + wave * 16 + fq * 4);
#pragma unroll
            for (int kk = 0; kk < 2; ++kk) ak[kk] = *(const LAS bf16x8*)(KOT + (wave * 16 + fr) * 144 + (((kk * 4 + fq) + wave) & 7) * 16);
#pragma unroll
            for (int vt = 0; vt < 4; ++vt) {
                Sacc[vt] *= blv;
#pragma unroll
                for (int kk = 0; kk < 2; ++kk) {
                    const bf16x8 bv = *(const LAS bf16x8*)(VT + (vt * 16 + fr) * 144 + (kk * 32 + fq * 8) * 2);
                    Sacc[vt] = __builtin_amdgcn_mfma_f32_16x16x32_bf16(ak[kk], bv, Sacc[vt], 0, 0, 0);
                }
                *(LAS u32x2*)(STn + (vt * 16 + fr) * 272 + (wave * 16 + fq * 4) * 2) = (u32x2){pk2(Sacc[vt][0], Sacc[vt][1]), pk2(Sacc[vt][2], Sacc[vt][3])};
            }
            if (n + 1 < 68) GLA_CUMSUM(par ^ 1);
            __syncthreads();
        }
        GLA_OSTORE(67);
    }
}
#undef GLA_OSTORE
#undef GLA_CUMSUM
#undef GLA_LOAD
__device__ __forceinline__ void gla_readout_phase(const Args& a, int lane, int gw, int NGW) {
    const bf16_t* OF = (const bf16_t*)(a.ws + WS_OF); const bf16_t* OB = (const bf16_t*)(a.ws + WS_OB);
    const bf16_t* G = (const bf16_t*)(a.ws + WS_G); bf16_t* OG = (bf16_t*)(a.ws + WS_OG);
    f32x4 ng[4];
#pragma unroll
    for (int j = 0; j < 4; ++j) ng[j] = *(const f32x4*)(a.in[I_HGNG] + 16 * lane + 4 * j);
    for (int row0 = gw * 4; row0 < NTOK; row0 += NGW * 4) {
        u32x4 of[4][2], ob[4][2], gg[4][2];
#pragma unroll
        for (int r = 0; r < 4; ++r) { const size_t o = (size_t)(row0 + r) * D + 16 * lane;
            of[r][0] = *(const u32x4*)(OF + o); of[r][1] = *(const u32x4*)(OF + o + 8); ob[r][0] = *(const u32x4*)(OB + o); ob[r][1] = *(const u32x4*)(OB + o + 8);
            gg[r][0] = *(const u32x4*)(G + o); gg[r][1] = *(const u32x4*)(G + o + 8); }
#pragma unroll
        for (int r = 0; r < 4; ++r) {
            float v[16]; float s = 0.f;
#pragma unroll
            for (int q = 0; q < 8; ++q) { const unsigned wf = of[r][q >> 2][q & 3], wb = ob[r][q >> 2][q & 3]; v[2 * q] = bflo(wf) + bflo(wb); v[2 * q + 1] = bfhi(wf) + bfhi(wb); s += v[2 * q] * v[2 * q] + v[2 * q + 1] * v[2 * q + 1]; }
            s += __shfl_xor(s, 1); s += __shfl_xor(s, 2); s += __shfl_xor(s, 4);
            const float rstd = 1.0f / sqrtf(s * (1.0f / 128.0f) + EPS);
            unsigned ow[8];
#pragma unroll
            for (int q = 0; q < 8; ++q) { const unsigned wg = gg[r][q >> 2][q & 3];
                ow[q] = pk2(v[2 * q] * rstd * ng[q >> 1][(2 * q) & 3] * silu_f(bflo(wg)), v[2 * q + 1] * rstd * ng[q >> 1][(2 * q + 1) & 3] * silu_f(bfhi(wg))); }
            const size_t o = (size_t)(row0 + r) * D + 16 * lane;
            *(u32x4*)(OG + o) = (u32x4){ow[0], ow[1], ow[2], ow[3]}; *(u32x4*)(OG + o + 8) = (u32x4){ow[4], ow[5], ow[6], ow[7]};
        }
    }
}

struct EpiMoe1 {
    static constexpr bool PERM = true;
    const float* b1; bf16_t* ACT;
    __device__ __forceinline__ void operator()(const f32x4 (&acc)[2][2][4][2], const Unit& u, int wr, int wc, int fr, int fq) const {
        const int e = u.pn >> 3, pnl = u.pn & 7, cb = pnl * 128 + wc * 32 + 8 * fq, row0 = u.pm * 256 + wr * 64 + fr;
        const float* bg = b1 + (size_t)e * 2048;
        const f32x4 bg0 = *(const f32x4*)(bg + cb), bg1 = *(const f32x4*)(bg + cb + 4), bl0 = *(const f32x4*)(bg + 1024 + cb), bl1 = *(const f32x4*)(bg + 1024 + cb + 4);
#pragma unroll
        for (int ai = 0; ai < 2; ++ai)
#pragma unroll
            for (int m = 0; m < 4; ++m) {
                f32x4 o[2];
#pragma unroll
                for (int n = 0; n < 2; ++n) {
                    const f32x4 zg = acc[ai][0][m][n] + (n ? bg1 : bg0), zl = acc[ai][1][m][n] + (n ? bl1 : bl0);
#pragma unroll
                    for (int j = 0; j < 4; ++j) { const float g_ = fminf(zg[j], 7.0f), l_ = fminf(fmaxf(zl[j], -7.0f), 7.0f); o[n][j] = g_ * sigmoid_f(1.702f * g_) * (l_ + 1.0f); }
                }
                *(u32x4*)(ACT + (size_t)(row0 + ai * 128 + m * 16) * D + cb) = (u32x4){pk2(o[0][0], o[0][1]), pk2(o[0][2], o[0][3]), pk2(o[1][0], o[1][1]), pk2(o[1][2], o[1][3])};
            }
    }
};
struct EpiMoe2 {
    static constexpr bool PERM = true;
    const float* b2; bf16_t* YS;
    __device__ __forceinline__ void operator()(const f32x4 (&acc)[2][2][4][2], const Unit& u, int wr, int wc, int fr, int fq) const {
        const int e = u.pn >> 2, pnl = u.pn & 3, cb = pnl * 256 + wc * 32 + 8 * fq, row0 = u.pm * 256 + wr * 64 + fr;
        const float* bb = b2 + (size_t)e * 1024;
#pragma unroll
        for (int bj = 0; bj < 2; ++bj) {
            const int c = cb + bj * 128; const f32x4 bv0 = *(const f32x4*)(bb + c), bv1 = *(const f32x4*)(bb + c + 4);
#pragma unroll
            for (int ai = 0; ai < 2; ++ai)
#pragma unroll
                for (int m = 0; m < 4; ++m) {
                    const f32x4 v0 = acc[ai][bj][m][0] + bv0, v1 = acc[ai][bj][m][1] + bv1;
                    *(u32x4*)(YS + (size_t)(row0 + ai * 128 + m * 16) * D + c) = (u32x4){pk2(v0[0], v0[1]), pk2(v0[2], v0[3]), pk2(v1[0], v1[1]), pk2(v1[2], v1[3])};
                }
        }
    }
};

__device__ __forceinline__ void router_phase(const Args& a, LAS unsigned char* lds, int layer, int row_lo, int tid) {
    const int lane = tid & 63, wave = tid >> 6, fr = lane & 15, fq = lane >> 4;
    const bf16_t* H = (const bf16_t*)(a.ws + WS_H); bf16_t* F = (bf16_t*)(a.ws + WS_F);
    const float* modv = (const float*)(a.ws + WS_MODV) + (size_t)layer * 9 * 6144;
    int* TOKE = (int*)(a.ws + WS_TOKE); float* TOKW = (float*)(a.ws + WS_TOKW);
    unsigned* cntb = (unsigned*)(a.ws + WS_CTL) + CW_CNTB + layer * 8192;
    LAS float* FS = (LAS float*)lds;
    LAS float* PART = (LAS float*)(lds + 16 * 1028 * 4);
    LAS int* hist = (LAS int*)(lds + 16 * 1028 * 4 + 16384);
    if (tid < 32) hist[tid] = 0;
    const float* n2g = a.in[I_N2G] + layer * D; const float* rw = a.in[I_RW] + (size_t)layer * D * NE; const float* rb = a.in[I_RB] + layer * NE;
    float rwr[2][32];
#pragma unroll
    for (int s = 0; s < 32; ++s) { rwr[0][s] = rw[(size_t)(wave * 128 + 4 * s + fq) * NE + fr]; rwr[1][s] = rw[(size_t)(wave * 128 + 4 * s + fq) * NE + 16 + fr]; }
    const int ngroups = (NTOK - row_lo) >> 4;
    f32x4 vv[2][4], gvv[4], scvv[4], shvv[4];
#pragma unroll
    for (int j = 0; j < 4; ++j) gvv[j] = *(const f32x4*)(n2g + 4 * lane + 256 * j);
#define RT_LOAD(gi_) do { _Pragma("unroll") for (int rr = 0; rr < 2; ++rr) _Pragma("unroll") for (int j = 0; j < 4; ++j) \
        vv[rr][j] = ld_bf16x4(H + (size_t)(row_lo + (gi_) * 16 + 2 * wave + rr) * D + 4 * lane + 256 * j); \
        { const float* mvp_ = modv + (size_t)mod_row(row_lo + (gi_) * 16) * 6144; _Pragma("unroll") for (int j = 0; j < 4; ++j) { scvv[j] = *(const f32x4*)(mvp_ + 4096 + 4 * lane + 256 * j); shvv[j] = *(const f32x4*)(mvp_ + 3072 + 4 * lane + 256 * j); } } } while (0)
    if ((int)blockIdx.x < ngroups) RT_LOAD(blockIdx.x);
    int pend_i = 0; float pend_w = 0.f; long pend_o = -1;
    for (int gi = blockIdx.x; gi < ngroups; gi += gridDim.x) {
        const int row0 = row_lo + gi * 16;
        __syncthreads();
#pragma unroll
        for (int rr = 0; rr < 2; ++rr) {
            const int rl = 2 * wave + rr, row = row0 + rl; const f32x4 (&v)[4] = vv[rr];
            const float rstd = row_rstd(v);
#pragma unroll
            for (int j = 0; j < 4; ++j) {
                const int c = 4 * lane + 256 * j;
                const f32x4 f = v[j] * rstd * gvv[j] * (scvv[j] + 1.0f) + shvv[j];
                st_bf16x4(F + (size_t)row * D + c, f);
                *(LAS f32x4*)(FS + rl * 1028 + c) = f;
            }
        }
        if (pend_o >= 0) { TOKE[pend_o] = pend_i; TOKW[pend_o] = pend_w; pend_o = -1; }
        if (gi + (int)gridDim.x < ngroups) RT_LOAD(gi + gridDim.x);
        __syncthreads();
        f32x4 acc0 = (f32x4){0.f, 0.f, 0.f, 0.f}, acc1 = (f32x4){0.f, 0.f, 0.f, 0.f};
#pragma unroll
        for (int s = 0; s < 32; ++s) {
            const float av = FS[fr * 1028 + wave * 128 + 4 * s + fq];
            acc0 = __builtin_amdgcn_mfma_f32_16x16x4f32(av, rwr[0][s], acc0, 0, 0, 0);
            acc1 = __builtin_amdgcn_mfma_f32_16x16x4f32(av, rwr[1][s], acc1, 0, 0, 0);
        }
#pragma unroll
        for (int j = 0; j < 4; ++j) { PART[(wave * 16 + fq * 4 + j) * 32 + fr] = acc0[j]; PART[(wave * 16 + fq * 4 + j) * 32 + 16 + fr] = acc1[j]; }
        __syncthreads();
        {
            const int half = lane >> 5, e = lane & 31, rl = 2 * wave + half, row = row0 + rl;
            float lg = rb[e];
#pragma unroll
            for (int w = 0; w < 8; ++w) lg += PART[(w * 16 + rl) * 32 + e];
            float sv[4]; int si[4];
#pragma unroll
            for (int r = 0; r < 4; ++r) {
                float m = lg;
#pragma unroll
                for (int o = 1; o < 32; o <<= 1) m = fmaxf(m, __shfl_xor(m, o));
                const unsigned long long bal = __ballot(lg == m); const unsigned mine = (unsigned)(bal >> (32 * half));
                const int idx = __ffs((int)mine) - 1;
                sv[r] = m; si[r] = idx; if (e == idx) lg = -3.0e38f;
            }
            const float e1 = __expf(sv[1] - sv[0]), e2 = __expf(sv[2] - sv[0]), e3 = __expf(sv[3] - sv[0]); const float inv = 1.0f / (1.0f + e1 + e2 + e3);
            if (e < 4) {
                const int myi = e == 0 ? si[0] : (e == 1 ? si[1] : (e == 2 ? si[2] : si[3]));
                const float myw = (e == 0 ? 1.0f : (e == 1 ? e1 : (e == 2 ? e2 : e3))) * inv;
                pend_i = myi; pend_w = myw; pend_o = (long)row * 4 + e;
                atomicAdd((int*)hist + myi, 1);
            }
        }
    }
    if (pend_o >= 0) { TOKE[pend_o] = pend_i; TOKW[pend_o] = pend_w; }
    __syncthreads();
    if (tid < 32) cntb[(size_t)blockIdx.x * 32 + tid] = (unsigned)hist[tid];
}
#undef RT_LOAD
__device__ __forceinline__ void assign_phase(const Args& a, LAS unsigned char* lds, int layer, int row_lo, int tid) {
    const int lane = tid & 63, wave = tid >> 6;
    const unsigned* cntb = (const unsigned*)(a.ws + WS_CTL) + CW_CNTB + layer * 8192; unsigned* gcnt = (unsigned*)(a.ws + WS_CTL) + CW_CNT + layer * 64;
    const bf16_t* F = (const bf16_t*)(a.ws + WS_F); bf16_t* AG = (bf16_t*)(a.ws + WS_AG);
    const int* TOKE = (const int*)(a.ws + WS_TOKE); int* TOKS = (int*)(a.ws + WS_TOKS);
    LAS int* off = (LAS int*)lds; LAS int* cnt = (LAS int*)(lds + 256); LAS int* base = (LAS int*)(lds + 512); LAS int* cur = (LAS int*)(lds + 768);
    LAS int* pa = (LAS int*)(lds + 1024); LAS int* pl = (LAS int*)(lds + 1024 + 2048);
    {
        const int e = tid & 31, part = tid >> 5; int s_all = 0, s_lt = 0;
        for (int bb = part; bb < (int)gridDim.x; bb += 16) { const int c = (int)cntb[(size_t)bb * 32 + e]; s_all += c; if (bb < (int)blockIdx.x) s_lt += c; }
        pa[part * 32 + e] = s_all; pl[part * 32 + e] = s_lt;
    }
    __syncthreads();
    if (tid < 32) { int s_all = 0, s_lt = 0; for (int p = 0; p < 16; ++p) { s_all += pa[p * 32 + tid]; s_lt += pl[p * 32 + tid]; } cnt[tid] = s_all; base[tid] = s_lt; cur[tid] = 0; if (blockIdx.x == 0) gcnt[tid] = (unsigned)s_all; }
    __syncthreads();
    if (tid == 0) { int o = 0; for (int e = 0; e < 32; ++e) { off[e] = o; o += ((cnt[e] + 255) >> 8) << 8; } }
    __syncthreads();
    if (tid < 32) base[tid] += off[tid];
    __syncthreads();
    const int gw = blockIdx.x * 8 + wave, NGW = gridDim.x * 8;
    int* SLOTTOK = (int*)(a.ws + WS_SLOTTOK);
    for (int idx = blockIdx.x * NTHREADS + tid; idx < 32 * 256; idx += gridDim.x * NTHREADS) {
        const int e = idx >> 8, c = cnt[e], r = c + (idx & 255), padded = ((c + 255) >> 8) << 8;
        if (r < padded) SLOTTOK[off[e] + r] = 0;
    }
    const int ngroups = (NTOK - row_lo) >> 4;
    for (int gi = blockIdx.x; gi < ngroups; gi += gridDim.x) {
        const int r0 = row_lo + gi * 16 + 2 * wave;
        if (lane < 8) { const int e = TOKE[(size_t)r0 * 4 + lane]; const int pos = atomicAdd((int*)cur + e, 1); const int slot = base[e] + pos; TOKS[(size_t)r0 * 4 + lane] = slot; SLOTTOK[slot] = r0 + (lane >> 2); }
    }
    (void)gw; (void)NGW; (void)F; (void)AG;
}
__device__ __forceinline__ int moe_tiles(const Args& a, LAS unsigned char* lds, int layer, int tid) {
    const unsigned* gcnt = (const unsigned*)(a.ws + WS_CTL) + CW_CNT + layer * 64;
    LAS int* tbl = (LAS int*)(lds + 131072 + 1024);
    if (tid == 0) { int t = 0; for (int e = 0; e < 32; ++e) { const int nt = ((int)gcnt[e] + 255) >> 8; for (int k = 0; k < nt; ++k) tbl[t++] = e; } tbl[1000] = t; }
    __syncthreads();
    return tbl[1000];
}
__device__ __forceinline__ void combine_phase(const Args& a, int layer, int row_lo, int lane, int gw, int NGW) {
    bf16_t* H = (bf16_t*)(a.ws + WS_H); const bf16_t* YS = (const bf16_t*)(a.ws + WS_YS);
    const int* TOKS = (const int*)(a.ws + WS_TOKS); const float* TOKW = (const float*)(a.ws + WS_TOKW);
    const float* modv = (const float*)(a.ws + WS_MODV);
    for (int row0 = row_lo + gw * 2; row0 < NTOK; row0 += NGW * 2) {
        const int mr = mod_row(row0);
        u32x4 sl[2]; f32x4 wv[2];
#pragma unroll
        for (int r = 0; r < 2; ++r) { sl[r] = *(const u32x4*)(TOKS + (size_t)(row0 + r) * 4); wv[r] = *(const f32x4*)(TOKW + (size_t)(row0 + r) * 4); }
        u32x2 ys[2][4][4]; f32x4 hv[2][4];
#pragma unroll
        for (int r = 0; r < 2; ++r)
#pragma unroll
            for (int j = 0; j < 4; ++j) {
                hv[r][j] = ld_bf16x4(H + (size_t)(row0 + r) * D + 4 * lane + 256 * j);
#pragma unroll
                for (int k = 0; k < 4; ++k) ys[r][k][j] = *(const u32x2*)(YS + (size_t)sl[r][k] * D + 4 * lane + 256 * j);
            }
        const float* g2 = modv + (size_t)(layer * 9 + mr) * 6144 + 5120;
        f32x4 g2v[4];
#pragma unroll
        for (int j = 0; j < 4; ++j) g2v[j] = *(const f32x4*)(g2 + 4 * lane + 256 * j);
        ModVec m;
        if (layer == 0) { const float* mv = modv + (size_t)(9 + mr) * 6144; modvec_load(m, a.in[I_N1G] + D, mv + 1024, mv, lane); }
        else {
#pragma unroll
            for (int j = 0; j < 4; ++j) m.g[j] = *(const f32x4*)(a.in[I_FG] + 4 * lane + 256 * j);
        }
#pragma unroll
        for (int r = 0; r < 2; ++r) {
            const int row = row0 + r; f32x4 v[4];
#pragma unroll
            for (int j = 0; j < 4; ++j) {
                const int c = 4 * lane + 256 * j; f32x4 y = (f32x4){0.f, 0.f, 0.f, 0.f};
#pragma unroll
                for (int k = 0; k < 4; ++k) { const u32x2 w = ys[r][k][j]; y += (f32x4){bflo(w.x), bfhi(w.x), bflo(w.y), bfhi(w.y)} * wv[r][k]; }
                v[j] = hv[r][j] + g2v[j] * y;
                if (layer == 0) st_bf16x4(H + (size_t)row * D + c, v[j]);
            }
            const float rstd = row_rstd(v);
            if (layer == 0) {
                int orow = row;
                if (row >= NCTX) { const int li = row - NCTX, b = li >> 12, t = li & 4095; orow = NCTX + b * SEQ + (t & 63) * 64 + (t >> 6); }
                norm_mod_store(v, rstd, m, (bf16_t*)(a.ws + WS_A) + (size_t)orow * D, lane);
            } else {
#pragma unroll
                for (int j = 0; j < 4; ++j) { const int c = 4 * lane + 256 * j; *(f32x4*)(a.out + (size_t)(row - NCTX) * D + c) = v[j] * rstd * m.g[j]; }
            }
        }
    }
}
__device__ __forceinline__ void moe_gemm1(const Args& a, LAS unsigned char* lds, int layer, int tid, int G, int vcu) {
    unsigned char* ws = a.ws;
    const int TT = moe_tiles(a, lds, layer, tid);
    const LAS int* tbl = (const LAS int*)(lds + 131072 + 1024);
    pg8::Gemm g{(const bf16_t*)(ws + WS_F), (const bf16_t*)(ws + WS_W1) + (size_t)layer * 32 * 2048 * 1024, MPAD, 32 * 2048, 1024};
    pg8::MoeOrder S{tbl, TT, 3, G, vcu};
    EpiMoe1 E{a.in[I_B1] + (size_t)layer * 32 * 2048, (bf16_t*)(ws + WS_ACT)};
    pg8::gemm_phase<EpiMoe1, pg8::MoeOrder, true>(lds, g, S, E, (const int*)(ws + WS_SLOTTOK));
}
__device__ __forceinline__ void moe_gemm2(const Args& a, LAS unsigned char* lds, int layer, int tid, int G, int vcu) {
    unsigned char* ws = a.ws;
    const int TT = moe_tiles(a, lds, layer, tid);
    const LAS int* tbl = (const LAS int*)(lds + 131072 + 1024);
    pg8::Gemm g{(const bf16_t*)(ws + WS_ACT), (const bf16_t*)(ws + WS_W2) + (size_t)layer * 32 * 1024 * 1024, MPAD, 32 * 1024, 1024};
    pg8::MoeOrder S{tbl, TT, 2, G, vcu};
    EpiMoe2 E{a.in[I_B2] + (size_t)layer * 32 * 1024, (bf16_t*)(ws + WS_YS)};
    pg8::gemm_phase<EpiMoe2, pg8::MoeOrder>(lds, g, S, E);
}


__device__ __forceinline__ void s5_disc(const Args& a, int d, int g, int p, float& ab_re, float& ab_im, float& co_re, float& co_im) {
    const float lam_re = fminf(a.in[I_S5ARE][(d * 64 + g) * 64 + p], -1e-4f), lam_im = a.in[I_S5AIM][(d * 64 + g) * 64 + p];
    const float dt = expf(a.in[I_S5LDT][d * 64 + g]);
    const float mag = expf(lam_re * dt), ang = lam_im * dt;
    ab_re = mag * cosf(ang); ab_im = mag * sinf(ang);
    const float den = lam_re * lam_re + lam_im * lam_im;
    co_re = ((ab_re - 1.0f) * lam_re + ab_im * lam_im) / den;
    co_im = (ab_im * lam_re - (ab_re - 1.0f) * lam_im) / den;
}
__device__ __forceinline__ void s5_phase(const Args& a, LAS unsigned char* lds, int tid) {
    const int lane = tid & 63, wave = tid >> 6, fr = lane & 15, fq = lane >> 4;
    if (wave >= 4) {
        LAS unsigned* scr = (LAS unsigned*)(lds + 102400 + (wave - 4) * 8320);
        const int cw = blockIdx.x * 4 + (wave - 4), NCW = gridDim.x * 4;
#define L1_ITEM(i) moe_item(a, (i), 1)
        TR_LOOP(cw, NCW, 32 * 512 + 32 * 256, L1_ITEM);
#undef L1_ITEM
        return;
    }
    LAS unsigned char* wl = lds + wave * 25600;
    const bf16_t* A1 = (const bf16_t*)(a.ws + WS_A);
    for (int item = blockIdx.x; item < 256; item += gridDim.x) {
        const int b = item >> 5, dir = (item >> 4) & 1, g = (item & 15) * 4 + wave;
        bf16_t* Y = (bf16_t*)(a.ws + (dir ? WS_YB : WS_YF));
        float ab_re, ab_im, cr_, ci_;
        s5_disc(a, dir, g, lane, ab_re, ab_im, cr_, ci_);
        bf16x8 Bd[8], Cf[4];
        {
            f32x4 cre[4], cim[4];
#pragma unroll
            for (int kk = 0; kk < 4; ++kk) { const size_t o = ((size_t)(dir * 64 + g) * 16 + fr) * 64 + kk * 16 + fq * 4; cre[kk] = *(const f32x4*)(a.in[I_S5CRE] + o); cim[kk] = *(const f32x4*)(a.in[I_S5CIM] + o); }
#pragma unroll
            for (int kk = 0; kk < 4; ++kk)
#pragma unroll
                for (int j = 0; j < 8; ++j) Cf[kk][j] = (short)f2bf((j & 1) ? -cim[kk][j >> 1] : cre[kk][j >> 1]);
#pragma unroll
            for (int hg = 0; hg < 2; ++hg) {
                f32x4 br0[4], br1[4], bi0[4], bi1[4];
#pragma unroll
                for (int q = 0; q < 4; ++q) {
                    const int pp = (hg * 4 + q) * 8 + (fr >> 1); const size_t o = (size_t)(g * 64 + pp) * 16 + (fq & 1) * 8;
                    br0[q] = *(const f32x4*)(a.in[I_S5BRE] + o); br1[q] = *(const f32x4*)(a.in[I_S5BRE] + o + 4); bi0[q] = *(const f32x4*)(a.in[I_S5BIM] + o); bi1[q] = *(const f32x4*)(a.in[I_S5BIM] + o + 4);
                }
#pragma unroll
                for (int q = 0; q < 4; ++q) {
                    const int pt = hg * 4 + q, pp = pt * 8 + (fr >> 1); const float qr = __shfl(cr_, pp), qi = __shfl(ci_, pp);
#pragma unroll
                    for (int j = 0; j < 8; ++j) {
                        const float br = j < 4 ? br0[q][j & 3] : br1[q][j & 3], bi = j < 4 ? bi0[q][j & 3] : bi1[q][j & 3];
                        float v = (fr & 1) ? (qr * bi + qi * br) : (qr * br - qi * bi);
                        if (fq >= 2) v = 0.f;
                        Bd[pt][j] = (short)f2bf(v);
                    }
                }
                asm volatile("" ::: "memory");
            }
        }
#define S5_POS(n_, t_) ((((n_) < 8) ? (n_) : (n_) - 8) * 32 + (t_))
#define S5_ROW(n_, t_) ((((n_) < 8) ? b * CTXL : NCTX + b * SEQ) + (dir ? (((n_) < 8) ? CTXL : SEQ) - 1 - S5_POS(n_, t_) : S5_POS(n_, t_)))
#define S5_LOADU(d0, d1, n_) do { d0 = (bf16x8){0, 0, 0, 0, 0, 0, 0, 0}; d1 = d0; if (fq < 2 && (n_) < 136) { d0 = *(const bf16x8*)(A1 + (size_t)S5_ROW(n_, fr) * D + g * 16 + fq * 8); d1 = *(const bf16x8*)(A1 + (size_t)S5_ROW(n_, 16 + fr) * D + g * 16 + fq * 8); } } while (0)
        LAS float* BUF = (LAS float*)wl; LAS unsigned* HW = (LAS unsigned*)(wl + 16896); const LAS unsigned char* HP = wl + 16896;
        bf16x8 ua0, ua1, ub0, ub1;
        S5_LOADU(ua0, ua1, 0);
        f32x2 s = (f32x2){0.f, 0.f};
        const f32x2 abr = (f32x2){ab_re, ab_re}, abi = (f32x2){-ab_im, ab_im};
        bf16_t* yp = Y + (size_t)(b * SEQ + (dir ? SEQ - 1 - fq * 4 : fq * 4)) * D + g * 16 + fr;
        const long ystep = dir ? -(long)D : (long)D;
        unsigned yw[4] = {0u, 0u, 0u, 0u};
#define S5_YSTORE() do { yp[0] = (bf16_t)(yw[0] & 0xffffu); yp[ystep] = (bf16_t)(yw[0] >> 16); yp[2 * ystep] = (bf16_t)(yw[1] & 0xffffu); yp[3 * ystep] = (bf16_t)(yw[1] >> 16); \
            yp[16 * ystep] = (bf16_t)(yw[2] & 0xffffu); yp[17 * ystep] = (bf16_t)(yw[2] >> 16); yp[18 * ystep] = (bf16_t)(yw[3] & 0xffffu); yp[19 * ystep] = (bf16_t)(yw[3] >> 16); yp += 32 * ystep; } while (0)
        for (int n = 0; n < 136; ++n) {
#pragma unroll
            for (int hf = 0; hf < 2; ++hf)
#pragma unroll
                for (int pt = 0; pt < 8; ++pt) {
                    const f32x4 z = (f32x4){0.f, 0.f, 0.f, 0.f};
                    const f32x4 d = __builtin_amdgcn_mfma_f32_16x16x32_bf16(hf ? ua1 : ua0, Bd[pt], z, 0, 0, 0);
#pragma unroll
                    for (int j = 0; j < 4; ++j) BUF[(hf * 16 + fq * 4 + j) * 132 + pt * 16 + fr] = d[j];
                }
            if (n >= 9) S5_YSTORE();
            S5_LOADU(ub0, ub1, n + 1);
            LDS_WAIT();
            {
                const bool hist = n >= 8;
                f32x2 bu[32];
#pragma unroll
                for (int j = 0; j < 32; ++j) bu[j] = *(const LAS f32x2*)(BUF + j * 132 + 2 * lane);
                unsigned hw[32];
#pragma unroll
                for (int j = 0; j < 32; ++j) { const f32x2 t1 = abr * s + bu[j]; s = abi * (f32x2){s.y, s.x} + t1; hw[j] = cvt_pk_bf16(s.x, s.y); }
                if (hist) {
#pragma unroll
                    for (int j = 0; j < 32; ++j) HW[j * 68 + lane] = hw[j];
                }
            }
            LDS_WAIT();
            if (n >= 8) {
                f32x4 y0 = (f32x4){0.f, 0.f, 0.f, 0.f}, y1 = (f32x4){0.f, 0.f, 0.f, 0.f};
                bf16x8 ha[2][4];
#pragma unroll
                for (int hf = 0; hf < 2; ++hf)
#pragma unroll
                    for (int kk = 0; kk < 4; ++kk) ha[hf][kk] = *(const LAS bf16x8*)(HP + (hf * 16 + fr) * 272 + (kk * 32 + fq * 8) * 2);
#pragma unroll
                for (int kk = 0; kk < 4; ++kk) { y0 = __builtin_amdgcn_mfma_f32_16x16x32_bf16(ha[0][kk], Cf[kk], y0, 0, 0, 0); y1 = __builtin_amdgcn_mfma_f32_16x16x32_bf16(ha[1][kk], Cf[kk], y1, 0, 0, 0); }
                yw[0] = cvt_pk_bf16(y0[0], y0[1]); yw[1] = cvt_pk_bf16(y0[2], y0[3]); yw[2] = cvt_pk_bf16(y1[0], y1[1]); yw[3] = cvt_pk_bf16(y1[2], y1[3]);
                LDS_WAIT();
            }
            ua0 = ub0; ua1 = ub1;
        }
        S5_YSTORE();
#undef S5_YSTORE
#undef S5_POS
#undef S5_ROW
#undef S5_LOADU
    }
}
__device__ __forceinline__ float gelu_tanh_f(float x) { const float z = 0.7978845608f * (x + 0.044715f * x * x * x); return x * (1.0f - __builtin_amdgcn_rcpf(1.0f + __expf(2.0f * z))); }
__device__ __forceinline__ void s5_post_phase(const Args& a, int lane, int gw, int NGW) {
    const bf16_t* YF = (const bf16_t*)(a.ws + WS_YF); const bf16_t* YB = (const bf16_t*)(a.ws + WS_YB);
    const bf16_t* A1 = (const bf16_t*)(a.ws + WS_A); bf16_t* YG = (bf16_t*)(a.ws + WS_YG);
    f32x4 dk[4];
#pragma unroll
    for (int j = 0; j < 4; ++j) dk[j] = *(const f32x4*)(a.in[I_S5D] + 4 * lane + 256 * j);
    for (int tok0 = gw * 4; tok0 < NLAT; tok0 += NGW * 4) {
        u32x2 yf[4][4], yb[4][4], uu[4][4];
#pragma unroll
        for (int r = 0; r < 4; ++r) { const int tok = tok0 + r, b = tok >> 12, t = tok & 4095, src = b * SEQ + (t & 63) * 64 + (t >> 6);
#pragma unroll
            for (int j = 0; j < 4; ++j) { const int c = 4 * lane + 256 * j; yf[r][j] = *(const u32x2*)(YF + (size_t)src * D + c); yb[r][j] = *(const u32x2*)(YB + (size_t)src * D + c); uu[r][j] = *(const u32x2*)(A1 + (size_t)(NCTX + src) * D + c); } }
#pragma unroll
        for (int r = 0; r < 4; ++r)
#pragma unroll
            for (int j = 0; j < 4; ++j) {
                const u32x2 f = yf[r][j], bk = yb[r][j], uw = uu[r][j];
                const f32x4 y = (f32x4){bflo(f.x) + bflo(bk.x), bfhi(f.x) + bfhi(bk.x), bflo(f.y) + bflo(bk.y), bfhi(f.y) + bfhi(bk.y)} + dk[j] * (f32x4){bflo(uw.x), bfhi(uw.x), bflo(uw.y), bfhi(uw.y)};
                f32x4 o;
#pragma unroll
                for (int i = 0; i < 4; ++i) o[i] = gelu_tanh_f(y[i]);
                st_bf16x4(YG + (size_t)(tok0 + r) * D + 4 * lane + 256 * j, o);
            }
    }
}
struct EpiGlu {
    static constexpr bool PERM = true;
    const float* bglu; const float* modv1; bf16_t* H;
    __device__ __forceinline__ void operator()(const f32x4 (&acc)[2][2][4][2], const Unit& u, int wr, int wc, int fr, int fq) const {
        const int rt0 = u.pm * 256, bidx = rt0 >> 12, cb = u.pn * 128 + wc * 32 + 8 * fq, rl0 = wr * 64 + fr;
        const float* gp = modv1 + bidx * 6144 + 2048;
        const f32x4 ba0 = *(const f32x4*)(bglu + cb), ba1 = *(const f32x4*)(bglu + cb + 4), bb0 = *(const f32x4*)(bglu + 1024 + cb), bb1 = *(const f32x4*)(bglu + 1024 + cb + 4);
        const f32x4 gv0 = *(const f32x4*)(gp + cb), gv1 = *(const f32x4*)(gp + cb + 4);
        u32x4 hws[2][4];
#pragma unroll
        for (int ai = 0; ai < 2; ++ai)
#pragma unroll
            for (int m = 0; m < 4; ++m) hws[ai][m] = *(const u32x4*)(H + (size_t)(NCTX + rt0 + rl0 + ai * 128 + m * 16) * D + cb);
#pragma unroll
        for (int ai = 0; ai < 2; ++ai)
#pragma unroll
            for (int m = 0; m < 4; ++m) {
                bf16_t* hp = H + (size_t)(NCTX + rt0 + rl0 + ai * 128 + m * 16) * D + cb;
                const u32x4 hw = hws[ai][m]; const f32x4 h0 = (f32x4){bflo(hw.x), bfhi(hw.x), bflo(hw.y), bfhi(hw.y)}, h1 = (f32x4){bflo(hw.z), bfhi(hw.z), bflo(hw.w), bfhi(hw.w)};
                const f32x4 za0 = acc[ai][0][m][0] + ba0, za1 = acc[ai][0][m][1] + ba1, zb0 = acc[ai][1][m][0] + bb0, zb1 = acc[ai][1][m][1] + bb1; f32x4 o0, o1;
#pragma unroll
                for (int j = 0; j < 4; ++j) { o0[j] = za0[j] * sigmoid_f(zb0[j]); o1[j] = za1[j] * sigmoid_f(zb1[j]); }
                const f32x4 r0 = h0 + gv0 * o0, r1 = h1 + gv1 * o1;
                *(u32x4*)hp = (u32x4){pk2(r0[0], r0[1]), pk2(r0[2], r0[3]), pk2(r1[0], r1[1]), pk2(r1[2], r1[3])};
            }
    }
};

#define XB_TMO      128
#define XB_XCNT(j)  (256  + 64 * (j))
#define XB_XSUB(j)  (1280 + 64 * (j))
#define XB_XGEN(j)  (2304 + 64 * (j))
#define XB_TOP      3328
#define XB_TOPGEN   3392
#define XCD_BAR_WORDS 3456
#define XB_SPIN_CAP (1u << 18)
__device__ __forceinline__ unsigned xb_ld(unsigned* p)              { return __hip_atomic_load(p, __ATOMIC_RELAXED, __HIP_MEMORY_SCOPE_AGENT); }
__device__ __forceinline__ unsigned xb_add(unsigned* p, unsigned v) { return __hip_atomic_fetch_add(p, v, __ATOMIC_RELAXED, __HIP_MEMORY_SCOPE_AGENT); }
__device__ __forceinline__ unsigned xb_xcc_id() { return (unsigned)__builtin_amdgcn_s_getreg((3 << 11) | 20) & 0xFu; }
#define XB_SPIN(cond, bar) do { unsigned _sp = 0; while (cond) { __builtin_amdgcn_s_sleep(1); \
    if ((++_sp & 255u) == 0u) { if (xb_ld(&(bar)[XB_TMO])) break; if (_sp > XB_SPIN_CAP) { atomicAdd(&(bar)[XB_TMO], 1u); break; } } } } while (0)
struct XcdBarrier { unsigned* bar; unsigned x; volatile LAS unsigned* st; };
__device__ __forceinline__ XcdBarrier xcd_barrier_post(unsigned* bar, volatile LAS unsigned* st) {
    XcdBarrier b; b.bar = bar; b.x = xb_xcc_id(); b.st = st;
    if (threadIdx.x == 0) (void)xb_add(&bar[XB_XCNT(b.x)], 1u);
    return b;
}
__device__ __forceinline__ void xcd_barrier_complete(unsigned* bar, unsigned x, unsigned& nloc, unsigned& nx) {
    const unsigned G = gridDim.x * gridDim.y * gridDim.z;
    unsigned sum, cnt, mine, sp = 0u;
    for (;;) {
        sum = 0u; cnt = 0u; mine = 0u;
#pragma unroll
        for (unsigned j = 0; j < 16; ++j) { const unsigned c = xb_ld(&bar[XB_XCNT(j)]); sum += c; cnt += (c > 0u) ? 1u : 0u; mine = (j == x) ? c : mine; }
        if (sum == G) break;
        __builtin_amdgcn_s_sleep(1);
        if ((++sp & 255u) == 0u) { if (xb_ld(&bar[XB_TMO])) break; if (sp > XB_SPIN_CAP) { atomicAdd(&bar[XB_TMO], 1u); break; } }
    }
    nloc = mine > 0u ? mine : 1u; nx = cnt > 0u ? cnt : 1u;
}
__device__ __forceinline__ void xcd_barrier(const XcdBarrier& b) {
    asm volatile("s_waitcnt vmcnt(0)" ::: "memory");
    __syncthreads();
    if (threadIdx.x == 0) {
        unsigned* bar = b.bar;
        __builtin_amdgcn_s_waitcnt(0);
        unsigned nloc = b.st[0], nx = b.st[1];
        if (nloc == 0u) { xcd_barrier_complete(bar, b.x, nloc, nx); b.st[0] = nloc; b.st[1] = nx; }
        const unsigned old = xb_add(&bar[XB_XSUB(b.x)], 1u);
        const unsigned gen = old / nloc;
        if (old + 1u == (gen + 1u) * nloc) {
            __builtin_amdgcn_fence(__ATOMIC_RELEASE, "agent");
            asm volatile("s_waitcnt vmcnt(0)" ::: "memory");
            const unsigned og = xb_add(&bar[XB_TOP], 1u);
            const unsigned tg = og / nx;
            if (og + 1u == (tg + 1u) * nx) xb_add(&bar[XB_TOPGEN], 1u);
            else XB_SPIN(xb_ld(&bar[XB_TOPGEN]) == tg, bar);
            __builtin_amdgcn_fence(__ATOMIC_ACQUIRE, "agent");
            xb_add(&bar[XB_XGEN(b.x)], 1u);
            asm volatile("s_waitcnt vmcnt(0)" ::: "memory");
        } else {
            XB_SPIN(xb_ld(&bar[XB_XGEN(b.x)]) == gen, bar);
            __builtin_amdgcn_fence(__ATOMIC_ACQUIRE, "agent");
            asm volatile("s_waitcnt vmcnt(0)" ::: "memory");
        }
    }
    __syncthreads();
}

__device__ __forceinline__ int opaque_tid() { int t = threadIdx.x; asm volatile("" : "+v"(t)); return t; }
#define PHASE_IDS() const int tid = opaque_tid(); const int lane = tid & 63, wave = tid >> 6; const int G = gridDim.x, gw = blockIdx.x * 8 + wave, NGW = G * 8; \
    const int vcu = (G % 8 == 0) ? (int)(blockIdx.x % 8) * (G / 8) + (int)(blockIdx.x / 8) : (int)blockIdx.x; (void)lane; (void)wave; (void)gw; (void)NGW; (void)vcu; (void)G
__global__ void __launch_bounds__(NTHREADS, 2) fwd_mega(Args a) {
    extern __shared__ __attribute__((aligned(16))) unsigned char lds_raw[];
    LAS unsigned char* lds = (LAS unsigned char*)lds_raw;
    cg::grid_group grid = cg::this_grid();
    unsigned char* ws = a.ws;
    if (threadIdx.x < 2) ((LAS unsigned*)(lds + LDS_BYTES - 16))[threadIdx.x] = 0u;
    __syncthreads();
    const XcdBarrier xbar = xcd_barrier_post((unsigned*)(ws + WS_CTL) + CW_BAR, (volatile LAS unsigned*)(lds + LDS_BYTES - 16));
#ifdef TS_SEL
    volatile LAS unsigned long long* tsbuf = (volatile LAS unsigned long long*)(lds + LDS_BYTES - 16 - 256);
    int tsn = 0;
#define TS_MARK() do { if (blockIdx.x == 0 && threadIdx.x == 0) tsbuf[tsn] = __builtin_amdgcn_s_memrealtime(); ++tsn; } while (0)
#else
#define TS_MARK() do { } while (0)
#endif
    TS_MARK();
#define GSYNC() do { xcd_barrier(xbar); TS_MARK(); } while (0)

    for (int rep = 0; rep < REP_P0; ++rep) { PHASE_IDS(); p0_phase(a, lds, tid, gw, NGW); if (REP_P0 > 1) __syncthreads(); }
    if (a.pad1 != 0) grid.sync();
    GSYNC();
    for (int rep = 0; rep < REP_P1; ++rep) { PHASE_IDS(); p1_phase(a, lane, gw, NGW); }
    GSYNC();
    {
        PHASE_IDS();
        pg8::Gemm g{(const bf16_t*)(ws + WS_A), (const bf16_t*)(ws + WS_WIN), NTOK, 5120, 1024};
        pg8::StaticOrder S; S.init(NTOK, 5120, G, (int)blockIdx.x);
        EpiInProj E{(bf16_t*)(ws + WS_Q), (bf16_t*)(ws + WS_V), (bf16_t*)(ws + WS_G), (_Float16*)(ws + WS_LFF), (_Float16*)(ws + WS_LFB), (const float*)(ws + WS_LBV)};
        for (int rep = 0; rep < REP_INP; ++rep) pg8::gemm_phase<EpiInProj, pg8::StaticOrder>(lds, g, S, E);
    }
    GSYNC();
    for (int rep = 0; rep < REP_GLA; ++rep) { PHASE_IDS(); gla_phase(a, lds, tid); if (REP_GLA > 1) __syncthreads(); }
    GSYNC();
    for (int rep = 0; rep < REP_RO; ++rep) { PHASE_IDS(); gla_readout_phase(a, lane, gw, NGW); }
    GSYNC();
    {
        PHASE_IDS();
        pg8::Gemm g{(const bf16_t*)(ws + WS_OG), (const bf16_t*)(ws + WS_WOUT), NTOK, 1024, 1024};
        pg8::StaticOrder S; S.init(NTOK, 1024, G, (int)blockIdx.x);
        EpiResid E{a.in[I_X], a.in[I_CTX], (const float*)(ws + WS_MODV), (bf16_t*)(ws + WS_H), 2048};
        for (int rep = 0; rep < REP_OUT; ++rep) pg8::gemm_phase<EpiResid, pg8::StaticOrder>(lds, g, S, E);
    }
    GSYNC();
    for (int rep = 0; rep < REP_RT; ++rep) { PHASE_IDS(); router_phase(a, lds, 0, 0, tid); if (REP_RT > 1) __syncthreads(); }
    GSYNC();
    for (int rep = 0; rep < REP_AS; ++rep) { PHASE_IDS(); assign_phase(a, lds, 0, 0, tid); if (REP_AS > 1) __syncthreads(); }
    GSYNC();
    for (int rep = 0; rep < REP_M1; ++rep) { PHASE_IDS(); moe_gemm1(a, lds, 0, tid, G, vcu); }
    GSYNC();
    for (int rep = 0; rep < REP_M2; ++rep) { PHASE_IDS(); moe_gemm2(a, lds, 0, tid, G, vcu); }
    GSYNC();
    { PHASE_IDS(); combine_phase(a, 0, 0, lane, gw, NGW); }
    GSYNC();
    for (int rep = 0; rep < REP_S5; ++rep) { PHASE_IDS(); s5_phase(a, lds, tid); if (REP_S5 > 1) __syncthreads(); }
    GSYNC();
    for (int rep = 0; rep < REP_POST; ++rep) { PHASE_IDS(); s5_post_phase(a, lane, gw, NGW); }
    GSYNC();
    {
        PHASE_IDS();
        pg8::Gemm g{(const bf16_t*)(ws + WS_YG), (const bf16_t*)(ws + WS_WGLU), NLAT, 2048, 1024};
        pg8::StaticOrder S; S.init(NLAT, 2048, G, (int)blockIdx.x);
        EpiGlu E{a.in[I_S5BGLU], (const float*)(ws + WS_MODV) + 9 * 6144, (bf16_t*)(ws + WS_H)};
        pg8::gemm_phase<EpiGlu, pg8::StaticOrder>(lds, g, S, E);
    }
    GSYNC();
    { PHASE_IDS(); router_phase(a, lds, 1, NCTX, tid); }
    GSYNC();
    { PHASE_IDS(); assign_phase(a, lds, 1, NCTX, tid); }
    GSYNC();
    { PHASE_IDS(); moe_gemm1(a, lds, 1, tid, G, vcu); }
    GSYNC();
    { PHASE_IDS(); moe_gemm2(a, lds, 1, tid, G, vcu); }
    GSYNC();
    for (int rep = 0; rep < REP_CMB1; ++rep) { PHASE_IDS(); combine_phase(a, 1, NCTX, lane, gw, NGW); }
#ifdef TS_SEL
    TS_MARK();
    if (blockIdx.x == 0 && threadIdx.x == 0) {
        asm volatile("s_waitcnt vmcnt(0)" ::: "memory"); __threadfence();
        const unsigned long long dt = tsbuf[TS_SEL + 1] - tsbuf[TS_SEL];
        atomicAdd(a.out, (float)dt * 0.001f);
    }
#endif
}

extern "C" void kernel_launch(void* const* d_in, const int* in_sizes, int n_in, void* d_out, int out_size,
                              void* d_ws, size_t ws_size, hipStream_t stream) {
    static int grid_blocks = 0;
    if (!grid_blocks) {
        int dev = 0, cus = 0, per_cu = 0;
        (void)hipGetDevice(&dev);
        (void)hipDeviceGetAttribute(&cus, hipDeviceAttributeMultiprocessorCount, dev);
        (void)hipFuncSetAttribute((const void*)fwd_mega, hipFuncAttributeMaxDynamicSharedMemorySize, LDS_BYTES);
        (void)hipOccupancyMaxActiveBlocksPerMultiprocessor(&per_cu, (const void*)fwd_mega, NTHREADS, LDS_BYTES);
        if (per_cu < 1) { fprintf(stderr, "occupancy query says %d blocks/CU\n", per_cu); }
        grid_blocks = cus < 256 ? cus : 256;
        if (ws_size < WS_END) fprintf(stderr, "kernel_launch: workspace too small: %zu < %zu\n", ws_size, (size_t)WS_END);
    }
    (void)hipMemsetAsync((char*)d_ws + WS_CTL, 0, 1 * MiB, stream);
    Args a{};
    for (int i = 0; i < 29; ++i) a.in[i] = (const float*)d_in[i];
    a.out = (float*)d_out; a.ws = (unsigned char*)d_ws;
    void* kargs[] = {&a};
    hipError_t e = hipLaunchCooperativeKernel((const void*)fwd_mega, dim3(grid_blocks), dim3(NTHREADS), kargs, LDS_BYTES, stream);
    if (e != hipSuccess) fprintf(stderr, "cooperative launch failed: %s (grid %d)\n", hipGetErrorString(e), grid_blocks);
}
```

```cpp
#include <hip/hip_runtime.h>
#include <hip/hip_cooperative_groups.h>
#include <cstdio>
#include <cstdint>
namespace cg = cooperative_groups;

#define LAS __attribute__((address_space(3)))
typedef unsigned short bf16_t;
typedef short bf16x8 __attribute__((ext_vector_type(8)));
typedef float f32x4 __attribute__((ext_vector_type(4)));
typedef unsigned u32x4 __attribute__((ext_vector_type(4)));
typedef unsigned u32x2 __attribute__((ext_vector_type(2)));
typedef float f32x2 __attribute__((ext_vector_type(2)));

constexpr int NTHREADS = 512;
constexpr int LDS_BYTES = 147456;
constexpr int D = 1024, NB = 8, SEQ = 4096, CTXL = 256;
constexpr int NCTX = NB * CTXL;
constexpr int NLAT = NB * SEQ;
constexpr int NTOK = NCTX + NLAT;
constexpr int NE = 32;
constexpr int MPAD = 147456;
constexpr float EPS = 1e-6f;

constexpr size_t MiB = 1u << 20;
constexpr size_t WS_CTL = 0;
constexpr size_t WS_MODV = 1 * MiB;
constexpr size_t WS_LBV = 1 * MiB + 512 * 1024;
constexpr size_t WS_WIN = 2 * MiB;
constexpr size_t WS_WOUT = 12 * MiB;
constexpr size_t WS_WGLU = 14 * MiB;
constexpr size_t WS_W1 = 18 * MiB;
constexpr size_t WS_W2 = 274 * MiB;
constexpr size_t WS_H = 402 * MiB;
constexpr size_t WS_A = 538 * MiB;
constexpr size_t WS_F = 606 * MiB;
constexpr size_t WS_TOKE = 674 * MiB;
constexpr size_t WS_TOKW = 674 * MiB + 640 * 1024;
constexpr size_t WS_TOKS = 674 * MiB + 1280 * 1024;
constexpr size_t WS_SLOTTOK = 256 * 1024;
constexpr size_t WS_BIG = 676 * MiB;
constexpr size_t WS_Q = WS_BIG, WS_V = WS_BIG + 68 * MiB, WS_G = WS_BIG + 136 * MiB;
constexpr size_t WS_LFF = WS_BIG + 204 * MiB, WS_LFB = WS_BIG + 340 * MiB;
constexpr size_t WS_OF = WS_BIG + 476 * MiB, WS_OB = WS_BIG + 612 * MiB;
constexpr size_t WS_OG = WS_BIG + 748 * MiB;
constexpr size_t WS_AG = WS_BIG, WS_ACT = WS_BIG + 288 * MiB, WS_YS = WS_BIG;
constexpr size_t WS_YF = WS_BIG, WS_YB = WS_BIG + 128 * MiB, WS_YG = WS_BIG + 256 * MiB;
constexpr size_t WS_END = WS_BIG + 816 * MiB;
constexpr int CW_CNT = 64;
constexpr int CW_CUR = 256;
constexpr int CW_CNTB = 8192;
constexpr int CW_BAR = 4096;
#ifndef REP_P0
#define REP_P0 1
#endif
#ifndef REP_GLA
#define REP_GLA 1
#endif
#ifndef REP_S5
#define REP_S5 1
#endif
#ifndef REP_P1
#define REP_P1 1
#endif
#ifndef REP_RO
#define REP_RO 1
#endif
#ifndef REP_POST
#define REP_POST 1
#endif
#ifndef REP_CMB1
#define REP_CMB1 1
#endif
#ifndef REP_OUT
#define REP_OUT 1
#endif
#ifndef REP_RT
#define REP_RT 1
#endif
#ifndef REP_AS
#define REP_AS 1
#endif
#ifndef REP_INP
#define REP_INP 1
#endif
#ifndef REP_M1
#define REP_M1 1
#endif
#ifndef REP_M2
#define REP_M2 1
#endif

struct Args {
    const float* in[29];
    float* out;
    unsigned char* ws;
    int stop_after, pad1;
};
enum { I_X = 0, I_C, I_CTX, I_CCTX, I_MODW, I_MODB, I_N1G, I_N2G, I_HGWIN, I_HGLB, I_HGNG, I_HGWOUT, I_S5ARE, I_S5AIM, I_S5LDT,
       I_S5BRE, I_S5BIM, I_S5CRE, I_S5CIM, I_S5D, I_S5WGLU, I_S5BGLU, I_RW, I_RB, I_W1, I_B1, I_W2, I_B2, I_FG };

__device__ __forceinline__ unsigned f2bf(float f) { unsigned u = __builtin_bit_cast(unsigned, f); return (u + 0x7fffu + ((u >> 16) & 1u)) >> 16; }
typedef __bf16 bf16x2_t __attribute__((ext_vector_type(2)));
__device__ __forceinline__ unsigned cvt_pk_bf16(float lo, float hi) { const bf16x2_t v = {(__bf16)lo, (__bf16)hi}; return __builtin_bit_cast(unsigned, v); }
__device__ __forceinline__ unsigned pk2(float lo, float hi) { return cvt_pk_bf16(lo, hi); }
__device__ __forceinline__ float bf2f(unsigned short b) { return __builtin_bit_cast(float, ((unsigned)b) << 16); }
__device__ __forceinline__ float bflo(unsigned w) { return __builtin_bit_cast(float, w << 16); }
__device__ __forceinline__ float bfhi(unsigned w) { return __builtin_bit_cast(float, w & 0xffff0000u); }
__device__ __forceinline__ float wave_sum(float v) {
#pragma unroll
    for (int o = 1; o < 64; o <<= 1) v += __shfl_xor(v, o);
    return v;
}
__device__ __forceinline__ float wave_max(float v) {
#pragma unroll
    for (int o = 1; o < 64; o <<= 1) v = fmaxf(v, __shfl_xor(v, o));
    return v;
}
__device__ __forceinline__ float sigmoid_f(float x) { return __builtin_amdgcn_rcpf(1.0f + __expf(-x)); }
__device__ __forceinline__ float silu_f(float x) { return x * __builtin_amdgcn_rcpf(1.0f + __expf(-x)); }
#define LDS_WAIT() asm volatile("s_waitcnt lgkmcnt(0)" ::: "memory")

namespace pg8 {
constexpr int BM = 256, BK = 64, HALF = 128, HTB = HALF * BK * 2, STAGE_BYTES = 8 * HTB, NXCD = 8, WGM = 8;
__host__ __device__ __forceinline__ int lds_byte(int r, int c) { const int st = (r >> 4) * 2 + (c >> 5), rr = r & 15, cc = c & 31, ob = rr * 64 + cc * 2; return st * 1024 + (ob ^ (((ob >> 9) & 1) << 5)); }
__host__ __device__ __forceinline__ void stage_rc(int b, int& R, int& C) { const int st = b / 1024, sb = b % 1024, swz = sb ^ (((sb >> 9) & 1) << 5); R = (st >> 1) * 16 + swz / 64; C = (st & 1) * 32 + (swz % 64) / 2; }
__host__ __device__ __forceinline__ int perm32(int rho) { const int n = rho >> 4, i = rho & 15; return 8 * (i >> 2) + 4 * n + (i & 3); }
struct Unit { int pm, pn; };
struct Gemm { const bf16_t* A; const bf16_t* Bt; int M, N, K; };
struct StaticOrder {
    int nM, nN, nwg, G, c;
    __device__ void init(int M, int N, int G_, int c_) { nM = M / BM; nN = N / BM; nwg = nM * nN; G = G_; c = c_; }
    __device__ bool next(int i, Unit& u) const {
        const long L = (long)i * G + c; if (L >= nwg) return false;
        int wgid = (int)L; { const int q = nwg / NXCD, r = nwg % NXCD, xcd = wgid % NXCD, off = wgid / NXCD; wgid = (xcd < r ? xcd * (q + 1) : r * (q + 1) + (xcd - r) * q) + off; }
        const int nig = WGM * nN, gid = wgid / nig, fm = gid * WGM, gsz = (nM - fm) < WGM ? (nM - fm) : WGM;
        u.pm = fm + ((wgid % nig) % gsz); u.pn = (wgid % nig) / gsz; return true;
    }
    __device__ __forceinline__ void a_ready(const Unit&) const {}
    __device__ __forceinline__ void done(const Unit&) const {}
};
struct MoeOrder {
    const LAS int* tile_e; int TT, sh, G, v;
    __device__ bool next(int i, Unit& u) const {
        const bool p2 = (G & (G - 1)) == 0 && G >= 8;
        const int lg = p2 ? (31 - __builtin_clz((unsigned)G)) - 3 : 0, per = p2 ? (1 << lg) : G, x = p2 ? (v >> lg) : 0, j = p2 ? (v & (per - 1)) : v, nx = p2 ? 8 : 1;
        const int t0 = (x * TT) / nx, t1 = ((x + 1) * TT) / nx;
        const int uu = i * per + j, rt = t0 + (uu >> sh), pnl = uu & ((1 << sh) - 1);
        if (rt >= t1) return false;
        u.pm = rt; u.pn = (tile_e[rt] << sh) + pnl; return true;
    }
    __device__ __forceinline__ void a_ready(const Unit&) const {}
    __device__ __forceinline__ void done(const Unit&) const {}
};

template <class Epi, class Sched, bool GATHER = false>
__device__ __forceinline__ void gemm_phase(LAS unsigned char* lds, const Gemm g, const Sched& S, const Epi& E, const LAS unsigned short* rowl = nullptr) {
    int tid_ = threadIdx.x; asm volatile("" : "+v"(tid_));
    const int tid = tid_, wid = __builtin_amdgcn_readfirstlane(tid >> 6), lane = tid & 63, wr = wid >> 2, wc = wid & 3, fr = lane & 15, fq = lane >> 4;
    const int K = g.K, nt = K / BK;
    unsigned voffA[2], voffB[2];
    int Rr[2], Cc2[2];
#pragma unroll
    for (int i = 0; i < 2; ++i) { int R, C; stage_rc(tid * 16 + i * 8192, R, C); voffA[i] = (unsigned)(R * K + C) * 2u; const int Rb = Epi::PERM ? ((R & ~31) + perm32(R & 31)) : R; voffB[i] = (unsigned)(Rb * K + C) * 2u; Rr[i] = R; Cc2[i] = C * 2; }
    unsigned gA0[2] = {0u, 0u}, gA1[2] = {0u, 0u}, nG0[2] = {0u, 0u}, nG1[2] = {0u, 0u};
#define PG8_ROWS(ui_, d0, d1) do { _Pragma("unroll") for (int _i = 0; _i < 2; ++_i) { d0[_i] = (unsigned)rowl[(ui_) * BM + Rr[_i]] * (unsigned)(K * 2) + (unsigned)Cc2[_i]; d1[_i] = (unsigned)rowl[(ui_) * BM + HALF + Rr[_i]] * (unsigned)(K * 2) + (unsigned)Cc2[_i]; } } while (0)
#define PG8_STAGE_A(bufoff, ptr, h, nx) do { if constexpr (GATHER) { unsigned _o[2]; _o[0] = (nx) ? ((h) ? nG1[0] : nG0[0]) : ((h) ? gA1[0] : gA0[0]); _o[1] = (nx) ? ((h) ? nG1[1] : nG0[1]) : ((h) ? gA1[1] : gA0[1]); PG8_STAGE(bufoff, ptr, _o); } \
        else { PG8_STAGE(bufoff, (ptr) + ((h) ? hstep : 0), voffA); } } while (0)
    const size_t kstep = (size_t)(BK * 2);
    const size_t hstep = (size_t)HALF * K * 2;
    const size_t tstep = 2 * hstep;
    const unsigned ldsw = (unsigned)wid * 1024u;
    const int aoff = lds_byte(wr * 64 + fr, fq * 8), boff = lds_byte(wc * 32 + fr, fq * 8);
#define PG8_SA(b, h) (((b) * 2 + (h)) * HTB)
#define PG8_SB(b, h) ((4 + (b) * 2 + (h)) * HTB)
#define PG8_STAGE(bufoff, gbase, voff) do { _Pragma("unroll") for (int _i = 0; _i < 2; ++_i) \
        __builtin_amdgcn_global_load_lds((const unsigned*)((const char*)(gbase) + (voff)[_i]), (LAS unsigned*)(lds + (bufoff) + ldsw + _i * 8192), 16, 0, 0); } while (0)
#define PG8_LDA(dst, b, h) do { _Pragma("unroll") for (int m = 0; m < 4; ++m) _Pragma("unroll") for (int k = 0; k < 2; ++k) dst[m][k] = *(const LAS bf16x8*)(lds + PG8_SA(b, h) + aoff + m * 2048 + k * 1024); } while (0)
#define PG8_LDB(dst, b, h) do { _Pragma("unroll") for (int n = 0; n < 2; ++n) _Pragma("unroll") for (int k = 0; k < 2; ++k) dst[n][k] = *(const LAS bf16x8*)(lds + PG8_SB(b, h) + boff + n * 2048 + k * 1024); } while (0)
#define PG8_MMA(ai, bj, At, Bt) do { __builtin_amdgcn_s_setprio(1); _Pragma("unroll") for (int m = 0; m < 4; ++m) _Pragma("unroll") for (int n = 0; n < 2; ++n) _Pragma("unroll") for (int k = 0; k < 2; ++k) \
        acc[ai][bj][m][n] = __builtin_amdgcn_mfma_f32_16x16x32_bf16(Bt[n][k], At[m][k], acc[ai][bj][m][n], 0, 0, 0); __builtin_amdgcn_s_setprio(0); } while (0)
#define PG8_WAIT_V(n) asm volatile("s_waitcnt vmcnt(" #n ")" ::: "memory")
#define PG8_WAIT_L(n) asm volatile("s_waitcnt lgkmcnt(" #n ")" ::: "memory")
#define PG8_BAR __builtin_amdgcn_s_barrier()
#define PG8_SCHED __builtin_amdgcn_sched_barrier(0)
    Unit cur, nxt; int ui = 0;
    if (!S.next(0, cur)) return;
    f32x4 acc[2][2][4][2];
#pragma unroll
    for (int a = 0; a < 2; ++a)
#pragma unroll
        for (int b = 0; b < 2; ++b)
#pragma unroll
            for (int m = 0; m < 4; ++m)
#pragma unroll
                for (int n = 0; n < 2; ++n) acc[a][b][m][n] = (f32x4){0.f, 0.f, 0.f, 0.f};
    bf16x8 At[4][2], B0[2][2], B1[2][2];
    const char* cA = GATHER ? (const char*)g.A : (const char*)g.A + (size_t)cur.pm * tstep; const char* cB = (const char*)g.Bt + (size_t)cur.pn * tstep;
    S.a_ready(cur);
    if constexpr (GATHER) PG8_ROWS(0, gA0, gA1);
    PG8_STAGE(PG8_SB(0, 0), cB, voffB); PG8_STAGE_A(PG8_SA(0, 0), cA, 0, false); PG8_STAGE(PG8_SB(0, 1), cB + hstep, voffB); PG8_STAGE_A(PG8_SA(0, 1), cA, 1, false);
    if (wr == 1) PG8_BAR;
    PG8_WAIT_V(4); PG8_BAR;
    PG8_STAGE(PG8_SB(1, 0), cB + kstep, voffB); PG8_STAGE_A(PG8_SA(1, 0), cA + kstep, 0, false); PG8_STAGE(PG8_SB(1, 1), cB + hstep + kstep, voffB);
    PG8_WAIT_V(6); PG8_BAR;
    for (;;) {
        const bool has_next = S.next(ui + 1, nxt);
        const char* nA = GATHER ? cA : (has_next ? (const char*)g.A + (size_t)nxt.pm * tstep : cA); const char* nB = has_next ? (const char*)g.Bt + (size_t)nxt.pn * tstep : cB;
        if constexpr (GATHER) { if (has_next) PG8_ROWS(ui + 1, nG0, nG1); else { nG0[0] = gA0[0]; nG0[1] = gA0[1]; nG1[0] = gA1[0]; nG1[1] = gA1[1]; } }
        for (int t = 0; t < nt; t += 2) {
            const bool last = (t == nt - 2);
            const char* a1 = cA + (size_t)(t + 1) * kstep;
            const char* a2 = last ? nA : cA + (size_t)(t + 2) * kstep; const char* b2 = last ? nB : cB + (size_t)(t + 2) * kstep;
            const char* a3 = a2 + kstep; const char* b3 = b2 + kstep;
            if (last && has_next) S.a_ready(nxt);
            PG8_LDB(B0, 0, 0); PG8_SCHED; PG8_LDA(At, 0, 0); PG8_STAGE_A(PG8_SA(1, 1), a1, 1, false);
            PG8_WAIT_L(8); PG8_BAR; PG8_WAIT_L(0); PG8_MMA(0, 0, At, B0); PG8_BAR; PG8_SCHED;
            PG8_LDB(B1, 0, 1); PG8_STAGE(PG8_SB(0, 0), b2, voffB);
            PG8_BAR; PG8_WAIT_L(0); PG8_MMA(0, 1, At, B1); PG8_BAR;
            PG8_LDA(At, 0, 1); PG8_STAGE_A(PG8_SA(0, 0), a2, 0, last);
            PG8_BAR; PG8_WAIT_L(0); PG8_MMA(1, 0, At, B0); PG8_BAR; PG8_SCHED;
            PG8_STAGE(PG8_SB(0, 1), b2 + hstep, voffB);
            PG8_WAIT_V(6); PG8_BAR; PG8_MMA(1, 1, At, B1); PG8_BAR;
            PG8_LDB(B0, 1, 0); PG8_SCHED; PG8_LDA(At, 1, 0); PG8_STAGE_A(PG8_SA(0, 1), a2, 1, last);
            PG8_WAIT_L(8); PG8_BAR; PG8_WAIT_L(0); PG8_MMA(0, 0, At, B0); PG8_BAR; PG8_SCHED;
            PG8_LDB(B1, 1, 1); PG8_STAGE(PG8_SB(1, 0), b3, voffB);
            PG8_BAR; PG8_WAIT_L(0); PG8_MMA(0, 1, At, B1); PG8_BAR;
            PG8_LDA(At, 1, 1); PG8_STAGE_A(PG8_SA(1, 0), a3, 0, last);
            PG8_BAR; PG8_WAIT_L(0); PG8_MMA(1, 0, At, B0); PG8_BAR; PG8_SCHED;
            PG8_STAGE(PG8_SB(1, 1), b3 + hstep, voffB);
            PG8_WAIT_V(6); PG8_BAR; PG8_MMA(1, 1, At, B1); PG8_BAR;
        }
        E(acc, cur, wr, wc, fr, fq); S.done(cur);
        if (!has_next) break;
#pragma unroll
        for (int a = 0; a < 2; ++a)
#pragma unroll
            for (int b = 0; b < 2; ++b)
#pragma unroll
                for (int m = 0; m < 4; ++m)
#pragma unroll
                    for (int n = 0; n < 2; ++n) acc[a][b][m][n] = (f32x4){0.f, 0.f, 0.f, 0.f};
        cur = nxt; cA = nA; cB = nB; ++ui;
        if constexpr (GATHER) { gA0[0] = nG0[0]; gA0[1] = nG0[1]; gA1[0] = nG1[0]; gA1[1] = nG1[1]; }
    }
    PG8_WAIT_V(0);
    if (wr == 0) PG8_BAR;
    PG8_BAR;
#undef PG8_SA
#undef PG8_ROWS
#undef PG8_STAGE_A
#undef PG8_SB
#undef PG8_STAGE
#undef PG8_LDA
#undef PG8_LDB
#undef PG8_MMA
#undef PG8_WAIT_V
#undef PG8_WAIT_L
#undef PG8_BAR
#undef PG8_SCHED
}
}
using pg8::Unit;

__device__ __forceinline__ f32x4 ld_bf16x4(const bf16_t* p) { const u32x2 w = *(const u32x2*)p; return (f32x4){bflo(w.x), bfhi(w.x), bflo(w.y), bfhi(w.y)}; }
__device__ __forceinline__ void st_bf16x4(bf16_t* p, f32x4 v) { u32x2 w; w.x = pk2(v[0], v[1]); w.y = pk2(v[2], v[3]); *(u32x2*)p = w; }

struct EpiInProj {
    static constexpr bool PERM = true;
    bf16_t *Q, *V, *G; _Float16 *LFF, *LFB; const float* lbv;
    __device__ __forceinline__ void operator()(const f32x4 (&acc)[2][2][4][2], const Unit& u, int wr, int wc, int fr, int fq) const {
        const int seg = u.pn >> 2, cb = (u.pn & 3) * 256 + wc * 32 + 8 * fq, row0 = u.pm * 256 + wr * 64 + fr;
#pragma unroll
        for (int bj = 0; bj < 2; ++bj) {
            const int c = cb + bj * 128;
            f32x4 lb0 = (f32x4){0.f, 0.f, 0.f, 0.f}, lb1 = lb0;
            if (seg == 2 || seg == 3) { lb0 = *(const f32x4*)(lbv + (seg - 2) * D + c); lb1 = *(const f32x4*)(lbv + (seg - 2) * D + c + 4); }
#pragma unroll
            for (int ai = 0; ai < 2; ++ai)
#pragma unroll
                for (int m = 0; m < 4; ++m) {
                    const size_t ro = (size_t)(row0 + ai * 128 + m * 16) * D + c;
                    const f32x4 v0 = acc[ai][bj][m][0], v1 = acc[ai][bj][m][1];
                    if (seg == 0) { f32x4 o0, o1; for (int j = 0; j < 4; ++j) { o0[j] = silu_f(v0[j]); o1[j] = silu_f(v1[j]); }
                        *(u32x4*)(Q + ro) = (u32x4){pk2(o0[0], o0[1]), pk2(o0[2], o0[3]), pk2(o1[0], o1[1]), pk2(o1[2], o1[3])}; }
                    else if (seg == 1) { *(u32x4*)(V + ro) = (u32x4){pk2(v0[0], v0[1]), pk2(v0[2], v0[3]), pk2(v1[0], v1[1]), pk2(v1[2], v1[3])}; }
                    else if (seg == 4) { *(u32x4*)(G + ro) = (u32x4){pk2(v0[0], v0[1]), pk2(v0[2], v0[3]), pk2(v1[0], v1[1]), pk2(v1[2], v1[3])}; }
                    else {
                        f32x4 o0, o1;
                        for (int j = 0; j < 4; ++j) { o0[j] = __logf(lb0[j] + (1.0f - lb0[j]) * sigmoid_f(v0[j])); o1[j] = __logf(lb1[j] + (1.0f - lb1[j]) * sigmoid_f(v1[j])); }
                        u32x4 hw; hw.x = __builtin_bit_cast(unsigned, __builtin_amdgcn_cvt_pkrtz(o0[0], o0[1])); hw.y = __builtin_bit_cast(unsigned, __builtin_amdgcn_cvt_pkrtz(o0[2], o0[3]));
                        hw.z = __builtin_bit_cast(unsigned, __builtin_amdgcn_cvt_pkrtz(o1[0], o1[1])); hw.w = __builtin_bit_cast(unsigned, __builtin_amdgcn_cvt_pkrtz(o1[2], o1[3]));
                        *(u32x4*)((seg == 2 ? LFF : LFB) + ro) = hw;
                    }
                }
        }
    }
};
struct EpiResid {
    static constexpr bool PERM = true;
    const float* x; const float* ctx; const float* modv; bf16_t* H; int gate_off;
    __device__ __forceinline__ void operator()(const f32x4 (&acc)[2][2][4][2], const Unit& u, int wr, int wc, int fr, int fq) const {
        const int rt0 = u.pm * 256; const int mr = rt0 < NCTX ? 8 : ((rt0 - NCTX) >> 12);
        const float* src = rt0 < NCTX ? ctx + (size_t)rt0 * D : x + (size_t)(rt0 - NCTX) * D;
        const int cb = u.pn * 256 + wc * 32 + 8 * fq, rl0 = wr * 64 + fr;
        const float* gp = modv + mr * 6144 + gate_off;
        f32x4 gg[2][2];
#pragma unroll
        for (int bj = 0; bj < 2; ++bj) { gg[bj][0] = *(const f32x4*)(gp + cb + bj * 128); gg[bj][1] = *(const f32x4*)(gp + cb + bj * 128 + 4); }
#pragma unroll
        for (int bj = 0; bj < 2; ++bj)
#pragma unroll
            for (int ai = 0; ai < 2; ++ai) {
                const int c = cb + bj * 128; f32x4 h0[4], h1[4];
#pragma unroll
                for (int m = 0; m < 4; ++m) { const float* hp = src + (size_t)(rl0 + ai * 128 + m * 16) * D + c; h0[m] = *(const f32x4*)hp; h1[m] = *(const f32x4*)(hp + 4); }
#pragma unroll
                for (int m = 0; m < 4; ++m) {
                    const f32x4 o0 = h0[m] + gg[bj][0] * acc[ai][bj][m][0], o1 = h1[m] + gg[bj][1] * acc[ai][bj][m][1];
                    *(u32x4*)(H + (size_t)(rt0 + rl0 + ai * 128 + m * 16) * D + c) = (u32x4){pk2(o0[0], o0[1]), pk2(o0[2], o0[3]), pk2(o1[0], o1[1]), pk2(o1[2], o1[3])};
                }
                asm volatile("" ::: "memory");
            }
    }
};

struct TrItem { const float* src; bf16_t* dst; int N; };
__device__ __forceinline__ void tr_load(const TrItem& t, f32x4 (&v)[16], int lane) {
    const float* p = t.src + (size_t)(2 * (lane >> 4)) * t.N + 4 * (lane & 15);
#pragma unroll
    for (int i = 0; i < 8; ++i) { v[2 * i] = *(const f32x4*)(p + (size_t)(8 * i) * t.N); v[2 * i + 1] = *(const f32x4*)(p + (size_t)(8 * i + 1) * t.N); }
}
__device__ __forceinline__ void tr_finish(const TrItem& t, const f32x4 (&v)[16], LAS unsigned* scr, int lane) {
#pragma unroll
    for (int i = 0; i < 8; ++i) {
        const int kp = 4 * i + (lane >> 4); LAS unsigned* s = scr + kp * 65 + 4 * (lane & 15);
        s[0] = cvt_pk_bf16(v[2 * i][0], v[2 * i + 1][0]); s[1] = cvt_pk_bf16(v[2 * i][1], v[2 * i + 1][1]); s[2] = cvt_pk_bf16(v[2 * i][2], v[2 * i + 1][2]); s[3] = cvt_pk_bf16(v[2 * i][3], v[2 * i + 1][3]);
    }
    LDS_WAIT();
    const int c = lane & 7;
#pragma unroll
    for (int j = 0; j < 8; ++j) {
        const int n = (lane >> 3) + 8 * j; const LAS unsigned* s = scr + (4 * c) * 65 + n;
        *(u32x4*)(t.dst + (size_t)n * 1024 + 8 * c) = (u32x4){s[0], s[65], s[130], s[195]};
    }
    LDS_WAIT();
}
__device__ __forceinline__ int ilv_row(int c) { const int bj = c >> 10, r = c & 1023; return (r >> 7) * 256 + bj * 128 + (r & 127); }

__device__ __forceinline__ TrItem moe_item(const Args& a, int r, int layer) {
    TrItem t;
    if (r < 32 * 512) { const int mat = layer * 32 + (r >> 9), sub = r & 511, kb = sub >> 5, nb = sub & 31;
        t.src = a.in[I_W1] + (size_t)mat * 1024 * 2048 + (size_t)(kb * 64) * 2048 + nb * 64; t.dst = (bf16_t*)(a.ws + WS_W1) + (size_t)mat * 2048 * 1024 + (size_t)ilv_row(nb * 64) * 1024 + kb * 64; t.N = 2048; }
    else { r -= 32 * 512; const int mat = layer * 32 + (r >> 8), sub = r & 255, kb = sub >> 4, nb = sub & 15;
        t.src = a.in[I_W2] + (size_t)mat * 1024 * 1024 + (size_t)(kb * 64) * 1024 + nb * 64; t.dst = (bf16_t*)(a.ws + WS_W2) + (size_t)mat * 1024 * 1024 + (size_t)(nb * 64) * 1024 + kb * 64; t.N = 1024; }
    return t;
}
constexpr int P0_NWIN = 16 * 80, P0_NWOUT = 16 * 16, P0_NWGLU = 16 * 32, P0_NITEMS = P0_NWIN + P0_NWOUT + P0_NWGLU + 32 * 512 + 32 * 256;
__device__ __forceinline__ TrItem p0_item(const Args& a, int r) {
    TrItem t;
    if (r < P0_NWIN) { const int kb = r / 80, nb = r % 80; t.src = a.in[I_HGWIN] + (size_t)(kb * 64) * 5120 + nb * 64; t.dst = (bf16_t*)(a.ws + WS_WIN) + (size_t)(nb * 64) * 1024 + kb * 64; t.N = 5120; return t; } r -= P0_NWIN;
    if (r < P0_NWOUT) { const int kb = r / 16, nb = r % 16; t.src = a.in[I_HGWOUT] + (size_t)(kb * 64) * 1024 + nb * 64; t.dst = (bf16_t*)(a.ws + WS_WOUT) + (size_t)(nb * 64) * 1024 + kb * 64; t.N = 1024; return t; } r -= P0_NWOUT;
    if (r < P0_NWGLU) { const int kb = r / 32, nb = r % 32; t.src = a.in[I_S5WGLU] + (size_t)(kb * 64) * 2048 + nb * 64; t.dst = (bf16_t*)(a.ws + WS_WGLU) + (size_t)ilv_row(nb * 64) * 1024 + kb * 64; t.N = 2048; return t; } r -= P0_NWGLU;
    return moe_item(a, r, 0);
}
#define TR_LOOP(first, stride, count, ITEM) do { int _it = (first); if (_it < (count)) { f32x4 _va[16], _vb[16]; TrItem _A = ITEM(_it), _B = _A; tr_load(_A, _va, lane); \
        for (;;) { const int _i2 = _it + (stride); const bool _h2 = _i2 < (count); if (_h2) { _B = ITEM(_i2); tr_load(_B, _vb, lane); } tr_finish(_A, _va, scr, lane); if (!_h2) break; \
                   _it = _i2 + (stride); const bool _h1 = _it < (count); if (_h1) { _A = ITEM(_it); tr_load(_A, _va, lane); } tr_finish(_B, _vb, scr, lane); if (!_h1) break; } } } while (0)
__device__ __forceinline__ void p0_phase(const Args& a, LAS unsigned char* lds, int tid, int gw, int NGW) {
    const int lane = tid & 63, wave = tid >> 6;
    unsigned char* ws = a.ws;
    float* modv = (float*)(ws + WS_MODV);
    if (blockIdx.x < 192) {
        LAS float* SC = (LAS float*)lds;
        LAS float* PART = (LAS float*)(lds + 40960);
        for (int i = tid; i < 9 * 1024; i += NTHREADS) { const int r = i >> 10, k = i & 1023; const float v = r < 8 ? a.in[I_C][r * 1024 + k] : a.in[I_CCTX][k]; SC[i] = silu_f(v); }
        __syncthreads();
        const int layer = blockIdx.x / 96, ng = blockIdx.x % 96;
        const float* W = a.in[I_MODW] + (size_t)layer * 1024 * 6144 + ng * 64 + lane;
        float acc[9];
#pragma unroll
        for (int r = 0; r < 9; ++r) acc[r] = 0.f;
#pragma unroll 8
        for (int kk = 0; kk < 128; ++kk) {
            const int k = wave * 128 + kk; const float w = W[(size_t)k * 6144];
#pragma unroll
            for (int r = 0; r < 9; ++r) acc[r] += SC[r * 1024 + k] * w;
        }
#pragma unroll
        for (int r = 0; r < 9; ++r) PART[(wave * 9 + r) * 64 + lane] = acc[r];
        __syncthreads();
        for (int i = tid; i < 9 * 64; i += NTHREADS) {
            const int r = i >> 6, l = i & 63; float s = a.in[I_MODB][layer * 6144 + ng * 64 + l];
#pragma unroll
            for (int w = 0; w < 8; ++w) s += PART[(w * 9 + r) * 64 + l];
            modv[(size_t)(layer * 9 + r) * 6144 + ng * 64 + l] = s;
        }
        __syncthreads();
    } else if (blockIdx.x == 192) {
        float* lbv = (float*)(ws + WS_LBV);
        for (int i = tid; i < 2048; i += NTHREADS) { const float l0 = a.in[I_HGLB][i], l1 = a.in[I_HGLB][2048 + i]; lbv[i] = 1.0f / (1.0f + __expf(l1 - l0)); }
    }
    LAS unsigned* scr = (LAS unsigned*)(lds + 59392 + wave * 8320);
#define P0_ITEM(i) p0_item(a, (i))
    TR_LOOP(gw, NGW, P0_NITEMS, P0_ITEM);
#undef P0_ITEM
}

__device__ __forceinline__ const float* hin_row(const Args& a, int row) { return row < NCTX ? a.in[I_CTX] + (size_t)row * D : a.in[I_X] + (size_t)(row - NCTX) * D; }
__device__ __forceinline__ int mod_row(int row) { return row < NCTX ? 8 : ((row - NCTX) >> 12); }
__device__ __forceinline__ float row_rstd(const f32x4 (&v)[4]) {
    float s = 0.f;
#pragma unroll
    for (int j = 0; j < 4; ++j) s += (v[j][0] * v[j][0] + v[j][1] * v[j][1]) + (v[j][2] * v[j][2] + v[j][3] * v[j][3]);
    return 1.0f / sqrtf(wave_sum(s) * (1.0f / D) + EPS);
}
struct ModVec { f32x4 g[4], sc[4], sh[4]; };
__device__ __forceinline__ void modvec_load(ModVec& m, const float* g, const float* sc, const float* sh, int lane) {
#pragma unroll
    for (int j = 0; j < 4; ++j) { const int c = 4 * lane + 256 * j; m.g[j] = *(const f32x4*)(g + c); m.sc[j] = *(const f32x4*)(sc + c); m.sh[j] = *(const f32x4*)(sh + c); }
}
__device__ __forceinline__ void norm_mod_store(const f32x4 (&v)[4], float rstd, const ModVec& m, bf16_t* orow, int lane) {
#pragma unroll
    for (int j = 0; j < 4; ++j) st_bf16x4(orow + 4 * lane + 256 * j, v[j] * rstd * m.g[j] * (m.sc[j] + 1.0f) + m.sh[j]);
}

__device__ __forceinline__ void p1_phase(const Args& a, int lane, int gw, int NGW) {
    const float* modv = (const float*)(a.ws + WS_MODV);
    bf16_t* A = (bf16_t*)(a.ws + WS_A);
    for (int row0 = gw * 4; row0 < NTOK; row0 += NGW * 4) {
        f32x4 v[4][4];
#pragma unroll
        for (int r = 0; r < 4; ++r) { const float* hr = hin_row(a, row0 + r);
#pragma unroll
            for (int j = 0; j < 4; ++j) v[r][j] = *(const f32x4*)(hr + 4 * lane + 256 * j); }
        const float* mv = modv + (size_t)mod_row(row0) * 6144;
        ModVec m; modvec_load(m, a.in[I_N1G], mv + 1024, mv, lane);
#pragma unroll
        for (int r = 0; r < 4; ++r) { const float rstd = row_rstd(v[r]); norm_mod_store(v[r], rstd, m, A + (size_t)(row0 + r) * D, lane); }
    }
}

__device__ __forceinline__ int gla_row(int n, int t, int b, int dir) {
    const bool isctx = n < 4; const int cn = isctx ? n : n - 4, slen = isctx ? CTXL : SEQ, rbase = isctx ? b * CTXL : NCTX + b * SEQ;
    const int pos = cn * 64 + t; return rbase + (dir ? slen - 1 - pos : pos);
}
__device__ __forceinline__ void gla_phase(const Args& a, LAS unsigned char* lds, int tid) {
    const int lane = tid & 63, wave = tid >> 6, fr = lane & 15, fq = lane >> 4;
    LAS unsigned char* QS = lds;
    LAS unsigned char* KS = lds + 17408;
    LAS unsigned char* QIN = lds + 34816;
    LAS unsigned char* KOT = lds + 52224;
    LAS unsigned char* VT = lds + 70656;
    LAS unsigned char* ST0 = lds + 79872;
    LAS unsigned char* PPW = lds + 114688 + wave * 2304;
    LAS float* GT0 = (LAS float*)(lds + 133120);
    LAS float* BL = (LAS float*)(lds + 141312);
    const bf16_t* Qg = (const bf16_t*)(a.ws + WS_Q); const bf16_t* Vg = (const bf16_t*)(a.ws + WS_V);
    for (int item = blockIdx.x; item < 256; item += gridDim.x) {
        const int vs = item & 1, dir = (item >> 1) & 1, h = (item >> 2) & 7, b = item >> 5;
        const _Float16* LF = (const _Float16*)(a.ws + (dir ? WS_LFB : WS_LFF)); bf16_t* Og = (bf16_t*)(a.ws + (dir ? WS_OB : WS_OF));
        f32x4 Sacc[4];
#pragma unroll
        for (int i = 0; i < 4; ++i) Sacc[i] = (f32x4){0.f, 0.f, 0.f, 0.f};
        for (int i = tid; i < 2 * 17408 / 4; i += NTHREADS) ((LAS unsigned*)ST0)[i] = 0u;
        const int kc2 = (tid & 63) * 2, tg = tid >> 6, chq = h * 128 + kc2;
        const int vt_t = tid & 63, vt_v8 = (tid >> 6) * 8;
        unsigned lf2[8], q2[8]; u32x4 vv;
#define GLA_LOAD(n_) do { _Pragma("unroll") for (int i = 0; i < 8; ++i) { const size_t o = (size_t)gla_row(n_, tg * 8 + i, b, dir) * D + chq; lf2[i] = *(const unsigned*)(LF + o); q2[i] = *(const unsigned*)(Qg + o); } \
            vv = *(const u32x4*)(Vg + (size_t)gla_row(n_, vt_t, b, dir) * D + h * 128 + vs * 64 + vt_v8); } while (0)
        float fa[8], fb[8], bca[8], bcb[8];
#define GLA_CUMSUM(par_) do { float csa = 0.f, csb = 0.f; _Pragma("unroll") for (int i = 0; i < 8; ++i) { typedef _Float16 h2 __attribute__((ext_vector_type(2))); const h2 hv = __builtin_bit_cast(h2, lf2[i]); \
            const float la = (float)hv[0], lb_ = (float)hv[1]; fa[i] = __expf(la); fb[i] = __expf(lb_); csa += la; csb += lb_; bca[i] = csa; bcb[i] = csb; } \
            *(LAS f32x2*)(GT0 + (par_) * 1024 + tg * 128 + kc2) = (f32x2){csa, csb}; } while (0)
        GLA_LOAD(0);
        GLA_CUMSUM(0);
        __syncthreads();
        for (int n = 0; n < 68; ++n) {
            const int par = n & 1;
            LAS unsigned char* STc = ST0 + par * 17408; LAS unsigned char* STn = ST0 + (par ^ 1) * 17408;
            { const unsigned w[4] = {vv.x, vv.y, vv.z, vv.w};
#pragma unroll
              for (int i = 0; i < 4; ++i) { *(LAS bf16_t*)(VT + (vt_v8 + 2 * i) * 144 + vt_t * 2) = (bf16_t)(w[i] & 0xffffu); *(LAS bf16_t*)(VT + (vt_v8 + 2 * i + 1) * 144 + vt_t * 2) = (bf16_t)(w[i] >> 16); } }
#define GLA_OSTORE(n_) do { const u32x4 od = *(const LAS u32x4*)(PPW + (lane >> 2) * 144 + (lane & 3) * 16); \
                *(u32x4*)(Og + (size_t)gla_row(n_, (wave >> 1) * 16 + (lane >> 2), b, dir) * D + h * 128 + vs * 64 + (wave & 1) * 32 + (lane & 3) * 8) = od; } while (0)
            if (n > 0) GLA_OSTORE(n - 1);
            f32x2 pre = (f32x2){0.f, 0.f}, bref = (f32x2){0.f, 0.f}, blast = (f32x2){0.f, 0.f};
#pragma unroll
            for (int g8 = 0; g8 < 8; ++g8) { const f32x2 gv = *(const LAS f32x2*)(GT0 + par * 1024 + g8 * 128 + kc2); if (g8 < tg) pre += gv; if (g8 < 4) bref += gv; blast += gv; }
            const float era = __expf(bref.x), erb = __expf(bref.y), ela = __expf(blast.x - bref.x), elb = __expf(blast.y - bref.y);
            float e1a = __expf(pre.x - bref.x), e1b = __expf(pre.y - bref.y);
            unsigned kota[4], kotb[4];
#pragma unroll
            for (int i = 0; i < 8; ++i) {
                const int t = tg * 8 + i;
                const float qa = bflo(q2[i]), qb = bfhi(q2[i]);
                e1a *= fa[i]; e1b *= fb[i];
                const float ka = 1.0f - fa[i], kb = 1.0f - fb[i];
                const float e2a = __builtin_amdgcn_rcpf(e1a), e2b = __builtin_amdgcn_rcpf(e1b);
                const float qsa = qa * e1a, qsb = qb * e1b, ksa = ka * e2a, ksb = kb * e2b;
                *(LAS unsigned*)(QS + t * 272 + kc2 * 2) = cvt_pk_bf16(qsa, qsb);
                *(LAS unsigned*)(KS + t * 272 + kc2 * 2) = cvt_pk_bf16(ksa, ksb);
                *(LAS unsigned*)(QIN + t * 272 + kc2 * 2) = cvt_pk_bf16(qsa * era, qsb * erb);
                const unsigned ko = cvt_pk_bf16(ksa * ela, ksb * elb);
                if (i & 1) { kota[i >> 1] |= ko << 16; kotb[i >> 1] |= ko & 0xffff0000u; } else { kota[i >> 1] = ko & 0xffffu; kotb[i >> 1] = ko >> 16; }
            }
            { const int rot = ((kc2 >> 4) + tg) & 7;
              *(LAS u32x4*)(KOT + kc2 * 144 + rot * 16) = (u32x4){kota[0], kota[1], kota[2], kota[3]};
              *(LAS u32x4*)(KOT + (kc2 + 1) * 144 + rot * 16) = (u32x4){kotb[0], kotb[1], kotb[2], kotb[3]}; }
            if (tg == 0) *(LAS f32x2*)(BL + kc2) = (f32x2){__expf(blast.x), __expf(blast.y)};
            if (n + 1 < 68) GLA_LOAD(n + 1);
            __syncthreads();
            const int tt = wave >> 1;
            bf16x8 aq[4];
#pragma unroll
            for (int kk = 0; kk < 4; ++kk) aq[kk] = *(const LAS bf16x8*)(QS + (tt * 16 + fr) * 272 + (kk * 32 + fq * 8) * 2);
#pragma unroll
            for (int st = 0; st < 4; ++st) {
                f32x4 acc = (f32x4){0.f, 0.f, 0.f, 0.f};
                if (st <= tt) {
#pragma unroll
                    for (int kk = 0; kk < 4; ++kk) {
                        const bf16x8 bv = *(const LAS bf16x8*)(KS + (st * 16 + fr) * 272 + (kk * 32 + fq * 8) * 2);
                        acc = __builtin_amdgcn_mfma_f32_16x16x32_bf16(aq[kk], bv, acc, 0, 0, 0);
                    }
                }
#pragma unroll
                for (int j = 0; j < 4; ++j) { const int tl = fq * 4 + j, s = st * 16 + fr; *(LAS bf16_t*)(PPW + tl * 144 + s * 2) = (bf16_t)f2bf(s <= tt * 16 + tl ? acc[j] : 0.f); }
            }
            LDS_WAIT();
            unsigned ow[2][2];
            bf16x8 ap[2], ai[4];
#pragma unroll
            for (int kk = 0; kk < 2; ++kk) ap[kk] = *(const LAS bf16x8*)(PPW + fr * 144 + (kk * 32 + fq * 8) * 2);
#pragma unroll
            for (int kk = 0; kk < 4; ++kk) ai[kk] = *(const LAS bf16x8*)(QIN + (tt * 16 + fr) * 272 + (kk * 32 + fq * 8) * 2);
#pragma unroll
            for (int vti = 0; vti < 2; ++vti) {
                const int vt = 2 * (wave & 1) + vti; f32x4 acc = (f32x4){0.f, 0.f, 0.f, 0.f};
#pragma unroll
                for (int kk = 0; kk < 2; ++kk) {
                    const bf16x8 bv = *(const LAS bf16x8*)(VT + (vt * 16 + fr) * 144 + (kk * 32 + fq * 8) * 2);
                    acc = __builtin_amdgcn_mfma_f32_16x16x32_bf16(ap[kk], bv, acc, 0, 0, 0);
                }
#pragma unroll
                for (int kk = 0; kk < 4; ++kk) {
                    const bf16x8 bv = *(const LAS bf16x8*)(STc + (vt * 16 + fr) * 272 + (kk * 32 + fq * 8) * 2);
                    acc = __builtin_amdgcn_mfma_f32_16x16x32_bf16(ai[kk], bv, acc, 0, 0, 0);
                }
                ow[vti][0] = cvt_pk_bf16(acc[0], acc[1]); ow[vti][1] = cvt_pk_bf16(acc[2], acc[3]);
            }
#pragma unroll
            for (int vti = 0; vti < 2; ++vti)
#pragma unroll
                for (int j = 0; j < 4; ++j) { const unsigned w = ow[vti][j >> 1]; *(LAS bf16_t*)(PPW + (fq * 4 + j) * 144 + (vti * 16 + fr) * 2) = (bf16_t)((j & 1) ? (w >> 16) : (w & 0xffffu)); }
            bf16x8 ak[2]; const f32x4 blv = *(const LAS f32x4*)(BL + wave * 16 + fq * 4);
#pragma unroll
            for (int kk = 0; kk < 2; ++kk) ak[kk] = *(const LAS bf16x8*)(KOT + (wave * 16 + fr) * 144 + (((kk * 4 + fq) + wave) & 7) * 16);
#pragma unroll
            for (int vt = 0; vt < 4; ++vt) {
                Sacc[vt] *= blv;
#pragma unroll
                for (int kk = 0; kk < 2; ++kk) {
                    const bf16x8 bv = *(const LAS bf16x8*)(VT + (vt * 16 + fr) * 144 + (kk * 32 + fq * 8) * 2);
                    Sacc[vt] = __builtin_amdgcn_mfma_f32_16x16x32_bf16(ak[kk], bv, Sacc[vt], 0, 0, 0);
                }
                *(LAS u32x2*)(STn + (vt * 16 + fr) * 272 + (wave * 16 + fq * 4) * 2) = (u32x2){pk2(Sacc[vt][0], Sacc[vt][1]), pk2(Sacc[vt][2], Sacc[vt][3])};
            }
            if (n + 1 < 68) GLA_CUMSUM(par ^ 1);
            __syncthreads();
        }
        GLA_OSTORE(67);
    }
}
#undef GLA_OSTORE
#undef GLA_CUMSUM
#undef GLA_LOAD
__device__ __forceinline__ void gla_readout_phase(const Args& a, int lane, int gw, int NGW) {
    const bf16_t* OF = (const bf16_t*)(a.ws + WS_OF); const bf16_t* OB = (const bf16_t*)(a.ws + WS_OB);
    const bf16_t* G = (const bf16_t*)(a.ws + WS_G); bf16_t* OG = (bf16_t*)(a.ws + WS_OG);
    f32x4 ng[4];
#pragma unroll
    for (int j = 0; j < 4; ++j) ng[j] = *(const f32x4*)(a.in[I_HGNG] + 16 * lane + 4 * j);
    for (int row0 = gw * 4; row0 < NTOK; row0 += NGW * 4) {
        u32x4 of[4][2], ob[4][2], gg[4][2];
#pragma unroll
        for (int r = 0; r < 4; ++r) { const size_t o = (size_t)(row0 + r) * D + 16 * lane;
            of[r][0] = *(const u32x4*)(OF + o); of[r][1] = *(const u32x4*)(OF + o + 8); ob[r][0] = *(const u32x4*)(OB + o); ob[r][1] = *(const u32x4*)(OB + o + 8);
            gg[r][0] = *(const u32x4*)(G + o); gg[r][1] = *(const u32x4*)(G + o + 8); }
#pragma unroll
        for (int r = 0; r < 4; ++r) {
            float v[16]; float s = 0.f;
#pragma unroll
            for (int q = 0; q < 8; ++q) { const unsigned wf = of[r][q >> 2][q & 3], wb = ob[r][q >> 2][q & 3]; v[2 * q] = bflo(wf) + bflo(wb); v[2 * q + 1] = bfhi(wf) + bfhi(wb); s += v[2 * q] * v[2 * q] + v[2 * q + 1] * v[2 * q + 1]; }
            s += __shfl_xor(s, 1); s += __shfl_xor(s, 2); s += __shfl_xor(s, 4);
            const float rstd = 1.0f / sqrtf(s * (1.0f / 128.0f) + EPS);
            unsigned ow[8];
#pragma unroll
            for (int q = 0; q < 8; ++q) { const unsigned wg = gg[r][q >> 2][q & 3];
                ow[q] = pk2(v[2 * q] * rstd * ng[q >> 1][(2 * q) & 3] * silu_f(bflo(wg)), v[2 * q + 1] * rstd * ng[q >> 1][(2 * q + 1) & 3] * silu_f(bfhi(wg))); }
            const size_t o = (size_t)(row0 + r) * D + 16 * lane;
            *(u32x4*)(OG + o) = (u32x4){ow[0], ow[1], ow[2], ow[3]}; *(u32x4*)(OG + o + 8) = (u32x4){ow[4], ow[5], ow[6], ow[7]};
        }
    }
}

struct EpiMoe1 {
    static constexpr bool PERM = true;
    const float* b1; bf16_t* ACT;
    __device__ __forceinline__ void operator()(const f32x4 (&acc)[2][2][4][2], const Unit& u, int wr, int wc, int fr, int fq) const {
        const int e = u.pn >> 3, pnl = u.pn & 7, cb = pnl * 128 + wc * 32 + 8 * fq, row0 = u.pm * 256 + wr * 64 + fr;
        const float* bg = b1 + (size_t)e * 2048;
        const f32x4 bg0 = *(const f32x4*)(bg + cb), bg1 = *(const f32x4*)(bg + cb + 4), bl0 = *(const f32x4*)(bg + 1024 + cb), bl1 = *(const f32x4*)(bg + 1024 + cb + 4);
#pragma unroll
        for (int ai = 0; ai < 2; ++ai)
#pragma unroll
            for (int m = 0; m < 4; ++m) {
                f32x4 o[2];
#pragma unroll
                for (int n = 0; n < 2; ++n) {
                    const f32x4 zg = acc[ai][0][m][n] + (n ? bg1 : bg0), zl = acc[ai][1][m][n] + (n ? bl1 : bl0);
#pragma unroll
                    for (int j = 0; j < 4; ++j) { const float g_ = fminf(zg[j], 7.0f), l_ = fminf(fmaxf(zl[j], -7.0f), 7.0f); o[n][j] = g_ * sigmoid_f(1.702f * g_) * (l_ + 1.0f); }
                }
                *(u32x4*)(ACT + (size_t)(row0 + ai * 128 + m * 16) * D + cb) = (u32x4){pk2(o[0][0], o[0][1]), pk2(o[0][2], o[0][3]), pk2(o[1][0], o[1][1]), pk2(o[1][2], o[1][3])};
            }
    }
};
struct EpiMoe2 {
    static constexpr bool PERM = true;
    const float* b2; bf16_t* YS;
    __device__ __forceinline__ void operator()(const f32x4 (&acc)[2][2][4][2], const Unit& u, int wr, int wc, int fr, int fq) const {
        const int e = u.pn >> 2, pnl = u.pn & 3, cb = pnl * 256 + wc * 32 + 8 * fq, row0 = u.pm * 256 + wr * 64 + fr;
        const float* bb = b2 + (size_t)e * 1024;
#pragma unroll
        for (int bj = 0; bj < 2; ++bj) {
            const int c = cb + bj * 128; const f32x4 bv0 = *(const f32x4*)(bb + c), bv1 = *(const f32x4*)(bb + c + 4);
#pragma unroll
            for (int ai = 0; ai < 2; ++ai)
#pragma unroll
                for (int m = 0; m < 4; ++m) {
                    const f32x4 v0 = acc[ai][bj][m][0] + bv0, v1 = acc[ai][bj][m][1] + bv1;
                    *(u32x4*)(YS + (size_t)(row0 + ai * 128 + m * 16) * D + c) = (u32x4){pk2(v0[0], v0[1]), pk2(v0[2], v0[3]), pk2(v1[0], v1[1]), pk2(v1[2], v1[3])};
                }
        }
    }
};

__device__ __forceinline__ void router_phase(const Args& a, LAS unsigned char* lds, int layer, int row_lo, int tid) {
    const int lane = tid & 63, wave = tid >> 6, fr = lane & 15, fq = lane >> 4;
    const bf16_t* H = (const bf16_t*)(a.ws + WS_H); bf16_t* F = (bf16_t*)(a.ws + WS_F);
    const float* modv = (const float*)(a.ws + WS_MODV) + (size_t)layer * 9 * 6144;
    int* TOKE = (int*)(a.ws + WS_TOKE); float* TOKW = (float*)(a.ws + WS_TOKW);
    unsigned* cntb = (unsigned*)(a.ws + WS_CTL) + CW_CNTB + layer * 8192;
    LAS float* FS = (LAS float*)lds;
    LAS float* PART = (LAS float*)(lds + 16 * 1028 * 4);
    LAS int* hist = (LAS int*)(lds + 16 * 1028 * 4 + 16384);
    if (tid < 32) hist[tid] = 0;
    const float* n2g = a.in[I_N2G] + layer * D; const float* rw = a.in[I_RW] + (size_t)layer * D * NE; const float* rb = a.in[I_RB] + layer * NE;
    float rwr[2][32];
#pragma unroll
    for (int s = 0; s < 32; ++s) { rwr[0][s] = rw[(size_t)(wave * 128 + 4 * s + fq) * NE + fr]; rwr[1][s] = rw[(size_t)(wave * 128 + 4 * s + fq) * NE + 16 + fr]; }
    const int ngroups = (NTOK - row_lo) >> 4;
    f32x4 vv[2][4], gvv[4], scvv[4], shvv[4];
#pragma unroll
    for (int j = 0; j < 4; ++j) gvv[j] = *(const f32x4*)(n2g + 4 * lane + 256 * j);
#define RT_LOAD(gi_) do { _Pragma("unroll") for (int rr = 0; rr < 2; ++rr) _Pragma("unroll") for (int j = 0; j < 4; ++j) \
        vv[rr][j] = ld_bf16x4(H + (size_t)(row_lo + (gi_) * 16 + 2 * wave + rr) * D + 4 * lane + 256 * j); \
        { const float* mvp_ = modv + (size_t)mod_row(row_lo + (gi_) * 16) * 6144; _Pragma("unroll") for (int j = 0; j < 4; ++j) { scvv[j] = *(const f32x4*)(mvp_ + 4096 + 4 * lane + 256 * j); shvv[j] = *(const f32x4*)(mvp_ + 3072 + 4 * lane + 256 * j); } } } while (0)
    if ((int)blockIdx.x < ngroups) RT_LOAD(blockIdx.x);
    int pend_i = 0; float pend_w = 0.f; long pend_o = -1;
    for (int gi = blockIdx.x; gi < ngroups; gi += gridDim.x) {
        const int row0 = row_lo + gi * 16;
        __syncthreads();
#pragma unroll
        for (int rr = 0; rr < 2; ++rr) {
            const int rl = 2 * wave + rr, row = row0 + rl; const f32x4 (&v)[4] = vv[rr];
            const float rstd = row_rstd(v);
#pragma unroll
            for (int j = 0; j < 4; ++j) {
                const int c = 4 * lane + 256 * j;
                const f32x4 f = v[j] * rstd * gvv[j] * (scvv[j] + 1.0f) + shvv[j];
                st_bf16x4(F + (size_t)row * D + c, f);
                *(LAS f32x4*)(FS + rl * 1028 + c) = f;
            }
        }
        if (pend_o >= 0) { TOKE[pend_o] = pend_i; TOKW[pend_o] = pend_w; pend_o = -1; }
        if (gi + (int)gridDim.x < ngroups) RT_LOAD(gi + gridDim.x);
        __syncthreads();
        f32x4 acc0 = (f32x4){0.f, 0.f, 0.f, 0.f}, acc1 = (f32x4){0.f, 0.f, 0.f, 0.f};
#pragma unroll
        for (int s = 0; s < 32; ++s) {
            const float av = FS[fr * 1028 + wave * 128 + 4 * s + fq];
            acc0 = __builtin_amdgcn_mfma_f32_16x16x4f32(av, rwr[0][s], acc0, 0, 0, 0);
            acc1 = __builtin_amdgcn_mfma_f32_16x16x4f32(av, rwr[1][s], acc1, 0, 0, 0);
        }
#pragma unroll
        for (int j = 0; j < 4; ++j) { PART[(wave * 16 + fq * 4 + j) * 32 + fr] = acc0[j]; PART[(wave * 16 + fq * 4 + j) * 32 + 16 + fr] = acc1[j]; }
        __syncthreads();
        {
            const int half = lane >> 5, e = lane & 31, rl = 2 * wave + half, row = row0 + rl;
            float lg = rb[e];
#pragma unroll
            for (int w = 0; w < 8; ++w) lg += PART[(w * 16 + rl) * 32 + e];
            float sv[4]; int si[4];
#pragma unroll
            for (int r = 0; r < 4; ++r) {
                float m = lg;
#pragma unroll
                for (int o = 1; o < 32; o <<= 1) m = fmaxf(m, __shfl_xor(m, o));
                const unsigned long long bal = __ballot(lg == m); const unsigned mine = (unsigned)(bal >> (32 * half));
                const int idx = __ffs((int)mine) - 1;
                sv[r] = m; si[r] = idx; if (e == idx) lg = -3.0e38f;
            }
            const float e1 = __expf(sv[1] - sv[0]), e2 = __expf(sv[2] - sv[0]), e3 = __expf(sv[3] - sv[0]); const float inv = 1.0f / (1.0f + e1 + e2 + e3);
            if (e < 4) {
                const int myi = e == 0 ? si[0] : (e == 1 ? si[1] : (e == 2 ? si[2] : si[3]));
                const float myw = (e == 0 ? 1.0f : (e == 1 ? e1 : (e == 2 ? e2 : e3))) * inv;
                pend_i = myi; pend_w = myw; pend_o = (long)row * 4 + e;
                atomicAdd((int*)hist + myi, 1);
            }
        }
    }
    if (pend_o >= 0) { TOKE[pend_o] = pend_i; TOKW[pend_o] = pend_w; }
    __syncthreads();
    if (tid < 32) cntb[(size_t)blockIdx.x * 32 + tid] = (unsigned)hist[tid];
}
#undef RT_LOAD
__device__ __forceinline__ void assign_phase(const Args& a, LAS unsigned char* lds, int layer, int row_lo, int tid) {
    const int lane = tid & 63, wave = tid >> 6;
    const unsigned* cntb = (const unsigned*)(a.ws + WS_CTL) + CW_CNTB + layer * 8192; unsigned* gcnt = (unsigned*)(a.ws + WS_CTL) + CW_CNT + layer * 64;
    const bf16_t* F = (const bf16_t*)(a.ws + WS_F); bf16_t* AG = (bf16_t*)(a.ws + WS_AG);
    const int* TOKE = (const int*)(a.ws + WS_TOKE); int* TOKS = (int*)(a.ws + WS_TOKS);
    LAS int* off = (LAS int*)lds; LAS int* cnt = (LAS int*)(lds + 256); LAS int* base = (LAS int*)(lds + 512); LAS int* cur = (LAS int*)(lds + 768);
    LAS int* pa = (LAS int*)(lds + 1024); LAS int* pl = (LAS int*)(lds + 1024 + 2048);
    {
        const int e = tid & 31, part = tid >> 5; int s_all = 0, s_lt = 0;
        for (int bb = part; bb < (int)gridDim.x; bb += 16) { const int c = (int)cntb[(size_t)bb * 32 + e]; s_all += c; if (bb < (int)blockIdx.x) s_lt += c; }
        pa[part * 32 + e] = s_all; pl[part * 32 + e] = s_lt;
    }
    __syncthreads();
    if (tid < 32) { int s_all = 0, s_lt = 0; for (int p = 0; p < 16; ++p) { s_all += pa[p * 32 + tid]; s_lt += pl[p * 32 + tid]; } cnt[tid] = s_all; base[tid] = s_lt; cur[tid] = 0; if (blockIdx.x == 0) gcnt[tid] = (unsigned)s_all; }
    __syncthreads();
    if (tid == 0) { int o = 0; for (int e = 0; e < 32; ++e) { off[e] = o; o += ((cnt[e] + 255) >> 8) << 8; } }
    __syncthreads();
    if (tid < 32) base[tid] += off[tid];
    __syncthreads();
    const int gw = blockIdx.x * 8 + wave, NGW = gridDim.x * 8;
    int* SLOTTOK = (int*)(a.ws + WS_SLOTTOK);
    for (int idx = blockIdx.x * NTHREADS + tid; idx < 32 * 256; idx += gridDim.x * NTHREADS) {
        const int e = idx >> 8, c = cnt[e], r = c + (idx & 255), padded = ((c + 255) >> 8) << 8;
        if (r < padded) SLOTTOK[off[e] + r] = 0;
    }
    const int ngroups = (NTOK - row_lo) >> 4;
    for (int gi = blockIdx.x; gi < ngroups; gi += gridDim.x) {
        const int r0 = row_lo + gi * 16 + 2 * wave;
        if (lane < 8) { const int e = TOKE[(size_t)r0 * 4 + lane]; const int pos = atomicAdd((int*)cur + e, 1); const int slot = base[e] + pos; TOKS[(size_t)r0 * 4 + lane] = slot; SLOTTOK[slot] = r0 + (lane >> 2); }
    }
    (void)gw; (void)NGW; (void)F; (void)AG;
}
__device__ __forceinline__ int moe_tiles(const Args& a, LAS unsigned char* lds, int layer, int tid) {
    const unsigned* gcnt = (const unsigned*)(a.ws + WS_CTL) + CW_CNT + layer * 64;
    LAS int* tbl = (LAS int*)(lds + 131072 + 1024);
    if (tid == 0) { int t = 0; for (int e = 0; e < 32; ++e) { const int nt = ((int)gcnt[e] + 255) >> 8; for (int k = 0; k < nt; ++k) tbl[t++] = e; } tbl[1000] = t; }
    __syncthreads();
    return tbl[1000];
}
__device__ __forceinline__ void combine_phase(const Args& a, int layer, int row_lo, int lane, int gw, int NGW) {
    bf16_t* H = (bf16_t*)(a.ws + WS_H); const bf16_t* YS = (const bf16_t*)(a.ws + WS_YS);
    const int* TOKS = (const int*)(a.ws + WS_TOKS); const float* TOKW = (const float*)(a.ws + WS_TOKW);
    const float* modv = (const float*)(a.ws + WS_MODV);
    for (int row0 = row_lo + gw * 2; row0 < NTOK; row0 += NGW * 2) {
        const int mr = mod_row(row0);
        u32x4 sl[2]; f32x4 wv[2];
#pragma unroll
        for (int r = 0; r < 2; ++r) { sl[r] = *(const u32x4*)(TOKS + (size_t)(row0 + r) * 4); wv[r] = *(const f32x4*)(TOKW + (size_t)(row0 + r) * 4); }
        u32x2 ys[2][4][4]; f32x4 hv[2][4];
#pragma unroll
        for (int r = 0; r < 2; ++r)
#pragma unroll
            for (int j = 0; j < 4; ++j) {
                hv[r][j] = ld_bf16x4(H + (size_t)(row0 + r) * D + 4 * lane + 256 * j);
#pragma unroll
                for (int k = 0; k < 4; ++k) ys[r][k][j] = *(const u32x2*)(YS + (size_t)sl[r][k] * D + 4 * lane + 256 * j);
            }
        const float* g2 = modv + (size_t)(layer * 9 + mr) * 6144 + 5120;
        f32x4 g2v[4];
#pragma unroll
        for (int j = 0; j < 4; ++j) g2v[j] = *(const f32x4*)(g2 + 4 * lane + 256 * j);
        ModVec m;
        if (layer == 0) { const float* mv = modv + (size_t)(9 + mr) * 6144; modvec_load(m, a.in[I_N1G] + D, mv + 1024, mv, lane); }
        else {
#pragma unroll
            for (int j = 0; j < 4; ++j) m.g[j] = *(const f32x4*)(a.in[I_FG] + 4 * lane + 256 * j);
        }
#pragma unroll
        for (int r = 0; r < 2; ++r) {
            const int row = row0 + r; f32x4 v[4];
#pragma unroll
            for (int j = 0; j < 4; ++j) {
                const int c = 4 * lane + 256 * j; f32x4 y = (f32x4){0.f, 0.f, 0.f, 0.f};
#pragma unroll
                for (int k = 0; k < 4; ++k) { const u32x2 w = ys[r][k][j]; y += (f32x4){bflo(w.x), bfhi(w.x), bflo(w.y), bfhi(w.y)} * wv[r][k]; }
                v[j] = hv[r][j] + g2v[j] * y;
                if (layer == 0) st_bf16x4(H + (size_t)row * D + c, v[j]);
            }
            const float rstd = row_rstd(v);
            if (layer == 0) {
                int orow = row;
                if (row >= NCTX) { const int li = row - NCTX, b = li >> 12, t = li & 4095; orow = NCTX + b * SEQ + (t & 63) * 64 + (t >> 6); }
                norm_mod_store(v, rstd, m, (bf16_t*)(a.ws + WS_A) + (size_t)orow * D, lane);
            } else {
#pragma unroll
                for (int j = 0; j < 4; ++j) { const int c = 4 * lane + 256 * j; *(f32x4*)(a.out + (size_t)(row - NCTX) * D + c) = v[j] * rstd * m.g[j]; }
            }
        }
    }
}
__device__ __forceinline__ void moe_gemm1(const Args& a, LAS unsigned char* lds, int layer, int tid, int G, int vcu) {
    unsigned char* ws = a.ws;
    const int TT = moe_tiles(a, lds, layer, tid);
    const LAS int* tbl = (const LAS int*)(lds + 131072 + 1024);
    pg8::Gemm g{(const bf16_t*)(ws + WS_F), (const bf16_t*)(ws + WS_W1) + (size_t)layer * 32 * 2048 * 1024, MPAD, 32 * 2048, 1024};
    pg8::MoeOrder S{tbl, TT, 3, G, vcu};
    EpiMoe1 E{a.in[I_B1] + (size_t)layer * 32 * 2048, (bf16_t*)(ws + WS_ACT)};
    LAS unsigned short* rowl = (LAS unsigned short*)(lds + 136192);
    { const int* slottok = (const int*)(ws + WS_SLOTTOK); pg8::Unit uu; int t2 = threadIdx.x; asm volatile("" : "+v"(t2)); const int tid = t2;
      for (int i = 0; i < 21; i += 2) { const int ii = i + (tid >> 8); if (ii < 21 && S.next(ii, uu)) rowl[ii * 256 + (tid & 255)] = (unsigned short)slottok[uu.pm * 256 + (tid & 255)]; } }
    __syncthreads();
    pg8::gemm_phase<EpiMoe1, pg8::MoeOrder, true>(lds, g, S, E, rowl);
}
__device__ __forceinline__ void moe_gemm2(const Args& a, LAS unsigned char* lds, int layer, int tid, int G, int vcu) {
    unsigned char* ws = a.ws;
    const int TT = moe_tiles(a, lds, layer, tid);
    const LAS int* tbl = (const LAS int*)(lds + 131072 + 1024);
    pg8::Gemm g{(const bf16_t*)(ws + WS_ACT), (const bf16_t*)(ws + WS_W2) + (size_t)layer * 32 * 1024 * 1024, MPAD, 32 * 1024, 1024};
    pg8::MoeOrder S{tbl, TT, 2, G, vcu};
    EpiMoe2 E{a.in[I_B2] + (size_t)layer * 32 * 1024, (bf16_t*)(ws + WS_YS)};
    pg8::gemm_phase<EpiMoe2, pg8::MoeOrder>(lds, g, S, E);
}


__device__ __forceinline__ void s5_disc(const Args& a, int d, int g, int p, float& ab_re, float& ab_im, float& co_re, float& co_im) {
    const float lam_re = fminf(a.in[I_S5ARE][(d * 64 + g) * 64 + p], -1e-4f), lam_im = a.in[I_S5AIM][(d * 64 + g) * 64 + p];
    const float dt = expf(a.in[I_S5LDT][d * 64 + g]);
    const float mag = expf(lam_re * dt), ang = lam_im * dt;
    ab_re = mag * cosf(ang); ab_im = mag * sinf(ang);
    const float den = lam_re * lam_re + lam_im * lam_im;
    co_re = ((ab_re - 1.0f) * lam_re + ab_im * lam_im) / den;
    co_im = (ab_im * lam_re - (ab_re - 1.0f) * lam_im) / den;
}
__device__ __forceinline__ void s5_phase(const Args& a, LAS unsigned char* lds, int tid) {
    const int lane = tid & 63, wave = tid >> 6, fr = lane & 15, fq = lane >> 4;
    if (wave >= 4) {
        LAS unsigned* scr = (LAS unsigned*)(lds + 102400 + (wave - 4) * 8320);
        const int cw = blockIdx.x * 4 + (wave - 4), NCW = gridDim.x * 4;
#define L1_ITEM(i) moe_item(a, (i), 1)
        TR_LOOP(cw, NCW, 32 * 512 + 32 * 256, L1_ITEM);
#undef L1_ITEM
        return;
    }
    LAS unsigned char* wl = lds + wave * 25600;
    const bf16_t* A1 = (const bf16_t*)(a.ws + WS_A);
    for (int item = blockIdx.x; item < 256; item += gridDim.x) {
        const int b = item >> 5, dir = (item >> 4) & 1, g = (item & 15) * 4 + wave;
        bf16_t* Y = (bf16_t*)(a.ws + (dir ? WS_YB : WS_YF));
        float ab_re, ab_im, cr_, ci_;
        s5_disc(a, dir, g, lane, ab_re, ab_im, cr_, ci_);
        bf16x8 Bd[8], Cf[4];
        {
            f32x4 cre[4], cim[4];
#pragma unroll
            for (int kk = 0; kk < 4; ++kk) { const size_t o = ((size_t)(dir * 64 + g) * 16 + fr) * 64 + kk * 16 + fq * 4; cre[kk] = *(const f32x4*)(a.in[I_S5CRE] + o); cim[kk] = *(const f32x4*)(a.in[I_S5CIM] + o); }
#pragma unroll
            for (int kk = 0; kk < 4; ++kk)
#pragma unroll
                for (int j = 0; j < 8; ++j) Cf[kk][j] = (short)f2bf((j & 1) ? -cim[kk][j >> 1] : cre[kk][j >> 1]);
#pragma unroll
            for (int hg = 0; hg < 2; ++hg) {
                f32x4 br0[4], br1[4], bi0[4], bi1[4];
#pragma unroll
                for (int q = 0; q < 4; ++q) {
                    const int pp = (hg * 4 + q) * 8 + (fr >> 1); const size_t o = (size_t)(g * 64 + pp) * 16 + (fq & 1) * 8;
                    br0[q] = *(const f32x4*)(a.in[I_S5BRE] + o); br1[q] = *(const f32x4*)(a.in[I_S5BRE] + o + 4); bi0[q] = *(const f32x4*)(a.in[I_S5BIM] + o); bi1[q] = *(const f32x4*)(a.in[I_S5BIM] + o + 4);
                }
#pragma unroll
                for (int q = 0; q < 4; ++q) {
                    const int pt = hg * 4 + q, pp = pt * 8 + (fr >> 1); const float qr = __shfl(cr_, pp), qi = __shfl(ci_, pp);
#pragma unroll
                    for (int j = 0; j < 8; ++j) {
                        const float br = j < 4 ? br0[q][j & 3] : br1[q][j & 3], bi = j < 4 ? bi0[q][j & 3] : bi1[q][j & 3];
                        float v = (fr & 1) ? (qr * bi + qi * br) : (qr * br - qi * bi);
                        if (fq >= 2) v = 0.f;
                        Bd[pt][j] = (short)f2bf(v);
                    }
                }
                asm volatile("" ::: "memory");
            }
        }
#define S5_POS(n_, t_) ((((n_) < 8) ? (n_) : (n_) - 8) * 32 + (t_))
#define S5_ROW(n_, t_) ((((n_) < 8) ? b * CTXL : NCTX + b * SEQ) + (dir ? (((n_) < 8) ? CTXL : SEQ) - 1 - S5_POS(n_, t_) : S5_POS(n_, t_)))
#define S5_LOADU(d0, d1, n_) do { d0 = (bf16x8){0, 0, 0, 0, 0, 0, 0, 0}; d1 = d0; if (fq < 2 && (n_) < 136) { d0 = *(const bf16x8*)(A1 + (size_t)S5_ROW(n_, fr) * D + g * 16 + fq * 8); d1 = *(const bf16x8*)(A1 + (size_t)S5_ROW(n_, 16 + fr) * D + g * 16 + fq * 8); } } while (0)
        LAS float* BUF = (LAS float*)wl; LAS unsigned* HW = (LAS unsigned*)(wl + 16896); const LAS unsigned char* HP = wl + 16896;
        bf16x8 ua0, ua1, ub0, ub1;
        S5_LOADU(ua0, ua1, 0);
        f32x2 s = (f32x2){0.f, 0.f};
        const f32x2 abr = (f32x2){ab_re, ab_re}, abi = (f32x2){-ab_im, ab_im};
        bf16_t* yp = Y + (size_t)(b * SEQ + (dir ? SEQ - 1 - fq * 4 : fq * 4)) * D + g * 16 + fr;
        const long ystep = dir ? -(long)D : (long)D;
        unsigned yw[4] = {0u, 0u, 0u, 0u};
#define S5_YSTORE() do { yp[0] = (bf16_t)(yw[0] & 0xffffu); yp[ystep] = (bf16_t)(yw[0] >> 16); yp[2 * ystep] = (bf16_t)(yw[1] & 0xffffu); yp[3 * ystep] = (bf16_t)(yw[1] >> 16); \
            yp[16 * ystep] = (bf16_t)(yw[2] & 0xffffu); yp[17 * ystep] = (bf16_t)(yw[2] >> 16); yp[18 * ystep] = (bf16_t)(yw[3] & 0xffffu); yp[19 * ystep] = (bf16_t)(yw[3] >> 16); yp += 32 * ystep; } while (0)
        for (int n = 0; n < 136; ++n) {
#pragma unroll
            for (int hf = 0; hf < 2; ++hf)
#pragma unroll
                for (int pt = 0; pt < 8; ++pt) {
                    const f32x4 z = (f32x4){0.f, 0.f, 0.f, 0.f};
                    const f32x4 d = __builtin_amdgcn_mfma_f32_16x16x32_bf16(hf ? ua1 : ua0, Bd[pt], z, 0, 0, 0);
#pragma unroll
                    for (int j = 0; j < 4; ++j) BUF[(hf * 16 + fq * 4 + j) * 132 + pt * 16 + fr] = d[j];
                }
            if (n >= 9) S5_YSTORE();
            S5_LOADU(ub0, ub1, n + 1);
            LDS_WAIT();
            {
                const bool hist = n >= 8;
                f32x2 bu[32];
#pragma unroll
                for (int j = 0; j < 32; ++j) bu[j] = *(const LAS f32x2*)(BUF + j * 132 + 2 * lane);
                unsigned hw[32];
#pragma unroll
                for (int j = 0; j < 32; ++j) { const f32x2 t1 = abr * s + bu[j]; s = abi * (f32x2){s.y, s.x} + t1; hw[j] = cvt_pk_bf16(s.x, s.y); }
                if (hist) {
#pragma unroll
                    for (int j = 0; j < 32; ++j) HW[j * 68 + lane] = hw[j];
                }
            }
            LDS_WAIT();
            if (n >= 8) {
                f32x4 y0 = (f32x4){0.f, 0.f, 0.f, 0.f}, y1 = (f32x4){0.f, 0.f, 0.f, 0.f};
                bf16x8 ha[2][4];
#pragma unroll
                for (int hf = 0; hf < 2; ++hf)
#pragma unroll
                    for (int kk = 0; kk < 4; ++kk) ha[hf][kk] = *(const LAS bf16x8*)(HP + (hf * 16 + fr) * 272 + (kk * 32 + fq * 8) * 2);
#pragma unroll
                for (int kk = 0; kk < 4; ++kk) { y0 = __builtin_amdgcn_mfma_f32_16x16x32_bf16(ha[0][kk], Cf[kk], y0, 0, 0, 0); y1 = __builtin_amdgcn_mfma_f32_16x16x32_bf16(ha[1][kk], Cf[kk], y1, 0, 0, 0); }
                yw[0] = cvt_pk_bf16(y0[0], y0[1]); yw[1] = cvt_pk_bf16(y0[2], y0[3]); yw[2] = cvt_pk_bf16(y1[0], y1[1]); yw[3] = cvt_pk_bf16(y1[2], y1[3]);
                LDS_WAIT();
            }
            ua0 = ub0; ua1 = ub1;
        }
        S5_YSTORE();
#undef S5_YSTORE
#undef S5_POS
#undef S5_ROW
#undef S5_LOADU
    }
}
__device__ __forceinline__ float gelu_tanh_f(float x) { const float z = 0.7978845608f * (x + 0.044715f * x * x * x); return x * (1.0f - __builtin_amdgcn_rcpf(1.0f + __expf(2.0f * z))); }
__device__ __forceinline__ void s5_post_phase(const Args& a, int lane, int gw, int NGW) {
    const bf16_t* YF = (const bf16_t*)(a.ws + WS_YF); const bf16_t* YB = (const bf16_t*)(a.ws + WS_YB);
    const bf16_t* A1 = (const bf16_t*)(a.ws + WS_A); bf16_t* YG = (bf16_t*)(a.ws + WS_YG);
    f32x4 dk[4];
#pragma unroll
    for (int j = 0; j < 4; ++j) dk[j] = *(const f32x4*)(a.in[I_S5D] + 4 * lane + 256 * j);
    for (int tok0 = gw * 4; tok0 < NLAT; tok0 += NGW * 4) {
        u32x2 yf[4][4], yb[4][4], uu[4][4];
#pragma unroll
        for (int r = 0; r < 4; ++r) { const int tok = tok0 + r, b = tok >> 12, t = tok & 4095, src = b * SEQ + (t & 63) * 64 + (t >> 6);
#pragma unroll
            for (int j = 0; j < 4; ++j) { const int c = 4 * lane + 256 * j; yf[r][j] = *(const u32x2*)(YF + (size_t)src * D + c); yb[r][j] = *(const u32x2*)(YB + (size_t)src * D + c); uu[r][j] = *(const u32x2*)(A1 + (size_t)(NCTX + src) * D + c); } }
#pragma unroll
        for (int r = 0; r < 4; ++r)
#pragma unroll
            for (int j = 0; j < 4; ++j) {
                const u32x2 f = yf[r][j], bk = yb[r][j], uw = uu[r][j];
                const f32x4 y = (f32x4){bflo(f.x) + bflo(bk.x), bfhi(f.x) + bfhi(bk.x), bflo(f.y) + bflo(bk.y), bfhi(f.y) + bfhi(bk.y)} + dk[j] * (f32x4){bflo(uw.x), bfhi(uw.x), bflo(uw.y), bfhi(uw.y)};
                f32x4 o;
#pragma unroll
                for (int i = 0; i < 4; ++i) o[i] = gelu_tanh_f(y[i]);
                st_bf16x4(YG + (size_t)(tok0 + r) * D + 4 * lane + 256 * j, o);
            }
    }
}
struct EpiGlu {
    static constexpr bool PERM = true;
    const float* bglu; const float* modv1; bf16_t* H;
    __device__ __forceinline__ void operator()(const f32x4 (&acc)[2][2][4][2], const Unit& u, int wr, int wc, int fr, int fq) const {
        const int rt0 = u.pm * 256, bidx = rt0 >> 12, cb = u.pn * 128 + wc * 32 + 8 * fq, rl0 = wr * 64 + fr;
        const float* gp = modv1 + bidx * 6144 + 2048;
        const f32x4 ba0 = *(const f32x4*)(bglu + cb), ba1 = *(const f32x4*)(bglu + cb + 4), bb0 = *(const f32x4*)(bglu + 1024 + cb), bb1 = *(const f32x4*)(bglu + 1024 + cb + 4);
        const f32x4 gv0 = *(const f32x4*)(gp + cb), gv1 = *(const f32x4*)(gp + cb + 4);
        u32x4 hws[2][4];
#pragma unroll
        for (int ai = 0; ai < 2; ++ai)
#pragma unroll
            for (int m = 0; m < 4; ++m) hws[ai][m] = *(const u32x4*)(H + (size_t)(NCTX + rt0 + rl0 + ai * 128 + m * 16) * D + cb);
#pragma unroll
        for (int ai = 0; ai < 2; ++ai)
#pragma unroll
            for (int m = 0; m < 4; ++m) {
                bf16_t* hp = H + (size_t)(NCTX + rt0 + rl0 + ai * 128 + m * 16) * D + cb;
                const u32x4 hw = hws[ai][m]; const f32x4 h0 = (f32x4){bflo(hw.x), bfhi(hw.x), bflo(hw.y), bfhi(hw.y)}, h1 = (f32x4){bflo(hw.z), bfhi(hw.z), bflo(hw.w), bfhi(hw.w)};
                const f32x4 za0 = acc[ai][0][m][0] + ba0, za1 = acc[ai][0][m][1] + ba1, zb0 = acc[ai][1][m][0] + bb0, zb1 = acc[ai][1][m][1] + bb1; f32x4 o0, o1;
#pragma unroll
                for (int j = 0; j < 4; ++j) { o0[j] = za0[j] * sigmoid_f(zb0[j]); o1[j] = za1[j] * sigmoid_f(zb1[j]); }
                const f32x4 r0 = h0 + gv0 * o0, r1 = h1 + gv1 * o1;
                *(u32x4*)hp = (u32x4){pk2(r0[0], r0[1]), pk2(r0[2], r0[3]), pk2(r1[0], r1[1]), pk2(r1[2], r1[3])};
            }
    }
};

#define XB_TMO      128
#define XB_XCNT(j)  (256  + 64 * (j))
#define XB_XSUB(j)  (1280 + 64 * (j))
#define XB_XGEN(j)  (2304 + 64 * (j))
#define XB_TOP      3328
#define XB_TOPGEN   3392
#define XCD_BAR_WORDS 3456
#define XB_SPIN_CAP (1u << 18)
__device__ __forceinline__ unsigned xb_ld(unsigned* p)              { return __hip_atomic_load(p, __ATOMIC_RELAXED, __HIP_MEMORY_SCOPE_AGENT); }
__device__ __forceinline__ unsigned xb_add(unsigned* p, unsigned v) { return __hip_atomic_fetch_add(p, v, __ATOMIC_RELAXED, __HIP_MEMORY_SCOPE_AGENT); }
__device__ __forceinline__ unsigned xb_xcc_id() { return (unsigned)__builtin_amdgcn_s_getreg((3 << 11) | 20) & 0xFu; }
#define XB_SPIN(cond, bar) do { unsigned _sp = 0; while (cond) { __builtin_amdgcn_s_sleep(1); \
    if ((++_sp & 255u) == 0u) { if (xb_ld(&(bar)[XB_TMO])) break; if (_sp > XB_SPIN_CAP) { atomicAdd(&(bar)[XB_TMO], 1u); break; } } } } while (0)
struct XcdBarrier { unsigned* bar; unsigned x; volatile LAS unsigned* st; };
__device__ __forceinline__ XcdBarrier xcd_barrier_post(unsigned* bar, volatile LAS unsigned* st) {
    XcdBarrier b; b.bar = bar; b.x = xb_xcc_id(); b.st = st;
    if (threadIdx.x == 0) (void)xb_add(&bar[XB_XCNT(b.x)], 1u);
    return b;
}
__device__ __forceinline__ void xcd_barrier_complete(unsigned* bar, unsigned x, unsigned& nloc, unsigned& nx) {
    const unsigned G = gridDim.x * gridDim.y * gridDim.z;
    unsigned sum, cnt, mine, sp = 0u;
    for (;;) {
        sum = 0u; cnt = 0u; mine = 0u;
#pragma unroll
        for (unsigned j = 0; j < 16; ++j) { const unsigned c = xb_ld(&bar[XB_XCNT(j)]); sum += c; cnt += (c > 0u) ? 1u : 0u; mine = (j == x) ? c : mine; }
        if (sum == G) break;
        __builtin_amdgcn_s_sleep(1);
        if ((++sp & 255u) == 0u) { if (xb_ld(&bar[XB_TMO])) break; if (sp > XB_SPIN_CAP) { atomicAdd(&bar[XB_TMO], 1u); break; } }
    }
    nloc = mine > 0u ? mine : 1u; nx = cnt > 0u ? cnt : 1u;
}
__device__ __forceinline__ void xcd_barrier(const XcdBarrier& b) {
    asm volatile("s_waitcnt vmcnt(0)" ::: "memory");
    __syncthreads();
    if (threadIdx.x == 0) {
        unsigned* bar = b.bar;
        __builtin_amdgcn_s_waitcnt(0);
        unsigned nloc = b.st[0], nx = b.st[1];
        if (nloc == 0u) { xcd_barrier_complete(bar, b.x, nloc, nx); b.st[0] = nloc; b.st[1] = nx; }
        const unsigned old = xb_add(&bar[XB_XSUB(b.x)], 1u);
        const unsigned gen = old / nloc;
        if (old + 1u == (gen + 1u) * nloc) {
            __builtin_amdgcn_fence(__ATOMIC_RELEASE, "agent");
            asm volatile("s_waitcnt vmcnt(0)" ::: "memory");
            const unsigned og = xb_add(&bar[XB_TOP], 1u);
            const unsigned tg = og / nx;
            if (og + 1u == (tg + 1u) * nx) xb_add(&bar[XB_TOPGEN], 1u);
            else XB_SPIN(xb_ld(&bar[XB_TOPGEN]) == tg, bar);
            __builtin_amdgcn_fence(__ATOMIC_ACQUIRE, "agent");
            xb_add(&bar[XB_XGEN(b.x)], 1u);
            asm volatile("s_waitcnt vmcnt(0)" ::: "memory");
        } else {
            XB_SPIN(xb_ld(&bar[XB_XGEN(b.x)]) == gen, bar);
            __builtin_amdgcn_fence(__ATOMIC_ACQUIRE, "agent");
            asm volatile("s_waitcnt vmcnt(0)" ::: "memory");
        }
    }
    __syncthreads();
}

__device__ __forceinline__ int opaque_tid() { int t = threadIdx.x; asm volatile("" : "+v"(t)); return t; }
#define PHASE_IDS() const int tid = opaque_tid(); const int lane = tid & 63, wave = tid >> 6; const int G = gridDim.x, gw = blockIdx.x * 8 + wave, NGW = G * 8; \
    const int vcu = (G % 8 == 0) ? (int)(blockIdx.x % 8) * (G / 8) + (int)(blockIdx.x / 8) : (int)blockIdx.x; (void)lane; (void)wave; (void)gw; (void)NGW; (void)vcu; (void)G
__global__ void __launch_bounds__(NTHREADS, 2) fwd_mega(Args a) {
    extern __shared__ __attribute__((aligned(16))) unsigned char lds_raw[];
    LAS unsigned char* lds = (LAS unsigned char*)lds_raw;
    cg::grid_group grid = cg::this_grid();
    unsigned char* ws = a.ws;
    if (threadIdx.x < 2) ((LAS unsigned*)(lds + LDS_BYTES - 16))[threadIdx.x] = 0u;
    __syncthreads();
    const XcdBarrier xbar = xcd_barrier_post((unsigned*)(ws + WS_CTL) + CW_BAR, (volatile LAS unsigned*)(lds + LDS_BYTES - 16));
#ifdef TS_SEL
    volatile LAS unsigned long long* tsbuf = (volatile LAS unsigned long long*)(lds + LDS_BYTES - 16 - 256);
    int tsn = 0;
#define TS_MARK() do { if (blockIdx.x == 0 && threadIdx.x == 0) tsbuf[tsn] = __builtin_amdgcn_s_memrealtime(); ++tsn; } while (0)
#else
#define TS_MARK() do { } while (0)
#endif
    TS_MARK();
#define GSYNC() do { xcd_barrier(xbar); TS_MARK(); } while (0)

    for (int rep = 0; rep < REP_P0; ++rep) { PHASE_IDS(); p0_phase(a, lds, tid, gw, NGW); if (REP_P0 > 1) __syncthreads(); }
    if (a.pad1 != 0) grid.sync();
    GSYNC();
    for (int rep = 0; rep < REP_P1; ++rep) { PHASE_IDS(); p1_phase(a, lane, gw, NGW); }
    GSYNC();
    {
        PHASE_IDS();
        pg8::Gemm g{(const bf16_t*)(ws + WS_A), (const bf16_t*)(ws + WS_WIN), NTOK, 5120, 1024};
        pg8::StaticOrder S; S.init(NTOK, 5120, G, (int)blockIdx.x);
        EpiInProj E{(bf16_t*)(ws + WS_Q), (bf16_t*)(ws + WS_V), (bf16_t*)(ws + WS_G), (_Float16*)(ws + WS_LFF), (_Float16*)(ws + WS_LFB), (const float*)(ws + WS_LBV)};
        for (int rep = 0; rep < REP_INP; ++rep) pg8::gemm_phase<EpiInProj, pg8::StaticOrder>(lds, g, S, E);
    }
    GSYNC();
    for (int rep = 0; rep < REP_GLA; ++rep) { PHASE_IDS(); gla_phase(a, lds, tid); if (REP_GLA > 1) __syncthreads(); }
    GSYNC();
    for (int rep = 0; rep < REP_RO; ++rep) { PHASE_IDS(); gla_readout_phase(a, lane, gw, NGW); }
    GSYNC();
    {
        PHASE_IDS();
        pg8::Gemm g{(const bf16_t*)(ws + WS_OG), (const bf16_t*)(ws + WS_WOUT), NTOK, 1024, 1024};
        pg8::StaticOrder S; S.init(NTOK, 1024, G, (int)blockIdx.x);
        EpiResid E{a.in[I_X], a.in[I_CTX], (const float*)(ws + WS_MODV), (bf16_t*)(ws + WS_H), 2048};
        for (int rep = 0; rep < REP_OUT; ++rep) pg8::gemm_phase<EpiResid, pg8::StaticOrder>(lds, g, S, E);
    }
    GSYNC();
    for (int rep = 0; rep < REP_RT; ++rep) { PHASE_IDS(); router_phase(a, lds, 0, 0, tid); if (REP_RT > 1) __syncthreads(); }
    GSYNC();
    for (int rep = 0; rep < REP_AS; ++rep) { PHASE_IDS(); assign_phase(a, lds, 0, 0, tid); if (REP_AS > 1) __syncthreads(); }
    GSYNC();
    for (int rep = 0; rep < REP_M1; ++rep) { PHASE_IDS(); moe_gemm1(a, lds, 0, tid, G, vcu); }
    GSYNC();
    for (int rep = 0; rep < REP_M2; ++rep) { PHASE_IDS(); moe_gemm2(a, lds, 0, tid, G, vcu); }
    GSYNC();
    { PHASE_IDS(); combine_phase(a, 0, 0, lane, gw, NGW); }
    GSYNC();
    for (int rep = 0; rep < REP_S5; ++rep) { PHASE_IDS(); s5_phase(a, lds, tid); if (REP_S5 > 1) __syncthreads(); }
    GSYNC();
    for (int rep = 0; rep < REP_POST; ++rep) { PHASE_IDS(); s5_post_phase(a, lane, gw, NGW); }
    GSYNC();
    {
        PHASE_IDS();
        pg8::Gemm g{(const bf16_t*)(ws + WS_YG), (const bf16_t*)(ws + WS_WGLU), NLAT, 2048, 1024};
        pg8::StaticOrder S; S.init(NLAT, 2048, G, (int)blockIdx.x);
        EpiGlu E{a.in[I_S5BGLU], (const float*)(ws + WS_MODV) + 9 * 6144, (bf16_t*)(ws + WS_H)};
        pg8::gemm_phase<EpiGlu, pg8::StaticOrder>(lds, g, S, E);
    }
    GSYNC();
    { PHASE_IDS(); router_phase(a, lds, 1, NCTX, tid); }
    GSYNC();
    { PHASE_IDS(); assign_phase(a, lds, 1, NCTX, tid); }
    GSYNC();
    { PHASE_IDS(); moe_gemm1(a, lds, 1, tid, G, vcu); }
    GSYNC();
    { PHASE_IDS(); moe_gemm2(a, lds, 1, tid, G, vcu); }
    GSYNC();
    for (int rep = 0; rep < REP_CMB1; ++rep) { PHASE_IDS(); combine_phase(a, 1, NCTX, lane, gw, NGW); }
#ifdef TS_SEL
    TS_MARK();
    if (blockIdx.x == 0 && threadIdx.x == 0) {
        asm volatile("s_waitcnt vmcnt(0)" ::: "memory"); __threadfence();
        const unsigned long long dt = tsbuf[TS_SEL + 1] - tsbuf[TS_SEL];
        atomicAdd(a.out, (float)dt * 0.001f);
    }
#endif
}

extern "C" void kernel_launch(void* const* d_in, const int* in_sizes, int n_in, void* d_out, int out_size,
                              void* d_ws, size_t ws_size, hipStream_t stream) {
    static int grid_blocks = 0;
    if (!grid_blocks) {
        int dev = 0, cus = 0, per_cu = 0;
        (void)hipGetDevice(&dev);
        (void)hipDeviceGetAttribute(&cus, hipDeviceAttributeMultiprocessorCount, dev);
        (void)hipFuncSetAttribute((const void*)fwd_mega, hipFuncAttributeMaxDynamicSharedMemorySize, LDS_BYTES);
        (void)hipOccupancyMaxActiveBlocksPerMultiprocessor(&per_cu, (const void*)fwd_mega, NTHREADS, LDS_BYTES);
        if (per_cu < 1) { fprintf(stderr, "occupancy query says %d blocks/CU\n", per_cu); }
        grid_blocks = cus < 256 ? cus : 256;
        if (ws_size < WS_END) fprintf(stderr, "kernel_launch: workspace too small: %zu < %zu\n", ws_size, (size_t)WS_END);
    }
    (void)hipMemsetAsync((char*)d_ws + WS_CTL, 0, 1 * MiB, stream);
    Args a{};
    for (int i = 0; i < 29; ++i) a.in[i] = (const float*)d_in[i];
    a.out = (float*)d_out; a.ws = (unsigned char*)d_ws;
    void* kargs[] = {&a};
    hipError_t e = hipLaunchCooperativeKernel((const void*)fwd_mega, dim3(grid_blocks), dim3(NTHREADS), kargs, LDS_BYTES, stream);
    if (e != hipSuccess) fprintf(stderr, "cooperative launch failed: %s (grid %d)\n", hipGetErrorString(e), grid_blocks);
}
```

```cpp
#include <hip/hip_runtime.h>
#include <hip/hip_cooperative_groups.h>
#include <cstdio>
#include <cstdint>
namespace cg = cooperative_groups;

#define LAS __attribute__((address_space(3)))
typedef unsigned short bf16_t;
typedef short bf16x8 __attribute__((ext_vector_type(8)));
typedef float f32x4 __attribute__((ext_vector_type(4)));
typedef unsigned u32x4 __attribute__((ext_vector_type(4)));
typedef unsigned u32x2 __attribute__((ext_vector_type(2)));
typedef float f32x2 __attribute__((ext_vector_type(2)));

constexpr int NTHREADS = 512;
constexpr int LDS_BYTES = 147456;
constexpr int D = 1024, NB = 8, SEQ = 4096, CTXL = 256;
constexpr int NCTX = NB * CTXL;
constexpr int NLAT = NB * SEQ;
constexpr int NTOK = NCTX + NLAT;
constexpr int NE = 32;
constexpr int MPAD = 147456;
constexpr float EPS = 1e-6f;

constexpr size_t MiB = 1u << 20;
constexpr size_t WS_CTL = 0;
constexpr size_t WS_MODV = 1 * MiB;
constexpr size_t WS_LBV = 1 * MiB + 512 * 1024;
constexpr size_t WS_WIN = 2 * MiB;
constexpr size_t WS_WOUT = 12 * MiB;
constexpr size_t WS_WGLU = 14 * MiB;
constexpr size_t WS_W1 = 18 * MiB;
constexpr size_t WS_W2 = 274 * MiB;
constexpr size_t WS_H = 402 * MiB;
constexpr size_t WS_A = 538 * MiB;
constexpr size_t WS_F = 606 * MiB;
constexpr size_t WS_TOKE = 674 * MiB;
constexpr size_t WS_TOKW = 674 * MiB + 640 * 1024;
constexpr size_t WS_TOKS = 674 * MiB + 1280 * 1024;
constexpr size_t WS_SLOTTOK = 256 * 1024;
constexpr size_t WS_BIG = 676 * MiB;
constexpr size_t WS_Q = WS_BIG, WS_V = WS_BIG + 68 * MiB, WS_G = WS_BIG + 136 * MiB;
constexpr size_t WS_LFF = WS_BIG + 204 * MiB, WS_LFB = WS_BIG + 340 * MiB;
constexpr size_t WS_OF = WS_BIG + 476 * MiB, WS_OB = WS_BIG + 612 * MiB;
constexpr size_t WS_OG = WS_BIG + 748 * MiB;
constexpr size_t WS_AG = WS_BIG, WS_ACT = WS_BIG + 288 * MiB, WS_YS = WS_BIG;
constexpr size_t WS_YF = WS_BIG, WS_YB = WS_BIG + 128 * MiB, WS_YG = WS_BIG + 256 * MiB;
constexpr size_t WS_END = WS_BIG + 816 * MiB;
constexpr int CW_CNT = 64;
constexpr int CW_CUR = 256;
constexpr int CW_CNTB = 8192;
constexpr int CW_BAR = 4096;
#ifndef REP_P0
#define REP_P0 1
#endif
#ifndef REP_GLA
#define REP_GLA 1
#endif
#ifndef REP_S5
#define REP_S5 1
#endif
#ifndef REP_P1
#define REP_P1 1
#endif
#ifndef REP_RO
#define REP_RO 1
#endif
#ifndef REP_POST
#define REP_POST 1
#endif
#ifndef REP_CMB1
#define REP_CMB1 1
#endif
#ifndef REP_OUT
#define REP_OUT 1
#endif
#ifndef REP_RT
#define REP_RT 1
#endif
#ifndef REP_AS
#define REP_AS 1
#endif
#ifndef REP_INP
#define REP_INP 1
#endif
#ifndef REP_M1
#define REP_M1 1
#endif
#ifndef REP_M2
#define REP_M2 1
#endif

struct Args {
    const float* in[29];
    float* out;
    unsigned char* ws;
    int stop_after, pad1;
};
enum { I_X = 0, I_C, I_CTX, I_CCTX, I_MODW, I_MODB, I_N1G, I_N2G, I_HGWIN, I_HGLB, I_HGNG, I_HGWOUT, I_S5ARE, I_S5AIM, I_S5LDT,
       I_S5BRE, I_S5BIM, I_S5CRE, I_S5CIM, I_S5D, I_S5WGLU, I_S5BGLU, I_RW, I_RB, I_W1, I_B1, I_W2, I_B2, I_FG };

__device__ __forceinline__ unsigned f2bf(float f) { unsigned u = __builtin_bit_cast(unsigned, f); return (u + 0x7fffu + ((u >> 16) & 1u)) >> 16; }
typedef __bf16 bf16x2_t __attribute__((ext_vector_type(2)));
__device__ __forceinline__ unsigned cvt_pk_bf16(float lo, float hi) { const bf16x2_t v = {(__bf16)lo, (__bf16)hi}; return __builtin_bit_cast(unsigned, v); }
__device__ __forceinline__ unsigned pk2(float lo, float hi) { return cvt_pk_bf16(lo, hi); }
__device__ __forceinline__ float bf2f(unsigned short b) { return __builtin_bit_cast(float, ((unsigned)b) << 16); }
__device__ __forceinline__ float bflo(unsigned w) { return __builtin_bit_cast(float, w << 16); }
__device__ __forceinline__ float bfhi(unsigned w) { return __builtin_bit_cast(float, w & 0xffff0000u); }
__device__ __forceinline__ float wave_sum(float v) {
#pragma unroll
    for (int o = 1; o < 64; o <<= 1) v += __shfl_xor(v, o);
    return v;
}
__device__ __forceinline__ float wave_max(float v) {
#pragma unroll
    for (int o = 1; o < 64; o <<= 1) v = fmaxf(v, __shfl_xor(v, o));
    return v;
}
__device__ __forceinline__ float sigmoid_f(float x) { return __builtin_amdgcn_rcpf(1.0f + __expf(-x)); }
__device__ __forceinline__ float silu_f(float x) { return x * __builtin_amdgcn_rcpf(1.0f + __expf(-x)); }
#define LDS_WAIT() asm volatile("s_waitcnt lgkmcnt(0)" ::: "memory")

namespace pg8 {
constexpr int BM = 256, BK = 64, HALF = 128, HTB = HALF * BK * 2, STAGE_BYTES = 8 * HTB, NXCD = 8, WGM = 8;
__host__ __device__ __forceinline__ int lds_byte(int r, int c) { const int st = (r >> 4) * 2 + (c >> 5), rr = r & 15, cc = c & 31, ob = rr * 64 + cc * 2; return st * 1024 + (ob ^ (((ob >> 9) & 1) << 5)); }
__host__ __device__ __forceinline__ void stage_rc(int b, int& R, int& C) { const int st = b / 1024, sb = b % 1024, swz = sb ^ (((sb >> 9) & 1) << 5); R = (st >> 1) * 16 + swz / 64; C = (st & 1) * 32 + (swz % 64) / 2; }
__host__ __device__ __forceinline__ int perm32(int rho) { const int n = rho >> 4, i = rho & 15; return 8 * (i >> 2) + 4 * n + (i & 3); }
struct Unit { int pm, pn; };
struct Gemm { const bf16_t* A; const bf16_t* Bt; int M, N, K; };
struct StaticOrder {
    int nM, nN, nwg, G, c;
    __device__ void init(int M, int N, int G_, int c_) { nM = M / BM; nN = N / BM; nwg = nM * nN; G = G_; c = c_; }
    __device__ bool next(int i, Unit& u) const {
        const long L = (long)i * G + c; if (L >= nwg) return false;
        int wgid = (int)L; { const int q = nwg / NXCD, r = nwg % NXCD, xcd = wgid % NXCD, off = wgid / NXCD; wgid = (xcd < r ? xcd * (q + 1) : r * (q + 1) + (xcd - r) * q) + off; }
        const int nig = WGM * nN, gid = wgid / nig, fm = gid * WGM, gsz = (nM - fm) < WGM ? (nM - fm) : WGM;
        u.pm = fm + ((wgid % nig) % gsz); u.pn = (wgid % nig) / gsz; return true;
    }
    __device__ __forceinline__ void a_ready(const Unit&) const {}
    __device__ __forceinline__ void done(const Unit&) const {}
};
struct MoeOrder {
    const LAS int* tile_e; int TT, sh, G, v;
    __device__ bool next(int i, Unit& u) const {
        const bool p2 = (G & (G - 1)) == 0 && G >= 8;
        const int lg = p2 ? (31 - __builtin_clz((unsigned)G)) - 3 : 0, per = p2 ? (1 << lg) : G, x = p2 ? (v >> lg) : 0, j = p2 ? (v & (per - 1)) : v, nx = p2 ? 8 : 1;
        const int t0 = (x * TT) / nx, t1 = ((x + 1) * TT) / nx;
        const int uu = i * per + j, rt = t0 + (uu >> sh), pnl = uu & ((1 << sh) - 1);
        if (rt >= t1) return false;
        u.pm = rt; u.pn = (tile_e[rt] << sh) + pnl; return true;
    }
    __device__ __forceinline__ void a_ready(const Unit&) const {}
    __device__ __forceinline__ void done(const Unit&) const {}
};

template <class Epi, class Sched, bool GATHER = false>
__device__ __forceinline__ void gemm_phase(LAS unsigned char* lds, const Gemm g, const Sched& S, const Epi& E, const LAS unsigned short* rowl = nullptr) {
    int tid_ = threadIdx.x; asm volatile("" : "+v"(tid_));
    const int tid = tid_, wid = __builtin_amdgcn_readfirstlane(tid >> 6), lane = tid & 63, wr = wid >> 2, wc = wid & 3, fr = lane & 15, fq = lane >> 4;
    const int K = g.K, nt = K / BK;
    unsigned voffA[2], voffB[2];
    int Rr[2], Cc2[2];
#pragma unroll
    for (int i = 0; i < 2; ++i) { int R, C; stage_rc(tid * 16 + i * 8192, R, C); voffA[i] = (unsigned)(R * K + C) * 2u; const int Rb = Epi::PERM ? ((R & ~31) + perm32(R & 31)) : R; voffB[i] = (unsigned)(Rb * K + C) * 2u; Rr[i] = R; Cc2[i] = C * 2; }
    unsigned gA0[2] = {0u, 0u}, gA1[2] = {0u, 0u}, nG0[2] = {0u, 0u}, nG1[2] = {0u, 0u};
#define PG8_ROWS(ui_, d0, d1) do { _Pragma("unroll") for (int _i = 0; _i < 2; ++_i) { d0[_i] = (unsigned)rowl[(ui_) * BM + Rr[_i]] * (unsigned)(K * 2) + (unsigned)Cc2[_i]; d1[_i] = (unsigned)rowl[(ui_) * BM + HALF + Rr[_i]] * (unsigned)(K * 2) + (unsigned)Cc2[_i]; } } while (0)
#define PG8_STAGE_A(bufoff, ptr, h, nx) do { if constexpr (GATHER) { unsigned _o[2]; _o[0] = (nx) ? ((h) ? nG1[0] : nG0[0]) : ((h) ? gA1[0] : gA0[0]); _o[1] = (nx) ? ((h) ? nG1[1] : nG0[1]) : ((h) ? gA1[1] : gA0[1]); PG8_STAGE(bufoff, ptr, _o); } \
        else { PG8_STAGE(bufoff, (ptr) + ((h) ? hstep : 0), voffA); } } while (0)
    const size_t kstep = (size_t)(BK * 2);
    const size_t hstep = (size_t)HALF * K * 2;
    const size_t tstep = 2 * hstep;
    const unsigned ldsw = (unsigned)wid * 1024u;
    const int aoff = lds_byte(wr * 64 + fr, fq * 8), boff = lds_byte(wc * 32 + fr, fq * 8);
#define PG8_SA(b, h) (((b) * 2 + (h)) * HTB)
#define PG8_SB(b, h) ((4 + (b) * 2 + (h)) * HTB)
#define PG8_STAGE(bufoff, gbase, voff) do { _Pragma("unroll") for (int _i = 0; _i < 2; ++_i) \
        __builtin_amdgcn_global_load_lds((const unsigned*)((const char*)(gbase) + (voff)[_i]), (LAS unsigned*)(lds + (bufoff) + ldsw + _i * 8192), 16, 0, 0); } while (0)
#define PG8_LDA(dst, b, h) do { _Pragma("unroll") for (int m = 0; m < 4; ++m) _Pragma("unroll") for (int k = 0; k < 2; ++k) dst[m][k] = *(const LAS bf16x8*)(lds + PG8_SA(b, h) + aoff + m * 2048 + k * 1024); } while (0)
#define PG8_LDB(dst, b, h) do { _Pragma("unroll") for (int n = 0; n < 2; ++n) _Pragma("unroll") for (int k = 0; k < 2; ++k) dst[n][k] = *(const LAS bf16x8*)(lds + PG8_SB(b, h) + boff + n * 2048 + k * 1024); } while (0)
#define PG8_MMA(ai, bj, At, Bt) do { __builtin_amdgcn_s_setprio(1); _Pragma("unroll") for (int m = 0; m < 4; ++m) _Pragma("unroll") for (int n = 0; n < 2; ++n) _Pragma("unroll") for (int k = 0; k < 2; ++k) \
        acc[ai][bj][m][n] = __builtin_amdgcn_mfma_f32_16x16x32_bf16(Bt[n][k], At[m][k], acc[ai][bj][m][n], 0, 0, 0); __builtin_amdgcn_s_setprio(0); } while (0)
#define PG8_WAIT_V(n) asm volatile("s_waitcnt vmcnt(" #n ")" ::: "memory")
#define PG8_WAIT_L(n) asm volatile("s_waitcnt lgkmcnt(" #n ")" ::: "memory")
#define PG8_BAR __builtin_amdgcn_s_barrier()
#define PG8_SCHED __builtin_amdgcn_sched_barrier(0)
    Unit cur, nxt; int ui = 0;
    if (!S.next(0, cur)) return;
    f32x4 acc[2][2][4][2];
#pragma unroll
    for (int a = 0; a < 2; ++a)
#pragma unroll
        for (int b = 0; b < 2; ++b)
#pragma unroll
            for (int m = 0; m < 4; ++m)
#pragma unroll
                for (int n = 0; n < 2; ++n) acc[a][b][m][n] = (f32x4){0.f, 0.f, 0.f, 0.f};
    bf16x8 At[4][2], B0[2][2], B1[2][2];
    const char* cA = GATHER ? (const char*)g.A : (const char*)g.A + (size_t)cur.pm * tstep; const char* cB = (const char*)g.Bt + (size_t)cur.pn * tstep;
    S.a_ready(cur);
    if constexpr (GATHER) PG8_ROWS(0, gA0, gA1);
    PG8_STAGE(PG8_SB(0, 0), cB, voffB); PG8_STAGE_A(PG8_SA(0, 0), cA, 0, false); PG8_STAGE(PG8_SB(0, 1), cB + hstep, voffB); PG8_STAGE_A(PG8_SA(0, 1), cA, 1, false);
    if (wr == 1) PG8_BAR;
    PG8_WAIT_V(4); PG8_BAR;
    PG8_STAGE(PG8_SB(1, 0), cB + kstep, voffB); PG8_STAGE_A(PG8_SA(1, 0), cA + kstep, 0, false); PG8_STAGE(PG8_SB(1, 1), cB + hstep + kstep, voffB);
    PG8_WAIT_V(6); PG8_BAR;
    for (;;) {
        const bool has_next = S.next(ui + 1, nxt);
        const char* nA = GATHER ? cA : (has_next ? (const char*)g.A + (size_t)nxt.pm * tstep : cA); const char* nB = has_next ? (const char*)g.Bt + (size_t)nxt.pn * tstep : cB;
        if constexpr (GATHER) { if (has_next) PG8_ROWS(ui + 1, nG0, nG1); else { nG0[0] = gA0[0]; nG0[1] = gA0[1]; nG1[0] = gA1[0]; nG1[1] = gA1[1]; } }
        for (int t = 0; t < nt; t += 2) {
            const bool last = (t == nt - 2);
            const char* a1 = cA + (size_t)(t + 1) * kstep;
            const char* a2 = last ? nA : cA + (size_t)(t + 2) * kstep; const char* b2 = last ? nB : cB + (size_t)(t + 2) * kstep;
            const char* a3 = a2 + kstep; const char* b3 = b2 + kstep;
            if (last && has_next) S.a_ready(nxt);
            PG8_LDB(B0, 0, 0); PG8_SCHED; PG8_LDA(At, 0, 0); PG8_STAGE_A(PG8_SA(1, 1), a1, 1, false);
            PG8_WAIT_L(8); PG8_BAR; PG8_WAIT_L(0); PG8_MMA(0, 0, At, B0); PG8_BAR; PG8_SCHED;
            PG8_LDB(B1, 0, 1); PG8_STAGE(PG8_SB(0, 0), b2, voffB);
            PG8_BAR; PG8_WAIT_L(0); PG8_MMA(0, 1, At, B1); PG8_BAR;
            PG8_LDA(At, 0, 1); PG8_STAGE_A(PG8_SA(0, 0), a2, 0, last);
            PG8_BAR; PG8_WAIT_L(0); PG8_MMA(1, 0, At, B0); PG8_BAR; PG8_SCHED;
            PG8_STAGE(PG8_SB(0, 1), b2 + hstep, voffB);
            PG8_WAIT_V(6); PG8_BAR; PG8_MMA(1, 1, At, B1); PG8_BAR;
            PG8_LDB(B0, 1, 0); PG8_SCHED; PG8_LDA(At, 1, 0); PG8_STAGE_A(PG8_SA(0, 1), a2, 1, last);
            PG8_WAIT_L(8); PG8_BAR; PG8_WAIT_L(0); PG8_MMA(0, 0, At, B0); PG8_BAR; PG8_SCHED;
            PG8_LDB(B1, 1, 1); PG8_STAGE(PG8_SB(1, 0), b3, voffB);
            PG8_BAR; PG8_WAIT_L(0); PG8_MMA(0, 1, At, B1); PG8_BAR;
            PG8_LDA(At, 1, 1); PG8_STAGE_A(PG8_SA(1, 0), a3, 0, last);
            PG8_BAR; PG8_WAIT_L(0); PG8_MMA(1, 0, At, B0); PG8_BAR; PG8_SCHED;
            PG8_STAGE(PG8_SB(1, 1), b3 + hstep, voffB);
            PG8_WAIT_V(6); PG8_BAR; PG8_MMA(1, 1, At, B1); PG8_BAR;
        }
        E(acc, cur, wr, wc, fr, fq); S.done(cur);
        if (!has_next) break;
#pragma unroll
        for (int a = 0; a < 2; ++a)
#pragma unroll
            for (int b = 0; b < 2; ++b)
#pragma unroll
                for (int m = 0; m < 4; ++m)
#pragma unroll
                    for (int n = 0; n < 2; ++n) acc[a][b][m][n] = (f32x4){0.f, 0.f, 0.f, 0.f};
        cur = nxt; cA = nA; cB = nB; ++ui;
        if constexpr (GATHER) { gA0[0] = nG0[0]; gA0[1] = nG0[1]; gA1[0] = nG1[0]; gA1[1] = nG1[1]; }
    }
    PG8_WAIT_V(0);
    if (wr == 0) PG8_BAR;
    PG8_BAR;
#undef PG8_SA
#undef PG8_ROWS
#undef PG8_STAGE_A
#undef PG8_SB
#undef PG8_STAGE
#undef PG8_LDA
#undef PG8_LDB
#undef PG8_MMA
#undef PG8_WAIT_V
#undef PG8_WAIT_L
#undef PG8_BAR
#undef PG8_SCHED
}
}
using pg8::Unit;

__device__ __forceinline__ f32x4 ld_bf16x4(const bf16_t* p) { const u32x2 w = *(const u32x2*)p; return (f32x4){bflo(w.x), bfhi(w.x), bflo(w.y), bfhi(w.y)}; }
__device__ __forceinline__ void st_bf16x4(bf16_t* p, f32x4 v) { u32x2 w; w.x = pk2(v[0], v[1]); w.y = pk2(v[2], v[3]); *(u32x2*)p = w; }

struct EpiInProj {
    static constexpr bool PERM = true;
    bf16_t *Q, *V, *G; _Float16 *LFF, *LFB; const float* lbv;
    __device__ __forceinline__ void operator()(const f32x4 (&acc)[2][2][4][2], const Unit& u, int wr, int wc, int fr, int fq) const {
        const int seg = u.pn >> 2, cb = (u.pn & 3) * 256 + wc * 32 + 8 * fq, row0 = u.pm * 256 + wr * 64 + fr;
#pragma unroll
        for (int bj = 0; bj < 2; ++bj) {
            const int c = cb + bj * 128;
            f32x4 lb0 = (f32x4){0.f, 0.f, 0.f, 0.f}, lb1 = lb0;
            if (seg == 2 || seg == 3) { lb0 = *(const f32x4*)(lbv + (seg - 2) * D + c); lb1 = *(const f32x4*)(lbv + (seg - 2) * D + c + 4); }
#pragma unroll
            for (int ai = 0; ai < 2; ++ai)
#pragma unroll
                for (int m = 0; m < 4; ++m) {
                    const size_t ro = (size_t)(row0 + ai * 128 + m * 16) * D + c;
                    const f32x4 v0 = acc[ai][bj][m][0], v1 = acc[ai][bj][m][1];
                    if (seg == 0) { f32x4 o0, o1; for (int j = 0; j < 4; ++j) { o0[j] = silu_f(v0[j]); o1[j] = silu_f(v1[j]); }
                        *(u32x4*)(Q + ro) = (u32x4){pk2(o0[0], o0[1]), pk2(o0[2], o0[3]), pk2(o1[0], o1[1]), pk2(o1[2], o1[3])}; }
                    else if (seg == 1) { *(u32x4*)(V + ro) = (u32x4){pk2(v0[0], v0[1]), pk2(v0[2], v0[3]), pk2(v1[0], v1[1]), pk2(v1[2], v1[3])}; }
                    else if (seg == 4) { *(u32x4*)(G + ro) = (u32x4){pk2(v0[0], v0[1]), pk2(v0[2], v0[3]), pk2(v1[0], v1[1]), pk2(v1[2], v1[3])}; }
                    else {
                        f32x4 o0, o1;
                        for (int j = 0; j < 4; ++j) { o0[j] = __logf(lb0[j] + (1.0f - lb0[j]) * sigmoid_f(v0[j])); o1[j] = __logf(lb1[j] + (1.0f - lb1[j]) * sigmoid_f(v1[j])); }
                        u32x4 hw; hw.x = __builtin_bit_cast(unsigned, __builtin_amdgcn_cvt_pkrtz(o0[0], o0[1])); hw.y = __builtin_bit_cast(unsigned, __builtin_amdgcn_cvt_pkrtz(o0[2], o0[3]));
                        hw.z = __builtin_bit_cast(unsigned, __builtin_amdgcn_cvt_pkrtz(o1[0], o1[1])); hw.w = __builtin_bit_cast(unsigned, __builtin_amdgcn_cvt_pkrtz(o1[2], o1[3]));
                        *(u32x4*)((seg == 2 ? LFF : LFB) + ro) = hw;
                    }
                }
        }
    }
};
struct EpiResid {
    static constexpr bool PERM = true;
    const float* x; const float* ctx; const float* modv; bf16_t* H; int gate_off;
    __device__ __forceinline__ void operator()(const f32x4 (&acc)[2][2][4][2], const Unit& u, int wr, int wc, int fr, int fq) const {
        const int rt0 = u.pm * 256; const int mr = rt0 < NCTX ? 8 : ((rt0 - NCTX) >> 12);
        const float* src = rt0 < NCTX ? ctx + (size_t)rt0 * D : x + (size_t)(rt0 - NCTX) * D;
        const int cb = u.pn * 256 + wc * 32 + 8 * fq, rl0 = wr * 64 + fr;
        const float* gp = modv + mr * 6144 + gate_off;
        f32x4 gg[2][2];
#pragma unroll
        for (int bj = 0; bj < 2; ++bj) { gg[bj][0] = *(const f32x4*)(gp + cb + bj * 128); gg[bj][1] = *(const f32x4*)(gp + cb + bj * 128 + 4); }
#pragma unroll
        for (int bj = 0; bj < 2; ++bj)
#pragma unroll
            for (int ai = 0; ai < 2; ++ai) {
                const int c = cb + bj * 128; f32x4 h0[4], h1[4];
#pragma unroll
                for (int m = 0; m < 4; ++m) { const float* hp = src + (size_t)(rl0 + ai * 128 + m * 16) * D + c; h0[m] = *(const f32x4*)hp; h1[m] = *(const f32x4*)(hp + 4); }
#pragma unroll
                for (int m = 0; m < 4; ++m) {
                    const f32x4 o0 = h0[m] + gg[bj][0] * acc[ai][bj][m][0], o1 = h1[m] + gg[bj][1] * acc[ai][bj][m][1];
                    *(u32x4*)(H + (size_t)(rt0 + rl0 + ai * 128 + m * 16) * D + c) = (u32x4){pk2(o0[0], o0[1]), pk2(o0[2], o0[3]), pk2(o1[0], o1[1]), pk2(o1[2], o1[3])};
                }
                asm volatile("" ::: "memory");
            }
    }
};

struct TrItem { const float* src; bf16_t* dst; int N; };
__device__ __forceinline__ void tr_load(const TrItem& t, f32x4 (&v)[16], int lane) {
    const float* p = t.src + (size_t)(2 * (lane >> 4)) * t.N + 4 * (lane & 15);
#pragma unroll
    for (int i = 0; i < 8; ++i) { v[2 * i] = *(const f32x4*)(p + (size_t)(8 * i) * t.N); v[2 * i + 1] = *(const f32x4*)(p + (size_t)(8 * i + 1) * t.N); }
}
__device__ __forceinline__ void tr_finish(const TrItem& t, const f32x4 (&v)[16], LAS unsigned* scr, int lane) {
#pragma unroll
    for (int i = 0; i < 8; ++i) {
        const int kp = 4 * i + (lane >> 4); LAS unsigned* s = scr + kp * 65 + 4 * (lane & 15);
        s[0] = cvt_pk_bf16(v[2 * i][0], v[2 * i + 1][0]); s[1] = cvt_pk_bf16(v[2 * i][1], v[2 * i + 1][1]); s[2] = cvt_pk_bf16(v[2 * i][2], v[2 * i + 1][2]); s[3] = cvt_pk_bf16(v[2 * i][3], v[2 * i + 1][3]);
    }
    LDS_WAIT();
    const int c = lane & 7;
#pragma unroll
    for (int j = 0; j < 8; ++j) {
        const int n = (lane >> 3) + 8 * j; const LAS unsigned* s = scr + (4 * c) * 65 + n;
        *(u32x4*)(t.dst + (size_t)n * 1024 + 8 * c) = (u32x4){s[0], s[65], s[130], s[195]};
    }
    LDS_WAIT();
}
__device__ __forceinline__ int ilv_row(int c) { const int bj = c >> 10, r = c & 1023; return (r >> 7) * 256 + bj * 128 + (r & 127); }

__device__ __forceinline__ TrItem moe_item(const Args& a, int r, int layer) {
    TrItem t;
    if (r < 32 * 512) { const int mat = layer * 32 + (r >> 9), sub = r & 511, kb = sub >> 5, nb = sub & 31;
        t.src = a.in[I_W1] + (size_t)mat * 1024 * 2048 + (size_t)(kb * 64) * 2048 + nb * 64; t.dst = (bf16_t*)(a.ws + WS_W1) + (size_t)mat * 2048 * 1024 + (size_t)ilv_row(nb * 64) * 1024 + kb * 64; t.N = 2048; }
    else { r -= 32 * 512; const int mat = layer * 32 + (r >> 8), sub = r & 255, kb = sub >> 4, nb = sub & 15;
        t.src = a.in[I_W2] + (size_t)mat * 1024 * 1024 + (size_t)(kb * 64) * 1024 + nb * 64; t.dst = (bf16_t*)(a.ws + WS_W2) + (size_t)mat * 1024 * 1024 + (size_t)(nb * 64) * 1024 + kb * 64; t.N = 1024; }
    return t;
}
constexpr int P0_NWIN = 16 * 80, P0_NWOUT = 16 * 16, P0_NWGLU = 16 * 32, P0_NITEMS = P0_NWIN + P0_NWOUT + P0_NWGLU + 32 * 512 + 32 * 256;
__device__ __forceinline__ TrItem p0_item(const Args& a, int r) {
    TrItem t;
    if (r < P0_NWIN) { const int kb = r / 80, nb = r % 80; t.src = a.in[I_HGWIN] + (size_t)(kb * 64) * 5120 + nb * 64; t.dst = (bf16_t*)(a.ws + WS_WIN) + (size_t)(nb * 64) * 1024 + kb * 64; t.N = 5120; return t; } r -= P0_NWIN;
    if (r < P0_NWOUT) { const int kb = r / 16, nb = r % 16; t.src = a.in[I_HGWOUT] + (size_t)(kb * 64) * 1024 + nb * 64; t.dst = (bf16_t*)(a.ws + WS_WOUT) + (size_t)(nb * 64) * 1024 + kb * 64; t.N = 1024; return t; } r -= P0_NWOUT;
    if (r < P0_NWGLU) { const int kb = r / 32, nb = r % 32; t.src = a.in[I_S5WGLU] + (size_t)(kb * 64) * 2048 + nb * 64; t.dst = (bf16_t*)(a.ws + WS_WGLU) + (size_t)ilv_row(nb * 64) * 1024 + kb * 64; t.N = 2048; return t; } r -= P0_NWGLU;
    return moe_item(a, r, 0);
}
#define TR_LOOP(first, stride, count, ITEM) do { int _it = (first); if (_it < (count)) { f32x4 _va[16], _vb[16]; TrItem _A = ITEM(_it), _B = _A; tr_load(_A, _va, lane); \
        for (;;) { const int _i2 = _it + (stride); const bool _h2 = _i2 < (count); if (_h2) { _B = ITEM(_i2); tr_load(_B, _vb, lane); } tr_finish(_A, _va, scr, lane); if (!_h2) break; \
                   _it = _i2 + (stride); const bool _h1 = _it < (count); if (_h1) { _A = ITEM(_it); tr_load(_A, _va, lane); } tr_finish(_B, _vb, scr, lane); if (!_h1) break; } } } while (0)
__device__ __forceinline__ void p0_phase(const Args& a, LAS unsigned char* lds, int tid, int gw, int NGW) {
    const int lane = tid & 63, wave = tid >> 6;
    unsigned char* ws = a.ws;
    float* modv = (float*)(ws + WS_MODV);
    if (blockIdx.x < 192) {
        LAS float* SC = (LAS float*)lds;
        LAS float* PART = (LAS float*)(lds + 40960);
        for (int i = tid; i < 9 * 1024; i += NTHREADS) { const int r = i >> 10, k = i & 1023; const float v = r < 8 ? a.in[I_C][r * 1024 + k] : a.in[I_CCTX][k]; SC[i] = silu_f(v); }
        __syncthreads();
        const int layer = blockIdx.x / 96, ng = blockIdx.x % 96;
        const float* W = a.in[I_MODW] + (size_t)layer * 1024 * 6144 + ng * 64 + lane;
        float acc[9];
#pragma unroll
        for (int r = 0; r < 9; ++r) acc[r] = 0.f;
#pragma unroll 8
        for (int kk = 0; kk < 128; ++kk) {
            const int k = wave * 128 + kk; const float w = W[(size_t)k * 6144];
#pragma unroll
            for (int r = 0; r < 9; ++r) acc[r] += SC[r * 1024 + k] * w;
        }
#pragma unroll
        for (int r = 0; r < 9; ++r) PART[(wave * 9 + r) * 64 + lane] = acc[r];
        __syncthreads();
        for (int i = tid; i < 9 * 64; i += NTHREADS) {
            const int r = i >> 6, l = i & 63; float s = a.in[I_MODB][layer * 6144 + ng * 64 + l];
#pragma unroll
            for (int w = 0; w < 8; ++w) s += PART[(w * 9 + r) * 64 + l];
            modv[(size_t)(layer * 9 + r) * 6144 + ng * 64 + l] = s;
        }
        __syncthreads();
    } else if (blockIdx.x == 192) {
        float* lbv = (float*)(ws + WS_LBV);
        for (int i = tid; i < 2048; i += NTHREADS) { const float l0 = a.in[I_HGLB][i], l1 = a.in[I_HGLB][2048 + i]; lbv[i] = 1.0f / (1.0f + __expf(l1 - l0)); }
    }
    LAS unsigned* scr = (LAS unsigned*)(lds + 59392 + wave * 8320);
#define P0_ITEM(i) p0_item(a, (i))
    const int nfast = ((int)gridDim.x > 192) ? ((int)gridDim.x - 192) * 8 : 0, nextra = nfast * 3, n1 = P0_NITEMS - nextra;
    TR_LOOP(gw, NGW, n1, P0_ITEM);
    if (blockIdx.x >= 192) { TR_LOOP(n1 + (gw - 192 * 8), nfast, P0_NITEMS, P0_ITEM); }
#undef P0_ITEM
}

__device__ __forceinline__ const float* hin_row(const Args& a, int row) { return row < NCTX ? a.in[I_CTX] + (size_t)row * D : a.in[I_X] + (size_t)(row - NCTX) * D; }
__device__ __forceinline__ int mod_row(int row) { return row < NCTX ? 8 : ((row - NCTX) >> 12); }
__device__ __forceinline__ float row_rstd(const f32x4 (&v)[4]) {
    float s = 0.f;
#pragma unroll
    for (int j = 0; j < 4; ++j) s += (v[j][0] * v[j][0] + v[j][1] * v[j][1]) + (v[j][2] * v[j][2] + v[j][3] * v[j][3]);
    return 1.0f / sqrtf(wave_sum(s) * (1.0f / D) + EPS);
}
struct ModVec { f32x4 g[4], sc[4], sh[4]; };
__device__ __forceinline__ void modvec_load(ModVec& m, const float* g, const float* sc, const float* sh, int lane) {
#pragma unroll
    for (int j = 0; j < 4; ++j) { const int c = 4 * lane + 256 * j; m.g[j] = *(const f32x4*)(g + c); m.sc[j] = *(const f32x4*)(sc + c); m.sh[j] = *(const f32x4*)(sh + c); }
}
__device__ __forceinline__ void norm_mod_store(const f32x4 (&v)[4], float rstd, const ModVec& m, bf16_t* orow, int lane) {
#pragma unroll
    for (int j = 0; j < 4; ++j) st_bf16x4(orow + 4 * lane + 256 * j, v[j] * rstd * m.g[j] * (m.sc[j] + 1.0f) + m.sh[j]);
}

__device__ __forceinline__ void p1_phase(const Args& a, int lane, int gw, int NGW) {
    const float* modv = (const float*)(a.ws + WS_MODV);
    bf16_t* A = (bf16_t*)(a.ws + WS_A);
    for (int row0 = gw * 4; row0 < NTOK; row0 += NGW * 4) {
        f32x4 v[4][4];
#pragma unroll
        for (int r = 0; r < 4; ++r) { const float* hr = hin_row(a, row0 + r);
#pragma unroll
            for (int j = 0; j < 4; ++j) v[r][j] = *(const f32x4*)(hr + 4 * lane + 256 * j); }
        const float* mv = modv + (size_t)mod_row(row0) * 6144;
        ModVec m; modvec_load(m, a.in[I_N1G], mv + 1024, mv, lane);
#pragma unroll
        for (int r = 0; r < 4; ++r) { const float rstd = row_rstd(v[r]); norm_mod_store(v[r], rstd, m, A + (size_t)(row0 + r) * D, lane); }
    }
}

__device__ __forceinline__ int gla_row(int n, int t, int b, int dir) {
    const bool isctx = n < 4; const int cn = isctx ? n : n - 4, slen = isctx ? CTXL : SEQ, rbase = isctx ? b * CTXL : NCTX + b * SEQ;
    const int pos = cn * 64 + t; return rbase + (dir ? slen - 1 - pos : pos);
}
__device__ __forceinline__ void gla_phase(const Args& a, LAS unsigned char* lds, int tid) {
    const int lane = tid & 63, wave = tid >> 6, fr = lane & 15, fq = lane >> 4;
    LAS unsigned char* QS = lds;
    LAS unsigned char* KS = lds + 17408;
    LAS unsigned char* QIN = lds + 34816;
    LAS unsigned char* KOT = lds + 52224;
    LAS unsigned char* VT = lds + 70656;
    LAS unsigned char* ST0 = lds + 79872;
    LAS unsigned char* PPW = lds + 114688 + wave * 2304;
    LAS float* GT0 = (LAS float*)(lds + 133120);
    LAS float* BL = (LAS float*)(lds + 141312);
    const bf16_t* Qg = (const bf16_t*)(a.ws + WS_Q); const bf16_t* Vg = (const bf16_t*)(a.ws + WS_V);
    for (int item = blockIdx.x; item < 256; item += gridDim.x) {
        const int vs = item & 1, dir = (item >> 1) & 1, h = (item >> 2) & 7, b = item >> 5;
        const _Float16* LF = (const _Float16*)(a.ws + (dir ? WS_LFB : WS_LFF)); bf16_t* Og = (bf16_t*)(a.ws + (dir ? WS_OB : WS_OF));
        f32x4 Sacc[4];
#pragma unroll
        for (int i = 0; i < 4; ++i) Sacc[i] = (f32x4){0.f, 0.f, 0.f, 0.f};
        for (int i = tid; i < 2 * 17408 / 4; i += NTHREADS) ((LAS unsigned*)ST0)[i] = 0u;
        const int kc2 = (tid & 63) * 2, tg = tid >> 6, chq = h * 128 + kc2;
        const int vt_t = tid & 63, vt_v8 = (tid >> 6) * 8;
        unsigned lf2[8], q2[8]; u32x4 vv;
#define GLA_LOAD(n_) do { _Pragma("unroll") for (int i = 0; i < 8; ++i) { const size_t o = (size_t)gla_row(n_, tg * 8 + i, b, dir) * D + chq; lf2[i] = *(const unsigned*)(LF + o); q2[i] = *(const unsigned*)(Qg + o); } \
            vv = *(const u32x4*)(Vg + (size_t)gla_row(n_, vt_t, b, dir) * D + h * 128 + vs * 64 + vt_v8); } while (0)
        float fa[8], fb[8], bca[8], bcb[8];
#define GLA_CUMSUM(par_) do { float csa = 0.f, csb = 0.f; _Pragma("unroll") for (int i = 0; i < 8; ++i) { typedef _Float16 h2 __attribute__((ext_vector_type(2))); const h2 hv = __builtin_bit_cast(h2, lf2[i]); \
            const float la = (float)hv[0], lb_ = (float)hv[1]; fa[i] = __expf(la); fb[i] = __expf(lb_); csa += la; csb += lb_; bca[i] = csa; bcb[i] = csb; } \
            *(LAS f32x2*)(GT0 + (par_) * 1024 + tg * 128 + kc2) = (f32x2){csa, csb}; } while (0)
        GLA_LOAD(0);
        GLA_CUMSUM(0);
        __syncthreads();
        for (int n = 0; n < 68; ++n) {
            const int par = n & 1;
            LAS unsigned char* STc = ST0 + par * 17408; LAS unsigned char* STn = ST0 + (par ^ 1) * 17408;
            { const unsigned w[4] = {vv.x, vv.y, vv.z, vv.w};
#pragma unroll
              for (int i = 0; i < 4; ++i) { *(LAS bf16_t*)(VT + (vt_v8 + 2 * i) * 144 + vt_t * 2) = (bf16_t)(w[i] & 0xffffu); *(LAS bf16_t*)(VT + (vt_v8 + 2 * i + 1) * 144 + vt_t * 2) = (bf16_t)(w[i] >> 16); } }
#define GLA_OSTORE(n_) do { const u32x4 od = *(const LAS u32x4*)(PPW + (lane >> 2) * 144 + (lane & 3) * 16); \
                *(u32x4*)(Og + (size_t)gla_row(n_, (wave >> 1) * 16 + (lane >> 2), b, dir) * D + h * 128 + vs * 64 + (wave & 1) * 32 + (lane & 3) * 8) = od; } while (0)
            if (n > 0) GLA_OSTORE(n - 1);
            f32x2 pre = (f32x2){0.f, 0.f}, bref = (f32x2){0.f, 0.f}, blast = (f32x2){0.f, 0.f};
#pragma unroll
            for (int g8 = 0; g8 < 8; ++g8) { const f32x2 gv = *(const LAS f32x2*)(GT0 + par * 1024 + g8 * 128 + kc2); if (g8 < tg) pre += gv; if (g8 < 4) bref += gv; blast += gv; }
            const float era = __expf(bref.x), erb = __expf(bref.y), ela = __expf(blast.x - bref.x), elb = __expf(blast.y - bref.y);
            float e1a = __expf(pre.x - bref.x), e1b = __expf(pre.y - bref.y);
            unsigned kota[4], kotb[4];
#pragma unroll
            for (int i = 0; i < 8; ++i) {
                const int t = tg * 8 + i;
                const float qa = bflo(q2[i]), qb = bfhi(q2[i]);
                e1a *= fa[i]; e1b *= fb[i];
                const float ka = 1.0f - fa[i], kb = 1.0f - fb[i];
                const float e2a = __builtin_amdgcn_rcpf(e1a), e2b = __builtin_amdgcn_rcpf(e1b);
                const float qsa = qa * e1a, qsb = qb * e1b, ksa = ka * e2a, ksb = kb * e2b;
                *(LAS unsigned*)(QS + t * 272 + kc2 * 2) = cvt_pk_bf16(qsa, qsb);
                *(LAS unsigned*)(KS + t * 272 + kc2 * 2) = cvt_pk_bf16(ksa, ksb);
                *(LAS unsigned*)(QIN + t * 272 + kc2 * 2) = cvt_pk_bf16(qsa * era, qsb * erb);
                const unsigned ko = cvt_pk_bf16(ksa * ela, ksb * elb);
                if (i & 1) { kota[i >> 1] |= ko << 16; kotb[i >> 1] |= ko & 0xffff0000u; } else { kota[i >> 1] = ko & 0xffffu; kotb[i >> 1] = ko >> 16; }
            }
            { const int rot = ((kc2 >> 4) + tg) & 7;
              *(LAS u32x4*)(KOT + kc2 * 144 + rot * 16) = (u32x4){kota[0], kota[1], kota[2], kota[3]};
              *(LAS u32x4*)(KOT + (kc2 + 1) * 144 + rot * 16) = (u32x4){kotb[0], kotb[1], kotb[2], kotb[3]}; }
            if (tg == 0) *(LAS f32x2*)(BL + kc2) = (f32x2){__expf(blast.x), __expf(blast.y)};
            if (n + 1 < 68) GLA_LOAD(n + 1);
            __syncthreads();
            const int tt = wave >> 1;
            bf16x8 aq[4];
#pragma unroll
            for (int kk = 0; kk < 4; ++kk) aq[kk] = *(const LAS bf16x8*)(QS + (tt * 16 + fr) * 272 + (kk * 32 + fq * 8) * 2);
#pragma unroll
            for (int st = 0; st < 4; ++st) {
                f32x4 acc = (f32x4){0.f, 0.f, 0.f, 0.f};
                if (st <= tt) {
#pragma unroll
                    for (int kk = 0; kk < 4; ++kk) {
                        const bf16x8 bv = *(const LAS bf16x8*)(KS + (st * 16 + fr) * 272 + (kk * 32 + fq * 8) * 2);
                        acc = __builtin_amdgcn_mfma_f32_16x16x32_bf16(aq[kk], bv, acc, 0, 0, 0);
                    }
                }
#pragma unroll
                for (int j = 0; j < 4; ++j) { const int tl = fq * 4 + j, s = st * 16 + fr; *(LAS bf16_t*)(PPW + tl * 144 + s * 2) = (bf16_t)f2bf(s <= tt * 16 + tl ? acc[j] : 0.f); }
            }
            LDS_WAIT();
            unsigned ow[2][2];
            bf16x8 ap[2], ai[4];
#pragma unroll
            for (int kk = 0; kk < 2; ++kk) ap[kk] = *(const LAS bf16x8*)(PPW + fr * 144 + (kk * 32 + fq * 8) * 2);
#pragma unroll
            for (int kk = 0; kk < 4; ++kk) ai[kk] = *(const LAS bf16x8*)(QIN + (tt * 16 + fr) * 272 + (kk * 32 + fq * 8) * 2);
#pragma unroll
            for (int vti = 0; vti < 2; ++vti) {
                const int vt = 2 * (wave & 1) + vti; f32x4 acc = (f32x4){0.f, 0.f, 0.f, 0.f};
#pragma unroll
                for (int kk = 0; kk < 2; ++kk) {
                    const bf16x8 bv = *(const LAS bf16x8*)(VT + (vt * 16 + fr) * 144 + (kk * 32 + fq * 8) * 2);
                    acc = __builtin_amdgcn_mfma_f32_16x16x32_bf16(ap[kk], bv, acc, 0, 0, 0);
                }
#pragma unroll
                for (int kk = 0; kk < 4; ++kk) {
                    const bf16x8 bv = *(const LAS bf16x8*)(STc + (vt * 16 + fr) * 272 + (kk * 32 + fq * 8) * 2);
                    acc = __builtin_amdgcn_mfma_f32_16x16x32_bf16(ai[kk], bv, acc, 0, 0, 0);
                }
                ow[vti][0] = cvt_pk_bf16(acc[0], acc[1]); ow[vti][1] = cvt_pk_bf16(acc[2], acc[3]);
            }
#pragma unroll
            for (int vti = 0; vti < 2; ++vti)
#pragma unroll
                for (int j = 0; j < 4; ++j) { const unsigned w = ow[vti][j >> 1]; *(LAS bf16_t*)(PPW + (fq * 4 + j) * 144 + (vti * 16 + fr) * 2) = (bf16_t)((j & 1) ? (w >> 16) : (w & 0xffffu)); }
            bf16x8 ak[2]; const f32x4 blv = *(const LAS f32x4*)(BL + wave * 16 + fq * 4);
#pragma unroll
            for (int kk = 0; kk < 2; ++kk) ak[kk] = *(const LAS bf16x8*)(KOT + (wave * 16 + fr) * 144 + (((kk * 4 + fq) + wave) & 7) * 16);
#pragma unroll
            for (int vt = 0; vt < 4; ++vt) {
                Sacc[vt] *= blv;
#pragma unroll
                for (int kk = 0; kk < 2; ++kk) {
                    const bf16x8 bv = *(const LAS bf16x8*)(VT + (vt * 16 + fr) * 144 + (kk * 32 + fq * 8) * 2);
                    Sacc[vt] = __builtin_amdgcn_mfma_f32_16x16x32_bf16(ak[kk], bv, Sacc[vt], 0, 0, 0);
                }
                *(LAS u32x2*)(STn + (vt * 16 + fr) * 272 + (wave * 16 + fq * 4) * 2) = (u32x2){pk2(Sacc[vt][0], Sacc[vt][1]), pk2(Sacc[vt][2], Sacc[vt][3])};
            }
            if (n + 1 < 68) GLA_CUMSUM(par ^ 1);
            __syncthreads();
        }
        GLA_OSTORE(67);
    }
}
#undef GLA_OSTORE
#undef GLA_CUMSUM
#undef GLA_LOAD
__device__ __forceinline__ void gla_readout_phase(const Args& a, int lane, int gw, int NGW) {
    const bf16_t* OF = (const bf16_t*)(a.ws + WS_OF); const bf16_t* OB = (const bf16_t*)(a.ws + WS_OB);
    const bf16_t* G = (const bf16_t*)(a.ws + WS_G); bf16_t* OG = (bf16_t*)(a.ws + WS_OG);
    f32x4 ng[4];
#pragma unroll
    for (int j = 0; j < 4; ++j) ng[j] = *(const f32x4*)(a.in[I_HGNG] + 16 * lane + 4 * j);
    for (int row0 = gw * 4; row0 < NTOK; row0 += NGW * 4) {
        u32x4 of[4][2], ob[4][2], gg[4][2];
#pragma unroll
        for (int r = 0; r < 4; ++r) { const size_t o = (size_t)(row0 + r) * D + 16 * lane;
            of[r][0] = *(const u32x4*)(OF + o); of[r][1] = *(const u32x4*)(OF + o + 8); ob[r][0] = *(const u32x4*)(OB + o); ob[r][1] = *(const u32x4*)(OB + o + 8);
            gg[r][0] = *(const u32x4*)(G + o); gg[r][1] = *(const u32x4*)(G + o + 8); }
#pragma unroll
        for (int r = 0; r < 4; ++r) {
            float v[16]; float s = 0.f;
#pragma unroll
            for (int q = 0; q < 8; ++q) { const unsigned wf = of[r][q >> 2][q & 3], wb = ob[r][q >> 2][q & 3]; v[2 * q] = bflo(wf) + bflo(wb); v[2 * q + 1] = bfhi(wf) + bfhi(wb); s += v[2 * q] * v[2 * q] + v[2 * q + 1] * v[2 * q + 1]; }
            s += __shfl_xor(s, 1); s += __shfl_xor(s, 2); s += __shfl_xor(s, 4);
            const float rstd = 1.0f / sqrtf(s * (1.0f / 128.0f) + EPS);
            unsigned ow[8];
#pragma unroll
            for (int q = 0; q < 8; ++q) { const unsigned wg = gg[r][q >> 2][q & 3];
                ow[q] = pk2(v[2 * q] * rstd * ng[q >> 1][(2 * q) & 3] * silu_f(bflo(wg)), v[2 * q + 1] * rstd * ng[q >> 1][(2 * q + 1) & 3] * silu_f(bfhi(wg))); }
            const size_t o = (size_t)(row0 + r) * D + 16 * lane;
            *(u32x4*)(OG + o) = (u32x4){ow[0], ow[1], ow[2], ow[3]}; *(u32x4*)(OG + o + 8) = (u32x4){ow[4], ow[5], ow[6], ow[7]};
        }
    }
}

struct EpiMoe1 {
    static constexpr bool PERM = true;
    const float* b1; bf16_t* ACT;
    __device__ __forceinline__ void operator()(const f32x4 (&acc)[2][2][4][2], const Unit& u, int wr, int wc, int fr, int fq) const {
        const int e = u.pn >> 3, pnl = u.pn & 7, cb = pnl * 128 + wc * 32 + 8 * fq, row0 = u.pm * 256 + wr * 64 + fr;
        const float* bg = b1 + (size_t)e * 2048;
        const f32x4 bg0 = *(const f32x4*)(bg + cb), bg1 = *(const f32x4*)(bg + cb + 4), bl0 = *(const f32x4*)(bg + 1024 + cb), bl1 = *(const f32x4*)(bg + 1024 + cb + 4);
#pragma unroll
        for (int ai = 0; ai < 2; ++ai)
#pragma unroll
            for (int m = 0; m < 4; ++m) {
                f32x4 o[2];
#pragma unroll
                for (int n = 0; n < 2; ++n) {
                    const f32x4 zg = acc[ai][0][m][n] + (n ? bg1 : bg0), zl = acc[ai][1][m][n] + (n ? bl1 : bl0);
#pragma unroll
                    for (int j = 0; j < 4; ++j) { const float g_ = fminf(zg[j], 7.0f), l_ = fminf(fmaxf(zl[j], -7.0f), 7.0f); o[n][j] = g_ * sigmoid_f(1.702f * g_) * (l_ + 1.0f); }
                }
                *(u32x4*)(ACT + (size_t)(row0 + ai * 128 + m * 16) * D + cb) = (u32x4){pk2(o[0][0], o[0][1]), pk2(o[0][2], o[0][3]), pk2(o[1][0], o[1][1]), pk2(o[1][2], o[1][3])};
            }
    }
};
struct EpiMoe2 {
    static constexpr bool PERM = true;
    const float* b2; bf16_t* YS;
    __device__ __forceinline__ void operator()(const f32x4 (&acc)[2][2][4][2], const Unit& u, int wr, int wc, int fr, int fq) const {
        const int e = u.pn >> 2, pnl = u.pn & 3, cb = pnl * 256 + wc * 32 + 8 * fq, row0 = u.pm * 256 + wr * 64 + fr;
        const float* bb = b2 + (size_t)e * 1024;
#pragma unroll
        for (int bj = 0; bj < 2; ++bj) {
            const int c = cb + bj * 128; const f32x4 bv0 = *(const f32x4*)(bb + c), bv1 = *(const f32x4*)(bb + c + 4);
#pragma unroll
            for (int ai = 0; ai < 2; ++ai)
#pragma unroll
                for (int m = 0; m < 4; ++m) {
                    const f32x4 v0 = acc[ai][bj][m][0] + bv0, v1 = acc[ai][bj][m][1] + bv1;
                    *(u32x4*)(YS + (size_t)(row0 + ai * 128 + m * 16) * D + c) = (u32x4){pk2(v0[0], v0[1]), pk2(v0[2], v0[3]), pk2(v1[0], v1[1]), pk2(v1[2], v1[3])};
                }
        }
    }
};

__device__ __forceinline__ void router_phase(const Args& a, LAS unsigned char* lds, int layer, int row_lo, int tid) {
    const int lane = tid & 63, wave = tid >> 6, fr = lane & 15, fq = lane >> 4;
    const bf16_t* H = (const bf16_t*)(a.ws + WS_H); bf16_t* F = (bf16_t*)(a.ws + WS_F);
    const float* modv = (const float*)(a.ws + WS_MODV) + (size_t)layer * 9 * 6144;
    int* TOKE = (int*)(a.ws + WS_TOKE); float* TOKW = (float*)(a.ws + WS_TOKW);
    unsigned* cntb = (unsigned*)(a.ws + WS_CTL) + CW_CNTB + layer * 8192;
    LAS float* FS = (LAS float*)lds;
    LAS float* PART = (LAS float*)(lds + 16 * 1028 * 4);
    LAS int* hist = (LAS int*)(lds + 16 * 1028 * 4 + 16384);
    if (tid < 32) hist[tid] = 0;
    const float* n2g = a.in[I_N2G] + layer * D; const float* rw = a.in[I_RW] + (size_t)layer * D * NE; const float* rb = a.in[I_RB] + layer * NE;
    float rwr[2][32];
#pragma unroll
    for (int s = 0; s < 32; ++s) { rwr[0][s] = rw[(size_t)(wave * 128 + 4 * s + fq) * NE + fr]; rwr[1][s] = rw[(size_t)(wave * 128 + 4 * s + fq) * NE + 16 + fr]; }
    const int ngroups = (NTOK - row_lo) >> 4;
    f32x4 vv[2][4], gvv[4], scvv[4], shvv[4];
#pragma unroll
    for (int j = 0; j < 4; ++j) gvv[j] = *(const f32x4*)(n2g + 4 * lane + 256 * j);
#define RT_LOAD(gi_) do { _Pragma("unroll") for (int rr = 0; rr < 2; ++rr) _Pragma("unroll") for (int j = 0; j < 4; ++j) \
        vv[rr][j] = ld_bf16x4(H + (size_t)(row_lo + (gi_) * 16 + 2 * wave + rr) * D + 4 * lane + 256 * j); \
        { const float* mvp_ = modv + (size_t)mod_row(row_lo + (gi_) * 16) * 6144; _Pragma("unroll") for (int j = 0; j < 4; ++j) { scvv[j] = *(const f32x4*)(mvp_ + 4096 + 4 * lane + 256 * j); shvv[j] = *(const f32x4*)(mvp_ + 3072 + 4 * lane + 256 * j); } } } while (0)
    if ((int)blockIdx.x < ngroups) RT_LOAD(blockIdx.x);
    int pend_i = 0; float pend_w = 0.f; long pend_o = -1;
    for (int gi = blockIdx.x; gi < ngroups; gi += gridDim.x) {
        const int row0 = row_lo + gi * 16;
        __syncthreads();
#pragma unroll
        for (int rr = 0; rr < 2; ++rr) {
            const int rl = 2 * wave + rr, row = row0 + rl; const f32x4 (&v)[4] = vv[rr];
            const float rstd = row_rstd(v);
#pragma unroll
            for (int j = 0; j < 4; ++j) {
                const int c = 4 * lane + 256 * j;
                const f32x4 f = v[j] * rstd * gvv[j] * (scvv[j] + 1.0f) + shvv[j];
                st_bf16x4(F + (size_t)row * D + c, f);
                *(LAS f32x4*)(FS + rl * 1028 + c) = f;
            }
        }
        if (pend_o >= 0) { TOKE[pend_o] = pend_i; TOKW[pend_o] = pend_w; pend_o = -1; }
        if (gi + (int)gridDim.x < ngroups) RT_LOAD(gi + gridDim.x);
        __syncthreads();
        f32x4 acc0 = (f32x4){0.f, 0.f, 0.f, 0.f}, acc1 = (f32x4){0.f, 0.f, 0.f, 0.f};
#pragma unroll
        for (int s = 0; s < 32; ++s) {
            const float av = FS[fr * 1028 + wave * 128 + 4 * s + fq];
            acc0 = __builtin_amdgcn_mfma_f32_16x16x4f32(av, rwr[0][s], acc0, 0, 0, 0);
            acc1 = __builtin_amdgcn_mfma_f32_16x16x4f32(av, rwr[1][s], acc1, 0, 0, 0);
        }
#pragma unroll
        for (int j = 0; j < 4; ++j) { PART[(wave * 16 + fq * 4 + j) * 32 + fr] = acc0[j]; PART[(wave * 16 + fq * 4 + j) * 32 + 16 + fr] = acc1[j]; }
        __syncthreads();
        {
            const int half = lane >> 5, e = lane & 31, rl = 2 * wave + half, row = row0 + rl;
            float lg = rb[e];
#pragma unroll
            for (int w = 0; w < 8; ++w) lg += PART[(w * 16 + rl) * 32 + e];
            float sv[4]; int si[4];
#pragma unroll
            for (int r = 0; r < 4; ++r) {
                float m = lg;
#pragma unroll
                for (int o = 1; o < 32; o <<= 1) m = fmaxf(m, __shfl_xor(m, o));
                const unsigned long long bal = __ballot(lg == m); const unsigned mine = (unsigned)(bal >> (32 * half));
                const int idx = __ffs((int)mine) - 1;
                sv[r] = m; si[r] = idx; if (e == idx) lg = -3.0e38f;
            }
            const float e1 = __expf(sv[1] - sv[0]), e2 = __expf(sv[2] - sv[0]), e3 = __expf(sv[3] - sv[0]); const float inv = 1.0f / (1.0f + e1 + e2 + e3);
            if (e < 4) {
                const int myi = e == 0 ? si[0] : (e == 1 ? si[1] : (e == 2 ? si[2] : si[3]));
                const float myw = (e == 0 ? 1.0f : (e == 1 ? e1 : (e == 2 ? e2 : e3))) * inv;
                pend_i = myi; pend_w = myw; pend_o = (long)row * 4 + e;
                atomicAdd((int*)hist + myi, 1);
            }
        }
    }
    if (pend_o >= 0) { TOKE[pend_o] = pend_i; TOKW[pend_o] = pend_w; }
    __syncthreads();
    if (tid < 32) cntb[(size_t)blockIdx.x * 32 + tid] = (unsigned)hist[tid];
}
#undef RT_LOAD
__device__ __forceinline__ void assign_phase(const Args& a, LAS unsigned char* lds, int layer, int row_lo, int tid) {
    const int lane = tid & 63, wave = tid >> 6;
    const unsigned* cntb = (const unsigned*)(a.ws + WS_CTL) + CW_CNTB + layer * 8192; unsigned* gcnt = (unsigned*)(a.ws + WS_CTL) + CW_CNT + layer * 64;
    const bf16_t* F = (const bf16_t*)(a.ws + WS_F); bf16_t* AG = (bf16_t*)(a.ws + WS_AG);
    const int* TOKE = (const int*)(a.ws + WS_TOKE); int* TOKS = (int*)(a.ws + WS_TOKS);
    LAS int* off = (LAS int*)lds; LAS int* cnt = (LAS int*)(lds + 256); LAS int* base = (LAS int*)(lds + 512); LAS int* cur = (LAS int*)(lds + 768);
    LAS int* pa = (LAS int*)(lds + 1024); LAS int* pl = (LAS int*)(lds + 1024 + 2048);
    {
        const int e = tid & 31, part = tid >> 5; int s_all = 0, s_lt = 0;
        for (int bb = part; bb < (int)gridDim.x; bb += 16) { const int c = (int)cntb[(size_t)bb * 32 + e]; s_all += c; if (bb < (int)blockIdx.x) s_lt += c; }
        pa[part * 32 + e] = s_all; pl[part * 32 + e] = s_lt;
    }
    __syncthreads();
    if (tid < 32) { int s_all = 0, s_lt = 0; for (int p = 0; p < 16; ++p) { s_all += pa[p * 32 + tid]; s_lt += pl[p * 32 + tid]; } cnt[tid] = s_all; base[tid] = s_lt; cur[tid] = 0; if (blockIdx.x == 0) gcnt[tid] = (unsigned)s_all; }
    __syncthreads();
    if (tid == 0) { int o = 0; for (int e = 0; e < 32; ++e) { off[e] = o; o += ((cnt[e] + 255) >> 8) << 8; } }
    __syncthreads();
    if (tid < 32) base[tid] += off[tid];
    __syncthreads();
    const int gw = blockIdx.x * 8 + wave, NGW = gridDim.x * 8;
    int* SLOTTOK = (int*)(a.ws + WS_SLOTTOK);
    for (int idx = blockIdx.x * NTHREADS + tid; idx < 32 * 256; idx += gridDim.x * NTHREADS) {
        const int e = idx >> 8, c = cnt[e], r = c + (idx & 255), padded = ((c + 255) >> 8) << 8;
        if (r < padded) SLOTTOK[off[e] + r] = 0;
    }
    const int ngroups = (NTOK - row_lo) >> 4;
    for (int gi = blockIdx.x; gi < ngroups; gi += gridDim.x) {
        const int r0 = row_lo + gi * 16 + 2 * wave;
        if (lane < 8) { const int e = TOKE[(size_t)r0 * 4 + lane]; const int pos = atomicAdd((int*)cur + e, 1); const int slot = base[e] + pos; TOKS[(size_t)r0 * 4 + lane] = slot; SLOTTOK[slot] = r0 + (lane >> 2); }
    }
    (void)gw; (void)NGW; (void)F; (void)AG;
}
__device__ __forceinline__ int moe_tiles(const Args& a, LAS unsigned char* lds, int layer, int tid) {
    const unsigned* gcnt = (const unsigned*)(a.ws + WS_CTL) + CW_CNT + layer * 64;
    LAS int* tbl = (LAS int*)(lds + 131072 + 1024);
    if (tid == 0) { int t = 0; for (int e = 0; e < 32; ++e) { const int nt = ((int)gcnt[e] + 255) >> 8; for (int k = 0; k < nt; ++k) tbl[t++] = e; } tbl[1000] = t; }
    __syncthreads();
    return tbl[1000];
}
__device__ __forceinline__ void combine_phase(const Args& a, int layer, int row_lo, int lane, int gw, int NGW) {
    bf16_t* H = (bf16_t*)(a.ws + WS_H); const bf16_t* YS = (const bf16_t*)(a.ws + WS_YS);
    const int* TOKS = (const int*)(a.ws + WS_TOKS); const float* TOKW = (const float*)(a.ws + WS_TOKW);
    const float* modv = (const float*)(a.ws + WS_MODV);
    for (int row0 = row_lo + gw * 2; row0 < NTOK; row0 += NGW * 2) {
        const int mr = mod_row(row0);
        u32x4 sl[2]; f32x4 wv[2];
#pragma unroll
        for (int r = 0; r < 2; ++r) { sl[r] = *(const u32x4*)(TOKS + (size_t)(row0 + r) * 4); wv[r] = *(const f32x4*)(TOKW + (size_t)(row0 + r) * 4); }
        u32x2 ys[2][4][4]; f32x4 hv[2][4];
#pragma unroll
        for (int r = 0; r < 2; ++r)
#pragma unroll
            for (int j = 0; j < 4; ++j) {
                hv[r][j] = ld_bf16x4(H + (size_t)(row0 + r) * D + 4 * lane + 256 * j);
#pragma unroll
                for (int k = 0; k < 4; ++k) ys[r][k][j] = *(const u32x2*)(YS + (size_t)sl[r][k] * D + 4 * lane + 256 * j);
            }
        const float* g2 = modv + (size_t)(layer * 9 + mr) * 6144 + 5120;
        f32x4 g2v[4];
#pragma unroll
        for (int j = 0; j < 4; ++j) g2v[j] = *(const f32x4*)(g2 + 4 * lane + 256 * j);
        ModVec m;
        if (layer == 0) { const float* mv = modv + (size_t)(9 + mr) * 6144; modvec_load(m, a.in[I_N1G] + D, mv + 1024, mv, lane); }
        else {
#pragma unroll
            for (int j = 0; j < 4; ++j) m.g[j] = *(const f32x4*)(a.in[I_FG] + 4 * lane + 256 * j);
        }
#pragma unroll
        for (int r = 0; r < 2; ++r) {
            const int row = row0 + r; f32x4 v[4];
#pragma unroll
            for (int j = 0; j < 4; ++j) {
                const int c = 4 * lane + 256 * j; f32x4 y = (f32x4){0.f, 0.f, 0.f, 0.f};
#pragma unroll
                for (int k = 0; k < 4; ++k) { const u32x2 w = ys[r][k][j]; y += (f32x4){bflo(w.x), bfhi(w.x), bflo(w.y), bfhi(w.y)} * wv[r][k]; }
                v[j] = hv[r][j] + g2v[j] * y;
                if (layer == 0) st_bf16x4(H + (size_t)row * D + c, v[j]);
            }
            const float rstd = row_rstd(v);
            if (layer == 0) {
                int orow = row;
                if (row >= NCTX) { const int li = row - NCTX, b = li >> 12, t = li & 4095; orow = NCTX + b * SEQ + (t & 63) * 64 + (t >> 6); }
                norm_mod_store(v, rstd, m, (bf16_t*)(a.ws + WS_A) + (size_t)orow * D, lane);
            } else {
#pragma unroll
                for (int j = 0; j < 4; ++j) { const int c = 4 * lane + 256 * j; *(f32x4*)(a.out + (size_t)(row - NCTX) * D + c) = v[j] * rstd * m.g[j]; }
            }
        }
    }
}
__device__ __forceinline__ void moe_gemm1(const Args& a, LAS unsigned char* lds, int layer, int tid, int G, int vcu) {
    unsigned char* ws = a.ws;
    const int TT = moe_tiles(a, lds, layer, tid);
    const LAS int* tbl = (const LAS int*)(lds + 131072 + 1024);
    pg8::Gemm g{(const bf16_t*)(ws + WS_F), (const bf16_t*)(ws + WS_W1) + (size_t)layer * 32 * 2048 * 1024, MPAD, 32 * 2048, 1024};
    pg8::MoeOrder S{tbl, TT, 3, G, vcu};
    EpiMoe1 E{a.in[I_B1] + (size_t)layer * 32 * 2048, (bf16_t*)(ws + WS_ACT)};
    LAS unsigned short* rowl = (LAS unsigned short*)(lds + 136192);
    { const int* slottok = (const int*)(ws + WS_SLOTTOK); pg8::Unit uu; int t2 = threadIdx.x; asm volatile("" : "+v"(t2)); const int tid = t2;
      for (int i = 0; i < 21; i += 2) { const int ii = i + (tid >> 8); if (ii < 21 && S.next(ii, uu)) rowl[ii * 256 + (tid & 255)] = (unsigned short)slottok[uu.pm * 256 + (tid & 255)]; } }
    __syncthreads();
    pg8::gemm_phase<EpiMoe1, pg8::MoeOrder, true>(lds, g, S, E, rowl);
}
__device__ __forceinline__ void moe_gemm2(const Args& a, LAS unsigned char* lds, int layer, int tid, int G, int vcu) {
    unsigned char* ws = a.ws;
    const int TT = moe_tiles(a, lds, layer, tid);
    const LAS int* tbl = (const LAS int*)(lds + 131072 + 1024);
    pg8::Gemm g{(const bf16_t*)(ws + WS_ACT), (const bf16_t*)(ws + WS_W2) + (size_t)layer * 32 * 1024 * 1024, MPAD, 32 * 1024, 1024};
    pg8::MoeOrder S{tbl, TT, 2, G, vcu};
    EpiMoe2 E{a.in[I_B2] + (size_t)layer * 32 * 1024, (bf16_t*)(ws + WS_YS)};
    pg8::gemm_phase<EpiMoe2, pg8::MoeOrder>(lds, g, S, E);
}


__device__ __forceinline__ void s5_disc(const Args& a, int d, int g, int p, float& ab_re, float& ab_im, float& co_re, float& co_im) {
    const float lam_re = fminf(a.in[I_S5ARE][(d * 64 + g) * 64 + p], -1e-4f), lam_im = a.in[I_S5AIM][(d * 64 + g) * 64 + p];
    const float dt = expf(a.in[I_S5LDT][d * 64 + g]);
    const float mag = expf(lam_re * dt), ang = lam_im * dt;
    ab_re = mag * cosf(ang); ab_im = mag * sinf(ang);
    const float den = lam_re * lam_re + lam_im * lam_im;
    co_re = ((ab_re - 1.0f) * lam_re + ab_im * lam_im) / den;
    co_im = (ab_im * lam_re - (ab_re - 1.0f) * lam_im) / den;
}
__device__ __forceinline__ void s5_phase(const Args& a, LAS unsigned char* lds, int tid) {
    const int lane = tid & 63, wave = tid >> 6, fr = lane & 15, fq = lane >> 4;
    if (wave >= 4) {
        LAS unsigned* scr = (LAS unsigned*)(lds + 102400 + (wave - 4) * 8320);
        const int cw = blockIdx.x * 4 + (wave - 4), NCW = gridDim.x * 4;
#define L1_ITEM(i) moe_item(a, (i), 1)
        TR_LOOP(cw, NCW, 32 * 512 + 32 * 256, L1_ITEM);
#undef L1_ITEM
        return;
    }
    LAS unsigned char* wl = lds + wave * 25600;
    const bf16_t* A1 = (const bf16_t*)(a.ws + WS_A);
    for (int item = blockIdx.x; item < 256; item += gridDim.x) {
        const int b = item >> 5, dir = (item >> 4) & 1, g = (item & 15) * 4 + wave;
        bf16_t* Y = (bf16_t*)(a.ws + (dir ? WS_YB : WS_YF));
        float ab_re, ab_im, cr_, ci_;
        s5_disc(a, dir, g, lane, ab_re, ab_im, cr_, ci_);
        bf16x8 Bd[8], Cf[4];
        {
            f32x4 cre[4], cim[4];
#pragma unroll
            for (int kk = 0; kk < 4; ++kk) { const size_t o = ((size_t)(dir * 64 + g) * 16 + fr) * 64 + kk * 16 + fq * 4; cre[kk] = *(const f32x4*)(a.in[I_S5CRE] + o); cim[kk] = *(const f32x4*)(a.in[I_S5CIM] + o); }
#pragma unroll
            for (int kk = 0; kk < 4; ++kk)
#pragma unroll
                for (int j = 0; j < 8; ++j) Cf[kk][j] = (short)f2bf((j & 1) ? -cim[kk][j >> 1] : cre[kk][j >> 1]);
#pragma unroll
            for (int hg = 0; hg < 2; ++hg) {
                f32x4 br0[4], br1[4], bi0[4], bi1[4];
#pragma unroll
                for (int q = 0; q < 4; ++q) {
                    const int pp = (hg * 4 + q) * 8 + (fr >> 1); const size_t o = (size_t)(g * 64 + pp) * 16 + (fq & 1) * 8;
                    br0[q] = *(const f32x4*)(a.in[I_S5BRE] + o); br1[q] = *(const f32x4*)(a.in[I_S5BRE] + o + 4); bi0[q] = *(const f32x4*)(a.in[I_S5BIM] + o); bi1[q] = *(const f32x4*)(a.in[I_S5BIM] + o + 4);
                }
#pragma unroll
                for (int q = 0; q < 4; ++q) {
                    const int pt = hg * 4 + q, pp = pt * 8 + (fr >> 1); const float qr = __shfl(cr_, pp), qi = __shfl(ci_, pp);
#pragma unroll
                    for (int j = 0; j < 8; ++j) {
                        const float br = j < 4 ? br0[q][j & 3] : br1[q][j & 3], bi = j < 4 ? bi0[q][j & 3] : bi1[q][j & 3];
                        float v = (fr & 1) ? (qr * bi + qi * br) : (qr * br - qi * bi);
                        if (fq >= 2) v = 0.f;
                        Bd[pt][j] = (short)f2bf(v);
                    }
                }
                asm volatile("" ::: "memory");
            }
        }
#define S5_POS(n_, t_) ((((n_) < 8) ? (n_) : (n_) - 8) * 32 + (t_))
#define S5_ROW(n_, t_) ((((n_) < 8) ? b * CTXL : NCTX + b * SEQ) + (dir ? (((n_) < 8) ? CTXL : SEQ) - 1 - S5_POS(n_, t_) : S5_POS(n_, t_)))
#define S5_LOADU(d0, d1, n_) do { d0 = (bf16x8){0, 0, 0, 0, 0, 0, 0, 0}; d1 = d0; if (fq < 2 && (n_) < 136) { d0 = *(const bf16x8*)(A1 + (size_t)S5_ROW(n_, fr) * D + g * 16 + fq * 8); d1 = *(const bf16x8*)(A1 + (size_t)S5_ROW(n_, 16 + fr) * D + g * 16 + fq * 8); } } while (0)
        LAS float* BUF = (LAS float*)wl; LAS unsigned* HW = (LAS unsigned*)(wl + 16896); const LAS unsigned char* HP = wl + 16896;
        bf16x8 ua0, ua1, ub0, ub1;
        S5_LOADU(ua0, ua1, 0);
        f32x2 s = (f32x2){0.f, 0.f};
        const f32x2 abr = (f32x2){ab_re, ab_re}, abi = (f32x2){-ab_im, ab_im};
        bf16_t* yp = Y + (size_t)(b * SEQ + (dir ? SEQ - 1 - fq * 4 : fq * 4)) * D + g * 16 + fr;
        const long ystep = dir ? -(long)D : (long)D;
        unsigned yw[4] = {0u, 0u, 0u, 0u};
#define S5_YSTORE() do { yp[0] = (bf16_t)(yw[0] & 0xffffu); yp[ystep] = (bf16_t)(yw[0] >> 16); yp[2 * ystep] = (bf16_t)(yw[1] & 0xffffu); yp[3 * ystep] = (bf16_t)(yw[1] >> 16); \
            yp[16 * ystep] = (bf16_t)(yw[2] & 0xffffu); yp[17 * ystep] = (bf16_t)(yw[2] >> 16); yp[18 * ystep] = (bf16_t)(yw[3] & 0xffffu); yp[19 * ystep] = (bf16_t)(yw[3] >> 16); yp += 32 * ystep; } while (0)
        for (int n = 0; n < 136; ++n) {
#pragma unroll
            for (int hf = 0; hf < 2; ++hf)
#pragma unroll
                for (int pt = 0; pt < 8; ++pt) {
                    const f32x4 z = (f32x4){0.f, 0.f, 0.f, 0.f};
                    const f32x4 d = __builtin_amdgcn_mfma_f32_16x16x32_bf16(hf ? ua1 : ua0, Bd[pt], z, 0, 0, 0);
#pragma unroll
                    for (int j = 0; j < 4; ++j) BUF[(hf * 16 + fq * 4 + j) * 132 + pt * 16 + fr] = d[j];
                }
            if (n >= 9) S5_YSTORE();
            S5_LOADU(ub0, ub1, n + 1);
            LDS_WAIT();
            {
                const bool hist = n >= 8;
                f32x2 bu[32];
#pragma unroll
                for (int j = 0; j < 32; ++j) bu[j] = *(const LAS f32x2*)(BUF + j * 132 + 2 * lane);
                unsigned hw[32];
#pragma unroll
                for (int j = 0; j < 32; ++j) { const f32x2 t1 = abr * s + bu[j]; s = abi * (f32x2){s.y, s.x} + t1; hw[j] = cvt_pk_bf16(s.x, s.y); }
                if (hist) {
#pragma unroll
                    for (int j = 0; j < 32; ++j) HW[j * 68 + lane] = hw[j];
                }
            }
            LDS_WAIT();
            if (n >= 8) {
                f32x4 y0 = (f32x4){0.f, 0.f, 0.f, 0.f}, y1 = (f32x4){0.f, 0.f, 0.f, 0.f};
                bf16x8 ha[2][4];
#pragma unroll
                for (int hf = 0; hf < 2; ++hf)
#pragma unroll
                    for (int kk = 0; kk < 4; ++kk) ha[hf][kk] = *(const LAS bf16x8*)(HP + (hf * 16 + fr) * 272 + (kk * 32 + fq * 8) * 2);
#pragma unroll
                for (int kk = 0; kk < 4; ++kk) { y0 = __builtin_amdgcn_mfma_f32_16x16x32_bf16(ha[0][kk], Cf[kk], y0, 0, 0, 0); y1 = __builtin_amdgcn_mfma_f32_16x16x32_bf16(ha[1][kk], Cf[kk], y1, 0, 0, 0); }
                yw[0] = cvt_pk_bf16(y0[0], y0[1]); yw[1] = cvt_pk_bf16(y0[2], y0[3]); yw[2] = cvt_pk_bf16(y1[0], y1[1]); yw[3] = cvt_pk_bf16(y1[2], y1[3]);
                LDS_WAIT();
            }
            ua0 = ub0; ua1 = ub1;
        }
        S5_YSTORE();
#undef S5_YSTORE
#undef S5_POS
#undef S5_ROW
#undef S5_LOADU
    }
}
__device__ __forceinline__ float gelu_tanh_f(float x) { const float z = 0.7978845608f * (x + 0.044715f * x * x * x); return x * (1.0f - __builtin_amdgcn_rcpf(1.0f + __expf(2.0f * z))); }
__device__ __forceinline__ void s5_post_phase(const Args& a, int lane, int gw, int NGW) {
    const bf16_t* YF = (const bf16_t*)(a.ws + WS_YF); const bf16_t* YB = (const bf16_t*)(a.ws + WS_YB);
    const bf16_t* A1 = (const bf16_t*)(a.ws + WS_A); bf16_t* YG = (bf16_t*)(a.ws + WS_YG);
    f32x4 dk[4];
#pragma unroll
    for (int j = 0; j < 4; ++j) dk[j] = *(const f32x4*)(a.in[I_S5D] + 4 * lane + 256 * j);
    for (int tok0 = gw * 4; tok0 < NLAT; tok0 += NGW * 4) {
        u32x2 yf[4][4], yb[4][4], uu[4][4];
#pragma unroll
        for (int r = 0; r < 4; ++r) { const int tok = tok0 + r, b = tok >> 12, t = tok & 4095, src = b * SEQ + (t & 63) * 64 + (t >> 6);
#pragma unroll
            for (int j = 0; j < 4; ++j) { const int c = 4 * lane + 256 * j; yf[r][j] = *(const u32x2*)(YF + (size_t)src * D + c); yb[r][j] = *(const u32x2*)(YB + (size_t)src * D + c); uu[r][j] = *(const u32x2*)(A1 + (size_t)(NCTX + src) * D + c); } }
#pragma unroll
        for (int r = 0; r < 4; ++r)
#pragma unroll
            for (int j = 0; j < 4; ++j) {
                const u32x2 f = yf[r][j], bk = yb[r][j], uw = uu[r][j];
                const f32x4 y = (f32x4){bflo(f.x) + bflo(bk.x), bfhi(f.x) + bfhi(bk.x), bflo(f.y) + bflo(bk.y), bfhi(f.y) + bfhi(bk.y)} + dk[j] * (f32x4){bflo(uw.x), bfhi(uw.x), bflo(uw.y), bfhi(uw.y)};
                f32x4 o;
#pragma unroll
                for (int i = 0; i < 4; ++i) o[i] = gelu_tanh_f(y[i]);
                st_bf16x4(YG + (size_t)(tok0 + r) * D + 4 * lane + 256 * j, o);
            }
    }
}
struct EpiGlu {
    static constexpr bool PERM = true;
    const float* bglu; const float* modv1; bf16_t* H;
    __device__ __forceinline__ void operator()(const f32x4 (&acc)[2][2][4][2], const Unit& u, int wr, int wc, int fr, int fq) const {
        const int rt0 = u.pm * 256, bidx = rt0 >> 12, cb = u.pn * 128 + wc * 32 + 8 * fq, rl0 = wr * 64 + fr;
        const float* gp = modv1 + bidx * 6144 + 2048;
        const f32x4 ba0 = *(const f32x4*)(bglu + cb), ba1 = *(const f32x4*)(bglu + cb + 4), bb0 = *(const f32x4*)(bglu + 1024 + cb), bb1 = *(const f32x4*)(bglu + 1024 + cb + 4);
        const f32x4 gv0 = *(const f32x4*)(gp + cb), gv1 = *(const f32x4*)(gp + cb + 4);
        u32x4 hws[2][4];
#pragma unroll
        for (int ai = 0; ai < 2; ++ai)
#pragma unroll
            for (int m = 0; m < 4; ++m) hws[ai][m] = *(const u32x4*)(H + (size_t)(NCTX + rt0 + rl0 + ai * 128 + m * 16) * D + cb);
#pragma unroll
        for (int ai = 0; ai < 2; ++ai)
#pragma unroll
            for (int m = 0; m < 4; ++m) {
                bf16_t* hp = H + (size_t)(NCTX + rt0 + rl0 + ai * 128 + m * 16) * D + cb;
                const u32x4 hw = hws[ai][m]; const f32x4 h0 = (f32x4){bflo(hw.x), bfhi(hw.x), bflo(hw.y), bfhi(hw.y)}, h1 = (f32x4){bflo(hw.z), bfhi(hw.z), bflo(hw.w), bfhi(hw.w)};
                const f32x4 za0 = acc[ai][0][m][0] + ba0, za1 = acc[ai][0][m][1] + ba1, zb0 = acc[ai][1][m][0] + bb0, zb1 = acc[ai][1][m][1] + bb1; f32x4 o0, o1;
#pragma unroll
                for (int j = 0; j < 4; ++j) { o0[j] = za0[j] * sigmoid_f(zb0[j]); o1[j] = za1[j] * sigmoid_f(zb1[j]); }
                const f32x4 r0 = h0 + gv0 * o0, r1 = h1 + gv1 * o1;
                *(u32x4*)hp = (u32x4){pk2(r0[0], r0[1]), pk2(r0[2], r0[3]), pk2(r1[0], r1[1]), pk2(r1[2], r1[3])};
            }
    }
};

#define XB_TMO      128
#define XB_XCNT(j)  (256  + 64 * (j))
#define XB_XSUB(j)  (1280 + 64 * (j))
#define XB_XGEN(j)  (2304 + 64 * (j))
#define XB_TOP      3328
#define XB_TOPGEN   3392
#define XCD_BAR_WORDS 3456
#define XB_SPIN_CAP (1u << 18)
__device__ __forceinline__ unsigned xb_ld(unsigned* p)              { return __hip_atomic_load(p, __ATOMIC_RELAXED, __HIP_MEMORY_SCOPE_AGENT); }
__device__ __forceinline__ unsigned xb_add(unsigned* p, unsigned v) { return __hip_atomic_fetch_add(p, v, __ATOMIC_RELAXED, __HIP_MEMORY_SCOPE_AGENT); }
__device__ __forceinline__ unsigned xb_xcc_id() { return (unsigned)__builtin_amdgcn_s_getreg((3 << 11) | 20) & 0xFu; }
#define XB_SPIN(cond, bar) do { unsigned _sp = 0; while (cond) { __builtin_amdgcn_s_sleep(1); \
    if ((++_sp & 255u) == 0u) { if (xb_ld(&(bar)[XB_TMO])) break; if (_sp > XB_SPIN_CAP) { atomicAdd(&(bar)[XB_TMO], 1u); break; } } } } while (0)
struct XcdBarrier { unsigned* bar; unsigned x; volatile LAS unsigned* st; };
__device__ __forceinline__ XcdBarrier xcd_barrier_post(unsigned* bar, volatile LAS unsigned* st) {
    XcdBarrier b; b.bar = bar; b.x = xb_xcc_id(); b.st = st;
    if (threadIdx.x == 0) (void)xb_add(&bar[XB_XCNT(b.x)], 1u);
    return b;
}
__device__ __forceinline__ void xcd_barrier_complete(unsigned* bar, unsigned x, unsigned& nloc, unsigned& nx) {
    const unsigned G = gridDim.x * gridDim.y * gridDim.z;
    unsigned sum, cnt, mine, sp = 0u;
    for (;;) {
        sum = 0u; cnt = 0u; mine = 0u;
#pragma unroll
        for (unsigned j = 0; j < 16; ++j) { const unsigned c = xb_ld(&bar[XB_XCNT(j)]); sum += c; cnt += (c > 0u) ? 1u : 0u; mine = (j == x) ? c : mine; }
        if (sum == G) break;
        __builtin_amdgcn_s_sleep(1);
        if ((++sp & 255u) == 0u) { if (xb_ld(&bar[XB_TMO])) break; if (sp > XB_SPIN_CAP) { atomicAdd(&bar[XB_TMO], 1u); break; } }
    }
    nloc = mine > 0u ? mine : 1u; nx = cnt > 0u ? cnt : 1u;
}
__device__ __forceinline__ void xcd_barrier(const XcdBarrier& b) {
    asm volatile("s_waitcnt vmcnt(0)" ::: "memory");
    __syncthreads();
    if (threadIdx.x == 0) {
        unsigned* bar = b.bar;
        __builtin_amdgcn_s_waitcnt(0);
        unsigned nloc = b.st[0], nx = b.st[1];
        if (nloc == 0u) { xcd_barrier_complete(bar, b.x, nloc, nx); b.st[0] = nloc; b.st[1] = nx; }
        const unsigned old = xb_add(&bar[XB_XSUB(b.x)], 1u);
        const unsigned gen = old / nloc;
        if (old + 1u == (gen + 1u) * nloc) {
            __builtin_amdgcn_fence(__ATOMIC_RELEASE, "agent");
            asm volatile("s_waitcnt vmcnt(0)" ::: "memory");
            const unsigned og = xb_add(&bar[XB_TOP], 1u);
            const unsigned tg = og / nx;
            if (og + 1u == (tg + 1u) * nx) xb_add(&bar[XB_TOPGEN], 1u);
            else XB_SPIN(xb_ld(&bar[XB_TOPGEN]) == tg, bar);
            __builtin_amdgcn_fence(__ATOMIC_ACQUIRE, "agent");
            xb_add(&bar[XB_XGEN(b.x)], 1u);
            asm volatile("s_waitcnt vmcnt(0)" ::: "memory");
        } else {
            XB_SPIN(xb_ld(&bar[XB_XGEN(b.x)]) == gen, bar);
            __builtin_amdgcn_fence(__ATOMIC_ACQUIRE, "agent");
            asm volatile("s_waitcnt vmcnt(0)" ::: "memory");
        }
    }
    __syncthreads();
}

__device__ __forceinline__ int opaque_tid() { int t = threadIdx.x; asm volatile("" : "+v"(t)); return t; }
#define PHASE_IDS() const int tid = opaque_tid(); const int lane = tid & 63, wave = tid >> 6; const int G = gridDim.x, gw = blockIdx.x * 8 + wave, NGW = G * 8; \
    const int vcu = (G % 8 == 0) ? (int)(blockIdx.x % 8) * (G / 8) + (int)(blockIdx.x / 8) : (int)blockIdx.x; (void)lane; (void)wave; (void)gw; (void)NGW; (void)vcu; (void)G
__global__ void __launch_bounds__(NTHREADS, 2) fwd_mega(Args a) {
    extern __shared__ __attribute__((aligned(16))) unsigned char lds_raw[];
    LAS unsigned char* lds = (LAS unsigned char*)lds_raw;
    cg::grid_group grid = cg::this_grid();
    unsigned char* ws = a.ws;
    if (threadIdx.x < 2) ((LAS unsigned*)(lds + LDS_BYTES - 16))[threadIdx.x] = 0u;
    __syncthreads();
    const XcdBarrier xbar = xcd_barrier_post((unsigned*)(ws + WS_CTL) + CW_BAR, (volatile LAS unsigned*)(lds + LDS_BYTES - 16));
#ifdef TS_SEL
    volatile LAS unsigned long long* tsbuf = (volatile LAS unsigned long long*)(lds + LDS_BYTES - 16 - 256);
    int tsn = 0;
#define TS_MARK() do { if (blockIdx.x == 0 && threadIdx.x == 0) tsbuf[tsn] = __builtin_amdgcn_s_memrealtime(); ++tsn; } while (0)
#else
#define TS_MARK() do { } while (0)
#endif
    TS_MARK();
#define GSYNC() do { xcd_barrier(xbar); TS_MARK(); } while (0)

    for (int rep = 0; rep < REP_P0; ++rep) { PHASE_IDS(); p0_phase(a, lds, tid, gw, NGW); if (REP_P0 > 1) __syncthreads(); }
    if (a.pad1 != 0) grid.sync();
    GSYNC();
    for (int rep = 0; rep < REP_P1; ++rep) { PHASE_IDS(); p1_phase(a, lane, gw, NGW); }
    GSYNC();
    {
        PHASE_IDS();
        pg8::Gemm g{(const bf16_t*)(ws + WS_A), (const bf16_t*)(ws + WS_WIN), NTOK, 5120, 1024};
        pg8::StaticOrder S; S.init(NTOK, 5120, G, (int)blockIdx.x);
        EpiInProj E{(bf16_t*)(ws + WS_Q), (bf16_t*)(ws + WS_V), (bf16_t*)(ws + WS_G), (_Float16*)(ws + WS_LFF), (_Float16*)(ws + WS_LFB), (const float*)(ws + WS_LBV)};
        for (int rep = 0; rep < REP_INP; ++rep) pg8::gemm_phase<EpiInProj, pg8::StaticOrder>(lds, g, S, E);
    }
    GSYNC();
    for (int rep = 0; rep < REP_GLA; ++rep) { PHASE_IDS(); gla_phase(a, lds, tid); if (REP_GLA > 1) __syncthreads(); }
    GSYNC();
    for (int rep = 0; rep < REP_RO; ++rep) { PHASE_IDS(); gla_readout_phase(a, lane, gw, NGW); }
    GSYNC();
    {
        PHASE_IDS();
        pg8::Gemm g{(const bf16_t*)(ws + WS_OG), (const bf16_t*)(ws + WS_WOUT), NTOK, 1024, 1024};
        pg8::StaticOrder S; S.init(NTOK, 1024, G, (int)blockIdx.x);
        EpiResid E{a.in[I_X], a.in[I_CTX], (const float*)(ws + WS_MODV), (bf16_t*)(ws + WS_H), 2048};
        for (int rep = 0; rep < REP_OUT; ++rep) pg8::gemm_phase<EpiResid, pg8::StaticOrder>(lds, g, S, E);
    }
    GSYNC();
    for (int rep = 0; rep < REP_RT; ++rep) { PHASE_IDS(); router_phase(a, lds, 0, 0, tid); if (REP_RT > 1) __syncthreads(); }
    GSYNC();
    for (int rep = 0; rep < REP_AS; ++rep) { PHASE_IDS(); assign_phase(a, lds, 0, 0, tid); if (REP_AS > 1) __syncthreads(); }
    GSYNC();
    for (int rep = 0; rep < REP_M1; ++rep) { PHASE_IDS(); moe_gemm1(a, lds, 0, tid, G, vcu); }
    GSYNC();
    for (int rep = 0; rep < REP_M2; ++rep) { PHASE_IDS(); moe_gemm2(a, lds, 0, tid, G, vcu); }
    GSYNC();
    { PHASE_IDS(); combine_phase(a, 0, 0, lane, gw, NGW); }
    GSYNC();
    for (int rep = 0; rep < REP_S5; ++rep) { PHASE_IDS(); s5_phase(a, lds, tid); if (REP_S5 > 1) __syncthreads(); }
    GSYNC();
    for (int rep = 0; rep < REP_POST; ++rep) { PHASE_IDS(); s5_post_phase(a, lane, gw, NGW); }
    GSYNC();
    {
        PHASE_IDS();
        pg8::Gemm g{(const bf16_t*)(ws + WS_YG), (const bf16_t*)(ws + WS_WGLU), NLAT, 2048, 1024};
        pg8::StaticOrder S; S.init(NLAT, 2048, G, (int)blockIdx.x);
        EpiGlu E{a.in[I_S5BGLU], (const float*)(ws + WS_MODV) + 9 * 6144, (bf16_t*)(ws + WS_H)};
        pg8::gemm_phase<EpiGlu, pg8::StaticOrder>(lds, g, S, E);
    }
    GSYNC();
    { PHASE_IDS(); router_phase(a, lds, 1, NCTX, tid); }
    GSYNC();
    { PHASE_IDS(); assign_phase(a, lds, 1, NCTX, tid); }
    GSYNC();
    { PHASE_IDS(); moe_gemm1(a, lds, 1, tid, G, vcu); }
    GSYNC();
    { PHASE_IDS(); moe_gemm2(a, lds, 1, tid, G, vcu); }
    GSYNC();
    for (int rep = 0; rep < REP_CMB1; ++rep) { PHASE_IDS(); combine_phase(a, 1, NCTX, lane, gw, NGW); }
#ifdef TS_SEL
    TS_MARK();
    if (blockIdx.x == 0 && threadIdx.x == 0) {
        asm volatile("s_waitcnt vmcnt(0)" ::: "memory"); __threadfence();
        const unsigned long long dt = tsbuf[TS_SEL + 1] - tsbuf[TS_SEL];
        atomicAdd(a.out, (float)dt * 0.001f);
    }
#endif
}

extern "C" void kernel_launch(void* const* d_in, const int* in_sizes, int n_in, void* d_out, int out_size,
                              void* d_ws, size_t ws_size, hipStream_t stream) {
    static int grid_blocks = 0;
    if (!grid_blocks) {
        int dev = 0, cus = 0, per_cu = 0;
        (void)hipGetDevice(&dev);
        (void)hipDeviceGetAttribute(&cus, hipDeviceAttributeMultiprocessorCount, dev);
        (void)hipFuncSetAttribute((const void*)fwd_mega, hipFuncAttributeMaxDynamicSharedMemorySize, LDS_BYTES);
        (void)hipOccupancyMaxActiveBlocksPerMultiprocessor(&per_cu, (const void*)fwd_mega, NTHREADS, LDS_BYTES);
        if (per_cu < 1) { fprintf(stderr, "occupancy query says %d blocks/CU\n", per_cu); }
        grid_blocks = cus < 256 ? cus : 256;
        if (ws_size < WS_END) fprintf(stderr, "kernel_launch: workspace too small: %zu < %zu\n", ws_size, (size_t)WS_END);
    }
    (void)hipMemsetAsync((char*)d_ws + WS_CTL, 0, 1 * MiB, stream);
    Args a{};
    for (int i = 0; i < 29; ++i) a.in[i] = (const float*)d_in[i];
    a.out = (float*)d_out; a.ws = (unsigned char*)d_ws;
    void* kargs[] = {&a};
    hipError_t e = hipLaunchCooperativeKernel((const void*)fwd_mega, dim3(grid_blocks), dim3(NTHREADS), kargs, LDS_BYTES, stream);
    if (e != hipSuccess) fprintf(stderr, "cooperative launch failed: %s (grid %d)\n", hipGetErrorString(e), grid_blocks);
}
```

```cpp
#include <hip/hip_runtime.h>
#include <hip/hip_cooperative_groups.h>
#include <cstdio>
#include <cstdint>
namespace cg = cooperative_groups;

#define LAS __attribute__((address_space(3)))
typedef unsigned short bf16_t;
typedef short bf16x8 __attribute__((ext_vector_type(8)));
typedef float f32x4 __attribute__((ext_vector_type(4)));
typedef unsigned u32x4 __attribute__((ext_vector_type(4)));
typedef unsigned u32x2 __attribute__((ext_vector_type(2)));
typedef float f32x2 __attribute__((ext_vector_type(2)));

constexpr int NTHREADS = 512;
constexpr int LDS_BYTES = 147456;
constexpr int D = 1024, NB = 8, SEQ = 4096, CTXL = 256;
constexpr int NCTX = NB * CTXL;
constexpr int NLAT = NB * SEQ;
constexpr int NTOK = NCTX + NLAT;
constexpr int NE = 32;
constexpr int MPAD = 147456;
constexpr float EPS = 1e-6f;

constexpr size_t MiB = 1u << 20;
constexpr size_t WS_CTL = 0;
constexpr size_t WS_MODV = 1 * MiB;
constexpr size_t WS_LBV = 1 * MiB + 512 * 1024;
constexpr size_t WS_WIN = 2 * MiB;
constexpr size_t WS_WOUT = 12 * MiB;
constexpr size_t WS_WGLU = 14 * MiB;
constexpr size_t WS_W1 = 18 * MiB;
constexpr size_t WS_W2 = 274 * MiB;
constexpr size_t WS_H = 402 * MiB;
constexpr size_t WS_A = 538 * MiB;
constexpr size_t WS_F = 606 * MiB;
constexpr size_t WS_TOKE = 674 * MiB;
constexpr size_t WS_TOKW = 674 * MiB + 640 * 1024;
constexpr size_t WS_TOKS = 674 * MiB + 1280 * 1024;
constexpr size_t WS_SLOTTOK = 256 * 1024;
constexpr size_t WS_BIG = 676 * MiB;
constexpr size_t WS_Q = WS_BIG, WS_V = WS_BIG + 68 * MiB, WS_G = WS_BIG + 136 * MiB;
constexpr size_t WS_LFF = WS_BIG + 204 * MiB, WS_LFB = WS_BIG + 340 * MiB;
constexpr size_t WS_OF = WS_BIG + 476 * MiB, WS_OB = WS_BIG + 612 * MiB;
constexpr size_t WS_OG = WS_BIG + 748 * MiB;
constexpr size_t WS_AG = WS_BIG, WS_ACT = WS_BIG + 288 * MiB, WS_YS = WS_BIG;
constexpr size_t WS_YF = WS_BIG, WS_YB = WS_BIG + 128 * MiB, WS_YG = WS_BIG + 256 * MiB;
constexpr size_t WS_END = WS_BIG + 816 * MiB;
constexpr int CW_CNT = 64;
constexpr int CW_CUR = 256;
constexpr int CW_CNTB = 8192;
constexpr int CW_BAR = 4096;
#ifndef REP_P0
#define REP_P0 1
#endif
#ifndef REP_GLA
#define REP_GLA 1
#endif
#ifndef REP_S5
#define REP_S5 1
#endif
#ifndef REP_P1
#define REP_P1 1
#endif
#ifndef REP_RO
#define REP_RO 1
#endif
#ifndef REP_POST
#define REP_POST 1
#endif
#ifndef REP_CMB1
#define REP_CMB1 1
#endif
#ifndef REP_OUT
#define REP_OUT 1
#endif
#ifndef REP_RT
#define REP_RT 1
#endif
#ifndef REP_AS
#define REP_AS 1
#endif
#ifndef REP_INP
#define REP_INP 1
#endif
#ifndef REP_M1
#define REP_M1 1
#endif
#ifndef REP_M2
#define REP_M2 1
#endif

struct Args {
    const float* in[29];
    float* out;
    unsigned char* ws;
    int stop_after, pad1;
};
enum { I_X = 0, I_C, I_CTX, I_CCTX, I_MODW, I_MODB, I_N1G, I_N2G, I_HGWIN, I_HGLB, I_HGNG, I_HGWOUT, I_S5ARE, I_S5AIM, I_S5LDT,
       I_S5BRE, I_S5BIM, I_S5CRE, I_S5CIM, I_S5D, I_S5WGLU, I_S5BGLU, I_RW, I_RB, I_W1, I_B1, I_W2, I_B2, I_FG };

__device__ __forceinline__ unsigned f2bf(float f) { unsigned u = __builtin_bit_cast(unsigned, f); return (u + 0x7fffu + ((u >> 16) & 1u)) >> 16; }
typedef __bf16 bf16x2_t __attribute__((ext_vector_type(2)));
__device__ __forceinline__ unsigned cvt_pk_bf16(float lo, float hi) { const bf16x2_t v = {(__bf16)lo, (__bf16)hi}; return __builtin_bit_cast(unsigned, v); }
__device__ __forceinline__ unsigned pk2(float lo, float hi) { return cvt_pk_bf16(lo, hi); }
__device__ __forceinline__ float bf2f(unsigned short b) { return __builtin_bit_cast(float, ((unsigned)b) << 16); }
__device__ __forceinline__ float bflo(unsigned w) { return __builtin_bit_cast(float, w << 16); }
__device__ __forceinline__ float bfhi(unsigned w) { return __builtin_bit_cast(float, w & 0xffff0000u); }
__device__ __forceinline__ float wave_sum(float v) {
#pragma unroll
    for (int o = 1; o < 64; o <<= 1) v += __shfl_xor(v, o);
    return v;
}
__device__ __forceinline__ float wave_max(float v) {
#pragma unroll
    for (int o = 1; o < 64; o <<= 1) v = fmaxf(v, __shfl_xor(v, o));
    return v;
}
__device__ __forceinline__ float sigmoid_f(float x) { return __builtin_amdgcn_rcpf(1.0f + __expf(-x)); }
__device__ __forceinline__ float silu_f(float x) { return x * __builtin_amdgcn_rcpf(1.0f + __expf(-x)); }
#define LDS_WAIT() asm volatile("s_waitcnt lgkmcnt(0)" ::: "memory")

namespace pg8 {
constexpr int BM = 256, BK = 64, HALF = 128, HTB = HALF * BK * 2, STAGE_BYTES = 8 * HTB, NXCD = 8, WGM = 8;
__host__ __device__ __forceinline__ int lds_byte(int r, int c) { const int st = (r >> 4) * 2 + (c >> 5), rr = r & 15, cc = c & 31, ob = rr * 64 + cc * 2; return st * 1024 + (ob ^ (((ob >> 9) & 1) << 5)); }
__host__ __device__ __forceinline__ void stage_rc(int b, int& R, int& C) { const int st = b / 1024, sb = b % 1024, swz = sb ^ (((sb >> 9) & 1) << 5); R = (st >> 1) * 16 + swz / 64; C = (st & 1) * 32 + (swz % 64) / 2; }
__host__ __device__ __forceinline__ int perm32(int rho) { const int n = rho >> 4, i = rho & 15; return 8 * (i >> 2) + 4 * n + (i & 3); }
struct Unit { int pm, pn; };
struct Gemm { const bf16_t* A; const bf16_t* Bt; int M, N, K; };
struct StaticOrder {
    int nM, nN, nwg, G, c;
    __device__ void init(int M, int N, int G_, int c_) { nM = M / BM; nN = N / BM; nwg = nM * nN; G = G_; c = c_; }
    __device__ bool next(int i, Unit& u) const {
        const long L = (long)i * G + c; if (L >= nwg) return false;
        int wgid = (int)L; { const int q = nwg / NXCD, r = nwg % NXCD, xcd = wgid % NXCD, off = wgid / NXCD; wgid = (xcd < r ? xcd * (q + 1) : r * (q + 1) + (xcd - r) * q) + off; }
        const int nig = WGM * nN, gid = wgid / nig, fm = gid * WGM, gsz = (nM - fm) < WGM ? (nM - fm) : WGM;
        u.pm = fm + ((wgid % nig) % gsz); u.pn = (wgid % nig) / gsz; return true;
    }
    __device__ __forceinline__ void a_ready(const Unit&) const {}
    __device__ __forceinline__ void done(const Unit&) const {}
};
struct MoeOrder {
    const LAS int* tile_e; int TT, sh, G, v;
    __device__ bool next(int i, Unit& u) const {
        const bool p2 = (G & (G - 1)) == 0 && G >= 8;
        const int lg = p2 ? (31 - __builtin_clz((unsigned)G)) - 3 : 0, per = p2 ? (1 << lg) : G, x = p2 ? (v >> lg) : 0, j = p2 ? (v & (per - 1)) : v, nx = p2 ? 8 : 1;
        const int t0 = (x * TT) / nx, t1 = ((x + 1) * TT) / nx;
        const int uu = i * per + j, rt = t0 + (uu >> sh), pnl = uu & ((1 << sh) - 1);
        if (rt >= t1) return false;
        u.pm = rt; u.pn = (tile_e[rt] << sh) + pnl; return true;
    }
    __device__ __forceinline__ void a_ready(const Unit&) const {}
    __device__ __forceinline__ void done(const Unit&) const {}
};

template <class Epi, class Sched, bool GATHER = false, bool ALIGN_EPI = true, bool SP2 = true>
__device__ __forceinline__ void gemm_phase(LAS unsigned char* lds, const Gemm g, const Sched& S, const Epi& E, const LAS unsigned short* rowl = nullptr) {
    int tid_ = threadIdx.x; asm volatile("" : "+v"(tid_));
    const int tid = tid_, wid = __builtin_amdgcn_readfirstlane(tid >> 6), lane = tid & 63, wr = wid >> 2, wc = wid & 3, fr = lane & 15, fq = lane >> 4;
    const int K = g.K, nt = K / BK;
    unsigned voffA[2], voffB[2];
    int Rr[2], Cc2[2];
#pragma unroll
    for (int i = 0; i < 2; ++i) { int R, C; stage_rc(tid * 16 + i * 8192, R, C); voffA[i] = (unsigned)(R * K + C) * 2u; const int Rb = Epi::PERM ? ((R & ~31) + perm32(R & 31)) : R; voffB[i] = (unsigned)(Rb * K + C) * 2u; Rr[i] = R; Cc2[i] = C * 2; }
    unsigned gA0[2] = {0u, 0u}, gA1[2] = {0u, 0u}, nG0[2] = {0u, 0u}, nG1[2] = {0u, 0u};
#define PG8_ROWS(ui_, d0, d1) do { _Pragma("unroll") for (int _i = 0; _i < 2; ++_i) { d0[_i] = (unsigned)rowl[(ui_) * BM + Rr[_i]] * (unsigned)(K * 2) + (unsigned)Cc2[_i]; d1[_i] = (unsigned)rowl[(ui_) * BM + HALF + Rr[_i]] * (unsigned)(K * 2) + (unsigned)Cc2[_i]; } } while (0)
#define PG8_STAGE_A(bufoff, ptr, h, nx) do { if constexpr (GATHER) { unsigned _o[2]; _o[0] = (nx) ? ((h) ? nG1[0] : nG0[0]) : ((h) ? gA1[0] : gA0[0]); _o[1] = (nx) ? ((h) ? nG1[1] : nG0[1]) : ((h) ? gA1[1] : gA0[1]); PG8_STAGE(bufoff, ptr, _o); } \
        else { PG8_STAGE(bufoff, (ptr) + ((h) ? hstep : 0), voffA); } } while (0)
    const size_t kstep = (size_t)(BK * 2);
    const size_t hstep = (size_t)HALF * K * 2;
    const size_t tstep = 2 * hstep;
    const unsigned ldsw = (unsigned)wid * 1024u;
    const int aoff = lds_byte(wr * 64 + fr, fq * 8), boff = lds_byte(wc * 32 + fr, fq * 8);
#define PG8_SA(b, h) (((b) * 2 + (h)) * HTB)
#define PG8_SB(b, h) ((4 + (b) * 2 + (h)) * HTB)
#define PG8_STAGE(bufoff, gbase, voff) do { _Pragma("unroll") for (int _i = 0; _i < 2; ++_i) \
        __builtin_amdgcn_global_load_lds((const unsigned*)((const char*)(gbase) + (voff)[_i]), (LAS unsigned*)(lds + (bufoff) + ldsw + _i * 8192), 16, 0, 0); } while (0)
#define PG8_LDA(dst, b, h) do { _Pragma("unroll") for (int m = 0; m < 4; ++m) _Pragma("unroll") for (int k = 0; k < 2; ++k) dst[m][k] = *(const LAS bf16x8*)(lds + PG8_SA(b, h) + aoff + m * 2048 + k * 1024); } while (0)
#define PG8_LDB(dst, b, h) do { _Pragma("unroll") for (int n = 0; n < 2; ++n) _Pragma("unroll") for (int k = 0; k < 2; ++k) dst[n][k] = *(const LAS bf16x8*)(lds + PG8_SB(b, h) + boff + n * 2048 + k * 1024); } while (0)
#define PG8_MMA(ai, bj, At, Bt) do { __builtin_amdgcn_s_setprio(1); _Pragma("unroll") for (int m = 0; m < 4; ++m) _Pragma("unroll") for (int n = 0; n < 2; ++n) _Pragma("unroll") for (int k = 0; k < 2; ++k) \
        acc[ai][bj][m][n] = __builtin_amdgcn_mfma_f32_16x16x32_bf16(Bt[n][k], At[m][k], acc[ai][bj][m][n], 0, 0, 0); __builtin_amdgcn_s_setprio(0); } while (0)
#define PG8_WAIT_V(n) asm volatile("s_waitcnt vmcnt(" #n ")" ::: "memory")
#define PG8_WAIT_L(n) asm volatile("s_waitcnt lgkmcnt(" #n ")" ::: "memory")
#define PG8_BAR __builtin_amdgcn_s_barrier()
#define PG8_SCHED __builtin_amdgcn_sched_barrier(0)
    Unit cur, nxt; int ui = 0;
    if (!S.next(0, cur)) return;
    f32x4 acc[2][2][4][2];
#pragma unroll
    for (int a = 0; a < 2; ++a)
#pragma unroll
        for (int b = 0; b < 2; ++b)
#pragma unroll
            for (int m = 0; m < 4; ++m)
#pragma unroll
                for (int n = 0; n < 2; ++n) acc[a][b][m][n] = (f32x4){0.f, 0.f, 0.f, 0.f};
    bf16x8 At[4][2], B0[2][2], B1[2][2];
    const char* cA = GATHER ? (const char*)g.A : (const char*)g.A + (size_t)cur.pm * tstep; const char* cB = (const char*)g.Bt + (size_t)cur.pn * tstep;
    S.a_ready(cur);
    if constexpr (GATHER) PG8_ROWS(0, gA0, gA1);
    if constexpr (SP2) {
        PG8_STAGE(PG8_SB(0, 0), cB, voffB); PG8_STAGE(PG8_SB(0, 1), cB + hstep, voffB); PG8_STAGE_A(PG8_SA(0, 0), cA, 0, false); PG8_STAGE_A(PG8_SA(0, 1), cA, 1, false);
        if (wr == 1) PG8_BAR;
        PG8_WAIT_V(2); PG8_BAR;
        PG8_STAGE(PG8_SB(1, 0), cB + kstep, voffB); PG8_STAGE_A(PG8_SA(1, 0), cA + kstep, 0, false); PG8_STAGE(PG8_SB(1, 1), cB + hstep + kstep, voffB);
        PG8_WAIT_V(6); PG8_BAR;
    } else {
        PG8_STAGE(PG8_SB(0, 0), cB, voffB); PG8_STAGE_A(PG8_SA(0, 0), cA, 0, false); PG8_STAGE(PG8_SB(0, 1), cB + hstep, voffB); PG8_STAGE_A(PG8_SA(0, 1), cA, 1, false);
        if (wr == 1) PG8_BAR;
        PG8_WAIT_V(4); PG8_BAR;
        PG8_STAGE(PG8_SB(1, 0), cB + kstep, voffB); PG8_STAGE_A(PG8_SA(1, 0), cA + kstep, 0, false); PG8_STAGE(PG8_SB(1, 1), cB + hstep + kstep, voffB);
        PG8_WAIT_V(6); PG8_BAR;
    }
    for (;;) {
        const bool has_next = S.next(ui + 1, nxt);
        const char* nA = GATHER ? cA : (has_next ? (const char*)g.A + (size_t)nxt.pm * tstep : cA); const char* nB = has_next ? (const char*)g.Bt + (size_t)nxt.pn * tstep : cB;
        if constexpr (GATHER) { if (has_next) PG8_ROWS(ui + 1, nG0, nG1); else { nG0[0] = gA0[0]; nG0[1] = gA0[1]; nG1[0] = gA1[0]; nG1[1] = gA1[1]; } }
        for (int t = 0; t < nt; t += 2) {
            const bool last = (t == nt - 2);
            const char* a1 = cA + (size_t)(t + 1) * kstep;
            const char* a2 = last ? nA : cA + (size_t)(t + 2) * kstep; const char* b2 = last ? nB : cB + (size_t)(t + 2) * kstep;
            const char* a3 = a2 + kstep; const char* b3 = b2 + kstep;
            if (last && has_next) S.a_ready(nxt);
            if constexpr (SP2) {
            PG8_LDB(B0, 0, 0); PG8_LDB(B1, 0, 1); PG8_SCHED; PG8_LDA(At, 0, 0); PG8_STAGE_A(PG8_SA(1, 1), a1, 1, false);
            PG8_WAIT_V(8); PG8_WAIT_L(0); PG8_BAR; PG8_MMA(0, 0, At, B0); PG8_MMA(0, 1, At, B1); PG8_BAR; PG8_SCHED;
            PG8_LDA(At, 0, 1); PG8_STAGE(PG8_SB(0, 0), b2, voffB); PG8_STAGE(PG8_SB(0, 1), b2 + hstep, voffB); PG8_STAGE_A(PG8_SA(0, 0), a2, 0, last);
            PG8_WAIT_V(8); PG8_WAIT_L(0); PG8_BAR; PG8_MMA(1, 0, At, B0); PG8_MMA(1, 1, At, B1); PG8_BAR; PG8_SCHED;
            PG8_LDB(B0, 1, 0); PG8_LDB(B1, 1, 1); PG8_SCHED; PG8_LDA(At, 1, 0); PG8_STAGE_A(PG8_SA(0, 1), a2, 1, last);
            PG8_WAIT_V(8); PG8_WAIT_L(0); PG8_BAR; PG8_MMA(0, 0, At, B0); PG8_MMA(0, 1, At, B1); PG8_BAR; PG8_SCHED;
            PG8_LDA(At, 1, 1); PG8_STAGE(PG8_SB(1, 0), b3, voffB); PG8_STAGE(PG8_SB(1, 1), b3 + hstep, voffB); PG8_STAGE_A(PG8_SA(1, 0), a3, 0, last);
            PG8_WAIT_V(8); PG8_WAIT_L(0); PG8_BAR; PG8_MMA(1, 0, At, B0); PG8_MMA(1, 1, At, B1); PG8_BAR; PG8_SCHED;
            } else {
            PG8_LDB(B0, 0, 0); PG8_SCHED; PG8_LDA(At, 0, 0); PG8_STAGE_A(PG8_SA(1, 1), a1, 1, false);
            PG8_WAIT_L(8); PG8_BAR; PG8_WAIT_L(0); PG8_MMA(0, 0, At, B0); PG8_BAR; PG8_SCHED;
            PG8_LDB(B1, 0, 1); PG8_STAGE(PG8_SB(0, 0), b2, voffB);
            PG8_BAR; PG8_WAIT_L(0); PG8_MMA(0, 1, At, B1); PG8_BAR;
            PG8_LDA(At, 0, 1); PG8_STAGE_A(PG8_SA(0, 0), a2, 0, last);
            PG8_BAR; PG8_WAIT_L(0); PG8_MMA(1, 0, At, B0); PG8_BAR; PG8_SCHED;
            PG8_STAGE(PG8_SB(0, 1), b2 + hstep, voffB);
            PG8_WAIT_V(6); PG8_BAR; PG8_MMA(1, 1, At, B1); PG8_BAR;
            PG8_LDB(B0, 1, 0); PG8_SCHED; PG8_LDA(At, 1, 0); PG8_STAGE_A(PG8_SA(0, 1), a2, 1, last);
            PG8_WAIT_L(8); PG8_BAR; PG8_WAIT_L(0); PG8_MMA(0, 0, At, B0); PG8_BAR; PG8_SCHED;
            PG8_LDB(B1, 1, 1); PG8_STAGE(PG8_SB(1, 0), b3, voffB);
            PG8_BAR; PG8_WAIT_L(0); PG8_MMA(0, 1, At, B1); PG8_BAR;
            PG8_LDA(At, 1, 1); PG8_STAGE_A(PG8_SA(1, 0), a3, 0, last);
            PG8_BAR; PG8_WAIT_L(0); PG8_MMA(1, 0, At, B0); PG8_BAR; PG8_SCHED;
            PG8_STAGE(PG8_SB(1, 1), b3 + hstep, voffB);
            PG8_WAIT_V(6); PG8_BAR; PG8_MMA(1, 1, At, B1); PG8_BAR;
                    }
        }
        if constexpr (ALIGN_EPI) { if (wr == 0) PG8_BAR; }
        E(acc, cur, wr, wc, fr, fq); S.done(cur);
        if (!has_next) break;
#pragma unroll
        for (int a = 0; a < 2; ++a)
#pragma unroll
            for (int b = 0; b < 2; ++b)
#pragma unroll
                for (int m = 0; m < 4; ++m)
#pragma unroll
                    for (int n = 0; n < 2; ++n) acc[a][b][m][n] = (f32x4){0.f, 0.f, 0.f, 0.f};
        cur = nxt; cA = nA; cB = nB; ++ui;
        if constexpr (GATHER) { gA0[0] = nG0[0]; gA0[1] = nG0[1]; gA1[0] = nG1[0]; gA1[1] = nG1[1]; }
        if constexpr (ALIGN_EPI) { if (wr == 1) PG8_BAR; }
    }
    PG8_WAIT_V(0);
    if constexpr (!ALIGN_EPI) { if (wr == 0) PG8_BAR; }
    PG8_BAR;
#undef PG8_SA
#undef PG8_ROWS
#undef PG8_STAGE_A
#undef PG8_SB
#undef PG8_STAGE
#undef PG8_LDA
#undef PG8_LDB
#undef PG8_MMA
#undef PG8_WAIT_V
#undef PG8_WAIT_L
#undef PG8_BAR
#undef PG8_SCHED
}
}
using pg8::Unit;

__device__ __forceinline__ f32x4 ld_bf16x4(const bf16_t* p) { const u32x2 w = *(const u32x2*)p; return (f32x4){bflo(w.x), bfhi(w.x), bflo(w.y), bfhi(w.y)}; }
__device__ __forceinline__ void st_bf16x4(bf16_t* p, f32x4 v) { u32x2 w; w.x = pk2(v[0], v[1]); w.y = pk2(v[2], v[3]); *(u32x2*)p = w; }

struct EpiInProj {
    static constexpr bool PERM = true;
    bf16_t *Q, *V, *G; _Float16 *LFF, *LFB; const float* lbv;
    __device__ __forceinline__ void operator()(const f32x4 (&acc)[2][2][4][2], const Unit& u, int wr, int wc, int fr, int fq) const {
        const int seg = u.pn >> 2, cb = (u.pn & 3) * 256 + wc * 32 + 8 * fq, row0 = u.pm * 256 + wr * 64 + fr;
#pragma unroll
        for (int bj = 0; bj < 2; ++bj) {
            const int c = cb + bj * 128;
            f32x4 lb0 = (f32x4){0.f, 0.f, 0.f, 0.f}, lb1 = lb0;
            if (seg == 2 || seg == 3) { lb0 = *(const f32x4*)(lbv + (seg - 2) * D + c); lb1 = *(const f32x4*)(lbv + (seg - 2) * D + c + 4); }
#pragma unroll
            for (int ai = 0; ai < 2; ++ai)
#pragma unroll
                for (int m = 0; m < 4; ++m) {
                    const size_t ro = (size_t)(row0 + ai * 128 + m * 16) * D + c;
                    const f32x4 v0 = acc[ai][bj][m][0], v1 = acc[ai][bj][m][1];
                    if (seg == 0) { f32x4 o0, o1; for (int j = 0; j < 4; ++j) { o0[j] = silu_f(v0[j]); o1[j] = silu_f(v1[j]); }
                        *(u32x4*)(Q + ro) = (u32x4){pk2(o0[0], o0[1]), pk2(o0[2], o0[3]), pk2(o1[0], o1[1]), pk2(o1[2], o1[3])}; }
                    else if (seg == 1) { *(u32x4*)(V + ro) = (u32x4){pk2(v0[0], v0[1]), pk2(v0[2], v0[3]), pk2(v1[0], v1[1]), pk2(v1[2], v1[3])}; }
                    else if (seg == 4) { *(u32x4*)(G + ro) = (u32x4){pk2(v0[0], v0[1]), pk2(v0[2], v0[3]), pk2(v1[0], v1[1]), pk2(v1[2], v1[3])}; }
                    else {
                        f32x4 o0, o1;
                        for (int j = 0; j < 4; ++j) { o0[j] = __logf(lb0[j] + (1.0f - lb0[j]) * sigmoid_f(v0[j])); o1[j] = __logf(lb1[j] + (1.0f - lb1[j]) * sigmoid_f(v1[j])); }
                        u32x4 hw; hw.x = __builtin_bit_cast(unsigned, __builtin_amdgcn_cvt_pkrtz(o0[0], o0[1])); hw.y = __builtin_bit_cast(unsigned, __builtin_amdgcn_cvt_pkrtz(o0[2], o0[3]));
                        hw.z = __builtin_bit_cast(unsigned, __builtin_amdgcn_cvt_pkrtz(o1[0], o1[1])); hw.w = __builtin_bit_cast(unsigned, __builtin_amdgcn_cvt_pkrtz(o1[2], o1[3]));
                        *(u32x4*)((seg == 2 ? LFF : LFB) + ro) = hw;
                    }
                }
        }
    }
};
struct EpiResid {
    static constexpr bool PERM = true;
    const float* x; const float* ctx; const float* modv; bf16_t* H; int gate_off;
    __device__ __forceinline__ void operator()(const f32x4 (&acc)[2][2][4][2], const Unit& u, int wr, int wc, int fr, int fq) const {
        const int rt0 = u.pm * 256; const int mr = rt0 < NCTX ? 8 : ((rt0 - NCTX) >> 12);
        const float* src = rt0 < NCTX ? ctx + (size_t)rt0 * D : x + (size_t)(rt0 - NCTX) * D;
        const int cb = u.pn * 256 + wc * 32 + 8 * fq, rl0 = wr * 64 + fr;
        const float* gp = modv + mr * 6144 + gate_off;
        f32x4 gg[2][2];
#pragma unroll
        for (int bj = 0; bj < 2; ++bj) { gg[bj][0] = *(const f32x4*)(gp + cb + bj * 128); gg[bj][1] = *(const f32x4*)(gp + cb + bj * 128 + 4); }
#pragma unroll
        for (int bj = 0; bj < 2; ++bj)
#pragma unroll
            for (int ai = 0; ai < 2; ++ai) {
                const int c = cb + bj * 128; f32x4 h0[4], h1[4];
#pragma unroll
                for (int m = 0; m < 4; ++m) { const float* hp = src + (size_t)(rl0 + ai * 128 + m * 16) * D + c; h0[m] = *(const f32x4*)hp; h1[m] = *(const f32x4*)(hp + 4); }
#pragma unroll
                for (int m = 0; m < 4; ++m) {
                    const f32x4 o0 = h0[m] + gg[bj][0] * acc[ai][bj][m][0], o1 = h1[m] + gg[bj][1] * acc[ai][bj][m][1];
                    *(u32x4*)(H + (size_t)(rt0 + rl0 + ai * 128 + m * 16) * D + c) = (u32x4){pk2(o0[0], o0[1]), pk2(o0[2], o0[3]), pk2(o1[0], o1[1]), pk2(o1[2], o1[3])};
                }
                asm volatile("" ::: "memory");
            }
    }
};

struct TrItem { const float* src; bf16_t* dst; int N; };
__device__ __forceinline__ void tr_load(const TrItem& t, f32x4 (&v)[16], int lane) {
    const float* p = t.src + (size_t)(2 * (lane >> 4)) * t.N + 4 * (lane & 15);
#pragma unroll
    for (int i = 0; i < 8; ++i) { v[2 * i] = *(const f32x4*)(p + (size_t)(8 * i) * t.N); v[2 * i + 1] = *(const f32x4*)(p + (size_t)(8 * i + 1) * t.N); }
}
__device__ __forceinline__ void tr_finish(const TrItem& t, const f32x4 (&v)[16], LAS unsigned* scr, int lane) {
#pragma unroll
    for (int i = 0; i < 8; ++i) {
        const int kp = 4 * i + (lane >> 4); LAS unsigned* s = scr + kp * 65 + 4 * (lane & 15);
        s[0] = cvt_pk_bf16(v[2 * i][0], v[2 * i + 1][0]); s[1] = cvt_pk_bf16(v[2 * i][1], v[2 * i + 1][1]); s[2] = cvt_pk_bf16(v[2 * i][2], v[2 * i + 1][2]); s[3] = cvt_pk_bf16(v[2 * i][3], v[2 * i + 1][3]);
    }
    LDS_WAIT();
    const int c = lane & 7;
#pragma unroll
    for (int j = 0; j < 8; ++j) {
        const int n = (lane >> 3) + 8 * j; const LAS unsigned* s = scr + (4 * c) * 65 + n;
        *(u32x4*)(t.dst + (size_t)n * 1024 + 8 * c) = (u32x4){s[0], s[65], s[130], s[195]};
    }
    LDS_WAIT();
}
__device__ __forceinline__ int ilv_row(int c) { const int bj = c >> 10, r = c & 1023; return (r >> 7) * 256 + bj * 128 + (r & 127); }

__device__ __forceinline__ TrItem moe_item(const Args& a, int r, int layer) {
    TrItem t;
    if (r < 32 * 512) { const int mat = layer * 32 + (r >> 9), sub = r & 511, kb = sub >> 5, nb = sub & 31;
        t.src = a.in[I_W1] + (size_t)mat * 1024 * 2048 + (size_t)(kb * 64) * 2048 + nb * 64; t.dst = (bf16_t*)(a.ws + WS_W1) + (size_t)mat * 2048 * 1024 + (size_t)ilv_row(nb * 64) * 1024 + kb * 64; t.N = 2048; }
    else { r -= 32 * 512; const int mat = layer * 32 + (r >> 8), sub = r & 255, kb = sub >> 4, nb = sub & 15;
        t.src = a.in[I_W2] + (size_t)mat * 1024 * 1024 + (size_t)(kb * 64) * 1024 + nb * 64; t.dst = (bf16_t*)(a.ws + WS_W2) + (size_t)mat * 1024 * 1024 + (size_t)(nb * 64) * 1024 + kb * 64; t.N = 1024; }
    return t;
}
constexpr int P0_NWIN = 16 * 80, P0_NWOUT = 16 * 16, P0_NWGLU = 16 * 32, P0_NITEMS = P0_NWIN + P0_NWOUT + P0_NWGLU + 32 * 512 + 32 * 256;
__device__ __forceinline__ TrItem p0_item(const Args& a, int r) {
    TrItem t;
    if (r < P0_NWIN) { const int kb = r / 80, nb = r % 80; t.src = a.in[I_HGWIN] + (size_t)(kb * 64) * 5120 + nb * 64; t.dst = (bf16_t*)(a.ws + WS_WIN) + (size_t)(nb * 64) * 1024 + kb * 64; t.N = 5120; return t; } r -= P0_NWIN;
    if (r < P0_NWOUT) { const int kb = r / 16, nb = r % 16; t.src = a.in[I_HGWOUT] + (size_t)(kb * 64) * 1024 + nb * 64; t.dst = (bf16_t*)(a.ws + WS_WOUT) + (size_t)(nb * 64) * 1024 + kb * 64; t.N = 1024; return t; } r -= P0_NWOUT;
    if (r < P0_NWGLU) { const int kb = r / 32, nb = r % 32; t.src = a.in[I_S5WGLU] + (size_t)(kb * 64) * 2048 + nb * 64; t.dst = (bf16_t*)(a.ws + WS_WGLU) + (size_t)ilv_row(nb * 64) * 1024 + kb * 64; t.N = 2048; return t; } r -= P0_NWGLU;
    return moe_item(a, r, 0);
}
#define TR_LOOP(first, stride, count, ITEM) do { int _it = (first); if (_it < (count)) { f32x4 _va[16], _vb[16]; TrItem _A = ITEM(_it), _B = _A; tr_load(_A, _va, lane); \
        for (;;) { const int _i2 = _it + (stride); const bool _h2 = _i2 < (count); if (_h2) { _B = ITEM(_i2); tr_load(_B, _vb, lane); } tr_finish(_A, _va, scr, lane); if (!_h2) break; \
                   _it = _i2 + (stride); const bool _h1 = _it < (count); if (_h1) { _A = ITEM(_it); tr_load(_A, _va, lane); } tr_finish(_B, _vb, scr, lane); if (!_h1) break; } } } while (0)
__device__ __forceinline__ void p0_phase(const Args& a, LAS unsigned char* lds, int tid, int gw, int NGW) {
    const int lane = tid & 63, wave = tid >> 6;
    unsigned char* ws = a.ws;
    float* modv = (float*)(ws + WS_MODV);
    if (blockIdx.x < 192) {
        LAS float* SC = (LAS float*)lds;
        LAS float* PART = (LAS float*)(lds + 40960);
        for (int i = tid; i < 9 * 1024; i += NTHREADS) { const int r = i >> 10, k = i & 1023; const float v = r < 8 ? a.in[I_C][r * 1024 + k] : a.in[I_CCTX][k]; SC[i] = silu_f(v); }
        __syncthreads();
        const int layer = blockIdx.x / 96, ng = blockIdx.x % 96;
        const float* W = a.in[I_MODW] + (size_t)layer * 1024 * 6144 + ng * 64 + lane;
        float acc[9];
#pragma unroll
        for (int r = 0; r < 9; ++r) acc[r] = 0.f;
#pragma unroll 8
        for (int kk = 0; kk < 128; ++kk) {
            const int k = wave * 128 + kk; const float w = W[(size_t)k * 6144];
#pragma unroll
            for (int r = 0; r < 9; ++r) acc[r] += SC[r * 1024 + k] * w;
        }
#pragma unroll
        for (int r = 0; r < 9; ++r) PART[(wave * 9 + r) * 64 + lane] = acc[r];
        __syncthreads();
        for (int i = tid; i < 9 * 64; i += NTHREADS) {
            const int r = i >> 6, l = i & 63; float s = a.in[I_MODB][layer * 6144 + ng * 64 + l];
#pragma unroll
            for (int w = 0; w < 8; ++w) s += PART[(w * 9 + r) * 64 + l];
            modv[(size_t)(layer * 9 + r) * 6144 + ng * 64 + l] = s;
        }
        __syncthreads();
    } else if (blockIdx.x == 192) {
        float* lbv = (float*)(ws + WS_LBV);
        for (int i = tid; i < 2048; i += NTHREADS) { const float l0 = a.in[I_HGLB][i], l1 = a.in[I_HGLB][2048 + i]; lbv[i] = 1.0f / (1.0f + __expf(l1 - l0)); }
    }
    LAS unsigned* scr = (LAS unsigned*)(lds + 59392 + wave * 8320);
#define P0_ITEM(i) p0_item(a, (i))
    const int nfast = ((int)gridDim.x > 192) ? ((int)gridDim.x - 192) * 8 : 0, nextra = nfast * 3, n1 = P0_NITEMS - nextra;
    TR_LOOP(gw, NGW, n1, P0_ITEM);
    if (blockIdx.x >= 192) { TR_LOOP(n1 + (gw - 192 * 8), nfast, P0_NITEMS, P0_ITEM); }
#undef P0_ITEM
}

__device__ __forceinline__ const float* hin_row(const Args& a, int row) { return row < NCTX ? a.in[I_CTX] + (size_t)row * D : a.in[I_X] + (size_t)(row - NCTX) * D; }
__device__ __forceinline__ int mod_row(int row) { return row < NCTX ? 8 : ((row - NCTX) >> 12); }
__device__ __forceinline__ float row_rstd(const f32x4 (&v)[4]) {
    float s = 0.f;
#pragma unroll
    for (int j = 0; j < 4; ++j) s += (v[j][0] * v[j][0] + v[j][1] * v[j][1]) + (v[j][2] * v[j][2] + v[j][3] * v[j][3]);
    return 1.0f / sqrtf(wave_sum(s) * (1.0f / D) + EPS);
}
struct ModVec { f32x4 g[4], sc[4], sh[4]; };
__device__ __forceinline__ void modvec_load(ModVec& m, const float* g, const float* sc, const float* sh, int lane) {
#pragma unroll
    for (int j = 0; j < 4; ++j) { const int c = 4 * lane + 256 * j; m.g[j] = *(const f32x4*)(g + c); m.sc[j] = *(const f32x4*)(sc + c); m.sh[j] = *(const f32x4*)(sh + c); }
}
__device__ __forceinline__ void norm_mod_store(const f32x4 (&v)[4], float rstd, const ModVec& m, bf16_t* orow, int lane) {
#pragma unroll
    for (int j = 0; j < 4; ++j) st_bf16x4(orow + 4 * lane + 256 * j, v[j] * rstd * m.g[j] * (m.sc[j] + 1.0f) + m.sh[j]);
}

__device__ __forceinline__ void p1_phase(const Args& a, int lane, int gw, int NGW) {
    const float* modv = (const float*)(a.ws + WS_MODV);
    bf16_t* A = (bf16_t*)(a.ws + WS_A);
    for (int row0 = gw * 4; row0 < NTOK; row0 += NGW * 4) {
        f32x4 v[4][4];
#pragma unroll
        for (int r = 0; r < 4; ++r) { const float* hr = hin_row(a, row0 + r);
#pragma unroll
            for (int j = 0; j < 4; ++j) v[r][j] = *(const f32x4*)(hr + 4 * lane + 256 * j); }
        const float* mv = modv + (size_t)mod_row(row0) * 6144;
        ModVec m; modvec_load(m, a.in[I_N1G], mv + 1024, mv, lane);
#pragma unroll
        for (int r = 0; r < 4; ++r) { const float rstd = row_rstd(v[r]); norm_mod_store(v[r], rstd, m, A + (size_t)(row0 + r) * D, lane); }
    }
}

__device__ __forceinline__ int gla_row(int n, int t, int b, int dir) {
    const bool isctx = n < 4; const int cn = isctx ? n : n - 4, slen = isctx ? CTXL : SEQ, rbase = isctx ? b * CTXL : NCTX + b * SEQ;
    const int pos = cn * 64 + t; return rbase + (dir ? slen - 1 - pos : pos);
}
__device__ __forceinline__ void gla_phase(const Args& a, LAS unsigned char* lds, int tid) {
    const int lane = tid & 63, wave = tid >> 6, fr = lane & 15, fq = lane >> 4;
    LAS unsigned char* QS = lds;
    LAS unsigned char* KS = lds + 17408;
    LAS unsigned char* QIN = lds + 34816;
    LAS unsigned char* KOT = lds + 52224;
    LAS unsigned char* VT = lds + 70656;
    LAS unsigned char* ST0 = lds + 79872;
    LAS unsigned char* PPW = lds + 114688 + wave * 2304;
    LAS float* GT0 = (LAS float*)(lds + 133120);
    LAS float* BL = (LAS float*)(lds + 141312);
    const bf16_t* Qg = (const bf16_t*)(a.ws + WS_Q); const bf16_t* Vg = (const bf16_t*)(a.ws + WS_V);
    for (int item = blockIdx.x; item < 256; item += gridDim.x) {
        const int vs = item & 1, dir = (item >> 1) & 1, h = (item >> 2) & 7, b = item >> 5;
        const _Float16* LF = (const _Float16*)(a.ws + (dir ? WS_LFB : WS_LFF)); bf16_t* Og = (bf16_t*)(a.ws + (dir ? WS_OB : WS_OF));
        f32x4 Sacc[4];
#pragma unroll
        for (int i = 0; i < 4; ++i) Sacc[i] = (f32x4){0.f, 0.f, 0.f, 0.f};
        for (int i = tid; i < 2 * 17408 / 4; i += NTHREADS) ((LAS unsigned*)ST0)[i] = 0u;
        const int kc2 = (tid & 63) * 2, tg = tid >> 6, chq = h * 128 + kc2;
        const int vt_t = tid & 63, vt_v8 = (tid >> 6) * 8;
        unsigned lf2[8], q2[8]; u32x4 vv;
#define GLA_LOAD(n_) do { _Pragma("unroll") for (int i = 0; i < 8; ++i) { const size_t o = (size_t)gla_row(n_, tg * 8 + i, b, dir) * D + chq; lf2[i] = *(const unsigned*)(LF + o); q2[i] = *(const unsigned*)(Qg + o); } \
            vv = *(const u32x4*)(Vg + (size_t)gla_row(n_, vt_t, b, dir) * D + h * 128 + vs * 64 + vt_v8); } while (0)
        float fa[8], fb[8], bca[8], bcb[8];
#define GLA_CUMSUM(par_) do { float csa = 0.f, csb = 0.f; _Pragma("unroll") for (int i = 0; i < 8; ++i) { typedef _Float16 h2 __attribute__((ext_vector_type(2))); const h2 hv = __builtin_bit_cast(h2, lf2[i]); \
            const float la = (float)hv[0], lb_ = (float)hv[1]; fa[i] = __expf(la); fb[i] = __expf(lb_); csa += la; csb += lb_; bca[i] = csa; bcb[i] = csb; } \
            *(LAS f32x2*)(GT0 + (par_) * 1024 + tg * 128 + kc2) = (f32x2){csa, csb}; } while (0)
        GLA_LOAD(0);
        GLA_CUMSUM(0);
        __syncthreads();
        for (int n = 0; n < 68; ++n) {
            const int par = n & 1;
            LAS unsigned char* STc = ST0 + par * 17408; LAS unsigned char* STn = ST0 + (par ^ 1) * 17408;
            { const unsigned w[4] = {vv.x, vv.y, vv.z, vv.w};
#pragma unroll
              for (int i = 0; i < 4; ++i) { *(LAS bf16_t*)(VT + (vt_v8 + 2 * i) * 144 + vt_t * 2) = (bf16_t)(w[i] & 0xffffu); *(LAS bf16_t*)(VT + (vt_v8 + 2 * i + 1) * 144 + vt_t * 2) = (bf16_t)(w[i] >> 16); } }
#define GLA_OSTORE(n_) do { const u32x4 od = *(const LAS u32x4*)(PPW + (lane >> 2) * 144 + (lane & 3) * 16); \
                *(u32x4*)(Og + (size_t)gla_row(n_, (wave >> 1) * 16 + (lane >> 2), b, dir) * D + h * 128 + vs * 64 + (wave & 1) * 32 + (lane & 3) * 8) = od; } while (0)
            if (n > 0) GLA_OSTORE(n - 1);
            f32x2 pre = (f32x2){0.f, 0.f}, bref = (f32x2){0.f, 0.f}, blast = (f32x2){0.f, 0.f};
#pragma unroll
            for (int g8 = 0; g8 < 8; ++g8) { const f32x2 gv = *(const LAS f32x2*)(GT0 + par * 1024 + g8 * 128 + kc2); if (g8 < tg) pre += gv; if (g8 < 4) bref += gv; blast += gv; }
            const float era = __expf(bref.x), erb = __expf(bref.y), ela = __expf(blast.x - bref.x), elb = __expf(blast.y - bref.y);
            float e1a = __expf(pre.x - bref.x), e1b = __expf(pre.y - bref.y);
            unsigned kota[4], kotb[4];
#pragma unroll
            for (int i = 0; i < 8; ++i) {
                const int t = tg * 8 + i;
                const float qa = bflo(q2[i]), qb = bfhi(q2[i]);
                e1a *= fa[i]; e1b *= fb[i];
                const float ka = 1.0f - fa[i], kb = 1.0f - fb[i];
                const float e2a = __builtin_amdgcn_rcpf(e1a), e2b = __builtin_amdgcn_rcpf(e1b);
                const float qsa = qa * e1a, qsb = qb * e1b, ksa = ka * e2a, ksb = kb * e2b;
                *(LAS unsigned*)(QS + t * 272 + kc2 * 2) = cvt_pk_bf16(qsa, qsb);
                *(LAS unsigned*)(KS + t * 272 + kc2 * 2) = cvt_pk_bf16(ksa, ksb);
                *(LAS unsigned*)(QIN + t * 272 + kc2 * 2) = cvt_pk_bf16(qsa * era, qsb * erb);
                const unsigned ko = cvt_pk_bf16(ksa * ela, ksb * elb);
                if (i & 1) { kota[i >> 1] |= ko << 16; kotb[i >> 1] |= ko & 0xffff0000u; } else { kota[i >> 1] = ko & 0xffffu; kotb[i >> 1] = ko >> 16; }
            }
            { const int rot = ((kc2 >> 4) + tg) & 7;
              *(LAS u32x4*)(KOT + kc2 * 144 + rot * 16) = (u32x4){kota[0], kota[1], kota[2], kota[3]};
              *(LAS u32x4*)(KOT + (kc2 + 1) * 144 + rot * 16) = (u32x4){kotb[0], kotb[1], kotb[2], kotb[3]}; }
            if (tg == 0) *(LAS f32x2*)(BL + kc2) = (f32x2){__expf(blast.x), __expf(blast.y)};
            if (n + 1 < 68) GLA_LOAD(n + 1);
            __syncthreads();
            const int tt = wave >> 1;
            bf16x8 aq[4];
#pragma unroll
            for (int kk = 0; kk < 4; ++kk) aq[kk] = *(const LAS bf16x8*)(QS + (tt * 16 + fr) * 272 + (kk * 32 + fq * 8) * 2);
#pragma unroll
            for (int st = 0; st < 4; ++st) {
                f32x4 acc = (f32x4){0.f, 0.f, 0.f, 0.f};
                if (st <= tt) {
#pragma unroll
                    for (int kk = 0; kk < 4; ++kk) {
                        const bf16x8 bv = *(const LAS bf16x8*)(KS + (st * 16 + fr) * 272 + (kk * 32 + fq * 8) * 2);
                        acc = __builtin_amdgcn_mfma_f32_16x16x32_bf16(aq[kk], bv, acc, 0, 0, 0);
                    }
                }
#pragma unroll
                for (int j = 0; j < 4; ++j) { const int tl = fq * 4 + j, s = st * 16 + fr; *(LAS bf16_t*)(PPW + tl * 144 + s * 2) = (bf16_t)f2bf(s <= tt * 16 + tl ? acc[j] : 0.f); }
            }
            LDS_WAIT();
            unsigned ow[2][2];
            bf16x8 ap[2], ai[4];
#pragma unroll
            for (int kk = 0; kk < 2; ++kk) ap[kk] = *(const LAS bf16x8*)(PPW + fr * 144 + (kk * 32 + fq * 8) * 2);
#pragma unroll
            for (int kk = 0; kk < 4; ++kk) ai[kk] = *(const LAS bf16x8*)(QIN + (tt * 16 + fr) * 272 + (kk * 32 + fq * 8) * 2);
#pragma unroll
            for (int vti = 0; vti < 2; ++vti) {
                const int vt = 2 * (wave & 1) + vti; f32x4 acc = (f32x4){0.f, 0.f, 0.f, 0.f};
#pragma unroll
                for (int kk = 0; kk < 2; ++kk) {
                    const bf16x8 bv = *(const LAS bf16x8*)(VT + (vt * 16 + fr) * 144 + (kk * 32 + fq * 8) * 2);
                    acc = __builtin_amdgcn_mfma_f32_16x16x32_bf16(ap[kk], bv, acc, 0, 0, 0);
                }
#pragma unroll
                for (int kk = 0; kk < 4; ++kk) {
                    const bf16x8 bv = *(const LAS bf16x8*)(STc + (vt * 16 + fr) * 272 + (kk * 32 + fq * 8) * 2);
                    acc = __builtin_amdgcn_mfma_f32_16x16x32_bf16(ai[kk], bv, acc, 0, 0, 0);
                }
                ow[vti][0] = cvt_pk_bf16(acc[0], acc[1]); ow[vti][1] = cvt_pk_bf16(acc[2], acc[3]);
            }
#pragma unroll
            for (int vti = 0; vti < 2; ++vti)
#pragma unroll
                for (int j = 0; j < 4; ++j) { const unsigned w = ow[vti][j >> 1]; *(LAS bf16_t*)(PPW + (fq * 4 + j) * 144 + (vti * 16 + fr) * 2) = (bf16_t)((j & 1) ? (w >> 16) : (w & 0xffffu)); }
            bf16x8 ak[2]; const f32x4 blv = *(const LAS f32x4*)(BL + wave * 16 + fq * 4);
#pragma unroll
            for (int kk = 0; kk < 2; ++kk) ak[kk] = *(const LAS bf16x8*)(KOT + (wave * 16 + fr) * 144 + (((kk * 4 + fq) + wave) & 7) * 16);
#pragma unroll
            for (int vt = 0; vt < 4; ++vt) {
                Sacc[vt] *= blv;
#pragma unroll
                for (int kk = 0; kk < 2; ++kk) {
                    const bf16x8 bv = *(const LAS bf16x8*)(VT + (vt * 16 + fr) * 144 + (kk * 32 + fq * 8) * 2);
                    Sacc[vt] = __builtin_amdgcn_mfma_f32_16x16x32_bf16(ak[kk], bv, Sacc[vt], 0, 0, 0);
                }
                *(LAS u32x2*)(STn + (vt * 16 + fr) * 272 + (wave * 16 + fq * 4) * 2) = (u32x2){pk2(Sacc[vt][0], Sacc[vt][1]), pk2(Sacc[vt][2], Sacc[vt][3])};
            }
            if (n + 1 < 68) GLA_CUMSUM(par ^ 1);
            __syncthreads();
        }
        GLA_OSTORE(67);
    }
}
#undef GLA_OSTORE
#undef GLA_CUMSUM
#undef GLA_LOAD
__device__ __forceinline__ void gla_readout_phase(const Args& a, int lane, int gw, int NGW) {
    const bf16_t* OF = (const bf16_t*)(a.ws + WS_OF); const bf16_t* OB = (const bf16_t*)(a.ws + WS_OB);
    const bf16_t* G = (const bf16_t*)(a.ws + WS_G); bf16_t* OG = (bf16_t*)(a.ws + WS_OG);
    f32x4 ng[4];
#pragma unroll
    for (int j = 0; j < 4; ++j) ng[j] = *(const f32x4*)(a.in[I_HGNG] + 16 * lane + 4 * j);
    for (int row0 = gw * 4; row0 < NTOK; row0 += NGW * 4) {
        u32x4 of[4][2], ob[4][2], gg[4][2];
#pragma unroll
        for (int r = 0; r < 4; ++r) { const size_t o = (size_t)(row0 + r) * D + 16 * lane;
            of[r][0] = *(const u32x4*)(OF + o); of[r][1] = *(const u32x4*)(OF + o + 8); ob[r][0] = *(const u32x4*)(OB + o); ob[r][1] = *(const u32x4*)(OB + o + 8);
            gg[r][0] = *(const u32x4*)(G + o); gg[r][1] = *(const u32x4*)(G + o + 8); }
#pragma unroll
        for (int r = 0; r < 4; ++r) {
            float v[16]; float s = 0.f;
#pragma unroll
            for (int q = 0; q < 8; ++q) { const unsigned wf = of[r][q >> 2][q & 3], wb = ob[r][q >> 2][q & 3]; v[2 * q] = bflo(wf) + bflo(wb); v[2 * q + 1] = bfhi(wf) + bfhi(wb); s += v[2 * q] * v[2 * q] + v[2 * q + 1] * v[2 * q + 1]; }
            s += __shfl_xor(s, 1); s += __shfl_xor(s, 2); s += __shfl_xor(s, 4);
            const float rstd = 1.0f / sqrtf(s * (1.0f / 128.0f) + EPS);
            unsigned ow[8];
#pragma unroll
            for (int q = 0; q < 8; ++q) { const unsigned wg = gg[r][q >> 2][q & 3];
                ow[q] = pk2(v[2 * q] * rstd * ng[q >> 1][(2 * q) & 3] * silu_f(bflo(wg)), v[2 * q + 1] * rstd * ng[q >> 1][(2 * q + 1) & 3] * silu_f(bfhi(wg))); }
            const size_t o = (size_t)(row0 + r) * D + 16 * lane;
            *(u32x4*)(OG + o) = (u32x4){ow[0], ow[1], ow[2], ow[3]}; *(u32x4*)(OG + o + 8) = (u32x4){ow[4], ow[5], ow[6], ow[7]};
        }
    }
}

struct EpiMoe1 {
    static constexpr bool PERM = true;
    const float* b1; bf16_t* ACT;
    __device__ __forceinline__ void operator()(const f32x4 (&acc)[2][2][4][2], const Unit& u, int wr, int wc, int fr, int fq) const {
        const int e = u.pn >> 3, pnl = u.pn & 7, cb = pnl * 128 + wc * 32 + 8 * fq, row0 = u.pm * 256 + wr * 64 + fr;
        const float* bg = b1 + (size_t)e * 2048;
        const f32x4 bg0 = *(const f32x4*)(bg + cb), bg1 = *(const f32x4*)(bg + cb + 4), bl0 = *(const f32x4*)(bg + 1024 + cb), bl1 = *(const f32x4*)(bg + 1024 + cb + 4);
#pragma unroll
        for (int ai = 0; ai < 2; ++ai)
#pragma unroll
            for (int m = 0; m < 4; ++m) {
                f32x4 o[2];
#pragma unroll
                for (int n = 0; n < 2; ++n) {
                    const f32x4 zg = acc[ai][0][m][n] + (n ? bg1 : bg0), zl = acc[ai][1][m][n] + (n ? bl1 : bl0);
#pragma unroll
                    for (int j = 0; j < 4; ++j) { const float g_ = fminf(zg[j], 7.0f), l_ = fminf(fmaxf(zl[j], -7.0f), 7.0f); o[n][j] = g_ * sigmoid_f(1.702f * g_) * (l_ + 1.0f); }
                }
                *(u32x4*)(ACT + (size_t)(row0 + ai * 128 + m * 16) * D + cb) = (u32x4){pk2(o[0][0], o[0][1]), pk2(o[0][2], o[0][3]), pk2(o[1][0], o[1][1]), pk2(o[1][2], o[1][3])};
            }
    }
};
struct EpiMoe2 {
    static constexpr bool PERM = true;
    const float* b2; bf16_t* YS;
    __device__ __forceinline__ void operator()(const f32x4 (&acc)[2][2][4][2], const Unit& u, int wr, int wc, int fr, int fq) const {
        const int e = u.pn >> 2, pnl = u.pn & 3, cb = pnl * 256 + wc * 32 + 8 * fq, row0 = u.pm * 256 + wr * 64 + fr;
        const float* bb = b2 + (size_t)e * 1024;
#pragma unroll
        for (int bj = 0; bj < 2; ++bj) {
            const int c = cb + bj * 128; const f32x4 bv0 = *(const f32x4*)(bb + c), bv1 = *(const f32x4*)(bb + c + 4);
#pragma unroll
            for (int ai = 0; ai < 2; ++ai)
#pragma unroll
                for (int m = 0; m < 4; ++m) {
                    const f32x4 v0 = acc[ai][bj][m][0] + bv0, v1 = acc[ai][bj][m][1] + bv1;
                    *(u32x4*)(YS + (size_t)(row0 + ai * 128 + m * 16) * D + c) = (u32x4){pk2(v0[0], v0[1]), pk2(v0[2], v0[3]), pk2(v1[0], v1[1]), pk2(v1[2], v1[3])};
                }
        }
    }
};

__device__ __forceinline__ void router_phase(const Args& a, LAS unsigned char* lds, int layer, int row_lo, int tid) {
    const int lane = tid & 63, wave = tid >> 6, fr = lane & 15, fq = lane >> 4;
    const bf16_t* H = (const bf16_t*)(a.ws + WS_H); bf16_t* F = (bf16_t*)(a.ws + WS_F);
    const float* modv = (const float*)(a.ws + WS_MODV) + (size_t)layer * 9 * 6144;
    int* TOKE = (int*)(a.ws + WS_TOKE); float* TOKW = (float*)(a.ws + WS_TOKW);
    unsigned* cntb = (unsigned*)(a.ws + WS_CTL) + CW_CNTB + layer * 8192;
    LAS float* FS = (LAS float*)lds;
    LAS float* PART = (LAS float*)(lds + 16 * 1028 * 4);
    LAS int* hist = (LAS int*)(lds + 16 * 1028 * 4 + 16384);
    if (tid < 32) hist[tid] = 0;
    const float* n2g = a.in[I_N2G] + layer * D; const float* rw = a.in[I_RW] + (size_t)layer * D * NE; const float* rb = a.in[I_RB] + layer * NE;
    float rwr[2][32];
#pragma unroll
    for (int s = 0; s < 32; ++s) { rwr[0][s] = rw[(size_t)(wave * 128 + 4 * s + fq) * NE + fr]; rwr[1][s] = rw[(size_t)(wave * 128 + 4 * s + fq) * NE + 16 + fr]; }
    const int ngroups = (NTOK - row_lo) >> 4;
    f32x4 vv[2][4], gvv[4], scvv[4], shvv[4];
#pragma unroll
    for (int j = 0; j < 4; ++j) gvv[j] = *(const f32x4*)(n2g + 4 * lane + 256 * j);
#define RT_LOAD(gi_) do { _Pragma("unroll") for (int rr = 0; rr < 2; ++rr) _Pragma("unroll") for (int j = 0; j < 4; ++j) \
        vv[rr][j] = ld_bf16x4(H + (size_t)(row_lo + (gi_) * 16 + 2 * wave + rr) * D + 4 * lane + 256 * j); \
        { const float* mvp_ = modv + (size_t)mod_row(row_lo + (gi_) * 16) * 6144; _Pragma("unroll") for (int j = 0; j < 4; ++j) { scvv[j] = *(const f32x4*)(mvp_ + 4096 + 4 * lane + 256 * j); shvv[j] = *(const f32x4*)(mvp_ + 3072 + 4 * lane + 256 * j); } } } while (0)
    if ((int)blockIdx.x < ngroups) RT_LOAD(blockIdx.x);
    int pend_i = 0; float pend_w = 0.f; long pend_o = -1;
    for (int gi = blockIdx.x; gi < ngroups; gi += gridDim.x) {
        const int row0 = row_lo + gi * 16;
        __syncthreads();
#pragma unroll
        for (int rr = 0; rr < 2; ++rr) {
            const int rl = 2 * wave + rr, row = row0 + rl; const f32x4 (&v)[4] = vv[rr];
            const float rstd = row_rstd(v);
#pragma unroll
            for (int j = 0; j < 4; ++j) {
                const int c = 4 * lane + 256 * j;
                const f32x4 f = v[j] * rstd * gvv[j] * (scvv[j] + 1.0f) + shvv[j];
                st_bf16x4(F + (size_t)row * D + c, f);
                *(LAS f32x4*)(FS + rl * 1028 + c) = f;
            }
        }
        if (pend_o >= 0) { TOKE[pend_o] = pend_i; TOKW[pend_o] = pend_w; pend_o = -1; }
        if (gi + (int)gridDim.x < ngroups) RT_LOAD(gi + gridDim.x);
        __syncthreads();
        f32x4 acc0 = (f32x4){0.f, 0.f, 0.f, 0.f}, acc1 = (f32x4){0.f, 0.f, 0.f, 0.f};
#pragma unroll
        for (int s = 0; s < 32; ++s) {
            const float av = FS[fr * 1028 + wave * 128 + 4 * s + fq];
            acc0 = __builtin_amdgcn_mfma_f32_16x16x4f32(av, rwr[0][s], acc0, 0, 0, 0);
            acc1 = __builtin_amdgcn_mfma_f32_16x16x4f32(av, rwr[1][s], acc1, 0, 0, 0);
        }
#pragma unroll
        for (int j = 0; j < 4; ++j) { PART[(wave * 16 + fq * 4 + j) * 32 + fr] = acc0[j]; PART[(wave * 16 + fq * 4 + j) * 32 + 16 + fr] = acc1[j]; }
        __syncthreads();
        {
            const int half = lane >> 5, e = lane & 31, rl = 2 * wave + half, row = row0 + rl;
            float lg = rb[e];
#pragma unroll
            for (int w = 0; w < 8; ++w) lg += PART[(w * 16 + rl) * 32 + e];
            float sv[4]; int si[4];
#pragma unroll
            for (int r = 0; r < 4; ++r) {
                float m = lg;
#pragma unroll
                for (int o = 1; o < 32; o <<= 1) m = fmaxf(m, __shfl_xor(m, o));
                const unsigned long long bal = __ballot(lg == m); const unsigned mine = (unsigned)(bal >> (32 * half));
                const int idx = __ffs((int)mine) - 1;
                sv[r] = m; si[r] = idx; if (e == idx) lg = -3.0e38f;
            }
            const float e1 = __expf(sv[1] - sv[0]), e2 = __expf(sv[2] - sv[0]), e3 = __expf(sv[3] - sv[0]); const float inv = 1.0f / (1.0f + e1 + e2 + e3);
            if (e < 4) {
                const int myi = e == 0 ? si[0] : (e == 1 ? si[1] : (e == 2 ? si[2] : si[3]));
                const float myw = (e == 0 ? 1.0f : (e == 1 ? e1 : (e == 2 ? e2 : e3))) * inv;
                pend_i = myi; pend_w = myw; pend_o = (long)row * 4 + e;
                atomicAdd((int*)hist + myi, 1);
            }
        }
    }
    if (pend_o >= 0) { TOKE[pend_o] = pend_i; TOKW[pend_o] = pend_w; }
    __syncthreads();
    if (tid < 32) cntb[(size_t)blockIdx.x * 32 + tid] = (unsigned)hist[tid];
}
#undef RT_LOAD
__device__ __forceinline__ void assign_phase(const Args& a, LAS unsigned char* lds, int layer, int row_lo, int tid) {
    const int lane = tid & 63, wave = tid >> 6;
    const unsigned* cntb = (const unsigned*)(a.ws + WS_CTL) + CW_CNTB + layer * 8192; unsigned* gcnt = (unsigned*)(a.ws + WS_CTL) + CW_CNT + layer * 64;
    const bf16_t* F = (const bf16_t*)(a.ws + WS_F); bf16_t* AG = (bf16_t*)(a.ws + WS_AG);
    const int* TOKE = (const int*)(a.ws + WS_TOKE); int* TOKS = (int*)(a.ws + WS_TOKS);
    LAS int* off = (LAS int*)lds; LAS int* cnt = (LAS int*)(lds + 256); LAS int* base = (LAS int*)(lds + 512); LAS int* cur = (LAS int*)(lds + 768);
    LAS int* pa = (LAS int*)(lds + 1024); LAS int* pl = (LAS int*)(lds + 1024 + 2048);
    {
        const int e = tid & 31, part = tid >> 5; int s_all = 0, s_lt = 0;
        for (int bb = part; bb < (int)gridDim.x; bb += 16) { const int c = (int)cntb[(size_t)bb * 32 + e]; s_all += c; if (bb < (int)blockIdx.x) s_lt += c; }
        pa[part * 32 + e] = s_all; pl[part * 32 + e] = s_lt;
    }
    __syncthreads();
    if (tid < 32) { int s_all = 0, s_lt = 0; for (int p = 0; p < 16; ++p) { s_all += pa[p * 32 + tid]; s_lt += pl[p * 32 + tid]; } cnt[tid] = s_all; base[tid] = s_lt; cur[tid] = 0; if (blockIdx.x == 0) gcnt[tid] = (unsigned)s_all; }
    __syncthreads();
    if (tid == 0) { int o = 0; for (int e = 0; e < 32; ++e) { off[e] = o; o += ((cnt[e] + 255) >> 8) << 8; } }
    __syncthreads();
    if (tid < 32) base[tid] += off[tid];
    __syncthreads();
    const int gw = blockIdx.x * 8 + wave, NGW = gridDim.x * 8;
    int* SLOTTOK = (int*)(a.ws + WS_SLOTTOK);
    for (int idx = blockIdx.x * NTHREADS + tid; idx < 32 * 256; idx += gridDim.x * NTHREADS) {
        const int e = idx >> 8, c = cnt[e], r = c + (idx & 255), padded = ((c + 255) >> 8) << 8;
        if (r < padded) SLOTTOK[off[e] + r] = 0;
    }
    const int ngroups = (NTOK - row_lo) >> 4;
    for (int gi = blockIdx.x; gi < ngroups; gi += gridDim.x) {
        const int r0 = row_lo + gi * 16 + 2 * wave;
        if (lane < 8) { const int e = TOKE[(size_t)r0 * 4 + lane]; const int pos = atomicAdd((int*)cur + e, 1); const int slot = base[e] + pos; TOKS[(size_t)r0 * 4 + lane] = slot; SLOTTOK[slot] = r0 + (lane >> 2); }
    }
    (void)gw; (void)NGW; (void)F; (void)AG;
}
__device__ __forceinline__ int moe_tiles(const Args& a, LAS unsigned char* lds, int layer, int tid) {
    const unsigned* gcnt = (const unsigned*)(a.ws + WS_CTL) + CW_CNT + layer * 64;
    LAS int* tbl = (LAS int*)(lds + 131072 + 1024);
    if (tid == 0) { int t = 0; for (int e = 0; e < 32; ++e) { const int nt = ((int)gcnt[e] + 255) >> 8; for (int k = 0; k < nt; ++k) tbl[t++] = e; } tbl[1000] = t; }
    __syncthreads();
    return tbl[1000];
}
__device__ __forceinline__ void combine_phase(const Args& a, int layer, int row_lo, int lane, int gw, int NGW) {
    bf16_t* H = (bf16_t*)(a.ws + WS_H); const bf16_t* YS = (const bf16_t*)(a.ws + WS_YS);
    const int* TOKS = (const int*)(a.ws + WS_TOKS); const float* TOKW = (const float*)(a.ws + WS_TOKW);
    const float* modv = (const float*)(a.ws + WS_MODV);
    for (int row0 = row_lo + gw * 2; row0 < NTOK; row0 += NGW * 2) {
        const int mr = mod_row(row0);
        u32x4 sl[2]; f32x4 wv[2];
#pragma unroll
        for (int r = 0; r < 2; ++r) { sl[r] = *(const u32x4*)(TOKS + (size_t)(row0 + r) * 4); wv[r] = *(const f32x4*)(TOKW + (size_t)(row0 + r) * 4); }
        u32x2 ys[2][4][4]; f32x4 hv[2][4];
#pragma unroll
        for (int r = 0; r < 2; ++r)
#pragma unroll
            for (int j = 0; j < 4; ++j) {
                hv[r][j] = ld_bf16x4(H + (size_t)(row0 + r) * D + 4 * lane + 256 * j);
#pragma unroll
                for (int k = 0; k < 4; ++k) ys[r][k][j] = *(const u32x2*)(YS + (size_t)sl[r][k] * D + 4 * lane + 256 * j);
            }
        const float* g2 = modv + (size_t)(layer * 9 + mr) * 6144 + 5120;
        f32x4 g2v[4];
#pragma unroll
        for (int j = 0; j < 4; ++j) g2v[j] = *(const f32x4*)(g2 + 4 * lane + 256 * j);
        ModVec m;
        if (layer == 0) { const float* mv = modv + (size_t)(9 + mr) * 6144; modvec_load(m, a.in[I_N1G] + D, mv + 1024, mv, lane); }
        else {
#pragma unroll
            for (int j = 0; j < 4; ++j) m.g[j] = *(const f32x4*)(a.in[I_FG] + 4 * lane + 256 * j);
        }
#pragma unroll
        for (int r = 0; r < 2; ++r) {
            const int row = row0 + r; f32x4 v[4];
#pragma unroll
            for (int j = 0; j < 4; ++j) {
                const int c = 4 * lane + 256 * j; f32x4 y = (f32x4){0.f, 0.f, 0.f, 0.f};
#pragma unroll
                for (int k = 0; k < 4; ++k) { const u32x2 w = ys[r][k][j]; y += (f32x4){bflo(w.x), bfhi(w.x), bflo(w.y), bfhi(w.y)} * wv[r][k]; }
                v[j] = hv[r][j] + g2v[j] * y;
                if (layer == 0) st_bf16x4(H + (size_t)row * D + c, v[j]);
            }
            const float rstd = row_rstd(v);
            if (layer == 0) {
                int orow = row;
                if (row >= NCTX) { const int li = row - NCTX, b = li >> 12, t = li & 4095; orow = NCTX + b * SEQ + (t & 63) * 64 + (t >> 6); }
                norm_mod_store(v, rstd, m, (bf16_t*)(a.ws + WS_A) + (size_t)orow * D, lane);
            } else {
#pragma unroll
                for (int j = 0; j < 4; ++j) { const int c = 4 * lane + 256 * j; *(f32x4*)(a.out + (size_t)(row - NCTX) * D + c) = v[j] * rstd * m.g[j]; }
            }
        }
    }
}
__device__ __forceinline__ void moe_gemm1(const Args& a, LAS unsigned char* lds, int layer, int tid, int G, int vcu) {
    unsigned char* ws = a.ws;
    const int TT = moe_tiles(a, lds, layer, tid);
    const LAS int* tbl = (const LAS int*)(lds + 131072 + 1024);
    pg8::Gemm g{(const bf16_t*)(ws + WS_F), (const bf16_t*)(ws + WS_W1) + (size_t)layer * 32 * 2048 * 1024, MPAD, 32 * 2048, 1024};
    pg8::MoeOrder S{tbl, TT, 3, G, vcu};
    EpiMoe1 E{a.in[I_B1] + (size_t)layer * 32 * 2048, (bf16_t*)(ws + WS_ACT)};
    LAS unsigned short* rowl = (LAS unsigned short*)(lds + 136192);
    { const int* slottok = (const int*)(ws + WS_SLOTTOK); pg8::Unit uu; int t2 = threadIdx.x; asm volatile("" : "+v"(t2)); const int tid = t2;
      for (int i = 0; i < 21; i += 2) { const int ii = i + (tid >> 8); if (ii < 21 && S.next(ii, uu)) rowl[ii * 256 + (tid & 255)] = (unsigned short)slottok[uu.pm * 256 + (tid & 255)]; } }
    __syncthreads();
    pg8::gemm_phase<EpiMoe1, pg8::MoeOrder, true>(lds, g, S, E, rowl);
}
__device__ __forceinline__ void moe_gemm2(const Args& a, LAS unsigned char* lds, int layer, int tid, int G, int vcu) {
    unsigned char* ws = a.ws;
    const int TT = moe_tiles(a, lds, layer, tid);
    const LAS int* tbl = (const LAS int*)(lds + 131072 + 1024);
    pg8::Gemm g{(const bf16_t*)(ws + WS_ACT), (const bf16_t*)(ws + WS_W2) + (size_t)layer * 32 * 1024 * 1024, MPAD, 32 * 1024, 1024};
    pg8::MoeOrder S{tbl, TT, 2, G, vcu};
    EpiMoe2 E{a.in[I_B2] + (size_t)layer * 32 * 1024, (bf16_t*)(ws + WS_YS)};
    pg8::gemm_phase<EpiMoe2, pg8::MoeOrder>(lds, g, S, E);
}


__device__ __forceinline__ void s5_disc(const Args& a, int d, int g, int p, float& ab_re, float& ab_im, float& co_re, float& co_im) {
    const float lam_re = fminf(a.in[I_S5ARE][(d * 64 + g) * 64 + p], -1e-4f), lam_im = a.in[I_S5AIM][(d * 64 + g) * 64 + p];
    const float dt = expf(a.in[I_S5LDT][d * 64 + g]);
    const float mag = expf(lam_re * dt), ang = lam_im * dt;
    ab_re = mag * cosf(ang); ab_im = mag * sinf(ang);
    const float den = lam_re * lam_re + lam_im * lam_im;
    co_re = ((ab_re - 1.0f) * lam_re + ab_im * lam_im) / den;
    co_im = (ab_im * lam_re - (ab_re - 1.0f) * lam_im) / den;
}
__device__ __forceinline__ void s5_phase(const Args& a, LAS unsigned char* lds, int tid) {
    const int lane = tid & 63, wave = tid >> 6, fr = lane & 15, fq = lane >> 4;
    if (wave >= 4) {
        LAS unsigned* scr = (LAS unsigned*)(lds + 102400 + (wave - 4) * 8320);
        const int cw = blockIdx.x * 4 + (wave - 4), NCW = gridDim.x * 4;
#define L1_ITEM(i) moe_item(a, (i), 1)
        TR_LOOP(cw, NCW, 32 * 512 + 32 * 256, L1_ITEM);
#undef L1_ITEM
        return;
    }
    LAS unsigned char* wl = lds + wave * 25600;
    const bf16_t* A1 = (const bf16_t*)(a.ws + WS_A);
    for (int item = blockIdx.x; item < 256; item += gridDim.x) {
        const int b = item >> 5, dir = (item >> 4) & 1, g = (item & 15) * 4 + wave;
        bf16_t* Y = (bf16_t*)(a.ws + (dir ? WS_YB : WS_YF));
        float ab_re, ab_im, cr_, ci_;
        s5_disc(a, dir, g, lane, ab_re, ab_im, cr_, ci_);
        bf16x8 Bd[8], Cf[4];
        {
            f32x4 cre[4], cim[4];
#pragma unroll
            for (int kk = 0; kk < 4; ++kk) { const size_t o = ((size_t)(dir * 64 + g) * 16 + fr) * 64 + kk * 16 + fq * 4; cre[kk] = *(const f32x4*)(a.in[I_S5CRE] + o); cim[kk] = *(const f32x4*)(a.in[I_S5CIM] + o); }
#pragma unroll
            for (int kk = 0; kk < 4; ++kk)
#pragma unroll
                for (int j = 0; j < 8; ++j) Cf[kk][j] = (short)f2bf((j & 1) ? -cim[kk][j >> 1] : cre[kk][j >> 1]);
#pragma unroll
            for (int hg = 0; hg < 2; ++hg) {
                f32x4 br0[4], br1[4], bi0[4], bi1[4];
#pragma unroll
                for (int q = 0; q < 4; ++q) {
                    const int pp = (hg * 4 + q) * 8 + (fr >> 1); const size_t o = (size_t)(g * 64 + pp) * 16 + (fq & 1) * 8;
                    br0[q] = *(const f32x4*)(a.in[I_S5BRE] + o); br1[q] = *(const f32x4*)(a.in[I_S5BRE] + o + 4); bi0[q] = *(const f32x4*)(a.in[I_S5BIM] + o); bi1[q] = *(const f32x4*)(a.in[I_S5BIM] + o + 4);
                }
#pragma unroll
                for (int q = 0; q < 4; ++q) {
                    const int pt = hg * 4 + q, pp = pt * 8 + (fr >> 1); const float qr = __shfl(cr_, pp), qi = __shfl(ci_, pp);
#pragma unroll
                    for (int j = 0; j < 8; ++j) {
                        const float br = j < 4 ? br0[q][j & 3] : br1[q][j & 3], bi = j < 4 ? bi0[q][j & 3] : bi1[q][j & 3];
                        float v = (fr & 1) ? (qr * bi + qi * br) : (qr * br - qi * bi);
                        if (fq >= 2) v = 0.f;
                        Bd[pt][j] = (short)f2bf(v);
                    }
                }
                asm volatile("" ::: "memory");
            }
        }
#define S5_POS(n_, t_) ((((n_) < 8) ? (n_) : (n_) - 8) * 32 + (t_))
#define S5_ROW(n_, t_) ((((n_) < 8) ? b * CTXL : NCTX + b * SEQ) + (dir ? (((n_) < 8) ? CTXL : SEQ) - 1 - S5_POS(n_, t_) : S5_POS(n_, t_)))
#define S5_LOADU(d0, d1, n_) do { d0 = (bf16x8){0, 0, 0, 0, 0, 0, 0, 0}; d1 = d0; if (fq < 2 && (n_) < 136) { d0 = *(const bf16x8*)(A1 + (size_t)S5_ROW(n_, fr) * D + g * 16 + fq * 8); d1 = *(const bf16x8*)(A1 + (size_t)S5_ROW(n_, 16 + fr) * D + g * 16 + fq * 8); } } while (0)
        LAS float* BUF = (LAS float*)wl; LAS unsigned* HW = (LAS unsigned*)(wl + 16896); const LAS unsigned char* HP = wl + 16896;
        bf16x8 ua0, ua1, ub0, ub1;
        S5_LOADU(ua0, ua1, 0);
        f32x2 s = (f32x2){0.f, 0.f};
        const f32x2 abr = (f32x2){ab_re, ab_re}, abi = (f32x2){-ab_im, ab_im};
        bf16_t* yp = Y + (size_t)(b * SEQ + (dir ? SEQ - 1 - fq * 4 : fq * 4)) * D + g * 16 + fr;
        const long ystep = dir ? -(long)D : (long)D;
        unsigned yw[4] = {0u, 0u, 0u, 0u};
#define S5_YSTORE() do { yp[0] = (bf16_t)(yw[0] & 0xffffu); yp[ystep] = (bf16_t)(yw[0] >> 16); yp[2 * ystep] = (bf16_t)(yw[1] & 0xffffu); yp[3 * ystep] = (bf16_t)(yw[1] >> 16); \
            yp[16 * ystep] = (bf16_t)(yw[2] & 0xffffu); yp[17 * ystep] = (bf16_t)(yw[2] >> 16); yp[18 * ystep] = (bf16_t)(yw[3] & 0xffffu); yp[19 * ystep] = (bf16_t)(yw[3] >> 16); yp += 32 * ystep; } while (0)
        for (int n = 0; n < 136; ++n) {
#pragma unroll
            for (int hf = 0; hf < 2; ++hf)
#pragma unroll
                for (int pt = 0; pt < 8; ++pt) {
                    const f32x4 z = (f32x4){0.f, 0.f, 0.f, 0.f};
                    const f32x4 d = __builtin_amdgcn_mfma_f32_16x16x32_bf16(hf ? ua1 : ua0, Bd[pt], z, 0, 0, 0);
#pragma unroll
                    for (int j = 0; j < 4; ++j) BUF[(hf * 16 + fq * 4 + j) * 132 + pt * 16 + fr] = d[j];
                }
            if (n >= 9) S5_YSTORE();
            S5_LOADU(ub0, ub1, n + 1);
            LDS_WAIT();
            {
                const bool hist = n >= 8;
                f32x2 bu[32];
#pragma unroll
                for (int j = 0; j < 32; ++j) bu[j] = *(const LAS f32x2*)(BUF + j * 132 + 2 * lane);
                unsigned hw[32];
#pragma unroll
                for (int j = 0; j < 32; ++j) { const f32x2 t1 = abr * s + bu[j]; s = abi * (f32x2){s.y, s.x} + t1; hw[j] = cvt_pk_bf16(s.x, s.y); }
                if (hist) {
#pragma unroll
                    for (int j = 0; j < 32; ++j) HW[j * 68 + lane] = hw[j];
                }
            }
            LDS_WAIT();
            if (n >= 8) {
                f32x4 y0 = (f32x4){0.f, 0.f, 0.f, 0.f}, y1 = (f32x4){0.f, 0.f, 0.f, 0.f};
                bf16x8 ha[2][4];
#pragma unroll
                for (int hf = 0; hf < 2; ++hf)
#pragma unroll
                    for (int kk = 0; kk < 4; ++kk) ha[hf][kk] = *(const LAS bf16x8*)(HP + (hf * 16 + fr) * 272 + (kk * 32 + fq * 8) * 2);
#pragma unroll
                for (int kk = 0; kk < 4; ++kk) { y0 = __builtin_amdgcn_mfma_f32_16x16x32_bf16(ha[0][kk], Cf[kk], y0, 0, 0, 0); y1 = __builtin_amdgcn_mfma_f32_16x16x32_bf16(ha[1][kk], Cf[kk], y1, 0, 0, 0); }
                yw[0] = cvt_pk_bf16(y0[0], y0[1]); yw[1] = cvt_pk_bf16(y0[2], y0[3]); yw[2] = cvt_pk_bf16(y1[0], y1[1]); yw[3] = cvt_pk_bf16(y1[2], y1[3]);
                LDS_WAIT();
            }
            ua0 = ub0; ua1 = ub1;
        }
        S5_YSTORE();
#undef S5_YSTORE
#undef S5_POS
#undef S5_ROW
#undef S5_LOADU
    }
}
__device__ __forceinline__ float gelu_tanh_f(float x) { const float z = 0.7978845608f * (x + 0.044715f * x * x * x); return x * (1.0f - __builtin_amdgcn_rcpf(1.0f + __expf(2.0f * z))); }
__device__ __forceinline__ void s5_post_phase(const Args& a, int lane, int gw, int NGW) {
    const bf16_t* YF = (const bf16_t*)(a.ws + WS_YF); const bf16_t* YB = (const bf16_t*)(a.ws + WS_YB);
    const bf16_t* A1 = (const bf16_t*)(a.ws + WS_A); bf16_t* YG = (bf16_t*)(a.ws + WS_YG);
    f32x4 dk[4];
#pragma unroll
    for (int j = 0; j < 4; ++j) dk[j] = *(const f32x4*)(a.in[I_S5D] + 4 * lane + 256 * j);
    for (int tok0 = gw * 4; tok0 < NLAT; tok0 += NGW * 4) {
        u32x2 yf[4][4], yb[4][4], uu[4][4];
#pragma unroll
        for (int r = 0; r < 4; ++r) { const int tok = tok0 + r, b = tok >> 12, t = tok & 4095, src = b * SEQ + (t & 63) * 64 + (t >> 6);
#pragma unroll
            for (int j = 0; j < 4; ++j) { const int c = 4 * lane + 256 * j; yf[r][j] = *(const u32x2*)(YF + (size_t)src * D + c); yb[r][j] = *(const u32x2*)(YB + (size_t)src * D + c); uu[r][j] = *(const u32x2*)(A1 + (size_t)(NCTX + src) * D + c); } }
#pragma unroll
        for (int r = 0; r < 4; ++r)
#pragma unroll
            for (int j = 0; j < 4; ++j) {
                const u32x2 f = yf[r][j], bk = yb[r][j], uw = uu[r][j];
                const f32x4 y = (f32x4){bflo(f.x) + bflo(bk.x), bfhi(f.x) + bfhi(bk.x), bflo(f.y) + bflo(bk.y), bfhi(f.y) + bfhi(bk.y)} + dk[j] * (f32x4){bflo(uw.x), bfhi(uw.x), bflo(uw.y), bfhi(uw.y)};
                f32x4 o;
#pragma unroll
                for (int i = 0; i < 4; ++i) o[i] = gelu_tanh_f(y[i]);
                st_bf16x4(YG + (size_t)(tok0 + r) * D + 4 * lane + 256 * j, o);
            }
    }
}
struct EpiGlu {
    static constexpr bool PERM = true;
    const float* bglu; const float* modv1; bf16_t* H;
    __device__ __forceinline__ void operator()(const f32x4 (&acc)[2][2][4][2], const Unit& u, int wr, int wc, int fr, int fq) const {
        const int rt0 = u.pm * 256, bidx = rt0 >> 12, cb = u.pn * 128 + wc * 32 + 8 * fq, rl0 = wr * 64 + fr;
        const float* gp = modv1 + bidx * 6144 + 2048;
        const f32x4 ba0 = *(const f32x4*)(bglu + cb), ba1 = *(const f32x4*)(bglu + cb + 4), bb0 = *(const f32x4*)(bglu + 1024 + cb), bb1 = *(const f32x4*)(bglu + 1024 + cb + 4);
        const f32x4 gv0 = *(const f32x4*)(gp + cb), gv1 = *(const f32x4*)(gp + cb + 4);
        u32x4 hws[2][4];
#pragma unroll
        for (int ai = 0; ai < 2; ++ai)
#pragma unroll
            for (int m = 0; m < 4; ++m) hws[ai][m] = *(const u32x4*)(H + (size_t)(NCTX + rt0 + rl0 + ai * 128 + m * 16) * D + cb);
#pragma unroll
        for (int ai = 0; ai < 2; ++ai)
#pragma unroll
            for (int m = 0; m < 4; ++m) {
                bf16_t* hp = H + (size_t)(NCTX + rt0 + rl0 + ai * 128 + m * 16) * D + cb;
                const u32x4 hw = hws[ai][m]; const f32x4 h0 = (f32x4){bflo(hw.x), bfhi(hw.x), bflo(hw.y), bfhi(hw.y)}, h1 = (f32x4){bflo(hw.z), bfhi(hw.z), bflo(hw.w), bfhi(hw.w)};
                const f32x4 za0 = acc[ai][0][m][0] + ba0, za1 = acc[ai][0][m][1] + ba1, zb0 = acc[ai][1][m][0] + bb0, zb1 = acc[ai][1][m][1] + bb1; f32x4 o0, o1;
#pragma unroll
                for (int j = 0; j < 4; ++j) { o0[j] = za0[j] * sigmoid_f(zb0[j]); o1[j] = za1[j] * sigmoid_f(zb1[j]); }
                const f32x4 r0 = h0 + gv0 * o0, r1 = h1 + gv1 * o1;
                *(u32x4*)hp = (u32x4){pk2(r0[0], r0[1]), pk2(r0[2], r0[3]), pk2(r1[0], r1[1]), pk2(r1[2], r1[3])};
            }
    }
};

#define XB_TMO      128
#define XB_XCNT(j)  (256  + 64 * (j))
#define XB_XSUB(j)  (1280 + 64 * (j))
#define XB_XGEN(j)  (2304 + 64 * (j))
#define XB_TOP      3328
#define XB_TOPGEN   3392
#define XCD_BAR_WORDS 3456
#define XB_SPIN_CAP (1u << 18)
__device__ __forceinline__ unsigned xb_ld(unsigned* p)              { return __hip_atomic_load(p, __ATOMIC_RELAXED, __HIP_MEMORY_SCOPE_AGENT); }
__device__ __forceinline__ unsigned xb_add(unsigned* p, unsigned v) { return __hip_atomic_fetch_add(p, v, __ATOMIC_RELAXED, __HIP_MEMORY_SCOPE_AGENT); }
__device__ __forceinline__ unsigned xb_xcc_id() { return (unsigned)__builtin_amdgcn_s_getreg((3 << 11) | 20) & 0xFu; }
#define XB_SPIN(cond, bar) do { unsigned _sp = 0; while (cond) { __builtin_amdgcn_s_sleep(1); \
    if ((++_sp & 255u) == 0u) { if (xb_ld(&(bar)[XB_TMO])) break; if (_sp > XB_SPIN_CAP) { atomicAdd(&(bar)[XB_TMO], 1u); break; } } } } while (0)
struct XcdBarrier { unsigned* bar; unsigned x; volatile LAS unsigned* st; };
__device__ __forceinline__ XcdBarrier xcd_barrier_post(unsigned* bar, volatile LAS unsigned* st) {
    XcdBarrier b; b.bar = bar; b.x = xb_xcc_id(); b.st = st;
    if (threadIdx.x == 0) (void)xb_add(&bar[XB_XCNT(b.x)], 1u);
    return b;
}
__device__ __forceinline__ void xcd_barrier_complete(unsigned* bar, unsigned x, unsigned& nloc, unsigned& nx) {
    const unsigned G = gridDim.x * gridDim.y * gridDim.z;
    unsigned sum, cnt, mine, sp = 0u;
    for (;;) {
        sum = 0u; cnt = 0u; mine = 0u;
#pragma unroll
        for (unsigned j = 0; j < 16; ++j) { const unsigned c = xb_ld(&bar[XB_XCNT(j)]); sum += c; cnt += (c > 0u) ? 1u : 0u; mine = (j == x) ? c : mine; }
        if (sum == G) break;
        __builtin_amdgcn_s_sleep(1);
        if ((++sp & 255u) == 0u) { if (xb_ld(&bar[XB_TMO])) break; if (sp > XB_SPIN_CAP) { atomicAdd(&bar[XB_TMO], 1u); break; } }
    }
    nloc = mine > 0u ? mine : 1u; nx = cnt > 0u ? cnt : 1u;
}
__device__ __forceinline__ void xcd_barrier(const XcdBarrier& b) {
    asm volatile("s_waitcnt vmcnt(0)" ::: "memory");
    __syncthreads();
    if (threadIdx.x == 0) {
        unsigned* bar = b.bar;
        __builtin_amdgcn_s_waitcnt(0);
        unsigned nloc = b.st[0], nx = b.st[1];
        if (nloc == 0u) { xcd_barrier_complete(bar, b.x, nloc, nx); b.st[0] = nloc; b.st[1] = nx; }
        const unsigned old = xb_add(&bar[XB_XSUB(b.x)], 1u);
        const unsigned gen = old / nloc;
        if (old + 1u == (gen + 1u) * nloc) {
            __builtin_amdgcn_fence(__ATOMIC_RELEASE, "agent");
            asm volatile("s_waitcnt vmcnt(0)" ::: "memory");
            const unsigned og = xb_add(&bar[XB_TOP], 1u);
            const unsigned tg = og / nx;
            if (og + 1u == (tg + 1u) * nx) xb_add(&bar[XB_TOPGEN], 1u);
            else XB_SPIN(xb_ld(&bar[XB_TOPGEN]) == tg, bar);
            __builtin_amdgcn_fence(__ATOMIC_ACQUIRE, "agent");
            xb_add(&bar[XB_XGEN(b.x)], 1u);
            asm volatile("s_waitcnt vmcnt(0)" ::: "memory");
        } else {
            XB_SPIN(xb_ld(&bar[XB_XGEN(b.x)]) == gen, bar);
            __builtin_amdgcn_fence(__ATOMIC_ACQUIRE, "agent");
            asm volatile("s_waitcnt vmcnt(0)" ::: "memory");
        }
    }
    __syncthreads();
}

__device__ __forceinline__ int opaque_tid() { int t = threadIdx.x; asm volatile("" : "+v"(t)); return t; }
#define PHASE_IDS() const int tid = opaque_tid(); const int lane = tid & 63, wave = tid >> 6; const int G = gridDim.x, gw = blockIdx.x * 8 + wave, NGW = G * 8; \
    const int vcu = (G % 8 == 0) ? (int)(blockIdx.x % 8) * (G / 8) + (int)(blockIdx.x / 8) : (int)blockIdx.x; (void)lane; (void)wave; (void)gw; (void)NGW; (void)vcu; (void)G
__global__ void __launch_bounds__(NTHREADS, 2) fwd_mega(Args a) {
    extern __shared__ __attribute__((aligned(16))) unsigned char lds_raw[];
    LAS unsigned char* lds = (LAS unsigned char*)lds_raw;
    cg::grid_group grid = cg::this_grid();
    unsigned char* ws = a.ws;
    if (threadIdx.x < 2) ((LAS unsigned*)(lds + LDS_BYTES - 16))[threadIdx.x] = 0u;
    __syncthreads();
    const XcdBarrier xbar = xcd_barrier_post((unsigned*)(ws + WS_CTL) + CW_BAR, (volatile LAS unsigned*)(lds + LDS_BYTES - 16));
#ifdef TS_SEL
    volatile LAS unsigned long long* tsbuf = (volatile LAS unsigned long long*)(lds + LDS_BYTES - 16 - 256);
    int tsn = 0;
#define TS_MARK() do { if (blockIdx.x == 0 && threadIdx.x == 0) tsbuf[tsn] = __builtin_amdgcn_s_memrealtime(); ++tsn; } while (0)
#else
#define TS_MARK() do { } while (0)
#endif
    TS_MARK();
#define GSYNC() do { xcd_barrier(xbar); TS_MARK(); } while (0)

    for (int rep = 0; rep < REP_P0; ++rep) { PHASE_IDS(); p0_phase(a, lds, tid, gw, NGW); if (REP_P0 > 1) __syncthreads(); }
    if (a.pad1 != 0) grid.sync();
    GSYNC();
    for (int rep = 0; rep < REP_P1; ++rep) { PHASE_IDS(); p1_phase(a, lane, gw, NGW); }
    GSYNC();
    {
        PHASE_IDS();
        pg8::Gemm g{(const bf16_t*)(ws + WS_A), (const bf16_t*)(ws + WS_WIN), NTOK, 5120, 1024};
        pg8::StaticOrder S; S.init(NTOK, 5120, G, (int)blockIdx.x);
        EpiInProj E{(bf16_t*)(ws + WS_Q), (bf16_t*)(ws + WS_V), (bf16_t*)(ws + WS_G), (_Float16*)(ws + WS_LFF), (_Float16*)(ws + WS_LFB), (const float*)(ws + WS_LBV)};
        for (int rep = 0; rep < REP_INP; ++rep) pg8::gemm_phase<EpiInProj, pg8::StaticOrder>(lds, g, S, E);
    }
    GSYNC();
    for (int rep = 0; rep < REP_GLA; ++rep) { PHASE_IDS(); gla_phase(a, lds, tid); if (REP_GLA > 1) __syncthreads(); }
    GSYNC();
    for (int rep = 0; rep < REP_RO; ++rep) { PHASE_IDS(); gla_readout_phase(a, lane, gw, NGW); }
    GSYNC();
    {
        PHASE_IDS();
        pg8::Gemm g{(const bf16_t*)(ws + WS_OG), (const bf16_t*)(ws + WS_WOUT), NTOK, 1024, 1024};
        pg8::StaticOrder S; S.init(NTOK, 1024, G, (int)blockIdx.x);
        EpiResid E{a.in[I_X], a.in[I_CTX], (const float*)(ws + WS_MODV), (bf16_t*)(ws + WS_H), 2048};
        for (int rep = 0; rep < REP_OUT; ++rep) pg8::gemm_phase<EpiResid, pg8::StaticOrder>(lds, g, S, E);
    }
    GSYNC();
    for (int rep = 0; rep < REP_RT; ++rep) { PHASE_IDS(); router_phase(a, lds, 0, 0, tid); if (REP_RT > 1) __syncthreads(); }
    GSYNC();
    for (int rep = 0; rep < REP_AS; ++rep) { PHASE_IDS(); assign_phase(a, lds, 0, 0, tid); if (REP_AS > 1) __syncthreads(); }
    GSYNC();
    for (int rep = 0; rep < REP_M1; ++rep) { PHASE_IDS(); moe_gemm1(a, lds, 0, tid, G, vcu); }
    GSYNC();
    for (int rep = 0; rep < REP_M2; ++rep) { PHASE_IDS(); moe_gemm2(a, lds, 0, tid, G, vcu); }
    GSYNC();
    { PHASE_IDS(); combine_phase(a, 0, 0, lane, gw, NGW); }
    GSYNC();
    for (int rep = 0; rep < REP_S5; ++rep) { PHASE_IDS(); s5_phase(a, lds, tid); if (REP_S5 > 1) __syncthreads(); }
    GSYNC();
    for (int rep = 0; rep < REP_POST; ++rep) { PHASE_IDS(); s5_post_phase(a, lane, gw, NGW); }
    GSYNC();
    {
        PHASE_IDS();
        pg8::Gemm g{(const bf16_t*)(ws + WS_YG), (const bf16_t*)(ws + WS_WGLU), NLAT, 2048, 1024};
        pg8::StaticOrder S; S.init(NLAT, 2048, G, (int)blockIdx.x);
        EpiGlu E{a.in[I_S5BGLU], (const float*)(ws + WS_MODV) + 9 * 6144, (bf16_t*)(ws + WS_H)};
        pg8::gemm_phase<EpiGlu, pg8::StaticOrder>(lds, g, S, E);
    }
    GSYNC();
    { PHASE_IDS(); router_phase(a, lds, 1, NCTX, tid); }
    GSYNC();
    { PHASE_IDS(); assign_phase(a, lds, 1, NCTX, tid); }
    GSYNC();
    { PHASE_IDS(); moe_gemm1(a, lds, 1, tid, G, vcu); }
    GSYNC();
    { PHASE_IDS(); moe_gemm2(a, lds, 1, tid, G, vcu); }
    GSYNC();
    for (int rep = 0; rep < REP_CMB1; ++rep) { PHASE_IDS(); combine_phase(a, 1, NCTX, lane, gw, NGW); }
#ifdef TS_SEL
    TS_MARK();
    if (blockIdx.x == 0 && threadIdx.x == 0) {
        asm volatile("s_waitcnt vmcnt(0)" ::: "memory"); __threadfence();
        const unsigned long long dt = tsbuf[TS_SEL + 1] - tsbuf[TS_SEL];
        atomicAdd(a.out, (float)dt * 0.001f);
    }
#endif
}

extern "C" void kernel_launch(void* const* d_in, const int* in_sizes, int n_in, void* d_out, int out_size,
                              void* d_ws, size_t ws_size, hipStream_t stream) {
    static int grid_blocks = 0;
    if (!grid_blocks) {
        int dev = 0, cus = 0, per_cu = 0;
        (void)hipGetDevice(&dev);
        (void)hipDeviceGetAttribute(&cus, hipDeviceAttributeMultiprocessorCount, dev);
        (void)hipFuncSetAttribute((const void*)fwd_mega, hipFuncAttributeMaxDynamicSharedMemorySize, LDS_BYTES);
        (void)hipOccupancyMaxActiveBlocksPerMultiprocessor(&per_cu, (const void*)fwd_mega, NTHREADS, LDS_BYTES);
        if (per_cu < 1) { fprintf(stderr, "occupancy query says %d blocks/CU\n", per_cu); }
        grid_blocks = cus < 256 ? cus : 256;
        if (ws_size < WS_END) fprintf(stderr, "kernel_launch: workspace too small: %zu < %zu\n", ws_size, (size_t)WS_END);
    }
    (void)hipMemsetAsync((char*)d_ws + WS_CTL, 0, 1 * MiB, stream);
    Args a{};
    for (int i = 0; i < 29; ++i) a.in[i] = (const float*)d_in[i];
    a.out = (float*)d_out; a.ws = (unsigned char*)d_ws;
    void* kargs[] = {&a};
    hipError_t e = hipLaunchCooperativeKernel((const void*)fwd_mega, dim3(grid_blocks), dim3(NTHREADS), kargs, LDS_BYTES, stream);
    if (e != hipSuccess) fprintf(stderr, "cooperative launch failed: %s (grid %d)\n", hipGetErrorString(e), grid_blocks);
}
```

```cpp
#include <hip/hip_runtime.h>
#include <hip/hip_cooperative_groups.h>
#include <cstdio>
#include <cstdint>
namespace cg = cooperative_groups;

#define LAS __attribute__((address_space(3)))
typedef unsigned short bf16_t;
typedef short bf16x8 __attribute__((ext_vector_type(8)));
typedef float f32x4 __attribute__((ext_vector_type(4)));
typedef unsigned u32x4 __attribute__((ext_vector_type(4)));
typedef unsigned u32x2 __attribute__((ext_vector_type(2)));
typedef float f32x2 __attribute__((ext_vector_type(2)));

constexpr int NTHREADS = 512;
constexpr int LDS_BYTES = 147456;
constexpr int D = 1024, NB = 8, SEQ = 4096, CTXL = 256;
constexpr int NCTX = NB * CTXL;
constexpr int NLAT = NB * SEQ;
constexpr int NTOK = NCTX + NLAT;
constexpr int NE = 32;
constexpr int MPAD = 147456;
constexpr float EPS = 1e-6f;

constexpr size_t MiB = 1u << 20;
constexpr size_t WS_CTL = 0;
constexpr size_t WS_MODV = 1 * MiB;
constexpr size_t WS_LBV = 1 * MiB + 512 * 1024;
constexpr size_t WS_WIN = 2 * MiB;
constexpr size_t WS_WOUT = 12 * MiB;
constexpr size_t WS_WGLU = 14 * MiB;
constexpr size_t WS_W1 = 18 * MiB;
constexpr size_t WS_W2 = 274 * MiB;
constexpr size_t WS_H = 402 * MiB;
constexpr size_t WS_A = 538 * MiB;
constexpr size_t WS_F = 606 * MiB;
constexpr size_t WS_TOKE = 674 * MiB;
constexpr size_t WS_TOKW = 674 * MiB + 640 * 1024;
constexpr size_t WS_TOKS = 674 * MiB + 1280 * 1024;
constexpr size_t WS_SLOTTOK = 256 * 1024;
constexpr size_t WS_BIG = 676 * MiB;
constexpr size_t WS_Q = WS_BIG, WS_V = WS_BIG + 68 * MiB, WS_G = WS_BIG + 136 * MiB;
constexpr size_t WS_LFF = WS_BIG + 204 * MiB, WS_LFB = WS_BIG + 340 * MiB;
constexpr size_t WS_OF = WS_BIG + 476 * MiB, WS_OB = WS_BIG + 612 * MiB;
constexpr size_t WS_OG = WS_BIG + 748 * MiB;
constexpr size_t WS_AG = WS_BIG, WS_ACT = WS_BIG + 288 * MiB, WS_YS = WS_BIG;
constexpr size_t WS_YF = WS_BIG, WS_YB = WS_BIG + 128 * MiB, WS_YG = WS_BIG + 256 * MiB;
constexpr size_t WS_END = WS_BIG + 816 * MiB;
constexpr int CW_CNT = 64;
constexpr int CW_CUR = 256;
constexpr int CW_CNTB = 8192;
constexpr int CW_BAR = 4096;
#ifndef REP_P0
#define REP_P0 1
#endif
#ifndef REP_GLA
#define REP_GLA 1
#endif
#ifndef REP_S5
#define REP_S5 1
#endif
#ifndef REP_P1
#define REP_P1 1
#endif
#ifndef REP_RO
#define REP_RO 1
#endif
#ifndef REP_POST
#define REP_POST 1
#endif
#ifndef REP_CMB1
#define REP_CMB1 1
#endif
#ifndef REP_OUT
#define REP_OUT 1
#endif
#ifndef REP_RT
#define REP_RT 1
#endif
#ifndef REP_AS
#define REP_AS 1
#endif
#ifndef REP_INP
#define REP_INP 1
#endif
#ifndef REP_M1
#define REP_M1 1
#endif
#ifndef REP_M2
#define REP_M2 1
#endif

struct Args {
    const float* in[29];
    float* out;
    unsigned char* ws;
    int stop_after, pad1;
};
enum { I_X = 0, I_C, I_CTX, I_CCTX, I_MODW, I_MODB, I_N1G, I_N2G, I_HGWIN, I_HGLB, I_HGNG, I_HGWOUT, I_S5ARE, I_S5AIM, I_S5LDT,
       I_S5BRE, I_S5BIM, I_S5CRE, I_S5CIM, I_S5D, I_S5WGLU, I_S5BGLU, I_RW, I_RB, I_W1, I_B1, I_W2, I_B2, I_FG };

__device__ __forceinline__ unsigned f2bf(float f) { unsigned u = __builtin_bit_cast(unsigned, f); return (u + 0x7fffu + ((u >> 16) & 1u)) >> 16; }
typedef __bf16 bf16x2_t __attribute__((ext_vector_type(2)));
__device__ __forceinline__ unsigned cvt_pk_bf16(float lo, float hi) { const bf16x2_t v = {(__bf16)lo, (__bf16)hi}; return __builtin_bit_cast(unsigned, v); }
__device__ __forceinline__ unsigned pk2(float lo, float hi) { return cvt_pk_bf16(lo, hi); }
__device__ __forceinline__ float bf2f(unsigned short b) { return __builtin_bit_cast(float, ((unsigned)b) << 16); }
__device__ __forceinline__ float bflo(unsigned w) { return __builtin_bit_cast(float, w << 16); }
__device__ __forceinline__ float bfhi(unsigned w) { return __builtin_bit_cast(float, w & 0xffff0000u); }
__device__ __forceinline__ float wave_sum(float v) {
#pragma unroll
    for (int o = 1; o < 64; o <<= 1) v += __shfl_xor(v, o);
    return v;
}
__device__ __forceinline__ float wave_max(float v) {
#pragma unroll
    for (int o = 1; o < 64; o <<= 1) v = fmaxf(v, __shfl_xor(v, o));
    return v;
}
__device__ __forceinline__ float sigmoid_f(float x) { return __builtin_amdgcn_rcpf(1.0f + __expf(-x)); }
__device__ __forceinline__ float silu_f(float x) { return x * __builtin_amdgcn_rcpf(1.0f + __expf(-x)); }
#define LDS_WAIT() asm volatile("s_waitcnt lgkmcnt(0)" ::: "memory")

namespace pg8 {
constexpr int BM = 256, BK = 64, HALF = 128, HTB = HALF * BK * 2, STAGE_BYTES = 8 * HTB, NXCD = 8, WGM = 8;
__host__ __device__ __forceinline__ int lds_byte(int r, int c) { const int st = (r >> 4) * 2 + (c >> 5), rr = r & 15, cc = c & 31, ob = rr * 64 + cc * 2; return st * 1024 + (ob ^ (((ob >> 9) & 1) << 5)); }
__host__ __device__ __forceinline__ void stage_rc(int b, int& R, int& C) { const int st = b / 1024, sb = b % 1024, swz = sb ^ (((sb >> 9) & 1) << 5); R = (st >> 1) * 16 + swz / 64; C = (st & 1) * 32 + (swz % 64) / 2; }
__host__ __device__ __forceinline__ int perm32(int rho) { const int n = rho >> 4, i = rho & 15; return 8 * (i >> 2) + 4 * n + (i & 3); }
struct Unit { int pm, pn; };
struct Gemm { const bf16_t* A; const bf16_t* Bt; int M, N, K; };
struct StaticOrder {
    int nM, nN, nwg, G, c;
    __device__ void init(int M, int N, int G_, int c_) { nM = M / BM; nN = N / BM; nwg = nM * nN; G = G_; c = c_; }
    __device__ bool next(int i, Unit& u) const {
        const long L = (long)i * G + c; if (L >= nwg) return false;
        int wgid = (int)L; { const int q = nwg / NXCD, r = nwg % NXCD, xcd = wgid % NXCD, off = wgid / NXCD; wgid = (xcd < r ? xcd * (q + 1) : r * (q + 1) + (xcd - r) * q) + off; }
        const int nig = WGM * nN, gid = wgid / nig, fm = gid * WGM, gsz = (nM - fm) < WGM ? (nM - fm) : WGM;
        u.pm = fm + ((wgid % nig) % gsz); u.pn = (wgid % nig) / gsz; return true;
    }
    __device__ __forceinline__ void a_ready(const Unit&) const {}
    __device__ __forceinline__ void done(const Unit&) const {}
};
struct MoeOrder {
    const LAS int* tile_e; int TT, sh, G, v;
    __device__ bool next(int i, Unit& u) const {
        const bool p2 = (G & (G - 1)) == 0 && G >= 8;
        const int lg = p2 ? (31 - __builtin_clz((unsigned)G)) - 3 : 0, per = p2 ? (1 << lg) : G, x = p2 ? (v >> lg) : 0, j = p2 ? (v & (per - 1)) : v, sh3 = p2 ? 3 : 0;
        const int t0 = (x * TT) >> sh3, t1 = ((x + 1) * TT) >> sh3;
        const int uu = i * per + j, rt = t0 + (uu >> sh), pnl = uu & ((1 << sh) - 1);
        if (rt >= t1) return false;
        u.pm = rt; u.pn = (tile_e[rt] << sh) + pnl; return true;
    }
    __device__ __forceinline__ void a_ready(const Unit&) const {}
    __device__ __forceinline__ void done(const Unit&) const {}
};

template <class Epi, class Sched, bool GATHER = false, bool ALIGN_EPI = true, bool SP2 = true>
__device__ __forceinline__ void gemm_phase(LAS unsigned char* lds, const Gemm g, const Sched& S, const Epi& E, const LAS unsigned short* rowl = nullptr) {
    int tid_ = threadIdx.x; asm volatile("" : "+v"(tid_));
    const int tid = tid_, wid = __builtin_amdgcn_readfirstlane(tid >> 6), lane = tid & 63, wr = wid >> 2, wc = wid & 3, fr = lane & 15, fq = lane >> 4;
    const int K = g.K, nt = K / BK;
    unsigned voffA[2], voffB[2];
    int Rr[2], Cc2[2];
#pragma unroll
    for (int i = 0; i < 2; ++i) { int R, C; stage_rc(tid * 16 + i * 8192, R, C); voffA[i] = (unsigned)(R * K + C) * 2u; const int Rb = Epi::PERM ? ((R & ~31) + perm32(R & 31)) : R; voffB[i] = (unsigned)(Rb * K + C) * 2u; Rr[i] = R; Cc2[i] = C * 2; }
    unsigned gA0[2] = {0u, 0u}, gA1[2] = {0u, 0u}, nG0[2] = {0u, 0u}, nG1[2] = {0u, 0u};
#define PG8_ROWS(ui_, d0, d1) do { _Pragma("unroll") for (int _i = 0; _i < 2; ++_i) { d0[_i] = (unsigned)rowl[(ui_) * BM + Rr[_i]] * (unsigned)(K * 2) + (unsigned)Cc2[_i]; d1[_i] = (unsigned)rowl[(ui_) * BM + HALF + Rr[_i]] * (unsigned)(K * 2) + (unsigned)Cc2[_i]; } } while (0)
#define PG8_STAGE_A(bufoff, ptr, h, nx) do { if constexpr (GATHER) { unsigned _o[2]; _o[0] = (nx) ? ((h) ? nG1[0] : nG0[0]) : ((h) ? gA1[0] : gA0[0]); _o[1] = (nx) ? ((h) ? nG1[1] : nG0[1]) : ((h) ? gA1[1] : gA0[1]); PG8_STAGE(bufoff, ptr, _o); } \
        else { PG8_STAGE(bufoff, (ptr) + ((h) ? hstep : 0), voffA); } } while (0)
    const size_t kstep = (size_t)(BK * 2);
    const size_t hstep = (size_t)HALF * K * 2;
    const size_t tstep = 2 * hstep;
    const unsigned ldsw = (unsigned)wid * 1024u;
    const int aoff = lds_byte(wr * 64 + fr, fq * 8), boff = lds_byte(wc * 32 + fr, fq * 8);
#define PG8_SA(b, h) (((b) * 2 + (h)) * HTB)
#define PG8_SB(b, h) ((4 + (b) * 2 + (h)) * HTB)
#define PG8_STAGE(bufoff, gbase, voff) do { _Pragma("unroll") for (int _i = 0; _i < 2; ++_i) \
        __builtin_amdgcn_global_load_lds((const unsigned*)((const char*)(gbase) + (voff)[_i]), (LAS unsigned*)(lds + (bufoff) + ldsw + _i * 8192), 16, 0, 0); } while (0)
#define PG8_LDA(dst, b, h) do { _Pragma("unroll") for (int m = 0; m < 4; ++m) _Pragma("unroll") for (int k = 0; k < 2; ++k) dst[m][k] = *(const LAS bf16x8*)(lds + PG8_SA(b, h) + aoff + m * 2048 + k * 1024); } while (0)
#define PG8_LDB(dst, b, h) do { _Pragma("unroll") for (int n = 0; n < 2; ++n) _Pragma("unroll") for (int k = 0; k < 2; ++k) dst[n][k] = *(const LAS bf16x8*)(lds + PG8_SB(b, h) + boff + n * 2048 + k * 1024); } while (0)
#define PG8_MMA(ai, bj, At, Bt) do { __builtin_amdgcn_s_setprio(1); _Pragma("unroll") for (int m = 0; m < 4; ++m) _Pragma("unroll") for (int n = 0; n < 2; ++n) _Pragma("unroll") for (int k = 0; k < 2; ++k) \
        acc[ai][bj][m][n] = __builtin_amdgcn_mfma_f32_16x16x32_bf16(Bt[n][k], At[m][k], acc[ai][bj][m][n], 0, 0, 0); __builtin_amdgcn_s_setprio(0); } while (0)
#define PG8_WAIT_V(n) asm volatile("s_waitcnt vmcnt(" #n ")" ::: "memory")
#define PG8_WAIT_L(n) asm volatile("s_waitcnt lgkmcnt(" #n ")" ::: "memory")
#define PG8_BAR __builtin_amdgcn_s_barrier()
#define PG8_SCHED __builtin_amdgcn_sched_barrier(0)
    Unit cur, nxt; int ui = 0;
    if (!S.next(0, cur)) return;
    f32x4 acc[2][2][4][2];
#pragma unroll
    for (int a = 0; a < 2; ++a)
#pragma unroll
        for (int b = 0; b < 2; ++b)
#pragma unroll
            for (int m = 0; m < 4; ++m)
#pragma unroll
                for (int n = 0; n < 2; ++n) acc[a][b][m][n] = (f32x4){0.f, 0.f, 0.f, 0.f};
    bf16x8 At[4][2], B0[2][2], B1[2][2];
    const char* cA = GATHER ? (const char*)g.A : (const char*)g.A + (size_t)cur.pm * tstep; const char* cB = (const char*)g.Bt + (size_t)cur.pn * tstep;
    S.a_ready(cur);
    if constexpr (GATHER) PG8_ROWS(0, gA0, gA1);
    if constexpr (SP2) {
        PG8_STAGE(PG8_SB(0, 0), cB, voffB); PG8_STAGE(PG8_SB(0, 1), cB + hstep, voffB); PG8_STAGE_A(PG8_SA(0, 0), cA, 0, false); PG8_STAGE_A(PG8_SA(0, 1), cA, 1, false);
        if (wr == 1) PG8_BAR;
        PG8_WAIT_V(2); PG8_BAR;
        PG8_STAGE(PG8_SB(1, 0), cB + kstep, voffB); PG8_STAGE_A(PG8_SA(1, 0), cA + kstep, 0, false); PG8_STAGE(PG8_SB(1, 1), cB + hstep + kstep, voffB);
        PG8_WAIT_V(6); PG8_BAR;
    } else {
        PG8_STAGE(PG8_SB(0, 0), cB, voffB); PG8_STAGE_A(PG8_SA(0, 0), cA, 0, false); PG8_STAGE(PG8_SB(0, 1), cB + hstep, voffB); PG8_STAGE_A(PG8_SA(0, 1), cA, 1, false);
        if (wr == 1) PG8_BAR;
        PG8_WAIT_V(4); PG8_BAR;
        PG8_STAGE(PG8_SB(1, 0), cB + kstep, voffB); PG8_STAGE_A(PG8_SA(1, 0), cA + kstep, 0, false); PG8_STAGE(PG8_SB(1, 1), cB + hstep + kstep, voffB);
        PG8_WAIT_V(6); PG8_BAR;
    }
    for (;;) {
        const bool has_next = S.next(ui + 1, nxt);
        const char* nA = GATHER ? cA : (has_next ? (const char*)g.A + (size_t)nxt.pm * tstep : cA); const char* nB = has_next ? (const char*)g.Bt + (size_t)nxt.pn * tstep : cB;
        if constexpr (GATHER) { if (has_next) PG8_ROWS(ui + 1, nG0, nG1); else { nG0[0] = gA0[0]; nG0[1] = gA0[1]; nG1[0] = gA1[0]; nG1[1] = gA1[1]; } }
        for (int t = 0; t < nt; t += 2) {
            const bool last = (t == nt - 2);
            const char* a1 = cA + (size_t)(t + 1) * kstep;
            const char* a2 = last ? nA : cA + (size_t)(t + 2) * kstep; const char* b2 = last ? nB : cB + (size_t)(t + 2) * kstep;
            const char* a3 = a2 + kstep; const char* b3 = b2 + kstep;
            if (last && has_next) S.a_ready(nxt);
            if constexpr (SP2) {
            PG8_LDB(B0, 0, 0); PG8_LDB(B1, 0, 1); PG8_SCHED; PG8_LDA(At, 0, 0); PG8_STAGE_A(PG8_SA(1, 1), a1, 1, false);
            PG8_WAIT_V(8); PG8_WAIT_L(0); PG8_BAR; PG8_MMA(0, 0, At, B0); PG8_MMA(0, 1, At, B1); PG8_BAR; PG8_SCHED;
            PG8_LDA(At, 0, 1); PG8_STAGE(PG8_SB(0, 0), b2, voffB); PG8_STAGE(PG8_SB(0, 1), b2 + hstep, voffB); PG8_STAGE_A(PG8_SA(0, 0), a2, 0, last);
            PG8_WAIT_V(8); PG8_WAIT_L(0); PG8_BAR; PG8_MMA(1, 0, At, B0); PG8_MMA(1, 1, At, B1); PG8_BAR; PG8_SCHED;
            PG8_LDB(B0, 1, 0); PG8_LDB(B1, 1, 1); PG8_SCHED; PG8_LDA(At, 1, 0); PG8_STAGE_A(PG8_SA(0, 1), a2, 1, last);
            PG8_WAIT_V(8); PG8_WAIT_L(0); PG8_BAR; PG8_MMA(0, 0, At, B0); PG8_MMA(0, 1, At, B1); PG8_BAR; PG8_SCHED;
            PG8_LDA(At, 1, 1); PG8_STAGE(PG8_SB(1, 0), b3, voffB); PG8_STAGE(PG8_SB(1, 1), b3 + hstep, voffB); PG8_STAGE_A(PG8_SA(1, 0), a3, 0, last);
            PG8_WAIT_V(8); PG8_WAIT_L(0); PG8_BAR; PG8_MMA(1, 0, At, B0); PG8_MMA(1, 1, At, B1); PG8_BAR; PG8_SCHED;
            } else {
            PG8_LDB(B0, 0, 0); PG8_SCHED; PG8_LDA(At, 0, 0); PG8_STAGE_A(PG8_SA(1, 1), a1, 1, false);
            PG8_WAIT_L(8); PG8_BAR; PG8_WAIT_L(0); PG8_MMA(0, 0, At, B0); PG8_BAR; PG8_SCHED;
            PG8_LDB(B1, 0, 1); PG8_STAGE(PG8_SB(0, 0), b2, voffB);
            PG8_BAR; PG8_WAIT_L(0); PG8_MMA(0, 1, At, B1); PG8_BAR;
            PG8_LDA(At, 0, 1); PG8_STAGE_A(PG8_SA(0, 0), a2, 0, last);
            PG8_BAR; PG8_WAIT_L(0); PG8_MMA(1, 0, At, B0); PG8_BAR; PG8_SCHED;
            PG8_STAGE(PG8_SB(0, 1), b2 + hstep, voffB);
            PG8_WAIT_V(6); PG8_BAR; PG8_MMA(1, 1, At, B1); PG8_BAR;
            PG8_LDB(B0, 1, 0); PG8_SCHED; PG8_LDA(At, 1, 0); PG8_STAGE_A(PG8_SA(0, 1), a2, 1, last);
            PG8_WAIT_L(8); PG8_BAR; PG8_WAIT_L(0); PG8_MMA(0, 0, At, B0); PG8_BAR; PG8_SCHED;
            PG8_LDB(B1, 1, 1); PG8_STAGE(PG8_SB(1, 0), b3, voffB);
            PG8_BAR; PG8_WAIT_L(0); PG8_MMA(0, 1, At, B1); PG8_BAR;
            PG8_LDA(At, 1, 1); PG8_STAGE_A(PG8_SA(1, 0), a3, 0, last);
            PG8_BAR; PG8_WAIT_L(0); PG8_MMA(1, 0, At, B0); PG8_BAR; PG8_SCHED;
            PG8_STAGE(PG8_SB(1, 1), b3 + hstep, voffB);
            PG8_WAIT_V(6); PG8_BAR; PG8_MMA(1, 1, At, B1); PG8_BAR;
                    }
        }
        if constexpr (ALIGN_EPI) { if (wr == 0) PG8_BAR; }
        E(acc, cur, wr, wc, fr, fq); S.done(cur);
        if (!has_next) break;
#pragma unroll
        for (int a = 0; a < 2; ++a)
#pragma unroll
            for (int b = 0; b < 2; ++b)
#pragma unroll
                for (int m = 0; m < 4; ++m)
#pragma unroll
                    for (int n = 0; n < 2; ++n) acc[a][b][m][n] = (f32x4){0.f, 0.f, 0.f, 0.f};
        cur = nxt; cA = nA; cB = nB; ++ui;
        if constexpr (GATHER) { gA0[0] = nG0[0]; gA0[1] = nG0[1]; gA1[0] = nG1[0]; gA1[1] = nG1[1]; }
        if constexpr (ALIGN_EPI) { if (wr == 1) PG8_BAR; }
    }
    PG8_WAIT_V(0);
    if constexpr (!ALIGN_EPI) { if (wr == 0) PG8_BAR; }
    PG8_BAR;
#undef PG8_SA
#undef PG8_ROWS
#undef PG8_STAGE_A
#undef PG8_SB
#undef PG8_STAGE
#undef PG8_LDA
#undef PG8_LDB
#undef PG8_MMA
#undef PG8_WAIT_V
#undef PG8_WAIT_L
#undef PG8_BAR
#undef PG8_SCHED
}
}
using pg8::Unit;

__device__ __forceinline__ f32x4 ld_bf16x4(const bf16_t* p) { const u32x2 w = *(const u32x2*)p; return (f32x4){bflo(w.x), bfhi(w.x), bflo(w.y), bfhi(w.y)}; }
__device__ __forceinline__ void st_bf16x4(bf16_t* p, f32x4 v) { u32x2 w; w.x = pk2(v[0], v[1]); w.y = pk2(v[2], v[3]); *(u32x2*)p = w; }

struct EpiInProj {
    static constexpr bool PERM = true;
    bf16_t *Q, *V, *G; _Float16 *LFF, *LFB; const float* lbv;
    __device__ __forceinline__ void operator()(const f32x4 (&acc)[2][2][4][2], const Unit& u, int wr, int wc, int fr, int fq) const {
        const int seg = u.pn >> 2, cb = (u.pn & 3) * 256 + wc * 32 + 8 * fq, row0 = u.pm * 256 + wr * 64 + fr;
#pragma unroll
        for (int bj = 0; bj < 2; ++bj) {
            const int c = cb + bj * 128;
            f32x4 lb0 = (f32x4){0.f, 0.f, 0.f, 0.f}, lb1 = lb0;
            if (seg == 2 || seg == 3) { lb0 = *(const f32x4*)(lbv + (seg - 2) * D + c); lb1 = *(const f32x4*)(lbv + (seg - 2) * D + c + 4); }
#pragma unroll
            for (int ai = 0; ai < 2; ++ai)
#pragma unroll
                for (int m = 0; m < 4; ++m) {
                    const size_t ro = (size_t)(row0 + ai * 128 + m * 16) * D + c;
                    const f32x4 v0 = acc[ai][bj][m][0], v1 = acc[ai][bj][m][1];
                    if (seg == 0) { f32x4 o0, o1; for (int j = 0; j < 4; ++j) { o0[j] = silu_f(v0[j]); o1[j] = silu_f(v1[j]); }
                        *(u32x4*)(Q + ro) = (u32x4){pk2(o0[0], o0[1]), pk2(o0[2], o0[3]), pk2(o1[0], o1[1]), pk2(o1[2], o1[3])}; }
                    else if (seg == 1) { *(u32x4*)(V + ro) = (u32x4){pk2(v0[0], v0[1]), pk2(v0[2], v0[3]), pk2(v1[0], v1[1]), pk2(v1[2], v1[3])}; }
                    else if (seg == 4) { *(u32x4*)(G + ro) = (u32x4){pk2(v0[0], v0[1]), pk2(v0[2], v0[3]), pk2(v1[0], v1[1]), pk2(v1[2], v1[3])}; }
                    else {
                        f32x4 o0, o1;
                        for (int j = 0; j < 4; ++j) { o0[j] = __logf(lb0[j] + (1.0f - lb0[j]) * sigmoid_f(v0[j])); o1[j] = __logf(lb1[j] + (1.0f - lb1[j]) * sigmoid_f(v1[j])); }
                        u32x4 hw; hw.x = __builtin_bit_cast(unsigned, __builtin_amdgcn_cvt_pkrtz(o0[0], o0[1])); hw.y = __builtin_bit_cast(unsigned, __builtin_amdgcn_cvt_pkrtz(o0[2], o0[3]));
                        hw.z = __builtin_bit_cast(unsigned, __builtin_amdgcn_cvt_pkrtz(o1[0], o1[1])); hw.w = __builtin_bit_cast(unsigned, __builtin_amdgcn_cvt_pkrtz(o1[2], o1[3]));
                        *(u32x4*)((seg == 2 ? LFF : LFB) + ro) = hw;
                    }
                }
        }
    }
};
struct EpiResid {
    static constexpr bool PERM = true;
    const float* x; const float* ctx; const float* modv; bf16_t* H; int gate_off;
    __device__ __forceinline__ void operator()(const f32x4 (&acc)[2][2][4][2], const Unit& u, int wr, int wc, int fr, int fq) const {
        const int rt0 = u.pm * 256; const int mr = rt0 < NCTX ? 8 : ((rt0 - NCTX) >> 12);
        const float* src = rt0 < NCTX ? ctx + (size_t)rt0 * D : x + (size_t)(rt0 - NCTX) * D;
        const int cb = u.pn * 256 + wc * 32 + 8 * fq, rl0 = wr * 64 + fr;
        const float* gp = modv + mr * 6144 + gate_off;
        f32x4 gg[2][2];
#pragma unroll
        for (int bj = 0; bj < 2; ++bj) { gg[bj][0] = *(const f32x4*)(gp + cb + bj * 128); gg[bj][1] = *(const f32x4*)(gp + cb + bj * 128 + 4); }
#pragma unroll
        for (int bj = 0; bj < 2; ++bj)
#pragma unroll
            for (int ai = 0; ai < 2; ++ai) {
                const int c = cb + bj * 128; f32x4 h0[4], h1[4];
#pragma unroll
                for (int m = 0; m < 4; ++m) { const float* hp = src + (size_t)(rl0 + ai * 128 + m * 16) * D + c; h0[m] = *(const f32x4*)hp; h1[m] = *(const f32x4*)(hp + 4); }
#pragma unroll
                for (int m = 0; m < 4; ++m) {
                    const f32x4 o0 = h0[m] + gg[bj][0] * acc[ai][bj][m][0], o1 = h1[m] + gg[bj][1] * acc[ai][bj][m][1];
                    *(u32x4*)(H + (size_t)(rt0 + rl0 + ai * 128 + m * 16) * D + c) = (u32x4){pk2(o0[0], o0[1]), pk2(o0[2], o0[3]), pk2(o1[0], o1[1]), pk2(o1[2], o1[3])};
                }
                asm volatile("" ::: "memory");
            }
    }
};

struct TrItem { const float* src; bf16_t* dst; int N; };
__device__ __forceinline__ void tr_load(const TrItem& t, f32x4 (&v)[16], int lane) {
    const float* p = t.src + (size_t)(2 * (lane >> 4)) * t.N + 4 * (lane & 15);
#pragma unroll
    for (int i = 0; i < 8; ++i) { v[2 * i] = *(const f32x4*)(p + (size_t)(8 * i) * t.N); v[2 * i + 1] = *(const f32x4*)(p + (size_t)(8 * i + 1) * t.N); }
}
__device__ __forceinline__ void tr_finish(const TrItem& t, const f32x4 (&v)[16], LAS unsigned* scr, int lane) {
#pragma unroll
    for (int i = 0; i < 8; ++i) {
        const int kp = 4 * i + (lane >> 4); LAS unsigned* s = scr + kp * 65 + 4 * (lane & 15);
        s[0] = cvt_pk_bf16(v[2 * i][0], v[2 * i + 1][0]); s[1] = cvt_pk_bf16(v[2 * i][1], v[2 * i + 1][1]); s[2] = cvt_pk_bf16(v[2 * i][2], v[2 * i + 1][2]); s[3] = cvt_pk_bf16(v[2 * i][3], v[2 * i + 1][3]);
    }
    LDS_WAIT();
    const int c = lane & 7;
#pragma unroll
    for (int j = 0; j < 8; ++j) {
        const int n = (lane >> 3) + 8 * j; const LAS unsigned* s = scr + (4 * c) * 65 + n;
        *(u32x4*)(t.dst + (size_t)n * 1024 + 8 * c) = (u32x4){s[0], s[65], s[130], s[195]};
    }
    LDS_WAIT();
}
__device__ __forceinline__ int ilv_row(int c) { const int bj = c >> 10, r = c & 1023; return (r >> 7) * 256 + bj * 128 + (r & 127); }

__device__ __forceinline__ TrItem moe_item(const Args& a, int r, int layer) {
    TrItem t;
    if (r < 32 * 512) { const int mat = layer * 32 + (r >> 9), sub = r & 511, kb = sub >> 5, nb = sub & 31;
        t.src = a.in[I_W1] + (size_t)mat * 1024 * 2048 + (size_t)(kb * 64) * 2048 + nb * 64; t.dst = (bf16_t*)(a.ws + WS_W1) + (size_t)mat * 2048 * 1024 + (size_t)ilv_row(nb * 64) * 1024 + kb * 64; t.N = 2048; }
    else { r -= 32 * 512; const int mat = layer * 32 + (r >> 8), sub = r & 255, kb = sub >> 4, nb = sub & 15;
        t.src = a.in[I_W2] + (size_t)mat * 1024 * 1024 + (size_t)(kb * 64) * 1024 + nb * 64; t.dst = (bf16_t*)(a.ws + WS_W2) + (size_t)mat * 1024 * 1024 + (size_t)(nb * 64) * 1024 + kb * 64; t.N = 1024; }
    return t;
}
constexpr int P0_NWIN = 16 * 80, P0_NWOUT = 16 * 16, P0_NWGLU = 16 * 32, P0_NITEMS = P0_NWIN + P0_NWOUT + P0_NWGLU + 32 * 512 + 32 * 256;
__device__ __forceinline__ TrItem p0_item(const Args& a, int r) {
    TrItem t;
    if (r < P0_NWIN) { const int kb = r / 80, nb = r % 80; t.src = a.in[I_HGWIN] + (size_t)(kb * 64) * 5120 + nb * 64; t.dst = (bf16_t*)(a.ws + WS_WIN) + (size_t)(nb * 64) * 1024 + kb * 64; t.N = 5120; return t; } r -= P0_NWIN;
    if (r < P0_NWOUT) { const int kb = r / 16, nb = r % 16; t.src = a.in[I_HGWOUT] + (size_t)(kb * 64) * 1024 + nb * 64; t.dst = (bf16_t*)(a.ws + WS_WOUT) + (size_t)(nb * 64) * 1024 + kb * 64; t.N = 1024; return t; } r -= P0_NWOUT;
    if (r < P0_NWGLU) { const int kb = r / 32, nb = r % 32; t.src = a.in[I_S5WGLU] + (size_t)(kb * 64) * 2048 + nb * 64; t.dst = (bf16_t*)(a.ws + WS_WGLU) + (size_t)ilv_row(nb * 64) * 1024 + kb * 64; t.N = 2048; return t; } r -= P0_NWGLU;
    return moe_item(a, r, 0);
}
#define TR_LOOP(first, stride, count, ITEM) do { int _it = (first); if (_it < (count)) { f32x4 _va[16], _vb[16]; TrItem _A = ITEM(_it), _B = _A; tr_load(_A, _va, lane); \
        for (;;) { const int _i2 = _it + (stride); const bool _h2 = _i2 < (count); if (_h2) { _B = ITEM(_i2); tr_load(_B, _vb, lane); } tr_finish(_A, _va, scr, lane); if (!_h2) break; \
                   _it = _i2 + (stride); const bool _h1 = _it < (count); if (_h1) { _A = ITEM(_it); tr_load(_A, _va, lane); } tr_finish(_B, _vb, scr, lane); if (!_h1) break; } } } while (0)
__device__ __forceinline__ void p0_phase(const Args& a, LAS unsigned char* lds, int tid, int gw, int NGW) {
    const int lane = tid & 63, wave = tid >> 6;
    unsigned char* ws = a.ws;
    float* modv = (float*)(ws + WS_MODV);
    if (blockIdx.x < 192) {
        LAS float* SC = (LAS float*)lds;
        LAS float* PART = (LAS float*)(lds + 40960);
        for (int i = tid; i < 9 * 1024; i += NTHREADS) { const int r = i >> 10, k = i & 1023; const float v = r < 8 ? a.in[I_C][r * 1024 + k] : a.in[I_CCTX][k]; SC[i] = silu_f(v); }
        __syncthreads();
        const int layer = blockIdx.x / 96, ng = blockIdx.x % 96;
        const float* W = a.in[I_MODW] + (size_t)layer * 1024 * 6144 + ng * 64 + lane;
        float acc[9];
#pragma unroll
        for (int r = 0; r < 9; ++r) acc[r] = 0.f;
#pragma unroll 8
        for (int kk = 0; kk < 128; ++kk) {
            const int k = wave * 128 + kk; const float w = W[(size_t)k * 6144];
#pragma unroll
            for (int r = 0; r < 9; ++r) acc[r] += SC[r * 1024 + k] * w;
        }
#pragma unroll
        for (int r = 0; r < 9; ++r) PART[(wave * 9 + r) * 64 + lane] = acc[r];
        __syncthreads();
        for (int i = tid; i < 9 * 64; i += NTHREADS) {
            const int r = i >> 6, l = i & 63; float s = a.in[I_MODB][layer * 6144 + ng * 64 + l];
#pragma unroll
            for (int w = 0; w < 8; ++w) s += PART[(w * 9 + r) * 64 + l];
            modv[(size_t)(layer * 9 + r) * 6144 + ng * 64 + l] = s;
        }
        __syncthreads();
    } else if (blockIdx.x == 192) {
        float* lbv = (float*)(ws + WS_LBV);
        for (int i = tid; i < 2048; i += NTHREADS) { const float l0 = a.in[I_HGLB][i], l1 = a.in[I_HGLB][2048 + i]; lbv[i] = 1.0f / (1.0f + __expf(l1 - l0)); }
    }
    LAS unsigned* scr = (LAS unsigned*)(lds + 59392 + wave * 8320);
#define P0_ITEM(i) p0_item(a, (i))
    const int nfast = ((int)gridDim.x > 192) ? ((int)gridDim.x - 192) * 8 : 0, nextra = nfast * 3, n1 = P0_NITEMS - nextra;
    TR_LOOP(gw, NGW, n1, P0_ITEM);
    if (blockIdx.x >= 192) { TR_LOOP(n1 + (gw - 192 * 8), nfast, P0_NITEMS, P0_ITEM); }
#undef P0_ITEM
}

__device__ __forceinline__ const float* hin_row(const Args& a, int row) { return row < NCTX ? a.in[I_CTX] + (size_t)row * D : a.in[I_X] + (size_t)(row - NCTX) * D; }
__device__ __forceinline__ int mod_row(int row) { return row < NCTX ? 8 : ((row - NCTX) >> 12); }
__device__ __forceinline__ float row_rstd(const f32x4 (&v)[4]) {
    float s = 0.f;
#pragma unroll
    for (int j = 0; j < 4; ++j) s += (v[j][0] * v[j][0] + v[j][1] * v[j][1]) + (v[j][2] * v[j][2] + v[j][3] * v[j][3]);
    return 1.0f / sqrtf(wave_sum(s) * (1.0f / D) + EPS);
}
struct ModVec { f32x4 g[4], sc[4], sh[4]; };
__device__ __forceinline__ void modvec_load(ModVec& m, const float* g, const float* sc, const float* sh, int lane) {
#pragma unroll
    for (int j = 0; j < 4; ++j) { const int c = 4 * lane + 256 * j; m.g[j] = *(const f32x4*)(g + c); m.sc[j] = *(const f32x4*)(sc + c); m.sh[j] = *(const f32x4*)(sh + c); }
}
__device__ __forceinline__ void norm_mod_store(const f32x4 (&v)[4], float rstd, const ModVec& m, bf16_t* orow, int lane) {
#pragma unroll
    for (int j = 0; j < 4; ++j) st_bf16x4(orow + 4 * lane + 256 * j, v[j] * rstd * m.g[j] * (m.sc[j] + 1.0f) + m.sh[j]);
}

__device__ __forceinline__ void p1_phase(const Args& a, int lane, int gw, int NGW) {
    const float* modv = (const float*)(a.ws + WS_MODV);
    bf16_t* A = (bf16_t*)(a.ws + WS_A);
    for (int row0 = gw * 4; row0 < NTOK; row0 += NGW * 4) {
        f32x4 v[4][4];
#pragma unroll
        for (int r = 0; r < 4; ++r) { const float* hr = hin_row(a, row0 + r);
#pragma unroll
            for (int j = 0; j < 4; ++j) v[r][j] = *(const f32x4*)(hr + 4 * lane + 256 * j); }
        const float* mv = modv + (size_t)mod_row(row0) * 6144;
        ModVec m; modvec_load(m, a.in[I_N1G], mv + 1024, mv, lane);
#pragma unroll
        for (int r = 0; r < 4; ++r) { const float rstd = row_rstd(v[r]); norm_mod_store(v[r], rstd, m, A + (size_t)(row0 + r) * D, lane); }
    }
}

__device__ __forceinline__ int gla_row(int n, int t, int b, int dir) {
    const bool isctx = n < 4; const int cn = isctx ? n : n - 4, slen = isctx ? CTXL : SEQ, rbase = isctx ? b * CTXL : NCTX + b * SEQ;
    const int pos = cn * 64 + t; return rbase + (dir ? slen - 1 - pos : pos);
}
__device__ __forceinline__ void gla_phase(const Args& a, LAS unsigned char* lds, int tid) {
    const int lane = tid & 63, wave = tid >> 6, fr = lane & 15, fq = lane >> 4;
    LAS unsigned char* QS = lds;
    LAS unsigned char* KS = lds + 17408;
    LAS unsigned char* QIN = lds + 34816;
    LAS unsigned char* KOT = lds + 52224;
    LAS unsigned char* VT = lds + 70656;
    LAS unsigned char* ST0 = lds + 79872;
    LAS unsigned char* PPW = lds + 114688 + wave * 2304;
    LAS float* GT0 = (LAS float*)(lds + 133120);
    LAS float* BL = (LAS float*)(lds + 141312);
    const bf16_t* Qg = (const bf16_t*)(a.ws + WS_Q); const bf16_t* Vg = (const bf16_t*)(a.ws + WS_V);
    for (int item = blockIdx.x; item < 256; item += gridDim.x) {
        const int vs = item & 1, dir = (item >> 1) & 1, h = (item >> 2) & 7, b = item >> 5;
        const _Float16* LF = (const _Float16*)(a.ws + (dir ? WS_LFB : WS_LFF)); bf16_t* Og = (bf16_t*)(a.ws + (dir ? WS_OB : WS_OF));
        f32x4 Sacc[4];
#pragma unroll
        for (int i = 0; i < 4; ++i) Sacc[i] = (f32x4){0.f, 0.f, 0.f, 0.f};
        for (int i = tid; i < 2 * 17408 / 4; i += NTHREADS) ((LAS unsigned*)ST0)[i] = 0u;
        const int kc2 = (tid & 63) * 2, tg = tid >> 6, chq = h * 128 + kc2;
        const int vt_t = tid & 63, vt_v8 = (tid >> 6) * 8;
        unsigned lf2[8], q2[8]; u32x4 vv;
#define GLA_LOAD(n_) do { _Pragma("unroll") for (int i = 0; i < 8; ++i) { const size_t o = (size_t)gla_row(n_, tg * 8 + i, b, dir) * D + chq; lf2[i] = *(const unsigned*)(LF + o); q2[i] = *(const unsigned*)(Qg + o); } \
            vv = *(const u32x4*)(Vg + (size_t)gla_row(n_, vt_t, b, dir) * D + h * 128 + vs * 64 + vt_v8); } while (0)
        float fa[8], fb[8], bca[8], bcb[8];
#define GLA_CUMSUM(par_) do { float csa = 0.f, csb = 0.f; _Pragma("unroll") for (int i = 0; i < 8; ++i) { typedef _Float16 h2 __attribute__((ext_vector_type(2))); const h2 hv = __builtin_bit_cast(h2, lf2[i]); \
            const float la = (float)hv[0], lb_ = (float)hv[1]; fa[i] = __expf(la); fb[i] = __expf(lb_); csa += la; csb += lb_; bca[i] = csa; bcb[i] = csb; } \
            *(LAS f32x2*)(GT0 + (par_) * 1024 + tg * 128 + kc2) = (f32x2){csa, csb}; } while (0)
        GLA_LOAD(0);
        GLA_CUMSUM(0);
        __syncthreads();
        for (int n = 0; n < 68; ++n) {
            const int par = n & 1;
            LAS unsigned char* STc = ST0 + par * 17408; LAS unsigned char* STn = ST0 + (par ^ 1) * 17408;
            { const unsigned w[4] = {vv.x, vv.y, vv.z, vv.w};
#pragma unroll
              for (int i = 0; i < 4; ++i) { *(LAS bf16_t*)(VT + (vt_v8 + 2 * i) * 144 + vt_t * 2) = (bf16_t)(w[i] & 0xffffu); *(LAS bf16_t*)(VT + (vt_v8 + 2 * i + 1) * 144 + vt_t * 2) = (bf16_t)(w[i] >> 16); } }
#define GLA_OSTORE(n_) do { const u32x4 od = *(const LAS u32x4*)(PPW + (lane >> 2) * 144 + (lane & 3) * 16); \
                *(u32x4*)(Og + (size_t)gla_row(n_, (wave >> 1) * 16 + (lane >> 2), b, dir) * D + h * 128 + vs * 64 + (wave & 1) * 32 + (lane & 3) * 8) = od; } while (0)
            if (n > 0) GLA_OSTORE(n - 1);
            f32x2 pre = (f32x2){0.f, 0.f}, bref = (f32x2){0.f, 0.f}, blast = (f32x2){0.f, 0.f};
#pragma unroll
            for (int g8 = 0; g8 < 8; ++g8) { const f32x2 gv = *(const LAS f32x2*)(GT0 + par * 1024 + g8 * 128 + kc2); if (g8 < tg) pre += gv; if (g8 < 4) bref += gv; blast += gv; }
            const float era = __expf(bref.x), erb = __expf(bref.y), ela = __expf(blast.x - bref.x), elb = __expf(blast.y - bref.y);
            float e1a = __expf(pre.x - bref.x), e1b = __expf(pre.y - bref.y);
            unsigned kota[4], kotb[4];
#pragma unroll
            for (int i = 0; i < 8; ++i) {
                const int t = tg * 8 + i;
                const float qa = bflo(q2[i]), qb = bfhi(q2[i]);
                e1a *= fa[i]; e1b *= fb[i];
                const float ka = 1.0f - fa[i], kb = 1.0f - fb[i];
                const float e2a = __builtin_amdgcn_rcpf(e1a), e2b = __builtin_amdgcn_rcpf(e1b);
                const float qsa = qa * e1a, qsb = qb * e1b, ksa = ka * e2a, ksb = kb * e2b;
                *(LAS unsigned*)(QS + t * 272 + kc2 * 2) = cvt_pk_bf16(qsa, qsb);
                *(LAS unsigned*)(KS + t * 272 + kc2 * 2) = cvt_pk_bf16(ksa, ksb);
                *(LAS unsigned*)(QIN + t * 272 + kc2 * 2) = cvt_pk_bf16(qsa * era, qsb * erb);
                const unsigned ko = cvt_pk_bf16(ksa * ela, ksb * elb);
                if (i & 1) { kota[i >> 1] |= ko << 16; kotb[i >> 1] |= ko & 0xffff0000u; } else { kota[i >> 1] = ko & 0xffffu; kotb[i >> 1] = ko >> 16; }
            }
            { const int rot = ((kc2 >> 4) + tg) & 7;
              *(LAS u32x4*)(KOT + kc2 * 144 + rot * 16) = (u32x4){kota[0], kota[1], kota[2], kota[3]};
              *(LAS u32x4*)(KOT + (kc2 + 1) * 144 + rot * 16) = (u32x4){kotb[0], kotb[1], kotb[2], kotb[3]}; }
            if (tg == 0) *(LAS f32x2*)(BL + kc2) = (f32x2){__expf(blast.x), __expf(blast.y)};
            if (n + 1 < 68) GLA_LOAD(n + 1);
            __syncthreads();
            const int tt = wave >> 1;
            bf16x8 aq[4];
#pragma unroll
            for (int kk = 0; kk < 4; ++kk) aq[kk] = *(const LAS bf16x8*)(QS + (tt * 16 + fr) * 272 + (kk * 32 + fq * 8) * 2);
#pragma unroll
            for (int st = 0; st < 4; ++st) {
                f32x4 acc = (f32x4){0.f, 0.f, 0.f, 0.f};
                if (st <= tt) {
#pragma unroll
                    for (int kk = 0; kk < 4; ++kk) {
                        const bf16x8 bv = *(const LAS bf16x8*)(KS + (st * 16 + fr) * 272 + (kk * 32 + fq * 8) * 2);
                        acc = __builtin_amdgcn_mfma_f32_16x16x32_bf16(aq[kk], bv, acc, 0, 0, 0);
                    }
                }
#pragma unroll
                for (int j = 0; j < 4; ++j) { const int tl = fq * 4 + j, s = st * 16 + fr; *(LAS bf16_t*)(PPW + tl * 144 + s * 2) = (bf16_t)f2bf(s <= tt * 16 + tl ? acc[j] : 0.f); }
            }
            LDS_WAIT();
            unsigned ow[2][2];
            bf16x8 ap[2], ai[4];
#pragma unroll
            for (int kk = 0; kk < 2; ++kk) ap[kk] = *(const LAS bf16x8*)(PPW + fr * 144 + (kk * 32 + fq * 8) * 2);
#pragma unroll
            for (int kk = 0; kk < 4; ++kk) ai[kk] = *(const LAS bf16x8*)(QIN + (tt * 16 + fr) * 272 + (kk * 32 + fq * 8) * 2);
#pragma unroll
            for (int vti = 0; vti < 2; ++vti) {
                const int vt = 2 * (wave & 1) + vti; f32x4 acc = (f32x4){0.f, 0.f, 0.f, 0.f};
#pragma unroll
                for (int kk = 0; kk < 2; ++kk) {
                    const bf16x8 bv = *(const LAS bf16x8*)(VT + (vt * 16 + fr) * 144 + (kk * 32 + fq * 8) * 2);
                    acc = __builtin_amdgcn_mfma_f32_16x16x32_bf16(ap[kk], bv, acc, 0, 0, 0);
                }
#pragma unroll
                for (int kk = 0; kk < 4; ++kk) {
                    const bf16x8 bv = *(const LAS bf16x8*)(STc + (vt * 16 + fr) * 272 + (kk * 32 + fq * 8) * 2);
                    acc = __builtin_amdgcn_mfma_f32_16x16x32_bf16(ai[kk], bv, acc, 0, 0, 0);
                }
                ow[vti][0] = cvt_pk_bf16(acc[0], acc[1]); ow[vti][1] = cvt_pk_bf16(acc[2], acc[3]);
            }
#pragma unroll
            for (int vti = 0; vti < 2; ++vti)
#pragma unroll
                for (int j = 0; j < 4; ++j) { const unsigned w = ow[vti][j >> 1]; *(LAS bf16_t*)(PPW + (fq * 4 + j) * 144 + (vti * 16 + fr) * 2) = (bf16_t)((j & 1) ? (w >> 16) : (w & 0xffffu)); }
            bf16x8 ak[2]; const f32x4 blv = *(const LAS f32x4*)(BL + wave * 16 + fq * 4);
#pragma unroll
            for (int kk = 0; kk < 2; ++kk) ak[kk] = *(const LAS bf16x8*)(KOT + (wave * 16 + fr) * 144 + (((kk * 4 + fq) + wave) & 7) * 16);
#pragma unroll
            for (int vt = 0; vt < 4; ++vt) {
                Sacc[vt] *= blv;
#pragma unroll
                for (int kk = 0; kk < 2; ++kk) {
                    const bf16x8 bv = *(const LAS bf16x8*)(VT + (vt * 16 + fr) * 144 + (kk * 32 + fq * 8) * 2);
                    Sacc[vt] = __builtin_amdgcn_mfma_f32_16x16x32_bf16(ak[kk], bv, Sacc[vt], 0, 0, 0);
                }
                *(LAS u32x2*)(STn + (vt * 16 + fr) * 272 + (wave * 16 + fq * 4) * 2) = (u32x2){pk2(Sacc[vt][0], Sacc[vt][1]), pk2(Sacc[vt][2], Sacc[vt][3])};
            }
            if (n + 1 < 68) GLA_CUMSUM(par ^ 1);
            __syncthreads();
        }
        GLA_OSTORE(67);
    }
}
#undef GLA_OSTORE
#undef GLA_CUMSUM
#undef GLA_LOAD
__device__ __forceinline__ void gla_readout_phase(const Args& a, int lane, int gw, int NGW) {
    const bf16_t* OF = (const bf16_t*)(a.ws + WS_OF); const bf16_t* OB = (const bf16_t*)(a.ws + WS_OB);
    const bf16_t* G = (const bf16_t*)(a.ws + WS_G); bf16_t* OG = (bf16_t*)(a.ws + WS_OG);
    f32x4 ng[4];
#pragma unroll
    for (int j = 0; j < 4; ++j) ng[j] = *(const f32x4*)(a.in[I_HGNG] + 16 * lane + 4 * j);
    for (int row0 = gw * 4; row0 < NTOK; row0 += NGW * 4) {
        u32x4 of[4][2], ob[4][2], gg[4][2];
#pragma unroll
        for (int r = 0; r < 4; ++r) { const size_t o = (size_t)(row0 + r) * D + 16 * lane;
            of[r][0] = *(const u32x4*)(OF + o); of[r][1] = *(const u32x4*)(OF + o + 8); ob[r][0] = *(const u32x4*)(OB + o); ob[r][1] = *(const u32x4*)(OB + o + 8);
            gg[r][0] = *(const u32x4*)(G + o); gg[r][1] = *(const u32x4*)(G + o + 8); }
#pragma unroll
        for (int r = 0; r < 4; ++r) {
            float v[16]; float s = 0.f;
#pragma unroll
            for (int q = 0; q < 8; ++q) { const unsigned wf = of[r][q >> 2][q & 3], wb = ob[r][q >> 2][q & 3]; v[2 * q] = bflo(wf) + bflo(wb); v[2 * q + 1] = bfhi(wf) + bfhi(wb); s += v[2 * q] * v[2 * q] + v[2 * q + 1] * v[2 * q + 1]; }
            s += __shfl_xor(s, 1); s += __shfl_xor(s, 2); s += __shfl_xor(s, 4);
            const float rstd = 1.0f / sqrtf(s * (1.0f / 128.0f) + EPS);
            unsigned ow[8];
#pragma unroll
            for (int q = 0; q < 8; ++q) { const unsigned wg = gg[r][q >> 2][q & 3];
                ow[q] = pk2(v[2 * q] * rstd * ng[q >> 1][(2 * q) & 3] * silu_f(bflo(wg)), v[2 * q + 1] * rstd * ng[q >> 1][(2 * q + 1) & 3] * silu_f(bfhi(wg))); }
            const size_t o = (size_t)(row0 + r) * D + 16 * lane;
            *(u32x4*)(OG + o) = (u32x4){ow[0], ow[1], ow[2], ow[3]}; *(u32x4*)(OG + o + 8) = (u32x4){ow[4], ow[5], ow[6], ow[7]};
        }
    }
}

struct EpiMoe1 {
    static constexpr bool PERM = true;
    const float* b1; bf16_t* ACT;
    __device__ __forceinline__ void operator()(const f32x4 (&acc)[2][2][4][2], const Unit& u, int wr, int wc, int fr, int fq) const {
        const int e = u.pn >> 3, pnl = u.pn & 7, cb = pnl * 128 + wc * 32 + 8 * fq, row0 = u.pm * 256 + wr * 64 + fr;
        const float* bg = b1 + (size_t)e * 2048;
        const f32x4 bg0 = *(const f32x4*)(bg + cb), bg1 = *(const f32x4*)(bg + cb + 4), bl0 = *(const f32x4*)(bg + 1024 + cb), bl1 = *(const f32x4*)(bg + 1024 + cb + 4);
#pragma unroll
        for (int ai = 0; ai < 2; ++ai)
#pragma unroll
            for (int m = 0; m < 4; ++m) {
                f32x4 o[2];
#pragma unroll
                for (int n = 0; n < 2; ++n) {
                    const f32x4 zg = acc[ai][0][m][n] + (n ? bg1 : bg0), zl = acc[ai][1][m][n] + (n ? bl1 : bl0);
#pragma unroll
                    for (int j = 0; j < 4; ++j) { const float g_ = fminf(zg[j], 7.0f), l_ = fminf(fmaxf(zl[j], -7.0f), 7.0f); o[n][j] = g_ * sigmoid_f(1.702f * g_) * (l_ + 1.0f); }
                }
                *(u32x4*)(ACT + (size_t)(row0 + ai * 128 + m * 16) * D + cb) = (u32x4){pk2(o[0][0], o[0][1]), pk2(o[0][2], o[0][3]), pk2(o[1][0], o[1][1]), pk2(o[1][2], o[1][3])};
            }
    }
};
struct EpiMoe2 {
    static constexpr bool PERM = true;
    const float* b2; bf16_t* YS;
    __device__ __forceinline__ void operator()(const f32x4 (&acc)[2][2][4][2], const Unit& u, int wr, int wc, int fr, int fq) const {
        const int e = u.pn >> 2, pnl = u.pn & 3, cb = pnl * 256 + wc * 32 + 8 * fq, row0 = u.pm * 256 + wr * 64 + fr;
        const float* bb = b2 + (size_t)e * 1024;
#pragma unroll
        for (int bj = 0; bj < 2; ++bj) {
            const int c = cb + bj * 128; const f32x4 bv0 = *(const f32x4*)(bb + c), bv1 = *(const f32x4*)(bb + c + 4);
#pragma unroll
            for (int ai = 0; ai < 2; ++ai)
#pragma unroll
                for (int m = 0; m < 4; ++m) {
                    const f32x4 v0 = acc[ai][bj][m][0] + bv0, v1 = acc[ai][bj][m][1] + bv1;
                    *(u32x4*)(YS + (size_t)(row0 + ai * 128 + m * 16) * D + c) = (u32x4){pk2(v0[0], v0[1]), pk2(v0[2], v0[3]), pk2(v1[0], v1[1]), pk2(v1[2], v1[3])};
                }
        }
    }
};

__device__ __forceinline__ void router_phase(const Args& a, LAS unsigned char* lds, int layer, int row_lo, int tid) {
    const int lane = tid & 63, wave = tid >> 6, fr = lane & 15, fq = lane >> 4;
    const bf16_t* H = (const bf16_t*)(a.ws + WS_H); bf16_t* F = (bf16_t*)(a.ws + WS_F);
    const float* modv = (const float*)(a.ws + WS_MODV) + (size_t)layer * 9 * 6144;
    int* TOKE = (int*)(a.ws + WS_TOKE); float* TOKW = (float*)(a.ws + WS_TOKW);
    unsigned* cntb = (unsigned*)(a.ws + WS_CTL) + CW_CNTB + layer * 8192;
    LAS unsigned char* FH = lds;
    LAS unsigned char* FL = lds + 16 * 2064;
    LAS float* PART = (LAS float*)(lds + 2 * 16 * 2064);
    LAS int* hist = (LAS int*)(lds + 2 * 16 * 2064 + 16384);
    if (tid < 32) hist[tid] = 0;
    const float* n2g = a.in[I_N2G] + layer * D; const float* rw = a.in[I_RW] + (size_t)layer * D * NE; const float* rb = a.in[I_RB] + layer * NE;
    const float* rwp = rw + (size_t)(wave * 128 + fq * 8) * NE + fr;
    bf16x8 rwH[2][4], rwL[2][4];
#pragma unroll
    for (int kk = 0; kk < 4; ++kk) {
#pragma unroll
        for (int et = 0; et < 2; ++et)
#pragma unroll
            for (int j = 0; j < 8; ++j) {
                const float w = rwp[kk * 32 * NE + j * NE + et * 16];
                const unsigned h = f2bf(w); const float lo = w - bf2f((unsigned short)h);
                rwH[et][kk][j] = (short)h; rwL[et][kk][j] = (short)f2bf(lo);
            }
        asm volatile("" ::: "memory");
    }
    const int ngroups = (NTOK - row_lo) >> 4;
    u32x2 vvp[2][4]; f32x4 gvv[4], scvv[4], shvv[4];
#pragma unroll
    for (int j = 0; j < 4; ++j) gvv[j] = *(const f32x4*)(n2g + 4 * lane + 256 * j);
#define RT_LOAD(gi_) do { _Pragma("unroll") for (int rr = 0; rr < 2; ++rr) _Pragma("unroll") for (int j = 0; j < 4; ++j) \
        vvp[rr][j] = *(const u32x2*)(H + (size_t)(row_lo + (gi_) * 16 + 2 * wave + rr) * D + 4 * lane + 256 * j); \
        { const float* mvp_ = modv + (size_t)mod_row(row_lo + (gi_) * 16) * 6144; _Pragma("unroll") for (int j = 0; j < 4; ++j) { scvv[j] = *(const f32x4*)(mvp_ + 4096 + 4 * lane + 256 * j); shvv[j] = *(const f32x4*)(mvp_ + 3072 + 4 * lane + 256 * j); } } } while (0)
    if ((int)blockIdx.x < ngroups) RT_LOAD(blockIdx.x);
    int pend_i = 0; float pend_w = 0.f; long pend_o = -1;
    for (int gi = blockIdx.x; gi < ngroups; gi += gridDim.x) {
        const int row0 = row_lo + gi * 16;
        __syncthreads();
#pragma unroll
        for (int rr = 0; rr < 2; ++rr) {
            const int rl = 2 * wave + rr, row = row0 + rl; f32x4 v[4];
#pragma unroll
            for (int j = 0; j < 4; ++j) { const u32x2 w = vvp[rr][j]; v[j] = (f32x4){bflo(w.x), bfhi(w.x), bflo(w.y), bfhi(w.y)}; }
            const float rstd = row_rstd(v);
#pragma unroll
            for (int j = 0; j < 4; ++j) {
                const int c = 4 * lane + 256 * j;
                const f32x4 f = v[j] * rstd * gvv[j] * (scvv[j] + 1.0f) + shvv[j];
                st_bf16x4(F + (size_t)row * D + c, f);
                { const unsigned h01 = cvt_pk_bf16(f[0], f[1]), h23 = cvt_pk_bf16(f[2], f[3]);
                  *(LAS u32x2*)(FH + rl * 2064 + c * 2) = (u32x2){h01, h23};
                  *(LAS u32x2*)(FL + rl * 2064 + c * 2) = (u32x2){cvt_pk_bf16(f[0] - bflo(h01), f[1] - bfhi(h01)), cvt_pk_bf16(f[2] - bflo(h23), f[3] - bfhi(h23))}; }
            }
        }
        if (pend_o >= 0) { TOKE[pend_o] = pend_i; TOKW[pend_o] = pend_w; pend_o = -1; }
        if (gi + (int)gridDim.x < ngroups) RT_LOAD(gi + gridDim.x);
        __syncthreads();
        f32x4 acc0 = (f32x4){0.f, 0.f, 0.f, 0.f}, acc1 = (f32x4){0.f, 0.f, 0.f, 0.f};
        bf16x8 aH[4], aL[4];
#pragma unroll
        for (int kk = 0; kk < 4; ++kk) { aH[kk] = *(const LAS bf16x8*)(FH + fr * 2064 + (wave * 128 + kk * 32 + fq * 8) * 2); aL[kk] = *(const LAS bf16x8*)(FL + fr * 2064 + (wave * 128 + kk * 32 + fq * 8) * 2); }
#pragma unroll
        for (int kk = 0; kk < 4; ++kk) {
            acc0 = __builtin_amdgcn_mfma_f32_16x16x32_bf16(aL[kk], rwH[0][kk], acc0, 0, 0, 0); acc1 = __builtin_amdgcn_mfma_f32_16x16x32_bf16(aL[kk], rwH[1][kk], acc1, 0, 0, 0);
            acc0 = __builtin_amdgcn_mfma_f32_16x16x32_bf16(aH[kk], rwL[0][kk], acc0, 0, 0, 0); acc1 = __builtin_amdgcn_mfma_f32_16x16x32_bf16(aH[kk], rwL[1][kk], acc1, 0, 0, 0);
            acc0 = __builtin_amdgcn_mfma_f32_16x16x32_bf16(aH[kk], rwH[0][kk], acc0, 0, 0, 0); acc1 = __builtin_amdgcn_mfma_f32_16x16x32_bf16(aH[kk], rwH[1][kk], acc1, 0, 0, 0);
        }
#pragma unroll
        for (int j = 0; j < 4; ++j) { PART[(wave * 16 + fq * 4 + j) * 32 + fr] = acc0[j]; PART[(wave * 16 + fq * 4 + j) * 32 + 16 + fr] = acc1[j]; }
        __syncthreads();
        {
            const int half = lane >> 5, e = lane & 31, rl = 2 * wave + half, row = row0 + rl;
            float lg = rb[e];
#pragma unroll
            for (int w = 0; w < 8; ++w) lg += PART[(w * 16 + rl) * 32 + e];
            float sv[4]; int si[4];
#pragma unroll
            for (int r = 0; r < 4; ++r) {
                float m = lg;
#pragma unroll
                for (int o = 1; o < 32; o <<= 1) m = fmaxf(m, __shfl_xor(m, o));
                const unsigned long long bal = __ballot(lg == m); const unsigned mine = (unsigned)(bal >> (32 * half));
                const int idx = __ffs((int)mine) - 1;
                sv[r] = m; si[r] = idx; if (e == idx) lg = -3.0e38f;
            }
            const float e1 = __expf(sv[1] - sv[0]), e2 = __expf(sv[2] - sv[0]), e3 = __expf(sv[3] - sv[0]); const float inv = 1.0f / (1.0f + e1 + e2 + e3);
            if (e < 4) {
                const int myi = e == 0 ? si[0] : (e == 1 ? si[1] : (e == 2 ? si[2] : si[3]));
                const float myw = (e == 0 ? 1.0f : (e == 1 ? e1 : (e == 2 ? e2 : e3))) * inv;
                pend_i = myi; pend_w = myw; pend_o = (long)row * 4 + e;
                atomicAdd((int*)hist + myi, 1);
            }
        }
    }
    if (pend_o >= 0) { TOKE[pend_o] = pend_i; TOKW[pend_o] = pend_w; }
    __syncthreads();
    if (tid < 32) cntb[(size_t)blockIdx.x * 32 + tid] = (unsigned)hist[tid];
}
#undef RT_LOAD
__device__ __forceinline__ void assign_phase(const Args& a, LAS unsigned char* lds, int layer, int row_lo, int tid) {
    const int lane = tid & 63, wave = tid >> 6;
    const unsigned* cntb = (const unsigned*)(a.ws + WS_CTL) + CW_CNTB + layer * 8192; unsigned* gcnt = (unsigned*)(a.ws + WS_CTL) + CW_CNT + layer * 64;
    const bf16_t* F = (const bf16_t*)(a.ws + WS_F); bf16_t* AG = (bf16_t*)(a.ws + WS_AG);
    const int* TOKE = (const int*)(a.ws + WS_TOKE); int* TOKS = (int*)(a.ws + WS_TOKS);
    LAS int* off = (LAS int*)lds; LAS int* cnt = (LAS int*)(lds + 256); LAS int* base = (LAS int*)(lds + 512); LAS int* cur = (LAS int*)(lds + 768);
    LAS int* pa = (LAS int*)(lds + 1024); LAS int* pl = (LAS int*)(lds + 1024 + 2048);
    {
        const int e = tid & 31, part = tid >> 5; int s_all = 0, s_lt = 0;
        for (int bb = part; bb < (int)gridDim.x; bb += 16) { const int c = (int)cntb[(size_t)bb * 32 + e]; s_all += c; if (bb < (int)blockIdx.x) s_lt += c; }
        pa[part * 32 + e] = s_all; pl[part * 32 + e] = s_lt;
    }
    __syncthreads();
    if (tid < 32) { int s_all = 0, s_lt = 0; for (int p = 0; p < 16; ++p) { s_all += pa[p * 32 + tid]; s_lt += pl[p * 32 + tid]; } cnt[tid] = s_all; base[tid] = s_lt; cur[tid] = 0; if (blockIdx.x == 0) gcnt[tid] = (unsigned)s_all; }
    __syncthreads();
    if (tid == 0) { int o = 0; for (int e = 0; e < 32; ++e) { off[e] = o; o += ((cnt[e] + 255) >> 8) << 8; } }
    __syncthreads();
    if (tid < 32) base[tid] += off[tid];
    __syncthreads();
    const int gw = blockIdx.x * 8 + wave, NGW = gridDim.x * 8;
    int* SLOTTOK = (int*)(a.ws + WS_SLOTTOK);
    for (int idx = blockIdx.x * NTHREADS + tid; idx < 32 * 256; idx += gridDim.x * NTHREADS) {
        const int e = idx >> 8, c = cnt[e], r = c + (idx & 255), padded = ((c + 255) >> 8) << 8;
        if (r < padded) SLOTTOK[off[e] + r] = 0;
    }
    const int ngroups = (NTOK - row_lo) >> 4;
    for (int gi = blockIdx.x; gi < ngroups; gi += gridDim.x) {
        const int r0 = row_lo + gi * 16 + 2 * wave;
        if (lane < 8) { const int e = TOKE[(size_t)r0 * 4 + lane]; const int pos = atomicAdd((int*)cur + e, 1); const int slot = base[e] + pos; TOKS[(size_t)r0 * 4 + lane] = slot; SLOTTOK[slot] = r0 + (lane >> 2); }
    }
    (void)gw; (void)NGW; (void)F; (void)AG;
}
__device__ __forceinline__ int moe_tiles(const Args& a, LAS unsigned char* lds, int layer, int tid) {
    const unsigned* gcnt = (const unsigned*)(a.ws + WS_CTL) + CW_CNT + layer * 64;
    LAS int* tbl = (LAS int*)(lds + 131072 + 1024);
    if (tid == 0) { int t = 0; for (int e = 0; e < 32; ++e) { const int nt = ((int)gcnt[e] + 255) >> 8; for (int k = 0; k < nt; ++k) tbl[t++] = e; } tbl[1000] = t; }
    __syncthreads();
    return tbl[1000];
}
__device__ __forceinline__ void combine_phase(const Args& a, int layer, int row_lo, int lane, int gw, int NGW) {
    bf16_t* H = (bf16_t*)(a.ws + WS_H); const bf16_t* YS = (const bf16_t*)(a.ws + WS_YS);
    const int* TOKS = (const int*)(a.ws + WS_TOKS); const float* TOKW = (const float*)(a.ws + WS_TOKW);
    const float* modv = (const float*)(a.ws + WS_MODV);
    for (int row0 = row_lo + gw * 2; row0 < NTOK; row0 += NGW * 2) {
        const int mr = mod_row(row0);
        u32x4 sl[2]; f32x4 wv[2];
#pragma unroll
        for (int r = 0; r < 2; ++r) { sl[r] = *(const u32x4*)(TOKS + (size_t)(row0 + r) * 4); wv[r] = *(const f32x4*)(TOKW + (size_t)(row0 + r) * 4); }
        u32x2 ys[2][4][4]; f32x4 hv[2][4];
#pragma unroll
        for (int r = 0; r < 2; ++r)
#pragma unroll
            for (int j = 0; j < 4; ++j) {
                hv[r][j] = ld_bf16x4(H + (size_t)(row0 + r) * D + 4 * lane + 256 * j);
#pragma unroll
                for (int k = 0; k < 4; ++k) ys[r][k][j] = *(const u32x2*)(YS + (size_t)sl[r][k] * D + 4 * lane + 256 * j);
            }
        const float* g2 = modv + (size_t)(layer * 9 + mr) * 6144 + 5120;
        f32x4 g2v[4];
#pragma unroll
        for (int j = 0; j < 4; ++j) g2v[j] = *(const f32x4*)(g2 + 4 * lane + 256 * j);
        ModVec m;
        if (layer == 0) { const float* mv = modv + (size_t)(9 + mr) * 6144; modvec_load(m, a.in[I_N1G] + D, mv + 1024, mv, lane); }
        else {
#pragma unroll
            for (int j = 0; j < 4; ++j) m.g[j] = *(const f32x4*)(a.in[I_FG] + 4 * lane + 256 * j);
        }
#pragma unroll
        for (int r = 0; r < 2; ++r) {
            const int row = row0 + r; f32x4 v[4];
#pragma unroll
            for (int j = 0; j < 4; ++j) {
                const int c = 4 * lane + 256 * j; f32x4 y = (f32x4){0.f, 0.f, 0.f, 0.f};
#pragma unroll
                for (int k = 0; k < 4; ++k) { const u32x2 w = ys[r][k][j]; y += (f32x4){bflo(w.x), bfhi(w.x), bflo(w.y), bfhi(w.y)} * wv[r][k]; }
                v[j] = hv[r][j] + g2v[j] * y;
                if (layer == 0) st_bf16x4(H + (size_t)row * D + c, v[j]);
            }
            const float rstd = row_rstd(v);
            if (layer == 0) {
                int orow = row;
                if (row >= NCTX) { const int li = row - NCTX, b = li >> 12, t = li & 4095; orow = NCTX + b * SEQ + (t & 63) * 64 + (t >> 6); }
                norm_mod_store(v, rstd, m, (bf16_t*)(a.ws + WS_A) + (size_t)orow * D, lane);
            } else {
#pragma unroll
                for (int j = 0; j < 4; ++j) { const int c = 4 * lane + 256 * j; *(f32x4*)(a.out + (size_t)(row - NCTX) * D + c) = v[j] * rstd * m.g[j]; }
            }
        }
    }
}
__device__ __forceinline__ void moe_gemm1(const Args& a, LAS unsigned char* lds, int layer, int tid, int G, int vcu) {
    unsigned char* ws = a.ws;
    const int TT = moe_tiles(a, lds, layer, tid);
    const LAS int* tbl = (const LAS int*)(lds + 131072 + 1024);
    pg8::Gemm g{(const bf16_t*)(ws + WS_F), (const bf16_t*)(ws + WS_W1) + (size_t)layer * 32 * 2048 * 1024, MPAD, 32 * 2048, 1024};
    pg8::MoeOrder S{tbl, TT, 3, G, vcu};
    EpiMoe1 E{a.in[I_B1] + (size_t)layer * 32 * 2048, (bf16_t*)(ws + WS_ACT)};
    LAS unsigned short* rowl = (LAS unsigned short*)(lds + 136192);
    { const int* slottok = (const int*)(ws + WS_SLOTTOK); pg8::Unit uu; int t2 = threadIdx.x; asm volatile("" : "+v"(t2)); const int tid = t2;
      for (int i = 0; i < 21; i += 2) { const int ii = i + (tid >> 8); if (ii < 21 && S.next(ii, uu)) rowl[ii * 256 + (tid & 255)] = (unsigned short)slottok[uu.pm * 256 + (tid & 255)]; } }
    __syncthreads();
    pg8::gemm_phase<EpiMoe1, pg8::MoeOrder, true>(lds, g, S, E, rowl);
}
__device__ __forceinline__ void moe_gemm2(const Args& a, LAS unsigned char* lds, int layer, int tid, int G, int vcu) {
    unsigned char* ws = a.ws;
    const int TT = moe_tiles(a, lds, layer, tid);
    const LAS int* tbl = (const LAS int*)(lds + 131072 + 1024);
    pg8::Gemm g{(const bf16_t*)(ws + WS_ACT), (const bf16_t*)(ws + WS_W2) + (size_t)layer * 32 * 1024 * 1024, MPAD, 32 * 1024, 1024};
    pg8::MoeOrder S{tbl, TT, 2, G, vcu};
    EpiMoe2 E{a.in[I_B2] + (size_t)layer * 32 * 1024, (bf16_t*)(ws + WS_YS)};
    pg8::gemm_phase<EpiMoe2, pg8::MoeOrder>(lds, g, S, E);
}


__device__ __forceinline__ void s5_disc(const Args& a, int d, int g, int p, float& ab_re, float& ab_im, float& co_re, float& co_im) {
    const float lam_re = fminf(a.in[I_S5ARE][(d * 64 + g) * 64 + p], -1e-4f), lam_im = a.in[I_S5AIM][(d * 64 + g) * 64 + p];
    const float dt = expf(a.in[I_S5LDT][d * 64 + g]);
    const float mag = expf(lam_re * dt), ang = lam_im * dt;
    ab_re = mag * cosf(ang); ab_im = mag * sinf(ang);
    const float den = lam_re * lam_re + lam_im * lam_im;
    co_re = ((ab_re - 1.0f) * lam_re + ab_im * lam_im) / den;
    co_im = (ab_im * lam_re - (ab_re - 1.0f) * lam_im) / den;
}
__device__ __forceinline__ void s5_phase(const Args& a, LAS unsigned char* lds, int tid) {
    const int lane = tid & 63, wave = tid >> 6, fr = lane & 15, fq = lane >> 4;
    if (wave >= 4) {
        LAS unsigned* scr = (LAS unsigned*)(lds + 102400 + (wave - 4) * 8320);
        const int cw = blockIdx.x * 4 + (wave - 4), NCW = gridDim.x * 4;
#define L1_ITEM(i) moe_item(a, (i), 1)
        TR_LOOP(cw, NCW, 32 * 512 + 32 * 256, L1_ITEM);
#undef L1_ITEM
        return;
    }
    LAS unsigned char* wl = lds + wave * 25600;
    const bf16_t* A1 = (const bf16_t*)(a.ws + WS_A);
    for (int item = blockIdx.x; item < 256; item += gridDim.x) {
        const int b = item >> 5, dir = (item >> 4) & 1, g = (item & 15) * 4 + wave;
        bf16_t* Y = (bf16_t*)(a.ws + (dir ? WS_YB : WS_YF));
        float ab_re, ab_im, cr_, ci_;
        s5_disc(a, dir, g, lane, ab_re, ab_im, cr_, ci_);
        bf16x8 Bd[8], Cf[4];
        {
            f32x4 cre[4], cim[4];
#pragma unroll
            for (int kk = 0; kk < 4; ++kk) { const size_t o = ((size_t)(dir * 64 + g) * 16 + fr) * 64 + kk * 16 + fq * 4; cre[kk] = *(const f32x4*)(a.in[I_S5CRE] + o); cim[kk] = *(const f32x4*)(a.in[I_S5CIM] + o); }
#pragma unroll
            for (int kk = 0; kk < 4; ++kk)
#pragma unroll
                for (int j = 0; j < 8; ++j) Cf[kk][j] = (short)f2bf((j & 1) ? -cim[kk][j >> 1] : cre[kk][j >> 1]);
#pragma unroll
            for (int hg = 0; hg < 2; ++hg) {
                f32x4 br0[4], br1[4], bi0[4], bi1[4];
#pragma unroll
                for (int q = 0; q < 4; ++q) {
                    const int pp = (hg * 4 + q) * 8 + (fr >> 1); const size_t o = (size_t)(g * 64 + pp) * 16 + (fq & 1) * 8;
                    br0[q] = *(const f32x4*)(a.in[I_S5BRE] + o); br1[q] = *(const f32x4*)(a.in[I_S5BRE] + o + 4); bi0[q] = *(const f32x4*)(a.in[I_S5BIM] + o); bi1[q] = *(const f32x4*)(a.in[I_S5BIM] + o + 4);
                }
#pragma unroll
                for (int q = 0; q < 4; ++q) {
                    const int pt = hg * 4 + q, pp = pt * 8 + (fr >> 1); const float qr = __shfl(cr_, pp), qi = __shfl(ci_, pp);
#pragma unroll
                    for (int j = 0; j < 8; ++j) {
                        const float br = j < 4 ? br0[q][j & 3] : br1[q][j & 3], bi = j < 4 ? bi0[q][j & 3] : bi1[q][j & 3];
                        float v = (fr & 1) ? (qr * bi + qi * br) : (qr * br - qi * bi);
                        if (fq >= 2) v = 0.f;
                        Bd[pt][j] = (short)f2bf(v);
                    }
                }
                asm volatile("" ::: "memory");
            }
        }
#define S5_POS(n_, t_) ((((n_) < 8) ? (n_) : (n_) - 8) * 32 + (t_))
#define S5_ROW(n_, t_) ((((n_) < 8) ? b * CTXL : NCTX + b * SEQ) + (dir ? (((n_) < 8) ? CTXL : SEQ) - 1 - S5_POS(n_, t_) : S5_POS(n_, t_)))
#define S5_LOADU(d0, d1, n_) do { d0 = (bf16x8){0, 0, 0, 0, 0, 0, 0, 0}; d1 = d0; if (fq < 2 && (n_) < 136) { d0 = *(const bf16x8*)(A1 + (size_t)S5_ROW(n_, fr) * D + g * 16 + fq * 8); d1 = *(const bf16x8*)(A1 + (size_t)S5_ROW(n_, 16 + fr) * D + g * 16 + fq * 8); } } while (0)
        LAS float* BUF = (LAS float*)wl; LAS unsigned* HW = (LAS unsigned*)(wl + 16896); const LAS unsigned char* HP = wl + 16896;
        bf16x8 ua0, ua1, ub0, ub1;
        S5_LOADU(ua0, ua1, 0);
        f32x2 s = (f32x2){0.f, 0.f};
        const f32x2 abr = (f32x2){ab_re, ab_re}, abi = (f32x2){-ab_im, ab_im};
        bf16_t* yp = Y + (size_t)(b * SEQ + (dir ? SEQ - 1 - fq * 4 : fq * 4)) * D + g * 16 + fr;
        const long ystep = dir ? -(long)D : (long)D;
        unsigned yw[4] = {0u, 0u, 0u, 0u};
#define S5_YSTORE() do { yp[0] = (bf16_t)(yw[0] & 0xffffu); yp[ystep] = (bf16_t)(yw[0] >> 16); yp[2 * ystep] = (bf16_t)(yw[1] & 0xffffu); yp[3 * ystep] = (bf16_t)(yw[1] >> 16); \
            yp[16 * ystep] = (bf16_t)(yw[2] & 0xffffu); yp[17 * ystep] = (bf16_t)(yw[2] >> 16); yp[18 * ystep] = (bf16_t)(yw[3] & 0xffffu); yp[19 * ystep] = (bf16_t)(yw[3] >> 16); yp += 32 * ystep; } while (0)
        for (int n = 0; n < 136; ++n) {
#pragma unroll
            for (int hf = 0; hf < 2; ++hf)
#pragma unroll
                for (int pt = 0; pt < 8; ++pt) {
                    const f32x4 z = (f32x4){0.f, 0.f, 0.f, 0.f};
                    const f32x4 d = __builtin_amdgcn_mfma_f32_16x16x32_bf16(hf ? ua1 : ua0, Bd[pt], z, 0, 0, 0);
#pragma unroll
                    for (int j = 0; j < 4; ++j) BUF[(hf * 16 + fq * 4 + j) * 132 + pt * 16 + fr] = d[j];
                }
            if (n >= 9) S5_YSTORE();
            S5_LOADU(ub0, ub1, n + 1);
            LDS_WAIT();
            {
                const bool hist = n >= 8;
                f32x2 bu[32];
#pragma unroll
                for (int j = 0; j < 32; ++j) bu[j] = *(const LAS f32x2*)(BUF + j * 132 + 2 * lane);
                unsigned hw[32];
#pragma unroll
                for (int j = 0; j < 32; ++j) { const f32x2 t1 = abr * s + bu[j]; s = abi * (f32x2){s.y, s.x} + t1; hw[j] = cvt_pk_bf16(s.x, s.y); }
                if (hist) {
#pragma unroll
                    for (int j = 0; j < 32; ++j) HW[j * 68 + lane] = hw[j];
                }
            }
            LDS_WAIT();
            if (n >= 8) {
                f32x4 y0 = (f32x4){0.f, 0.f, 0.f, 0.f}, y1 = (f32x4){0.f, 0.f, 0.f, 0.f};
                bf16x8 ha[2][4];
#pragma unroll
                for (int hf = 0; hf < 2; ++hf)
#pragma unroll
                    for (int kk = 0; kk < 4; ++kk) ha[hf][kk] = *(const LAS bf16x8*)(HP + (hf * 16 + fr) * 272 + (kk * 32 + fq * 8) * 2);
#pragma unroll
                for (int kk = 0; kk < 4; ++kk) { y0 = __builtin_amdgcn_mfma_f32_16x16x32_bf16(ha[0][kk], Cf[kk], y0, 0, 0, 0); y1 = __builtin_amdgcn_mfma_f32_16x16x32_bf16(ha[1][kk], Cf[kk], y1, 0, 0, 0); }
                yw[0] = cvt_pk_bf16(y0[0], y0[1]); yw[1] = cvt_pk_bf16(y0[2], y0[3]); yw[2] = cvt_pk_bf16(y1[0], y1[1]); yw[3] = cvt_pk_bf16(y1[2], y1[3]);
                LDS_WAIT();
            }
            ua0 = ub0; ua1 = ub1;
        }
        S5_YSTORE();
#undef S5_YSTORE
#undef S5_POS
#undef S5_ROW
#undef S5_LOADU
    }
}
__device__ __forceinline__ float gelu_tanh_f(float x) { const float z = 0.7978845608f * (x + 0.044715f * x * x * x); return x * (1.0f - __builtin_amdgcn_rcpf(1.0f + __expf(2.0f * z))); }
__device__ __forceinline__ void s5_post_phase(const Args& a, int lane, int gw, int NGW) {
    const bf16_t* YF = (const bf16_t*)(a.ws + WS_YF); const bf16_t* YB = (const bf16_t*)(a.ws + WS_YB);
    const bf16_t* A1 = (const bf16_t*)(a.ws + WS_A); bf16_t* YG = (bf16_t*)(a.ws + WS_YG);
    f32x4 dk[4];
#pragma unroll
    for (int j = 0; j < 4; ++j) dk[j] = *(const f32x4*)(a.in[I_S5D] + 4 * lane + 256 * j);
    for (int tok0 = gw * 4; tok0 < NLAT; tok0 += NGW * 4) {
        u32x2 yf[4][4], yb[4][4], uu[4][4];
#pragma unroll
        for (int r = 0; r < 4; ++r) { const int tok = tok0 + r, b = tok >> 12, t = tok & 4095, src = b * SEQ + (t & 63) * 64 + (t >> 6);
#pragma unroll
            for (int j = 0; j < 4; ++j) { const int c = 4 * lane + 256 * j; yf[r][j] = *(const u32x2*)(YF + (size_t)src * D + c); yb[r][j] = *(const u32x2*)(YB + (size_t)src * D + c); uu[r][j] = *(const u32x2*)(A1 + (size_t)(NCTX + src) * D + c); } }
#pragma unroll
        for (int r = 0; r < 4; ++r)
#pragma unroll
            for (int j = 0; j < 4; ++j) {
                const u32x2 f = yf[r][j], bk = yb[r][j], uw = uu[r][j];
                const f32x4 y = (f32x4){bflo(f.x) + bflo(bk.x), bfhi(f.x) + bfhi(bk.x), bflo(f.y) + bflo(bk.y), bfhi(f.y) + bfhi(bk.y)} + dk[j] * (f32x4){bflo(uw.x), bfhi(uw.x), bflo(uw.y), bfhi(uw.y)};
                f32x4 o;
#pragma unroll
                for (int i = 0; i < 4; ++i) o[i] = gelu_tanh_f(y[i]);
                st_bf16x4(YG + (size_t)(tok0 + r) * D + 4 * lane + 256 * j, o);
            }
    }
}
struct EpiGlu {
    static constexpr bool PERM = true;
    const float* bglu; const float* modv1; bf16_t* H;
    __device__ __forceinline__ void operator()(const f32x4 (&acc)[2][2][4][2], const Unit& u, int wr, int wc, int fr, int fq) const {
        const int rt0 = u.pm * 256, bidx = rt0 >> 12, cb = u.pn * 128 + wc * 32 + 8 * fq, rl0 = wr * 64 + fr;
        const float* gp = modv1 + bidx * 6144 + 2048;
        const f32x4 ba0 = *(const f32x4*)(bglu + cb), ba1 = *(const f32x4*)(bglu + cb + 4), bb0 = *(const f32x4*)(bglu + 1024 + cb), bb1 = *(const f32x4*)(bglu + 1024 + cb + 4);
        const f32x4 gv0 = *(const f32x4*)(gp + cb), gv1 = *(const f32x4*)(gp + cb + 4);
        u32x4 hws[2][4];
#pragma unroll
        for (int ai = 0; ai < 2; ++ai)
#pragma unroll
            for (int m = 0; m < 4; ++m) hws[ai][m] = *(const u32x4*)(H + (size_t)(NCTX + rt0 + rl0 + ai * 128 + m * 16) * D + cb);
#pragma unroll
        for (int ai = 0; ai < 2; ++ai)
#pragma unroll
            for (int m = 0; m < 4; ++m) {
                bf16_t* hp = H + (size_t)(NCTX + rt0 + rl0 + ai * 128 + m * 16) * D + cb;
                const u32x4 hw = hws[ai][m]; const f32x4 h0 = (f32x4){bflo(hw.x), bfhi(hw.x), bflo(hw.y), bfhi(hw.y)}, h1 = (f32x4){bflo(hw.z), bfhi(hw.z), bflo(hw.w), bfhi(hw.w)};
                const f32x4 za0 = acc[ai][0][m][0] + ba0, za1 = acc[ai][0][m][1] + ba1, zb0 = acc[ai][1][m][0] + bb0, zb1 = acc[ai][1][m][1] + bb1; f32x4 o0, o1;
#pragma unroll
                for (int j = 0; j < 4; ++j) { o0[j] = za0[j] * sigmoid_f(zb0[j]); o1[j] = za1[j] * sigmoid_f(zb1[j]); }
                const f32x4 r0 = h0 + gv0 * o0, r1 = h1 + gv1 * o1;
                *(u32x4*)hp = (u32x4){pk2(r0[0], r0[1]), pk2(r0[2], r0[3]), pk2(r1[0], r1[1]), pk2(r1[2], r1[3])};
            }
    }
};

#define XB_TMO      128
#define XB_XCNT(j)  (256  + 64 * (j))
#define XB_XSUB(j)  (1280 + 64 * (j))
#define XB_XGEN(j)  (2304 + 64 * (j))
#define XB_TOP      3328
#define XB_TOPGEN   3392
#define XCD_BAR_WORDS 3456
#define XB_SPIN_CAP (1u << 18)
__device__ __forceinline__ unsigned xb_ld(unsigned* p)              { return __hip_atomic_load(p, __ATOMIC_RELAXED, __HIP_MEMORY_SCOPE_AGENT); }
__device__ __forceinline__ unsigned xb_add(unsigned* p, unsigned v) { return __hip_atomic_fetch_add(p, v, __ATOMIC_RELAXED, __HIP_MEMORY_SCOPE_AGENT); }
__device__ __forceinline__ unsigned xb_xcc_id() { return (unsigned)__builtin_amdgcn_s_getreg((3 << 11) | 20) & 0xFu; }
#define XB_SPIN(cond, bar) do { unsigned _sp = 0; while (cond) { __builtin_amdgcn_s_sleep(1); \
    if ((++_sp & 255u) == 0u) { if (xb_ld(&(bar)[XB_TMO])) break; if (_sp > XB_SPIN_CAP) { atomicAdd(&(bar)[XB_TMO], 1u); break; } } } } while (0)
struct XcdBarrier { unsigned* bar; unsigned x; volatile LAS unsigned* st; };
__device__ __forceinline__ XcdBarrier xcd_barrier_post(unsigned* bar, volatile LAS unsigned* st) {
    XcdBarrier b; b.bar = bar; b.x = xb_xcc_id(); b.st = st;
    if (threadIdx.x == 0) (void)xb_add(&bar[XB_XCNT(b.x)], 1u);
    return b;
}
__device__ __forceinline__ void xcd_barrier_complete(unsigned* bar, unsigned x, unsigned& nloc, unsigned& nx) {
    const unsigned G = gridDim.x * gridDim.y * gridDim.z;
    unsigned sum, cnt, mine, sp = 0u;
    for (;;) {
        sum = 0u; cnt = 0u; mine = 0u;
#pragma unroll
        for (unsigned j = 0; j < 16; ++j) { const unsigned c = xb_ld(&bar[XB_XCNT(j)]); sum += c; cnt += (c > 0u) ? 1u : 0u; mine = (j == x) ? c : mine; }
        if (sum == G) break;
        __builtin_amdgcn_s_sleep(1);
        if ((++sp & 255u) == 0u) { if (xb_ld(&bar[XB_TMO])) break; if (sp > XB_SPIN_CAP) { atomicAdd(&bar[XB_TMO], 1u); break; } }
    }
    nloc = mine > 0u ? mine : 1u; nx = cnt > 0u ? cnt : 1u;
}
__device__ __forceinline__ void xcd_barrier(const XcdBarrier& b) {
    asm volatile("s_waitcnt vmcnt(0)" ::: "memory");
    __syncthreads();
    if (threadIdx.x == 0) {
        unsigned* bar = b.bar;
        __builtin_amdgcn_s_waitcnt(0);
        unsigned nloc = b.st[0], nx = b.st[1];
        if (nloc == 0u) { xcd_barrier_complete(bar, b.x, nloc, nx); b.st[0] = nloc; b.st[1] = nx; }
        const unsigned old = xb_add(&bar[XB_XSUB(b.x)], 1u);
        const unsigned gen = old / nloc;
        if (old + 1u == (gen + 1u) * nloc) {
            __builtin_amdgcn_fence(__ATOMIC_RELEASE, "agent");
            asm volatile("s_waitcnt vmcnt(0)" ::: "memory");
            const unsigned og = xb_add(&bar[XB_TOP], 1u);
            const unsigned tg = og / nx;
            if (og + 1u == (tg + 1u) * nx) xb_add(&bar[XB_TOPGEN], 1u);
            else XB_SPIN(xb_ld(&bar[XB_TOPGEN]) == tg, bar);
            __builtin_amdgcn_fence(__ATOMIC_ACQUIRE, "agent");
            xb_add(&bar[XB_XGEN(b.x)], 1u);
            asm volatile("s_waitcnt vmcnt(0)" ::: "memory");
        } else {
            XB_SPIN(xb_ld(&bar[XB_XGEN(b.x)]) == gen, bar);
            __builtin_amdgcn_fence(__ATOMIC_ACQUIRE, "agent");
            asm volatile("s_waitcnt vmcnt(0)" ::: "memory");
        }
    }
    __syncthreads();
}

__device__ __forceinline__ int opaque_tid() { int t = threadIdx.x; asm volatile("" : "+v"(t)); return t; }
#define PHASE_IDS() const int tid = opaque_tid(); const int lane = tid & 63, wave = tid >> 6; const int G = gridDim.x, gw = blockIdx.x * 8 + wave, NGW = G * 8; \
    const int vcu = (G % 8 == 0) ? (int)(blockIdx.x % 8) * (G / 8) + (int)(blockIdx.x / 8) : (int)blockIdx.x; (void)lane; (void)wave; (void)gw; (void)NGW; (void)vcu; (void)G
__global__ void __launch_bounds__(NTHREADS, 2) fwd_mega(Args a) {
    extern __shared__ __attribute__((aligned(16))) unsigned char lds_raw[];
    LAS unsigned char* lds = (LAS unsigned char*)lds_raw;
    cg::grid_group grid = cg::this_grid();
    unsigned char* ws = a.ws;
    if (threadIdx.x < 2) ((LAS unsigned*)(lds + LDS_BYTES - 16))[threadIdx.x] = 0u;
    __syncthreads();
    const XcdBarrier xbar = xcd_barrier_post((unsigned*)(ws + WS_CTL) + CW_BAR, (volatile LAS unsigned*)(lds + LDS_BYTES - 16));
#ifdef TS_SEL
    volatile LAS unsigned long long* tsbuf = (volatile LAS unsigned long long*)(lds + LDS_BYTES - 16 - 256);
    int tsn = 0;
#define TS_MARK() do { if (blockIdx.x == 0 && threadIdx.x == 0) tsbuf[tsn] = __builtin_amdgcn_s_memrealtime(); ++tsn; } while (0)
#else
#define TS_MARK() do { } while (0)
#endif
    TS_MARK();
#define GSYNC() do { xcd_barrier(xbar); TS_MARK(); } while (0)

    for (int rep = 0; rep < REP_P0; ++rep) { PHASE_IDS(); p0_phase(a, lds, tid, gw, NGW); if (REP_P0 > 1) __syncthreads(); }
    if (a.pad1 != 0) grid.sync();
    GSYNC();
    for (int rep = 0; rep < REP_P1; ++rep) { PHASE_IDS(); p1_phase(a, lane, gw, NGW); }
    GSYNC();
    {
        PHASE_IDS();
        pg8::Gemm g{(const bf16_t*)(ws + WS_A), (const bf16_t*)(ws + WS_WIN), NTOK, 5120, 1024};
        pg8::StaticOrder S; S.init(NTOK, 5120, G, (int)blockIdx.x);
        EpiInProj E{(bf16_t*)(ws + WS_Q), (bf16_t*)(ws + WS_V), (bf16_t*)(ws + WS_G), (_Float16*)(ws + WS_LFF), (_Float16*)(ws + WS_LFB), (const float*)(ws + WS_LBV)};
        for (int rep = 0; rep < REP_INP; ++rep) pg8::gemm_phase<EpiInProj, pg8::StaticOrder>(lds, g, S, E);
    }
    GSYNC();
    for (int rep = 0; rep < REP_GLA; ++rep) { PHASE_IDS(); gla_phase(a, lds, tid); if (REP_GLA > 1) __syncthreads(); }
    GSYNC();
    for (int rep = 0; rep < REP_RO; ++rep) { PHASE_IDS(); gla_readout_phase(a, lane, gw, NGW); }
    GSYNC();
    {
        PHASE_IDS();
        pg8::Gemm g{(const bf16_t*)(ws + WS_OG), (const bf16_t*)(ws + WS_WOUT), NTOK, 1024, 1024};
        pg8::StaticOrder S; S.init(NTOK, 1024, G, (int)blockIdx.x);
        EpiResid E{a.in[I_X], a.in[I_CTX], (const float*)(ws + WS_MODV), (bf16_t*)(ws + WS_H), 2048};
        for (int rep = 0; rep < REP_OUT; ++rep) pg8::gemm_phase<EpiResid, pg8::StaticOrder>(lds, g, S, E);
    }
    GSYNC();
    for (int rep = 0; rep < REP_RT; ++rep) { PHASE_IDS(); router_phase(a, lds, 0, 0, tid); if (REP_RT > 1) __syncthreads(); }
    GSYNC();
    for (int rep = 0; rep < REP_AS; ++rep) { PHASE_IDS(); assign_phase(a, lds, 0, 0, tid); if (REP_AS > 1) __syncthreads(); }
    GSYNC();
    for (int rep = 0; rep < REP_M1; ++rep) { PHASE_IDS(); moe_gemm1(a, lds, 0, tid, G, vcu); }
    GSYNC();
    for (int rep = 0; rep < REP_M2; ++rep) { PHASE_IDS(); moe_gemm2(a, lds, 0, tid, G, vcu); }
    GSYNC();
    { PHASE_IDS(); combine_phase(a, 0, 0, lane, gw, NGW); }
    GSYNC();
    for (int rep = 0; rep < REP_S5; ++rep) { PHASE_IDS(); s5_phase(a, lds, tid); if (REP_S5 > 1) __syncthreads(); }
    GSYNC();
    for (int rep = 0; rep < REP_POST; ++rep) { PHASE_IDS(); s5_post_phase(a, lane, gw, NGW); }
    GSYNC();
    {
        PHASE_IDS();
        pg8::Gemm g{(const bf16_t*)(ws + WS_YG), (const bf16_t*)(ws + WS_WGLU), NLAT, 2048, 1024};
        pg8::StaticOrder S; S.init(NLAT, 2048, G, (int)blockIdx.x);
        EpiGlu E{a.in[I_S5BGLU], (const float*)(ws + WS_MODV) + 9 * 6144, (bf16_t*)(ws + WS_H)};
        pg8::gemm_phase<EpiGlu, pg8::StaticOrder>(lds, g, S, E);
    }
    GSYNC();
    { PHASE_IDS(); router_phase(a, lds, 1, NCTX, tid); }
    GSYNC();
    { PHASE_IDS(); assign_phase(a, lds, 1, NCTX, tid); }
    GSYNC();
    { PHASE_IDS(); moe_gemm1(a, lds, 1, tid, G, vcu); }
    GSYNC();
    { PHASE_IDS(); moe_gemm2(a, lds, 1, tid, G, vcu); }
    GSYNC();
    for (int rep = 0; rep < REP_CMB1; ++rep) { PHASE_IDS(); combine_phase(a, 1, NCTX, lane, gw, NGW); }
#ifdef TS_SEL
    TS_MARK();
    if (blockIdx.x == 0 && threadIdx.x == 0) {
        asm volatile("s_waitcnt vmcnt(0)" ::: "memory"); __threadfence();
        const unsigned long long dt = tsbuf[TS_SEL + 1] - tsbuf[TS_SEL];
        atomicAdd(a.out, (float)dt * 0.001f);
    }
#endif
}

extern "C" void kernel_launch(void* const* d_in, const int* in_sizes, int n_in, void* d_out, int out_size,
                              void* d_ws, size_t ws_size, hipStream_t stream) {
    static int grid_blocks = 0;
    if (!grid_blocks) {
        int dev = 0, cus = 0, per_cu = 0;
        (void)hipGetDevice(&dev);
        (void)hipDeviceGetAttribute(&cus, hipDeviceAttributeMultiprocessorCount, dev);
        (void)hipFuncSetAttribute((const void*)fwd_mega, hipFuncAttributeMaxDynamicSharedMemorySize, LDS_BYTES);
        (void)hipOccupancyMaxActiveBlocksPerMultiprocessor(&per_cu, (const void*)fwd_mega, NTHREADS, LDS_BYTES);
        if (per_cu < 1) { fprintf(stderr, "occupancy query says %d blocks/CU\n", per_cu); }
        grid_blocks = cus < 256 ? cus : 256;
        if (ws_size < WS_END) fprintf(stderr, "kernel_launch: workspace too small: %zu < %zu\n", ws_size, (size_t)WS_END);
    }
    (void)hipMemsetAsync((char*)d_ws + WS_CTL, 0, 1 * MiB, stream);
    Args a{};
    for (int i = 0; i < 29; ++i) a.in[i] = (const float*)d_in[i];
    a.out = (float*)d_out; a.ws = (unsigned char*)d_ws;
    void* kargs[] = {&a};
    hipError_t e = hipLaunchCooperativeKernel((const void*)fwd_mega, dim3(grid_blocks), dim3(NTHREADS), kargs, LDS_BYTES, stream);
    if (e != hipSuccess) fprintf(stderr, "cooperative launch failed: %s (grid %d)\n", hipGetErrorString(e), grid_blocks);
}
```

```cpp
#include <hip/hip_runtime.h>
#include <hip/hip_cooperative_groups.h>
#include <cstdio>
#include <cstdint>
namespace cg = cooperative_groups;

#define LAS __attribute__((address_space(3)))
typedef unsigned short bf16_t;
typedef short bf16x8 __attribute__((ext_vector_type(8)));
typedef float f32x4 __attribute__((ext_vector_type(4)));
typedef unsigned u32x4 __attribute__((ext_vector_type(4)));
typedef unsigned u32x2 __attribute__((ext_vector_type(2)));
typedef float f32x2 __attribute__((ext_vector_type(2)));

constexpr int NTHREADS = 512;
constexpr int LDS_BYTES = 147456;
constexpr int D = 1024, NB = 8, SEQ = 4096, CTXL = 256;
constexpr int NCTX = NB * CTXL;
constexpr int NLAT = NB * SEQ;
constexpr int NTOK = NCTX + NLAT;
constexpr int NE = 32;
constexpr int MPAD = 147456;
constexpr float EPS = 1e-6f;

constexpr size_t MiB = 1u << 20;
constexpr size_t WS_CTL = 0;
constexpr size_t WS_MODV = 1 * MiB;
constexpr size_t WS_LBV = 1 * MiB + 512 * 1024;
constexpr size_t WS_WIN = 2 * MiB;
constexpr size_t WS_WOUT = 12 * MiB;
constexpr size_t WS_WGLU = 14 * MiB;
constexpr size_t WS_W1 = 18 * MiB;
constexpr size_t WS_W2 = 274 * MiB;
constexpr size_t WS_H = 402 * MiB;
constexpr size_t WS_A = 538 * MiB;
constexpr size_t WS_F = 606 * MiB;
constexpr size_t WS_TOKE = 674 * MiB;
constexpr size_t WS_TOKW = 674 * MiB + 640 * 1024;
constexpr size_t WS_TOKS = 674 * MiB + 1280 * 1024;
constexpr size_t WS_SLOTTOK = 256 * 1024;
constexpr size_t WS_BIG = 676 * MiB;
constexpr size_t WS_Q = WS_BIG, WS_V = WS_BIG + 68 * MiB, WS_G = WS_BIG + 136 * MiB;
constexpr size_t WS_LFF = WS_BIG + 204 * MiB, WS_LFB = WS_BIG + 340 * MiB;
constexpr size_t WS_OF = WS_BIG + 476 * MiB, WS_OB = WS_BIG + 612 * MiB;
constexpr size_t WS_OG = WS_BIG + 748 * MiB;
constexpr size_t WS_AG = WS_BIG, WS_ACT = WS_BIG + 288 * MiB, WS_YS = WS_BIG;
constexpr size_t WS_YF = WS_BIG, WS_YB = WS_BIG + 128 * MiB, WS_YG = WS_BIG + 256 * MiB;
constexpr size_t WS_END = WS_BIG + 816 * MiB;
constexpr int CW_CNT = 64;
constexpr int CW_CUR = 256;
constexpr int CW_CNTB = 8192;
constexpr int CW_BAR = 4096;
#ifndef REP_P0
#define REP_P0 1
#endif
#ifndef REP_GLA
#define REP_GLA 1
#endif
#ifndef REP_S5
#define REP_S5 1
#endif
#ifndef REP_P1
#define REP_P1 1
#endif
#ifndef REP_RO
#define REP_RO 1
#endif
#ifndef REP_POST
#define REP_POST 1
#endif
#ifndef REP_CMB1
#define REP_CMB1 1
#endif
#ifndef REP_OUT
#define REP_OUT 1
#endif
#ifndef REP_RT
#define REP_RT 1
#endif
#ifndef REP_AS
#define REP_AS 1
#endif
#ifndef REP_INP
#define REP_INP 1
#endif
#ifndef REP_M1
#define REP_M1 1
#endif
#ifndef REP_M2
#define REP_M2 1
#endif

struct Args {
    const float* in[29];
    float* out;
    unsigned char* ws;
    int stop_after, pad1;
};
enum { I_X = 0, I_C, I_CTX, I_CCTX, I_MODW, I_MODB, I_N1G, I_N2G, I_HGWIN, I_HGLB, I_HGNG, I_HGWOUT, I_S5ARE, I_S5AIM, I_S5LDT,
       I_S5BRE, I_S5BIM, I_S5CRE, I_S5CIM, I_S5D, I_S5WGLU, I_S5BGLU, I_RW, I_RB, I_W1, I_B1, I_W2, I_B2, I_FG };

__device__ __forceinline__ unsigned f2bf(float f) { unsigned u = __builtin_bit_cast(unsigned, f); return (u + 0x7fffu + ((u >> 16) & 1u)) >> 16; }
typedef __bf16 bf16x2_t __attribute__((ext_vector_type(2)));
__device__ __forceinline__ unsigned cvt_pk_bf16(float lo, float hi) { const bf16x2_t v = {(__bf16)lo, (__bf16)hi}; return __builtin_bit_cast(unsigned, v); }
__device__ __forceinline__ unsigned pk2(float lo, float hi) { return cvt_pk_bf16(lo, hi); }
__device__ __forceinline__ float bf2f(unsigned short b) { return __builtin_bit_cast(float, ((unsigned)b) << 16); }
__device__ __forceinline__ float bflo(unsigned w) { return __builtin_bit_cast(float, w << 16); }
__device__ __forceinline__ float bfhi(unsigned w) { return __builtin_bit_cast(float, w & 0xffff0000u); }
__device__ __forceinline__ float wave_sum(float v) {
#pragma unroll
    for (int o = 1; o < 64; o <<= 1) v += __shfl_xor(v, o);
    return v;
}
__device__ __forceinline__ float wave_max(float v) {
#pragma unroll
    for (int o = 1; o < 64; o <<= 1) v = fmaxf(v, __shfl_xor(v, o));
    return v;
}
__device__ __forceinline__ float sigmoid_f(float x) { return __builtin_amdgcn_rcpf(1.0f + __expf(-x)); }
__device__ __forceinline__ float silu_f(float x) { return x * __builtin_amdgcn_rcpf(1.0f + __expf(-x)); }
#define LDS_WAIT() asm volatile("s_waitcnt lgkmcnt(0)" ::: "memory")

namespace pg8 {
constexpr int BM = 256, BK = 64, HALF = 128, HTB = HALF * BK * 2, STAGE_BYTES = 8 * HTB, NXCD = 8, WGM = 8;
__host__ __device__ __forceinline__ int lds_byte(int r, int c) { const int st = (r >> 4) * 2 + (c >> 5), rr = r & 15, cc = c & 31, ob = rr * 64 + cc * 2; return st * 1024 + (ob ^ (((ob >> 9) & 1) << 5)); }
__host__ __device__ __forceinline__ void stage_rc(int b, int& R, int& C) { const int st = b / 1024, sb = b % 1024, swz = sb ^ (((sb >> 9) & 1) << 5); R = (st >> 1) * 16 + swz / 64; C = (st & 1) * 32 + (swz % 64) / 2; }
__host__ __device__ __forceinline__ int perm32(int rho) { const int n = rho >> 4, i = rho & 15; return 8 * (i >> 2) + 4 * n + (i & 3); }
struct Unit { int pm, pn; };
struct Gemm { const bf16_t* A; const bf16_t* Bt; int M, N, K; };
struct StaticOrder {
    int nM, nN, nwg, G, c;
    __device__ void init(int M, int N, int G_, int c_) { nM = M / BM; nN = N / BM; nwg = nM * nN; G = G_; c = c_; }
    __device__ bool next(int i, Unit& u) const {
        const long L = (long)i * G + c; if (L >= nwg) return false;
        int wgid = (int)L; { const int q = nwg / NXCD, r = nwg % NXCD, xcd = wgid % NXCD, off = wgid / NXCD; wgid = (xcd < r ? xcd * (q + 1) : r * (q + 1) + (xcd - r) * q) + off; }
        const int nig = WGM * nN, gid = wgid / nig, fm = gid * WGM, gsz = (nM - fm) < WGM ? (nM - fm) : WGM;
        u.pm = fm + ((wgid % nig) % gsz); u.pn = (wgid % nig) / gsz; return true;
    }
    __device__ __forceinline__ void a_ready(const Unit&) const {}
    __device__ __forceinline__ void done(const Unit&) const {}
};
struct MoeOrder {
    const LAS int* tile_e; int TT, sh, G, v;
    __device__ bool next(int i, Unit& u) const {
        const bool p2 = (G & (G - 1)) == 0 && G >= 8;
        const int lg = p2 ? (31 - __builtin_clz((unsigned)G)) - 3 : 0, per = p2 ? (1 << lg) : G, x = p2 ? (v >> lg) : 0, j = p2 ? (v & (per - 1)) : v, sh3 = p2 ? 3 : 0;
        const int t0 = (x * TT) >> sh3, t1 = ((x + 1) * TT) >> sh3;
        const int uu = i * per + j, rt = t0 + (uu >> sh), pnl = uu & ((1 << sh) - 1);
        if (rt >= t1) return false;
        u.pm = rt; u.pn = (tile_e[rt] << sh) + pnl; return true;
    }
    __device__ __forceinline__ void a_ready(const Unit&) const {}
    __device__ __forceinline__ void done(const Unit&) const {}
};

template <class Epi, class Sched, bool GATHER = false, bool ALIGN_EPI = true, bool SP2 = true>
__device__ __forceinline__ void gemm_phase(LAS unsigned char* lds, const Gemm g, const Sched& S, const Epi& E, const LAS unsigned short* rowl = nullptr) {
    int tid_ = threadIdx.x; asm volatile("" : "+v"(tid_));
    const int tid = tid_, wid = __builtin_amdgcn_readfirstlane(tid >> 6), lane = tid & 63, wr = wid >> 2, wc = wid & 3, fr = lane & 15, fq = lane >> 4;
    const int K = g.K, nt = K / BK;
    unsigned voffA[2], voffB[2];
    int Rr[2], Cc2[2];
#pragma unroll
    for (int i = 0; i < 2; ++i) { int R, C; stage_rc(tid * 16 + i * 8192, R, C); voffA[i] = (unsigned)(R * K + C) * 2u; const int Rb = Epi::PERM ? ((R & ~31) + perm32(R & 31)) : R; voffB[i] = (unsigned)(Rb * K + C) * 2u; Rr[i] = R; Cc2[i] = C * 2; }
    unsigned gA0[2] = {0u, 0u}, gA1[2] = {0u, 0u}, nG0[2] = {0u, 0u}, nG1[2] = {0u, 0u};
#define PG8_ROWS(ui_, d0, d1) do { _Pragma("unroll") for (int _i = 0; _i < 2; ++_i) { d0[_i] = (unsigned)rowl[(ui_) * BM + Rr[_i]] * (unsigned)(K * 2) + (unsigned)Cc2[_i]; d1[_i] = (unsigned)rowl[(ui_) * BM + HALF + Rr[_i]] * (unsigned)(K * 2) + (unsigned)Cc2[_i]; } } while (0)
#define PG8_STAGE_A(bufoff, ptr, h, nx) do { if constexpr (GATHER) { unsigned _o[2]; _o[0] = (nx) ? ((h) ? nG1[0] : nG0[0]) : ((h) ? gA1[0] : gA0[0]); _o[1] = (nx) ? ((h) ? nG1[1] : nG0[1]) : ((h) ? gA1[1] : gA0[1]); PG8_STAGE(bufoff, ptr, _o); } \
        else { PG8_STAGE(bufoff, (ptr) + ((h) ? hstep : 0), voffA); } } while (0)
    const size_t kstep = (size_t)(BK * 2);
    const size_t hstep = (size_t)HALF * K * 2;
    const size_t tstep = 2 * hstep;
    const unsigned ldsw = (unsigned)wid * 1024u;
    const int aoff = lds_byte(wr * 64 + fr, fq * 8), boff = lds_byte(wc * 32 + fr, fq * 8);
#define PG8_SA(b, h) (((b) * 2 + (h)) * HTB)
#define PG8_SB(b, h) ((4 + (b) * 2 + (h)) * HTB)
#define PG8_STAGE(bufoff, gbase, voff) do { _Pragma("unroll") for (int _i = 0; _i < 2; ++_i) \
        __builtin_amdgcn_global_load_lds((const unsigned*)((const char*)(gbase) + (voff)[_i]), (LAS unsigned*)(lds + (bufoff) + ldsw + _i * 8192), 16, 0, 0); } while (0)
#define PG8_LDA(dst, b, h) do { _Pragma("unroll") for (int m = 0; m < 4; ++m) _Pragma("unroll") for (int k = 0; k < 2; ++k) dst[m][k] = *(const LAS bf16x8*)(lds + PG8_SA(b, h) + aoff + m * 2048 + k * 1024); } while (0)
#define PG8_LDB(dst, b, h) do { _Pragma("unroll") for (int n = 0; n < 2; ++n) _Pragma("unroll") for (int k = 0; k < 2; ++k) dst[n][k] = *(const LAS bf16x8*)(lds + PG8_SB(b, h) + boff + n * 2048 + k * 1024); } while (0)
#define PG8_MMA(ai, bj, At, Bt) do { __builtin_amdgcn_s_setprio(1); _Pragma("unroll") for (int m = 0; m < 4; ++m) _Pragma("unroll") for (int n = 0; n < 2; ++n) _Pragma("unroll") for (int k = 0; k < 2; ++k) \
        acc[ai][bj][m][n] = __builtin_amdgcn_mfma_f32_16x16x32_bf16(Bt[n][k], At[m][k], acc[ai][bj][m][n], 0, 0, 0); __builtin_amdgcn_s_setprio(0); } while (0)
#define PG8_WAIT_V(n) asm volatile("s_waitcnt vmcnt(" #n ")" ::: "memory")
#define PG8_WAIT_L(n) asm volatile("s_waitcnt lgkmcnt(" #n ")" ::: "memory")
#define PG8_BAR __builtin_amdgcn_s_barrier()
#define PG8_SCHED __builtin_amdgcn_sched_barrier(0)
    Unit cur, nxt; int ui = 0;
    if (!S.next(0, cur)) return;
    f32x4 acc[2][2][4][2];
#pragma unroll
    for (int a = 0; a < 2; ++a)
#pragma unroll
        for (int b = 0; b < 2; ++b)
#pragma unroll
            for (int m = 0; m < 4; ++m)
#pragma unroll
                for (int n = 0; n < 2; ++n) acc[a][b][m][n] = (f32x4){0.f, 0.f, 0.f, 0.f};
    bf16x8 At[4][2], B0[2][2], B1[2][2];
    const char* cA = GATHER ? (const char*)g.A : (const char*)g.A + (size_t)cur.pm * tstep; const char* cB = (const char*)g.Bt + (size_t)cur.pn * tstep;
    S.a_ready(cur);
    if constexpr (GATHER) PG8_ROWS(0, gA0, gA1);
    if constexpr (SP2) {
        PG8_STAGE(PG8_SB(0, 0), cB, voffB); PG8_STAGE(PG8_SB(0, 1), cB + hstep, voffB); PG8_STAGE_A(PG8_SA(0, 0), cA, 0, false); PG8_STAGE_A(PG8_SA(0, 1), cA, 1, false);
        if (wr == 1) PG8_BAR;
        PG8_WAIT_V(2); PG8_BAR;
        PG8_STAGE(PG8_SB(1, 0), cB + kstep, voffB); PG8_STAGE_A(PG8_SA(1, 0), cA + kstep, 0, false); PG8_STAGE(PG8_SB(1, 1), cB + hstep + kstep, voffB);
        PG8_WAIT_V(6); PG8_BAR;
    } else {
        PG8_STAGE(PG8_SB(0, 0), cB, voffB); PG8_STAGE_A(PG8_SA(0, 0), cA, 0, false); PG8_STAGE(PG8_SB(0, 1), cB + hstep, voffB); PG8_STAGE_A(PG8_SA(0, 1), cA, 1, false);
        if (wr == 1) PG8_BAR;
        PG8_WAIT_V(4); PG8_BAR;
        PG8_STAGE(PG8_SB(1, 0), cB + kstep, voffB); PG8_STAGE_A(PG8_SA(1, 0), cA + kstep, 0, false); PG8_STAGE(PG8_SB(1, 1), cB + hstep + kstep, voffB);
        PG8_WAIT_V(6); PG8_BAR;
    }
    for (;;) {
        const bool has_next = S.next(ui + 1, nxt);
        const char* nA = GATHER ? cA : (has_next ? (const char*)g.A + (size_t)nxt.pm * tstep : cA); const char* nB = has_next ? (const char*)g.Bt + (size_t)nxt.pn * tstep : cB;
        if constexpr (GATHER) { if (has_next) PG8_ROWS(ui + 1, nG0, nG1); else { nG0[0] = gA0[0]; nG0[1] = gA0[1]; nG1[0] = gA1[0]; nG1[1] = gA1[1]; } }
        for (int t = 0; t < nt; t += 2) {
            const bool last = (t == nt - 2);
            const char* a1 = cA + (size_t)(t + 1) * kstep;
            const char* a2 = last ? nA : cA + (size_t)(t + 2) * kstep; const char* b2 = last ? nB : cB + (size_t)(t + 2) * kstep;
            const char* a3 = a2 + kstep; const char* b3 = b2 + kstep;
            if (last && has_next) S.a_ready(nxt);
            if constexpr (SP2) {
            PG8_LDB(B0, 0, 0); PG8_LDB(B1, 0, 1); PG8_SCHED; PG8_LDA(At, 0, 0); PG8_STAGE_A(PG8_SA(1, 1), a1, 1, false);
            PG8_WAIT_V(8); PG8_WAIT_L(0); PG8_BAR; PG8_MMA(0, 0, At, B0); PG8_MMA(0, 1, At, B1); PG8_BAR; PG8_SCHED;
            PG8_LDA(At, 0, 1); PG8_STAGE(PG8_SB(0, 0), b2, voffB); PG8_STAGE(PG8_SB(0, 1), b2 + hstep, voffB); PG8_STAGE_A(PG8_SA(0, 0), a2, 0, last);
            PG8_WAIT_V(8); PG8_WAIT_L(0); PG8_BAR; PG8_MMA(1, 0, At, B0); PG8_MMA(1, 1, At, B1); PG8_BAR; PG8_SCHED;
            PG8_LDB(B0, 1, 0); PG8_LDB(B1, 1, 1); PG8_SCHED; PG8_LDA(At, 1, 0); PG8_STAGE_A(PG8_SA(0, 1), a2, 1, last);
            PG8_WAIT_V(8); PG8_WAIT_L(0); PG8_BAR; PG8_MMA(0, 0, At, B0); PG8_MMA(0, 1, At, B1); PG8_BAR; PG8_SCHED;
            PG8_LDA(At, 1, 1); PG8_STAGE(PG8_SB(1, 0), b3, voffB); PG8_STAGE(PG8_SB(1, 1), b3 + hstep, voffB); PG8_STAGE_A(PG8_SA(1, 0), a3, 0, last);
            PG8_WAIT_V(8); PG8_WAIT_L(0); PG8_BAR; PG8_MMA(1, 0, At, B0); PG8_MMA(1, 1, At, B1); PG8_BAR; PG8_SCHED;
            } else {
            PG8_LDB(B0, 0, 0); PG8_SCHED; PG8_LDA(At, 0, 0); PG8_STAGE_A(PG8_SA(1, 1), a1, 1, false);
            PG8_WAIT_L(8); PG8_BAR; PG8_WAIT_L(0); PG8_MMA(0, 0, At, B0); PG8_BAR; PG8_SCHED;
            PG8_LDB(B1, 0, 1); PG8_STAGE(PG8_SB(0, 0), b2, voffB);
            PG8_BAR; PG8_WAIT_L(0); PG8_MMA(0, 1, At, B1); PG8_BAR;
            PG8_LDA(At, 0, 1); PG8_STAGE_A(PG8_SA(0, 0), a2, 0, last);
            PG8_BAR; PG8_WAIT_L(0); PG8_MMA(1, 0, At, B0); PG8_BAR; PG8_SCHED;
            PG8_STAGE(PG8_SB(0, 1), b2 + hstep, voffB);
            PG8_WAIT_V(6); PG8_BAR; PG8_MMA(1, 1, At, B1); PG8_BAR;
            PG8_LDB(B0, 1, 0); PG8_SCHED; PG8_LDA(At, 1, 0); PG8_STAGE_A(PG8_SA(0, 1), a2, 1, last);
            PG8_WAIT_L(8); PG8_BAR; PG8_WAIT_L(0); PG8_MMA(0, 0, At, B0); PG8_BAR; PG8_SCHED;
            PG8_LDB(B1, 1, 1); PG8_STAGE(PG8_SB(1, 0), b3, voffB);
            PG8_BAR; PG8_WAIT_L(0); PG8_MMA(0, 1, At, B1); PG8_BAR;
            PG8_LDA(At, 1, 1); PG8_STAGE_A(PG8_SA(1, 0), a3, 0, last);
            PG8_BAR; PG8_WAIT_L(0); PG8_MMA(1, 0, At, B0); PG8_BAR; PG8_SCHED;
            PG8_STAGE(PG8_SB(1, 1), b3 + hstep, voffB);
            PG8_WAIT_V(6); PG8_BAR; PG8_MMA(1, 1, At, B1); PG8_BAR;
                    }
        }
        if constexpr (ALIGN_EPI) { if (wr == 0) PG8_BAR; }
        E(acc, cur, wr, wc, fr, fq); S.done(cur);
        if (!has_next) break;
#pragma unroll
        for (int a = 0; a < 2; ++a)
#pragma unroll
            for (int b = 0; b < 2; ++b)
#pragma unroll
                for (int m = 0; m < 4; ++m)
#pragma unroll
                    for (int n = 0; n < 2; ++n) acc[a][b][m][n] = (f32x4){0.f, 0.f, 0.f, 0.f};
        cur = nxt; cA = nA; cB = nB; ++ui;
        if constexpr (GATHER) { gA0[0] = nG0[0]; gA0[1] = nG0[1]; gA1[0] = nG1[0]; gA1[1] = nG1[1]; }
        if constexpr (ALIGN_EPI) { if (wr == 1) PG8_BAR; }
    }
    PG8_WAIT_V(0);
    if constexpr (!ALIGN_EPI) { if (wr == 0) PG8_BAR; }
    PG8_BAR;
#undef PG8_SA
#undef PG8_ROWS
#undef PG8_STAGE_A
#undef PG8_SB
#undef PG8_STAGE
#undef PG8_LDA
#undef PG8_LDB
#undef PG8_MMA
#undef PG8_WAIT_V
#undef PG8_WAIT_L
#undef PG8_BAR
#undef PG8_SCHED
}
}
using pg8::Unit;

__device__ __forceinline__ f32x4 ld_bf16x4(const bf16_t* p) { const u32x2 w = *(const u32x2*)p; return (f32x4){bflo(w.x), bfhi(w.x), bflo(w.y), bfhi(w.y)}; }
__device__ __forceinline__ void st_bf16x4(bf16_t* p, f32x4 v) { u32x2 w; w.x = pk2(v[0], v[1]); w.y = pk2(v[2], v[3]); *(u32x2*)p = w; }

struct EpiInProj {
    static constexpr bool PERM = true;
    bf16_t *Q, *V, *G; _Float16 *LFF, *LFB; const float* lbv;
    __device__ __forceinline__ void operator()(const f32x4 (&acc)[2][2][4][2], const Unit& u, int wr, int wc, int fr, int fq) const {
        const int seg = u.pn >> 2, cb = (u.pn & 3) * 256 + wc * 32 + 8 * fq, row0 = u.pm * 256 + wr * 64 + fr;
#pragma unroll
        for (int bj = 0; bj < 2; ++bj) {
            const int c = cb + bj * 128;
            f32x4 lb0 = (f32x4){0.f, 0.f, 0.f, 0.f}, lb1 = lb0;
            if (seg == 2 || seg == 3) { lb0 = *(const f32x4*)(lbv + (seg - 2) * D + c); lb1 = *(const f32x4*)(lbv + (seg - 2) * D + c + 4); }
#pragma unroll
            for (int ai = 0; ai < 2; ++ai)
#pragma unroll
                for (int m = 0; m < 4; ++m) {
                    const size_t ro = (size_t)(row0 + ai * 128 + m * 16) * D + c;
                    const f32x4 v0 = acc[ai][bj][m][0], v1 = acc[ai][bj][m][1];
                    if (seg == 0) { f32x4 o0, o1; for (int j = 0; j < 4; ++j) { o0[j] = silu_f(v0[j]); o1[j] = silu_f(v1[j]); }
                        *(u32x4*)(Q + ro) = (u32x4){pk2(o0[0], o0[1]), pk2(o0[2], o0[3]), pk2(o1[0], o1[1]), pk2(o1[2], o1[3])}; }
                    else if (seg == 1) { *(u32x4*)(V + ro) = (u32x4){pk2(v0[0], v0[1]), pk2(v0[2], v0[3]), pk2(v1[0], v1[1]), pk2(v1[2], v1[3])}; }
                    else if (seg == 4) { *(u32x4*)(G + ro) = (u32x4){pk2(v0[0], v0[1]), pk2(v0[2], v0[3]), pk2(v1[0], v1[1]), pk2(v1[2], v1[3])}; }
                    else {
                        f32x4 o0, o1;
                        for (int j = 0; j < 4; ++j) { o0[j] = __logf(lb0[j] + (1.0f - lb0[j]) * sigmoid_f(v0[j])); o1[j] = __logf(lb1[j] + (1.0f - lb1[j]) * sigmoid_f(v1[j])); }
                        u32x4 hw; hw.x = __builtin_bit_cast(unsigned, __builtin_amdgcn_cvt_pkrtz(o0[0], o0[1])); hw.y = __builtin_bit_cast(unsigned, __builtin_amdgcn_cvt_pkrtz(o0[2], o0[3]));
                        hw.z = __builtin_bit_cast(unsigned, __builtin_amdgcn_cvt_pkrtz(o1[0], o1[1])); hw.w = __builtin_bit_cast(unsigned, __builtin_amdgcn_cvt_pkrtz(o1[2], o1[3]));
                        *(u32x4*)((seg == 2 ? LFF : LFB) + ro) = hw;
                    }
                }
        }
    }
};
struct EpiResid {
    static constexpr bool PERM = true;
    const float* x; const float* ctx; const float* modv; bf16_t* H; int gate_off;
    __device__ __forceinline__ void operator()(const f32x4 (&acc)[2][2][4][2], const Unit& u, int wr, int wc, int fr, int fq) const {
        const int rt0 = u.pm * 256; const int mr = rt0 < NCTX ? 8 : ((rt0 - NCTX) >> 12);
        const float* src = rt0 < NCTX ? ctx + (size_t)rt0 * D : x + (size_t)(rt0 - NCTX) * D;
        const int cb = u.pn * 256 + wc * 32 + 8 * fq, rl0 = wr * 64 + fr;
        const float* gp = modv + mr * 6144 + gate_off;
        f32x4 gg[2][2];
#pragma unroll
        for (int bj = 0; bj < 2; ++bj) { gg[bj][0] = *(const f32x4*)(gp + cb + bj * 128); gg[bj][1] = *(const f32x4*)(gp + cb + bj * 128 + 4); }
#pragma unroll
        for (int bj = 0; bj < 2; ++bj)
#pragma unroll
            for (int ai = 0; ai < 2; ++ai) {
                const int c = cb + bj * 128; f32x4 h0[4], h1[4];
#pragma unroll
                for (int m = 0; m < 4; ++m) { const float* hp = src + (size_t)(rl0 + ai * 128 + m * 16) * D + c; h0[m] = *(const f32x4*)hp; h1[m] = *(const f32x4*)(hp + 4); }
#pragma unroll
                for (int m = 0; m < 4; ++m) {
                    const f32x4 o0 = h0[m] + gg[bj][0] * acc[ai][bj][m][0], o1 = h1[m] + gg[bj][1] * acc[ai][bj][m][1];
                    *(u32x4*)(H + (size_t)(rt0 + rl0 + ai * 128 + m * 16) * D + c) = (u32x4){pk2(o0[0], o0[1]), pk2(o0[2], o0[3]), pk2(o1[0], o1[1]), pk2(o1[2], o1[3])};
                }
                asm volatile("" ::: "memory");
            }
    }
};

struct TrItem { const float* src; bf16_t* dst; int N; };
__device__ __forceinline__ void tr_load(const TrItem& t, f32x4 (&v)[16], int lane) {
    const float* p = t.src + (size_t)(2 * (lane >> 4)) * t.N + 4 * (lane & 15);
#pragma unroll
    for (int i = 0; i < 8; ++i) { v[2 * i] = *(const f32x4*)(p + (size_t)(8 * i) * t.N); v[2 * i + 1] = *(const f32x4*)(p + (size_t)(8 * i + 1) * t.N); }
}
__device__ __forceinline__ void tr_finish(const TrItem& t, const f32x4 (&v)[16], LAS unsigned* scr, int lane) {
#pragma unroll
    for (int i = 0; i < 8; ++i) {
        const int kp = 4 * i + (lane >> 4); LAS unsigned* s = scr + kp * 65 + 4 * (lane & 15);
        s[0] = cvt_pk_bf16(v[2 * i][0], v[2 * i + 1][0]); s[1] = cvt_pk_bf16(v[2 * i][1], v[2 * i + 1][1]); s[2] = cvt_pk_bf16(v[2 * i][2], v[2 * i + 1][2]); s[3] = cvt_pk_bf16(v[2 * i][3], v[2 * i + 1][3]);
    }
    LDS_WAIT();
    const int c = lane & 7;
#pragma unroll
    for (int j = 0; j < 8; ++j) {
        const int n = (lane >> 3) + 8 * j; const LAS unsigned* s = scr + (4 * c) * 65 + n;
        *(u32x4*)(t.dst + (size_t)n * 1024 + 8 * c) = (u32x4){s[0], s[65], s[130], s[195]};
    }
    LDS_WAIT();
}
__device__ __forceinline__ int ilv_row(int c) { const int bj = c >> 10, r = c & 1023; return (r >> 7) * 256 + bj * 128 + (r & 127); }

__device__ __forceinline__ TrItem moe_item(const Args& a, int r, int layer) {
    TrItem t;
    if (r < 32 * 512) { const int mat = layer * 32 + (r >> 9), sub = r & 511, kb = sub >> 5, nb = sub & 31;
        t.src = a.in[I_W1] + (size_t)mat * 1024 * 2048 + (size_t)(kb * 64) * 2048 + nb * 64; t.dst = (bf16_t*)(a.ws + WS_W1) + (size_t)mat * 2048 * 1024 + (size_t)ilv_row(nb * 64) * 1024 + kb * 64; t.N = 2048; }
    else { r -= 32 * 512; const int mat = layer * 32 + (r >> 8), sub = r & 255, kb = sub >> 4, nb = sub & 15;
        t.src = a.in[I_W2] + (size_t)mat * 1024 * 1024 + (size_t)(kb * 64) * 1024 + nb * 64; t.dst = (bf16_t*)(a.ws + WS_W2) + (size_t)mat * 1024 * 1024 + (size_t)(nb * 64) * 1024 + kb * 64; t.N = 1024; }
    return t;
}
constexpr int P0_NWIN = 16 * 80, P0_NWOUT = 16 * 16, P0_NWGLU = 16 * 32, P0_NITEMS = P0_NWIN + P0_NWOUT + P0_NWGLU + 32 * 512 + 32 * 256;
__device__ __forceinline__ TrItem p0_item(const Args& a, int r) {
    TrItem t;
    if (r < P0_NWIN) { const int kb = r / 80, nb = r % 80; t.src = a.in[I_HGWIN] + (size_t)(kb * 64) * 5120 + nb * 64; t.dst = (bf16_t*)(a.ws + WS_WIN) + (size_t)(nb * 64) * 1024 + kb * 64; t.N = 5120; return t; } r -= P0_NWIN;
    if (r < P0_NWOUT) { const int kb = r / 16, nb = r % 16; t.src = a.in[I_HGWOUT] + (size_t)(kb * 64) * 1024 + nb * 64; t.dst = (bf16_t*)(a.ws + WS_WOUT) + (size_t)(nb * 64) * 1024 + kb * 64; t.N = 1024; return t; } r -= P0_NWOUT;
    if (r < P0_NWGLU) { const int kb = r / 32, nb = r % 32; t.src = a.in[I_S5WGLU] + (size_t)(kb * 64) * 2048 + nb * 64; t.dst = (bf16_t*)(a.ws + WS_WGLU) + (size_t)ilv_row(nb * 64) * 1024 + kb * 64; t.N = 2048; return t; } r -= P0_NWGLU;
    return moe_item(a, r, 0);
}
#define TR_LOOP(first, stride, count, ITEM) do { int _it = (first); if (_it < (count)) { f32x4 _va[16], _vb[16]; TrItem _A = ITEM(_it), _B = _A; tr_load(_A, _va, lane); \
        for (;;) { const int _i2 = _it + (stride); const bool _h2 = _i2 < (count); if (_h2) { _B = ITEM(_i2); tr_load(_B, _vb, lane); } tr_finish(_A, _va, scr, lane); if (!_h2) break; \
                   _it = _i2 + (stride); const bool _h1 = _it < (count); if (_h1) { _A = ITEM(_it); tr_load(_A, _va, lane); } tr_finish(_B, _vb, scr, lane); if (!_h1) break; } } } while (0)
__device__ __forceinline__ void p0_phase(const Args& a, LAS unsigned char* lds, int tid, int gw, int NGW) {
    const int lane = tid & 63, wave = tid >> 6;
    unsigned char* ws = a.ws;
    float* modv = (float*)(ws + WS_MODV);
    if (blockIdx.x < 192) {
        LAS float* SC = (LAS float*)lds;
        LAS float* PART = (LAS float*)(lds + 40960);
        for (int i = tid; i < 9 * 1024; i += NTHREADS) { const int r = i >> 10, k = i & 1023; const float v = r < 8 ? a.in[I_C][r * 1024 + k] : a.in[I_CCTX][k]; SC[i] = silu_f(v); }
        __syncthreads();
        const int layer = blockIdx.x / 96, ng = blockIdx.x % 96;
        const float* W = a.in[I_MODW] + (size_t)layer * 1024 * 6144 + ng * 64 + lane;
        float acc[9];
#pragma unroll
        for (int r = 0; r < 9; ++r) acc[r] = 0.f;
#pragma unroll 8
        for (int kk = 0; kk < 128; ++kk) {
            const int k = wave * 128 + kk; const float w = W[(size_t)k * 6144];
#pragma unroll
            for (int r = 0; r < 9; ++r) acc[r] += SC[r * 1024 + k] * w;
        }
#pragma unroll
        for (int r = 0; r < 9; ++r) PART[(wave * 9 + r) * 64 + lane] = acc[r];
        __syncthreads();
        for (int i = tid; i < 9 * 64; i += NTHREADS) {
            const int r = i >> 6, l = i & 63; float s = a.in[I_MODB][layer * 6144 + ng * 64 + l];
#pragma unroll
            for (int w = 0; w < 8; ++w) s += PART[(w * 9 + r) * 64 + l];
            modv[(size_t)(layer * 9 + r) * 6144 + ng * 64 + l] = s;
        }
        __syncthreads();
    } else if (blockIdx.x == 192) {
        float* lbv = (float*)(ws + WS_LBV);
        for (int i = tid; i < 2048; i += NTHREADS) { const float l0 = a.in[I_HGLB][i], l1 = a.in[I_HGLB][2048 + i]; lbv[i] = 1.0f / (1.0f + __expf(l1 - l0)); }
    }
    LAS unsigned* scr = (LAS unsigned*)(lds + 59392 + wave * 8320);
#define P0_ITEM(i) p0_item(a, (i))
    const int nfast = ((int)gridDim.x > 192) ? ((int)gridDim.x - 192) * 8 : 0, nextra = nfast * 3, n1 = P0_NITEMS - nextra;
    TR_LOOP(gw, NGW, n1, P0_ITEM);
    if (blockIdx.x >= 192) { TR_LOOP(n1 + (gw - 192 * 8), nfast, P0_NITEMS, P0_ITEM); }
#undef P0_ITEM
}

__device__ __forceinline__ const float* hin_row(const Args& a, int row) { return row < NCTX ? a.in[I_CTX] + (size_t)row * D : a.in[I_X] + (size_t)(row - NCTX) * D; }
__device__ __forceinline__ int mod_row(int row) { return row < NCTX ? 8 : ((row - NCTX) >> 12); }
__device__ __forceinline__ float row_rstd(const f32x4 (&v)[4]) {
    float s = 0.f;
#pragma unroll
    for (int j = 0; j < 4; ++j) s += (v[j][0] * v[j][0] + v[j][1] * v[j][1]) + (v[j][2] * v[j][2] + v[j][3] * v[j][3]);
    return 1.0f / sqrtf(wave_sum(s) * (1.0f / D) + EPS);
}
struct ModVec { f32x4 g[4], sc[4], sh[4]; };
__device__ __forceinline__ void modvec_load(ModVec& m, const float* g, const float* sc, const float* sh, int lane) {
#pragma unroll
    for (int j = 0; j < 4; ++j) { const int c = 4 * lane + 256 * j; m.g[j] = *(const f32x4*)(g + c); m.sc[j] = *(const f32x4*)(sc + c); m.sh[j] = *(const f32x4*)(sh + c); }
}
__device__ __forceinline__ void norm_mod_store(const f32x4 (&v)[4], float rstd, const ModVec& m, bf16_t* orow, int lane) {
#pragma unroll
    for (int j = 0; j < 4; ++j) st_bf16x4(orow + 4 * lane + 256 * j, v[j] * rstd * m.g[j] * (m.sc[j] + 1.0f) + m.sh[j]);
}

__device__ __forceinline__ void p1_phase(const Args& a, int lane, int gw, int NGW) {
    const float* modv = (const float*)(a.ws + WS_MODV);
    bf16_t* A = (bf16_t*)(a.ws + WS_A);
    for (int row0 = gw * 4; row0 < NTOK; row0 += NGW * 4) {
        f32x4 v[4][4];
#pragma unroll
        for (int r = 0; r < 4; ++r) { const float* hr = hin_row(a, row0 + r);
#pragma unroll
            for (int j = 0; j < 4; ++j) v[r][j] = *(const f32x4*)(hr + 4 * lane + 256 * j); }
        const float* mv = modv + (size_t)mod_row(row0) * 6144;
        ModVec m; modvec_load(m, a.in[I_N1G], mv + 1024, mv, lane);
#pragma unroll
        for (int r = 0; r < 4; ++r) { const float rstd = row_rstd(v[r]); norm_mod_store(v[r], rstd, m, A + (size_t)(row0 + r) * D, lane); }
    }
}

__device__ __forceinline__ int gla_row(int n, int t, int b, int dir) {
    const bool isctx = n < 4; const int cn = isctx ? n : n - 4, slen = isctx ? CTXL : SEQ, rbase = isctx ? b * CTXL : NCTX + b * SEQ;
    const int pos = cn * 64 + t; return rbase + (dir ? slen - 1 - pos : pos);
}
__device__ __forceinline__ void gla_phase(const Args& a, LAS unsigned char* lds, int tid) {
    const int lane = tid & 63, wave = tid >> 6, fr = lane & 15, fq = lane >> 4;
    LAS unsigned char* QS = lds;
    LAS unsigned char* KS = lds + 17408;
    LAS unsigned char* QIN = lds + 34816;
    LAS unsigned char* KOT = lds + 52224;
    LAS unsigned char* VT = lds + 70656;
    LAS unsigned char* ST0 = lds + 79872;
    LAS unsigned char* PPW = lds + 114688 + wave * 2304;
    LAS float* GT0 = (LAS float*)(lds + 133120);
    LAS float* BL = (LAS float*)(lds + 141312);
    const bf16_t* Qg = (const bf16_t*)(a.ws + WS_Q); const bf16_t* Vg = (const bf16_t*)(a.ws + WS_V);
    for (int item = blockIdx.x; item < 256; item += gridDim.x) {
        const int vs = item & 1, dir = (item >> 1) & 1, h = (item >> 2) & 7, b = item >> 5;
        const _Float16* LF = (const _Float16*)(a.ws + (dir ? WS_LFB : WS_LFF)); bf16_t* Og = (bf16_t*)(a.ws + (dir ? WS_OB : WS_OF));
        f32x4 Sacc[4];
#pragma unroll
        for (int i = 0; i < 4; ++i) Sacc[i] = (f32x4){0.f, 0.f, 0.f, 0.f};
        for (int i = tid; i < 2 * 17408 / 4; i += NTHREADS) ((LAS unsigned*)ST0)[i] = 0u;
        const int kc2 = (tid & 63) * 2, tg = tid >> 6, chq = h * 128 + kc2;
        const int vt_t = tid & 63, vt_v8 = (tid >> 6) * 8;
        unsigned lf2[8], q2[8]; u32x4 vv;
#define GLA_LOAD(n_) do { _Pragma("unroll") for (int i = 0; i < 8; ++i) { const size_t o = (size_t)gla_row(n_, tg * 8 + i, b, dir) * D + chq; lf2[i] = *(const unsigned*)(LF + o); q2[i] = *(const unsigned*)(Qg + o); } \
            vv = *(const u32x4*)(Vg + (size_t)gla_row(n_, vt_t, b, dir) * D + h * 128 + vs * 64 + vt_v8); } while (0)
        float fa[8], fb[8], bca[8], bcb[8];
#define GLA_CUMSUM(par_) do { float csa = 0.f, csb = 0.f; _Pragma("unroll") for (int i = 0; i < 8; ++i) { typedef _Float16 h2 __attribute__((ext_vector_type(2))); const h2 hv = __builtin_bit_cast(h2, lf2[i]); \
            const float la = (float)hv[0], lb_ = (float)hv[1]; fa[i] = __expf(la); fb[i] = __expf(lb_); csa += la; csb += lb_; bca[i] = csa; bcb[i] = csb; } \
            *(LAS f32x2*)(GT0 + (par_) * 1024 + tg * 128 + kc2) = (f32x2){csa, csb}; } while (0)
        GLA_LOAD(0);
        GLA_CUMSUM(0);
        __syncthreads();
        for (int n = 0; n < 68; ++n) {
            const int par = n & 1;
            LAS unsigned char* STc = ST0 + par * 17408; LAS unsigned char* STn = ST0 + (par ^ 1) * 17408;
            { const unsigned w[4] = {vv.x, vv.y, vv.z, vv.w};
#pragma unroll
              for (int i = 0; i < 4; ++i) { *(LAS bf16_t*)(VT + (vt_v8 + 2 * i) * 144 + vt_t * 2) = (bf16_t)(w[i] & 0xffffu); *(LAS bf16_t*)(VT + (vt_v8 + 2 * i + 1) * 144 + vt_t * 2) = (bf16_t)(w[i] >> 16); } }
#define GLA_OSTORE(n_) do { const u32x4 od = *(const LAS u32x4*)(PPW + (lane >> 2) * 144 + (lane & 3) * 16); \
                *(u32x4*)(Og + (size_t)gla_row(n_, (wave >> 1) * 16 + (lane >> 2), b, dir) * D + h * 128 + vs * 64 + (wave & 1) * 32 + (lane & 3) * 8) = od; } while (0)
            if (n > 0) GLA_OSTORE(n - 1);
            f32x2 pre = (f32x2){0.f, 0.f}, bref = (f32x2){0.f, 0.f}, blast = (f32x2){0.f, 0.f};
#pragma unroll
            for (int g8 = 0; g8 < 8; ++g8) { const f32x2 gv = *(const LAS f32x2*)(GT0 + par * 1024 + g8 * 128 + kc2); if (g8 < tg) pre += gv; if (g8 < 4) bref += gv; blast += gv; }
            const float era = __expf(bref.x), erb = __expf(bref.y), ela = __expf(blast.x - bref.x), elb = __expf(blast.y - bref.y);
            float e1a = __expf(pre.x - bref.x), e1b = __expf(pre.y - bref.y);
            unsigned kota[4], kotb[4];
#pragma unroll
            for (int i = 0; i < 8; ++i) {
                const int t = tg * 8 + i;
                const float qa = bflo(q2[i]), qb = bfhi(q2[i]);
                e1a *= fa[i]; e1b *= fb[i];
                const float ka = 1.0f - fa[i], kb = 1.0f - fb[i];
                const float e2a = __builtin_amdgcn_rcpf(e1a), e2b = __builtin_amdgcn_rcpf(e1b);
                const float qsa = qa * e1a, qsb = qb * e1b, ksa = ka * e2a, ksb = kb * e2b;
                *(LAS unsigned*)(QS + t * 272 + kc2 * 2) = cvt_pk_bf16(qsa, qsb);
                *(LAS unsigned*)(KS + t * 272 + kc2 * 2) = cvt_pk_bf16(ksa, ksb);
                *(LAS unsigned*)(QIN + t * 272 + kc2 * 2) = cvt_pk_bf16(qsa * era, qsb * erb);
                const unsigned ko = cvt_pk_bf16(ksa * ela, ksb * elb);
                if (i & 1) { kota[i >> 1] |= ko << 16; kotb[i >> 1] |= ko & 0xffff0000u; } else { kota[i >> 1] = ko & 0xffffu; kotb[i >> 1] = ko >> 16; }
            }
            { const int rot = ((kc2 >> 4) + tg) & 7;
              *(LAS u32x4*)(KOT + kc2 * 144 + rot * 16) = (u32x4){kota[0], kota[1], kota[2], kota[3]};
              *(LAS u32x4*)(KOT + (kc2 + 1) * 144 + rot * 16) = (u32x4){kotb[0], kotb[1], kotb[2], kotb[3]}; }
            if (tg == 0) *(LAS f32x2*)(BL + kc2) = (f32x2){__expf(blast.x), __expf(blast.y)};
            if (n + 1 < 68) GLA_LOAD(n + 1);
            __syncthreads();
            const int tt = wave >> 1;
            bf16x8 aq[4];
#pragma unroll
            for (int kk = 0; kk < 4; ++kk) aq[kk] = *(const LAS bf16x8*)(QS + (tt * 16 + fr) * 272 + (kk * 32 + fq * 8) * 2);
#pragma unroll
            for (int st = 0; st < 4; ++st) {
                f32x4 acc = (f32x4){0.f, 0.f, 0.f, 0.f};
                if (st <= tt) {
#pragma unroll
                    for (int kk = 0; kk < 4; ++kk) {
                        const bf16x8 bv = *(const LAS bf16x8*)(KS + (st * 16 + fr) * 272 + (kk * 32 + fq * 8) * 2);
                        acc = __builtin_amdgcn_mfma_f32_16x16x32_bf16(aq[kk], bv, acc, 0, 0, 0);
                    }
                }
#pragma unroll
                for (int j = 0; j < 4; ++j) { const int tl = fq * 4 + j, s = st * 16 + fr; *(LAS bf16_t*)(PPW + tl * 144 + s * 2) = (bf16_t)f2bf(s <= tt * 16 + tl ? acc[j] : 0.f); }
            }
            LDS_WAIT();
            unsigned ow[2][2];
            bf16x8 ap[2], ai[4];
#pragma unroll
            for (int kk = 0; kk < 2; ++kk) ap[kk] = *(const LAS bf16x8*)(PPW + fr * 144 + (kk * 32 + fq * 8) * 2);
#pragma unroll
            for (int kk = 0; kk < 4; ++kk) ai[kk] = *(const LAS bf16x8*)(QIN + (tt * 16 + fr) * 272 + (kk * 32 + fq * 8) * 2);
#pragma unroll
            for (int vti = 0; vti < 2; ++vti) {
                const int vt = 2 * (wave & 1) + vti; f32x4 acc = (f32x4){0.f, 0.f, 0.f, 0.f};
#pragma unroll
                for (int kk = 0; kk < 2; ++kk) {
                    const bf16x8 bv = *(const LAS bf16x8*)(VT + (vt * 16 + fr) * 144 + (kk * 32 + fq * 8) * 2);
                    acc = __builtin_amdgcn_mfma_f32_16x16x32_bf16(ap[kk], bv, acc, 0, 0, 0);
                }
#pragma unroll
                for (int kk = 0; kk < 4; ++kk) {
                    const bf16x8 bv = *(const LAS bf16x8*)(STc + (vt * 16 + fr) * 272 + (kk * 32 + fq * 8) * 2);
                    acc = __builtin_amdgcn_mfma_f32_16x16x32_bf16(ai[kk], bv, acc, 0, 0, 0);
                }
                ow[vti][0] = cvt_pk_bf16(acc[0], acc[1]); ow[vti][1] = cvt_pk_bf16(acc[2], acc[3]);
            }
#pragma unroll
            for (int vti = 0; vti < 2; ++vti)
#pragma unroll
                for (int j = 0; j < 4; ++j) { const unsigned w = ow[vti][j >> 1]; *(LAS bf16_t*)(PPW + (fq * 4 + j) * 144 + (vti * 16 + fr) * 2) = (bf16_t)((j & 1) ? (w >> 16) : (w & 0xffffu)); }
            bf16x8 ak[2]; const f32x4 blv = *(const LAS f32x4*)(BL + wave * 16 + fq * 4);
#pragma unroll
            for (int kk = 0; kk < 2; ++kk) ak[kk] = *(const LAS bf16x8*)(KOT + (wave * 16 + fr) * 144 + (((kk * 4 + fq) + wave) & 7) * 16);
#pragma unroll
            for (int vt = 0; vt < 4; ++vt) {
                Sacc[vt] *= blv;
#pragma unroll
                for (int kk = 0; kk < 2; ++kk) {
                    const bf16x8 bv = *(const LAS bf16x8*)(VT + (vt * 16 + fr) * 144 + (kk * 32 + fq * 8) * 2);
                    Sacc[vt] = __builtin_amdgcn_mfma_f32_16x16x32_bf16(ak[kk], bv, Sacc[vt], 0, 0, 0);
                }
                *(LAS u32x2*)(STn + (vt * 16 + fr) * 272 + (wave * 16 + fq * 4) * 2) = (u32x2){pk2(Sacc[vt][0], Sacc[vt][1]), pk2(Sacc[vt][2], Sacc[vt][3])};
            }
            if (n + 1 < 68) GLA_CUMSUM(par ^ 1);
            __syncthreads();
        }
        GLA_OSTORE(67);
    }
}
#undef GLA_OSTORE
#undef GLA_CUMSUM
#undef GLA_LOAD
__device__ __forceinline__ void gla_readout_phase(const Args& a, int lane, int gw, int NGW) {
    const bf16_t* OF = (const bf16_t*)(a.ws + WS_OF); const bf16_t* OB = (const bf16_t*)(a.ws + WS_OB);
    const bf16_t* G = (const bf16_t*)(a.ws + WS_G); bf16_t* OG = (bf16_t*)(a.ws + WS_OG);
    f32x4 ng[4];
#pragma unroll
    for (int j = 0; j < 4; ++j) ng[j] = *(const f32x4*)(a.in[I_HGNG] + 16 * lane + 4 * j);
    for (int row0 = gw * 4; row0 < NTOK; row0 += NGW * 4) {
        u32x4 of[4][2], ob[4][2], gg[4][2];
#pragma unroll
        for (int r = 0; r < 4; ++r) { const size_t o = (size_t)(row0 + r) * D + 16 * lane;
            of[r][0] = *(const u32x4*)(OF + o); of[r][1] = *(const u32x4*)(OF + o + 8); ob[r][0] = *(const u32x4*)(OB + o); ob[r][1] = *(const u32x4*)(OB + o + 8);
            gg[r][0] = *(const u32x4*)(G + o); gg[r][1] = *(const u32x4*)(G + o + 8); }
#pragma unroll
        for (int r = 0; r < 4; ++r) {
            float v[16]; float s = 0.f;
#pragma unroll
            for (int q = 0; q < 8; ++q) { const unsigned wf = of[r][q >> 2][q & 3], wb = ob[r][q >> 2][q & 3]; v[2 * q] = bflo(wf) + bflo(wb); v[2 * q + 1] = bfhi(wf) + bfhi(wb); s += v[2 * q] * v[2 * q] + v[2 * q + 1] * v[2 * q + 1]; }
            s += __shfl_xor(s, 1); s += __shfl_xor(s, 2); s += __shfl_xor(s, 4);
            const float rstd = 1.0f / sqrtf(s * (1.0f / 128.0f) + EPS);
            unsigned ow[8];
#pragma unroll
            for (int q = 0; q < 8; ++q) { const unsigned wg = gg[r][q >> 2][q & 3];
                ow[q] = pk2(v[2 * q] * rstd * ng[q >> 1][(2 * q) & 3] * silu_f(bflo(wg)), v[2 * q + 1] * rstd * ng[q >> 1][(2 * q + 1) & 3] * silu_f(bfhi(wg))); }
            const size_t o = (size_t)(row0 + r) * D + 16 * lane;
            *(u32x4*)(OG + o) = (u32x4){ow[0], ow[1], ow[2], ow[3]}; *(u32x4*)(OG + o + 8) = (u32x4){ow[4], ow[5], ow[6], ow[7]};
        }
    }
}

struct EpiMoe1 {
    static constexpr bool PERM = true;
    const float* b1; bf16_t* ACT;
    __device__ __forceinline__ void operator()(const f32x4 (&acc)[2][2][4][2], const Unit& u, int wr, int wc, int fr, int fq) const {
        const int e = u.pn >> 3, pnl = u.pn & 7, cb = pnl * 128 + wc * 32 + 8 * fq, row0 = u.pm * 256 + wr * 64 + fr;
        const float* bg = b1 + (size_t)e * 2048;
        const f32x4 bg0 = *(const f32x4*)(bg + cb), bg1 = *(const f32x4*)(bg + cb + 4), bl0 = *(const f32x4*)(bg + 1024 + cb), bl1 = *(const f32x4*)(bg + 1024 + cb + 4);
#pragma unroll
        for (int ai = 0; ai < 2; ++ai)
#pragma unroll
            for (int m = 0; m < 4; ++m) {
                f32x4 o[2];
#pragma unroll
                for (int n = 0; n < 2; ++n) {
                    const f32x4 zg = acc[ai][0][m][n] + (n ? bg1 : bg0), zl = acc[ai][1][m][n] + (n ? bl1 : bl0);
#pragma unroll
                    for (int j = 0; j < 4; ++j) { const float g_ = fminf(zg[j], 7.0f), l_ = fminf(fmaxf(zl[j], -7.0f), 7.0f); o[n][j] = g_ * sigmoid_f(1.702f * g_) * (l_ + 1.0f); }
                }
                *(u32x4*)(ACT + (size_t)(row0 + ai * 128 + m * 16) * D + cb) = (u32x4){pk2(o[0][0], o[0][1]), pk2(o[0][2], o[0][3]), pk2(o[1][0], o[1][1]), pk2(o[1][2], o[1][3])};
            }
    }
};
struct EpiMoe2 {
    static constexpr bool PERM = true;
    const float* b2; bf16_t* YS;
    __device__ __forceinline__ void operator()(const f32x4 (&acc)[2][2][4][2], const Unit& u, int wr, int wc, int fr, int fq) const {
        const int e = u.pn >> 2, pnl = u.pn & 3, cb = pnl * 256 + wc * 32 + 8 * fq, row0 = u.pm * 256 + wr * 64 + fr;
        const float* bb = b2 + (size_t)e * 1024;
#pragma unroll
        for (int bj = 0; bj < 2; ++bj) {
            const int c = cb + bj * 128; const f32x4 bv0 = *(const f32x4*)(bb + c), bv1 = *(const f32x4*)(bb + c + 4);
#pragma unroll
            for (int ai = 0; ai < 2; ++ai)
#pragma unroll
                for (int m = 0; m < 4; ++m) {
                    const f32x4 v0 = acc[ai][bj][m][0] + bv0, v1 = acc[ai][bj][m][1] + bv1;
                    *(u32x4*)(YS + (size_t)(row0 + ai * 128 + m * 16) * D + c) = (u32x4){pk2(v0[0], v0[1]), pk2(v0[2], v0[3]), pk2(v1[0], v1[1]), pk2(v1[2], v1[3])};
                }
        }
    }
};

__device__ __forceinline__ void router_phase(const Args& a, LAS unsigned char* lds, int layer, int row_lo, int tid) {
    const int lane = tid & 63, wave = tid >> 6, fr = lane & 15, fq = lane >> 4;
    const bf16_t* H = (const bf16_t*)(a.ws + WS_H); bf16_t* F = (bf16_t*)(a.ws + WS_F);
    const float* modv = (const float*)(a.ws + WS_MODV) + (size_t)layer * 9 * 6144;
    int* TOKE = (int*)(a.ws + WS_TOKE); float* TOKW = (float*)(a.ws + WS_TOKW);
    unsigned* cntb = (unsigned*)(a.ws + WS_CTL) + CW_CNTB + layer * 8192;
    LAS unsigned char* FH = lds;
    LAS unsigned char* FL = lds + 16 * 2064;
    LAS float* PART = (LAS float*)(lds + 2 * 16 * 2064);
    LAS int* hist = (LAS int*)(lds + 2 * 16 * 2064 + 16384);
    if (tid < 32) hist[tid] = 0;
    const float* n2g = a.in[I_N2G] + layer * D; const float* rw = a.in[I_RW] + (size_t)layer * D * NE; const float* rb = a.in[I_RB] + layer * NE;
    const float* rwp = rw + (size_t)(wave * 128 + fq * 8) * NE + fr;
    bf16x8 rwH[2][4], rwL[2][4];
#pragma unroll
    for (int kk = 0; kk < 4; ++kk) {
#pragma unroll
        for (int et = 0; et < 2; ++et)
#pragma unroll
            for (int j = 0; j < 8; ++j) {
                const float w = rwp[kk * 32 * NE + j * NE + et * 16];
                const unsigned h = f2bf(w); const float lo = w - bf2f((unsigned short)h);
                rwH[et][kk][j] = (short)h; rwL[et][kk][j] = (short)f2bf(lo);
            }
        asm volatile("" ::: "memory");
    }
    const int ngroups = (NTOK - row_lo) >> 4;
    u32x2 vvp[2][4]; f32x4 gvv[4], scvv[4], shvv[4];
#pragma unroll
    for (int j = 0; j < 4; ++j) gvv[j] = *(const f32x4*)(n2g + 4 * lane + 256 * j);
#define RT_LOAD(gi_) do { _Pragma("unroll") for (int rr = 0; rr < 2; ++rr) _Pragma("unroll") for (int j = 0; j < 4; ++j) \
        vvp[rr][j] = *(const u32x2*)(H + (size_t)(row_lo + (gi_) * 16 + 2 * wave + rr) * D + 4 * lane + 256 * j); \
        { const float* mvp_ = modv + (size_t)mod_row(row_lo + (gi_) * 16) * 6144; _Pragma("unroll") for (int j = 0; j < 4; ++j) { scvv[j] = *(const f32x4*)(mvp_ + 4096 + 4 * lane + 256 * j); shvv[j] = *(const f32x4*)(mvp_ + 3072 + 4 * lane + 256 * j); } } } while (0)
    if ((int)blockIdx.x < ngroups) RT_LOAD(blockIdx.x);
    int pend_i = 0; float pend_w = 0.f; long pend_o = -1;
    for (int gi = blockIdx.x; gi < ngroups; gi += gridDim.x) {
        const int row0 = row_lo + gi * 16;
        __syncthreads();
#pragma unroll
        for (int rr = 0; rr < 2; ++rr) {
            const int rl = 2 * wave + rr, row = row0 + rl; f32x4 v[4];
#pragma unroll
            for (int j = 0; j < 4; ++j) { const u32x2 w = vvp[rr][j]; v[j] = (f32x4){bflo(w.x), bfhi(w.x), bflo(w.y), bfhi(w.y)}; }
            const float rstd = row_rstd(v);
#pragma unroll
            for (int j = 0; j < 4; ++j) {
                const int c = 4 * lane + 256 * j;
                const f32x4 f = v[j] * rstd * gvv[j] * (scvv[j] + 1.0f) + shvv[j];
                st_bf16x4(F + (size_t)row * D + c, f);
                { const unsigned h01 = cvt_pk_bf16(f[0], f[1]), h23 = cvt_pk_bf16(f[2], f[3]);
                  *(LAS u32x2*)(FH + rl * 2064 + c * 2) = (u32x2){h01, h23};
                  *(LAS u32x2*)(FL + rl * 2064 + c * 2) = (u32x2){cvt_pk_bf16(f[0] - bflo(h01), f[1] - bfhi(h01)), cvt_pk_bf16(f[2] - bflo(h23), f[3] - bfhi(h23))}; }
            }
        }
        if (pend_o >= 0) { TOKE[pend_o] = pend_i; TOKW[pend_o] = pend_w; pend_o = -1; }
        if (gi + (int)gridDim.x < ngroups) RT_LOAD(gi + gridDim.x);
        __syncthreads();
        f32x4 acc0 = (f32x4){0.f, 0.f, 0.f, 0.f}, acc1 = (f32x4){0.f, 0.f, 0.f, 0.f};
        bf16x8 aH[4], aL[4];
#pragma unroll
        for (int kk = 0; kk < 4; ++kk) { aH[kk] = *(const LAS bf16x8*)(FH + fr * 2064 + (wave * 128 + kk * 32 + fq * 8) * 2); aL[kk] = *(const LAS bf16x8*)(FL + fr * 2064 + (wave * 128 + kk * 32 + fq * 8) * 2); }
#pragma unroll
        for (int kk = 0; kk < 4; ++kk) {
            acc0 = __builtin_amdgcn_mfma_f32_16x16x32_bf16(aL[kk], rwH[0][kk], acc0, 0, 0, 0); acc1 = __builtin_amdgcn_mfma_f32_16x16x32_bf16(aL[kk], rwH[1][kk], acc1, 0, 0, 0);
            acc0 = __builtin_amdgcn_mfma_f32_16x16x32_bf16(aH[kk], rwL[0][kk], acc0, 0, 0, 0); acc1 = __builtin_amdgcn_mfma_f32_16x16x32_bf16(aH[kk], rwL[1][kk], acc1, 0, 0, 0);
            acc0 = __builtin_amdgcn_mfma_f32_16x16x32_bf16(aH[kk], rwH[0][kk], acc0, 0, 0, 0); acc1 = __builtin_amdgcn_mfma_f32_16x16x32_bf16(aH[kk], rwH[1][kk], acc1, 0, 0, 0);
        }
#pragma unroll
        for (int j = 0; j < 4; ++j) { PART[(wave * 16 + fq * 4 + j) * 32 + fr] = acc0[j]; PART[(wave * 16 + fq * 4 + j) * 32 + 16 + fr] = acc1[j]; }
        __syncthreads();
        {
            const int half = lane >> 5, e = lane & 31, rl = 2 * wave + half, row = row0 + rl;
            float lg = rb[e];
#pragma unroll
            for (int w = 0; w < 8; ++w) lg += PART[(w * 16 + rl) * 32 + e];
            float sv[4]; int si[4];
#pragma unroll
            for (int r = 0; r < 4; ++r) {
                float m = lg;
#pragma unroll
                for (int o = 1; o < 32; o <<= 1) m = fmaxf(m, __shfl_xor(m, o));
                const unsigned long long bal = __ballot(lg == m); const unsigned mine = (unsigned)(bal >> (32 * half));
                const int idx = __ffs((int)mine) - 1;
                sv[r] = m; si[r] = idx; if (e == idx) lg = -3.0e38f;
            }
            const float e1 = __expf(sv[1] - sv[0]), e2 = __expf(sv[2] - sv[0]), e3 = __expf(sv[3] - sv[0]); const float inv = 1.0f / (1.0f + e1 + e2 + e3);
            if (e < 4) {
                const int myi = e == 0 ? si[0] : (e == 1 ? si[1] : (e == 2 ? si[2] : si[3]));
                const float myw = (e == 0 ? 1.0f : (e == 1 ? e1 : (e == 2 ? e2 : e3))) * inv;
                pend_i = myi; pend_w = myw; pend_o = (long)row * 4 + e;
                atomicAdd((int*)hist + myi, 1);
            }
        }
    }
    if (pend_o >= 0) { TOKE[pend_o] = pend_i; TOKW[pend_o] = pend_w; }
    __syncthreads();
    if (tid < 32) cntb[(size_t)blockIdx.x * 32 + tid] = (unsigned)hist[tid];
}
#undef RT_LOAD
__device__ __forceinline__ void assign_phase(const Args& a, LAS unsigned char* lds, int layer, int row_lo, int tid) {
    const int lane = tid & 63, wave = tid >> 6;
    const unsigned* cntb = (const unsigned*)(a.ws + WS_CTL) + CW_CNTB + layer * 8192; unsigned* gcnt = (unsigned*)(a.ws + WS_CTL) + CW_CNT + layer * 64;
    const bf16_t* F = (const bf16_t*)(a.ws + WS_F); bf16_t* AG = (bf16_t*)(a.ws + WS_AG);
    const int* TOKE = (const int*)(a.ws + WS_TOKE); int* TOKS = (int*)(a.ws + WS_TOKS);
    LAS int* off = (LAS int*)lds; LAS int* cnt = (LAS int*)(lds + 256); LAS int* base = (LAS int*)(lds + 512); LAS int* cur = (LAS int*)(lds + 768);
    LAS int* pa = (LAS int*)(lds + 1024); LAS int* pl = (LAS int*)(lds + 1024 + 2048);
    {
        const int e = tid & 31, part = tid >> 5; int s_all = 0, s_lt = 0;
        for (int bb = part; bb < (int)gridDim.x; bb += 16) { const int c = (int)cntb[(size_t)bb * 32 + e]; s_all += c; if (bb < (int)blockIdx.x) s_lt += c; }
        pa[part * 32 + e] = s_all; pl[part * 32 + e] = s_lt;
    }
    __syncthreads();
    if (tid < 32) { int s_all = 0, s_lt = 0; for (int p = 0; p < 16; ++p) { s_all += pa[p * 32 + tid]; s_lt += pl[p * 32 + tid]; } cnt[tid] = s_all; base[tid] = s_lt; cur[tid] = 0; if (blockIdx.x == 0) gcnt[tid] = (unsigned)s_all; }
    __syncthreads();
    if (tid == 0) { int o = 0; for (int e = 0; e < 32; ++e) { off[e] = o; o += ((cnt[e] + 255) >> 8) << 8; } }
    __syncthreads();
    if (tid < 32) base[tid] += off[tid];
    __syncthreads();
    const int gw = blockIdx.x * 8 + wave, NGW = gridDim.x * 8;
    int* SLOTTOK = (int*)(a.ws + WS_SLOTTOK);
    for (int idx = blockIdx.x * NTHREADS + tid; idx < 32 * 256; idx += gridDim.x * NTHREADS) {
        const int e = idx >> 8, c = cnt[e], r = c + (idx & 255), padded = ((c + 255) >> 8) << 8;
        if (r < padded) SLOTTOK[off[e] + r] = 0;
    }
    const int ngroups = (NTOK - row_lo) >> 4;
    for (int gi = blockIdx.x; gi < ngroups; gi += gridDim.x) {
        const int r0 = row_lo + gi * 16 + 2 * wave;
        if (lane < 8) { const int e = TOKE[(size_t)r0 * 4 + lane]; const int pos = atomicAdd((int*)cur + e, 1); const int slot = base[e] + pos; TOKS[(size_t)r0 * 4 + lane] = slot; SLOTTOK[slot] = r0 + (lane >> 2); }
    }
    (void)gw; (void)NGW; (void)F; (void)AG;
}
__device__ __forceinline__ int moe_tiles(const Args& a, LAS unsigned char* lds, int layer, int tid) {
    const unsigned* gcnt = (const unsigned*)(a.ws + WS_CTL) + CW_CNT + layer * 64;
    LAS int* tbl = (LAS int*)(lds + 131072 + 1024);
    if (tid == 0) { int t = 0; for (int e = 0; e < 32; ++e) { const int nt = ((int)gcnt[e] + 255) >> 8; for (int k = 0; k < nt; ++k) tbl[t++] = e; } tbl[1000] = t; }
    __syncthreads();
    return tbl[1000];
}
__device__ __forceinline__ void combine_phase(const Args& a, int layer, int row_lo, int lane, int gw, int NGW) {
    bf16_t* H = (bf16_t*)(a.ws + WS_H); const bf16_t* YS = (const bf16_t*)(a.ws + WS_YS);
    const int* TOKS = (const int*)(a.ws + WS_TOKS); const float* TOKW = (const float*)(a.ws + WS_TOKW);
    const float* modv = (const float*)(a.ws + WS_MODV);
    for (int row0 = row_lo + gw * 2; row0 < NTOK; row0 += NGW * 2) {
        const int mr = mod_row(row0);
        u32x4 sl[2]; f32x4 wv[2];
#pragma unroll
        for (int r = 0; r < 2; ++r) { sl[r] = *(const u32x4*)(TOKS + (size_t)(row0 + r) * 4); wv[r] = *(const f32x4*)(TOKW + (size_t)(row0 + r) * 4); }
        u32x2 ys[2][4][4]; f32x4 hv[2][4];
#pragma unroll
        for (int r = 0; r < 2; ++r)
#pragma unroll
            for (int j = 0; j < 4; ++j) {
                hv[r][j] = ld_bf16x4(H + (size_t)(row0 + r) * D + 4 * lane + 256 * j);
#pragma unroll
                for (int k = 0; k < 4; ++k) ys[r][k][j] = *(const u32x2*)(YS + (size_t)sl[r][k] * D + 4 * lane + 256 * j);
            }
        const float* g2 = modv + (size_t)(layer * 9 + mr) * 6144 + 5120;
        f32x4 g2v[4];
#pragma unroll
        for (int j = 0; j < 4; ++j) g2v[j] = *(const f32x4*)(g2 + 4 * lane + 256 * j);
        ModVec m;
        if (layer == 0) { const float* mv = modv + (size_t)(9 + mr) * 6144; modvec_load(m, a.in[I_N1G] + D, mv + 1024, mv, lane); }
        else {
#pragma unroll
            for (int j = 0; j < 4; ++j) m.g[j] = *(const f32x4*)(a.in[I_FG] + 4 * lane + 256 * j);
        }
#pragma unroll
        for (int r = 0; r < 2; ++r) {
            const int row = row0 + r; f32x4 v[4];
#pragma unroll
            for (int j = 0; j < 4; ++j) {
                const int c = 4 * lane + 256 * j; f32x4 y = (f32x4){0.f, 0.f, 0.f, 0.f};
#pragma unroll
                for (int k = 0; k < 4; ++k) { const u32x2 w = ys[r][k][j]; y += (f32x4){bflo(w.x), bfhi(w.x), bflo(w.y), bfhi(w.y)} * wv[r][k]; }
                v[j] = hv[r][j] + g2v[j] * y;
                if (layer == 0) st_bf16x4(H + (size_t)row * D + c, v[j]);
            }
            const float rstd = row_rstd(v);
            if (layer == 0) {
                int orow = row;
                if (row >= NCTX) { const int li = row - NCTX, b = li >> 12, t = li & 4095; orow = NCTX + b * SEQ + (t & 63) * 64 + (t >> 6); }
                norm_mod_store(v, rstd, m, (bf16_t*)(a.ws + WS_A) + (size_t)orow * D, lane);
            } else {
#pragma unroll
                for (int j = 0; j < 4; ++j) { const int c = 4 * lane + 256 * j; *(f32x4*)(a.out + (size_t)(row - NCTX) * D + c) = v[j] * rstd * m.g[j]; }
            }
        }
    }
}
__device__ __forceinline__ void moe_gemm1(const Args& a, LAS unsigned char* lds, int layer, int tid, int G, int vcu) {
    unsigned char* ws = a.ws;
    const int TT = moe_tiles(a, lds, layer, tid);
    const LAS int* tbl = (const LAS int*)(lds + 131072 + 1024);
    pg8::Gemm g{(const bf16_t*)(ws + WS_F), (const bf16_t*)(ws + WS_W1) + (size_t)layer * 32 * 2048 * 1024, MPAD, 32 * 2048, 1024};
    pg8::MoeOrder S{tbl, TT, 3, G, vcu};
    EpiMoe1 E{a.in[I_B1] + (size_t)layer * 32 * 2048, (bf16_t*)(ws + WS_ACT)};
    LAS unsigned short* rowl = (LAS unsigned short*)(lds + 136192);
    { const int* slottok = (const int*)(ws + WS_SLOTTOK); pg8::Unit uu; int t2 = threadIdx.x; asm volatile("" : "+v"(t2)); const int tid = t2;
      for (int i = 0; i < 21; i += 2) { const int ii = i + (tid >> 8); if (ii < 21 && S.next(ii, uu)) rowl[ii * 256 + (tid & 255)] = (unsigned short)slottok[uu.pm * 256 + (tid & 255)]; } }
    __syncthreads();
    pg8::gemm_phase<EpiMoe1, pg8::MoeOrder, true>(lds, g, S, E, rowl);
}
__device__ __forceinline__ void moe_gemm2(const Args& a, LAS unsigned char* lds, int layer, int tid, int G, int vcu) {
    unsigned char* ws = a.ws;
    const int TT = moe_tiles(a, lds, layer, tid);
    const LAS int* tbl = (const LAS int*)(lds + 131072 + 1024);
    pg8::Gemm g{(const bf16_t*)(ws + WS_ACT), (const bf16_t*)(ws + WS_W2) + (size_t)layer * 32 * 1024 * 1024, MPAD, 32 * 1024, 1024};
    pg8::MoeOrder S{tbl, TT, 2, G, vcu};
    EpiMoe2 E{a.in[I_B2] + (size_t)layer * 32 * 1024, (bf16_t*)(ws + WS_YS)};
    pg8::gemm_phase<EpiMoe2, pg8::MoeOrder>(lds, g, S, E);
}


__device__ __forceinline__ void s5_disc(const Args& a, int d, int g, int p, float& ab_re, float& ab_im, float& co_re, float& co_im) {
    const float lam_re = fminf(a.in[I_S5ARE][(d * 64 + g) * 64 + p], -1e-4f), lam_im = a.in[I_S5AIM][(d * 64 + g) * 64 + p];
    const float dt = expf(a.in[I_S5LDT][d * 64 + g]);
    const float mag = expf(lam_re * dt), ang = lam_im * dt;
    ab_re = mag * cosf(ang); ab_im = mag * sinf(ang);
    const float den = lam_re * lam_re + lam_im * lam_im;
    co_re = ((ab_re - 1.0f) * lam_re + ab_im * lam_im) / den;
    co_im = (ab_im * lam_re - (ab_re - 1.0f) * lam_im) / den;
}
__device__ __forceinline__ void s5_phase(const Args& a, LAS unsigned char* lds, int tid) {
    const int lane = tid & 63, wave = tid >> 6, fr = lane & 15, fq = lane >> 4;
    if (wave >= 4) {
        LAS unsigned* scr = (LAS unsigned*)(lds + 104448 + (wave - 4) * 8320);
        const int cw = blockIdx.x * 4 + (wave - 4), NCW = gridDim.x * 4;
#define L1_ITEM(i) moe_item(a, (i), 1)
        TR_LOOP(cw, NCW, 32 * 512 + 32 * 256, L1_ITEM);
#undef L1_ITEM
        return;
    }
    LAS unsigned char* wl = lds + wave * 26112;
    const bf16_t* A1 = (const bf16_t*)(a.ws + WS_A);
    for (int item = blockIdx.x; item < 256; item += gridDim.x) {
        const int b = item >> 5, dir = (item >> 4) & 1, g = (item & 15) * 4 + wave;
        bf16_t* Y = (bf16_t*)(a.ws + (dir ? WS_YB : WS_YF));
        float ab_re, ab_im, cr_, ci_;
        s5_disc(a, dir, g, lane, ab_re, ab_im, cr_, ci_);
        bf16x8 Bd[4], Cf[4];
        {
            f32x4 cre[4], cim[4];
#pragma unroll
            for (int kk = 0; kk < 4; ++kk) { const size_t o = ((size_t)(dir * 64 + g) * 16 + fr) * 64 + kk * 16 + fq * 4; cre[kk] = *(const f32x4*)(a.in[I_S5CRE] + o); cim[kk] = *(const f32x4*)(a.in[I_S5CIM] + o); }
#pragma unroll
            for (int kk = 0; kk < 4; ++kk)
#pragma unroll
                for (int j = 0; j < 8; ++j) Cf[kk][j] = (short)f2bf((j & 1) ? -cim[kk][j >> 1] : cre[kk][j >> 1]);
            {
                const int c31 = lane & 31, h5 = lane >> 5;
                f32x4 br0[4], br1[4], bi0[4], bi1[4];
#pragma unroll
                for (int ct = 0; ct < 4; ++ct) {
                    const int pp = ct * 16 + (c31 >> 1); const size_t o = (size_t)(g * 64 + pp) * 16 + h5 * 8;
                    br0[ct] = *(const f32x4*)(a.in[I_S5BRE] + o); br1[ct] = *(const f32x4*)(a.in[I_S5BRE] + o + 4); bi0[ct] = *(const f32x4*)(a.in[I_S5BIM] + o); bi1[ct] = *(const f32x4*)(a.in[I_S5BIM] + o + 4);
                }
#pragma unroll
                for (int ct = 0; ct < 4; ++ct) {
                    const int pp = ct * 16 + (c31 >> 1); const float qr = __shfl(cr_, pp), qi = __shfl(ci_, pp);
#pragma unroll
                    for (int j = 0; j < 8; ++j) {
                        const float br = j < 4 ? br0[ct][j & 3] : br1[ct][j & 3], bi = j < 4 ? bi0[ct][j & 3] : bi1[ct][j & 3];
                        Bd[ct][j] = (short)f2bf((c31 & 1) ? (qr * bi + qi * br) : (qr * br - qi * bi));
                    }
                }
            }
        }
#define S5_POS(n_, t_) ((((n_) < 8) ? (n_) : (n_) - 8) * 32 + (t_))
#define S5_ROW(n_, t_) ((((n_) < 8) ? b * CTXL : NCTX + b * SEQ) + (dir ? (((n_) < 8) ? CTXL : SEQ) - 1 - S5_POS(n_, t_) : S5_POS(n_, t_)))
#define S5_LOADU(d0, n_) do { d0 = (bf16x8){0, 0, 0, 0, 0, 0, 0, 0}; if ((n_) < 136) d0 = *(const bf16x8*)(A1 + (size_t)S5_ROW(n_, lane & 31) * D + g * 16 + (lane >> 5) * 8); } while (0)
        LAS float* BUF = (LAS float*)wl; LAS unsigned* HW = (LAS unsigned*)(wl + 17408); const LAS unsigned char* HP = wl + 17408;
        bf16x8 ua0, ub0, uc0;
        S5_LOADU(ua0, 0); S5_LOADU(ub0, 1);
        f32x2 s = (f32x2){0.f, 0.f};
        const f32x2 abr = (f32x2){ab_re, ab_re}, abi = (f32x2){-ab_im, ab_im};
        bf16_t* yp = Y + (size_t)(b * SEQ + (dir ? SEQ - 1 - fq * 4 : fq * 4)) * D + g * 16 + fr;
        const long ystep = dir ? -(long)D : (long)D;
        unsigned yw[4] = {0u, 0u, 0u, 0u};
#define S5_YSTORE() do { yp[0] = (bf16_t)(yw[0] & 0xffffu); yp[ystep] = (bf16_t)(yw[0] >> 16); yp[2 * ystep] = (bf16_t)(yw[1] & 0xffffu); yp[3 * ystep] = (bf16_t)(yw[1] >> 16); \
            yp[16 * ystep] = (bf16_t)(yw[2] & 0xffffu); yp[17 * ystep] = (bf16_t)(yw[2] >> 16); yp[18 * ystep] = (bf16_t)(yw[3] & 0xffffu); yp[19 * ystep] = (bf16_t)(yw[3] >> 16); yp += 32 * ystep; } while (0)
        for (int n = 0; n < 136; ++n) {
#pragma unroll
            for (int ct = 0; ct < 4; ++ct) {
                typedef float f32x16 __attribute__((ext_vector_type(16)));
                f32x16 z; for (int r = 0; r < 16; ++r) z[r] = 0.f;
                const f32x16 d = __builtin_amdgcn_mfma_f32_32x32x16_bf16(Bd[ct], ua0, z, 0, 0, 0);
#pragma unroll
                for (int q = 0; q < 4; ++q) *(LAS f32x4*)(BUF + (lane & 31) * 132 + ct * 32 + 8 * q + 4 * (lane >> 5)) = (f32x4){d[4 * q], d[4 * q + 1], d[4 * q + 2], d[4 * q + 3]};
            }
            if (n >= 9) S5_YSTORE();
            S5_LOADU(uc0, n + 2);
            LDS_WAIT();
            {
                const bool hist = n >= 8;
                f32x2 bu[32];
#pragma unroll
                for (int j = 0; j < 32; ++j) bu[j] = *(const LAS f32x2*)(BUF + j * 132 + 2 * lane);
                unsigned hw[32];
#pragma unroll
                for (int j = 0; j < 32; ++j) { const f32x2 t1 = abr * s + bu[j]; s = abi * (f32x2){s.y, s.x} + t1; hw[j] = cvt_pk_bf16(s.x, s.y); }
                if (hist) {
#pragma unroll
                    for (int j = 0; j < 32; ++j) HW[j * 68 + lane] = hw[j];
                }
            }
            LDS_WAIT();
            if (n >= 8) {
                f32x4 y0 = (f32x4){0.f, 0.f, 0.f, 0.f}, y1 = (f32x4){0.f, 0.f, 0.f, 0.f};
                bf16x8 ha[2][4];
#pragma unroll
                for (int hf = 0; hf < 2; ++hf)
#pragma unroll
                    for (int kk = 0; kk < 4; ++kk) ha[hf][kk] = *(const LAS bf16x8*)(HP + (hf * 16 + fr) * 272 + (kk * 32 + fq * 8) * 2);
#pragma unroll
                for (int kk = 0; kk < 4; ++kk) { y0 = __builtin_amdgcn_mfma_f32_16x16x32_bf16(ha[0][kk], Cf[kk], y0, 0, 0, 0); y1 = __builtin_amdgcn_mfma_f32_16x16x32_bf16(ha[1][kk], Cf[kk], y1, 0, 0, 0); }
                yw[0] = cvt_pk_bf16(y0[0], y0[1]); yw[1] = cvt_pk_bf16(y0[2], y0[3]); yw[2] = cvt_pk_bf16(y1[0], y1[1]); yw[3] = cvt_pk_bf16(y1[2], y1[3]);
                LDS_WAIT();
            }
            ua0 = ub0; ub0 = uc0;
        }
        S5_YSTORE();
#undef S5_YSTORE
#undef S5_POS
#undef S5_ROW
#undef S5_LOADU
    }
}
__device__ __forceinline__ float gelu_tanh_f(float x) { const float z = 0.7978845608f * (x + 0.044715f * x * x * x); return x * (1.0f - __builtin_amdgcn_rcpf(1.0f + __expf(2.0f * z))); }
__device__ __forceinline__ void s5_post_phase(const Args& a, int lane, int gw, int NGW) {
    const bf16_t* YF = (const bf16_t*)(a.ws + WS_YF); const bf16_t* YB = (const bf16_t*)(a.ws + WS_YB);
    const bf16_t* A1 = (const bf16_t*)(a.ws + WS_A); bf16_t* YG = (bf16_t*)(a.ws + WS_YG);
    f32x4 dk[4];
#pragma unroll
    for (int j = 0; j < 4; ++j) dk[j] = *(const f32x4*)(a.in[I_S5D] + 4 * lane + 256 * j);
    for (int tok0 = gw * 4; tok0 < NLAT; tok0 += NGW * 4) {
        u32x2 yf[4][4], yb[4][4], uu[4][4];
#pragma unroll
        for (int r = 0; r < 4; ++r) { const int tok = tok0 + r, b = tok >> 12, t = tok & 4095, src = b * SEQ + (t & 63) * 64 + (t >> 6);
#pragma unroll
            for (int j = 0; j < 4; ++j) { const int c = 4 * lane + 256 * j; yf[r][j] = *(const u32x2*)(YF + (size_t)src * D + c); yb[r][j] = *(const u32x2*)(YB + (size_t)src * D + c); uu[r][j] = *(const u32x2*)(A1 + (size_t)(NCTX + src) * D + c); } }
#pragma unroll
        for (int r = 0; r < 4; ++r)
#pragma unroll
            for (int j = 0; j < 4; ++j) {
                const u32x2 f = yf[r][j], bk = yb[r][j], uw = uu[r][j];
                const f32x4 y = (f32x4){bflo(f.x) + bflo(bk.x), bfhi(f.x) + bfhi(bk.x), bflo(f.y) + bflo(bk.y), bfhi(f.y) + bfhi(bk.y)} + dk[j] * (f32x4){bflo(uw.x), bfhi(uw.x), bflo(uw.y), bfhi(uw.y)};
                f32x4 o;
#pragma unroll
                for (int i = 0; i < 4; ++i) o[i] = gelu_tanh_f(y[i]);
                st_bf16x4(YG + (size_t)(tok0 + r) * D + 4 * lane + 256 * j, o);
            }
    }
}
struct EpiGlu {
    static constexpr bool PERM = true;
    const float* bglu; const float* modv1; bf16_t* H;
    __device__ __forceinline__ void operator()(const f32x4 (&acc)[2][2][4][2], const Unit& u, int wr, int wc, int fr, int fq) const {
        const int rt0 = u.pm * 256, bidx = rt0 >> 12, cb = u.pn * 128 + wc * 32 + 8 * fq, rl0 = wr * 64 + fr;
        const float* gp = modv1 + bidx * 6144 + 2048;
        const f32x4 ba0 = *(const f32x4*)(bglu + cb), ba1 = *(const f32x4*)(bglu + cb + 4), bb0 = *(const f32x4*)(bglu + 1024 + cb), bb1 = *(const f32x4*)(bglu + 1024 + cb + 4);
        const f32x4 gv0 = *(const f32x4*)(gp + cb), gv1 = *(const f32x4*)(gp + cb + 4);
        u32x4 hws[2][4];
#pragma unroll
        for (int ai = 0; ai < 2; ++ai)
#pragma unroll
            for (int m = 0; m < 4; ++m) hws[ai][m] = *(const u32x4*)(H + (size_t)(NCTX + rt0 + rl0 + ai * 128 + m * 16) * D + cb);
#pragma unroll
        for (int ai = 0; ai < 2; ++ai)
#pragma unroll
            for (int m = 0; m < 4; ++m) {
                bf16_t* hp = H + (size_t)(NCTX + rt0 + rl0 + ai * 128 + m * 16) * D + cb;
                const u32x4 hw = hws[ai][m]; const f32x4 h0 = (f32x4){bflo(hw.x), bfhi(hw.x), bflo(hw.y), bfhi(hw.y)}, h1 = (f32x4){bflo(hw.z), bfhi(hw.z), bflo(hw.w), bfhi(hw.w)};
                const f32x4 za0 = acc[ai][0][m][0] + ba0, za1 = acc[ai][0][m][1] + ba1, zb0 = acc[ai][1][m][0] + bb0, zb1 = acc[ai][1][m][1] + bb1; f32x4 o0, o1;
#pragma unroll
                for (int j = 0; j < 4; ++j) { o0[j] = za0[j] * sigmoid_f(zb0[j]); o1[j] = za1[j] * sigmoid_f(zb1[j]); }
                const f32x4 r0 = h0 + gv0 * o0, r1 = h1 + gv1 * o1;
                *(u32x4*)hp = (u32x4){pk2(r0[0], r0[1]), pk2(r0[2], r0[3]), pk2(r1[0], r1[1]), pk2(r1[2], r1[3])};
            }
    }
};

#define XB_TMO      128
#define XB_XCNT(j)  (256  + 64 * (j))
#define XB_XSUB(j)  (1280 + 64 * (j))
#define XB_XGEN(j)  (2304 + 64 * (j))
#define XB_TOP      3328
#define XB_TOPGEN   3392
#define XCD_BAR_WORDS 3456
#define XB_SPIN_CAP (1u << 18)
__device__ __forceinline__ unsigned xb_ld(unsigned* p)              { return __hip_atomic_load(p, __ATOMIC_RELAXED, __HIP_MEMORY_SCOPE_AGENT); }
__device__ __forceinline__ unsigned xb_add(unsigned* p, unsigned v) { return __hip_atomic_fetch_add(p, v, __ATOMIC_RELAXED, __HIP_MEMORY_SCOPE_AGENT); }
__device__ __forceinline__ unsigned xb_xcc_id() { return (unsigned)__builtin_amdgcn_s_getreg((3 << 11) | 20) & 0xFu; }
#define XB_SPIN(cond, bar) do { unsigned _sp = 0; while (cond) { __builtin_amdgcn_s_sleep(1); \
    if ((++_sp & 255u) == 0u) { if (xb_ld(&(bar)[XB_TMO])) break; if (_sp > XB_SPIN_CAP) { atomicAdd(&(bar)[XB_TMO], 1u); break; } } } } while (0)
struct XcdBarrier { unsigned* bar; unsigned x; volatile LAS unsigned* st; };
__device__ __forceinline__ XcdBarrier xcd_barrier_post(unsigned* bar, volatile LAS unsigned* st) {
    XcdBarrier b; b.bar = bar; b.x = xb_xcc_id(); b.st = st;
    if (threadIdx.x == 0) (void)xb_add(&bar[XB_XCNT(b.x)], 1u);
    return b;
}
__device__ __forceinline__ void xcd_barrier_complete(unsigned* bar, unsigned x, unsigned& nloc, unsigned& nx) {
    const unsigned G = gridDim.x * gridDim.y * gridDim.z;
    unsigned sum, cnt, mine, sp = 0u;
    for (;;) {
        sum = 0u; cnt = 0u; mine = 0u;
#pragma unroll
        for (unsigned j = 0; j < 16; ++j) { const unsigned c = xb_ld(&bar[XB_XCNT(j)]); sum += c; cnt += (c > 0u) ? 1u : 0u; mine = (j == x) ? c : mine; }
        if (sum == G) break;
        __builtin_amdgcn_s_sleep(1);
        if ((++sp & 255u) == 0u) { if (xb_ld(&bar[XB_TMO])) break; if (sp > XB_SPIN_CAP) { atomicAdd(&bar[XB_TMO], 1u); break; } }
    }
    nloc = mine > 0u ? mine : 1u; nx = cnt > 0u ? cnt : 1u;
}
__device__ __forceinline__ void xcd_barrier(const XcdBarrier& b) {
    asm volatile("s_waitcnt vmcnt(0)" ::: "memory");
    __syncthreads();
    if (threadIdx.x == 0) {
        unsigned* bar = b.bar;
        __builtin_amdgcn_s_waitcnt(0);
        unsigned nloc = b.st[0], nx = b.st[1];
        if (nloc == 0u) { xcd_barrier_complete(bar, b.x, nloc, nx); b.st[0] = nloc; b.st[1] = nx; }
        const unsigned old = xb_add(&bar[XB_XSUB(b.x)], 1u);
        const unsigned gen = old / nloc;
        if (old + 1u == (gen + 1u) * nloc) {
            __builtin_amdgcn_fence(__ATOMIC_RELEASE, "agent");
            asm volatile("s_waitcnt vmcnt(0)" ::: "memory");
            const unsigned og = xb_add(&bar[XB_TOP], 1u);
            const unsigned tg = og / nx;
            if (og + 1u == (tg + 1u) * nx) xb_add(&bar[XB_TOPGEN], 1u);
            else XB_SPIN(xb_ld(&bar[XB_TOPGEN]) == tg, bar);
            __builtin_amdgcn_fence(__ATOMIC_ACQUIRE, "agent");
            xb_add(&bar[XB_XGEN(b.x)], 1u);
            asm volatile("s_waitcnt vmcnt(0)" ::: "memory");
        } else {
            XB_SPIN(xb_ld(&bar[XB_XGEN(b.x)]) == gen, bar);
            __builtin_amdgcn_fence(__ATOMIC_ACQUIRE, "agent");
            asm volatile("s_waitcnt vmcnt(0)" ::: "memory");
        }
    }
    __syncthreads();
}

__device__ __forceinline__ int opaque_tid() { int t = threadIdx.x; asm volatile("" : "+v"(t)); return t; }
#define PHASE_IDS() const int tid = opaque_tid(); const int lane = tid & 63, wave = tid >> 6; const int G = gridDim.x, gw = blockIdx.x * 8 + wave, NGW = G * 8; \
    const int vcu = (G % 8 == 0) ? (int)(blockIdx.x % 8) * (G / 8) + (int)(blockIdx.x / 8) : (int)blockIdx.x; (void)lane; (void)wave; (void)gw; (void)NGW; (void)vcu; (void)G
__global__ void __launch_bounds__(NTHREADS, 2) fwd_mega(Args a) {
    extern __shared__ __attribute__((aligned(16))) unsigned char lds_raw[];
    LAS unsigned char* lds = (LAS unsigned char*)lds_raw;
    cg::grid_group grid = cg::this_grid();
    unsigned char* ws = a.ws;
    if (threadIdx.x < 2) ((LAS unsigned*)(lds + LDS_BYTES - 16))[threadIdx.x] = 0u;
    __syncthreads();
    const XcdBarrier xbar = xcd_barrier_post((unsigned*)(ws + WS_CTL) + CW_BAR, (volatile LAS unsigned*)(lds + LDS_BYTES - 16));
#ifdef TS_SEL
    volatile LAS unsigned long long* tsbuf = (volatile LAS unsigned long long*)(lds + LDS_BYTES - 16 - 256);
    int tsn = 0;
#define TS_MARK() do { if (blockIdx.x == 0 && threadIdx.x == 0) tsbuf[tsn] = __builtin_amdgcn_s_memrealtime(); ++tsn; } while (0)
#else
#define TS_MARK() do { } while (0)
#endif
    TS_MARK();
#define GSYNC() do { xcd_barrier(xbar); TS_MARK(); } while (0)

    for (int rep = 0; rep < REP_P0; ++rep) { PHASE_IDS(); p0_phase(a, lds, tid, gw, NGW); if (REP_P0 > 1) __syncthreads(); }
    if (a.pad1 != 0) grid.sync();
    GSYNC();
    for (int rep = 0; rep < REP_P1; ++rep) { PHASE_IDS(); p1_phase(a, lane, gw, NGW); }
    GSYNC();
    {
        PHASE_IDS();
        pg8::Gemm g{(const bf16_t*)(ws + WS_A), (const bf16_t*)(ws + WS_WIN), NTOK, 5120, 1024};
        pg8::StaticOrder S; S.init(NTOK, 5120, G, (int)blockIdx.x);
        EpiInProj E{(bf16_t*)(ws + WS_Q), (bf16_t*)(ws + WS_V), (bf16_t*)(ws + WS_G), (_Float16*)(ws + WS_LFF), (_Float16*)(ws + WS_LFB), (const float*)(ws + WS_LBV)};
        for (int rep = 0; rep < REP_INP; ++rep) pg8::gemm_phase<EpiInProj, pg8::StaticOrder>(lds, g, S, E);
    }
    GSYNC();
    for (int rep = 0; rep < REP_GLA; ++rep) { PHASE_IDS(); gla_phase(a, lds, tid); if (REP_GLA > 1) __syncthreads(); }
    GSYNC();
    for (int rep = 0; rep < REP_RO; ++rep) { PHASE_IDS(); gla_readout_phase(a, lane, gw, NGW); }
    GSYNC();
    {
        PHASE_IDS();
        pg8::Gemm g{(const bf16_t*)(ws + WS_OG), (const bf16_t*)(ws + WS_WOUT), NTOK, 1024, 1024};
        pg8::StaticOrder S; S.init(NTOK, 1024, G, (int)blockIdx.x);
        EpiResid E{a.in[I_X], a.in[I_CTX], (const float*)(ws + WS_MODV), (bf16_t*)(ws + WS_H), 2048};
        for (int rep = 0; rep < REP_OUT; ++rep) pg8::gemm_phase<EpiResid, pg8::StaticOrder>(lds, g, S, E);
    }
    GSYNC();
    for (int rep = 0; rep < REP_RT; ++rep) { PHASE_IDS(); router_phase(a, lds, 0, 0, tid); if (REP_RT > 1) __syncthreads(); }
    GSYNC();
    for (int rep = 0; rep < REP_AS; ++rep) { PHASE_IDS(); assign_phase(a, lds, 0, 0, tid); if (REP_AS > 1) __syncthreads(); }
    GSYNC();
    for (int rep = 0; rep < REP_M1; ++rep) { PHASE_IDS(); moe_gemm1(a, lds, 0, tid, G, vcu); }
    GSYNC();
    for (int rep = 0; rep < REP_M2; ++rep) { PHASE_IDS(); moe_gemm2(a, lds, 0, tid, G, vcu); }
    GSYNC();
    { PHASE_IDS(); combine_phase(a, 0, 0, lane, gw, NGW); }
    GSYNC();
    for (int rep = 0; rep < REP_S5; ++rep) { PHASE_IDS(); s5_phase(a, lds, tid); if (REP_S5 > 1) __syncthreads(); }
    GSYNC();
    for (int rep = 0; rep < REP_POST; ++rep) { PHASE_IDS(); s5_post_phase(a, lane, gw, NGW); }
    GSYNC();
    {
        PHASE_IDS();
        pg8::Gemm g{(const bf16_t*)(ws + WS_YG), (const bf16_t*)(ws + WS_WGLU), NLAT, 2048, 1024};
        pg8::StaticOrder S; S.init(NLAT, 2048, G, (int)blockIdx.x);
        EpiGlu E{a.in[I_S5BGLU], (const float*)(ws + WS_MODV) + 9 * 6144, (bf16_t*)(ws + WS_H)};
        pg8::gemm_phase<EpiGlu, pg8::StaticOrder>(lds, g, S, E);
    }
    GSYNC();
    { PHASE_IDS(); router_phase(a, lds, 1, NCTX, tid); }
    GSYNC();
    { PHASE_IDS(); assign_phase(a, lds, 1, NCTX, tid); }
    GSYNC();
    { PHASE_IDS(); moe_gemm1(a, lds, 1, tid, G, vcu); }
    GSYNC();
    { PHASE_IDS(); moe_gemm2(a, lds, 1, tid, G, vcu); }
    GSYNC();
    for (int rep = 0; rep < REP_CMB1; ++rep) { PHASE_IDS(); combine_phase(a, 1, NCTX, lane, gw, NGW); }
#ifdef TS_SEL
    TS_MARK();
    if (blockIdx.x == 0 && threadIdx.x == 0) {
        asm volatile("s_waitcnt vmcnt(0)" ::: "memory"); __threadfence();
        const unsigned long long dt = tsbuf[TS_SEL + 1] - tsbuf[TS_SEL];
        atomicAdd(a.out, (float)dt * 0.001f);
    }
#endif
}

extern "C" void kernel_launch(void* const* d_in, const int* in_sizes, int n_in, void* d_out, int out_size,
                              void* d_ws, size_t ws_size, hipStream_t stream) {
    static int grid_blocks = 0;
    if (!grid_blocks) {
        int dev = 0, cus = 0, per_cu = 0;
        (void)hipGetDevice(&dev);
        (void)hipDeviceGetAttribute(&cus, hipDeviceAttributeMultiprocessorCount, dev);
        (void)hipFuncSetAttribute((const void*)fwd_mega, hipFuncAttributeMaxDynamicSharedMemorySize, LDS_BYTES);
        (void)hipOccupancyMaxActiveBlocksPerMultiprocessor(&per_cu, (const void*)fwd_mega, NTHREADS, LDS_BYTES);
        if (per_cu < 1) { fprintf(stderr, "occupancy query says %d blocks/CU\n", per_cu); }
        grid_blocks = cus < 256 ? cus : 256;
        if (ws_size < WS_END) fprintf(stderr, "kernel_launch: workspace too small: %zu < %zu\n", ws_size, (size_t)WS_END);
    }
    (void)hipMemsetAsync((char*)d_ws + WS_CTL, 0, 1 * MiB, stream);
    Args a{};
    for (int i = 0; i < 29; ++i) a.in[i] = (const float*)d_in[i];
    a.out = (float*)d_out; a.ws = (unsigned char*)d_ws;
    void* kargs[] = {&a};
    hipError_t e = hipLaunchCooperativeKernel((const void*)fwd_mega, dim3(grid_blocks), dim3(NTHREADS), kargs, LDS_BYTES, stream);
    if (e != hipSuccess) fprintf(stderr, "cooperative launch failed: %s (grid %d)\n", hipGetErrorString(e), grid_blocks);
}
```

```cpp
#include <hip/hip_runtime.h>
#include <hip/hip_cooperative_groups.h>
#include <cstdio>
#include <cstdint>
namespace cg = cooperative_groups;

#define LAS __attribute__((address_space(3)))
typedef unsigned short bf16_t;
typedef short bf16x8 __attribute__((ext_vector_type(8)));
typedef float f32x4 __attribute__((ext_vector_type(4)));
typedef unsigned u32x4 __attribute__((ext_vector_type(4)));
typedef unsigned u32x2 __attribute__((ext_vector_type(2)));
typedef float f32x2 __attribute__((ext_vector_type(2)));

constexpr int NTHREADS = 512;
constexpr int LDS_BYTES = 147456;
constexpr int D = 1024, NB = 8, SEQ = 4096, CTXL = 256;
constexpr int NCTX = NB * CTXL;
constexpr int NLAT = NB * SEQ;
constexpr int NTOK = NCTX + NLAT;
constexpr int NE = 32;
constexpr int MPAD = 147456;
constexpr float EPS = 1e-6f;

constexpr size_t MiB = 1u << 20;
constexpr size_t WS_CTL = 0;
constexpr size_t WS_MODV = 1 * MiB;
constexpr size_t WS_LBV = 1 * MiB + 512 * 1024;
constexpr size_t WS_WIN = 2 * MiB;
constexpr size_t WS_WOUT = 12 * MiB;
constexpr size_t WS_WGLU = 14 * MiB;
constexpr size_t WS_W1 = 18 * MiB;
constexpr size_t WS_W2 = 274 * MiB;
constexpr size_t WS_H = 402 * MiB;
constexpr size_t WS_A = 538 * MiB;
constexpr size_t WS_F = 606 * MiB;
constexpr size_t WS_TOKE = 674 * MiB;
constexpr size_t WS_TOKW = 674 * MiB + 640 * 1024;
constexpr size_t WS_TOKS = 674 * MiB + 1280 * 1024;
constexpr size_t WS_SLOTTOK = 256 * 1024;
constexpr size_t WS_BIG = 676 * MiB;
constexpr size_t WS_Q = WS_BIG, WS_V = WS_BIG + 68 * MiB, WS_G = WS_BIG + 136 * MiB;
constexpr size_t WS_LFF = WS_BIG + 204 * MiB, WS_LFB = WS_BIG + 340 * MiB;
constexpr size_t WS_OF = WS_BIG + 476 * MiB, WS_OB = WS_BIG + 612 * MiB;
constexpr size_t WS_OG = WS_BIG + 748 * MiB;
constexpr size_t WS_AG = WS_BIG, WS_ACT = WS_BIG + 288 * MiB, WS_YS = WS_BIG;
constexpr size_t WS_YF = WS_BIG, WS_YB = WS_BIG + 128 * MiB, WS_YG = WS_BIG + 256 * MiB;
constexpr size_t WS_END = WS_BIG + 816 * MiB;
constexpr int CW_CNT = 64;
constexpr int CW_CUR = 256;
constexpr int CW_CNTB = 8192;
constexpr int CW_BAR = 4096;
#ifndef REP_P0
#define REP_P0 1
#endif
#ifndef REP_GLA
#define REP_GLA 1
#endif
#ifndef REP_S5
#define REP_S5 1
#endif
#ifndef REP_P1
#define REP_P1 1
#endif
#ifndef REP_RO
#define REP_RO 1
#endif
#ifndef REP_POST
#define REP_POST 1
#endif
#ifndef REP_CMB1
#define REP_CMB1 1
#endif
#ifndef REP_OUT
#define REP_OUT 1
#endif
#ifndef REP_RT
#define REP_RT 1
#endif
#ifndef REP_AS
#define REP_AS 1
#endif
#ifndef REP_INP
#define REP_INP 1
#endif
#ifndef REP_M1
#define REP_M1 1
#endif
#ifndef REP_M2
#define REP_M2 1
#endif

struct Args {
    const float* in[29];
    float* out;
    unsigned char* ws;
    int stop_after, pad1;
};
enum { I_X = 0, I_C, I_CTX, I_CCTX, I_MODW, I_MODB, I_N1G, I_N2G, I_HGWIN, I_HGLB, I_HGNG, I_HGWOUT, I_S5ARE, I_S5AIM, I_S5LDT,
       I_S5BRE, I_S5BIM, I_S5CRE, I_S5CIM, I_S5D, I_S5WGLU, I_S5BGLU, I_RW, I_RB, I_W1, I_B1, I_W2, I_B2, I_FG };

__device__ __forceinline__ unsigned f2bf(float f) { unsigned u = __builtin_bit_cast(unsigned, f); return (u + 0x7fffu + ((u >> 16) & 1u)) >> 16; }
typedef __bf16 bf16x2_t __attribute__((ext_vector_type(2)));
__device__ __forceinline__ unsigned cvt_pk_bf16(float lo, float hi) { const bf16x2_t v = {(__bf16)lo, (__bf16)hi}; return __builtin_bit_cast(unsigned, v); }
__device__ __forceinline__ unsigned pk2(float lo, float hi) { return cvt_pk_bf16(lo, hi); }
__device__ __forceinline__ float bf2f(unsigned short b) { return __builtin_bit_cast(float, ((unsigned)b) << 16); }
__device__ __forceinline__ float bflo(unsigned w) { return __builtin_bit_cast(float, w << 16); }
__device__ __forceinline__ float bfhi(unsigned w) { return __builtin_bit_cast(float, w & 0xffff0000u); }
__device__ __forceinline__ float wave_sum(float v) {
#pragma unroll
    for (int o = 1; o < 64; o <<= 1) v += __shfl_xor(v, o);
    return v;
}
__device__ __forceinline__ float wave_max(float v) {
#pragma unroll
    for (int o = 1; o < 64; o <<= 1) v = fmaxf(v, __shfl_xor(v, o));
    return v;
}
__device__ __forceinline__ float sigmoid_f(float x) { return __builtin_amdgcn_rcpf(1.0f + __expf(-x)); }
__device__ __forceinline__ float silu_f(float x) { return x * __builtin_amdgcn_rcpf(1.0f + __expf(-x)); }
#define LDS_WAIT() asm volatile("s_waitcnt lgkmcnt(0)" ::: "memory")

namespace pg8 {
constexpr int BM = 256, BK = 64, HALF = 128, HTB = HALF * BK * 2, STAGE_BYTES = 8 * HTB, NXCD = 8, WGM = 8;
__host__ __device__ __forceinline__ int lds_byte(int r, int c) { const int st = (r >> 4) * 2 + (c >> 5), rr = r & 15, cc = c & 31, ob = rr * 64 + cc * 2; return st * 1024 + (ob ^ (((ob >> 9) & 1) << 5)); }
__host__ __device__ __forceinline__ void stage_rc(int b, int& R, int& C) { const int st = b / 1024, sb = b % 1024, swz = sb ^ (((sb >> 9) & 1) << 5); R = (st >> 1) * 16 + swz / 64; C = (st & 1) * 32 + (swz % 64) / 2; }
__host__ __device__ __forceinline__ int perm32(int rho) { const int n = rho >> 4, i = rho & 15; return 8 * (i >> 2) + 4 * n + (i & 3); }
struct Unit { int pm, pn; };
struct Gemm { const bf16_t* A; const bf16_t* Bt; int M, N, K; };
struct StaticOrder {
    int nM, nN, nwg, G, c;
    __device__ void init(int M, int N, int G_, int c_) { nM = M / BM; nN = N / BM; nwg = nM * nN; G = G_; c = c_; }
    __device__ bool next(int i, Unit& u) const {
        const long L = (long)i * G + c; if (L >= nwg) return false;
        int wgid = (int)L; { const int q = nwg / NXCD, r = nwg % NXCD, xcd = wgid % NXCD, off = wgid / NXCD; wgid = (xcd < r ? xcd * (q + 1) : r * (q + 1) + (xcd - r) * q) + off; }
        const int nig = WGM * nN, gid = wgid / nig, fm = gid * WGM, gsz = (nM - fm) < WGM ? (nM - fm) : WGM;
        u.pm = fm + ((wgid % nig) % gsz); u.pn = (wgid % nig) / gsz; return true;
    }
    __device__ __forceinline__ void a_ready(const Unit&) const {}
    __device__ __forceinline__ void done(const Unit&) const {}
};
struct MoeOrder {
    const LAS int* tile_e; int TT, sh, G, v;
    __device__ bool next(int i, Unit& u) const {
        const bool p2 = (G & (G - 1)) == 0 && G >= 8;
        const int lg = p2 ? (31 - __builtin_clz((unsigned)G)) - 3 : 0, per = p2 ? (1 << lg) : G, x = p2 ? (v >> lg) : 0, j = p2 ? (v & (per - 1)) : v, sh3 = p2 ? 3 : 0;
        const int t0 = (x * TT) >> sh3, t1 = ((x + 1) * TT) >> sh3;
        const int uu = i * per + j, rt = t0 + (uu >> sh), pnl = uu & ((1 << sh) - 1);
        if (rt >= t1) return false;
        u.pm = rt; u.pn = (tile_e[rt] << sh) + pnl; return true;
    }
    __device__ __forceinline__ void a_ready(const Unit&) const {}
    __device__ __forceinline__ void done(const Unit&) const {}
};

template <class Epi, class Sched, bool GATHER = false, bool ALIGN_EPI = true, bool SP2 = true>
__device__ __forceinline__ void gemm_phase(LAS unsigned char* lds, const Gemm g, const Sched& S, const Epi& E, const LAS unsigned short* rowl = nullptr) {
    int tid_ = threadIdx.x; asm volatile("" : "+v"(tid_));
    const int tid = tid_, wid = __builtin_amdgcn_readfirstlane(tid >> 6), lane = tid & 63, wr = wid >> 2, wc = wid & 3, fr = lane & 15, fq = lane >> 4;
    const int K = g.K, nt = K / BK;
    unsigned voffA[2], voffB[2];
    int Rr[2], Cc2[2];
#pragma unroll
    for (int i = 0; i < 2; ++i) { int R, C; stage_rc(tid * 16 + i * 8192, R, C); voffA[i] = (unsigned)(R * K + C) * 2u; const int Rb = Epi::PERM ? ((R & ~31) + perm32(R & 31)) : R; voffB[i] = (unsigned)(Rb * K + C) * 2u; Rr[i] = R; Cc2[i] = C * 2; }
    unsigned gA0[2] = {0u, 0u}, gA1[2] = {0u, 0u}, nG0[2] = {0u, 0u}, nG1[2] = {0u, 0u};
#define PG8_ROWS(ui_, d0, d1) do { _Pragma("unroll") for (int _i = 0; _i < 2; ++_i) { d0[_i] = (unsigned)rowl[(ui_) * BM + Rr[_i]] * (unsigned)(K * 2) + (unsigned)Cc2[_i]; d1[_i] = (unsigned)rowl[(ui_) * BM + HALF + Rr[_i]] * (unsigned)(K * 2) + (unsigned)Cc2[_i]; } } while (0)
#define PG8_STAGE_A(bufoff, ptr, h, nx) do { if constexpr (GATHER) { unsigned _o[2]; _o[0] = (nx) ? ((h) ? nG1[0] : nG0[0]) : ((h) ? gA1[0] : gA0[0]); _o[1] = (nx) ? ((h) ? nG1[1] : nG0[1]) : ((h) ? gA1[1] : gA0[1]); PG8_STAGE(bufoff, ptr, _o); } \
        else { PG8_STAGE(bufoff, (ptr) + ((h) ? hstep : 0), voffA); } } while (0)
    const size_t kstep = (size_t)(BK * 2);
    const size_t hstep = (size_t)HALF * K * 2;
    const size_t tstep = 2 * hstep;
    const unsigned ldsw = (unsigned)wid * 1024u;
    const int aoff = lds_byte(wr * 64 + fr, fq * 8), boff = lds_byte(wc * 32 + fr, fq * 8);
#define PG8_SA(b, h) (((b) * 2 + (h)) * HTB)
#define PG8_SB(b, h) ((4 + (b) * 2 + (h)) * HTB)
#define PG8_STAGE(bufoff, gbase, voff) do { _Pragma("unroll") for (int _i = 0; _i < 2; ++_i) \
        __builtin_amdgcn_global_load_lds((const unsigned*)((const char*)(gbase) + (voff)[_i]), (LAS unsigned*)(lds + (bufoff) + ldsw + _i * 8192), 16, 0, 0); } while (0)
#define PG8_LDA(dst, b, h) do { _Pragma("unroll") for (int m = 0; m < 4; ++m) _Pragma("unroll") for (int k = 0; k < 2; ++k) dst[m][k] = *(const LAS bf16x8*)(lds + PG8_SA(b, h) + aoff + m * 2048 + k * 1024); } while (0)
#define PG8_LDB(dst, b, h) do { _Pragma("unroll") for (int n = 0; n < 2; ++n) _Pragma("unroll") for (int k = 0; k < 2; ++k) dst[n][k] = *(const LAS bf16x8*)(lds + PG8_SB(b, h) + boff + n * 2048 + k * 1024); } while (0)
#define PG8_MMA(ai, bj, At, Bt) do { __builtin_amdgcn_s_setprio(1); _Pragma("unroll") for (int m = 0; m < 4; ++m) _Pragma("unroll") for (int n = 0; n < 2; ++n) _Pragma("unroll") for (int k = 0; k < 2; ++k) \
        acc[ai][bj][m][n] = __builtin_amdgcn_mfma_f32_16x16x32_bf16(Bt[n][k], At[m][k], acc[ai][bj][m][n], 0, 0, 0); __builtin_amdgcn_s_setprio(0); } while (0)
#define PG8_WAIT_V(n) asm volatile("s_waitcnt vmcnt(" #n ")" ::: "memory")
#define PG8_WAIT_L(n) asm volatile("s_waitcnt lgkmcnt(" #n ")" ::: "memory")
#define PG8_BAR __builtin_amdgcn_s_barrier()
#define PG8_SCHED __builtin_amdgcn_sched_barrier(0)
    Unit cur, nxt; int ui = 0;
    if (!S.next(0, cur)) return;
    f32x4 acc[2][2][4][2];
#pragma unroll
    for (int a = 0; a < 2; ++a)
#pragma unroll
        for (int b = 0; b < 2; ++b)
#pragma unroll
            for (int m = 0; m < 4; ++m)
#pragma unroll
                for (int n = 0; n < 2; ++n) acc[a][b][m][n] = (f32x4){0.f, 0.f, 0.f, 0.f};
    bf16x8 At[4][2], B0[2][2], B1[2][2];
    const char* cA = GATHER ? (const char*)g.A : (const char*)g.A + (size_t)cur.pm * tstep; const char* cB = (const char*)g.Bt + (size_t)cur.pn * tstep;
    S.a_ready(cur);
    if constexpr (GATHER) PG8_ROWS(0, gA0, gA1);
    if constexpr (SP2) {
        PG8_STAGE(PG8_SB(0, 0), cB, voffB); PG8_STAGE(PG8_SB(0, 1), cB + hstep, voffB); PG8_STAGE_A(PG8_SA(0, 0), cA, 0, false); PG8_STAGE_A(PG8_SA(0, 1), cA, 1, false);
        if (wr == 1) PG8_BAR;
        PG8_WAIT_V(2); PG8_BAR;
        PG8_STAGE(PG8_SB(1, 0), cB + kstep, voffB); PG8_STAGE_A(PG8_SA(1, 0), cA + kstep, 0, false); PG8_STAGE(PG8_SB(1, 1), cB + hstep + kstep, voffB);
        PG8_WAIT_V(6); PG8_BAR;
    } else {
        PG8_STAGE(PG8_SB(0, 0), cB, voffB); PG8_STAGE_A(PG8_SA(0, 0), cA, 0, false); PG8_STAGE(PG8_SB(0, 1), cB + hstep, voffB); PG8_STAGE_A(PG8_SA(0, 1), cA, 1, false);
        if (wr == 1) PG8_BAR;
        PG8_WAIT_V(4); PG8_BAR;
        PG8_STAGE(PG8_SB(1, 0), cB + kstep, voffB); PG8_STAGE_A(PG8_SA(1, 0), cA + kstep, 0, false); PG8_STAGE(PG8_SB(1, 1), cB + hstep + kstep, voffB);
        PG8_WAIT_V(6); PG8_BAR;
    }
    for (;;) {
        const bool has_next = S.next(ui + 1, nxt);
        const char* nA = GATHER ? cA : (has_next ? (const char*)g.A + (size_t)nxt.pm * tstep : cA); const char* nB = has_next ? (const char*)g.Bt + (size_t)nxt.pn * tstep : cB;
        if constexpr (GATHER) { if (has_next) PG8_ROWS(ui + 1, nG0, nG1); else { nG0[0] = gA0[0]; nG0[1] = gA0[1]; nG1[0] = gA1[0]; nG1[1] = gA1[1]; } }
        for (int t = 0; t < nt; t += 2) {
            const bool last = (t == nt - 2);
            const char* a1 = cA + (size_t)(t + 1) * kstep;
            const char* a2 = last ? nA : cA + (size_t)(t + 2) * kstep; const char* b2 = last ? nB : cB + (size_t)(t + 2) * kstep;
            const char* a3 = a2 + kstep; const char* b3 = b2 + kstep;
            if (last && has_next) S.a_ready(nxt);
            if constexpr (SP2) {
            PG8_LDB(B0, 0, 0); PG8_LDB(B1, 0, 1); PG8_SCHED; PG8_LDA(At, 0, 0); PG8_STAGE_A(PG8_SA(1, 1), a1, 1, false);
            PG8_WAIT_V(8); PG8_WAIT_L(0); PG8_BAR; PG8_MMA(0, 0, At, B0); PG8_MMA(0, 1, At, B1); PG8_BAR; PG8_SCHED;
            PG8_LDA(At, 0, 1); PG8_STAGE(PG8_SB(0, 0), b2, voffB); PG8_STAGE(PG8_SB(0, 1), b2 + hstep, voffB); PG8_STAGE_A(PG8_SA(0, 0), a2, 0, last);
            PG8_WAIT_V(8); PG8_WAIT_L(0); PG8_BAR; PG8_MMA(1, 0, At, B0); PG8_MMA(1, 1, At, B1); PG8_BAR; PG8_SCHED;
            PG8_LDB(B0, 1, 0); PG8_LDB(B1, 1, 1); PG8_SCHED; PG8_LDA(At, 1, 0); PG8_STAGE_A(PG8_SA(0, 1), a2, 1, last);
            PG8_WAIT_V(8); PG8_WAIT_L(0); PG8_BAR; PG8_MMA(0, 0, At, B0); PG8_MMA(0, 1, At, B1); PG8_BAR; PG8_SCHED;
            PG8_LDA(At, 1, 1); PG8_STAGE(PG8_SB(1, 0), b3, voffB); PG8_STAGE(PG8_SB(1, 1), b3 + hstep, voffB); PG8_STAGE_A(PG8_SA(1, 0), a3, 0, last);
            PG8_WAIT_V(8); PG8_WAIT_L(0); PG8_BAR; PG8_MMA(1, 0, At, B0); PG8_MMA(1, 1, At, B1); PG8_BAR; PG8_SCHED;
            } else {
            PG8_LDB(B0, 0, 0); PG8_SCHED; PG8_LDA(At, 0, 0); PG8_STAGE_A(PG8_SA(1, 1), a1, 1, false);
            PG8_WAIT_L(8); PG8_BAR; PG8_WAIT_L(0); PG8_MMA(0, 0, At, B0); PG8_BAR; PG8_SCHED;
            PG8_LDB(B1, 0, 1); PG8_STAGE(PG8_SB(0, 0), b2, voffB);
            PG8_BAR; PG8_WAIT_L(0); PG8_MMA(0, 1, At, B1); PG8_BAR;
            PG8_LDA(At, 0, 1); PG8_STAGE_A(PG8_SA(0, 0), a2, 0, last);
            PG8_BAR; PG8_WAIT_L(0); PG8_MMA(1, 0, At, B0); PG8_BAR; PG8_SCHED;
            PG8_STAGE(PG8_SB(0, 1), b2 + hstep, voffB);
            PG8_WAIT_V(6); PG8_BAR; PG8_MMA(1, 1, At, B1); PG8_BAR;
            PG8_LDB(B0, 1, 0); PG8_SCHED; PG8_LDA(At, 1, 0); PG8_STAGE_A(PG8_SA(0, 1), a2, 1, last);
            PG8_WAIT_L(8); PG8_BAR; PG8_WAIT_L(0); PG8_MMA(0, 0, At, B0); PG8_BAR; PG8_SCHED;
            PG8_LDB(B1, 1, 1); PG8_STAGE(PG8_SB(1, 0), b3, voffB);
            PG8_BAR; PG8_WAIT_L(0); PG8_MMA(0, 1, At, B1); PG8_BAR;
            PG8_LDA(At, 1, 1); PG8_STAGE_A(PG8_SA(1, 0), a3, 0, last);
            PG8_BAR; PG8_WAIT_L(0); PG8_MMA(1, 0, At, B0); PG8_BAR; PG8_SCHED;
            PG8_STAGE(PG8_SB(1, 1), b3 + hstep, voffB);
            PG8_WAIT_V(6); PG8_BAR; PG8_MMA(1, 1, At, B1); PG8_BAR;
                    }
        }
        if constexpr (ALIGN_EPI) { if (wr == 0) PG8_BAR; }
        E(acc, cur, wr, wc, fr, fq); S.done(cur);
        if (!has_next) break;
#pragma unroll
        for (int a = 0; a < 2; ++a)
#pragma unroll
            for (int b = 0; b < 2; ++b)
#pragma unroll
                for (int m = 0; m < 4; ++m)
#pragma unroll
                    for (int n = 0; n < 2; ++n) acc[a][b][m][n] = (f32x4){0.f, 0.f, 0.f, 0.f};
        cur = nxt; cA = nA; cB = nB; ++ui;
        if constexpr (GATHER) { gA0[0] = nG0[0]; gA0[1] = nG0[1]; gA1[0] = nG1[0]; gA1[1] = nG1[1]; }
        if constexpr (ALIGN_EPI) { if (wr == 1) PG8_BAR; }
    }
    PG8_WAIT_V(0);
    if constexpr (!ALIGN_EPI) { if (wr == 0) PG8_BAR; }
    PG8_BAR;
#undef PG8_SA
#undef PG8_ROWS
#undef PG8_STAGE_A
#undef PG8_SB
#undef PG8_STAGE
#undef PG8_LDA
#undef PG8_LDB
#undef PG8_MMA
#undef PG8_WAIT_V
#undef PG8_WAIT_L
#undef PG8_BAR
#undef PG8_SCHED
}
}
using pg8::Unit;

__device__ __forceinline__ f32x4 ld_bf16x4(const bf16_t* p) { const u32x2 w = *(const u32x2*)p; return (f32x4){bflo(w.x), bfhi(w.x), bflo(w.y), bfhi(w.y)}; }
__device__ __forceinline__ void st_bf16x4(bf16_t* p, f32x4 v) { u32x2 w; w.x = pk2(v[0], v[1]); w.y = pk2(v[2], v[3]); *(u32x2*)p = w; }

struct EpiInProj {
    static constexpr bool PERM = true;
    bf16_t *Q, *V, *G; _Float16 *LFF, *LFB; const float* lbv;
    __device__ __forceinline__ void operator()(const f32x4 (&acc)[2][2][4][2], const Unit& u, int wr, int wc, int fr, int fq) const {
        const int seg = u.pn >> 2, cb = (u.pn & 3) * 256 + wc * 32 + 8 * fq, row0 = u.pm * 256 + wr * 64 + fr;
#pragma unroll
        for (int bj = 0; bj < 2; ++bj) {
            const int c = cb + bj * 128;
            f32x4 lb0 = (f32x4){0.f, 0.f, 0.f, 0.f}, lb1 = lb0;
            if (seg == 2 || seg == 3) { lb0 = *(const f32x4*)(lbv + (seg - 2) * D + c); lb1 = *(const f32x4*)(lbv + (seg - 2) * D + c + 4); }
#pragma unroll
            for (int ai = 0; ai < 2; ++ai)
#pragma unroll
                for (int m = 0; m < 4; ++m) {
                    const size_t ro = (size_t)(row0 + ai * 128 + m * 16) * D + c;
                    const f32x4 v0 = acc[ai][bj][m][0], v1 = acc[ai][bj][m][1];
                    if (seg == 0) { f32x4 o0, o1; for (int j = 0; j < 4; ++j) { o0[j] = silu_f(v0[j]); o1[j] = silu_f(v1[j]); }
                        *(u32x4*)(Q + ro) = (u32x4){pk2(o0[0], o0[1]), pk2(o0[2], o0[3]), pk2(o1[0], o1[1]), pk2(o1[2], o1[3])}; }
                    else if (seg == 1) { *(u32x4*)(V + ro) = (u32x4){pk2(v0[0], v0[1]), pk2(v0[2], v0[3]), pk2(v1[0], v1[1]), pk2(v1[2], v1[3])}; }
                    else if (seg == 4) { *(u32x4*)(G + ro) = (u32x4){pk2(v0[0], v0[1]), pk2(v0[2], v0[3]), pk2(v1[0], v1[1]), pk2(v1[2], v1[3])}; }
                    else {
                        f32x4 o0, o1;
                        for (int j = 0; j < 4; ++j) { o0[j] = __logf(lb0[j] + (1.0f - lb0[j]) * sigmoid_f(v0[j])); o1[j] = __logf(lb1[j] + (1.0f - lb1[j]) * sigmoid_f(v1[j])); }
                        u32x4 hw; hw.x = __builtin_bit_cast(unsigned, __builtin_amdgcn_cvt_pkrtz(o0[0], o0[1])); hw.y = __builtin_bit_cast(unsigned, __builtin_amdgcn_cvt_pkrtz(o0[2], o0[3]));
                        hw.z = __builtin_bit_cast(unsigned, __builtin_amdgcn_cvt_pkrtz(o1[0], o1[1])); hw.w = __builtin_bit_cast(unsigned, __builtin_amdgcn_cvt_pkrtz(o1[2], o1[3]));
                        *(u32x4*)((seg == 2 ? LFF : LFB) + ro) = hw;
                    }
                }
        }
    }
};
struct EpiResid {
    static constexpr bool PERM = true;
    const float* x; const float* ctx; const float* modv; bf16_t* H; int gate_off;
    __device__ __forceinline__ void operator()(const f32x4 (&acc)[2][2][4][2], const Unit& u, int wr, int wc, int fr, int fq) const {
        const int rt0 = u.pm * 256; const int mr = rt0 < NCTX ? 8 : ((rt0 - NCTX) >> 12);
        const float* src = rt0 < NCTX ? ctx + (size_t)rt0 * D : x + (size_t)(rt0 - NCTX) * D;
        const int cb = u.pn * 256 + wc * 32 + 8 * fq, rl0 = wr * 64 + fr;
        const float* gp = modv + mr * 6144 + gate_off;
        f32x4 gg[2][2];
#pragma unroll
        for (int bj = 0; bj < 2; ++bj) { gg[bj][0] = *(const f32x4*)(gp + cb + bj * 128); gg[bj][1] = *(const f32x4*)(gp + cb + bj * 128 + 4); }
#pragma unroll
        for (int bj = 0; bj < 2; ++bj)
#pragma unroll
            for (int ai = 0; ai < 2; ++ai) {
                const int c = cb + bj * 128; f32x4 h0[4], h1[4];
#pragma unroll
                for (int m = 0; m < 4; ++m) { const float* hp = src + (size_t)(rl0 + ai * 128 + m * 16) * D + c; h0[m] = *(const f32x4*)hp; h1[m] = *(const f32x4*)(hp + 4); }
#pragma unroll
                for (int m = 0; m < 4; ++m) {
                    const f32x4 o0 = h0[m] + gg[bj][0] * acc[ai][bj][m][0], o1 = h1[m] + gg[bj][1] * acc[ai][bj][m][1];
                    *(u32x4*)(H + (size_t)(rt0 + rl0 + ai * 128 + m * 16) * D + c) = (u32x4){pk2(o0[0], o0[1]), pk2(o0[2], o0[3]), pk2(o1[0], o1[1]), pk2(o1[2], o1[3])};
                }
                asm volatile("" ::: "memory");
            }
    }
};

struct TrItem { const float* src; bf16_t* dst; int N; };
__device__ __forceinline__ void tr_load(const TrItem& t, f32x4 (&v)[16], int lane) {
    const float* p = t.src + (size_t)(2 * (lane >> 4)) * t.N + 4 * (lane & 15);
#pragma unroll
    for (int i = 0; i < 8; ++i) { v[2 * i] = *(const f32x4*)(p + (size_t)(8 * i) * t.N); v[2 * i + 1] = *(const f32x4*)(p + (size_t)(8 * i + 1) * t.N); }
}
__device__ __forceinline__ void tr_finish(const TrItem& t, const f32x4 (&v)[16], LAS unsigned* scr, int lane) {
#pragma unroll
    for (int i = 0; i < 8; ++i) {
        const int kp = 4 * i + (lane >> 4); LAS unsigned* s = scr + kp * 65 + 4 * (lane & 15);
        s[0] = cvt_pk_bf16(v[2 * i][0], v[2 * i + 1][0]); s[1] = cvt_pk_bf16(v[2 * i][1], v[2 * i + 1][1]); s[2] = cvt_pk_bf16(v[2 * i][2], v[2 * i + 1][2]); s[3] = cvt_pk_bf16(v[2 * i][3], v[2 * i + 1][3]);
    }
    LDS_WAIT();
    const int c = lane & 7;
#pragma unroll
    for (int j = 0; j < 8; ++j) {
        const int n = (lane >> 3) + 8 * j; const LAS unsigned* s = scr + (4 * c) * 65 + n;
        *(u32x4*)(t.dst + (size_t)n * 1024 + 8 * c) = (u32x4){s[0], s[65], s[130], s[195]};
    }
    LDS_WAIT();
}
__device__ __forceinline__ int ilv_row(int c) { const int bj = c >> 10, r = c & 1023; return (r >> 7) * 256 + bj * 128 + (r & 127); }

__device__ __forceinline__ TrItem moe_item(const Args& a, int r, int layer) {
    TrItem t;
    if (r < 32 * 512) { const int mat = layer * 32 + (r >> 9), sub = r & 511, kb = sub >> 5, nb = sub & 31;
        t.src = a.in[I_W1] + (size_t)mat * 1024 * 2048 + (size_t)(kb * 64) * 2048 + nb * 64; t.dst = (bf16_t*)(a.ws + WS_W1) + (size_t)mat * 2048 * 1024 + (size_t)ilv_row(nb * 64) * 1024 + kb * 64; t.N = 2048; }
    else { r -= 32 * 512; const int mat = layer * 32 + (r >> 8), sub = r & 255, kb = sub >> 4, nb = sub & 15;
        t.src = a.in[I_W2] + (size_t)mat * 1024 * 1024 + (size_t)(kb * 64) * 1024 + nb * 64; t.dst = (bf16_t*)(a.ws + WS_W2) + (size_t)mat * 1024 * 1024 + (size_t)(nb * 64) * 1024 + kb * 64; t.N = 1024; }
    return t;
}
constexpr int P0_NWIN = 16 * 80, P0_NWOUT = 16 * 16, P0_NWGLU = 16 * 32, P0_NITEMS = P0_NWIN + P0_NWOUT + P0_NWGLU + 32 * 512 + 32 * 256;
__device__ __forceinline__ TrItem p0_item(const Args& a, int r) {
    TrItem t;
    if (r < P0_NWIN) { const int kb = r / 80, nb = r % 80; t.src = a.in[I_HGWIN] + (size_t)(kb * 64) * 5120 + nb * 64; t.dst = (bf16_t*)(a.ws + WS_WIN) + (size_t)(nb * 64) * 1024 + kb * 64; t.N = 5120; return t; } r -= P0_NWIN;
    if (r < P0_NWOUT) { const int kb = r / 16, nb = r % 16; t.src = a.in[I_HGWOUT] + (size_t)(kb * 64) * 1024 + nb * 64; t.dst = (bf16_t*)(a.ws + WS_WOUT) + (size_t)(nb * 64) * 1024 + kb * 64; t.N = 1024; return t; } r -= P0_NWOUT;
    if (r < P0_NWGLU) { const int kb = r / 32, nb = r % 32; t.src = a.in[I_S5WGLU] + (size_t)(kb * 64) * 2048 + nb * 64; t.dst = (bf16_t*)(a.ws + WS_WGLU) + (size_t)ilv_row(nb * 64) * 1024 + kb * 64; t.N = 2048; return t; } r -= P0_NWGLU;
    return moe_item(a, r, 0);
}
#define TR_LOOP(first, stride, count, ITEM) do { int _it = (first); if (_it < (count)) { f32x4 _va[16], _vb[16]; TrItem _A = ITEM(_it), _B = _A; tr_load(_A, _va, lane); \
        for (;;) { const int _i2 = _it + (stride); const bool _h2 = _i2 < (count); if (_h2) { _B = ITEM(_i2); tr_load(_B, _vb, lane); } tr_finish(_A, _va, scr, lane); if (!_h2) break; \
                   _it = _i2 + (stride); const bool _h1 = _it < (count); if (_h1) { _A = ITEM(_it); tr_load(_A, _va, lane); } tr_finish(_B, _vb, scr, lane); if (!_h1) break; } } } while (0)
__device__ __forceinline__ void p0_phase(const Args& a, LAS unsigned char* lds, int tid, int gw, int NGW) {
    const int lane = tid & 63, wave = tid >> 6;
    unsigned char* ws = a.ws;
    float* modv = (float*)(ws + WS_MODV);
    if (blockIdx.x < 192) {
        LAS float* SC = (LAS float*)lds;
        LAS float* PART = (LAS float*)(lds + 40960);
        for (int i = tid; i < 9 * 1024; i += NTHREADS) { const int r = i >> 10, k = i & 1023; const float v = r < 8 ? a.in[I_C][r * 1024 + k] : a.in[I_CCTX][k]; SC[i] = silu_f(v); }
        __syncthreads();
        const int layer = blockIdx.x / 96, ng = blockIdx.x % 96;
        const float* W = a.in[I_MODW] + (size_t)layer * 1024 * 6144 + ng * 64 + lane;
        float acc[9];
#pragma unroll
        for (int r = 0; r < 9; ++r) acc[r] = 0.f;
#pragma unroll 8
        for (int kk = 0; kk < 128; ++kk) {
            const int k = wave * 128 + kk; const float w = W[(size_t)k * 6144];
#pragma unroll
            for (int r = 0; r < 9; ++r) acc[r] += SC[r * 1024 + k] * w;
        }
#pragma unroll
        for (int r = 0; r < 9; ++r) PART[(wave * 9 + r) * 64 + lane] = acc[r];
        __syncthreads();
        for (int i = tid; i < 9 * 64; i += NTHREADS) {
            const int r = i >> 6, l = i & 63; float s = a.in[I_MODB][layer * 6144 + ng * 64 + l];
#pragma unroll
            for (int w = 0; w < 8; ++w) s += PART[(w * 9 + r) * 64 + l];
            modv[(size_t)(layer * 9 + r) * 6144 + ng * 64 + l] = s;
        }
        __syncthreads();
    } else if (blockIdx.x == 192) {
        float* lbv = (float*)(ws + WS_LBV);
        for (int i = tid; i < 2048; i += NTHREADS) { const float l0 = a.in[I_HGLB][i], l1 = a.in[I_HGLB][2048 + i]; lbv[i] = 1.0f / (1.0f + __expf(l1 - l0)); }
    }
    LAS unsigned* scr = (LAS unsigned*)(lds + 59392 + wave * 8320);
#define P0_ITEM(i) p0_item(a, (i))
    const int nfast = ((int)gridDim.x > 192) ? ((int)gridDim.x - 192) * 8 : 0, nextra = nfast * 3, n1 = P0_NITEMS - nextra;
    TR_LOOP(gw, NGW, n1, P0_ITEM);
    if (blockIdx.x >= 192) { TR_LOOP(n1 + (gw - 192 * 8), nfast, P0_NITEMS, P0_ITEM); }
#undef P0_ITEM
}

__device__ __forceinline__ const float* hin_row(const Args& a, int row) { return row < NCTX ? a.in[I_CTX] + (size_t)row * D : a.in[I_X] + (size_t)(row - NCTX) * D; }
__device__ __forceinline__ int mod_row(int row) { return row < NCTX ? 8 : ((row - NCTX) >> 12); }
__device__ __forceinline__ float row_rstd(const f32x4 (&v)[4]) {
    float s = 0.f;
#pragma unroll
    for (int j = 0; j < 4; ++j) s += (v[j][0] * v[j][0] + v[j][1] * v[j][1]) + (v[j][2] * v[j][2] + v[j][3] * v[j][3]);
    return 1.0f / sqrtf(wave_sum(s) * (1.0f / D) + EPS);
}
struct ModVec { f32x4 g[4], sc[4], sh[4]; };
__device__ __forceinline__ void modvec_load(ModVec& m, const float* g, const float* sc, const float* sh, int lane) {
#pragma unroll
    for (int j = 0; j < 4; ++j) { const int c = 4 * lane + 256 * j; m.g[j] = *(const f32x4*)(g + c); m.sc[j] = *(const f32x4*)(sc + c); m.sh[j] = *(const f32x4*)(sh + c); }
}
__device__ __forceinline__ void norm_mod_store(const f32x4 (&v)[4], float rstd, const ModVec& m, bf16_t* orow, int lane) {
#pragma unroll
    for (int j = 0; j < 4; ++j) st_bf16x4(orow + 4 * lane + 256 * j, v[j] * rstd * m.g[j] * (m.sc[j] + 1.0f) + m.sh[j]);
}

__device__ __forceinline__ void p1_phase(const Args& a, int lane, int gw, int NGW) {
    const float* modv = (const float*)(a.ws + WS_MODV);
    bf16_t* A = (bf16_t*)(a.ws + WS_A);
    for (int row0 = gw * 4; row0 < NTOK; row0 += NGW * 4) {
        f32x4 v[4][4];
#pragma unroll
        for (int r = 0; r < 4; ++r) { const float* hr = hin_row(a, row0 + r);
#pragma unroll
            for (int j = 0; j < 4; ++j) v[r][j] = *(const f32x4*)(hr + 4 * lane + 256 * j); }
        const float* mv = modv + (size_t)mod_row(row0) * 6144;
        ModVec m; modvec_load(m, a.in[I_N1G], mv + 1024, mv, lane);
#pragma unroll
        for (int r = 0; r < 4; ++r) { const float rstd = row_rstd(v[r]); norm_mod_store(v[r], rstd, m, A + (size_t)(row0 + r) * D, lane); }
    }
}

__device__ __forceinline__ int gla_row(int n, int t, int b, int dir) {
    const bool isctx = n < 4; const int cn = isctx ? n : n - 4, slen = isctx ? CTXL : SEQ, rbase = isctx ? b * CTXL : NCTX + b * SEQ;
    const int pos = cn * 64 + t; return rbase + (dir ? slen - 1 - pos : pos);
}
__device__ __forceinline__ void gla_phase(const Args& a, LAS unsigned char* lds, int tid) {
    const int lane = tid & 63, wave = tid >> 6, fr = lane & 15, fq = lane >> 4;
    LAS unsigned char* QS = lds;
    LAS unsigned char* KS = lds + 17408;
    LAS unsigned char* QIN = lds + 34816;
    LAS unsigned char* KOT = lds + 52224;
    LAS unsigned char* VT = lds + 70656;
    LAS unsigned char* ST0 = lds + 79872;
    LAS unsigned char* PPW = lds + 114688 + wave * 2304;
    LAS float* GT0 = (LAS float*)(lds + 133120);
    LAS float* BL = (LAS float*)(lds + 141312);
    const bf16_t* Qg = (const bf16_t*)(a.ws + WS_Q); const bf16_t* Vg = (const bf16_t*)(a.ws + WS_V);
    for (int item = blockIdx.x; item < 256; item += gridDim.x) {
        const int vs = item & 1, dir = (item >> 1) & 1, h = (item >> 2) & 7, b = item >> 5;
        const _Float16* LF = (const _Float16*)(a.ws + (dir ? WS_LFB : WS_LFF)); bf16_t* Og = (bf16_t*)(a.ws + (dir ? WS_OB : WS_OF));
        f32x4 Sacc[4];
#pragma unroll
        for (int i = 0; i < 4; ++i) Sacc[i] = (f32x4){0.f, 0.f, 0.f, 0.f};
        for (int i = tid; i < 2 * 17408 / 4; i += NTHREADS) ((LAS unsigned*)ST0)[i] = 0u;
        const int kc2 = (tid & 63) * 2, tg = tid >> 6, chq = h * 128 + kc2;
        const int vt_t = tid & 63, vt_v8 = (tid >> 6) * 8;
        unsigned lf2[8], q2[8]; u32x4 vv;
#define GLA_LOAD(n_) do { const unsigned o0_ = (unsigned)(gla_row(n_, tg * 8, b, dir) * D + chq) * 2u; const unsigned os_ = dir ? (unsigned)(-2 * D) : (unsigned)(2 * D); \
            _Pragma("unroll") for (int i = 0; i < 8; ++i) { const unsigned o = o0_ + (unsigned)i * os_; lf2[i] = *(const unsigned*)((const char*)LF + o); q2[i] = *(const unsigned*)((const char*)Qg + o); } \
            vv = *(const u32x4*)((const char*)Vg + (unsigned)(gla_row(n_, vt_t, b, dir) * D + h * 128 + vs * 64 + vt_v8) * 2u); } while (0)
        float fa[8], fb[8], bca[8], bcb[8];
#define GLA_CUMSUM(par_) do { float csa = 0.f, csb = 0.f; _Pragma("unroll") for (int i = 0; i < 8; ++i) { typedef _Float16 h2 __attribute__((ext_vector_type(2))); const h2 hv = __builtin_bit_cast(h2, lf2[i]); \
            const float la = (float)hv[0], lb_ = (float)hv[1]; fa[i] = __expf(la); fb[i] = __expf(lb_); csa += la; csb += lb_; bca[i] = csa; bcb[i] = csb; } \
            *(LAS f32x2*)(GT0 + (par_) * 1024 + tg * 128 + kc2) = (f32x2){csa, csb}; } while (0)
        GLA_LOAD(0);
        GLA_CUMSUM(0);
        __syncthreads();
        for (int n = 0; n < 68; ++n) {
            const int par = n & 1;
            LAS unsigned char* STc = ST0 + par * 17408; LAS unsigned char* STn = ST0 + (par ^ 1) * 17408;
            { const unsigned w[4] = {vv.x, vv.y, vv.z, vv.w};
#pragma unroll
              for (int i = 0; i < 4; ++i) { *(LAS bf16_t*)(VT + (vt_v8 + 2 * i) * 144 + vt_t * 2) = (bf16_t)(w[i] & 0xffffu); *(LAS bf16_t*)(VT + (vt_v8 + 2 * i + 1) * 144 + vt_t * 2) = (bf16_t)(w[i] >> 16); } }
#define GLA_OSTORE(n_) do { const u32x4 od = *(const LAS u32x4*)(PPW + (lane >> 2) * 144 + (lane & 3) * 16); \
                *(u32x4*)(Og + (size_t)gla_row(n_, (wave >> 1) * 16 + (lane >> 2), b, dir) * D + h * 128 + vs * 64 + (wave & 1) * 32 + (lane & 3) * 8) = od; } while (0)
            if (n > 0) GLA_OSTORE(n - 1);
            f32x2 pre = (f32x2){0.f, 0.f}, bref = (f32x2){0.f, 0.f}, blast = (f32x2){0.f, 0.f};
#pragma unroll
            for (int g8 = 0; g8 < 8; ++g8) { const f32x2 gv = *(const LAS f32x2*)(GT0 + par * 1024 + g8 * 128 + kc2); if (g8 < tg) pre += gv; if (g8 < 4) bref += gv; blast += gv; }
            const float era = __expf(bref.x), erb = __expf(bref.y), ela = __expf(blast.x - bref.x), elb = __expf(blast.y - bref.y);
            float e1a = __expf(pre.x - bref.x), e1b = __expf(pre.y - bref.y);
            unsigned kota[4], kotb[4];
#pragma unroll
            for (int i = 0; i < 8; ++i) {
                const int t = tg * 8 + i;
                const float qa = bflo(q2[i]), qb = bfhi(q2[i]);
                e1a *= fa[i]; e1b *= fb[i];
                const float ka = 1.0f - fa[i], kb = 1.0f - fb[i];
                const float e2a = __builtin_amdgcn_rcpf(e1a), e2b = __builtin_amdgcn_rcpf(e1b);
                const float qsa = qa * e1a, qsb = qb * e1b, ksa = ka * e2a, ksb = kb * e2b;
                *(LAS unsigned*)(QS + t * 272 + kc2 * 2) = cvt_pk_bf16(qsa, qsb);
                *(LAS unsigned*)(KS + t * 272 + kc2 * 2) = cvt_pk_bf16(ksa, ksb);
                *(LAS unsigned*)(QIN + t * 272 + kc2 * 2) = cvt_pk_bf16(qsa * era, qsb * erb);
                const unsigned ko = cvt_pk_bf16(ksa * ela, ksb * elb);
                if (i & 1) { kota[i >> 1] |= ko << 16; kotb[i >> 1] |= ko & 0xffff0000u; } else { kota[i >> 1] = ko & 0xffffu; kotb[i >> 1] = ko >> 16; }
            }
            { const int rot = ((kc2 >> 4) + tg) & 7;
              *(LAS u32x4*)(KOT + kc2 * 144 + rot * 16) = (u32x4){kota[0], kota[1], kota[2], kota[3]};
              *(LAS u32x4*)(KOT + (kc2 + 1) * 144 + rot * 16) = (u32x4){kotb[0], kotb[1], kotb[2], kotb[3]}; }
            if (tg == 0) *(LAS f32x2*)(BL + kc2) = (f32x2){__expf(blast.x), __expf(blast.y)};
            if (n + 1 < 68) GLA_LOAD(n + 1);
            __syncthreads();
            const int tt = wave >> 1;
            bf16x8 aq[4];
#pragma unroll
            for (int kk = 0; kk < 4; ++kk) aq[kk] = *(const LAS bf16x8*)(QS + (tt * 16 + fr) * 272 + (kk * 32 + fq * 8) * 2);
#pragma unroll
            for (int st = 0; st < 4; ++st) {
                f32x4 acc = (f32x4){0.f, 0.f, 0.f, 0.f};
                if (st <= tt) {
#pragma unroll
                    for (int kk = 0; kk < 4; ++kk) {
                        const bf16x8 bv = *(const LAS bf16x8*)(KS + (st * 16 + fr) * 272 + (kk * 32 + fq * 8) * 2);
                        acc = __builtin_amdgcn_mfma_f32_16x16x32_bf16(aq[kk], bv, acc, 0, 0, 0);
                    }
                }
#pragma unroll
                for (int j = 0; j < 4; ++j) { const int tl = fq * 4 + j, s = st * 16 + fr; *(LAS bf16_t*)(PPW + tl * 144 + s * 2) = (bf16_t)f2bf(s <= tt * 16 + tl ? acc[j] : 0.f); }
            }
            LDS_WAIT();
            unsigned ow[2][2];
            bf16x8 ap[2], ai[4];
#pragma unroll
            for (int kk = 0; kk < 2; ++kk) ap[kk] = *(const LAS bf16x8*)(PPW + fr * 144 + (kk * 32 + fq * 8) * 2);
#pragma unroll
            for (int kk = 0; kk < 4; ++kk) ai[kk] = *(const LAS bf16x8*)(QIN + (tt * 16 + fr) * 272 + (kk * 32 + fq * 8) * 2);
#pragma unroll
            for (int vti = 0; vti < 2; ++vti) {
                const int vt = 2 * (wave & 1) + vti; f32x4 acc = (f32x4){0.f, 0.f, 0.f, 0.f};
#pragma unroll
                for (int kk = 0; kk < 2; ++kk) {
                    const bf16x8 bv = *(const LAS bf16x8*)(VT + (vt * 16 + fr) * 144 + (kk * 32 + fq * 8) * 2);
                    acc = __builtin_amdgcn_mfma_f32_16x16x32_bf16(ap[kk], bv, acc, 0, 0, 0);
                }
#pragma unroll
                for (int kk = 0; kk < 4; ++kk) {
                    const bf16x8 bv = *(const LAS bf16x8*)(STc + (vt * 16 + fr) * 272 + (kk * 32 + fq * 8) * 2);
                    acc = __builtin_amdgcn_mfma_f32_16x16x32_bf16(ai[kk], bv, acc, 0, 0, 0);
                }
                ow[vti][0] = cvt_pk_bf16(acc[0], acc[1]); ow[vti][1] = cvt_pk_bf16(acc[2], acc[3]);
            }
#pragma unroll
            for (int vti = 0; vti < 2; ++vti)
#pragma unroll
                for (int j = 0; j < 4; ++j) { const unsigned w = ow[vti][j >> 1]; *(LAS bf16_t*)(PPW + (fq * 4 + j) * 144 + (vti * 16 + fr) * 2) = (bf16_t)((j & 1) ? (w >> 16) : (w & 0xffffu)); }
            bf16x8 ak[2]; const f32x4 blv = *(const LAS f32x4*)(BL + wave * 16 + fq * 4);
#pragma unroll
            for (int kk = 0; kk < 2; ++kk) ak[kk] = *(const LAS bf16x8*)(KOT + (wave * 16 + fr) * 144 + (((kk * 4 + fq) + wave) & 7) * 16);
#pragma unroll
            for (int vt = 0; vt < 4; ++vt) {
                Sacc[vt] *= blv;
#pragma unroll
                for (int kk = 0; kk < 2; ++kk) {
                    const bf16x8 bv = *(const LAS bf16x8*)(VT + (vt * 16 + fr) * 144 + (kk * 32 + fq * 8) * 2);
                    Sacc[vt] = __builtin_amdgcn_mfma_f32_16x16x32_bf16(ak[kk], bv, Sacc[vt], 0, 0, 0);
                }
                *(LAS u32x2*)(STn + (vt * 16 + fr) * 272 + (wave * 16 + fq * 4) * 2) = (u32x2){pk2(Sacc[vt][0], Sacc[vt][1]), pk2(Sacc[vt][2], Sacc[vt][3])};
            }
            if (n + 1 < 68) GLA_CUMSUM(par ^ 1);
            __syncthreads();
        }
        GLA_OSTORE(67);
    }
}
#undef GLA_OSTORE
#undef GLA_CUMSUM
#undef GLA_LOAD
__device__ __forceinline__ void gla_readout_phase(const Args& a, int lane, int gw, int NGW) {
    const bf16_t* OF = (const bf16_t*)(a.ws + WS_OF); const bf16_t* OB = (const bf16_t*)(a.ws + WS_OB);
    const bf16_t* G = (const bf16_t*)(a.ws + WS_G); bf16_t* OG = (bf16_t*)(a.ws + WS_OG);
    f32x4 ng[4];
#pragma unroll
    for (int j = 0; j < 4; ++j) ng[j] = *(const f32x4*)(a.in[I_HGNG] + 16 * lane + 4 * j);
    for (int row0 = gw * 4; row0 < NTOK; row0 += NGW * 4) {
        u32x4 of[4][2], ob[4][2], gg[4][2];
#pragma unroll
        for (int r = 0; r < 4; ++r) { const size_t o = (size_t)(row0 + r) * D + 16 * lane;
            of[r][0] = *(const u32x4*)(OF + o); of[r][1] = *(const u32x4*)(OF + o + 8); ob[r][0] = *(const u32x4*)(OB + o); ob[r][1] = *(const u32x4*)(OB + o + 8);
            gg[r][0] = *(const u32x4*)(G + o); gg[r][1] = *(const u32x4*)(G + o + 8); }
#pragma unroll
        for (int r = 0; r < 4; ++r) {
            float v[16]; float s = 0.f;
#pragma unroll
            for (int q = 0; q < 8; ++q) { const unsigned wf = of[r][q >> 2][q & 3], wb = ob[r][q >> 2][q & 3]; v[2 * q] = bflo(wf) + bflo(wb); v[2 * q + 1] = bfhi(wf) + bfhi(wb); s += v[2 * q] * v[2 * q] + v[2 * q + 1] * v[2 * q + 1]; }
            s += __shfl_xor(s, 1); s += __shfl_xor(s, 2); s += __shfl_xor(s, 4);
            const float rstd = 1.0f / sqrtf(s * (1.0f / 128.0f) + EPS);
            unsigned ow[8];
#pragma unroll
            for (int q = 0; q < 8; ++q) { const unsigned wg = gg[r][q >> 2][q & 3];
                ow[q] = pk2(v[2 * q] * rstd * ng[q >> 1][(2 * q) & 3] * silu_f(bflo(wg)), v[2 * q + 1] * rstd * ng[q >> 1][(2 * q + 1) & 3] * silu_f(bfhi(wg))); }
            const size_t o = (size_t)(row0 + r) * D + 16 * lane;
            *(u32x4*)(OG + o) = (u32x4){ow[0], ow[1], ow[2], ow[3]}; *(u32x4*)(OG + o + 8) = (u32x4){ow[4], ow[5], ow[6], ow[7]};
        }
    }
}

struct EpiMoe1 {
    static constexpr bool PERM = true;
    const float* b1; bf16_t* ACT;
    __device__ __forceinline__ void operator()(const f32x4 (&acc)[2][2][4][2], const Unit& u, int wr, int wc, int fr, int fq) const {
        const int e = u.pn >> 3, pnl = u.pn & 7, cb = pnl * 128 + wc * 32 + 8 * fq, row0 = u.pm * 256 + wr * 64 + fr;
        const float* bg = b1 + (size_t)e * 2048;
        const f32x4 bg0 = *(const f32x4*)(bg + cb), bg1 = *(const f32x4*)(bg + cb + 4), bl0 = *(const f32x4*)(bg + 1024 + cb), bl1 = *(const f32x4*)(bg + 1024 + cb + 4);
#pragma unroll
        for (int ai = 0; ai < 2; ++ai)
#pragma unroll
            for (int m = 0; m < 4; ++m) {
                f32x4 o[2];
#pragma unroll
                for (int n = 0; n < 2; ++n) {
                    const f32x4 zg = acc[ai][0][m][n] + (n ? bg1 : bg0), zl = acc[ai][1][m][n] + (n ? bl1 : bl0);
#pragma unroll
                    for (int j = 0; j < 4; ++j) { const float g_ = fminf(zg[j], 7.0f), l_ = fminf(fmaxf(zl[j], -7.0f), 7.0f); o[n][j] = g_ * sigmoid_f(1.702f * g_) * (l_ + 1.0f); }
                }
                *(u32x4*)(ACT + (size_t)(row0 + ai * 128 + m * 16) * D + cb) = (u32x4){pk2(o[0][0], o[0][1]), pk2(o[0][2], o[0][3]), pk2(o[1][0], o[1][1]), pk2(o[1][2], o[1][3])};
            }
    }
};
struct EpiMoe2 {
    static constexpr bool PERM = true;
    const float* b2; bf16_t* YS;
    __device__ __forceinline__ void operator()(const f32x4 (&acc)[2][2][4][2], const Unit& u, int wr, int wc, int fr, int fq) const {
        const int e = u.pn >> 2, pnl = u.pn & 3, cb = pnl * 256 + wc * 32 + 8 * fq, row0 = u.pm * 256 + wr * 64 + fr;
        const float* bb = b2 + (size_t)e * 1024;
#pragma unroll
        for (int bj = 0; bj < 2; ++bj) {
            const int c = cb + bj * 128; const f32x4 bv0 = *(const f32x4*)(bb + c), bv1 = *(const f32x4*)(bb + c + 4);
#pragma unroll
            for (int ai = 0; ai < 2; ++ai)
#pragma unroll
                for (int m = 0; m < 4; ++m) {
                    const f32x4 v0 = acc[ai][bj][m][0] + bv0, v1 = acc[ai][bj][m][1] + bv1;
                    *(u32x4*)(YS + (size_t)(row0 + ai * 128 + m * 16) * D + c) = (u32x4){pk2(v0[0], v0[1]), pk2(v0[2], v0[3]), pk2(v1[0], v1[1]), pk2(v1[2], v1[3])};
                }
        }
    }
};

__device__ __forceinline__ void router_phase(const Args& a, LAS unsigned char* lds, int layer, int row_lo, int tid) {
    const int lane = tid & 63, wave = tid >> 6, fr = lane & 15, fq = lane >> 4;
    const bf16_t* H = (const bf16_t*)(a.ws + WS_H); bf16_t* F = (bf16_t*)(a.ws + WS_F);
    const float* modv = (const float*)(a.ws + WS_MODV) + (size_t)layer * 9 * 6144;
    int* TOKE = (int*)(a.ws + WS_TOKE); float* TOKW = (float*)(a.ws + WS_TOKW);
    unsigned* cntb = (unsigned*)(a.ws + WS_CTL) + CW_CNTB + layer * 8192;
    LAS unsigned char* FH = lds;
    LAS unsigned char* FL = lds + 16 * 2064;
    LAS float* PART = (LAS float*)(lds + 2 * 16 * 2064);
    LAS int* hist = (LAS int*)(lds + 2 * 16 * 2064 + 16384);
    if (tid < 32) hist[tid] = 0;
    const float* n2g = a.in[I_N2G] + layer * D; const float* rw = a.in[I_RW] + (size_t)layer * D * NE; const float* rb = a.in[I_RB] + layer * NE;
    const float* rwp = rw + (size_t)(wave * 128 + fq * 8) * NE + fr;
    bf16x8 rwH[2][4], rwL[2][4];
#pragma unroll
    for (int kk = 0; kk < 4; ++kk) {
#pragma unroll
        for (int et = 0; et < 2; ++et)
#pragma unroll
            for (int j = 0; j < 8; ++j) {
                const float w = rwp[kk * 32 * NE + j * NE + et * 16];
                const unsigned h = f2bf(w); const float lo = w - bf2f((unsigned short)h);
                rwH[et][kk][j] = (short)h; rwL[et][kk][j] = (short)f2bf(lo);
            }
        asm volatile("" ::: "memory");
    }
    const int ngroups = (NTOK - row_lo) >> 4;
    u32x2 vvp[2][4]; f32x4 gvv[4], scvv[4], shvv[4];
#pragma unroll
    for (int j = 0; j < 4; ++j) gvv[j] = *(const f32x4*)(n2g + 4 * lane + 256 * j);
#define RT_LOAD(gi_) do { _Pragma("unroll") for (int rr = 0; rr < 2; ++rr) _Pragma("unroll") for (int j = 0; j < 4; ++j) \
        vvp[rr][j] = *(const u32x2*)(H + (size_t)(row_lo + (gi_) * 16 + 2 * wave + rr) * D + 4 * lane + 256 * j); \
        { const float* mvp_ = modv + (size_t)mod_row(row_lo + (gi_) * 16) * 6144; _Pragma("unroll") for (int j = 0; j < 4; ++j) { scvv[j] = *(const f32x4*)(mvp_ + 4096 + 4 * lane + 256 * j); shvv[j] = *(const f32x4*)(mvp_ + 3072 + 4 * lane + 256 * j); } } } while (0)
    if ((int)blockIdx.x < ngroups) RT_LOAD(blockIdx.x);
    int pend_i = 0; float pend_w = 0.f; long pend_o = -1;
    for (int gi = blockIdx.x; gi < ngroups; gi += gridDim.x) {
        const int row0 = row_lo + gi * 16;
        __syncthreads();
#pragma unroll
        for (int rr = 0; rr < 2; ++rr) {
            const int rl = 2 * wave + rr, row = row0 + rl; f32x4 v[4];
#pragma unroll
            for (int j = 0; j < 4; ++j) { const u32x2 w = vvp[rr][j]; v[j] = (f32x4){bflo(w.x), bfhi(w.x), bflo(w.y), bfhi(w.y)}; }
            const float rstd = row_rstd(v);
#pragma unroll
            for (int j = 0; j < 4; ++j) {
                const int c = 4 * lane + 256 * j;
                const f32x4 f = v[j] * rstd * gvv[j] * (scvv[j] + 1.0f) + shvv[j];
                st_bf16x4(F + (size_t)row * D + c, f);
                { const unsigned h01 = cvt_pk_bf16(f[0], f[1]), h23 = cvt_pk_bf16(f[2], f[3]);
                  *(LAS u32x2*)(FH + rl * 2064 + c * 2) = (u32x2){h01, h23};
                  *(LAS u32x2*)(FL + rl * 2064 + c * 2) = (u32x2){cvt_pk_bf16(f[0] - bflo(h01), f[1] - bfhi(h01)), cvt_pk_bf16(f[2] - bflo(h23), f[3] - bfhi(h23))}; }
            }
        }
        if (pend_o >= 0) { TOKE[pend_o] = pend_i; TOKW[pend_o] = pend_w; pend_o = -1; }
        if (gi + (int)gridDim.x < ngroups) RT_LOAD(gi + gridDim.x);
        __syncthreads();
        f32x4 acc0 = (f32x4){0.f, 0.f, 0.f, 0.f}, acc1 = (f32x4){0.f, 0.f, 0.f, 0.f};
        bf16x8 aH[4], aL[4];
#pragma unroll
        for (int kk = 0; kk < 4; ++kk) { aH[kk] = *(const LAS bf16x8*)(FH + fr * 2064 + (wave * 128 + kk * 32 + fq * 8) * 2); aL[kk] = *(const LAS bf16x8*)(FL + fr * 2064 + (wave * 128 + kk * 32 + fq * 8) * 2); }
#pragma unroll
        for (int kk = 0; kk < 4; ++kk) {
            acc0 = __builtin_amdgcn_mfma_f32_16x16x32_bf16(aL[kk], rwH[0][kk], acc0, 0, 0, 0); acc1 = __builtin_amdgcn_mfma_f32_16x16x32_bf16(aL[kk], rwH[1][kk], acc1, 0, 0, 0);
            acc0 = __builtin_amdgcn_mfma_f32_16x16x32_bf16(aH[kk], rwL[0][kk], acc0, 0, 0, 0); acc1 = __builtin_amdgcn_mfma_f32_16x16x32_bf16(aH[kk], rwL[1][kk], acc1, 0, 0, 0);
            acc0 = __builtin_amdgcn_mfma_f32_16x16x32_bf16(aH[kk], rwH[0][kk], acc0, 0, 0, 0); acc1 = __builtin_amdgcn_mfma_f32_16x16x32_bf16(aH[kk], rwH[1][kk], acc1, 0, 0, 0);
        }
#pragma unroll
        for (int j = 0; j < 4; ++j) { PART[(wave * 16 + fq * 4 + j) * 32 + fr] = acc0[j]; PART[(wave * 16 + fq * 4 + j) * 32 + 16 + fr] = acc1[j]; }
        __syncthreads();
        {
            const int half = lane >> 5, e = lane & 31, rl = 2 * wave + half, row = row0 + rl;
            float lg = rb[e];
#pragma unroll
            for (int w = 0; w < 8; ++w) lg += PART[(w * 16 + rl) * 32 + e];
            float sv[4]; int si[4];
#pragma unroll
            for (int r = 0; r < 4; ++r) {
                float m = lg;
#pragma unroll
                for (int o = 1; o < 32; o <<= 1) m = fmaxf(m, __shfl_xor(m, o));
                const unsigned long long bal = __ballot(lg == m); const unsigned mine = (unsigned)(bal >> (32 * half));
                const int idx = __ffs((int)mine) - 1;
                sv[r] = m; si[r] = idx; if (e == idx) lg = -3.0e38f;
            }
            const float e1 = __expf(sv[1] - sv[0]), e2 = __expf(sv[2] - sv[0]), e3 = __expf(sv[3] - sv[0]); const float inv = 1.0f / (1.0f + e1 + e2 + e3);
            if (e < 4) {
                const int myi = e == 0 ? si[0] : (e == 1 ? si[1] : (e == 2 ? si[2] : si[3]));
                const float myw = (e == 0 ? 1.0f : (e == 1 ? e1 : (e == 2 ? e2 : e3))) * inv;
                pend_i = myi; pend_w = myw; pend_o = (long)row * 4 + e;
                atomicAdd((int*)hist + myi, 1);
            }
        }
    }
    if (pend_o >= 0) { TOKE[pend_o] = pend_i; TOKW[pend_o] = pend_w; }
    __syncthreads();
    if (tid < 32) cntb[(size_t)blockIdx.x * 32 + tid] = (unsigned)hist[tid];
}
#undef RT_LOAD
__device__ __forceinline__ void assign_phase(const Args& a, LAS unsigned char* lds, int layer, int row_lo, int tid) {
    const int lane = tid & 63, wave = tid >> 6;
    const unsigned* cntb = (const unsigned*)(a.ws + WS_CTL) + CW_CNTB + layer * 8192; unsigned* gcnt = (unsigned*)(a.ws + WS_CTL) + CW_CNT + layer * 64;
    const bf16_t* F = (const bf16_t*)(a.ws + WS_F); bf16_t* AG = (bf16_t*)(a.ws + WS_AG);
    const int* TOKE = (const int*)(a.ws + WS_TOKE); int* TOKS = (int*)(a.ws + WS_TOKS);
    LAS int* off = (LAS int*)lds; LAS int* cnt = (LAS int*)(lds + 256); LAS int* base = (LAS int*)(lds + 512); LAS int* cur = (LAS int*)(lds + 768);
    LAS int* pa = (LAS int*)(lds + 1024); LAS int* pl = (LAS int*)(lds + 1024 + 2048);
    {
        const int e = tid & 31, part = tid >> 5; int s_all = 0, s_lt = 0;
        for (int bb = part; bb < (int)gridDim.x; bb += 16) { const int c = (int)cntb[(size_t)bb * 32 + e]; s_all += c; if (bb < (int)blockIdx.x) s_lt += c; }
        pa[part * 32 + e] = s_all; pl[part * 32 + e] = s_lt;
    }
    __syncthreads();
    if (tid < 32) { int s_all = 0, s_lt = 0; for (int p = 0; p < 16; ++p) { s_all += pa[p * 32 + tid]; s_lt += pl[p * 32 + tid]; } cnt[tid] = s_all; base[tid] = s_lt; cur[tid] = 0; if (blockIdx.x == 0) gcnt[tid] = (unsigned)s_all; }
    __syncthreads();
    if (tid == 0) { int o = 0; for (int e = 0; e < 32; ++e) { off[e] = o; o += ((cnt[e] + 255) >> 8) << 8; } }
    __syncthreads();
    if (tid < 32) base[tid] += off[tid];
    __syncthreads();
    const int gw = blockIdx.x * 8 + wave, NGW = gridDim.x * 8;
    int* SLOTTOK = (int*)(a.ws + WS_SLOTTOK);
    for (int idx = blockIdx.x * NTHREADS + tid; idx < 32 * 256; idx += gridDim.x * NTHREADS) {
        const int e = idx >> 8, c = cnt[e], r = c + (idx & 255), padded = ((c + 255) >> 8) << 8;
        if (r < padded) SLOTTOK[off[e] + r] = 0;
    }
    const int ngroups = (NTOK - row_lo) >> 4;
    for (int gi = blockIdx.x; gi < ngroups; gi += gridDim.x) {
        const int r0 = row_lo + gi * 16 + 2 * wave;
        if (lane < 8) { const int e = TOKE[(size_t)r0 * 4 + lane]; const int pos = atomicAdd((int*)cur + e, 1); const int slot = base[e] + pos; TOKS[(size_t)r0 * 4 + lane] = slot; SLOTTOK[slot] = r0 + (lane >> 2); }
    }
    (void)gw; (void)NGW; (void)F; (void)AG;
}
__device__ __forceinline__ int moe_tiles(const Args& a, LAS unsigned char* lds, int layer, int tid) {
    const unsigned* gcnt = (const unsigned*)(a.ws + WS_CTL) + CW_CNT + layer * 64;
    LAS int* tbl = (LAS int*)(lds + 131072 + 1024);
    if (tid == 0) { int t = 0; for (int e = 0; e < 32; ++e) { const int nt = ((int)gcnt[e] + 255) >> 8; for (int k = 0; k < nt; ++k) tbl[t++] = e; } tbl[1000] = t; }
    __syncthreads();
    return tbl[1000];
}
__device__ __forceinline__ void combine_phase(const Args& a, int layer, int row_lo, int lane, int gw, int NGW) {
    bf16_t* H = (bf16_t*)(a.ws + WS_H); const bf16_t* YS = (const bf16_t*)(a.ws + WS_YS);
    const int* TOKS = (const int*)(a.ws + WS_TOKS); const float* TOKW = (const float*)(a.ws + WS_TOKW);
    const float* modv = (const float*)(a.ws + WS_MODV);
    for (int row0 = row_lo + gw * 2; row0 < NTOK; row0 += NGW * 2) {
        const int mr = mod_row(row0);
        u32x4 sl[2]; f32x4 wv[2];
#pragma unroll
        for (int r = 0; r < 2; ++r) { sl[r] = *(const u32x4*)(TOKS + (size_t)(row0 + r) * 4); wv[r] = *(const f32x4*)(TOKW + (size_t)(row0 + r) * 4); }
        u32x2 ys[2][4][4]; f32x4 hv[2][4];
#pragma unroll
        for (int r = 0; r < 2; ++r)
#pragma unroll
            for (int j = 0; j < 4; ++j) {
                hv[r][j] = ld_bf16x4(H + (size_t)(row0 + r) * D + 4 * lane + 256 * j);
#pragma unroll
                for (int k = 0; k < 4; ++k) ys[r][k][j] = *(const u32x2*)(YS + (size_t)sl[r][k] * D + 4 * lane + 256 * j);
            }
        const float* g2 = modv + (size_t)(layer * 9 + mr) * 6144 + 5120;
        f32x4 g2v[4];
#pragma unroll
        for (int j = 0; j < 4; ++j) g2v[j] = *(const f32x4*)(g2 + 4 * lane + 256 * j);
        ModVec m;
        if (layer == 0) { const float* mv = modv + (size_t)(9 + mr) * 6144; modvec_load(m, a.in[I_N1G] + D, mv + 1024, mv, lane); }
        else {
#pragma unroll
            for (int j = 0; j < 4; ++j) m.g[j] = *(const f32x4*)(a.in[I_FG] + 4 * lane + 256 * j);
        }
#pragma unroll
        for (int r = 0; r < 2; ++r) {
            const int row = row0 + r; f32x4 v[4];
#pragma unroll
            for (int j = 0; j < 4; ++j) {
                const int c = 4 * lane + 256 * j; f32x4 y = (f32x4){0.f, 0.f, 0.f, 0.f};
#pragma unroll
                for (int k = 0; k < 4; ++k) { const u32x2 w = ys[r][k][j]; y += (f32x4){bflo(w.x), bfhi(w.x), bflo(w.y), bfhi(w.y)} * wv[r][k]; }
                v[j] = hv[r][j] + g2v[j] * y;
                if (layer == 0) st_bf16x4(H + (size_t)row * D + c, v[j]);
            }
            const float rstd = row_rstd(v);
            if (layer == 0) {
                int orow = row;
                if (row >= NCTX) { const int li = row - NCTX, b = li >> 12, t = li & 4095; orow = NCTX + b * SEQ + (t & 63) * 64 + (t >> 6); }
                norm_mod_store(v, rstd, m, (bf16_t*)(a.ws + WS_A) + (size_t)orow * D, lane);
            } else {
#pragma unroll
                for (int j = 0; j < 4; ++j) { const int c = 4 * lane + 256 * j; *(f32x4*)(a.out + (size_t)(row - NCTX) * D + c) = v[j] * rstd * m.g[j]; }
            }
        }
    }
}
__device__ __forceinline__ void moe_gemm1(const Args& a, LAS unsigned char* lds, int layer, int tid, int G, int vcu) {
    unsigned char* ws = a.ws;
    const int TT = moe_tiles(a, lds, layer, tid);
    const LAS int* tbl = (const LAS int*)(lds + 131072 + 1024);
    pg8::Gemm g{(const bf16_t*)(ws + WS_F), (const bf16_t*)(ws + WS_W1) + (size_t)layer * 32 * 2048 * 1024, MPAD, 32 * 2048, 1024};
    pg8::MoeOrder S{tbl, TT, 3, G, vcu};
    EpiMoe1 E{a.in[I_B1] + (size_t)layer * 32 * 2048, (bf16_t*)(ws + WS_ACT)};
    LAS unsigned short* rowl = (LAS unsigned short*)(lds + 136192);
    { const int* slottok = (const int*)(ws + WS_SLOTTOK); pg8::Unit uu; int t2 = threadIdx.x; asm volatile("" : "+v"(t2)); const int tid = t2;
      for (int i = 0; i < 21; i += 2) { const int ii = i + (tid >> 8); if (ii < 21 && S.next(ii, uu)) rowl[ii * 256 + (tid & 255)] = (unsigned short)slottok[uu.pm * 256 + (tid & 255)]; } }
    __syncthreads();
    pg8::gemm_phase<EpiMoe1, pg8::MoeOrder, true>(lds, g, S, E, rowl);
}
__device__ __forceinline__ void moe_gemm2(const Args& a, LAS unsigned char* lds, int layer, int tid, int G, int vcu) {
    unsigned char* ws = a.ws;
    const int TT = moe_tiles(a, lds, layer, tid);
    const LAS int* tbl = (const LAS int*)(lds + 131072 + 1024);
    pg8::Gemm g{(const bf16_t*)(ws + WS_ACT), (const bf16_t*)(ws + WS_W2) + (size_t)layer * 32 * 1024 * 1024, MPAD, 32 * 1024, 1024};
    pg8::MoeOrder S{tbl, TT, 2, G, vcu};
    EpiMoe2 E{a.in[I_B2] + (size_t)layer * 32 * 1024, (bf16_t*)(ws + WS_YS)};
    pg8::gemm_phase<EpiMoe2, pg8::MoeOrder>(lds, g, S, E);
}


__device__ __forceinline__ void s5_disc(const Args& a, int d, int g, int p, float& ab_re, float& ab_im, float& co_re, float& co_im) {
    const float lam_re = fminf(a.in[I_S5ARE][(d * 64 + g) * 64 + p], -1e-4f), lam_im = a.in[I_S5AIM][(d * 64 + g) * 64 + p];
    const float dt = expf(a.in[I_S5LDT][d * 64 + g]);
    const float mag = expf(lam_re * dt), ang = lam_im * dt;
    ab_re = mag * cosf(ang); ab_im = mag * sinf(ang);
    const float den = lam_re * lam_re + lam_im * lam_im;
    co_re = ((ab_re - 1.0f) * lam_re + ab_im * lam_im) / den;
    co_im = (ab_im * lam_re - (ab_re - 1.0f) * lam_im) / den;
}
__device__ __forceinline__ void s5_phase(const Args& a, LAS unsigned char* lds, int tid) {
    const int lane = tid & 63, wave = tid >> 6, fr = lane & 15, fq = lane >> 4;
    if (wave >= 4) {
        LAS unsigned* scr = (LAS unsigned*)(lds + 104448 + (wave - 4) * 8320);
        const int cw = blockIdx.x * 4 + (wave - 4), NCW = gridDim.x * 4;
#define L1_ITEM(i) moe_item(a, (i), 1)
        TR_LOOP(cw, NCW, 32 * 512 + 32 * 256, L1_ITEM);
#undef L1_ITEM
        return;
    }
    LAS unsigned char* wl = lds + wave * 26112;
    const bf16_t* A1 = (const bf16_t*)(a.ws + WS_A);
    for (int item = blockIdx.x; item < 256; item += gridDim.x) {
        const int b = item >> 5, dir = (item >> 4) & 1, g = (item & 15) * 4 + wave;
        bf16_t* Y = (bf16_t*)(a.ws + (dir ? WS_YB : WS_YF));
        float ab_re, ab_im, cr_, ci_;
        s5_disc(a, dir, g, lane, ab_re, ab_im, cr_, ci_);
        bf16x8 Bd[4], Cf[4];
        {
            f32x4 cre[4], cim[4];
#pragma unroll
            for (int kk = 0; kk < 4; ++kk) { const size_t o = ((size_t)(dir * 64 + g) * 16 + fr) * 64 + kk * 16 + fq * 4; cre[kk] = *(const f32x4*)(a.in[I_S5CRE] + o); cim[kk] = *(const f32x4*)(a.in[I_S5CIM] + o); }
#pragma unroll
            for (int kk = 0; kk < 4; ++kk)
#pragma unroll
                for (int j = 0; j < 8; ++j) Cf[kk][j] = (short)f2bf((j & 1) ? -cim[kk][j >> 1] : cre[kk][j >> 1]);
            {
                const int c31 = lane & 31, h5 = lane >> 5;
                f32x4 br0[4], br1[4], bi0[4], bi1[4];
#pragma unroll
                for (int ct = 0; ct < 4; ++ct) {
                    const int pp = ct * 16 + (c31 >> 1); const size_t o = (size_t)(g * 64 + pp) * 16 + h5 * 8;
                    br0[ct] = *(const f32x4*)(a.in[I_S5BRE] + o); br1[ct] = *(const f32x4*)(a.in[I_S5BRE] + o + 4); bi0[ct] = *(const f32x4*)(a.in[I_S5BIM] + o); bi1[ct] = *(const f32x4*)(a.in[I_S5BIM] + o + 4);
                }
#pragma unroll
                for (int ct = 0; ct < 4; ++ct) {
                    const int pp = ct * 16 + (c31 >> 1); const float qr = __shfl(cr_, pp), qi = __shfl(ci_, pp);
#pragma unroll
                    for (int j = 0; j < 8; ++j) {
                        const float br = j < 4 ? br0[ct][j & 3] : br1[ct][j & 3], bi = j < 4 ? bi0[ct][j & 3] : bi1[ct][j & 3];
                        Bd[ct][j] = (short)f2bf((c31 & 1) ? (qr * bi + qi * br) : (qr * br - qi * bi));
                    }
                }
            }
        }
#define S5_POS(n_, t_) ((((n_) < 8) ? (n_) : (n_) - 8) * 32 + (t_))
#define S5_ROW(n_, t_) ((((n_) < 8) ? b * CTXL : NCTX + b * SEQ) + (dir ? (((n_) < 8) ? CTXL : SEQ) - 1 - S5_POS(n_, t_) : S5_POS(n_, t_)))
#define S5_LOADU(d0, n_) do { d0 = (bf16x8){0, 0, 0, 0, 0, 0, 0, 0}; if ((n_) < 136) d0 = *(const bf16x8*)(A1 + (size_t)S5_ROW(n_, lane & 31) * D + g * 16 + (lane >> 5) * 8); } while (0)
        LAS float* BUF = (LAS float*)wl; LAS unsigned* HW = (LAS unsigned*)(wl + 17408); const LAS unsigned char* HP = wl + 17408;
        bf16x8 ua0, ub0, uc0;
        S5_LOADU(ua0, 0); S5_LOADU(ub0, 1);
        f32x2 s = (f32x2){0.f, 0.f};
        const f32x2 abr = (f32x2){ab_re, ab_re}, abi = (f32x2){-ab_im, ab_im};
        bf16_t* yp = Y + (size_t)(b * SEQ + (dir ? SEQ - 1 - fq * 4 : fq * 4)) * D + g * 16 + fr;
        const long ystep = dir ? -(long)D : (long)D;
        unsigned yw[4] = {0u, 0u, 0u, 0u};
#define S5_YSTORE() do { yp[0] = (bf16_t)(yw[0] & 0xffffu); yp[ystep] = (bf16_t)(yw[0] >> 16); yp[2 * ystep] = (bf16_t)(yw[1] & 0xffffu); yp[3 * ystep] = (bf16_t)(yw[1] >> 16); \
            yp[16 * ystep] = (bf16_t)(yw[2] & 0xffffu); yp[17 * ystep] = (bf16_t)(yw[2] >> 16); yp[18 * ystep] = (bf16_t)(yw[3] & 0xffffu); yp[19 * ystep] = (bf16_t)(yw[3] >> 16); yp += 32 * ystep; } while (0)
        for (int n = 0; n < 136; ++n) {
#pragma unroll
            for (int ct = 0; ct < 4; ++ct) {
                typedef float f32x16 __attribute__((ext_vector_type(16)));
                f32x16 z; for (int r = 0; r < 16; ++r) z[r] = 0.f;
                const f32x16 d = __builtin_amdgcn_mfma_f32_32x32x16_bf16(Bd[ct], ua0, z, 0, 0, 0);
#pragma unroll
                for (int q = 0; q < 4; ++q) *(LAS f32x4*)(BUF + (lane & 31) * 132 + ct * 32 + 8 * q + 4 * (lane >> 5)) = (f32x4){d[4 * q], d[4 * q + 1], d[4 * q + 2], d[4 * q + 3]};
            }
            if (n >= 9) S5_YSTORE();
            S5_LOADU(uc0, n + 2);
            LDS_WAIT();
            {
                const bool hist = n >= 8;
                f32x2 bu[32];
#pragma unroll
                for (int j = 0; j < 32; ++j) bu[j] = *(const LAS f32x2*)(BUF + j * 132 + 2 * lane);
                unsigned hw[32];
#pragma unroll
                for (int j = 0; j < 32; ++j) { const f32x2 t1 = abr * s + bu[j]; s = abi * (f32x2){s.y, s.x} + t1; hw[j] = cvt_pk_bf16(s.x, s.y); }
                if (hist) {
#pragma unroll
                    for (int j = 0; j < 32; ++j) HW[j * 68 + lane] = hw[j];
                }
            }
            LDS_WAIT();
            if (n >= 8) {
                f32x4 y0 = (f32x4){0.f, 0.f, 0.f, 0.f}, y1 = (f32x4){0.f, 0.f, 0.f, 0.f};
                bf16x8 ha[2][4];
#pragma unroll
                for (int hf = 0; hf < 2; ++hf)
#pragma unroll
                    for (int kk = 0; kk < 4; ++kk) ha[hf][kk] = *(const LAS bf16x8*)(HP + (hf * 16 + fr) * 272 + (kk * 32 + fq * 8) * 2);
#pragma unroll
                for (int kk = 0; kk < 4; ++kk) { y0 = __builtin_amdgcn_mfma_f32_16x16x32_bf16(ha[0][kk], Cf[kk], y0, 0, 0, 0); y1 = __builtin_amdgcn_mfma_f32_16x16x32_bf16(ha[1][kk], Cf[kk], y1, 0, 0, 0); }
                yw[0] = cvt_pk_bf16(y0[0], y0[1]); yw[1] = cvt_pk_bf16(y0[2], y0[3]); yw[2] = cvt_pk_bf16(y1[0], y1[1]); yw[3] = cvt_pk_bf16(y1[2], y1[3]);
                LDS_WAIT();
            }
            ua0 = ub0; ub0 = uc0;
        }
        S5_YSTORE();
#undef S5_YSTORE
#undef S5_POS
#undef S5_ROW
#undef S5_LOADU
    }
}
__device__ __forceinline__ float gelu_tanh_f(float x) { const float z = 0.7978845608f * (x + 0.044715f * x * x * x); return x * (1.0f - __builtin_amdgcn_rcpf(1.0f + __expf(2.0f * z))); }
__device__ __forceinline__ void s5_post_phase(const Args& a, int lane, int gw, int NGW) {
    const bf16_t* YF = (const bf16_t*)(a.ws + WS_YF); const bf16_t* YB = (const bf16_t*)(a.ws + WS_YB);
    const bf16_t* A1 = (const bf16_t*)(a.ws + WS_A); bf16_t* YG = (bf16_t*)(a.ws + WS_YG);
    f32x4 dk[4];
#pragma unroll
    for (int j = 0; j < 4; ++j) dk[j] = *(const f32x4*)(a.in[I_S5D] + 4 * lane + 256 * j);
    for (int tok0 = gw * 4; tok0 < NLAT; tok0 += NGW * 4) {
        u32x2 yf[4][4], yb[4][4], uu[4][4];
#pragma unroll
        for (int r = 0; r < 4; ++r) { const int tok = tok0 + r, b = tok >> 12, t = tok & 4095, src = b * SEQ + (t & 63) * 64 + (t >> 6);
#pragma unroll
            for (int j = 0; j < 4; ++j) { const int c = 4 * lane + 256 * j; yf[r][j] = *(const u32x2*)(YF + (size_t)src * D + c); yb[r][j] = *(const u32x2*)(YB + (size_t)src * D + c); uu[r][j] = *(const u32x2*)(A1 + (size_t)(NCTX + src) * D + c); } }
#pragma unroll
        for (int r = 0; r < 4; ++r)
#pragma unroll
            for (int j = 0; j < 4; ++j) {
                const u32x2 f = yf[r][j], bk = yb[r][j], uw = uu[r][j];
                const f32x4 y = (f32x4){bflo(f.x) + bflo(bk.x), bfhi(f.x) + bfhi(bk.x), bflo(f.y) + bflo(bk.y), bfhi(f.y) + bfhi(bk.y)} + dk[j] * (f32x4){bflo(uw.x), bfhi(uw.x), bflo(uw.y), bfhi(uw.y)};
                f32x4 o;
#pragma unroll
                for (int i = 0; i < 4; ++i) o[i] = gelu_tanh_f(y[i]);
                st_bf16x4(YG + (size_t)(tok0 + r) * D + 4 * lane + 256 * j, o);
            }
    }
}
struct EpiGlu {
    static constexpr bool PERM = true;
    const float* bglu; const float* modv1; bf16_t* H;
    __device__ __forceinline__ void operator()(const f32x4 (&acc)[2][2][4][2], const Unit& u, int wr, int wc, int fr, int fq) const {
        const int rt0 = u.pm * 256, bidx = rt0 >> 12, cb = u.pn * 128 + wc * 32 + 8 * fq, rl0 = wr * 64 + fr;
        const float* gp = modv1 + bidx * 6144 + 2048;
        const f32x4 ba0 = *(const f32x4*)(bglu + cb), ba1 = *(const f32x4*)(bglu + cb + 4), bb0 = *(const f32x4*)(bglu + 1024 + cb), bb1 = *(const f32x4*)(bglu + 1024 + cb + 4);
        const f32x4 gv0 = *(const f32x4*)(gp + cb), gv1 = *(const f32x4*)(gp + cb + 4);
        u32x4 hws[2][4];
#pragma unroll
        for (int ai = 0; ai < 2; ++ai)
#pragma unroll
            for (int m = 0; m < 4; ++m) hws[ai][m] = *(const u32x4*)(H + (size_t)(NCTX + rt0 + rl0 + ai * 128 + m * 16) * D + cb);
#pragma unroll
        for (int ai = 0; ai < 2; ++ai)
#pragma unroll
            for (int m = 0; m < 4; ++m) {
                bf16_t* hp = H + (size_t)(NCTX + rt0 + rl0 + ai * 128 + m * 16) * D + cb;
                const u32x4 hw = hws[ai][m]; const f32x4 h0 = (f32x4){bflo(hw.x), bfhi(hw.x), bflo(hw.y), bfhi(hw.y)}, h1 = (f32x4){bflo(hw.z), bfhi(hw.z), bflo(hw.w), bfhi(hw.w)};
                const f32x4 za0 = acc[ai][0][m][0] + ba0, za1 = acc[ai][0][m][1] + ba1, zb0 = acc[ai][1][m][0] + bb0, zb1 = acc[ai][1][m][1] + bb1; f32x4 o0, o1;
#pragma unroll
                for (int j = 0; j < 4; ++j) { o0[j] = za0[j] * sigmoid_f(zb0[j]); o1[j] = za1[j] * sigmoid_f(zb1[j]); }
                const f32x4 r0 = h0 + gv0 * o0, r1 = h1 + gv1 * o1;
                *(u32x4*)hp = (u32x4){pk2(r0[0], r0[1]), pk2(r0[2], r0[3]), pk2(r1[0], r1[1]), pk2(r1[2], r1[3])};
            }
    }
};

#define XB_TMO      128
#define XB_XCNT(j)  (256  + 64 * (j))
#define XB_XSUB(j)  (1280 + 64 * (j))
#define XB_XGEN(j)  (2304 + 64 * (j))
#define XB_TOP      3328
#define XB_TOPGEN   3392
#define XCD_BAR_WORDS 3456
#define XB_SPIN_CAP (1u << 18)
__device__ __forceinline__ unsigned xb_ld(unsigned* p)              { return __hip_atomic_load(p, __ATOMIC_RELAXED, __HIP_MEMORY_SCOPE_AGENT); }
__device__ __forceinline__ unsigned xb_add(unsigned* p, unsigned v) { return __hip_atomic_fetch_add(p, v, __ATOMIC_RELAXED, __HIP_MEMORY_SCOPE_AGENT); }
__device__ __forceinline__ unsigned xb_xcc_id() { return (unsigned)__builtin_amdgcn_s_getreg((3 << 11) | 20) & 0xFu; }
#define XB_SPIN(cond, bar) do { unsigned _sp = 0; while (cond) { __builtin_amdgcn_s_sleep(1); \
    if ((++_sp & 255u) == 0u) { if (xb_ld(&(bar)[XB_TMO])) break; if (_sp > XB_SPIN_CAP) { atomicAdd(&(bar)[XB_TMO], 1u); break; } } } } while (0)
struct XcdBarrier { unsigned* bar; unsigned x; volatile LAS unsigned* st; };
__device__ __forceinline__ XcdBarrier xcd_barrier_post(unsigned* bar, volatile LAS unsigned* st) {
    XcdBarrier b; b.bar = bar; b.x = xb_xcc_id(); b.st = st;
    if (threadIdx.x == 0) (void)xb_add(&bar[XB_XCNT(b.x)], 1u);
    return b;
}
__device__ __forceinline__ void xcd_barrier_complete(unsigned* bar, unsigned x, unsigned& nloc, unsigned& nx) {
    const unsigned G = gridDim.x * gridDim.y * gridDim.z;
    unsigned sum, cnt, mine, sp = 0u;
    for (;;) {
        sum = 0u; cnt = 0u; mine = 0u;
#pragma unroll
        for (unsigned j = 0; j < 16; ++j) { const unsigned c = xb_ld(&bar[XB_XCNT(j)]); sum += c; cnt += (c > 0u) ? 1u : 0u; mine = (j == x) ? c : mine; }
        if (sum == G) break;
        __builtin_amdgcn_s_sleep(1);
        if ((++sp & 255u) == 0u) { if (xb_ld(&bar[XB_TMO])) break; if (sp > XB_SPIN_CAP) { atomicAdd(&bar[XB_TMO], 1u); break; } }
    }
    nloc = mine > 0u ? mine : 1u; nx = cnt > 0u ? cnt : 1u;
}
__device__ __forceinline__ void xcd_barrier(const XcdBarrier& b) {
    asm volatile("s_waitcnt vmcnt(0)" ::: "memory");
    __syncthreads();
    if (threadIdx.x == 0) {
        unsigned* bar = b.bar;
        __builtin_amdgcn_s_waitcnt(0);
        unsigned nloc = b.st[0], nx = b.st[1];
        if (nloc == 0u) { xcd_barrier_complete(bar, b.x, nloc, nx); b.st[0] = nloc; b.st[1] = nx; }
        const unsigned old = xb_add(&bar[XB_XSUB(b.x)], 1u);
        const unsigned gen = old / nloc;
        if (old + 1u == (gen + 1u) * nloc) {
            __builtin_amdgcn_fence(__ATOMIC_RELEASE, "agent");
            asm volatile("s_waitcnt vmcnt(0)" ::: "memory");
            const unsigned og = xb_add(&bar[XB_TOP], 1u);
            const unsigned tg = og / nx;
            if (og + 1u == (tg + 1u) * nx) xb_add(&bar[XB_TOPGEN], 1u);
            else XB_SPIN(xb_ld(&bar[XB_TOPGEN]) == tg, bar);
            __builtin_amdgcn_fence(__ATOMIC_ACQUIRE, "agent");
            xb_add(&bar[XB_XGEN(b.x)], 1u);
            asm volatile("s_waitcnt vmcnt(0)" ::: "memory");
        } else {
            XB_SPIN(xb_ld(&bar[XB_XGEN(b.x)]) == gen, bar);
            __builtin_amdgcn_fence(__ATOMIC_ACQUIRE, "agent");
            asm volatile("s_waitcnt vmcnt(0)" ::: "memory");
        }
    }
    __syncthreads();
}

__device__ __forceinline__ int opaque_tid() { int t = threadIdx.x; asm volatile("" : "+v"(t)); return t; }
#define PHASE_IDS() const int tid = opaque_tid(); const int lane = tid & 63, wave = tid >> 6; const int G = gridDim.x, gw = blockIdx.x * 8 + wave, NGW = G * 8; \
    const int vcu = (G % 8 == 0) ? (int)(blockIdx.x % 8) * (G / 8) + (int)(blockIdx.x / 8) : (int)blockIdx.x; (void)lane; (void)wave; (void)gw; (void)NGW; (void)vcu; (void)G
__global__ void __launch_bounds__(NTHREADS, 2) fwd_mega(Args a) {
    extern __shared__ __attribute__((aligned(16))) unsigned char lds_raw[];
    LAS unsigned char* lds = (LAS unsigned char*)lds_raw;
    cg::grid_group grid = cg::this_grid();
    unsigned char* ws = a.ws;
    if (threadIdx.x < 2) ((LAS unsigned*)(lds + LDS_BYTES - 16))[threadIdx.x] = 0u;
    __syncthreads();
    const XcdBarrier xbar = xcd_barrier_post((unsigned*)(ws + WS_CTL) + CW_BAR, (volatile LAS unsigned*)(lds + LDS_BYTES - 16));
#ifdef TS_SEL
    volatile LAS unsigned long long* tsbuf = (volatile LAS unsigned long long*)(lds + LDS_BYTES - 16 - 256);
    int tsn = 0;
#define TS_MARK() do { if (blockIdx.x == 0 && threadIdx.x == 0) tsbuf[tsn] = __builtin_amdgcn_s_memrealtime(); ++tsn; } while (0)
#else
#define TS_MARK() do { } while (0)
#endif
    TS_MARK();
#define GSYNC() do { xcd_barrier(xbar); TS_MARK(); } while (0)

    for (int rep = 0; rep < REP_P0; ++rep) { PHASE_IDS(); p0_phase(a, lds, tid, gw, NGW); if (REP_P0 > 1) __syncthreads(); }
    if (a.pad1 != 0) grid.sync();
    GSYNC();
    for (int rep = 0; rep < REP_P1; ++rep) { PHASE_IDS(); p1_phase(a, lane, gw, NGW); }
    GSYNC();
    {
        PHASE_IDS();
        pg8::Gemm g{(const bf16_t*)(ws + WS_A), (const bf16_t*)(ws + WS_WIN), NTOK, 5120, 1024};
        pg8::StaticOrder S; S.init(NTOK, 5120, G, (int)blockIdx.x);
        EpiInProj E{(bf16_t*)(ws + WS_Q), (bf16_t*)(ws + WS_V), (bf16_t*)(ws + WS_G), (_Float16*)(ws + WS_LFF), (_Float16*)(ws + WS_LFB), (const float*)(ws + WS_LBV)};
        for (int rep = 0; rep < REP_INP; ++rep) pg8::gemm_phase<EpiInProj, pg8::StaticOrder>(lds, g, S, E);
    }
    GSYNC();
    for (int rep = 0; rep < REP_GLA; ++rep) { PHASE_IDS(); gla_phase(a, lds, tid); if (REP_GLA > 1) __syncthreads(); }
    GSYNC();
    for (int rep = 0; rep < REP_RO; ++rep) { PHASE_IDS(); gla_readout_phase(a, lane, gw, NGW); }
    GSYNC();
    {
        PHASE_IDS();
        pg8::Gemm g{(const bf16_t*)(ws + WS_OG), (const bf16_t*)(ws + WS_WOUT), NTOK, 1024, 1024};
        pg8::StaticOrder S; S.init(NTOK, 1024, G, (int)blockIdx.x);
        EpiResid E{a.in[I_X], a.in[I_CTX], (const float*)(ws + WS_MODV), (bf16_t*)(ws + WS_H), 2048};
        for (int rep = 0; rep < REP_OUT; ++rep) pg8::gemm_phase<EpiResid, pg8::StaticOrder>(lds, g, S, E);
    }
    GSYNC();
    for (int rep = 0; rep < REP_RT; ++rep) { PHASE_IDS(); router_phase(a, lds, 0, 0, tid); if (REP_RT > 1) __syncthreads(); }
    GSYNC();
    for (int rep = 0; rep < REP_AS; ++rep) { PHASE_IDS(); assign_phase(a, lds, 0, 0, tid); if (REP_AS > 1) __syncthreads(); }
    GSYNC();
    for (int rep = 0; rep < REP_M1; ++rep) { PHASE_IDS(); moe_gemm1(a, lds, 0, tid, G, vcu); }
    GSYNC();
    for (int rep = 0; rep < REP_M2; ++rep) { PHASE_IDS(); moe_gemm2(a, lds, 0, tid, G, vcu); }
    GSYNC();
    { PHASE_IDS(); combine_phase(a, 0, 0, lane, gw, NGW); }
    GSYNC();
    for (int rep = 0; rep < REP_S5; ++rep) { PHASE_IDS(); s5_phase(a, lds, tid); if (REP_S5 > 1) __syncthreads(); }
    GSYNC();
    for (int rep = 0; rep < REP_POST; ++rep) { PHASE_IDS(); s5_post_phase(a, lane, gw, NGW); }
    GSYNC();
    {
        PHASE_IDS();
        pg8::Gemm g{(const bf16_t*)(ws + WS_YG), (const bf16_t*)(ws + WS_WGLU), NLAT, 2048, 1024};
        pg8::StaticOrder S; S.init(NLAT, 2048, G, (int)blockIdx.x);
        EpiGlu E{a.in[I_S5BGLU], (const float*)(ws + WS_MODV) + 9 * 6144, (bf16_t*)(ws + WS_H)};
        pg8::gemm_phase<EpiGlu, pg8::StaticOrder>(lds, g, S, E);
    }
    GSYNC();
    { PHASE_IDS(); router_phase(a, lds, 1, NCTX, tid); }
    GSYNC();
    { PHASE_IDS(); assign_phase(a, lds, 1, NCTX, tid); }
    GSYNC();
    { PHASE_IDS(); moe_gemm1(a, lds, 1, tid, G, vcu); }
    GSYNC();
    { PHASE_IDS(); moe_gemm2(a, lds, 1, tid, G, vcu); }
    GSYNC();
    for (int rep = 0; rep < REP_CMB1; ++rep) { PHASE_IDS(); combine_phase(a, 1, NCTX, lane, gw, NGW); }
#ifdef TS_SEL
    TS_MARK();
    if (blockIdx.x == 0 && threadIdx.x == 0) {
        asm volatile("s_waitcnt vmcnt(0)" ::: "memory"); __threadfence();
        const unsigned long long dt = tsbuf[TS_SEL + 1] - tsbuf[TS_SEL];
        atomicAdd(a.out, (float)dt * 0.001f);
    }
#endif
}

extern "C" void kernel_launch(void* const* d_in, const int* in_sizes, int n_in, void* d_out, int out_size,
                              void* d_ws, size_t ws_size, hipStream_t stream) {
    static int grid_blocks = 0;
    if (!grid_blocks) {
        int dev = 0, cus = 0, per_cu = 0;
        (void)hipGetDevice(&dev);
        (void)hipDeviceGetAttribute(&cus, hipDeviceAttributeMultiprocessorCount, dev);
        (void)hipFuncSetAttribute((const void*)fwd_mega, hipFuncAttributeMaxDynamicSharedMemorySize, LDS_BYTES);
        (void)hipOccupancyMaxActiveBlocksPerMultiprocessor(&per_cu, (const void*)fwd_mega, NTHREADS, LDS_BYTES);
        if (per_cu < 1) { fprintf(stderr, "occupancy query says %d blocks/CU\n", per_cu); }
        grid_blocks = cus < 256 ? cus : 256;
        if (ws_size < WS_END) fprintf(stderr, "kernel_launch: workspace too small: %zu < %zu\n", ws_size, (size_t)WS_END);
    }
    (void)hipMemsetAsync((char*)d_ws + WS_CTL, 0, 1 * MiB, stream);
    Args a{};
    for (int i = 0; i < 29; ++i) a.in[i] = (const float*)d_in[i];
    a.out = (float*)d_out; a.ws = (unsigned char*)d_ws;
    void* kargs[] = {&a};
    hipError_t e = hipLaunchCooperativeKernel((const void*)fwd_mega, dim3(grid_blocks), dim3(NTHREADS), kargs, LDS_BYTES, stream);
    if (e != hipSuccess) fprintf(stderr, "cooperative launch failed: %s (grid %d)\n", hipGetErrorString(e), grid_blocks);
}
```

```cpp
#include <hip/hip_runtime.h>
#include <hip/hip_cooperative_groups.h>
#include <cstdio>
#include <cstdint>
namespace cg = cooperative_groups;

#define LAS __attribute__((address_space(3)))
typedef unsigned short bf16_t;
typedef short bf16x8 __attribute__((ext_vector_type(8)));
typedef float f32x4 __attribute__((ext_vector_type(4)));
typedef unsigned u32x4 __attribute__((ext_vector_type(4)));
typedef unsigned u32x2 __attribute__((ext_vector_type(2)));
typedef float f32x2 __attribute__((ext_vector_type(2)));

constexpr int NTHREADS = 512;
constexpr int LDS_BYTES = 147456;
constexpr int D = 1024, NB = 8, SEQ = 4096, CTXL = 256;
constexpr int NCTX = NB * CTXL;
constexpr int NLAT = NB * SEQ;
constexpr int NTOK = NCTX + NLAT;
constexpr int NE = 32;
constexpr int MPAD = 147456;
constexpr float EPS = 1e-6f;

constexpr size_t MiB = 1u << 20;
constexpr size_t WS_CTL = 0;
constexpr size_t WS_MODV = 1 * MiB;
constexpr size_t WS_LBV = 1 * MiB + 512 * 1024;
constexpr size_t WS_WIN = 2 * MiB;
constexpr size_t WS_WOUT = 12 * MiB;
constexpr size_t WS_WGLU = 14 * MiB;
constexpr size_t WS_W1 = 18 * MiB;
constexpr size_t WS_W2 = 274 * MiB;
constexpr size_t WS_H = 402 * MiB;
constexpr size_t WS_A = 538 * MiB;
constexpr size_t WS_F = 606 * MiB;
constexpr size_t WS_TOKE = 674 * MiB;
constexpr size_t WS_TOKW = 674 * MiB + 640 * 1024;
constexpr size_t WS_TOKS = 674 * MiB + 1280 * 1024;
constexpr size_t WS_SLOTTOK = 256 * 1024;
constexpr size_t WS_BIG = 676 * MiB;
constexpr size_t WS_Q = WS_BIG, WS_V = WS_BIG + 68 * MiB, WS_G = WS_BIG + 136 * MiB;
constexpr size_t WS_LFF = WS_BIG + 204 * MiB, WS_LFB = WS_BIG + 340 * MiB;
constexpr size_t WS_OF = WS_BIG + 476 * MiB, WS_OB = WS_BIG + 612 * MiB;
constexpr size_t WS_OG = WS_BIG + 748 * MiB;
constexpr size_t WS_AG = WS_BIG, WS_ACT = WS_BIG + 288 * MiB, WS_YS = WS_BIG;
constexpr size_t WS_YF = WS_BIG, WS_YB = WS_BIG + 128 * MiB, WS_YG = WS_BIG + 256 * MiB;
constexpr size_t WS_END = WS_BIG + 816 * MiB;
constexpr int CW_CNT = 64;
constexpr int CW_CUR = 256;
constexpr int CW_CNTB = 8192;
constexpr int CW_BAR = 4096;
#ifndef REP_P0
#define REP_P0 1
#endif
#ifndef REP_GLA
#define REP_GLA 1
#endif
#ifndef REP_S5
#define REP_S5 1
#endif
#ifndef REP_P1
#define REP_P1 1
#endif
#ifndef REP_RO
#define REP_RO 1
#endif
#ifndef REP_POST
#define REP_POST 1
#endif
#ifndef REP_CMB1
#define REP_CMB1 1
#endif
#ifndef REP_OUT
#define REP_OUT 1
#endif
#ifndef REP_RT
#define REP_RT 1
#endif
#ifndef REP_AS
#define REP_AS 1
#endif
#ifndef REP_INP
#define REP_INP 1
#endif
#ifndef REP_M1
#define REP_M1 1
#endif
#ifndef REP_M2
#define REP_M2 1
#endif

struct Args {
    const float* in[29];
    float* out;
    unsigned char* ws;
    int stop_after, pad1;
};
enum { I_X = 0, I_C, I_CTX, I_CCTX, I_MODW, I_MODB, I_N1G, I_N2G, I_HGWIN, I_HGLB, I_HGNG, I_HGWOUT, I_S5ARE, I_S5AIM, I_S5LDT,
       I_S5BRE, I_S5BIM, I_S5CRE, I_S5CIM, I_S5D, I_S5WGLU, I_S5BGLU, I_RW, I_RB, I_W1, I_B1, I_W2, I_B2, I_FG };

__device__ __forceinline__ unsigned f2bf(float f) { unsigned u = __builtin_bit_cast(unsigned, f); return (u + 0x7fffu + ((u >> 16) & 1u)) >> 16; }
typedef __bf16 bf16x2_t __attribute__((ext_vector_type(2)));
__device__ __forceinline__ unsigned cvt_pk_bf16(float lo, float hi) { const bf16x2_t v = {(__bf16)lo, (__bf16)hi}; return __builtin_bit_cast(unsigned, v); }
__device__ __forceinline__ unsigned pk2(float lo, float hi) { return cvt_pk_bf16(lo, hi); }
__device__ __forceinline__ float bf2f(unsigned short b) { return __builtin_bit_cast(float, ((unsigned)b) << 16); }
__device__ __forceinline__ float bflo(unsigned w) { return __builtin_bit_cast(float, w << 16); }
__device__ __forceinline__ float bfhi(unsigned w) { return __builtin_bit_cast(float, w & 0xffff0000u); }
__device__ __forceinline__ float wave_sum(float v) {
#pragma unroll
    for (int o = 1; o < 64; o <<= 1) v += __shfl_xor(v, o);
    return v;
}
__device__ __forceinline__ float wave_max(float v) {
#pragma unroll
    for (int o = 1; o < 64; o <<= 1) v = fmaxf(v, __shfl_xor(v, o));
    return v;
}
__device__ __forceinline__ float sigmoid_f(float x) { return __builtin_amdgcn_rcpf(1.0f + __expf(-x)); }
__device__ __forceinline__ float silu_f(float x) { return x * __builtin_amdgcn_rcpf(1.0f + __expf(-x)); }
#define LDS_WAIT() asm volatile("s_waitcnt lgkmcnt(0)" ::: "memory")

namespace pg8 {
constexpr int BM = 256, BK = 64, HALF = 128, HTB = HALF * BK * 2, STAGE_BYTES = 8 * HTB, NXCD = 8, WGM = 8;
__host__ __device__ __forceinline__ int lds_byte(int r, int c) { const int st = (r >> 4) * 2 + (c >> 5), rr = r & 15, cc = c & 31, ob = rr * 64 + cc * 2; return st * 1024 + (ob ^ (((ob >> 9) & 1) << 5)); }
__host__ __device__ __forceinline__ void stage_rc(int b, int& R, int& C) { const int st = b / 1024, sb = b % 1024, swz = sb ^ (((sb >> 9) & 1) << 5); R = (st >> 1) * 16 + swz / 64; C = (st & 1) * 32 + (swz % 64) / 2; }
__host__ __device__ __forceinline__ int perm32(int rho) { const int n = rho >> 4, i = rho & 15; return 8 * (i >> 2) + 4 * n + (i & 3); }
struct Unit { int pm, pn; };
struct Gemm { const bf16_t* A; const bf16_t* Bt; int M, N, K; };
struct StaticOrder {
    int nM, nN, nwg, G, c;
    __device__ void init(int M, int N, int G_, int c_) { nM = M / BM; nN = N / BM; nwg = nM * nN; G = G_; c = c_; }
    __device__ bool next(int i, Unit& u) const {
        const long L = (long)i * G + c; if (L >= nwg) return false;
        int wgid = (int)L; { const int q = nwg / NXCD, r = nwg % NXCD, xcd = wgid % NXCD, off = wgid / NXCD; wgid = (xcd < r ? xcd * (q + 1) : r * (q + 1) + (xcd - r) * q) + off; }
        const int nig = WGM * nN, gid = wgid / nig, fm = gid * WGM, gsz = (nM - fm) < WGM ? (nM - fm) : WGM;
        u.pm = fm + ((wgid % nig) % gsz); u.pn = (wgid % nig) / gsz; return true;
    }
    __device__ __forceinline__ void a_ready(const Unit&) const {}
    __device__ __forceinline__ void done(const Unit&) const {}
};
struct MoeOrder {
    const LAS int* tile_e; int TT, sh, G, v;
    __device__ bool next(int i, Unit& u) const {
        const bool p2 = (G & (G - 1)) == 0 && G >= 8;
        const int lg = p2 ? (31 - __builtin_clz((unsigned)G)) - 3 : 0, per = p2 ? (1 << lg) : G, x = p2 ? (v >> lg) : 0, j = p2 ? (v & (per - 1)) : v, sh3 = p2 ? 3 : 0;
        const int t0 = (x * TT) >> sh3, t1 = ((x + 1) * TT) >> sh3;
        const int uu = i * per + j, rt = t0 + (uu >> sh), pnl = uu & ((1 << sh) - 1);
        if (rt >= t1) return false;
        u.pm = rt; u.pn = (tile_e[rt] << sh) + pnl; return true;
    }
    __device__ __forceinline__ void a_ready(const Unit&) const {}
    __device__ __forceinline__ void done(const Unit&) const {}
};

template <class Epi, class Sched, bool GATHER = false, bool ALIGN_EPI = true, bool SP2 = true>
__device__ __forceinline__ void gemm_phase(LAS unsigned char* lds, const Gemm g, const Sched& S, const Epi& E, const LAS unsigned short* rowl = nullptr) {
    int tid_ = threadIdx.x; asm volatile("" : "+v"(tid_));
    const int tid = tid_, wid = __builtin_amdgcn_readfirstlane(tid >> 6), lane = tid & 63, wr = wid >> 2, wc = wid & 3, fr = lane & 15, fq = lane >> 4;
    const int K = g.K, nt = K / BK;
    unsigned voffA[2], voffB[2];
    int Rr[2], Cc2[2];
#pragma unroll
    for (int i = 0; i < 2; ++i) { int R, C; stage_rc(tid * 16 + i * 8192, R, C); voffA[i] = (unsigned)(R * K + C) * 2u; const int Rb = Epi::PERM ? ((R & ~31) + perm32(R & 31)) : R; voffB[i] = (unsigned)(Rb * K + C) * 2u; Rr[i] = R; Cc2[i] = C * 2; }
    unsigned gA0[2] = {0u, 0u}, gA1[2] = {0u, 0u}, nG0[2] = {0u, 0u}, nG1[2] = {0u, 0u};
#define PG8_ROWS(ui_, d0, d1) do { _Pragma("unroll") for (int _i = 0; _i < 2; ++_i) { d0[_i] = (unsigned)rowl[(ui_) * BM + Rr[_i]] * (unsigned)(K * 2) + (unsigned)Cc2[_i]; d1[_i] = (unsigned)rowl[(ui_) * BM + HALF + Rr[_i]] * (unsigned)(K * 2) + (unsigned)Cc2[_i]; } } while (0)
#define PG8_STAGE_A(bufoff, ptr, h, nx) do { if constexpr (GATHER) { unsigned _o[2]; _o[0] = (nx) ? ((h) ? nG1[0] : nG0[0]) : ((h) ? gA1[0] : gA0[0]); _o[1] = (nx) ? ((h) ? nG1[1] : nG0[1]) : ((h) ? gA1[1] : gA0[1]); PG8_STAGE(bufoff, ptr, _o); } \
        else { PG8_STAGE(bufoff, (ptr) + ((h) ? hstep : 0), voffA); } } while (0)
    const size_t kstep = (size_t)(BK * 2);
    const size_t hstep = (size_t)HALF * K * 2;
    const size_t tstep = 2 * hstep;
    const unsigned ldsw = (unsigned)wid * 1024u;
    const int aoff = lds_byte(wr * 64 + fr, fq * 8), boff = lds_byte(wc * 32 + fr, fq * 8);
#define PG8_SA(b, h) (((b) * 2 + (h)) * HTB)
#define PG8_SB(b, h) ((4 + (b) * 2 + (h)) * HTB)
#define PG8_STAGE(bufoff, gbase, voff) do { _Pragma("unroll") for (int _i = 0; _i < 2; ++_i) \
        __builtin_amdgcn_global_load_lds((const unsigned*)((const char*)(gbase) + (voff)[_i]), (LAS unsigned*)(lds + (bufoff) + ldsw + _i * 8192), 16, 0, 0); } while (0)
#define PG8_LDA(dst, b, h) do { _Pragma("unroll") for (int m = 0; m < 4; ++m) _Pragma("unroll") for (int k = 0; k < 2; ++k) dst[m][k] = *(const LAS bf16x8*)(lds + PG8_SA(b, h) + aoff + m * 2048 + k * 1024); } while (0)
#define PG8_LDB(dst, b, h) do { _Pragma("unroll") for (int n = 0; n < 2; ++n) _Pragma("unroll") for (int k = 0; k < 2; ++k) dst[n][k] = *(const LAS bf16x8*)(lds + PG8_SB(b, h) + boff + n * 2048 + k * 1024); } while (0)
#define PG8_MMA(ai, bj, At, Bt) do { __builtin_amdgcn_s_setprio(1); _Pragma("unroll") for (int m = 0; m < 4; ++m) _Pragma("unroll") for (int n = 0; n < 2; ++n) _Pragma("unroll") for (int k = 0; k < 2; ++k) \
        acc[ai][bj][m][n] = __builtin_amdgcn_mfma_f32_16x16x32_bf16(Bt[n][k], At[m][k], acc[ai][bj][m][n], 0, 0, 0); __builtin_amdgcn_s_setprio(0); } while (0)
#define PG8_WAIT_V(n) asm volatile("s_waitcnt vmcnt(" #n ")" ::: "memory")
#define PG8_WAIT_L(n) asm volatile("s_waitcnt lgkmcnt(" #n ")" ::: "memory")
#define PG8_BAR __builtin_amdgcn_s_barrier()
#define PG8_SCHED __builtin_amdgcn_sched_barrier(0)
    Unit cur, nxt; int ui = 0;
    if (!S.next(0, cur)) return;
    f32x4 acc[2][2][4][2];
#pragma unroll
    for (int a = 0; a < 2; ++a)
#pragma unroll
        for (int b = 0; b < 2; ++b)
#pragma unroll
            for (int m = 0; m < 4; ++m)
#pragma unroll
                for (int n = 0; n < 2; ++n) acc[a][b][m][n] = (f32x4){0.f, 0.f, 0.f, 0.f};
    bf16x8 At[4][2], B0[2][2], B1[2][2];
    const char* cA = GATHER ? (const char*)g.A : (const char*)g.A + (size_t)cur.pm * tstep; const char* cB = (const char*)g.Bt + (size_t)cur.pn * tstep;
    S.a_ready(cur);
    if constexpr (GATHER) PG8_ROWS(0, gA0, gA1);
    if constexpr (SP2) {
        PG8_STAGE(PG8_SB(0, 0), cB, voffB); PG8_STAGE(PG8_SB(0, 1), cB + hstep, voffB); PG8_STAGE_A(PG8_SA(0, 0), cA, 0, false); PG8_STAGE_A(PG8_SA(0, 1), cA, 1, false);
        if (wr == 1) PG8_BAR;
        PG8_WAIT_V(2); PG8_BAR;
        PG8_STAGE(PG8_SB(1, 0), cB + kstep, voffB); PG8_STAGE_A(PG8_SA(1, 0), cA + kstep, 0, false); PG8_STAGE(PG8_SB(1, 1), cB + hstep + kstep, voffB);
        PG8_WAIT_V(6); PG8_BAR;
    } else {
        PG8_STAGE(PG8_SB(0, 0), cB, voffB); PG8_STAGE_A(PG8_SA(0, 0), cA, 0, false); PG8_STAGE(PG8_SB(0, 1), cB + hstep, voffB); PG8_STAGE_A(PG8_SA(0, 1), cA, 1, false);
        if (wr == 1) PG8_BAR;
        PG8_WAIT_V(4); PG8_BAR;
        PG8_STAGE(PG8_SB(1, 0), cB + kstep, voffB); PG8_STAGE_A(PG8_SA(1, 0), cA + kstep, 0, false); PG8_STAGE(PG8_SB(1, 1), cB + hstep + kstep, voffB);
        PG8_WAIT_V(6); PG8_BAR;
    }
    for (;;) {
        const bool has_next = S.next(ui + 1, nxt);
        const char* nA = GATHER ? cA : (has_next ? (const char*)g.A + (size_t)nxt.pm * tstep : cA); const char* nB = has_next ? (const char*)g.Bt + (size_t)nxt.pn * tstep : cB;
        if constexpr (GATHER) { if (has_next) PG8_ROWS(ui + 1, nG0, nG1); else { nG0[0] = gA0[0]; nG0[1] = gA0[1]; nG1[0] = gA1[0]; nG1[1] = gA1[1]; } }
        for (int t = 0; t < nt; t += 2) {
            const bool last = (t == nt - 2);
            const char* a1 = cA + (size_t)(t + 1) * kstep;
            const char* a2 = last ? nA : cA + (size_t)(t + 2) * kstep; const char* b2 = last ? nB : cB + (size_t)(t + 2) * kstep;
            const char* a3 = a2 + kstep; const char* b3 = b2 + kstep;
            if (last && has_next) S.a_ready(nxt);
            if constexpr (SP2) {
            PG8_LDB(B0, 0, 0); PG8_LDB(B1, 0, 1); PG8_SCHED; PG8_LDA(At, 0, 0); PG8_STAGE_A(PG8_SA(1, 1), a1, 1, false);
            PG8_WAIT_V(8); PG8_WAIT_L(0); PG8_BAR; PG8_MMA(0, 0, At, B0); PG8_MMA(0, 1, At, B1); PG8_BAR; PG8_SCHED;
            PG8_LDA(At, 0, 1); PG8_STAGE(PG8_SB(0, 0), b2, voffB); PG8_STAGE(PG8_SB(0, 1), b2 + hstep, voffB); PG8_STAGE_A(PG8_SA(0, 0), a2, 0, last);
            PG8_WAIT_V(8); PG8_WAIT_L(0); PG8_BAR; PG8_MMA(1, 0, At, B0); PG8_MMA(1, 1, At, B1); PG8_BAR; PG8_SCHED;
            PG8_LDB(B0, 1, 0); PG8_LDB(B1, 1, 1); PG8_SCHED; PG8_LDA(At, 1, 0); PG8_STAGE_A(PG8_SA(0, 1), a2, 1, last);
            PG8_WAIT_V(8); PG8_WAIT_L(0); PG8_BAR; PG8_MMA(0, 0, At, B0); PG8_MMA(0, 1, At, B1); PG8_BAR; PG8_SCHED;
            PG8_LDA(At, 1, 1); PG8_STAGE(PG8_SB(1, 0), b3, voffB); PG8_STAGE(PG8_SB(1, 1), b3 + hstep, voffB); PG8_STAGE_A(PG8_SA(1, 0), a3, 0, last);
            PG8_WAIT_V(8); PG8_WAIT_L(0); PG8_BAR; PG8_MMA(1, 0, At, B0); PG8_MMA(1, 1, At, B1); PG8_BAR; PG8_SCHED;
            } else {
            PG8_LDB(B0, 0, 0); PG8_SCHED; PG8_LDA(At, 0, 0); PG8_STAGE_A(PG8_SA(1, 1), a1, 1, false);
            PG8_WAIT_L(8); PG8_BAR; PG8_WAIT_L(0); PG8_MMA(0, 0, At, B0); PG8_BAR; PG8_SCHED;
            PG8_LDB(B1, 0, 1); PG8_STAGE(PG8_SB(0, 0), b2, voffB);
            PG8_BAR; PG8_WAIT_L(0); PG8_MMA(0, 1, At, B1); PG8_BAR;
            PG8_LDA(At, 0, 1); PG8_STAGE_A(PG8_SA(0, 0), a2, 0, last);
            PG8_BAR; PG8_WAIT_L(0); PG8_MMA(1, 0, At, B0); PG8_BAR; PG8_SCHED;
            PG8_STAGE(PG8_SB(0, 1), b2 + hstep, voffB);
            PG8_WAIT_V(6); PG8_BAR; PG8_MMA(1, 1, At, B1); PG8_BAR;
            PG8_LDB(B0, 1, 0); PG8_SCHED; PG8_LDA(At, 1, 0); PG8_STAGE_A(PG8_SA(0, 1), a2, 1, last);
            PG8_WAIT_L(8); PG8_BAR; PG8_WAIT_L(0); PG8_MMA(0, 0, At, B0); PG8_BAR; PG8_SCHED;
            PG8_LDB(B1, 1, 1); PG8_STAGE(PG8_SB(1, 0), b3, voffB);
            PG8_BAR; PG8_WAIT_L(0); PG8_MMA(0, 1, At, B1); PG8_BAR;
            PG8_LDA(At, 1, 1); PG8_STAGE_A(PG8_SA(1, 0), a3, 0, last);
            PG8_BAR; PG8_WAIT_L(0); PG8_MMA(1, 0, At, B0); PG8_BAR; PG8_SCHED;
            PG8_STAGE(PG8_SB(1, 1), b3 + hstep, voffB);
            PG8_WAIT_V(6); PG8_BAR; PG8_MMA(1, 1, At, B1); PG8_BAR;
                    }
        }
        if constexpr (ALIGN_EPI) { if (wr == 0) PG8_BAR; }
        E(acc, cur, wr, wc, fr, fq); S.done(cur);
        if (!has_next) break;
#pragma unroll
        for (int a = 0; a < 2; ++a)
#pragma unroll
            for (int b = 0; b < 2; ++b)
#pragma unroll
                for (int m = 0; m < 4; ++m)
#pragma unroll
                    for (int n = 0; n < 2; ++n) acc[a][b][m][n] = (f32x4){0.f, 0.f, 0.f, 0.f};
        cur = nxt; cA = nA; cB = nB; ++ui;
        if constexpr (GATHER) { gA0[0] = nG0[0]; gA0[1] = nG0[1]; gA1[0] = nG1[0]; gA1[1] = nG1[1]; }
        if constexpr (ALIGN_EPI) { if (wr == 1) PG8_BAR; }
    }
    PG8_WAIT_V(0);
    if constexpr (!ALIGN_EPI) { if (wr == 0) PG8_BAR; }
    PG8_BAR;
#undef PG8_SA
#undef PG8_ROWS
#undef PG8_STAGE_A
#undef PG8_SB
#undef PG8_STAGE
#undef PG8_LDA
#undef PG8_LDB
#undef PG8_MMA
#undef PG8_WAIT_V
#undef PG8_WAIT_L
#undef PG8_BAR
#undef PG8_SCHED
}
}
using pg8::Unit;

__device__ __forceinline__ f32x4 ld_bf16x4(const bf16_t* p) { const u32x2 w = *(const u32x2*)p; return (f32x4){bflo(w.x), bfhi(w.x), bflo(w.y), bfhi(w.y)}; }
__device__ __forceinline__ void pin(f32x4& v) { asm volatile("" : "+v"(v)); }
__device__ __forceinline__ void st_bf16x4(bf16_t* p, f32x4 v) { u32x2 w; w.x = pk2(v[0], v[1]); w.y = pk2(v[2], v[3]); *(u32x2*)p = w; }

struct EpiInProj {
    static constexpr bool PERM = true;
    bf16_t *Q, *V, *G; _Float16 *LFF, *LFB; const float* lbv;
    __device__ __forceinline__ void operator()(const f32x4 (&acc)[2][2][4][2], const Unit& u, int wr, int wc, int fr, int fq) const {
        const int seg = u.pn >> 2, cb = (u.pn & 3) * 256 + wc * 32 + 8 * fq, row0 = u.pm * 256 + wr * 64 + fr;
        if (seg == 2 || seg == 3) {
            _Float16* LF = seg == 2 ? LFF : LFB; const float* lbp = lbv + (seg - 2) * D + cb;
            f32x4 lbA0 = *(const f32x4*)lbp, lbA1 = *(const f32x4*)(lbp + 4), lbB0 = *(const f32x4*)(lbp + 128), lbB1 = *(const f32x4*)(lbp + 132);
            pin(lbA0); pin(lbA1); pin(lbB0); pin(lbB1);
#pragma unroll
            for (int bj = 0; bj < 2; ++bj)
#pragma unroll
                for (int ai = 0; ai < 2; ++ai)
#pragma unroll
                    for (int m = 0; m < 4; ++m) {
                        const f32x4 lb0 = bj ? lbB0 : lbA0, lb1 = bj ? lbB1 : lbA1; const f32x4 v0 = acc[ai][bj][m][0], v1 = acc[ai][bj][m][1]; f32x4 o0, o1;
#pragma unroll
                        for (int j = 0; j < 4; ++j) { o0[j] = __logf(lb0[j] + (1.0f - lb0[j]) * sigmoid_f(v0[j])); o1[j] = __logf(lb1[j] + (1.0f - lb1[j]) * sigmoid_f(v1[j])); }
                        u32x4 hw; hw.x = __builtin_bit_cast(unsigned, __builtin_amdgcn_cvt_pkrtz(o0[0], o0[1])); hw.y = __builtin_bit_cast(unsigned, __builtin_amdgcn_cvt_pkrtz(o0[2], o0[3]));
                        hw.z = __builtin_bit_cast(unsigned, __builtin_amdgcn_cvt_pkrtz(o1[0], o1[1])); hw.w = __builtin_bit_cast(unsigned, __builtin_amdgcn_cvt_pkrtz(o1[2], o1[3]));
                        *(u32x4*)(LF + (size_t)(row0 + ai * 128 + m * 16) * D + cb + bj * 128) = hw;
                    }
        } else if (seg == 0) {
#pragma unroll
            for (int bj = 0; bj < 2; ++bj)
#pragma unroll
                for (int ai = 0; ai < 2; ++ai)
#pragma unroll
                    for (int m = 0; m < 4; ++m) {
                        const f32x4 v0 = acc[ai][bj][m][0], v1 = acc[ai][bj][m][1]; f32x4 o0, o1;
#pragma unroll
                        for (int j = 0; j < 4; ++j) { o0[j] = silu_f(v0[j]); o1[j] = silu_f(v1[j]); }
                        *(u32x4*)(Q + (size_t)(row0 + ai * 128 + m * 16) * D + cb + bj * 128) = (u32x4){pk2(o0[0], o0[1]), pk2(o0[2], o0[3]), pk2(o1[0], o1[1]), pk2(o1[2], o1[3])};
                    }
        } else {
            bf16_t* O = seg == 1 ? V : G;
#pragma unroll
            for (int bj = 0; bj < 2; ++bj)
#pragma unroll
                for (int ai = 0; ai < 2; ++ai)
#pragma unroll
                    for (int m = 0; m < 4; ++m) {
                        const f32x4 v0 = acc[ai][bj][m][0], v1 = acc[ai][bj][m][1];
                        *(u32x4*)(O + (size_t)(row0 + ai * 128 + m * 16) * D + cb + bj * 128) = (u32x4){pk2(v0[0], v0[1]), pk2(v0[2], v0[3]), pk2(v1[0], v1[1]), pk2(v1[2], v1[3])};
                    }
        }
    }
};
struct EpiResid {
    static constexpr bool PERM = true;
    const float* x; const float* ctx; const float* modv; bf16_t* H; int gate_off;
    __device__ __forceinline__ void operator()(const f32x4 (&acc)[2][2][4][2], const Unit& u, int wr, int wc, int fr, int fq) const {
        const int rt0 = u.pm * 256; const int mr = rt0 < NCTX ? 8 : ((rt0 - NCTX) >> 12);
        const float* src = rt0 < NCTX ? ctx + (size_t)rt0 * D : x + (size_t)(rt0 - NCTX) * D;
        const int cb = u.pn * 256 + wc * 32 + 8 * fq, rl0 = wr * 64 + fr;
        const float* gp = modv + mr * 6144 + gate_off;
        f32x4 gg[2][2];
#pragma unroll
        for (int bj = 0; bj < 2; ++bj) { gg[bj][0] = *(const f32x4*)(gp + cb + bj * 128); gg[bj][1] = *(const f32x4*)(gp + cb + bj * 128 + 4); }
#pragma unroll
        for (int bj = 0; bj < 2; ++bj) { pin(gg[bj][0]); pin(gg[bj][1]); }
        f32x4 hA0[2], hA1[2], hB0[2], hB1[2];
#define ER_LOAD(k_, d0, d1) do { const int bj_ = (k_) >> 2, ai_ = ((k_) >> 1) & 1, m0_ = ((k_) & 1) * 2; _Pragma("unroll") for (int m = 0; m < 2; ++m) { const float* hp = src + (size_t)(rl0 + ai_ * 128 + (m0_ + m) * 16) * D + cb + bj_ * 128; d0[m] = *(const f32x4*)hp; d1[m] = *(const f32x4*)(hp + 4); } } while (0)
#define ER_STORE(k_, d0, d1) do { const int bj_ = (k_) >> 2, ai_ = ((k_) >> 1) & 1, m0_ = ((k_) & 1) * 2; _Pragma("unroll") for (int m = 0; m < 2; ++m) { \
            const f32x4 o0 = d0[m] + gg[bj_][0] * acc[ai_][bj_][m0_ + m][0], o1 = d1[m] + gg[bj_][1] * acc[ai_][bj_][m0_ + m][1]; \
            *(u32x4*)(H + (size_t)(rt0 + rl0 + ai_ * 128 + (m0_ + m) * 16) * D + cb + bj_ * 128) = (u32x4){pk2(o0[0], o0[1]), pk2(o0[2], o0[3]), pk2(o1[0], o1[1]), pk2(o1[2], o1[3])}; } } while (0)
        ER_LOAD(0, hA0, hA1);
        ER_LOAD(1, hB0, hB1); ER_STORE(0, hA0, hA1);
        ER_LOAD(2, hA0, hA1); ER_STORE(1, hB0, hB1);
        ER_LOAD(3, hB0, hB1); ER_STORE(2, hA0, hA1);
        ER_LOAD(4, hA0, hA1); ER_STORE(3, hB0, hB1);
        ER_LOAD(5, hB0, hB1); ER_STORE(4, hA0, hA1);
        ER_LOAD(6, hA0, hA1); ER_STORE(5, hB0, hB1);
        ER_LOAD(7, hB0, hB1); ER_STORE(6, hA0, hA1);
        ER_STORE(7, hB0, hB1);
#undef ER_LOAD
#undef ER_STORE
    }
};

struct TrItem { const float* src; bf16_t* dst; int N; };
__device__ __forceinline__ void tr_load(const TrItem& t, f32x4 (&v)[16], int lane) {
    const float* p = t.src + (size_t)(2 * (lane >> 4)) * t.N + 4 * (lane & 15);
#pragma unroll
    for (int i = 0; i < 8; ++i) { v[2 * i] = *(const f32x4*)(p + (size_t)(8 * i) * t.N); v[2 * i + 1] = *(const f32x4*)(p + (size_t)(8 * i + 1) * t.N); }
}
__device__ __forceinline__ void tr_finish(const TrItem& t, const f32x4 (&v)[16], LAS unsigned* scr, int lane) {
#pragma unroll
    for (int i = 0; i < 8; ++i) {
        const int kp = 4 * i + (lane >> 4); LAS unsigned* s = scr + kp * 65 + 4 * (lane & 15);
        s[0] = cvt_pk_bf16(v[2 * i][0], v[2 * i + 1][0]); s[1] = cvt_pk_bf16(v[2 * i][1], v[2 * i + 1][1]); s[2] = cvt_pk_bf16(v[2 * i][2], v[2 * i + 1][2]); s[3] = cvt_pk_bf16(v[2 * i][3], v[2 * i + 1][3]);
    }
    LDS_WAIT();
    const int c = lane & 7;
#pragma unroll
    for (int j = 0; j < 8; ++j) {
        const int n = (lane >> 3) + 8 * j; const LAS unsigned* s = scr + (4 * c) * 65 + n;
        *(u32x4*)(t.dst + (size_t)n * 1024 + 8 * c) = (u32x4){s[0], s[65], s[130], s[195]};
    }
    LDS_WAIT();
}
__device__ __forceinline__ int ilv_row(int c) { const int bj = c >> 10, r = c & 1023; return (r >> 7) * 256 + bj * 128 + (r & 127); }

__device__ __forceinline__ TrItem moe_item(const Args& a, int r, int layer) {
    TrItem t;
    if (r < 32 * 512) { const int mat = layer * 32 + (r >> 9), sub = r & 511, kb = sub >> 5, nb = sub & 31;
        t.src = a.in[I_W1] + (size_t)mat * 1024 * 2048 + (size_t)(kb * 64) * 2048 + nb * 64; t.dst = (bf16_t*)(a.ws + WS_W1) + (size_t)mat * 2048 * 1024 + (size_t)ilv_row(nb * 64) * 1024 + kb * 64; t.N = 2048; }
    else { r -= 32 * 512; const int mat = layer * 32 + (r >> 8), sub = r & 255, kb = sub >> 4, nb = sub & 15;
        t.src = a.in[I_W2] + (size_t)mat * 1024 * 1024 + (size_t)(kb * 64) * 1024 + nb * 64; t.dst = (bf16_t*)(a.ws + WS_W2) + (size_t)mat * 1024 * 1024 + (size_t)(nb * 64) * 1024 + kb * 64; t.N = 1024; }
    return t;
}
constexpr int P0_NWIN = 16 * 80, P0_NWOUT = 16 * 16, P0_NWGLU = 16 * 32, P0_NITEMS = P0_NWIN + P0_NWOUT + P0_NWGLU + 32 * 512 + 32 * 256;
__device__ __forceinline__ TrItem p0_item(const Args& a, int r) {
    TrItem t;
    if (r < P0_NWIN) { const int kb = r / 80, nb = r % 80; t.src = a.in[I_HGWIN] + (size_t)(kb * 64) * 5120 + nb * 64; t.dst = (bf16_t*)(a.ws + WS_WIN) + (size_t)(nb * 64) * 1024 + kb * 64; t.N = 5120; return t; } r -= P0_NWIN;
    if (r < P0_NWOUT) { const int kb = r / 16, nb = r % 16; t.src = a.in[I_HGWOUT] + (size_t)(kb * 64) * 1024 + nb * 64; t.dst = (bf16_t*)(a.ws + WS_WOUT) + (size_t)(nb * 64) * 1024 + kb * 64; t.N = 1024; return t; } r -= P0_NWOUT;
    if (r < P0_NWGLU) { const int kb = r / 32, nb = r % 32; t.src = a.in[I_S5WGLU] + (size_t)(kb * 64) * 2048 + nb * 64; t.dst = (bf16_t*)(a.ws + WS_WGLU) + (size_t)ilv_row(nb * 64) * 1024 + kb * 64; t.N = 2048; return t; } r -= P0_NWGLU;
    return moe_item(a, r, 0);
}
#define TR_LOOP(first, stride, count, ITEM) do { int _it = (first); if (_it < (count)) { f32x4 _va[16], _vb[16]; TrItem _A = ITEM(_it), _B = _A; tr_load(_A, _va, lane); \
        for (;;) { const int _i2 = _it + (stride); const bool _h2 = _i2 < (count); if (_h2) { _B = ITEM(_i2); tr_load(_B, _vb, lane); } tr_finish(_A, _va, scr, lane); if (!_h2) break; \
                   _it = _i2 + (stride); const bool _h1 = _it < (count); if (_h1) { _A = ITEM(_it); tr_load(_A, _va, lane); } tr_finish(_B, _vb, scr, lane); if (!_h1) break; } } } while (0)
__device__ __forceinline__ void p0_phase(const Args& a, LAS unsigned char* lds, int tid, int gw, int NGW) {
    const int lane = tid & 63, wave = tid >> 6;
    unsigned char* ws = a.ws;
    float* modv = (float*)(ws + WS_MODV);
    if (blockIdx.x < 192) {
        LAS float* SC = (LAS float*)lds;
        LAS float* PART = (LAS float*)(lds + 40960);
        for (int i = tid; i < 9 * 1024; i += NTHREADS) { const int r = i >> 10, k = i & 1023; const float v = r < 8 ? a.in[I_C][r * 1024 + k] : a.in[I_CCTX][k]; SC[i] = silu_f(v); }
        __syncthreads();
        const int layer = blockIdx.x / 96, ng = blockIdx.x % 96;
        const float* W = a.in[I_MODW] + (size_t)layer * 1024 * 6144 + ng * 64 + lane;
        float acc[9];
#pragma unroll
        for (int r = 0; r < 9; ++r) acc[r] = 0.f;
#pragma unroll 8
        for (int kk = 0; kk < 128; ++kk) {
            const int k = wave * 128 + kk; const float w = W[(size_t)k * 6144];
#pragma unroll
            for (int r = 0; r < 9; ++r) acc[r] += SC[r * 1024 + k] * w;
        }
#pragma unroll
        for (int r = 0; r < 9; ++r) PART[(wave * 9 + r) * 64 + lane] = acc[r];
        __syncthreads();
        for (int i = tid; i < 9 * 64; i += NTHREADS) {
            const int r = i >> 6, l = i & 63; float s = a.in[I_MODB][layer * 6144 + ng * 64 + l];
#pragma unroll
            for (int w = 0; w < 8; ++w) s += PART[(w * 9 + r) * 64 + l];
            modv[(size_t)(layer * 9 + r) * 6144 + ng * 64 + l] = s;
        }
        __syncthreads();
    } else if (blockIdx.x == 192) {
        float* lbv = (float*)(ws + WS_LBV);
        for (int i = tid; i < 2048; i += NTHREADS) { const float l0 = a.in[I_HGLB][i], l1 = a.in[I_HGLB][2048 + i]; lbv[i] = 1.0f / (1.0f + __expf(l1 - l0)); }
    }
    LAS unsigned* scr = (LAS unsigned*)(lds + 59392 + wave * 8320);
#define P0_ITEM(i) p0_item(a, (i))
    const int nfast = ((int)gridDim.x > 192) ? ((int)gridDim.x - 192) * 8 : 0, nextra = nfast * 3, n1 = P0_NITEMS - nextra;
    TR_LOOP(gw, NGW, n1, P0_ITEM);
    if (blockIdx.x >= 192) { TR_LOOP(n1 + (gw - 192 * 8), nfast, P0_NITEMS, P0_ITEM); }
#undef P0_ITEM
}

__device__ __forceinline__ const float* hin_row(const Args& a, int row) { return row < NCTX ? a.in[I_CTX] + (size_t)row * D : a.in[I_X] + (size_t)(row - NCTX) * D; }
__device__ __forceinline__ int mod_row(int row) { return row < NCTX ? 8 : ((row - NCTX) >> 12); }
__device__ __forceinline__ float row_rstd(const f32x4 (&v)[4]) {
    float s = 0.f;
#pragma unroll
    for (int j = 0; j < 4; ++j) s += (v[j][0] * v[j][0] + v[j][1] * v[j][1]) + (v[j][2] * v[j][2] + v[j][3] * v[j][3]);
    return 1.0f / sqrtf(wave_sum(s) * (1.0f / D) + EPS);
}
struct ModVec { f32x4 g[4], sc[4], sh[4]; };
__device__ __forceinline__ void modvec_load(ModVec& m, const float* g, const float* sc, const float* sh, int lane) {
#pragma unroll
    for (int j = 0; j < 4; ++j) { const int c = 4 * lane + 256 * j; m.g[j] = *(const f32x4*)(g + c); m.sc[j] = *(const f32x4*)(sc + c); m.sh[j] = *(const f32x4*)(sh + c); }
}
__device__ __forceinline__ void norm_mod_store(const f32x4 (&v)[4], float rstd, const ModVec& m, bf16_t* orow, int lane) {
#pragma unroll
    for (int j = 0; j < 4; ++j) st_bf16x4(orow + 4 * lane + 256 * j, v[j] * rstd * m.g[j] * (m.sc[j] + 1.0f) + m.sh[j]);
}

__device__ __forceinline__ void p1_phase(const Args& a, int lane, int gw, int NGW) {
    const float* modv = (const float*)(a.ws + WS_MODV);
    bf16_t* A = (bf16_t*)(a.ws + WS_A);
    for (int row0 = gw * 4; row0 < NTOK; row0 += NGW * 4) {
        f32x4 v[4][4];
#pragma unroll
        for (int r = 0; r < 4; ++r) { const float* hr = hin_row(a, row0 + r);
#pragma unroll
            for (int j = 0; j < 4; ++j) v[r][j] = *(const f32x4*)(hr + 4 * lane + 256 * j); }
        const float* mv = modv + (size_t)mod_row(row0) * 6144;
        ModVec m; modvec_load(m, a.in[I_N1G], mv + 1024, mv, lane);
#pragma unroll
        for (int r = 0; r < 4; ++r) { const float rstd = row_rstd(v[r]); norm_mod_store(v[r], rstd, m, A + (size_t)(row0 + r) * D, lane); }
    }
}

__device__ __forceinline__ int gla_row(int n, int t, int b, int dir) {
    const bool isctx = n < 4; const int cn = isctx ? n : n - 4, slen = isctx ? CTXL : SEQ, rbase = isctx ? b * CTXL : NCTX + b * SEQ;
    const int pos = cn * 64 + t; return rbase + (dir ? slen - 1 - pos : pos);
}
__device__ __forceinline__ void gla_phase(const Args& a, LAS unsigned char* lds, int tid) {
    const int lane = tid & 63, wave = tid >> 6, fr = lane & 15, fq = lane >> 4;
    LAS unsigned char* QS = lds;
    LAS unsigned char* KS = lds + 17408;
    LAS unsigned char* QIN = lds + 34816;
    LAS unsigned char* KOT = lds + 52224;
    LAS unsigned char* VT = lds + 70656;
    LAS unsigned char* ST0 = lds + 79872;
    LAS unsigned char* PPW = lds + 114688 + wave * 2304;
    LAS float* GT0 = (LAS float*)(lds + 133120);
    LAS float* BL = (LAS float*)(lds + 141312);
    const bf16_t* Qg = (const bf16_t*)(a.ws + WS_Q); const bf16_t* Vg = (const bf16_t*)(a.ws + WS_V);
    for (int item = blockIdx.x; item < 256; item += gridDim.x) {
        const int vs = item & 1, dir = (item >> 1) & 1, h = (item >> 2) & 7, b = item >> 5;
        const _Float16* LF = (const _Float16*)(a.ws + (dir ? WS_LFB : WS_LFF)); bf16_t* Og = (bf16_t*)(a.ws + (dir ? WS_OB : WS_OF));
        f32x4 Sacc[4];
#pragma unroll
        for (int i = 0; i < 4; ++i) Sacc[i] = (f32x4){0.f, 0.f, 0.f, 0.f};
        for (int i = tid; i < 2 * 17408 / 4; i += NTHREADS) ((LAS unsigned*)ST0)[i] = 0u;
        const int kc2 = (tid & 63) * 2, tg = tid >> 6, chq = h * 128 + kc2;
        const int vt_t = tid & 63, vt_v8 = (tid >> 6) * 8;
        unsigned lf2[8], q2[8]; u32x4 vv;
#define GLA_LOAD(n_) do { const unsigned o0_ = (unsigned)(gla_row(n_, tg * 8, b, dir) * D + chq) * 2u; const unsigned os_ = dir ? (unsigned)(-2 * D) : (unsigned)(2 * D); \
            _Pragma("unroll") for (int i = 0; i < 8; ++i) { const unsigned o = o0_ + (unsigned)i * os_; lf2[i] = *(const unsigned*)((const char*)LF + o); q2[i] = *(const unsigned*)((const char*)Qg + o); } \
            vv = *(const u32x4*)((const char*)Vg + (unsigned)(gla_row(n_, vt_t, b, dir) * D + h * 128 + vs * 64 + vt_v8) * 2u); } while (0)
        float fa[8], fb[8], bca[8], bcb[8];
#define GLA_CUMSUM(par_) do { float csa = 0.f, csb = 0.f; _Pragma("unroll") for (int i = 0; i < 8; ++i) { typedef _Float16 h2 __attribute__((ext_vector_type(2))); const h2 hv = __builtin_bit_cast(h2, lf2[i]); \
            const float la = (float)hv[0], lb_ = (float)hv[1]; fa[i] = __expf(la); fb[i] = __expf(lb_); csa += la; csb += lb_; bca[i] = csa; bcb[i] = csb; } \
            *(LAS f32x2*)(GT0 + (par_) * 1024 + tg * 128 + kc2) = (f32x2){csa, csb}; } while (0)
        GLA_LOAD(0);
        GLA_CUMSUM(0);
        __syncthreads();
        for (int n = 0; n < 68; ++n) {
            const int par = n & 1;
            LAS unsigned char* STc = ST0 + par * 17408; LAS unsigned char* STn = ST0 + (par ^ 1) * 17408;
            { const unsigned w[4] = {vv.x, vv.y, vv.z, vv.w};
#pragma unroll
              for (int i = 0; i < 4; ++i) { *(LAS bf16_t*)(VT + (vt_v8 + 2 * i) * 144 + vt_t * 2) = (bf16_t)(w[i] & 0xffffu); *(LAS bf16_t*)(VT + (vt_v8 + 2 * i + 1) * 144 + vt_t * 2) = (bf16_t)(w[i] >> 16); } }
#define GLA_OSTORE(n_) do { const u32x4 od = *(const LAS u32x4*)(PPW + (lane >> 2) * 144 + (lane & 3) * 16); \
                *(u32x4*)(Og + (size_t)gla_row(n_, (wave >> 1) * 16 + (lane >> 2), b, dir) * D + h * 128 + vs * 64 + (wave & 1) * 32 + (lane & 3) * 8) = od; } while (0)
            if (n > 0) GLA_OSTORE(n - 1);
            f32x2 pre = (f32x2){0.f, 0.f}, bref = (f32x2){0.f, 0.f}, blast = (f32x2){0.f, 0.f};
#pragma unroll
            for (int g8 = 0; g8 < 8; ++g8) { const f32x2 gv = *(const LAS f32x2*)(GT0 + par * 1024 + g8 * 128 + kc2); if (g8 < tg) pre += gv; if (g8 < 4) bref += gv; blast += gv; }
            const float era = __expf(bref.x), erb = __expf(bref.y), ela = __expf(blast.x - bref.x), elb = __expf(blast.y - bref.y);
            float e1a = __expf(pre.x - bref.x), e1b = __expf(pre.y - bref.y);
            unsigned kota[4], kotb[4];
#pragma unroll
            for (int i = 0; i < 8; ++i) {
                const int t = tg * 8 + i;
                const float qa = bflo(q2[i]), qb = bfhi(q2[i]);
                e1a *= fa[i]; e1b *= fb[i];
                const float ka = 1.0f - fa[i], kb = 1.0f - fb[i];
                const float e2a = __builtin_amdgcn_rcpf(e1a), e2b = __builtin_amdgcn_rcpf(e1b);
                const float qsa = qa * e1a, qsb = qb * e1b, ksa = ka * e2a, ksb = kb * e2b;
                *(LAS unsigned*)(QS + t * 272 + kc2 * 2) = cvt_pk_bf16(qsa, qsb);
                *(LAS unsigned*)(KS + t * 272 + kc2 * 2) = cvt_pk_bf16(ksa, ksb);
                *(LAS unsigned*)(QIN + t * 272 + kc2 * 2) = cvt_pk_bf16(qsa * era, qsb * erb);
                const unsigned ko = cvt_pk_bf16(ksa * ela, ksb * elb);
                if (i & 1) { kota[i >> 1] |= ko << 16; kotb[i >> 1] |= ko & 0xffff0000u; } else { kota[i >> 1] = ko & 0xffffu; kotb[i >> 1] = ko >> 16; }
            }
            { const int rot = ((kc2 >> 4) + tg) & 7;
              *(LAS u32x4*)(KOT + kc2 * 144 + rot * 16) = (u32x4){kota[0], kota[1], kota[2], kota[3]};
              *(LAS u32x4*)(KOT + (kc2 + 1) * 144 + rot * 16) = (u32x4){kotb[0], kotb[1], kotb[2], kotb[3]}; }
            if (tg == 0) *(LAS f32x2*)(BL + kc2) = (f32x2){__expf(blast.x), __expf(blast.y)};
            if (n + 1 < 68) GLA_LOAD(n + 1);
            __syncthreads();
            const int tt = wave >> 1;
            bf16x8 aq[4];
#pragma unroll
            for (int kk = 0; kk < 4; ++kk) aq[kk] = *(const LAS bf16x8*)(QS + (tt * 16 + fr) * 272 + (kk * 32 + fq * 8) * 2);
#pragma unroll
            for (int st = 0; st < 4; ++st) {
                f32x4 acc = (f32x4){0.f, 0.f, 0.f, 0.f};
                if (st <= tt) {
#pragma unroll
                    for (int kk = 0; kk < 4; ++kk) {
                        const bf16x8 bv = *(const LAS bf16x8*)(KS + (st * 16 + fr) * 272 + (kk * 32 + fq * 8) * 2);
                        acc = __builtin_amdgcn_mfma_f32_16x16x32_bf16(aq[kk], bv, acc, 0, 0, 0);
                    }
                }
#pragma unroll
                for (int j = 0; j < 4; ++j) { const int tl = fq * 4 + j, s = st * 16 + fr; *(LAS bf16_t*)(PPW + tl * 144 + s * 2) = (bf16_t)f2bf(s <= tt * 16 + tl ? acc[j] : 0.f); }
            }
            LDS_WAIT();
            unsigned ow[2][2];
            bf16x8 ap[2], ai[4];
#pragma unroll
            for (int kk = 0; kk < 2; ++kk) ap[kk] = *(const LAS bf16x8*)(PPW + fr * 144 + (kk * 32 + fq * 8) * 2);
#pragma unroll
            for (int kk = 0; kk < 4; ++kk) ai[kk] = *(const LAS bf16x8*)(QIN + (tt * 16 + fr) * 272 + (kk * 32 + fq * 8) * 2);
#pragma unroll
            for (int vti = 0; vti < 2; ++vti) {
                const int vt = 2 * (wave & 1) + vti; f32x4 acc = (f32x4){0.f, 0.f, 0.f, 0.f};
#pragma unroll
                for (int kk = 0; kk < 2; ++kk) {
                    const bf16x8 bv = *(const LAS bf16x8*)(VT + (vt * 16 + fr) * 144 + (kk * 32 + fq * 8) * 2);
                    acc = __builtin_amdgcn_mfma_f32_16x16x32_bf16(ap[kk], bv, acc, 0, 0, 0);
                }
#pragma unroll
                for (int kk = 0; kk < 4; ++kk) {
                    const bf16x8 bv = *(const LAS bf16x8*)(STc + (vt * 16 + fr) * 272 + (kk * 32 + fq * 8) * 2);
                    acc = __builtin_amdgcn_mfma_f32_16x16x32_bf16(ai[kk], bv, acc, 0, 0, 0);
                }
                ow[vti][0] = cvt_pk_bf16(acc[0], acc[1]); ow[vti][1] = cvt_pk_bf16(acc[2], acc[3]);
            }
#pragma unroll
            for (int vti = 0; vti < 2; ++vti)
#pragma unroll
                for (int j = 0; j < 4; ++j) { const unsigned w = ow[vti][j >> 1]; *(LAS bf16_t*)(PPW + (fq * 4 + j) * 144 + (vti * 16 + fr) * 2) = (bf16_t)((j & 1) ? (w >> 16) : (w & 0xffffu)); }
            bf16x8 ak[2]; const f32x4 blv = *(const LAS f32x4*)(BL + wave * 16 + fq * 4);
#pragma unroll
            for (int kk = 0; kk < 2; ++kk) ak[kk] = *(const LAS bf16x8*)(KOT + (wave * 16 + fr) * 144 + (((kk * 4 + fq) + wave) & 7) * 16);
#pragma unroll
            for (int vt = 0; vt < 4; ++vt) {
                Sacc[vt] *= blv;
#pragma unroll
                for (int kk = 0; kk < 2; ++kk) {
                    const bf16x8 bv = *(const LAS bf16x8*)(VT + (vt * 16 + fr) * 144 + (kk * 32 + fq * 8) * 2);
                    Sacc[vt] = __builtin_amdgcn_mfma_f32_16x16x32_bf16(ak[kk], bv, Sacc[vt], 0, 0, 0);
                }
                *(LAS u32x2*)(STn + (vt * 16 + fr) * 272 + (wave * 16 + fq * 4) * 2) = (u32x2){pk2(Sacc[vt][0], Sacc[vt][1]), pk2(Sacc[vt][2], Sacc[vt][3])};
            }
            if (n + 1 < 68) GLA_CUMSUM(par ^ 1);
            __syncthreads();
        }
        GLA_OSTORE(67);
    }
}
#undef GLA_OSTORE
#undef GLA_CUMSUM
#undef GLA_LOAD
__device__ __forceinline__ void gla_readout_phase(const Args& a, int lane, int gw, int NGW) {
    const bf16_t* OF = (const bf16_t*)(a.ws + WS_OF); const bf16_t* OB = (const bf16_t*)(a.ws + WS_OB);
    const bf16_t* G = (const bf16_t*)(a.ws + WS_G); bf16_t* OG = (bf16_t*)(a.ws + WS_OG);
    f32x4 ng[4];
#pragma unroll
    for (int j = 0; j < 4; ++j) ng[j] = *(const f32x4*)(a.in[I_HGNG] + 16 * lane + 4 * j);
    for (int row0 = gw * 4; row0 < NTOK; row0 += NGW * 4) {
        u32x4 of[4][2], ob[4][2], gg[4][2];
#pragma unroll
        for (int r = 0; r < 4; ++r) { const size_t o = (size_t)(row0 + r) * D + 16 * lane;
            of[r][0] = *(const u32x4*)(OF + o); of[r][1] = *(const u32x4*)(OF + o + 8); ob[r][0] = *(const u32x4*)(OB + o); ob[r][1] = *(const u32x4*)(OB + o + 8);
            gg[r][0] = *(const u32x4*)(G + o); gg[r][1] = *(const u32x4*)(G + o + 8); }
#pragma unroll
        for (int r = 0; r < 4; ++r) {
            float v[16]; float s = 0.f;
#pragma unroll
            for (int q = 0; q < 8; ++q) { const unsigned wf = of[r][q >> 2][q & 3], wb = ob[r][q >> 2][q & 3]; v[2 * q] = bflo(wf) + bflo(wb); v[2 * q + 1] = bfhi(wf) + bfhi(wb); s += v[2 * q] * v[2 * q] + v[2 * q + 1] * v[2 * q + 1]; }
            s += __shfl_xor(s, 1); s += __shfl_xor(s, 2); s += __shfl_xor(s, 4);
            const float rstd = 1.0f / sqrtf(s * (1.0f / 128.0f) + EPS);
            unsigned ow[8];
#pragma unroll
            for (int q = 0; q < 8; ++q) { const unsigned wg = gg[r][q >> 2][q & 3];
                ow[q] = pk2(v[2 * q] * rstd * ng[q >> 1][(2 * q) & 3] * silu_f(bflo(wg)), v[2 * q + 1] * rstd * ng[q >> 1][(2 * q + 1) & 3] * silu_f(bfhi(wg))); }
            const size_t o = (size_t)(row0 + r) * D + 16 * lane;
            *(u32x4*)(OG + o) = (u32x4){ow[0], ow[1], ow[2], ow[3]}; *(u32x4*)(OG + o + 8) = (u32x4){ow[4], ow[5], ow[6], ow[7]};
        }
    }
}

struct EpiMoe1 {
    static constexpr bool PERM = true;
    const float* b1; bf16_t* ACT;
    __device__ __forceinline__ void operator()(const f32x4 (&acc)[2][2][4][2], const Unit& u, int wr, int wc, int fr, int fq) const {
        const int e = u.pn >> 3, pnl = u.pn & 7, cb = pnl * 128 + wc * 32 + 8 * fq, row0 = u.pm * 256 + wr * 64 + fr;
        const float* bg = b1 + (size_t)e * 2048;
        f32x4 bg0 = *(const f32x4*)(bg + cb), bg1 = *(const f32x4*)(bg + cb + 4), bl0 = *(const f32x4*)(bg + 1024 + cb), bl1 = *(const f32x4*)(bg + 1024 + cb + 4);
        pin(bg0); pin(bg1); pin(bl0); pin(bl1);
#pragma unroll
        for (int ai = 0; ai < 2; ++ai)
#pragma unroll
            for (int m = 0; m < 4; ++m) {
                f32x4 o[2];
#pragma unroll
                for (int n = 0; n < 2; ++n) {
                    const f32x4 zg = acc[ai][0][m][n] + (n ? bg1 : bg0), zl = acc[ai][1][m][n] + (n ? bl1 : bl0);
#pragma unroll
                    for (int j = 0; j < 4; ++j) { const float g_ = fminf(zg[j], 7.0f), l_ = fminf(fmaxf(zl[j], -7.0f), 7.0f); o[n][j] = g_ * sigmoid_f(1.702f * g_) * (l_ + 1.0f); }
                }
                *(u32x4*)(ACT + (size_t)(row0 + ai * 128 + m * 16) * D + cb) = (u32x4){pk2(o[0][0], o[0][1]), pk2(o[0][2], o[0][3]), pk2(o[1][0], o[1][1]), pk2(o[1][2], o[1][3])};
            }
    }
};
struct EpiMoe2 {
    static constexpr bool PERM = true;
    const float* b2; bf16_t* YS;
    __device__ __forceinline__ void operator()(const f32x4 (&acc)[2][2][4][2], const Unit& u, int wr, int wc, int fr, int fq) const {
        const int e = u.pn >> 2, pnl = u.pn & 3, cb = pnl * 256 + wc * 32 + 8 * fq, row0 = u.pm * 256 + wr * 64 + fr;
        const float* bb = b2 + (size_t)e * 1024;
        f32x4 bvv[2][2];
#pragma unroll
        for (int bj = 0; bj < 2; ++bj) { bvv[bj][0] = *(const f32x4*)(bb + cb + bj * 128); bvv[bj][1] = *(const f32x4*)(bb + cb + bj * 128 + 4); }
#pragma unroll
        for (int bj = 0; bj < 2; ++bj) { pin(bvv[bj][0]); pin(bvv[bj][1]); }
#pragma unroll
        for (int bj = 0; bj < 2; ++bj) {
            const int c = cb + bj * 128; const f32x4 bv0 = bvv[bj][0], bv1 = bvv[bj][1];
#pragma unroll
            for (int ai = 0; ai < 2; ++ai)
#pragma unroll
                for (int m = 0; m < 4; ++m) {
                    const f32x4 v0 = acc[ai][bj][m][0] + bv0, v1 = acc[ai][bj][m][1] + bv1;
                    *(u32x4*)(YS + (size_t)(row0 + ai * 128 + m * 16) * D + c) = (u32x4){pk2(v0[0], v0[1]), pk2(v0[2], v0[3]), pk2(v1[0], v1[1]), pk2(v1[2], v1[3])};
                }
        }
    }
};

__device__ __forceinline__ void router_phase(const Args& a, LAS unsigned char* lds, int layer, int row_lo, int tid) {
    const int lane = tid & 63, wave = tid >> 6, fr = lane & 15, fq = lane >> 4;
    const bf16_t* H = (const bf16_t*)(a.ws + WS_H); bf16_t* F = (bf16_t*)(a.ws + WS_F);
    const float* modv = (const float*)(a.ws + WS_MODV) + (size_t)layer * 9 * 6144;
    int* TOKE = (int*)(a.ws + WS_TOKE); float* TOKW = (float*)(a.ws + WS_TOKW);
    unsigned* cntb = (unsigned*)(a.ws + WS_CTL) + CW_CNTB + layer * 8192;
    LAS unsigned char* FH = lds;
    LAS unsigned char* FL = lds + 16 * 2064;
    LAS float* PART = (LAS float*)(lds + 2 * 16 * 2064);
    LAS int* hist = (LAS int*)(lds + 2 * 16 * 2064 + 16384);
    if (tid < 32) hist[tid] = 0;
    const float* n2g = a.in[I_N2G] + layer * D; const float* rw = a.in[I_RW] + (size_t)layer * D * NE; const float* rb = a.in[I_RB] + layer * NE;
    const float* rwp = rw + (size_t)(wave * 128 + fq * 8) * NE + fr;
    bf16x8 rwH[2][4], rwL[2][4];
#pragma unroll
    for (int kk = 0; kk < 4; ++kk) {
#pragma unroll
        for (int et = 0; et < 2; ++et)
#pragma unroll
            for (int j = 0; j < 8; ++j) {
                const float w = rwp[kk * 32 * NE + j * NE + et * 16];
                const unsigned h = f2bf(w); const float lo = w - bf2f((unsigned short)h);
                rwH[et][kk][j] = (short)h; rwL[et][kk][j] = (short)f2bf(lo);
            }
        asm volatile("" ::: "memory");
    }
    const int ngroups = (NTOK - row_lo) >> 4;
    u32x2 vvp[2][4]; f32x4 gvv[4], scvv[4], shvv[4];
#pragma unroll
    for (int j = 0; j < 4; ++j) gvv[j] = *(const f32x4*)(n2g + 4 * lane + 256 * j);
#define RT_LOAD(gi_) do { _Pragma("unroll") for (int rr = 0; rr < 2; ++rr) _Pragma("unroll") for (int j = 0; j < 4; ++j) \
        vvp[rr][j] = *(const u32x2*)(H + (size_t)(row_lo + (gi_) * 16 + 2 * wave + rr) * D + 4 * lane + 256 * j); \
        { const float* mvp_ = modv + (size_t)mod_row(row_lo + (gi_) * 16) * 6144; _Pragma("unroll") for (int j = 0; j < 4; ++j) { scvv[j] = *(const f32x4*)(mvp_ + 4096 + 4 * lane + 256 * j); shvv[j] = *(const f32x4*)(mvp_ + 3072 + 4 * lane + 256 * j); } } } while (0)
    if ((int)blockIdx.x < ngroups) RT_LOAD(blockIdx.x);
    int pend_i = 0; float pend_w = 0.f; long pend_o = -1;
    for (int gi = blockIdx.x; gi < ngroups; gi += gridDim.x) {
        const int row0 = row_lo + gi * 16;
        __syncthreads();
#pragma unroll
        for (int rr = 0; rr < 2; ++rr) {
            const int rl = 2 * wave + rr, row = row0 + rl; f32x4 v[4];
#pragma unroll
            for (int j = 0; j < 4; ++j) { const u32x2 w = vvp[rr][j]; v[j] = (f32x4){bflo(w.x), bfhi(w.x), bflo(w.y), bfhi(w.y)}; }
            const float rstd = row_rstd(v);
#pragma unroll
            for (int j = 0; j < 4; ++j) {
                const int c = 4 * lane + 256 * j;
                const f32x4 f = v[j] * rstd * gvv[j] * (scvv[j] + 1.0f) + shvv[j];
                st_bf16x4(F + (size_t)row * D + c, f);
                { const unsigned h01 = cvt_pk_bf16(f[0], f[1]), h23 = cvt_pk_bf16(f[2], f[3]);
                  *(LAS u32x2*)(FH + rl * 2064 + c * 2) = (u32x2){h01, h23};
                  *(LAS u32x2*)(FL + rl * 2064 + c * 2) = (u32x2){cvt_pk_bf16(f[0] - bflo(h01), f[1] - bfhi(h01)), cvt_pk_bf16(f[2] - bflo(h23), f[3] - bfhi(h23))}; }
            }
        }
        if (pend_o >= 0) { TOKE[pend_o] = pend_i; TOKW[pend_o] = pend_w; pend_o = -1; }
        if (gi + (int)gridDim.x < ngroups) RT_LOAD(gi + gridDim.x);
        __syncthreads();
        f32x4 acc0 = (f32x4){0.f, 0.f, 0.f, 0.f}, acc1 = (f32x4){0.f, 0.f, 0.f, 0.f};
        bf16x8 aH[4], aL[4];
#pragma unroll
        for (int kk = 0; kk < 4; ++kk) { aH[kk] = *(const LAS bf16x8*)(FH + fr * 2064 + (wave * 128 + kk * 32 + fq * 8) * 2); aL[kk] = *(const LAS bf16x8*)(FL + fr * 2064 + (wave * 128 + kk * 32 + fq * 8) * 2); }
#pragma unroll
        for (int kk = 0; kk < 4; ++kk) {
            acc0 = __builtin_amdgcn_mfma_f32_16x16x32_bf16(aL[kk], rwH[0][kk], acc0, 0, 0, 0); acc1 = __builtin_amdgcn_mfma_f32_16x16x32_bf16(aL[kk], rwH[1][kk], acc1, 0, 0, 0);
            acc0 = __builtin_amdgcn_mfma_f32_16x16x32_bf16(aH[kk], rwL[0][kk], acc0, 0, 0, 0); acc1 = __builtin_amdgcn_mfma_f32_16x16x32_bf16(aH[kk], rwL[1][kk], acc1, 0, 0, 0);
            acc0 = __builtin_amdgcn_mfma_f32_16x16x32_bf16(aH[kk], rwH[0][kk], acc0, 0, 0, 0); acc1 = __builtin_amdgcn_mfma_f32_16x16x32_bf16(aH[kk], rwH[1][kk], acc1, 0, 0, 0);
        }
#pragma unroll
        for (int j = 0; j < 4; ++j) { PART[(wave * 16 + fq * 4 + j) * 32 + fr] = acc0[j]; PART[(wave * 16 + fq * 4 + j) * 32 + 16 + fr] = acc1[j]; }
        __syncthreads();
        {
            const int half = lane >> 5, e = lane & 31, rl = 2 * wave + half, row = row0 + rl;
            float lg = rb[e];
#pragma unroll
            for (int w = 0; w < 8; ++w) lg += PART[(w * 16 + rl) * 32 + e];
            float sv[4]; int si[4];
#pragma unroll
            for (int r = 0; r < 4; ++r) {
                float m = lg;
#pragma unroll
                for (int o = 1; o < 32; o <<= 1) m = fmaxf(m, __shfl_xor(m, o));
                const unsigned long long bal = __ballot(lg == m); const unsigned mine = (unsigned)(bal >> (32 * half));
                const int idx = __ffs((int)mine) - 1;
                sv[r] = m; si[r] = idx; if (e == idx) lg = -3.0e38f;
            }
            const float e1 = __expf(sv[1] - sv[0]), e2 = __expf(sv[2] - sv[0]), e3 = __expf(sv[3] - sv[0]); const float inv = 1.0f / (1.0f + e1 + e2 + e3);
            if (e < 4) {
                const int myi = e == 0 ? si[0] : (e == 1 ? si[1] : (e == 2 ? si[2] : si[3]));
                const float myw = (e == 0 ? 1.0f : (e == 1 ? e1 : (e == 2 ? e2 : e3))) * inv;
                pend_i = myi; pend_w = myw; pend_o = (long)row * 4 + e;
                atomicAdd((int*)hist + myi, 1);
            }
        }
    }
    if (pend_o >= 0) { TOKE[pend_o] = pend_i; TOKW[pend_o] = pend_w; }
    __syncthreads();
    if (tid < 32) cntb[(size_t)blockIdx.x * 32 + tid] = (unsigned)hist[tid];
}
#undef RT_LOAD
__device__ __forceinline__ void assign_phase(const Args& a, LAS unsigned char* lds, int layer, int row_lo, int tid) {
    const int lane = tid & 63, wave = tid >> 6;
    const unsigned* cntb = (const unsigned*)(a.ws + WS_CTL) + CW_CNTB + layer * 8192; unsigned* gcnt = (unsigned*)(a.ws + WS_CTL) + CW_CNT + layer * 64;
    const bf16_t* F = (const bf16_t*)(a.ws + WS_F); bf16_t* AG = (bf16_t*)(a.ws + WS_AG);
    const int* TOKE = (const int*)(a.ws + WS_TOKE); int* TOKS = (int*)(a.ws + WS_TOKS);
    LAS int* off = (LAS int*)lds; LAS int* cnt = (LAS int*)(lds + 256); LAS int* base = (LAS int*)(lds + 512); LAS int* cur = (LAS int*)(lds + 768);
    LAS int* pa = (LAS int*)(lds + 1024); LAS int* pl = (LAS int*)(lds + 1024 + 2048);
    {
        const int e = tid & 31, part = tid >> 5; int s_all = 0, s_lt = 0;
        for (int bb = part; bb < (int)gridDim.x; bb += 16) { const int c = (int)cntb[(size_t)bb * 32 + e]; s_all += c; if (bb < (int)blockIdx.x) s_lt += c; }
        pa[part * 32 + e] = s_all; pl[part * 32 + e] = s_lt;
    }
    __syncthreads();
    if (tid < 32) { int s_all = 0, s_lt = 0; for (int p = 0; p < 16; ++p) { s_all += pa[p * 32 + tid]; s_lt += pl[p * 32 + tid]; } cnt[tid] = s_all; base[tid] = s_lt; cur[tid] = 0; if (blockIdx.x == 0) gcnt[tid] = (unsigned)s_all; }
    __syncthreads();
    if (tid == 0) { int o = 0; for (int e = 0; e < 32; ++e) { off[e] = o; o += ((cnt[e] + 255) >> 8) << 8; } }
    __syncthreads();
    if (tid < 32) base[tid] += off[tid];
    __syncthreads();
    const int gw = blockIdx.x * 8 + wave, NGW = gridDim.x * 8;
    int* SLOTTOK = (int*)(a.ws + WS_SLOTTOK);
    for (int idx = blockIdx.x * NTHREADS + tid; idx < 32 * 256; idx += gridDim.x * NTHREADS) {
        const int e = idx >> 8, c = cnt[e], r = c + (idx & 255), padded = ((c + 255) >> 8) << 8;
        if (r < padded) SLOTTOK[off[e] + r] = 0;
    }
    const int ngroups = (NTOK - row_lo) >> 4;
    for (int gi = blockIdx.x; gi < ngroups; gi += gridDim.x) {
        const int r0 = row_lo + gi * 16 + 2 * wave;
        if (lane < 8) { const int e = TOKE[(size_t)r0 * 4 + lane]; const int pos = atomicAdd((int*)cur + e, 1); const int slot = base[e] + pos; TOKS[(size_t)r0 * 4 + lane] = slot; SLOTTOK[slot] = r0 + (lane >> 2); }
    }
    (void)gw; (void)NGW; (void)F; (void)AG;
}
__device__ __forceinline__ int moe_tiles(const Args& a, LAS unsigned char* lds, int layer, int tid) {
    const unsigned* gcnt = (const unsigned*)(a.ws + WS_CTL) + CW_CNT + layer * 64;
    LAS int* tbl = (LAS int*)(lds + 131072 + 1024);
    if (tid == 0) { int t = 0; for (int e = 0; e < 32; ++e) { const int nt = ((int)gcnt[e] + 255) >> 8; for (int k = 0; k < nt; ++k) tbl[t++] = e; } tbl[1000] = t; }
    __syncthreads();
    return tbl[1000];
}
__device__ __forceinline__ void combine_phase(const Args& a, int layer, int row_lo, int lane, int gw, int NGW) {
    bf16_t* H = (bf16_t*)(a.ws + WS_H); const bf16_t* YS = (const bf16_t*)(a.ws + WS_YS);
    const int* TOKS = (const int*)(a.ws + WS_TOKS); const float* TOKW = (const float*)(a.ws + WS_TOKW);
    const float* modv = (const float*)(a.ws + WS_MODV);
    for (int row0 = row_lo + gw * 2; row0 < NTOK; row0 += NGW * 2) {
        const int mr = mod_row(row0);
        u32x4 sl[2]; f32x4 wv[2];
#pragma unroll
        for (int r = 0; r < 2; ++r) { sl[r] = *(const u32x4*)(TOKS + (size_t)(row0 + r) * 4); wv[r] = *(const f32x4*)(TOKW + (size_t)(row0 + r) * 4); }
        u32x2 ys[2][4][4]; f32x4 hv[2][4];
#pragma unroll
        for (int r = 0; r < 2; ++r)
#pragma unroll
            for (int j = 0; j < 4; ++j) {
                hv[r][j] = ld_bf16x4(H + (size_t)(row0 + r) * D + 4 * lane + 256 * j);
#pragma unroll
                for (int k = 0; k < 4; ++k) ys[r][k][j] = *(const u32x2*)(YS + (size_t)sl[r][k] * D + 4 * lane + 256 * j);
            }
        const float* g2 = modv + (size_t)(layer * 9 + mr) * 6144 + 5120;
        f32x4 g2v[4];
#pragma unroll
        for (int j = 0; j < 4; ++j) g2v[j] = *(const f32x4*)(g2 + 4 * lane + 256 * j);
        ModVec m;
        if (layer == 0) { const float* mv = modv + (size_t)(9 + mr) * 6144; modvec_load(m, a.in[I_N1G] + D, mv + 1024, mv, lane); }
        else {
#pragma unroll
            for (int j = 0; j < 4; ++j) m.g[j] = *(const f32x4*)(a.in[I_FG] + 4 * lane + 256 * j);
        }
#pragma unroll
        for (int r = 0; r < 2; ++r) {
            const int row = row0 + r; f32x4 v[4];
#pragma unroll
            for (int j = 0; j < 4; ++j) {
                const int c = 4 * lane + 256 * j; f32x4 y = (f32x4){0.f, 0.f, 0.f, 0.f};
#pragma unroll
                for (int k = 0; k < 4; ++k) { const u32x2 w = ys[r][k][j]; y += (f32x4){bflo(w.x), bfhi(w.x), bflo(w.y), bfhi(w.y)} * wv[r][k]; }
                v[j] = hv[r][j] + g2v[j] * y;
                if (layer == 0) st_bf16x4(H + (size_t)row * D + c, v[j]);
            }
            const float rstd = row_rstd(v);
            if (layer == 0) {
                int orow = row;
                if (row >= NCTX) { const int li = row - NCTX, b = li >> 12, t = li & 4095; orow = NCTX + b * SEQ + (t & 63) * 64 + (t >> 6); }
                norm_mod_store(v, rstd, m, (bf16_t*)(a.ws + WS_A) + (size_t)orow * D, lane);
            } else {
#pragma unroll
                for (int j = 0; j < 4; ++j) { const int c = 4 * lane + 256 * j; *(f32x4*)(a.out + (size_t)(row - NCTX) * D + c) = v[j] * rstd * m.g[j]; }
            }
        }
    }
}
__device__ __forceinline__ void moe_gemm1(const Args& a, LAS unsigned char* lds, int layer, int tid, int G, int vcu) {
    unsigned char* ws = a.ws;
    const int TT = moe_tiles(a, lds, layer, tid);
    const LAS int* tbl = (const LAS int*)(lds + 131072 + 1024);
    pg8::Gemm g{(const bf16_t*)(ws + WS_F), (const bf16_t*)(ws + WS_W1) + (size_t)layer * 32 * 2048 * 1024, MPAD, 32 * 2048, 1024};
    pg8::MoeOrder S{tbl, TT, 3, G, vcu};
    EpiMoe1 E{a.in[I_B1] + (size_t)layer * 32 * 2048, (bf16_t*)(ws + WS_ACT)};
    LAS unsigned short* rowl = (LAS unsigned short*)(lds + 136192);
    { const int* slottok = (const int*)(ws + WS_SLOTTOK); pg8::Unit uu; int t2 = threadIdx.x; asm volatile("" : "+v"(t2)); const int tid = t2;
      for (int i = 0; i < 21; i += 2) { const int ii = i + (tid >> 8); if (ii < 21 && S.next(ii, uu)) rowl[ii * 256 + (tid & 255)] = (unsigned short)slottok[uu.pm * 256 + (tid & 255)]; } }
    __syncthreads();
    pg8::gemm_phase<EpiMoe1, pg8::MoeOrder, true>(lds, g, S, E, rowl);
}
__device__ __forceinline__ void moe_gemm2(const Args& a, LAS unsigned char* lds, int layer, int tid, int G, int vcu) {
    unsigned char* ws = a.ws;
    const int TT = moe_tiles(a, lds, layer, tid);
    const LAS int* tbl = (const LAS int*)(lds + 131072 + 1024);
    pg8::Gemm g{(const bf16_t*)(ws + WS_ACT), (const bf16_t*)(ws + WS_W2) + (size_t)layer * 32 * 1024 * 1024, MPAD, 32 * 1024, 1024};
    pg8::MoeOrder S{tbl, TT, 2, G, vcu};
    EpiMoe2 E{a.in[I_B2] + (size_t)layer * 32 * 1024, (bf16_t*)(ws + WS_YS)};
    pg8::gemm_phase<EpiMoe2, pg8::MoeOrder>(lds, g, S, E);
}


__device__ __forceinline__ void s5_disc(const Args& a, int d, int g, int p, float& ab_re, float& ab_im, float& co_re, float& co_im) {
    const float lam_re = fminf(a.in[I_S5ARE][(d * 64 + g) * 64 + p], -1e-4f), lam_im = a.in[I_S5AIM][(d * 64 + g) * 64 + p];
    const float dt = expf(a.in[I_S5LDT][d * 64 + g]);
    const float mag = expf(lam_re * dt), ang = lam_im * dt;
    ab_re = mag * cosf(ang); ab_im = mag * sinf(ang);
    const float den = lam_re * lam_re + lam_im * lam_im;
    co_re = ((ab_re - 1.0f) * lam_re + ab_im * lam_im) / den;
    co_im = (ab_im * lam_re - (ab_re - 1.0f) * lam_im) / den;
}
__device__ __forceinline__ void s5_phase(const Args& a, LAS unsigned char* lds, int tid) {
    const int lane = tid & 63, wave = tid >> 6, fr = lane & 15, fq = lane >> 4;
    if (wave >= 4) {
        LAS unsigned* scr = (LAS unsigned*)(lds + 104448 + (wave - 4) * 8320);
        const int cw = blockIdx.x * 4 + (wave - 4), NCW = gridDim.x * 4;
#define L1_ITEM(i) moe_item(a, (i), 1)
        TR_LOOP(cw, NCW, 32 * 512 + 32 * 256, L1_ITEM);
#undef L1_ITEM
        return;
    }
    LAS unsigned char* wl = lds + wave * 26112;
    const bf16_t* A1 = (const bf16_t*)(a.ws + WS_A);
    for (int item = blockIdx.x; item < 256; item += gridDim.x) {
        const int b = item >> 5, dir = (item >> 4) & 1, g = (item & 15) * 4 + wave;
        bf16_t* Y = (bf16_t*)(a.ws + (dir ? WS_YB : WS_YF));
        float ab_re, ab_im, cr_, ci_;
        s5_disc(a, dir, g, lane, ab_re, ab_im, cr_, ci_);
        bf16x8 Bd[4], Cf[4];
        {
            f32x4 cre[4], cim[4];
#pragma unroll
            for (int kk = 0; kk < 4; ++kk) { const size_t o = ((size_t)(dir * 64 + g) * 16 + fr) * 64 + kk * 16 + fq * 4; cre[kk] = *(const f32x4*)(a.in[I_S5CRE] + o); cim[kk] = *(const f32x4*)(a.in[I_S5CIM] + o); }
#pragma unroll
            for (int kk = 0; kk < 4; ++kk)
#pragma unroll
                for (int j = 0; j < 8; ++j) Cf[kk][j] = (short)f2bf((j & 1) ? -cim[kk][j >> 1] : cre[kk][j >> 1]);
            {
                const int c31 = lane & 31, h5 = lane >> 5;
                f32x4 br0[4], br1[4], bi0[4], bi1[4];
#pragma unroll
                for (int ct = 0; ct < 4; ++ct) {
                    const int pp = ct * 16 + (c31 >> 1); const size_t o = (size_t)(g * 64 + pp) * 16 + h5 * 8;
                    br0[ct] = *(const f32x4*)(a.in[I_S5BRE] + o); br1[ct] = *(const f32x4*)(a.in[I_S5BRE] + o + 4); bi0[ct] = *(const f32x4*)(a.in[I_S5BIM] + o); bi1[ct] = *(const f32x4*)(a.in[I_S5BIM] + o + 4);
                }
#pragma unroll
                for (int ct = 0; ct < 4; ++ct) {
                    const int pp = ct * 16 + (c31 >> 1); const float qr = __shfl(cr_, pp), qi = __shfl(ci_, pp);
#pragma unroll
                    for (int j = 0; j < 8; ++j) {
                        const float br = j < 4 ? br0[ct][j & 3] : br1[ct][j & 3], bi = j < 4 ? bi0[ct][j & 3] : bi1[ct][j & 3];
                        Bd[ct][j] = (short)f2bf((c31 & 1) ? (qr * bi + qi * br) : (qr * br - qi * bi));
                    }
                }
            }
        }
#define S5_POS(n_, t_) ((((n_) < 8) ? (n_) : (n_) - 8) * 32 + (t_))
#define S5_ROW(n_, t_) ((((n_) < 8) ? b * CTXL : NCTX + b * SEQ) + (dir ? (((n_) < 8) ? CTXL : SEQ) - 1 - S5_POS(n_, t_) : S5_POS(n_, t_)))
#define S5_LOADU(d0, n_) do { d0 = (bf16x8){0, 0, 0, 0, 0, 0, 0, 0}; if ((n_) < 136) d0 = *(const bf16x8*)(A1 + (size_t)S5_ROW(n_, lane & 31) * D + g * 16 + (lane >> 5) * 8); } while (0)
        LAS float* BUF = (LAS float*)wl; LAS unsigned* HW = (LAS unsigned*)(wl + 17408); const LAS unsigned char* HP = wl + 17408;
        bf16x8 ua0, ub0, uc0;
        S5_LOADU(ua0, 0); S5_LOADU(ub0, 1);
        f32x2 s = (f32x2){0.f, 0.f};
        const f32x2 abr = (f32x2){ab_re, ab_re}, abi = (f32x2){-ab_im, ab_im};
        bf16_t* yp = Y + (size_t)(b * SEQ + (dir ? SEQ - 1 - fq * 4 : fq * 4)) * D + g * 16 + fr;
        const long ystep = dir ? -(long)D : (long)D;
        unsigned yw[4] = {0u, 0u, 0u, 0u};
#define S5_YSTORE() do { yp[0] = (bf16_t)(yw[0] & 0xffffu); yp[ystep] = (bf16_t)(yw[0] >> 16); yp[2 * ystep] = (bf16_t)(yw[1] & 0xffffu); yp[3 * ystep] = (bf16_t)(yw[1] >> 16); \
            yp[16 * ystep] = (bf16_t)(yw[2] & 0xffffu); yp[17 * ystep] = (bf16_t)(yw[2] >> 16); yp[18 * ystep] = (bf16_t)(yw[3] & 0xffffu); yp[19 * ystep] = (bf16_t)(yw[3] >> 16); yp += 32 * ystep; } while (0)
        for (int n = 0; n < 136; ++n) {
#pragma unroll
            for (int ct = 0; ct < 4; ++ct) {
                typedef float f32x16 __attribute__((ext_vector_type(16)));
                f32x16 z; for (int r = 0; r < 16; ++r) z[r] = 0.f;
                const f32x16 d = __builtin_amdgcn_mfma_f32_32x32x16_bf16(Bd[ct], ua0, z, 0, 0, 0);
#pragma unroll
                for (int q = 0; q < 4; ++q) *(LAS f32x4*)(BUF + (lane & 31) * 132 + ct * 32 + 8 * q + 4 * (lane >> 5)) = (f32x4){d[4 * q], d[4 * q + 1], d[4 * q + 2], d[4 * q + 3]};
            }
            if (n >= 9) S5_YSTORE();
            S5_LOADU(uc0, n + 2);
            LDS_WAIT();
            {
                const bool hist = n >= 8;
                f32x2 bu[32];
#pragma unroll
                for (int j = 0; j < 32; ++j) bu[j] = *(const LAS f32x2*)(BUF + j * 132 + 2 * lane);
                unsigned hw[32];
#pragma unroll
                for (int j = 0; j < 32; ++j) { const f32x2 t1 = abr * s + bu[j]; s = abi * (f32x2){s.y, s.x} + t1; hw[j] = cvt_pk_bf16(s.x, s.y); }
                if (hist) {
#pragma unroll
                    for (int j = 0; j < 32; ++j) HW[j * 68 + lane] = hw[j];
                }
            }
            LDS_WAIT();
            if (n >= 8) {
                f32x4 y0 = (f32x4){0.f, 0.f, 0.f, 0.f}, y1 = (f32x4){0.f, 0.f, 0.f, 0.f};
                bf16x8 ha[2][4];
#pragma unroll
                for (int hf = 0; hf < 2; ++hf)
#pragma unroll
                    for (int kk = 0; kk < 4; ++kk) ha[hf][kk] = *(const LAS bf16x8*)(HP + (hf * 16 + fr) * 272 + (kk * 32 + fq * 8) * 2);
#pragma unroll
                for (int kk = 0; kk < 4; ++kk) { y0 = __builtin_amdgcn_mfma_f32_16x16x32_bf16(ha[0][kk], Cf[kk], y0, 0, 0, 0); y1 = __builtin_amdgcn_mfma_f32_16x16x32_bf16(ha[1][kk], Cf[kk], y1, 0, 0, 0); }
                yw[0] = cvt_pk_bf16(y0[0], y0[1]); yw[1] = cvt_pk_bf16(y0[2], y0[3]); yw[2] = cvt_pk_bf16(y1[0], y1[1]); yw[3] = cvt_pk_bf16(y1[2], y1[3]);
                LDS_WAIT();
            }
            ua0 = ub0; ub0 = uc0;
        }
        S5_YSTORE();
#undef S5_YSTORE
#undef S5_POS
#undef S5_ROW
#undef S5_LOADU
    }
}
__device__ __forceinline__ float gelu_tanh_f(float x) { const float z = 0.7978845608f * (x + 0.044715f * x * x * x); return x * (1.0f - __builtin_amdgcn_rcpf(1.0f + __expf(2.0f * z))); }
__device__ __forceinline__ void s5_post_phase(const Args& a, int lane, int gw, int NGW) {
    const bf16_t* YF = (const bf16_t*)(a.ws + WS_YF); const bf16_t* YB = (const bf16_t*)(a.ws + WS_YB);
    const bf16_t* A1 = (const bf16_t*)(a.ws + WS_A); bf16_t* YG = (bf16_t*)(a.ws + WS_YG);
    f32x4 dk[4];
#pragma unroll
    for (int j = 0; j < 4; ++j) dk[j] = *(const f32x4*)(a.in[I_S5D] + 4 * lane + 256 * j);
    for (int tok0 = gw * 4; tok0 < NLAT; tok0 += NGW * 4) {
        u32x2 yf[4][4], yb[4][4], uu[4][4];
#pragma unroll
        for (int r = 0; r < 4; ++r) { const int tok = tok0 + r, b = tok >> 12, t = tok & 4095, src = b * SEQ + (t & 63) * 64 + (t >> 6);
#pragma unroll
            for (int j = 0; j < 4; ++j) { const int c = 4 * lane + 256 * j; yf[r][j] = *(const u32x2*)(YF + (size_t)src * D + c); yb[r][j] = *(const u32x2*)(YB + (size_t)src * D + c); uu[r][j] = *(const u32x2*)(A1 + (size_t)(NCTX + src) * D + c); } }
#pragma unroll
        for (int r = 0; r < 4; ++r)
#pragma unroll
            for (int j = 0; j < 4; ++j) {
                const u32x2 f = yf[r][j], bk = yb[r][j], uw = uu[r][j];
                const f32x4 y = (f32x4){bflo(f.x) + bflo(bk.x), bfhi(f.x) + bfhi(bk.x), bflo(f.y) + bflo(bk.y), bfhi(f.y) + bfhi(bk.y)} + dk[j] * (f32x4){bflo(uw.x), bfhi(uw.x), bflo(uw.y), bfhi(uw.y)};
                f32x4 o;
#pragma unroll
                for (int i = 0; i < 4; ++i) o[i] = gelu_tanh_f(y[i]);
                st_bf16x4(YG + (size_t)(tok0 + r) * D + 4 * lane + 256 * j, o);
            }
    }
}
struct EpiGlu {
    static constexpr bool PERM = true;
    const float* bglu; const float* modv1; bf16_t* H;
    __device__ __forceinline__ void operator()(const f32x4 (&acc)[2][2][4][2], const Unit& u, int wr, int wc, int fr, int fq) const {
        const int rt0 = u.pm * 256, bidx = rt0 >> 12, cb = u.pn * 128 + wc * 32 + 8 * fq, rl0 = wr * 64 + fr;
        const float* gp = modv1 + bidx * 6144 + 2048;
        f32x4 ba0 = *(const f32x4*)(bglu + cb), ba1 = *(const f32x4*)(bglu + cb + 4), bb0 = *(const f32x4*)(bglu + 1024 + cb), bb1 = *(const f32x4*)(bglu + 1024 + cb + 4);
        f32x4 gv0 = *(const f32x4*)(gp + cb), gv1 = *(const f32x4*)(gp + cb + 4);
        pin(ba0); pin(ba1); pin(bb0); pin(bb1); pin(gv0); pin(gv1);
        u32x4 hws[2][4];
#pragma unroll
        for (int ai = 0; ai < 2; ++ai)
#pragma unroll
            for (int m = 0; m < 4; ++m) hws[ai][m] = *(const u32x4*)(H + (size_t)(NCTX + rt0 + rl0 + ai * 128 + m * 16) * D + cb);
#pragma unroll
        for (int ai = 0; ai < 2; ++ai)
#pragma unroll
            for (int m = 0; m < 4; ++m) {
                bf16_t* hp = H + (size_t)(NCTX + rt0 + rl0 + ai * 128 + m * 16) * D + cb;
                const u32x4 hw = hws[ai][m]; const f32x4 h0 = (f32x4){bflo(hw.x), bfhi(hw.x), bflo(hw.y), bfhi(hw.y)}, h1 = (f32x4){bflo(hw.z), bfhi(hw.z), bflo(hw.w), bfhi(hw.w)};
                const f32x4 za0 = acc[ai][0][m][0] + ba0, za1 = acc[ai][0][m][1] + ba1, zb0 = acc[ai][1][m][0] + bb0, zb1 = acc[ai][1][m][1] + bb1; f32x4 o0, o1;
#pragma unroll
                for (int j = 0; j < 4; ++j) { o0[j] = za0[j] * sigmoid_f(zb0[j]); o1[j] = za1[j] * sigmoid_f(zb1[j]); }
                const f32x4 r0 = h0 + gv0 * o0, r1 = h1 + gv1 * o1;
                *(u32x4*)hp = (u32x4){pk2(r0[0], r0[1]), pk2(r0[2], r0[3]), pk2(r1[0], r1[1]), pk2(r1[2], r1[3])};
            }
    }
};

#define XB_TMO      128
#define XB_XCNT(j)  (256  + 64 * (j))
#define XB_XSUB(j)  (1280 + 64 * (j))
#define XB_XGEN(j)  (2304 + 64 * (j))
#define XB_TOP      3328
#define XB_TOPGEN   3392
#define XCD_BAR_WORDS 3456
#define XB_SPIN_CAP (1u << 18)
__device__ __forceinline__ unsigned xb_ld(unsigned* p)              { return __hip_atomic_load(p, __ATOMIC_RELAXED, __HIP_MEMORY_SCOPE_AGENT); }
__device__ __forceinline__ unsigned xb_add(unsigned* p, unsigned v) { return __hip_atomic_fetch_add(p, v, __ATOMIC_RELAXED, __HIP_MEMORY_SCOPE_AGENT); }
__device__ __forceinline__ unsigned xb_xcc_id() { return (unsigned)__builtin_amdgcn_s_getreg((3 << 11) | 20) & 0xFu; }
#define XB_SPIN(cond, bar) do { unsigned _sp = 0; while (cond) { __builtin_amdgcn_s_sleep(1); \
    if ((++_sp & 255u) == 0u) { if (xb_ld(&(bar)[XB_TMO])) break; if (_sp > XB_SPIN_CAP) { atomicAdd(&(bar)[XB_TMO], 1u); break; } } } } while (0)
struct XcdBarrier { unsigned* bar; unsigned x; volatile LAS unsigned* st; };
__device__ __forceinline__ XcdBarrier xcd_barrier_post(unsigned* bar, volatile LAS unsigned* st) {
    XcdBarrier b; b.bar = bar; b.x = xb_xcc_id(); b.st = st;
    if (threadIdx.x == 0) (void)xb_add(&bar[XB_XCNT(b.x)], 1u);
    return b;
}
__device__ __forceinline__ void xcd_barrier_complete(unsigned* bar, unsigned x, unsigned& nloc, unsigned& nx) {
    const unsigned G = gridDim.x * gridDim.y * gridDim.z;
    unsigned sum, cnt, mine, sp = 0u;
    for (;;) {
        sum = 0u; cnt = 0u; mine = 0u;
#pragma unroll
        for (unsigned j = 0; j < 16; ++j) { const unsigned c = xb_ld(&bar[XB_XCNT(j)]); sum += c; cnt += (c > 0u) ? 1u : 0u; mine = (j == x) ? c : mine; }
        if (sum == G) break;
        __builtin_amdgcn_s_sleep(1);
        if ((++sp & 255u) == 0u) { if (xb_ld(&bar[XB_TMO])) break; if (sp > XB_SPIN_CAP) { atomicAdd(&bar[XB_TMO], 1u); break; } }
    }
    nloc = mine > 0u ? mine : 1u; nx = cnt > 0u ? cnt : 1u;
}
__device__ __forceinline__ void xcd_barrier(const XcdBarrier& b) {
    asm volatile("s_waitcnt vmcnt(0)" ::: "memory");
    __syncthreads();
    if (threadIdx.x == 0) {
        unsigned* bar = b.bar;
        __builtin_amdgcn_s_waitcnt(0);
        unsigned nloc = b.st[0], nx = b.st[1];
        if (nloc == 0u) { xcd_barrier_complete(bar, b.x, nloc, nx); b.st[0] = nloc; b.st[1] = nx; }
        const unsigned old = xb_add(&bar[XB_XSUB(b.x)], 1u);
        const unsigned gen = old / nloc;
        if (old + 1u == (gen + 1u) * nloc) {
            __builtin_amdgcn_fence(__ATOMIC_RELEASE, "agent");
            asm volatile("s_waitcnt vmcnt(0)" ::: "memory");
            const unsigned og = xb_add(&bar[XB_TOP], 1u);
            const unsigned tg = og / nx;
            if (og + 1u == (tg + 1u) * nx) xb_add(&bar[XB_TOPGEN], 1u);
            else XB_SPIN(xb_ld(&bar[XB_TOPGEN]) == tg, bar);
            __builtin_amdgcn_fence(__ATOMIC_ACQUIRE, "agent");
            xb_add(&bar[XB_XGEN(b.x)], 1u);
            asm volatile("s_waitcnt vmcnt(0)" ::: "memory");
        } else {
            XB_SPIN(xb_ld(&bar[XB_XGEN(b.x)]) == gen, bar);
            __builtin_amdgcn_fence(__ATOMIC_ACQUIRE, "agent");
            asm volatile("s_waitcnt vmcnt(0)" ::: "memory");
        }
    }
    __syncthreads();
}

__device__ __forceinline__ int opaque_tid() { int t = threadIdx.x; asm volatile("" : "+v"(t)); return t; }
#define PHASE_IDS() const int tid = opaque_tid(); const int lane = tid & 63, wave = tid >> 6; const int G = gridDim.x, gw = blockIdx.x * 8 + wave, NGW = G * 8; \
    const int vcu = (G % 8 == 0) ? (int)(blockIdx.x % 8) * (G / 8) + (int)(blockIdx.x / 8) : (int)blockIdx.x; (void)lane; (void)wave; (void)gw; (void)NGW; (void)vcu; (void)G
__global__ void __launch_bounds__(NTHREADS, 2) fwd_mega(Args a) {
    extern __shared__ __attribute__((aligned(16))) unsigned char lds_raw[];
    LAS unsigned char* lds = (LAS unsigned char*)lds_raw;
    cg::grid_group grid = cg::this_grid();
    unsigned char* ws = a.ws;
    if (threadIdx.x < 2) ((LAS unsigned*)(lds + LDS_BYTES - 16))[threadIdx.x] = 0u;
    __syncthreads();
    const XcdBarrier xbar = xcd_barrier_post((unsigned*)(ws + WS_CTL) + CW_BAR, (volatile LAS unsigned*)(lds + LDS_BYTES - 16));
#ifdef TS_SEL
    volatile LAS unsigned long long* tsbuf = (volatile LAS unsigned long long*)(lds + LDS_BYTES - 16 - 256);
    int tsn = 0;
#define TS_MARK() do { if (blockIdx.x == 0 && threadIdx.x == 0) tsbuf[tsn] = __builtin_amdgcn_s_memrealtime(); ++tsn; } while (0)
#else
#define TS_MARK() do { } while (0)
#endif
    TS_MARK();
#define GSYNC() do { xcd_barrier(xbar); TS_MARK(); } while (0)

    for (int rep = 0; rep < REP_P0; ++rep) { PHASE_IDS(); p0_phase(a, lds, tid, gw, NGW); if (REP_P0 > 1) __syncthreads(); }
    if (a.pad1 != 0) grid.sync();
    GSYNC();
    for (int rep = 0; rep < REP_P1; ++rep) { PHASE_IDS(); p1_phase(a, lane, gw, NGW); }
    GSYNC();
    {
        PHASE_IDS();
        pg8::Gemm g{(const bf16_t*)(ws + WS_A), (const bf16_t*)(ws + WS_WIN), NTOK, 5120, 1024};
        pg8::StaticOrder S; S.init(NTOK, 5120, G, (int)blockIdx.x);
        EpiInProj E{(bf16_t*)(ws + WS_Q), (bf16_t*)(ws + WS_V), (bf16_t*)(ws + WS_G), (_Float16*)(ws + WS_LFF), (_Float16*)(ws + WS_LFB), (const float*)(ws + WS_LBV)};
        for (int rep = 0; rep < REP_INP; ++rep) pg8::gemm_phase<EpiInProj, pg8::StaticOrder>(lds, g, S, E);
    }
    GSYNC();
    for (int rep = 0; rep < REP_GLA; ++rep) { PHASE_IDS(); gla_phase(a, lds, tid); if (REP_GLA > 1) __syncthreads(); }
    GSYNC();
    for (int rep = 0; rep < REP_RO; ++rep) { PHASE_IDS(); gla_readout_phase(a, lane, gw, NGW); }
    GSYNC();
    {
        PHASE_IDS();
        pg8::Gemm g{(const bf16_t*)(ws + WS_OG), (const bf16_t*)(ws + WS_WOUT), NTOK, 1024, 1024};
        pg8::StaticOrder S; S.init(NTOK, 1024, G, (int)blockIdx.x);
        EpiResid E{a.in[I_X], a.in[I_CTX], (const float*)(ws + WS_MODV), (bf16_t*)(ws + WS_H), 2048};
        for (int rep = 0; rep < REP_OUT; ++rep) pg8::gemm_phase<EpiResid, pg8::StaticOrder>(lds, g, S, E);
    }
    GSYNC();
    for (int rep = 0; rep < REP_RT; ++rep) { PHASE_IDS(); router_phase(a, lds, 0, 0, tid); if (REP_RT > 1) __syncthreads(); }
    GSYNC();
    for (int rep = 0; rep < REP_AS; ++rep) { PHASE_IDS(); assign_phase(a, lds, 0, 0, tid); if (REP_AS > 1) __syncthreads(); }
    GSYNC();
    for (int rep = 0; rep < REP_M1; ++rep) { PHASE_IDS(); moe_gemm1(a, lds, 0, tid, G, vcu); }
    GSYNC();
    for (int rep = 0; rep < REP_M2; ++rep) { PHASE_IDS(); moe_gemm2(a, lds, 0, tid, G, vcu); }
    GSYNC();
    { PHASE_IDS(); combine_phase(a, 0, 0, lane, gw, NGW); }
    GSYNC();
    for (int rep = 0; rep < REP_S5; ++rep) { PHASE_IDS(); s5_phase(a, lds, tid); if (REP_S5 > 1) __syncthreads(); }
    GSYNC();
    for (int rep = 0; rep < REP_POST; ++rep) { PHASE_IDS(); s5_post_phase(a, lane, gw, NGW); }
    GSYNC();
    {
        PHASE_IDS();
        pg8::Gemm g{(const bf16_t*)(ws + WS_YG), (const bf16_t*)(ws + WS_WGLU), NLAT, 2048, 1024};
        pg8::StaticOrder S; S.init(NLAT, 2048, G, (int)blockIdx.x);
        EpiGlu E{a.in[I_S5BGLU], (const float*)(ws + WS_MODV) + 9 * 6144, (bf16_t*)(ws + WS_H)};
        pg8::gemm_phase<EpiGlu, pg8::StaticOrder>(lds, g, S, E);
    }
    GSYNC();
    { PHASE_IDS(); router_phase(a, lds, 1, NCTX, tid); }
    GSYNC();
    { PHASE_IDS(); assign_phase(a, lds, 1, NCTX, tid); }
    GSYNC();
    { PHASE_IDS(); moe_gemm1(a, lds, 1, tid, G, vcu); }
    GSYNC();
    { PHASE_IDS(); moe_gemm2(a, lds, 1, tid, G, vcu); }
    GSYNC();
    for (int rep = 0; rep < REP_CMB1; ++rep) { PHASE_IDS(); combine_phase(a, 1, NCTX, lane, gw, NGW); }
#ifdef TS_SEL
    TS_MARK();
    if (blockIdx.x == 0 && threadIdx.x == 0) {
        asm volatile("s_waitcnt vmcnt(0)" ::: "memory"); __threadfence();
        const unsigned long long dt = tsbuf[TS_SEL + 1] - tsbuf[TS_SEL];
        atomicAdd(a.out, (float)dt * 0.001f);
    }
#endif
}

extern "C" void kernel_launch(void* const* d_in, const int* in_sizes, int n_in, void* d_out, int out_size,
                              void* d_ws, size_t ws_size, hipStream_t stream) {
    static int grid_blocks = 0;
    if (!grid_blocks) {
        int dev = 0, cus = 0, per_cu = 0;
        (void)hipGetDevice(&dev);
        (void)hipDeviceGetAttribute(&cus, hipDeviceAttributeMultiprocessorCount, dev);
        (void)hipFuncSetAttribute((const void*)fwd_mega, hipFuncAttributeMaxDynamicSharedMemorySize, LDS_BYTES);
        (void)hipOccupancyMaxActiveBlocksPerMultiprocessor(&per_cu, (const void*)fwd_mega, NTHREADS, LDS_BYTES);
        if (per_cu < 1) { fprintf(stderr, "occupancy query says %d blocks/CU\n", per_cu); }
        grid_blocks = cus < 256 ? cus : 256;
        if (ws_size < WS_END) fprintf(stderr, "kernel_launch: workspace too small: %zu < %zu\n", ws_size, (size_t)WS_END);
    }
    (void)hipMemsetAsync((char*)d_ws + WS_CTL, 0, 1 * MiB, stream);
    Args a{};
    for (int i = 0; i < 29; ++i) a.in[i] = (const float*)d_in[i];
    a.out = (float*)d_out; a.ws = (unsigned char*)d_ws;
    void* kargs[] = {&a};
    hipError_t e = hipLaunchCooperativeKernel((const void*)fwd_mega, dim3(grid_blocks), dim3(NTHREADS), kargs, LDS_BYTES, stream);
    if (e != hipSuccess) fprintf(stderr, "cooperative launch failed: %s (grid %d)\n", hipGetErrorString(e), grid_blocks);
}
```

```cpp
#include <hip/hip_runtime.h>
#include <hip/hip_cooperative_groups.h>
#include <cstdio>
#include <cstdint>
namespace cg = cooperative_groups;

#define LAS __attribute__((address_space(3)))
typedef unsigned short bf16_t;
typedef short bf16x8 __attribute__((ext_vector_type(8)));
typedef float f32x4 __attribute__((ext_vector_type(4)));
typedef unsigned u32x4 __attribute__((ext_vector_type(4)));
typedef unsigned u32x2 __attribute__((ext_vector_type(2)));
typedef float f32x2 __attribute__((ext_vector_type(2)));

constexpr int NTHREADS = 512;
constexpr int LDS_BYTES = 147456;
constexpr int D = 1024, NB = 8, SEQ = 4096, CTXL = 256;
constexpr int NCTX = NB * CTXL;
constexpr int NLAT = NB * SEQ;
constexpr int NTOK = NCTX + NLAT;
constexpr int NE = 32;
constexpr int MPAD = 147456;
constexpr float EPS = 1e-6f;

constexpr size_t MiB = 1u << 20;
constexpr size_t WS_CTL = 0;
constexpr size_t WS_MODV = 1 * MiB;
constexpr size_t WS_LBV = 1 * MiB + 512 * 1024;
constexpr size_t WS_WIN = 2 * MiB;
constexpr size_t WS_WOUT = 12 * MiB;
constexpr size_t WS_WGLU = 14 * MiB;
constexpr size_t WS_W1 = 18 * MiB;
constexpr size_t WS_W2 = 274 * MiB;
constexpr size_t WS_H = 402 * MiB;
constexpr size_t WS_A = 538 * MiB;
constexpr size_t WS_F = 606 * MiB;
constexpr size_t WS_TOKE = 674 * MiB;
constexpr size_t WS_TOKW = 674 * MiB + 640 * 1024;
constexpr size_t WS_TOKS = 674 * MiB + 1280 * 1024;
constexpr size_t WS_SLOTTOK = 256 * 1024;
constexpr size_t WS_BIG = 676 * MiB;
constexpr size_t WS_Q = WS_BIG, WS_V = WS_BIG + 68 * MiB, WS_G = WS_BIG + 136 * MiB;
constexpr size_t WS_LFF = WS_BIG + 204 * MiB, WS_LFB = WS_BIG + 340 * MiB;
constexpr size_t WS_OF = WS_BIG + 476 * MiB, WS_OB = WS_BIG + 612 * MiB;
constexpr size_t WS_OG = WS_BIG + 748 * MiB;
constexpr size_t WS_AG = WS_BIG, WS_ACT = WS_BIG + 288 * MiB, WS_YS = WS_BIG;
constexpr size_t WS_YF = WS_BIG, WS_YB = WS_BIG + 128 * MiB, WS_YG = WS_BIG + 256 * MiB;
constexpr size_t WS_END = WS_BIG + 816 * MiB;
constexpr int CW_CNT = 64;
constexpr int CW_CUR = 256;
constexpr int CW_CNTB = 8192;
constexpr int CW_BAR = 4096;
#ifndef REP_P0
#define REP_P0 1
#endif
#ifndef REP_GLA
#define REP_GLA 1
#endif
#ifndef REP_S5
#define REP_S5 1
#endif
#ifndef REP_P1
#define REP_P1 1
#endif
#ifndef REP_RO
#define REP_RO 1
#endif
#ifndef REP_POST
#define REP_POST 1
#endif
#ifndef REP_CMB1
#define REP_CMB1 1
#endif
#ifndef REP_OUT
#define REP_OUT 1
#endif
#ifndef REP_RT
#define REP_RT 1
#endif
#ifndef REP_AS
#define REP_AS 1
#endif
#ifndef REP_INP
#define REP_INP 1
#endif
#ifndef REP_M1
#define REP_M1 1
#endif
#ifndef REP_M2
#define REP_M2 1
#endif

struct Args {
    const float* in[29];
    float* out;
    unsigned char* ws;
    int stop_after, pad1;
};
enum { I_X = 0, I_C, I_CTX, I_CCTX, I_MODW, I_MODB, I_N1G, I_N2G, I_HGWIN, I_HGLB, I_HGNG, I_HGWOUT, I_S5ARE, I_S5AIM, I_S5LDT,
       I_S5BRE, I_S5BIM, I_S5CRE, I_S5CIM, I_S5D, I_S5WGLU, I_S5BGLU, I_RW, I_RB, I_W1, I_B1, I_W2, I_B2, I_FG };

__device__ __forceinline__ unsigned f2bf(float f) { unsigned u = __builtin_bit_cast(unsigned, f); return (u + 0x7fffu + ((u >> 16) & 1u)) >> 16; }
typedef __bf16 bf16x2_t __attribute__((ext_vector_type(2)));
__device__ __forceinline__ unsigned cvt_pk_bf16(float lo, float hi) { const bf16x2_t v = {(__bf16)lo, (__bf16)hi}; return __builtin_bit_cast(unsigned, v); }
__device__ __forceinline__ unsigned pk2(float lo, float hi) { return cvt_pk_bf16(lo, hi); }
__device__ __forceinline__ float bf2f(unsigned short b) { return __builtin_bit_cast(float, ((unsigned)b) << 16); }
__device__ __forceinline__ float bflo(unsigned w) { return __builtin_bit_cast(float, w << 16); }
__device__ __forceinline__ float bfhi(unsigned w) { return __builtin_bit_cast(float, w & 0xffff0000u); }
__device__ __forceinline__ float wave_sum(float v) {
#pragma unroll
    for (int o = 1; o < 64; o <<= 1) v += __shfl_xor(v, o);
    return v;
}
__device__ __forceinline__ float wave_max(float v) {
#pragma unroll
    for (int o = 1; o < 64; o <<= 1) v = fmaxf(v, __shfl_xor(v, o));
    return v;
}
__device__ __forceinline__ float sigmoid_f(float x) { return __builtin_amdgcn_rcpf(1.0f + __expf(-x)); }
__device__ __forceinline__ float silu_f(float x) { return x * __builtin_amdgcn_rcpf(1.0f + __expf(-x)); }
#define LDS_WAIT() asm volatile("s_waitcnt lgkmcnt(0)" ::: "memory")

namespace pg8 {
constexpr int BM = 256, BK = 64, HALF = 128, HTB = HALF * BK * 2, STAGE_BYTES = 8 * HTB, NXCD = 8, WGM = 8;
__host__ __device__ __forceinline__ int lds_byte(int r, int c) { const int st = (r >> 4) * 2 + (c >> 5), rr = r & 15, cc = c & 31, ob = rr * 64 + cc * 2; return st * 1024 + (ob ^ (((ob >> 9) & 1) << 5)); }
__host__ __device__ __forceinline__ void stage_rc(int b, int& R, int& C) { const int st = b / 1024, sb = b % 1024, swz = sb ^ (((sb >> 9) & 1) << 5); R = (st >> 1) * 16 + swz / 64; C = (st & 1) * 32 + (swz % 64) / 2; }
__host__ __device__ __forceinline__ int perm32(int rho) { const int n = rho >> 4, i = rho & 15; return 8 * (i >> 2) + 4 * n + (i & 3); }
struct Unit { int pm, pn; };
struct Gemm { const bf16_t* A; const bf16_t* Bt; int M, N, K; };
struct StaticOrder {
    int nM, nN, nwg, G, c;
    __device__ void init(int M, int N, int G_, int c_) { nM = M / BM; nN = N / BM; nwg = nM * nN; G = G_; c = c_; }
    __device__ bool next(int i, Unit& u) const {
        const long L = (long)i * G + c; if (L >= nwg) return false;
        int wgid = (int)L; { const int q = nwg / NXCD, r = nwg % NXCD, xcd = wgid % NXCD, off = wgid / NXCD; wgid = (xcd < r ? xcd * (q + 1) : r * (q + 1) + (xcd - r) * q) + off; }
        const int nig = WGM * nN, gid = wgid / nig, fm = gid * WGM, gsz = (nM - fm) < WGM ? (nM - fm) : WGM;
        u.pm = fm + ((wgid % nig) % gsz); u.pn = (wgid % nig) / gsz; return true;
    }
    __device__ __forceinline__ void a_ready(const Unit&) const {}
    __device__ __forceinline__ void done(const Unit&) const {}
};
struct MoeOrder {
    const LAS int* tile_e; int TT, sh, G, v;
    __device__ bool next(int i, Unit& u) const {
        const bool p2 = (G & (G - 1)) == 0 && G >= 8;
        const int lg = p2 ? (31 - __builtin_clz((unsigned)G)) - 3 : 0, per = p2 ? (1 << lg) : G, x = p2 ? (v >> lg) : 0, j = p2 ? (v & (per - 1)) : v, sh3 = p2 ? 3 : 0;
        const int t0 = (x * TT) >> sh3, t1 = ((x + 1) * TT) >> sh3;
        const int uu = i * per + j, rt = t0 + (uu >> sh), pnl = uu & ((1 << sh) - 1);
        if (rt >= t1) return false;
        u.pm = rt; u.pn = (tile_e[rt] << sh) + pnl; return true;
    }
    __device__ __forceinline__ void a_ready(const Unit&) const {}
    __device__ __forceinline__ void done(const Unit&) const {}
};

template <class Epi, class Sched, bool GATHER = false, bool ALIGN_EPI = true, bool SP2 = true>
__device__ __forceinline__ void gemm_phase(LAS unsigned char* lds, const Gemm g, const Sched& S, const Epi& E, const LAS unsigned short* rowl = nullptr) {
    int tid_ = threadIdx.x; asm volatile("" : "+v"(tid_));
    const int tid = tid_, wid = __builtin_amdgcn_readfirstlane(tid >> 6), lane = tid & 63, wr = wid >> 2, wc = wid & 3, fr = lane & 15, fq = lane >> 4;
    const int K = g.K, nt = K / BK;
    unsigned voffA[2], voffB[2];
    int Rr[2], Cc2[2];
#pragma unroll
    for (int i = 0; i < 2; ++i) { int R, C; stage_rc(tid * 16 + i * 8192, R, C); voffA[i] = (unsigned)(R * K + C) * 2u; const int Rb = Epi::PERM ? ((R & ~31) + perm32(R & 31)) : R; voffB[i] = (unsigned)(Rb * K + C) * 2u; Rr[i] = R; Cc2[i] = C * 2; }
    unsigned gA0[2] = {0u, 0u}, gA1[2] = {0u, 0u}, nG0[2] = {0u, 0u}, nG1[2] = {0u, 0u};
#define PG8_ROWS(ui_, d0, d1) do { _Pragma("unroll") for (int _i = 0; _i < 2; ++_i) { d0[_i] = (unsigned)rowl[(ui_) * BM + Rr[_i]] * (unsigned)(K * 2) + (unsigned)Cc2[_i]; d1[_i] = (unsigned)rowl[(ui_) * BM + HALF + Rr[_i]] * (unsigned)(K * 2) + (unsigned)Cc2[_i]; } } while (0)
#define PG8_STAGE_A(bufoff, ptr, h, nx) do { if constexpr (GATHER) { unsigned _o[2]; _o[0] = (nx) ? ((h) ? nG1[0] : nG0[0]) : ((h) ? gA1[0] : gA0[0]); _o[1] = (nx) ? ((h) ? nG1[1] : nG0[1]) : ((h) ? gA1[1] : gA0[1]); PG8_STAGE(bufoff, ptr, _o); } \
        else { PG8_STAGE(bufoff, (ptr) + ((h) ? hstep : 0), voffA); } } while (0)
    const size_t kstep = (size_t)(BK * 2);
    const size_t hstep = (size_t)HALF * K * 2;
    const size_t tstep = 2 * hstep;
    const unsigned ldsw = (unsigned)wid * 1024u;
    const int aoff = lds_byte(wr * 64 + fr, fq * 8), boff = lds_byte(wc * 32 + fr, fq * 8);
#define PG8_SA(b, h) (((b) * 2 + (h)) * HTB)
#define PG8_SB(b, h) ((4 + (b) * 2 + (h)) * HTB)
#define PG8_STAGE(bufoff, gbase, voff) do { _Pragma("unroll") for (int _i = 0; _i < 2; ++_i) \
        __builtin_amdgcn_global_load_lds((const unsigned*)((const char*)(gbase) + (voff)[_i]), (LAS unsigned*)(lds + (bufoff) + ldsw + _i * 8192), 16, 0, 0); } while (0)
#define PG8_LDA(dst, b, h) do { _Pragma("unroll") for (int m = 0; m < 4; ++m) _Pragma("unroll") for (int k = 0; k < 2; ++k) dst[m][k] = *(const LAS bf16x8*)(lds + PG8_SA(b, h) + aoff + m * 2048 + k * 1024); } while (0)
#define PG8_LDB(dst, b, h) do { _Pragma("unroll") for (int n = 0; n < 2; ++n) _Pragma("unroll") for (int k = 0; k < 2; ++k) dst[n][k] = *(const LAS bf16x8*)(lds + PG8_SB(b, h) + boff + n * 2048 + k * 1024); } while (0)
#define PG8_MMA(ai, bj, At, Bt) do { __builtin_amdgcn_s_setprio(1); _Pragma("unroll") for (int m = 0; m < 4; ++m) _Pragma("unroll") for (int n = 0; n < 2; ++n) _Pragma("unroll") for (int k = 0; k < 2; ++k) \
        acc[ai][bj][m][n] = __builtin_amdgcn_mfma_f32_16x16x32_bf16(Bt[n][k], At[m][k], acc[ai][bj][m][n], 0, 0, 0); __builtin_amdgcn_s_setprio(0); } while (0)
#define PG8_WAIT_V(n) asm volatile("s_waitcnt vmcnt(" #n ")" ::: "memory")
#define PG8_WAIT_L(n) asm volatile("s_waitcnt lgkmcnt(" #n ")" ::: "memory")
#define PG8_BAR __builtin_amdgcn_s_barrier()
#define PG8_SCHED __builtin_amdgcn_sched_barrier(0)
    Unit cur, nxt; int ui = 0;
    if (!S.next(0, cur)) return;
    f32x4 acc[2][2][4][2];
#pragma unroll
    for (int a = 0; a < 2; ++a)
#pragma unroll
        for (int b = 0; b < 2; ++b)
#pragma unroll
            for (int m = 0; m < 4; ++m)
#pragma unroll
                for (int n = 0; n < 2; ++n) acc[a][b][m][n] = (f32x4){0.f, 0.f, 0.f, 0.f};
    bf16x8 At[4][2], B0[2][2], B1[2][2];
    const char* cA = GATHER ? (const char*)g.A : (const char*)g.A + (size_t)cur.pm * tstep; const char* cB = (const char*)g.Bt + (size_t)cur.pn * tstep;
    S.a_ready(cur);
    if constexpr (GATHER) PG8_ROWS(0, gA0, gA1);
    if constexpr (SP2) {
        PG8_STAGE(PG8_SB(0, 0), cB, voffB); PG8_STAGE(PG8_SB(0, 1), cB + hstep, voffB); PG8_STAGE_A(PG8_SA(0, 0), cA, 0, false); PG8_STAGE_A(PG8_SA(0, 1), cA, 1, false);
        if (wr == 1) PG8_BAR;
        PG8_WAIT_V(2); PG8_BAR;
        PG8_STAGE(PG8_SB(1, 0), cB + kstep, voffB); PG8_STAGE_A(PG8_SA(1, 0), cA + kstep, 0, false); PG8_STAGE(PG8_SB(1, 1), cB + hstep + kstep, voffB);
        PG8_WAIT_V(6); PG8_BAR;
    } else {
        PG8_STAGE(PG8_SB(0, 0), cB, voffB); PG8_STAGE_A(PG8_SA(0, 0), cA, 0, false); PG8_STAGE(PG8_SB(0, 1), cB + hstep, voffB); PG8_STAGE_A(PG8_SA(0, 1), cA, 1, false);
        if (wr == 1) PG8_BAR;
        PG8_WAIT_V(4); PG8_BAR;
        PG8_STAGE(PG8_SB(1, 0), cB + kstep, voffB); PG8_STAGE_A(PG8_SA(1, 0), cA + kstep, 0, false); PG8_STAGE(PG8_SB(1, 1), cB + hstep + kstep, voffB);
        PG8_WAIT_V(6); PG8_BAR;
    }
    for (;;) {
        const bool has_next = S.next(ui + 1, nxt);
        const char* nA = GATHER ? cA : (has_next ? (const char*)g.A + (size_t)nxt.pm * tstep : cA); const char* nB = has_next ? (const char*)g.Bt + (size_t)nxt.pn * tstep : cB;
        if constexpr (GATHER) { if (has_next) PG8_ROWS(ui + 1, nG0, nG1); else { nG0[0] = gA0[0]; nG0[1] = gA0[1]; nG1[0] = gA1[0]; nG1[1] = gA1[1]; } }
        for (int t = 0; t < nt; t += 2) {
            const bool last = (t == nt - 2);
            const char* a1 = cA + (size_t)(t + 1) * kstep;
            const char* a2 = last ? nA : cA + (size_t)(t + 2) * kstep; const char* b2 = last ? nB : cB + (size_t)(t + 2) * kstep;
            const char* a3 = a2 + kstep; const char* b3 = b2 + kstep;
            if (last && has_next) S.a_ready(nxt);
            if constexpr (SP2) {
            PG8_LDB(B0, 0, 0); PG8_LDB(B1, 0, 1); PG8_SCHED; PG8_LDA(At, 0, 0); PG8_STAGE_A(PG8_SA(1, 1), a1, 1, false);
            PG8_WAIT_V(8); PG8_WAIT_L(0); PG8_BAR; PG8_MMA(0, 0, At, B0); PG8_MMA(0, 1, At, B1); PG8_BAR; PG8_SCHED;
            PG8_LDA(At, 0, 1); PG8_STAGE(PG8_SB(0, 0), b2, voffB); PG8_STAGE(PG8_SB(0, 1), b2 + hstep, voffB); PG8_STAGE_A(PG8_SA(0, 0), a2, 0, last);
            PG8_WAIT_V(8); PG8_WAIT_L(0); PG8_BAR; PG8_MMA(1, 0, At, B0); PG8_MMA(1, 1, At, B1); PG8_BAR; PG8_SCHED;
            PG8_LDB(B0, 1, 0); PG8_LDB(B1, 1, 1); PG8_SCHED; PG8_LDA(At, 1, 0); PG8_STAGE_A(PG8_SA(0, 1), a2, 1, last);
            PG8_WAIT_V(8); PG8_WAIT_L(0); PG8_BAR; PG8_MMA(0, 0, At, B0); PG8_MMA(0, 1, At, B1); PG8_BAR; PG8_SCHED;
            PG8_LDA(At, 1, 1); PG8_STAGE(PG8_SB(1, 0), b3, voffB); PG8_STAGE(PG8_SB(1, 1), b3 + hstep, voffB); PG8_STAGE_A(PG8_SA(1, 0), a3, 0, last);
            PG8_WAIT_V(8); PG8_WAIT_L(0); PG8_BAR; PG8_MMA(1, 0, At, B0); PG8_MMA(1, 1, At, B1); PG8_BAR; PG8_SCHED;
            } else {
            PG8_LDB(B0, 0, 0); PG8_SCHED; PG8_LDA(At, 0, 0); PG8_STAGE_A(PG8_SA(1, 1), a1, 1, false);
            PG8_WAIT_L(8); PG8_BAR; PG8_WAIT_L(0); PG8_MMA(0, 0, At, B0); PG8_BAR; PG8_SCHED;
            PG8_LDB(B1, 0, 1); PG8_STAGE(PG8_SB(0, 0), b2, voffB);
            PG8_BAR; PG8_WAIT_L(0); PG8_MMA(0, 1, At, B1); PG8_BAR;
            PG8_LDA(At, 0, 1); PG8_STAGE_A(PG8_SA(0, 0), a2, 0, last);
            PG8_BAR; PG8_WAIT_L(0); PG8_MMA(1, 0, At, B0); PG8_BAR; PG8_SCHED;
            PG8_STAGE(PG8_SB(0, 1), b2 + hstep, voffB);
            PG8_WAIT_V(6); PG8_BAR; PG8_MMA(1, 1, At, B1); PG8_BAR;
            PG8_LDB(B0, 1, 0); PG8_SCHED; PG8_LDA(At, 1, 0); PG8_STAGE_A(PG8_SA(0, 1), a2, 1, last);
            PG8_WAIT_L(8); PG8_BAR; PG8_WAIT_L(0); PG8_MMA(0, 0, At, B0); PG8_BAR; PG8_SCHED;
            PG8_LDB(B1, 1, 1); PG8_STAGE(PG8_SB(1, 0), b3, voffB);
            PG8_BAR; PG8_WAIT_L(0); PG8_MMA(0, 1, At, B1); PG8_BAR;
            PG8_LDA(At, 1, 1); PG8_STAGE_A(PG8_SA(1, 0), a3, 0, last);
            PG8_BAR; PG8_WAIT_L(0); PG8_MMA(1, 0, At, B0); PG8_BAR; PG8_SCHED;
            PG8_STAGE(PG8_SB(1, 1), b3 + hstep, voffB);
            PG8_WAIT_V(6); PG8_BAR; PG8_MMA(1, 1, At, B1); PG8_BAR;
                    }
        }
        if constexpr (ALIGN_EPI) { if (wr == 0) PG8_BAR; }
        E(acc, cur, wr, wc, fr, fq); S.done(cur);
        if (!has_next) break;
#pragma unroll
        for (int a = 0; a < 2; ++a)
#pragma unroll
            for (int b = 0; b < 2; ++b)
#pragma unroll
                for (int m = 0; m < 4; ++m)
#pragma unroll
                    for (int n = 0; n < 2; ++n) acc[a][b][m][n] = (f32x4){0.f, 0.f, 0.f, 0.f};
        cur = nxt; cA = nA; cB = nB; ++ui;
        if constexpr (GATHER) { gA0[0] = nG0[0]; gA0[1] = nG0[1]; gA1[0] = nG1[0]; gA1[1] = nG1[1]; }
        if constexpr (ALIGN_EPI) { if (wr == 1) PG8_BAR; }
    }
    PG8_WAIT_V(0);
    if constexpr (!ALIGN_EPI) { if (wr == 0) PG8_BAR; }
    PG8_BAR;
#undef PG8_SA
#undef PG8_ROWS
#undef PG8_STAGE_A
#undef PG8_SB
#undef PG8_STAGE
#undef PG8_LDA
#undef PG8_LDB
#undef PG8_MMA
#undef PG8_WAIT_V
#undef PG8_WAIT_L
#undef PG8_BAR
#undef PG8_SCHED
}
}
using pg8::Unit;

__device__ __forceinline__ f32x4 ld_bf16x4(const bf16_t* p) { const u32x2 w = *(const u32x2*)p; return (f32x4){bflo(w.x), bfhi(w.x), bflo(w.y), bfhi(w.y)}; }
__device__ __forceinline__ void pin(f32x4& v) { asm volatile("" : "+v"(v)); }
__device__ __forceinline__ void st_bf16x4(bf16_t* p, f32x4 v) { u32x2 w; w.x = pk2(v[0], v[1]); w.y = pk2(v[2], v[3]); *(u32x2*)p = w; }

struct EpiInProj {
    static constexpr bool PERM = true;
    bf16_t *Q, *V, *G; _Float16 *LFF, *LFB; const float* lbv;
    __device__ __forceinline__ void operator()(const f32x4 (&acc)[2][2][4][2], const Unit& u, int wr, int wc, int fr, int fq) const {
        const int seg = u.pn >> 2, cb = (u.pn & 3) * 256 + wc * 32 + 8 * fq, row0 = u.pm * 256 + wr * 64 + fr;
        if (seg == 2 || seg == 3) {
            _Float16* LF = seg == 2 ? LFF : LFB; const float* lbp = lbv + (seg - 2) * D + cb;
            f32x4 lbA0 = *(const f32x4*)lbp, lbA1 = *(const f32x4*)(lbp + 4), lbB0 = *(const f32x4*)(lbp + 128), lbB1 = *(const f32x4*)(lbp + 132);
            pin(lbA0); pin(lbA1); pin(lbB0); pin(lbB1);
#pragma unroll
            for (int bj = 0; bj < 2; ++bj)
#pragma unroll
                for (int ai = 0; ai < 2; ++ai)
#pragma unroll
                    for (int m = 0; m < 4; ++m) {
                        const f32x4 lb0 = bj ? lbB0 : lbA0, lb1 = bj ? lbB1 : lbA1; const f32x4 v0 = acc[ai][bj][m][0], v1 = acc[ai][bj][m][1]; f32x4 o0, o1;
#pragma unroll
                        for (int j = 0; j < 4; ++j) { o0[j] = __logf(lb0[j] + (1.0f - lb0[j]) * sigmoid_f(v0[j])); o1[j] = __logf(lb1[j] + (1.0f - lb1[j]) * sigmoid_f(v1[j])); }
                        u32x4 hw; hw.x = __builtin_bit_cast(unsigned, __builtin_amdgcn_cvt_pkrtz(o0[0], o0[1])); hw.y = __builtin_bit_cast(unsigned, __builtin_amdgcn_cvt_pkrtz(o0[2], o0[3]));
                        hw.z = __builtin_bit_cast(unsigned, __builtin_amdgcn_cvt_pkrtz(o1[0], o1[1])); hw.w = __builtin_bit_cast(unsigned, __builtin_amdgcn_cvt_pkrtz(o1[2], o1[3]));
                        *(u32x4*)(LF + (size_t)(row0 + ai * 128 + m * 16) * D + cb + bj * 128) = hw;
                    }
        } else if (seg == 0) {
#pragma unroll
            for (int bj = 0; bj < 2; ++bj)
#pragma unroll
                for (int ai = 0; ai < 2; ++ai)
#pragma unroll
                    for (int m = 0; m < 4; ++m) {
                        const f32x4 v0 = acc[ai][bj][m][0], v1 = acc[ai][bj][m][1]; f32x4 o0, o1;
#pragma unroll
                        for (int j = 0; j < 4; ++j) { o0[j] = silu_f(v0[j]); o1[j] = silu_f(v1[j]); }
                        *(u32x4*)(Q + (size_t)(row0 + ai * 128 + m * 16) * D + cb + bj * 128) = (u32x4){pk2(o0[0], o0[1]), pk2(o0[2], o0[3]), pk2(o1[0], o1[1]), pk2(o1[2], o1[3])};
                    }
        } else {
            bf16_t* O = seg == 1 ? V : G;
#pragma unroll
            for (int bj = 0; bj < 2; ++bj)
#pragma unroll
                for (int ai = 0; ai < 2; ++ai)
#pragma unroll
                    for (int m = 0; m < 4; ++m) {
                        const f32x4 v0 = acc[ai][bj][m][0], v1 = acc[ai][bj][m][1];
                        *(u32x4*)(O + (size_t)(row0 + ai * 128 + m * 16) * D + cb + bj * 128) = (u32x4){pk2(v0[0], v0[1]), pk2(v0[2], v0[3]), pk2(v1[0], v1[1]), pk2(v1[2], v1[3])};
                    }
        }
    }
};
struct EpiResid {
    static constexpr bool PERM = true;
    const float* x; const float* ctx; const float* modv; bf16_t* H; int gate_off;
    __device__ __forceinline__ void operator()(const f32x4 (&acc)[2][2][4][2], const Unit& u, int wr, int wc, int fr, int fq) const {
        const int rt0 = u.pm * 256; const int mr = rt0 < NCTX ? 8 : ((rt0 - NCTX) >> 12);
        const float* src = rt0 < NCTX ? ctx + (size_t)rt0 * D : x + (size_t)(rt0 - NCTX) * D;
        const int cb = u.pn * 256 + wc * 32 + 8 * fq, rl0 = wr * 64 + fr;
        const float* gp = modv + mr * 6144 + gate_off;
        f32x4 gg[2][2];
#pragma unroll
        for (int bj = 0; bj < 2; ++bj) { gg[bj][0] = *(const f32x4*)(gp + cb + bj * 128); gg[bj][1] = *(const f32x4*)(gp + cb + bj * 128 + 4); }
#pragma unroll
        for (int bj = 0; bj < 2; ++bj) { pin(gg[bj][0]); pin(gg[bj][1]); }
        f32x4 hA0[2], hA1[2], hB0[2], hB1[2];
#define ER_LOAD(k_, d0, d1) do { const int bj_ = (k_) >> 2, ai_ = ((k_) >> 1) & 1, m0_ = ((k_) & 1) * 2; _Pragma("unroll") for (int m = 0; m < 2; ++m) { const float* hp = src + (size_t)(rl0 + ai_ * 128 + (m0_ + m) * 16) * D + cb + bj_ * 128; d0[m] = *(const f32x4*)hp; d1[m] = *(const f32x4*)(hp + 4); } } while (0)
#define ER_STORE(k_, d0, d1) do { const int bj_ = (k_) >> 2, ai_ = ((k_) >> 1) & 1, m0_ = ((k_) & 1) * 2; _Pragma("unroll") for (int m = 0; m < 2; ++m) { \
            const f32x4 o0 = d0[m] + gg[bj_][0] * acc[ai_][bj_][m0_ + m][0], o1 = d1[m] + gg[bj_][1] * acc[ai_][bj_][m0_ + m][1]; \
            *(u32x4*)(H + (size_t)(rt0 + rl0 + ai_ * 128 + (m0_ + m) * 16) * D + cb + bj_ * 128) = (u32x4){pk2(o0[0], o0[1]), pk2(o0[2], o0[3]), pk2(o1[0], o1[1]), pk2(o1[2], o1[3])}; } } while (0)
        ER_LOAD(0, hA0, hA1);
        ER_LOAD(1, hB0, hB1); ER_STORE(0, hA0, hA1);
        ER_LOAD(2, hA0, hA1); ER_STORE(1, hB0, hB1);
        ER_LOAD(3, hB0, hB1); ER_STORE(2, hA0, hA1);
        ER_LOAD(4, hA0, hA1); ER_STORE(3, hB0, hB1);
        ER_LOAD(5, hB0, hB1); ER_STORE(4, hA0, hA1);
        ER_LOAD(6, hA0, hA1); ER_STORE(5, hB0, hB1);
        ER_LOAD(7, hB0, hB1); ER_STORE(6, hA0, hA1);
        ER_STORE(7, hB0, hB1);
#undef ER_LOAD
#undef ER_STORE
    }
};

struct TrItem { const float* src; bf16_t* dst; int N; };
__device__ __forceinline__ void tr_load(const TrItem& t, f32x4 (&v)[16], int lane) {
    const float* p = t.src + (size_t)(2 * (lane >> 4)) * t.N + 4 * (lane & 15);
#pragma unroll
    for (int i = 0; i < 8; ++i) { v[2 * i] = *(const f32x4*)(p + (size_t)(8 * i) * t.N); v[2 * i + 1] = *(const f32x4*)(p + (size_t)(8 * i + 1) * t.N); }
}
__device__ __forceinline__ void tr_finish(const TrItem& t, const f32x4 (&v)[16], LAS unsigned* scr, int lane) {
#pragma unroll
    for (int i = 0; i < 8; ++i) {
        const int kp = 4 * i + (lane >> 4); LAS unsigned* s = scr + kp * 65 + 4 * (lane & 15);
        s[0] = cvt_pk_bf16(v[2 * i][0], v[2 * i + 1][0]); s[1] = cvt_pk_bf16(v[2 * i][1], v[2 * i + 1][1]); s[2] = cvt_pk_bf16(v[2 * i][2], v[2 * i + 1][2]); s[3] = cvt_pk_bf16(v[2 * i][3], v[2 * i + 1][3]);
    }
    LDS_WAIT();
    const int c = lane & 7;
#pragma unroll
    for (int j = 0; j < 8; ++j) {
        const int n = (lane >> 3) + 8 * j; const LAS unsigned* s = scr + (4 * c) * 65 + n;
        *(u32x4*)(t.dst + (size_t)n * 1024 + 8 * c) = (u32x4){s[0], s[65], s[130], s[195]};
    }
    LDS_WAIT();
}
__device__ __forceinline__ int ilv_row(int c) { const int bj = c >> 10, r = c & 1023; return (r >> 7) * 256 + bj * 128 + (r & 127); }

__device__ __forceinline__ TrItem moe_item(const Args& a, int r, int layer) {
    TrItem t;
    if (r < 32 * 512) { const int mat = layer * 32 + (r >> 9), sub = r & 511, kb = sub >> 5, nb = sub & 31;
        t.src = a.in[I_W1] + (size_t)mat * 1024 * 2048 + (size_t)(kb * 64) * 2048 + nb * 64; t.dst = (bf16_t*)(a.ws + WS_W1) + (size_t)mat * 2048 * 1024 + (size_t)ilv_row(nb * 64) * 1024 + kb * 64; t.N = 2048; }
    else { r -= 32 * 512; const int mat = layer * 32 + (r >> 8), sub = r & 255, kb = sub >> 4, nb = sub & 15;
        t.src = a.in[I_W2] + (size_t)mat * 1024 * 1024 + (size_t)(kb * 64) * 1024 + nb * 64; t.dst = (bf16_t*)(a.ws + WS_W2) + (size_t)mat * 1024 * 1024 + (size_t)(nb * 64) * 1024 + kb * 64; t.N = 1024; }
    return t;
}
constexpr int P0_NWIN = 16 * 80, P0_NWOUT = 16 * 16, P0_NWGLU = 16 * 32, P0_NITEMS = P0_NWIN + P0_NWOUT + P0_NWGLU + 32 * 512 + 32 * 256;
__device__ __forceinline__ TrItem p0_item(const Args& a, int r) {
    TrItem t;
    if (r < P0_NWIN) { const int kb = r / 80, nb = r % 80; t.src = a.in[I_HGWIN] + (size_t)(kb * 64) * 5120 + nb * 64; t.dst = (bf16_t*)(a.ws + WS_WIN) + (size_t)(nb * 64) * 1024 + kb * 64; t.N = 5120; return t; } r -= P0_NWIN;
    if (r < P0_NWOUT) { const int kb = r / 16, nb = r % 16; t.src = a.in[I_HGWOUT] + (size_t)(kb * 64) * 1024 + nb * 64; t.dst = (bf16_t*)(a.ws + WS_WOUT) + (size_t)(nb * 64) * 1024 + kb * 64; t.N = 1024; return t; } r -= P0_NWOUT;
    if (r < P0_NWGLU) { const int kb = r / 32, nb = r % 32; t.src = a.in[I_S5WGLU] + (size_t)(kb * 64) * 2048 + nb * 64; t.dst = (bf16_t*)(a.ws + WS_WGLU) + (size_t)ilv_row(nb * 64) * 1024 + kb * 64; t.N = 2048; return t; } r -= P0_NWGLU;
    return moe_item(a, r, 0);
}
#define TR_LOOP(first, stride, count, ITEM) do { int _it = (first); if (_it < (count)) { f32x4 _va[16], _vb[16]; TrItem _A = ITEM(_it), _B = _A; tr_load(_A, _va, lane); \
        for (;;) { const int _i2 = _it + (stride); const bool _h2 = _i2 < (count); if (_h2) { _B = ITEM(_i2); tr_load(_B, _vb, lane); } tr_finish(_A, _va, scr, lane); if (!_h2) break; \
                   _it = _i2 + (stride); const bool _h1 = _it < (count); if (_h1) { _A = ITEM(_it); tr_load(_A, _va, lane); } tr_finish(_B, _vb, scr, lane); if (!_h1) break; } } } while (0)
__device__ __forceinline__ void p0_phase(const Args& a, LAS unsigned char* lds, int tid, int gw, int NGW) {
    const int lane = tid & 63, wave = tid >> 6;
    unsigned char* ws = a.ws;
    float* modv = (float*)(ws + WS_MODV);
    if (blockIdx.x < 192) {
        LAS float* SC = (LAS float*)lds;
        LAS float* PART = (LAS float*)(lds + 40960);
        for (int i = tid; i < 9 * 1024; i += NTHREADS) { const int r = i >> 10, k = i & 1023; const float v = r < 8 ? a.in[I_C][r * 1024 + k] : a.in[I_CCTX][k]; SC[i] = silu_f(v); }
        __syncthreads();
        const int layer = blockIdx.x / 96, ng = blockIdx.x % 96;
        const float* W = a.in[I_MODW] + (size_t)layer * 1024 * 6144 + ng * 64 + lane;
        float acc[9];
#pragma unroll
        for (int r = 0; r < 9; ++r) acc[r] = 0.f;
#pragma unroll 8
        for (int kk = 0; kk < 128; ++kk) {
            const int k = wave * 128 + kk; const float w = W[(size_t)k * 6144];
#pragma unroll
            for (int r = 0; r < 9; ++r) acc[r] += SC[r * 1024 + k] * w;
        }
#pragma unroll
        for (int r = 0; r < 9; ++r) PART[(wave * 9 + r) * 64 + lane] = acc[r];
        __syncthreads();
        for (int i = tid; i < 9 * 64; i += NTHREADS) {
            const int r = i >> 6, l = i & 63; float s = a.in[I_MODB][layer * 6144 + ng * 64 + l];
#pragma unroll
            for (int w = 0; w < 8; ++w) s += PART[(w * 9 + r) * 64 + l];
            modv[(size_t)(layer * 9 + r) * 6144 + ng * 64 + l] = s;
        }
        __syncthreads();
    } else if (blockIdx.x == 192) {
        float* lbv = (float*)(ws + WS_LBV);
        for (int i = tid; i < 2048; i += NTHREADS) { const float l0 = a.in[I_HGLB][i], l1 = a.in[I_HGLB][2048 + i]; lbv[i] = 1.0f / (1.0f + __expf(l1 - l0)); }
    }
    LAS unsigned* scr = (LAS unsigned*)(lds + 59392 + wave * 8320);
#define P0_ITEM(i) p0_item(a, (i))
    const int nfast = ((int)gridDim.x > 192) ? ((int)gridDim.x - 192) * 8 : 0, nextra = nfast * 3, n1 = P0_NITEMS - nextra;
    TR_LOOP(gw, NGW, n1, P0_ITEM);
    if (blockIdx.x >= 192) { TR_LOOP(n1 + (gw - 192 * 8), nfast, P0_NITEMS, P0_ITEM); }
#undef P0_ITEM
}

__device__ __forceinline__ const float* hin_row(const Args& a, int row) { return row < NCTX ? a.in[I_CTX] + (size_t)row * D : a.in[I_X] + (size_t)(row - NCTX) * D; }
__device__ __forceinline__ int mod_row(int row) { return row < NCTX ? 8 : ((row - NCTX) >> 12); }
__device__ __forceinline__ float row_rstd(const f32x4 (&v)[4]) {
    float s = 0.f;
#pragma unroll
    for (int j = 0; j < 4; ++j) s += (v[j][0] * v[j][0] + v[j][1] * v[j][1]) + (v[j][2] * v[j][2] + v[j][3] * v[j][3]);
    return 1.0f / sqrtf(wave_sum(s) * (1.0f / D) + EPS);
}
struct ModVec { f32x4 g[4], sc[4], sh[4]; };
__device__ __forceinline__ void modvec_load(ModVec& m, const float* g, const float* sc, const float* sh, int lane) {
#pragma unroll
    for (int j = 0; j < 4; ++j) { const int c = 4 * lane + 256 * j; m.g[j] = *(const f32x4*)(g + c); m.sc[j] = *(const f32x4*)(sc + c); m.sh[j] = *(const f32x4*)(sh + c); }
}
__device__ __forceinline__ void norm_mod_store(const f32x4 (&v)[4], float rstd, const ModVec& m, bf16_t* orow, int lane) {
#pragma unroll
    for (int j = 0; j < 4; ++j) st_bf16x4(orow + 4 * lane + 256 * j, v[j] * rstd * m.g[j] * (m.sc[j] + 1.0f) + m.sh[j]);
}

__device__ __forceinline__ void p1_phase(const Args& a, int lane, int gw, int NGW) {
    const float* modv = (const float*)(a.ws + WS_MODV);
    bf16_t* A = (bf16_t*)(a.ws + WS_A);
    for (int row0 = gw * 4; row0 < NTOK; row0 += NGW * 4) {
        f32x4 v[4][4];
#pragma unroll
        for (int r = 0; r < 4; ++r) { const float* hr = hin_row(a, row0 + r);
#pragma unroll
            for (int j = 0; j < 4; ++j) v[r][j] = *(const f32x4*)(hr + 4 * lane + 256 * j); }
        const float* mv = modv + (size_t)mod_row(row0) * 6144;
        ModVec m; modvec_load(m, a.in[I_N1G], mv + 1024, mv, lane);
#pragma unroll
        for (int r = 0; r < 4; ++r) { const float rstd = row_rstd(v[r]); norm_mod_store(v[r], rstd, m, A + (size_t)(row0 + r) * D, lane); }
    }
}

__device__ __forceinline__ int gla_row(int n, int t, int b, int dir) {
    const bool isctx = n < 4; const int cn = isctx ? n : n - 4, slen = isctx ? CTXL : SEQ, rbase = isctx ? b * CTXL : NCTX + b * SEQ;
    const int pos = cn * 64 + t; return rbase + (dir ? slen - 1 - pos : pos);
}
__device__ __forceinline__ void gla_phase(const Args& a, LAS unsigned char* lds, int tid) {
    const int lane = tid & 63, wave = tid >> 6, fr = lane & 15, fq = lane >> 4;
    LAS unsigned char* QS = lds;
    LAS unsigned char* KS = lds + 17408;
    LAS unsigned char* QIN = lds + 34816;
    LAS unsigned char* KOT = lds + 52224;
    LAS unsigned char* VT = lds + 70656;
    LAS unsigned char* ST0 = lds + 79872;
    LAS unsigned char* PPW = lds + 114688 + wave * 2304;
    LAS float* GT0 = (LAS float*)(lds + 133120);
    LAS float* BL = (LAS float*)(lds + 141312);
    const bf16_t* Qg = (const bf16_t*)(a.ws + WS_Q); const bf16_t* Vg = (const bf16_t*)(a.ws + WS_V);
    for (int item = blockIdx.x; item < 256; item += gridDim.x) {
        const int vs = item & 1, dir = (item >> 1) & 1, h = (item >> 2) & 7, b = item >> 5;
        const _Float16* LF = (const _Float16*)(a.ws + (dir ? WS_LFB : WS_LFF)); bf16_t* Og = (bf16_t*)(a.ws + (dir ? WS_OB : WS_OF));
        f32x4 Sacc[4];
#pragma unroll
        for (int i = 0; i < 4; ++i) Sacc[i] = (f32x4){0.f, 0.f, 0.f, 0.f};
        for (int i = tid; i < 2 * 17408 / 4; i += NTHREADS) ((LAS unsigned*)ST0)[i] = 0u;
        const int kc2 = (tid & 63) * 2, tg = tid >> 6, chq = h * 128 + kc2;
        const int vt_t = tid & 63, vt_v8 = (tid >> 6) * 8;
        unsigned lf2[8], q2[8]; u32x4 vv;
#define GLA_LOAD(n_) do { const unsigned o0_ = (unsigned)(gla_row(n_, tg * 8, b, dir) * D + chq) * 2u; const unsigned os_ = dir ? (unsigned)(-2 * D) : (unsigned)(2 * D); \
            _Pragma("unroll") for (int i = 0; i < 8; ++i) { const unsigned o = o0_ + (unsigned)i * os_; lf2[i] = *(const unsigned*)((const char*)LF + o); q2[i] = *(const unsigned*)((const char*)Qg + o); } \
            vv = *(const u32x4*)((const char*)Vg + (unsigned)(gla_row(n_, vt_t, b, dir) * D + h * 128 + vs * 64 + vt_v8) * 2u); } while (0)
        float fa[8], fb[8], bca[8], bcb[8];
#define GLA_CUMSUM(par_) do { float csa = 0.f, csb = 0.f; _Pragma("unroll") for (int i = 0; i < 8; ++i) { typedef _Float16 h2 __attribute__((ext_vector_type(2))); const h2 hv = __builtin_bit_cast(h2, lf2[i]); \
            const float la = (float)hv[0], lb_ = (float)hv[1]; fa[i] = __expf(la); fb[i] = __expf(lb_); csa += la; csb += lb_; bca[i] = csa; bcb[i] = csb; } \
            *(LAS f32x2*)(GT0 + (par_) * 1024 + tg * 128 + kc2) = (f32x2){csa, csb}; } while (0)
        GLA_LOAD(0);
        GLA_CUMSUM(0);
        __syncthreads();
        for (int n = 0; n < 68; ++n) {
            const int par = n & 1;
            LAS unsigned char* STc = ST0 + par * 17408; LAS unsigned char* STn = ST0 + (par ^ 1) * 17408;
            { const unsigned w[4] = {vv.x, vv.y, vv.z, vv.w};
#pragma unroll
              for (int i = 0; i < 4; ++i) { *(LAS bf16_t*)(VT + (vt_v8 + 2 * i) * 144 + vt_t * 2) = (bf16_t)(w[i] & 0xffffu); *(LAS bf16_t*)(VT + (vt_v8 + 2 * i + 1) * 144 + vt_t * 2) = (bf16_t)(w[i] >> 16); } }
#define GLA_OSTORE(n_) do { const u32x4 od = *(const LAS u32x4*)(PPW + (lane >> 2) * 144 + (lane & 3) * 16); \
                *(u32x4*)(Og + (size_t)gla_row(n_, (wave >> 1) * 16 + (lane >> 2), b, dir) * D + h * 128 + vs * 64 + (wave & 1) * 32 + (lane & 3) * 8) = od; } while (0)
            if (n > 0) GLA_OSTORE(n - 1);
            f32x2 pre = (f32x2){0.f, 0.f}, bref = (f32x2){0.f, 0.f}, blast = (f32x2){0.f, 0.f};
#pragma unroll
            for (int g8 = 0; g8 < 8; ++g8) { const f32x2 gv = *(const LAS f32x2*)(GT0 + par * 1024 + g8 * 128 + kc2); if (g8 < tg) pre += gv; if (g8 < 4) bref += gv; blast += gv; }
            const float era = __expf(bref.x), erb = __expf(bref.y), ela = __expf(blast.x - bref.x), elb = __expf(blast.y - bref.y);
            float e1a = __expf(pre.x - bref.x), e1b = __expf(pre.y - bref.y);
            unsigned kota[4], kotb[4];
#pragma unroll
            for (int i = 0; i < 8; ++i) {
                const int t = tg * 8 + i;
                const float qa = bflo(q2[i]), qb = bfhi(q2[i]);
                e1a *= fa[i]; e1b *= fb[i];
                const float ka = 1.0f - fa[i], kb = 1.0f - fb[i];
                const float e2a = __builtin_amdgcn_rcpf(e1a), e2b = __builtin_amdgcn_rcpf(e1b);
                const float qsa = qa * e1a, qsb = qb * e1b, ksa = ka * e2a, ksb = kb * e2b;
                *(LAS unsigned*)(QS + t * 272 + kc2 * 2) = cvt_pk_bf16(qsa, qsb);
                *(LAS unsigned*)(KS + t * 272 + kc2 * 2) = cvt_pk_bf16(ksa, ksb);
                *(LAS unsigned*)(QIN + t * 272 + kc2 * 2) = cvt_pk_bf16(qsa * era, qsb * erb);
                const unsigned ko = cvt_pk_bf16(ksa * ela, ksb * elb);
                if (i & 1) { kota[i >> 1] |= ko << 16; kotb[i >> 1] |= ko & 0xffff0000u; } else { kota[i >> 1] = ko & 0xffffu; kotb[i >> 1] = ko >> 16; }
            }
            { const int rot = ((kc2 >> 4) + tg) & 7;
              *(LAS u32x4*)(KOT + kc2 * 144 + rot * 16) = (u32x4){kota[0], kota[1], kota[2], kota[3]};
              *(LAS u32x4*)(KOT + (kc2 + 1) * 144 + rot * 16) = (u32x4){kotb[0], kotb[1], kotb[2], kotb[3]}; }
            if (tg == 0) *(LAS f32x2*)(BL + kc2) = (f32x2){__expf(blast.x), __expf(blast.y)};
            if (n + 1 < 68) GLA_LOAD(n + 1);
            __syncthreads();
            const int tt = wave >> 1;
            bf16x8 aq[4];
#pragma unroll
            for (int kk = 0; kk < 4; ++kk) aq[kk] = *(const LAS bf16x8*)(QS + (tt * 16 + fr) * 272 + (kk * 32 + fq * 8) * 2);
#pragma unroll
            for (int st = 0; st < 4; ++st) {
                f32x4 acc = (f32x4){0.f, 0.f, 0.f, 0.f};
                if (st <= tt) {
#pragma unroll
                    for (int kk = 0; kk < 4; ++kk) {
                        const bf16x8 bv = *(const LAS bf16x8*)(KS + (st * 16 + fr) * 272 + (kk * 32 + fq * 8) * 2);
                        acc = __builtin_amdgcn_mfma_f32_16x16x32_bf16(aq[kk], bv, acc, 0, 0, 0);
                    }
                }
#pragma unroll
                for (int j = 0; j < 4; ++j) { const int tl = fq * 4 + j, s = st * 16 + fr; *(LAS bf16_t*)(PPW + tl * 144 + s * 2) = (bf16_t)f2bf(s <= tt * 16 + tl ? acc[j] : 0.f); }
            }
            LDS_WAIT();
            unsigned ow[2][2];
            bf16x8 ap[2], ai[4];
#pragma unroll
            for (int kk = 0; kk < 2; ++kk) ap[kk] = *(const LAS bf16x8*)(PPW + fr * 144 + (kk * 32 + fq * 8) * 2);
#pragma unroll
            for (int kk = 0; kk < 4; ++kk) ai[kk] = *(const LAS bf16x8*)(QIN + (tt * 16 + fr) * 272 + (kk * 32 + fq * 8) * 2);
#pragma unroll
            for (int vti = 0; vti < 2; ++vti) {
                const int vt = 2 * (wave & 1) + vti; f32x4 acc = (f32x4){0.f, 0.f, 0.f, 0.f};
#pragma unroll
                for (int kk = 0; kk < 2; ++kk) {
                    const bf16x8 bv = *(const LAS bf16x8*)(VT + (vt * 16 + fr) * 144 + (kk * 32 + fq * 8) * 2);
                    acc = __builtin_amdgcn_mfma_f32_16x16x32_bf16(ap[kk], bv, acc, 0, 0, 0);
                }
#pragma unroll
                for (int kk = 0; kk < 4; ++kk) {
                    const bf16x8 bv = *(const LAS bf16x8*)(STc + (vt * 16 + fr) * 272 + (kk * 32 + fq * 8) * 2);
                    acc = __builtin_amdgcn_mfma_f32_16x16x32_bf16(ai[kk], bv, acc, 0, 0, 0);
                }
                ow[vti][0] = cvt_pk_bf16(acc[0], acc[1]); ow[vti][1] = cvt_pk_bf16(acc[2], acc[3]);
            }
#pragma unroll
            for (int vti = 0; vti < 2; ++vti)
#pragma unroll
                for (int j = 0; j < 4; ++j) { const unsigned w = ow[vti][j >> 1]; *(LAS bf16_t*)(PPW + (fq * 4 + j) * 144 + (vti * 16 + fr) * 2) = (bf16_t)((j & 1) ? (w >> 16) : (w & 0xffffu)); }
            bf16x8 ak[2]; const f32x4 blv = *(const LAS f32x4*)(BL + wave * 16 + fq * 4);
#pragma unroll
            for (int kk = 0; kk < 2; ++kk) ak[kk] = *(const LAS bf16x8*)(KOT + (wave * 16 + fr) * 144 + (((kk * 4 + fq) + wave) & 7) * 16);
#pragma unroll
            for (int vt = 0; vt < 4; ++vt) {
                Sacc[vt] *= blv;
#pragma unroll
                for (int kk = 0; kk < 2; ++kk) {
                    const bf16x8 bv = *(const LAS bf16x8*)(VT + (vt * 16 + fr) * 144 + (kk * 32 + fq * 8) * 2);
                    Sacc[vt] = __builtin_amdgcn_mfma_f32_16x16x32_bf16(ak[kk], bv, Sacc[vt], 0, 0, 0);
                }
                *(LAS u32x2*)(STn + (vt * 16 + fr) * 272 + (wave * 16 + fq * 4) * 2) = (u32x2){pk2(Sacc[vt][0], Sacc[vt][1]), pk2(Sacc[vt][2], Sacc[vt][3])};
            }
            if (n + 1 < 68) GLA_CUMSUM(par ^ 1);
            __syncthreads();
        }
        GLA_OSTORE(67);
    }
}
#undef GLA_OSTORE
#undef GLA_CUMSUM
#undef GLA_LOAD
__device__ __forceinline__ void gla_readout_phase(const Args& a, int lane, int gw, int NGW) {
    const bf16_t* OF = (const bf16_t*)(a.ws + WS_OF); const bf16_t* OB = (const bf16_t*)(a.ws + WS_OB);
    const bf16_t* G = (const bf16_t*)(a.ws + WS_G); bf16_t* OG = (bf16_t*)(a.ws + WS_OG);
    f32x4 ng[4];
#pragma unroll
    for (int j = 0; j < 4; ++j) ng[j] = *(const f32x4*)(a.in[I_HGNG] + 16 * lane + 4 * j);
    for (int row0 = gw * 4; row0 < NTOK; row0 += NGW * 4) {
        u32x4 of[4][2], ob[4][2], gg[4][2];
#pragma unroll
        for (int r = 0; r < 4; ++r) { const size_t o = (size_t)(row0 + r) * D + 16 * lane;
            of[r][0] = *(const u32x4*)(OF + o); of[r][1] = *(const u32x4*)(OF + o + 8); ob[r][0] = *(const u32x4*)(OB + o); ob[r][1] = *(const u32x4*)(OB + o + 8);
            gg[r][0] = *(const u32x4*)(G + o); gg[r][1] = *(const u32x4*)(G + o + 8); }
#pragma unroll
        for (int r = 0; r < 4; ++r) {
            float v[16]; float s = 0.f;
#pragma unroll
            for (int q = 0; q < 8; ++q) { const unsigned wf = of[r][q >> 2][q & 3], wb = ob[r][q >> 2][q & 3]; v[2 * q] = bflo(wf) + bflo(wb); v[2 * q + 1] = bfhi(wf) + bfhi(wb); s += v[2 * q] * v[2 * q] + v[2 * q + 1] * v[2 * q + 1]; }
            s += __shfl_xor(s, 1); s += __shfl_xor(s, 2); s += __shfl_xor(s, 4);
            const float rstd = 1.0f / sqrtf(s * (1.0f / 128.0f) + EPS);
            unsigned ow[8];
#pragma unroll
            for (int q = 0; q < 8; ++q) { const unsigned wg = gg[r][q >> 2][q & 3];
                ow[q] = pk2(v[2 * q] * rstd * ng[q >> 1][(2 * q) & 3] * silu_f(bflo(wg)), v[2 * q + 1] * rstd * ng[q >> 1][(2 * q + 1) & 3] * silu_f(bfhi(wg))); }
            const size_t o = (size_t)(row0 + r) * D + 16 * lane;
            *(u32x4*)(OG + o) = (u32x4){ow[0], ow[1], ow[2], ow[3]}; *(u32x4*)(OG + o + 8) = (u32x4){ow[4], ow[5], ow[6], ow[7]};
        }
    }
}

struct EpiMoe1 {
    static constexpr bool PERM = true;
    const float* b1; bf16_t* ACT;
    __device__ __forceinline__ void operator()(const f32x4 (&acc)[2][2][4][2], const Unit& u, int wr, int wc, int fr, int fq) const {
        const int e = u.pn >> 3, pnl = u.pn & 7, cb = pnl * 128 + wc * 32 + 8 * fq, row0 = u.pm * 256 + wr * 64 + fr;
        const float* bg = b1 + (size_t)e * 2048;
        f32x4 bg0 = *(const f32x4*)(bg + cb), bg1 = *(const f32x4*)(bg + cb + 4), bl0 = *(const f32x4*)(bg + 1024 + cb), bl1 = *(const f32x4*)(bg + 1024 + cb + 4);
        pin(bg0); pin(bg1); pin(bl0); pin(bl1);
#pragma unroll
        for (int ai = 0; ai < 2; ++ai)
#pragma unroll
            for (int m = 0; m < 4; ++m) {
                f32x4 o[2];
#pragma unroll
                for (int n = 0; n < 2; ++n) {
                    const f32x4 zg = acc[ai][0][m][n] + (n ? bg1 : bg0), zl = acc[ai][1][m][n] + (n ? bl1 : bl0);
#pragma unroll
                    for (int j = 0; j < 4; ++j) { const float g_ = fminf(zg[j], 7.0f), l_ = fminf(fmaxf(zl[j], -7.0f), 7.0f); o[n][j] = g_ * sigmoid_f(1.702f * g_) * (l_ + 1.0f); }
                }
                *(u32x4*)(ACT + (size_t)(row0 + ai * 128 + m * 16) * D + cb) = (u32x4){pk2(o[0][0], o[0][1]), pk2(o[0][2], o[0][3]), pk2(o[1][0], o[1][1]), pk2(o[1][2], o[1][3])};
            }
    }
};
struct EpiMoe2 {
    static constexpr bool PERM = true;
    const float* b2; bf16_t* YS;
    __device__ __forceinline__ void operator()(const f32x4 (&acc)[2][2][4][2], const Unit& u, int wr, int wc, int fr, int fq) const {
        const int e = u.pn >> 2, pnl = u.pn & 3, cb = pnl * 256 + wc * 32 + 8 * fq, row0 = u.pm * 256 + wr * 64 + fr;
        const float* bb = b2 + (size_t)e * 1024;
        f32x4 bvv[2][2];
#pragma unroll
        for (int bj = 0; bj < 2; ++bj) { bvv[bj][0] = *(const f32x4*)(bb + cb + bj * 128); bvv[bj][1] = *(const f32x4*)(bb + cb + bj * 128 + 4); }
#pragma unroll
        for (int bj = 0; bj < 2; ++bj) { pin(bvv[bj][0]); pin(bvv[bj][1]); }
#pragma unroll
        for (int bj = 0; bj < 2; ++bj) {
            const int c = cb + bj * 128; const f32x4 bv0 = bvv[bj][0], bv1 = bvv[bj][1];
#pragma unroll
            for (int ai = 0; ai < 2; ++ai)
#pragma unroll
                for (int m = 0; m < 4; ++m) {
                    const f32x4 v0 = acc[ai][bj][m][0] + bv0, v1 = acc[ai][bj][m][1] + bv1;
                    *(u32x4*)(YS + (size_t)(row0 + ai * 128 + m * 16) * D + c) = (u32x4){pk2(v0[0], v0[1]), pk2(v0[2], v0[3]), pk2(v1[0], v1[1]), pk2(v1[2], v1[3])};
                }
        }
    }
};

__device__ __forceinline__ void router_phase(const Args& a, LAS unsigned char* lds, int layer, int row_lo, int tid) {
    const int lane = tid & 63, wave = tid >> 6, fr = lane & 15, fq = lane >> 4;
    const bf16_t* H = (const bf16_t*)(a.ws + WS_H); bf16_t* F = (bf16_t*)(a.ws + WS_F);
    const float* modv = (const float*)(a.ws + WS_MODV) + (size_t)layer * 9 * 6144;
    int* TOKE = (int*)(a.ws + WS_TOKE); float* TOKW = (float*)(a.ws + WS_TOKW);
    unsigned* cntb = (unsigned*)(a.ws + WS_CTL) + CW_CNTB + layer * 8192;
    LAS unsigned char* FH = lds;
    LAS unsigned char* FL = lds + 16 * 2064;
    LAS float* PART = (LAS float*)(lds + 2 * 16 * 2064);
    LAS int* hist = (LAS int*)(lds + 2 * 16 * 2064 + 16384);
    if (tid < 32) hist[tid] = 0;
    const float* n2g = a.in[I_N2G] + layer * D; const float* rw = a.in[I_RW] + (size_t)layer * D * NE; const float* rb = a.in[I_RB] + layer * NE;
    const float* rwp = rw + (size_t)(wave * 128 + fq * 8) * NE + fr;
    bf16x8 rwH[2][4], rwL[2][4];
#pragma unroll
    for (int kk = 0; kk < 4; ++kk) {
#pragma unroll
        for (int et = 0; et < 2; ++et)
#pragma unroll
            for (int j = 0; j < 8; ++j) {
                const float w = rwp[kk * 32 * NE + j * NE + et * 16];
                const unsigned h = f2bf(w); const float lo = w - bf2f((unsigned short)h);
                rwH[et][kk][j] = (short)h; rwL[et][kk][j] = (short)f2bf(lo);
            }
        asm volatile("" ::: "memory");
    }
    const int ngroups = (NTOK - row_lo) >> 4;
    u32x2 vvp[2][4]; f32x4 gvv[4], scvv[4], shvv[4];
#pragma unroll
    for (int j = 0; j < 4; ++j) gvv[j] = *(const f32x4*)(n2g + 4 * lane + 256 * j);
#define RT_LOAD(gi_) do { _Pragma("unroll") for (int rr = 0; rr < 2; ++rr) _Pragma("unroll") for (int j = 0; j < 4; ++j) \
        vvp[rr][j] = *(const u32x2*)(H + (size_t)(row_lo + (gi_) * 16 + 2 * wave + rr) * D + 4 * lane + 256 * j); \
        { const float* mvp_ = modv + (size_t)mod_row(row_lo + (gi_) * 16) * 6144; _Pragma("unroll") for (int j = 0; j < 4; ++j) { scvv[j] = *(const f32x4*)(mvp_ + 4096 + 4 * lane + 256 * j); shvv[j] = *(const f32x4*)(mvp_ + 3072 + 4 * lane + 256 * j); } } } while (0)
    if ((int)blockIdx.x < ngroups) RT_LOAD(blockIdx.x);
    int pend_i = 0; float pend_w = 0.f; long pend_o = -1;
    for (int gi = blockIdx.x; gi < ngroups; gi += gridDim.x) {
        const int row0 = row_lo + gi * 16;
        __syncthreads();
#pragma unroll
        for (int rr = 0; rr < 2; ++rr) {
            const int rl = 2 * wave + rr, row = row0 + rl; f32x4 v[4];
#pragma unroll
            for (int j = 0; j < 4; ++j) { const u32x2 w = vvp[rr][j]; v[j] = (f32x4){bflo(w.x), bfhi(w.x), bflo(w.y), bfhi(w.y)}; }
            const float rstd = row_rstd(v);
#pragma unroll
            for (int j = 0; j < 4; ++j) {
                const int c = 4 * lane + 256 * j;
                const f32x4 f = v[j] * rstd * gvv[j] * (scvv[j] + 1.0f) + shvv[j];
                st_bf16x4(F + (size_t)row * D + c, f);
                { const unsigned h01 = cvt_pk_bf16(f[0], f[1]), h23 = cvt_pk_bf16(f[2], f[3]);
                  *(LAS u32x2*)(FH + rl * 2064 + c * 2) = (u32x2){h01, h23};
                  *(LAS u32x2*)(FL + rl * 2064 + c * 2) = (u32x2){cvt_pk_bf16(f[0] - bflo(h01), f[1] - bfhi(h01)), cvt_pk_bf16(f[2] - bflo(h23), f[3] - bfhi(h23))}; }
            }
        }
        if (pend_o >= 0) { TOKE[pend_o] = pend_i; TOKW[pend_o] = pend_w; pend_o = -1; }
        if (gi + (int)gridDim.x < ngroups) RT_LOAD(gi + gridDim.x);
        __syncthreads();
        f32x4 acc0 = (f32x4){0.f, 0.f, 0.f, 0.f}, acc1 = (f32x4){0.f, 0.f, 0.f, 0.f};
        bf16x8 aH[4], aL[4];
#pragma unroll
        for (int kk = 0; kk < 4; ++kk) { aH[kk] = *(const LAS bf16x8*)(FH + fr * 2064 + (wave * 128 + kk * 32 + fq * 8) * 2); aL[kk] = *(const LAS bf16x8*)(FL + fr * 2064 + (wave * 128 + kk * 32 + fq * 8) * 2); }
#pragma unroll
        for (int kk = 0; kk < 4; ++kk) {
            acc0 = __builtin_amdgcn_mfma_f32_16x16x32_bf16(aL[kk], rwH[0][kk], acc0, 0, 0, 0); acc1 = __builtin_amdgcn_mfma_f32_16x16x32_bf16(aL[kk], rwH[1][kk], acc1, 0, 0, 0);
            acc0 = __builtin_amdgcn_mfma_f32_16x16x32_bf16(aH[kk], rwL[0][kk], acc0, 0, 0, 0); acc1 = __builtin_amdgcn_mfma_f32_16x16x32_bf16(aH[kk], rwL[1][kk], acc1, 0, 0, 0);
            acc0 = __builtin_amdgcn_mfma_f32_16x16x32_bf16(aH[kk], rwH[0][kk], acc0, 0, 0, 0); acc1 = __builtin_amdgcn_mfma_f32_16x16x32_bf16(aH[kk], rwH[1][kk], acc1, 0, 0, 0);
        }
#pragma unroll
        for (int j = 0; j < 4; ++j) { PART[(wave * 16 + fq * 4 + j) * 32 + fr] = acc0[j]; PART[(wave * 16 + fq * 4 + j) * 32 + 16 + fr] = acc1[j]; }
        __syncthreads();
        {
            const int half = lane >> 5, e = lane & 31, rl = 2 * wave + half, row = row0 + rl;
            float lg = rb[e];
#pragma unroll
            for (int w = 0; w < 8; ++w) lg += PART[(w * 16 + rl) * 32 + e];
            float sv[4]; int si[4];
#pragma unroll
            for (int r = 0; r < 4; ++r) {
                float m = lg;
#pragma unroll
                for (int o = 1; o < 32; o <<= 1) m = fmaxf(m, __shfl_xor(m, o));
                const unsigned long long bal = __ballot(lg == m); const unsigned mine = (unsigned)(bal >> (32 * half));
                const int idx = __ffs((int)mine) - 1;
                sv[r] = m; si[r] = idx; if (e == idx) lg = -3.0e38f;
            }
            const float e1 = __expf(sv[1] - sv[0]), e2 = __expf(sv[2] - sv[0]), e3 = __expf(sv[3] - sv[0]); const float inv = 1.0f / (1.0f + e1 + e2 + e3);
            if (e < 4) {
                const int myi = e == 0 ? si[0] : (e == 1 ? si[1] : (e == 2 ? si[2] : si[3]));
                const float myw = (e == 0 ? 1.0f : (e == 1 ? e1 : (e == 2 ? e2 : e3))) * inv;
                pend_i = myi; pend_w = myw; pend_o = (long)row * 4 + e;
                atomicAdd((int*)hist + myi, 1);
            }
        }
    }
    if (pend_o >= 0) { TOKE[pend_o] = pend_i; TOKW[pend_o] = pend_w; }
    __syncthreads();
    if (tid < 32) cntb[(size_t)blockIdx.x * 32 + tid] = (unsigned)hist[tid];
}
#undef RT_LOAD
__device__ __forceinline__ void assign_phase(const Args& a, LAS unsigned char* lds, int layer, int row_lo, int tid) {
    const int lane = tid & 63, wave = tid >> 6;
    const unsigned* cntb = (const unsigned*)(a.ws + WS_CTL) + CW_CNTB + layer * 8192; unsigned* gcnt = (unsigned*)(a.ws + WS_CTL) + CW_CNT + layer * 64;
    const bf16_t* F = (const bf16_t*)(a.ws + WS_F); bf16_t* AG = (bf16_t*)(a.ws + WS_AG);
    const int* TOKE = (const int*)(a.ws + WS_TOKE); int* TOKS = (int*)(a.ws + WS_TOKS);
    LAS int* off = (LAS int*)lds; LAS int* cnt = (LAS int*)(lds + 256); LAS int* base = (LAS int*)(lds + 512); LAS int* cur = (LAS int*)(lds + 768);
    LAS int* pa = (LAS int*)(lds + 1024); LAS int* pl = (LAS int*)(lds + 1024 + 2048);
    {
        const int e = tid & 31, part = tid >> 5; int s_all = 0, s_lt = 0;
        for (int bb = part; bb < (int)gridDim.x; bb += 16) { const int c = (int)cntb[(size_t)bb * 32 + e]; s_all += c; if (bb < (int)blockIdx.x) s_lt += c; }
        pa[part * 32 + e] = s_all; pl[part * 32 + e] = s_lt;
    }
    __syncthreads();
    if (tid < 32) { int s_all = 0, s_lt = 0; for (int p = 0; p < 16; ++p) { s_all += pa[p * 32 + tid]; s_lt += pl[p * 32 + tid]; } cnt[tid] = s_all; base[tid] = s_lt; cur[tid] = 0; if (blockIdx.x == 0) gcnt[tid] = (unsigned)s_all; }
    __syncthreads();
    if (tid == 0) { int o = 0; for (int e = 0; e < 32; ++e) { off[e] = o; o += ((cnt[e] + 255) >> 8) << 8; } }
    __syncthreads();
    if (tid < 32) base[tid] += off[tid];
    __syncthreads();
    const int gw = blockIdx.x * 8 + wave, NGW = gridDim.x * 8;
    int* SLOTTOK = (int*)(a.ws + WS_SLOTTOK);
    for (int idx = blockIdx.x * NTHREADS + tid; idx < 32 * 256; idx += gridDim.x * NTHREADS) {
        const int e = idx >> 8, c = cnt[e], r = c + (idx & 255), padded = ((c + 255) >> 8) << 8;
        if (r < padded) SLOTTOK[off[e] + r] = 0;
    }
    const int ngroups = (NTOK - row_lo) >> 4;
    for (int gi = blockIdx.x; gi < ngroups; gi += gridDim.x) {
        const int r0 = row_lo + gi * 16 + 2 * wave;
        if (lane < 8) { const int e = TOKE[(size_t)r0 * 4 + lane]; const int pos = atomicAdd((int*)cur + e, 1); const int slot = base[e] + pos; TOKS[(size_t)r0 * 4 + lane] = slot; SLOTTOK[slot] = r0 + (lane >> 2); }
    }
    (void)gw; (void)NGW; (void)F; (void)AG;
}
__device__ __forceinline__ int moe_tiles(const Args& a, LAS unsigned char* lds, int layer, int tid) {
    const unsigned* gcnt = (const unsigned*)(a.ws + WS_CTL) + CW_CNT + layer * 64;
    LAS int* tbl = (LAS int*)(lds + 131072 + 1024);
    if (tid == 0) { int t = 0; for (int e = 0; e < 32; ++e) { const int nt = ((int)gcnt[e] + 255) >> 8; for (int k = 0; k < nt; ++k) tbl[t++] = e; } tbl[1000] = t; }
    __syncthreads();
    return tbl[1000];
}
__device__ __forceinline__ void combine_phase(const Args& a, int layer, int row_lo, int lane, int gw, int NGW) {
    bf16_t* H = (bf16_t*)(a.ws + WS_H); const bf16_t* YS = (const bf16_t*)(a.ws + WS_YS);
    const int* TOKS = (const int*)(a.ws + WS_TOKS); const float* TOKW = (const float*)(a.ws + WS_TOKW);
    const float* modv = (const float*)(a.ws + WS_MODV);
    for (int row0 = row_lo + gw * 2; row0 < NTOK; row0 += NGW * 2) {
        const int mr = mod_row(row0);
        u32x4 sl[2]; f32x4 wv[2];
#pragma unroll
        for (int r = 0; r < 2; ++r) { sl[r] = *(const u32x4*)(TOKS + (size_t)(row0 + r) * 4); wv[r] = *(const f32x4*)(TOKW + (size_t)(row0 + r) * 4); }
        u32x2 ys[2][4][4]; f32x4 hv[2][4];
#pragma unroll
        for (int r = 0; r < 2; ++r)
#pragma unroll
            for (int j = 0; j < 4; ++j) {
                hv[r][j] = ld_bf16x4(H + (size_t)(row0 + r) * D + 4 * lane + 256 * j);
#pragma unroll
                for (int k = 0; k < 4; ++k) ys[r][k][j] = *(const u32x2*)(YS + (size_t)sl[r][k] * D + 4 * lane + 256 * j);
            }
        const float* g2 = modv + (size_t)(layer * 9 + mr) * 6144 + 5120;
        f32x4 g2v[4];
#pragma unroll
        for (int j = 0; j < 4; ++j) g2v[j] = *(const f32x4*)(g2 + 4 * lane + 256 * j);
        ModVec m;
        if (layer == 0) { const float* mv = modv + (size_t)(9 + mr) * 6144; modvec_load(m, a.in[I_N1G] + D, mv + 1024, mv, lane); }
        else {
#pragma unroll
            for (int j = 0; j < 4; ++j) m.g[j] = *(const f32x4*)(a.in[I_FG] + 4 * lane + 256 * j);
        }
#pragma unroll
        for (int r = 0; r < 2; ++r) {
            const int row = row0 + r; f32x4 v[4];
#pragma unroll
            for (int j = 0; j < 4; ++j) {
                const int c = 4 * lane + 256 * j; f32x4 y = (f32x4){0.f, 0.f, 0.f, 0.f};
#pragma unroll
                for (int k = 0; k < 4; ++k) { const u32x2 w = ys[r][k][j]; y += (f32x4){bflo(w.x), bfhi(w.x), bflo(w.y), bfhi(w.y)} * wv[r][k]; }
                v[j] = hv[r][j] + g2v[j] * y;
                if (layer == 0) st_bf16x4(H + (size_t)row * D + c, v[j]);
            }
            const float rstd = row_rstd(v);
            if (layer == 0) {
                int orow = row;
                if (row >= NCTX) { const int li = row - NCTX, b = li >> 12, t = li & 4095; orow = NCTX + b * SEQ + (t & 63) * 64 + (t >> 6); }
                norm_mod_store(v, rstd, m, (bf16_t*)(a.ws + WS_A) + (size_t)orow * D, lane);
            } else {
#pragma unroll
                for (int j = 0; j < 4; ++j) { const int c = 4 * lane + 256 * j; *(f32x4*)(a.out + (size_t)(row - NCTX) * D + c) = v[j] * rstd * m.g[j]; }
            }
        }
    }
}
__device__ __forceinline__ void moe_gemm1(const Args& a, LAS unsigned char* lds, int layer, int tid, int G, int vcu) {
    unsigned char* ws = a.ws;
    const int TT = moe_tiles(a, lds, layer, tid);
    const LAS int* tbl = (const LAS int*)(lds + 131072 + 1024);
    pg8::Gemm g{(const bf16_t*)(ws + WS_F), (const bf16_t*)(ws + WS_W1) + (size_t)layer * 32 * 2048 * 1024, MPAD, 32 * 2048, 1024};
    pg8::MoeOrder S{tbl, TT, 3, G, vcu};
    EpiMoe1 E{a.in[I_B1] + (size_t)layer * 32 * 2048, (bf16_t*)(ws + WS_ACT)};
    LAS unsigned short* rowl = (LAS unsigned short*)(lds + 136192);
    { const int* slottok = (const int*)(ws + WS_SLOTTOK); pg8::Unit uu; int t2 = threadIdx.x; asm volatile("" : "+v"(t2)); const int tid = t2;
      for (int i = 0; i < 21; i += 2) { const int ii = i + (tid >> 8); if (ii < 21 && S.next(ii, uu)) rowl[ii * 256 + (tid & 255)] = (unsigned short)slottok[uu.pm * 256 + (tid & 255)]; } }
    __syncthreads();
    pg8::gemm_phase<EpiMoe1, pg8::MoeOrder, true>(lds, g, S, E, rowl);
}
__device__ __forceinline__ void moe_gemm2(const Args& a, LAS unsigned char* lds, int layer, int tid, int G, int vcu) {
    unsigned char* ws = a.ws;
    const int TT = moe_tiles(a, lds, layer, tid);
    const LAS int* tbl = (const LAS int*)(lds + 131072 + 1024);
    pg8::Gemm g{(const bf16_t*)(ws + WS_ACT), (const bf16_t*)(ws + WS_W2) + (size_t)layer * 32 * 1024 * 1024, MPAD, 32 * 1024, 1024};
    pg8::MoeOrder S{tbl, TT, 2, G, vcu};
    EpiMoe2 E{a.in[I_B2] + (size_t)layer * 32 * 1024, (bf16_t*)(ws + WS_YS)};
    pg8::gemm_phase<EpiMoe2, pg8::MoeOrder>(lds, g, S, E);
}


__device__ __forceinline__ void s5_disc(const Args& a, int d, int g, int p, float& ab_re, float& ab_im, float& co_re, float& co_im) {
    const float lam_re = fminf(a.in[I_S5ARE][(d * 64 + g) * 64 + p], -1e-4f), lam_im = a.in[I_S5AIM][(d * 64 + g) * 64 + p];
    const float dt = expf(a.in[I_S5LDT][d * 64 + g]);
    const float mag = expf(lam_re * dt), ang = lam_im * dt;
    ab_re = mag * cosf(ang); ab_im = mag * sinf(ang);
    const float den = lam_re * lam_re + lam_im * lam_im;
    co_re = ((ab_re - 1.0f) * lam_re + ab_im * lam_im) / den;
    co_im = (ab_im * lam_re - (ab_re - 1.0f) * lam_im) / den;
}
__device__ __forceinline__ void s5_phase(const Args& a, LAS unsigned char* lds, int tid) {
    const int lane = tid & 63, wave = tid >> 6, fr = lane & 15, fq = lane >> 4;
    if (wave >= 4) {
        LAS unsigned* scr = (LAS unsigned*)(lds + 104448 + (wave - 4) * 8320);
        const int cw = blockIdx.x * 4 + (wave - 4), NCW = gridDim.x * 4;
#define L1_ITEM(i) moe_item(a, (i), 1)
        TR_LOOP(cw, NCW, 32 * 512 + 32 * 256, L1_ITEM);
#undef L1_ITEM
        return;
    }
    LAS unsigned char* wl = lds + wave * 26112;
    const bf16_t* A1 = (const bf16_t*)(a.ws + WS_A);
    for (int item = blockIdx.x; item < 256; item += gridDim.x) {
        const int b = item >> 5, dir = (item >> 4) & 1, g = (item & 15) * 4 + wave;
        bf16_t* Y = (bf16_t*)(a.ws + (dir ? WS_YB : WS_YF));
        float ab_re, ab_im, cr_, ci_;
        s5_disc(a, dir, g, lane, ab_re, ab_im, cr_, ci_);
        bf16x8 Bd[4], Cf[4];
        {
            f32x4 cre[4], cim[4];
#pragma unroll
            for (int kk = 0; kk < 4; ++kk) { const size_t o = ((size_t)(dir * 64 + g) * 16 + fr) * 64 + kk * 16 + fq * 4; cre[kk] = *(const f32x4*)(a.in[I_S5CRE] + o); cim[kk] = *(const f32x4*)(a.in[I_S5CIM] + o); }
#pragma unroll
            for (int kk = 0; kk < 4; ++kk)
#pragma unroll
                for (int j = 0; j < 8; ++j) Cf[kk][j] = (short)f2bf((j & 1) ? -cim[kk][j >> 1] : cre[kk][j >> 1]);
            {
                const int c31 = lane & 31, h5 = lane >> 5;
                f32x4 br0[4], br1[4], bi0[4], bi1[4];
#pragma unroll
                for (int ct = 0; ct < 4; ++ct) {
                    const int pp = ct * 16 + (c31 >> 1); const size_t o = (size_t)(g * 64 + pp) * 16 + h5 * 8;
                    br0[ct] = *(const f32x4*)(a.in[I_S5BRE] + o); br1[ct] = *(const f32x4*)(a.in[I_S5BRE] + o + 4); bi0[ct] = *(const f32x4*)(a.in[I_S5BIM] + o); bi1[ct] = *(const f32x4*)(a.in[I_S5BIM] + o + 4);
                }
#pragma unroll
                for (int ct = 0; ct < 4; ++ct) {
                    const int pp = ct * 16 + (c31 >> 1); const float qr = __shfl(cr_, pp), qi = __shfl(ci_, pp);
#pragma unroll
                    for (int j = 0; j < 8; ++j) {
                        const float br = j < 4 ? br0[ct][j & 3] : br1[ct][j & 3], bi = j < 4 ? bi0[ct][j & 3] : bi1[ct][j & 3];
                        Bd[ct][j] = (short)f2bf((c31 & 1) ? (qr * bi + qi * br) : (qr * br - qi * bi));
                    }
                }
            }
        }
#define S5_POS(n_, t_) ((((n_) < 8) ? (n_) : (n_) - 8) * 32 + (t_))
#define S5_ROW(n_, t_) ((((n_) < 8) ? b * CTXL : NCTX + b * SEQ) + (dir ? (((n_) < 8) ? CTXL : SEQ) - 1 - S5_POS(n_, t_) : S5_POS(n_, t_)))
#define S5_LOADU(d0, n_) do { d0 = (bf16x8){0, 0, 0, 0, 0, 0, 0, 0}; if ((n_) < 136) d0 = *(const bf16x8*)(A1 + (size_t)S5_ROW(n_, lane & 31) * D + g * 16 + (lane >> 5) * 8); } while (0)
        LAS float* BUF = (LAS float*)wl; LAS unsigned* HW = (LAS unsigned*)(wl + 17408); const LAS unsigned char* HP = wl + 17408;
        bf16x8 ua0, ub0, uc0;
        S5_LOADU(ua0, 0); S5_LOADU(ub0, 1);
        f32x2 s = (f32x2){0.f, 0.f};
        const f32x2 abr = (f32x2){ab_re, ab_re}, abi = (f32x2){-ab_im, ab_im};
        bf16_t* yp = Y + (size_t)(b * SEQ + (dir ? SEQ - 1 - fq * 4 : fq * 4)) * D + g * 16 + fr;
        const long ystep = dir ? -(long)D : (long)D;
        unsigned yw[4] = {0u, 0u, 0u, 0u};
#define S5_YSTORE() do { yp[0] = (bf16_t)(yw[0] & 0xffffu); yp[ystep] = (bf16_t)(yw[0] >> 16); yp[2 * ystep] = (bf16_t)(yw[1] & 0xffffu); yp[3 * ystep] = (bf16_t)(yw[1] >> 16); \
            yp[16 * ystep] = (bf16_t)(yw[2] & 0xffffu); yp[17 * ystep] = (bf16_t)(yw[2] >> 16); yp[18 * ystep] = (bf16_t)(yw[3] & 0xffffu); yp[19 * ystep] = (bf16_t)(yw[3] >> 16); yp += 32 * ystep; } while (0)
        for (int n = 0; n < 136; ++n) {
#pragma unroll
            for (int ct = 0; ct < 4; ++ct) {
                typedef float f32x16 __attribute__((ext_vector_type(16)));
                f32x16 z; for (int r = 0; r < 16; ++r) z[r] = 0.f;
                const f32x16 d = __builtin_amdgcn_mfma_f32_32x32x16_bf16(Bd[ct], ua0, z, 0, 0, 0);
#pragma unroll
                for (int q = 0; q < 4; ++q) *(LAS f32x4*)(BUF + (lane & 31) * 132 + ct * 32 + 8 * q + 4 * (lane >> 5)) = (f32x4){d[4 * q], d[4 * q + 1], d[4 * q + 2], d[4 * q + 3]};
            }
            if (n >= 9) S5_YSTORE();
            S5_LOADU(uc0, n + 2);
            LDS_WAIT();
            {
                const bool hist = n >= 8;
                f32x2 bu[32];
#pragma unroll
                for (int j = 0; j < 32; ++j) bu[j] = *(const LAS f32x2*)(BUF + j * 132 + 2 * lane);
                unsigned hw[32];
#pragma unroll
                for (int j = 0; j < 32; ++j) { const f32x2 t1 = abr * s + bu[j]; s = abi * (f32x2){s.y, s.x} + t1; hw[j] = cvt_pk_bf16(s.x, s.y); }
                if (hist) {
#pragma unroll
                    for (int j = 0; j < 32; ++j) HW[j * 68 + lane] = hw[j];
                }
            }
            LDS_WAIT();
            if (n >= 8) {
                f32x4 y0 = (f32x4){0.f, 0.f, 0.f, 0.f}, y1 = (f32x4){0.f, 0.f, 0.f, 0.f};
                bf16x8 ha[2][4];
#pragma unroll
                for (int hf = 0; hf < 2; ++hf)
#pragma unroll
                    for (int kk = 0; kk < 4; ++kk) ha[hf][kk] = *(const LAS bf16x8*)(HP + (hf * 16 + fr) * 272 + (kk * 32 + fq * 8) * 2);
#pragma unroll
                for (int kk = 0; kk < 4; ++kk) { y0 = __builtin_amdgcn_mfma_f32_16x16x32_bf16(ha[0][kk], Cf[kk], y0, 0, 0, 0); y1 = __builtin_amdgcn_mfma_f32_16x16x32_bf16(ha[1][kk], Cf[kk], y1, 0, 0, 0); }
                yw[0] = cvt_pk_bf16(y0[0], y0[1]); yw[1] = cvt_pk_bf16(y0[2], y0[3]); yw[2] = cvt_pk_bf16(y1[0], y1[1]); yw[3] = cvt_pk_bf16(y1[2], y1[3]);
                LDS_WAIT();
            }
            ua0 = ub0; ub0 = uc0;
        }
        S5_YSTORE();
#undef S5_YSTORE
#undef S5_POS
#undef S5_ROW
#undef S5_LOADU
    }
}
__device__ __forceinline__ float gelu_tanh_f(float x) { const float z = 0.7978845608f * (x + 0.044715f * x * x * x); return x * (1.0f - __builtin_amdgcn_rcpf(1.0f + __expf(2.0f * z))); }
__device__ __forceinline__ void s5_post_phase(const Args& a, int lane, int gw, int NGW) {
    const bf16_t* YF = (const bf16_t*)(a.ws + WS_YF); const bf16_t* YB = (const bf16_t*)(a.ws + WS_YB);
    const bf16_t* A1 = (const bf16_t*)(a.ws + WS_A); bf16_t* YG = (bf16_t*)(a.ws + WS_YG);
    f32x4 dk[4];
#pragma unroll
    for (int j = 0; j < 4; ++j) dk[j] = *(const f32x4*)(a.in[I_S5D] + 4 * lane + 256 * j);
    for (int tok0 = gw * 4; tok0 < NLAT; tok0 += NGW * 4) {
        u32x2 yf[4][4], yb[4][4], uu[4][4];
#pragma unroll
        for (int r = 0; r < 4; ++r) { const int tok = tok0 + r, b = tok >> 12, t = tok & 4095, src = b * SEQ + (t & 63) * 64 + (t >> 6);
#pragma unroll
            for (int j = 0; j < 4; ++j) { const int c = 4 * lane + 256 * j; yf[r][j] = *(const u32x2*)(YF + (size_t)src * D + c); yb[r][j] = *(const u32x2*)(YB + (size_t)src * D + c); uu[r][j] = *(const u32x2*)(A1 + (size_t)(NCTX + src) * D + c); } }
#pragma unroll
        for (int r = 0; r < 4; ++r)
#pragma unroll
            for (int j = 0; j < 4; ++j) {
                const u32x2 f = yf[r][j], bk = yb[r][j], uw = uu[r][j];
                const f32x4 y = (f32x4){bflo(f.x) + bflo(bk.x), bfhi(f.x) + bfhi(bk.x), bflo(f.y) + bflo(bk.y), bfhi(f.y) + bfhi(bk.y)} + dk[j] * (f32x4){bflo(uw.x), bfhi(uw.x), bflo(uw.y), bfhi(uw.y)};
                f32x4 o;
#pragma unroll
                for (int i = 0; i < 4; ++i) o[i] = gelu_tanh_f(y[i]);
                st_bf16x4(YG + (size_t)(tok0 + r) * D + 4 * lane + 256 * j, o);
            }
    }
}
struct EpiGlu {
    static constexpr bool PERM = true;
    const float* bglu; const float* modv1; bf16_t* H;
    __device__ __forceinline__ void operator()(const f32x4 (&acc)[2][2][4][2], const Unit& u, int wr, int wc, int fr, int fq) const {
        const int rt0 = u.pm * 256, bidx = rt0 >> 12, cb = u.pn * 128 + wc * 32 + 8 * fq, rl0 = wr * 64 + fr;
        const float* gp = modv1 + bidx * 6144 + 2048;
        f32x4 ba0 = *(const f32x4*)(bglu + cb), ba1 = *(const f32x4*)(bglu + cb + 4), bb0 = *(const f32x4*)(bglu + 1024 + cb), bb1 = *(const f32x4*)(bglu + 1024 + cb + 4);
        f32x4 gv0 = *(const f32x4*)(gp + cb), gv1 = *(const f32x4*)(gp + cb + 4);
        pin(ba0); pin(ba1); pin(bb0); pin(bb1); pin(gv0); pin(gv1);
        u32x4 hws[2][4];
#pragma unroll
        for (int ai = 0; ai < 2; ++ai)
#pragma unroll
            for (int m = 0; m < 4; ++m) hws[ai][m] = *(const u32x4*)(H + (size_t)(NCTX + rt0 + rl0 + ai * 128 + m * 16) * D + cb);
#pragma unroll
        for (int ai = 0; ai < 2; ++ai)
#pragma unroll
            for (int m = 0; m < 4; ++m) {
                bf16_t* hp = H + (size_t)(NCTX + rt0 + rl0 + ai * 128 + m * 16) * D + cb;
                const u32x4 hw = hws[ai][m]; const f32x4 h0 = (f32x4){bflo(hw.x), bfhi(hw.x), bflo(hw.y), bfhi(hw.y)}, h1 = (f32x4){bflo(hw.z), bfhi(hw.z), bflo(hw.w), bfhi(hw.w)};
                const f32x4 za0 = acc[ai][0][m][0] + ba0, za1 = acc[ai][0][m][1] + ba1, zb0 = acc[ai][1][m][0] + bb0, zb1 = acc[ai][1][m][1] + bb1; f32x4 o0, o1;
#pragma unroll
                for (int j = 0; j < 4; ++j) { o0[j] = za0[j] * sigmoid_f(zb0[j]); o1[j] = za1[j] * sigmoid_f(zb1[j]); }
                const f32x4 r0 = h0 + gv0 * o0, r1 = h1 + gv1 * o1;
                *(u32x4*)hp = (u32x4){pk2(r0[0], r0[1]), pk2(r0[2], r0[3]), pk2(r1[0], r1[1]), pk2(r1[2], r1[3])};
            }
    }
};

#define XB_TMO      128
#define XB_XCNT(j)  (256  + 64 * (j))
#define XB_XSUB(j)  (1280 + 64 * (j))
#define XB_XGEN(j)  (2304 + 64 * (j))
#define XB_TOP      3328
#define XB_TOPGEN   3392
#define XCD_BAR_WORDS 3456
#define XB_SPIN_CAP (1u << 18)
__device__ __forceinline__ unsigned xb_ld(unsigned* p)              { return __hip_atomic_load(p, __ATOMIC_RELAXED, __HIP_MEMORY_SCOPE_AGENT); }
__device__ __forceinline__ unsigned xb_add(unsigned* p, unsigned v) { return __hip_atomic_fetch_add(p, v, __ATOMIC_RELAXED, __HIP_MEMORY_SCOPE_AGENT); }
__device__ __forceinline__ unsigned xb_xcc_id() { return (unsigned)__builtin_amdgcn_s_getreg((3 << 11) | 20) & 0xFu; }
#define XB_SPIN(cond, bar) do { unsigned _sp = 0; while (cond) { __builtin_amdgcn_s_sleep(1); \
    if ((++_sp & 255u) == 0u) { if (xb_ld(&(bar)[XB_TMO])) break; if (_sp > XB_SPIN_CAP) { atomicAdd(&(bar)[XB_TMO], 1u); break; } } } } while (0)
struct XcdBarrier { unsigned* bar; unsigned x; volatile LAS unsigned* st; };
__device__ __forceinline__ XcdBarrier xcd_barrier_post(unsigned* bar, volatile LAS unsigned* st) {
    XcdBarrier b; b.bar = bar; b.x = xb_xcc_id(); b.st = st;
    if (threadIdx.x == 0) (void)xb_add(&bar[XB_XCNT(b.x)], 1u);
    return b;
}
__device__ __forceinline__ void xcd_barrier_complete(unsigned* bar, unsigned x, unsigned& nloc, unsigned& nx) {
    const unsigned G = gridDim.x * gridDim.y * gridDim.z;
    unsigned sum, cnt, mine, sp = 0u;
    for (;;) {
        sum = 0u; cnt = 0u; mine = 0u;
#pragma unroll
        for (unsigned j = 0; j < 16; ++j) { const unsigned c = xb_ld(&bar[XB_XCNT(j)]); sum += c; cnt += (c > 0u) ? 1u : 0u; mine = (j == x) ? c : mine; }
        if (sum == G) break;
        __builtin_amdgcn_s_sleep(1);
        if ((++sp & 255u) == 0u) { if (xb_ld(&bar[XB_TMO])) break; if (sp > XB_SPIN_CAP) { atomicAdd(&bar[XB_TMO], 1u); break; } }
    }
    nloc = mine > 0u ? mine : 1u; nx = cnt > 0u ? cnt : 1u;
}
__device__ __forceinline__ void xcd_barrier(const XcdBarrier& b) {
    asm volatile("s_waitcnt vmcnt(0)" ::: "memory");
    __syncthreads();
    if (threadIdx.x == 0) {
        unsigned* bar = b.bar;
        __builtin_amdgcn_s_waitcnt(0);
        unsigned nloc = b.st[0], nx = b.st[1];
        if (nloc == 0u) { xcd_barrier_complete(bar, b.x, nloc, nx); b.st[0] = nloc; b.st[1] = nx; }
        const unsigned old = xb_add(&bar[XB_XSUB(b.x)], 1u);
        const unsigned gen = old / nloc;
        if (old + 1u == (gen + 1u) * nloc) {
            __builtin_amdgcn_fence(__ATOMIC_RELEASE, "agent");
            asm volatile("s_waitcnt vmcnt(0)" ::: "memory");
            const unsigned og = xb_add(&bar[XB_TOP], 1u);
            const unsigned tg = og / nx;
            if (og + 1u == (tg + 1u) * nx) xb_add(&bar[XB_TOPGEN], 1u);
            else XB_SPIN(xb_ld(&bar[XB_TOPGEN]) == tg, bar);
            __builtin_amdgcn_fence(__ATOMIC_ACQUIRE, "agent");
            xb_add(&bar[XB_XGEN(b.x)], 1u);
            asm volatile("s_waitcnt vmcnt(0)" ::: "memory");
        } else {
            XB_SPIN(xb_ld(&bar[XB_XGEN(b.x)]) == gen, bar);
            __builtin_amdgcn_fence(__ATOMIC_ACQUIRE, "agent");
            asm volatile("s_waitcnt vmcnt(0)" ::: "memory");
        }
    }
    __syncthreads();
}

__device__ __forceinline__ int opaque_tid() { int t = threadIdx.x; asm volatile("" : "+v"(t)); return t; }
#define PHASE_IDS() const int tid = opaque_tid(); const int lane = tid & 63, wave = tid >> 6; const int G = gridDim.x, gw = blockIdx.x * 8 + wave, NGW = G * 8; \
    const int vcu = (G % 8 == 0) ? (int)(blockIdx.x % 8) * (G / 8) + (int)(blockIdx.x / 8) : (int)blockIdx.x; (void)lane; (void)wave; (void)gw; (void)NGW; (void)vcu; (void)G
__global__ void __launch_bounds__(NTHREADS, 2) fwd_mega(Args a) {
    extern __shared__ __attribute__((aligned(16))) unsigned char lds_raw[];
    LAS unsigned char* lds = (LAS unsigned char*)lds_raw;
    cg::grid_group grid = cg::this_grid();
    unsigned char* ws = a.ws;
    if (threadIdx.x < 2) ((LAS unsigned*)(lds + LDS_BYTES - 16))[threadIdx.x] = 0u;
    __syncthreads();
    const XcdBarrier xbar = xcd_barrier_post((unsigned*)(ws + WS_CTL) + CW_BAR, (volatile LAS unsigned*)(lds + LDS_BYTES - 16));
#ifdef TS_SEL
    volatile LAS unsigned long long* tsbuf = (volatile LAS unsigned long long*)(lds + LDS_BYTES - 16 - 256);
    int tsn = 0;
#define TS_MARK() do { if (blockIdx.x == 0 && threadIdx.x == 0) tsbuf[tsn] = __builtin_amdgcn_s_memrealtime(); ++tsn; } while (0)
#else
#define TS_MARK() do { } while (0)
#endif
    TS_MARK();
#define GSYNC() do { xcd_barrier(xbar); TS_MARK(); } while (0)

    for (int rep = 0; rep < REP_P0; ++rep) { PHASE_IDS(); p0_phase(a, lds, tid, gw, NGW); if (REP_P0 > 1) __syncthreads(); }
    if (a.pad1 != 0) grid.sync();
    GSYNC();
    for (int rep = 0; rep < REP_P1; ++rep) { PHASE_IDS(); p1_phase(a, lane, gw, NGW); }
    GSYNC();
    {
        PHASE_IDS();
        pg8::Gemm g{(const bf16_t*)(ws + WS_A), (const bf16_t*)(ws + WS_WIN), NTOK, 5120, 1024};
        pg8::StaticOrder S; S.init(NTOK, 5120, G, (int)blockIdx.x);
        EpiInProj E{(bf16_t*)(ws + WS_Q), (bf16_t*)(ws + WS_V), (bf16_t*)(ws + WS_G), (_Float16*)(ws + WS_LFF), (_Float16*)(ws + WS_LFB), (const float*)(ws + WS_LBV)};
        for (int rep = 0; rep < REP_INP; ++rep) pg8::gemm_phase<EpiInProj, pg8::StaticOrder>(lds, g, S, E);
    }
    GSYNC();
    for (int rep = 0; rep < REP_GLA; ++rep) { PHASE_IDS(); gla_phase(a, lds, tid); if (REP_GLA > 1) __syncthreads(); }
    GSYNC();
    for (int rep = 0; rep < REP_RO; ++rep) { PHASE_IDS(); gla_readout_phase(a, lane, gw, NGW); }
    GSYNC();
    {
        PHASE_IDS();
        pg8::Gemm g{(const bf16_t*)(ws + WS_OG), (const bf16_t*)(ws + WS_WOUT), NTOK, 1024, 1024};
        pg8::StaticOrder S; S.init(NTOK, 1024, G, (int)blockIdx.x);
        EpiResid E{a.in[I_X], a.in[I_CTX], (const float*)(ws + WS_MODV), (bf16_t*)(ws + WS_H), 2048};
        for (int rep = 0; rep < REP_OUT; ++rep) pg8::gemm_phase<EpiResid, pg8::StaticOrder>(lds, g, S, E);
    }
    GSYNC();
    for (int rep = 0; rep < REP_RT; ++rep) { PHASE_IDS(); router_phase(a, lds, 0, 0, tid); if (REP_RT > 1) __syncthreads(); }
    GSYNC();
    for (int rep = 0; rep < REP_AS; ++rep) { PHASE_IDS(); assign_phase(a, lds, 0, 0, tid); if (REP_AS > 1) __syncthreads(); }
    GSYNC();
    for (int rep = 0; rep < REP_M1; ++rep) { PHASE_IDS(); moe_gemm1(a, lds, 0, tid, G, vcu); }
    GSYNC();
    for (int rep = 0; rep < REP_M2; ++rep) { PHASE_IDS(); moe_gemm2(a, lds, 0, tid, G, vcu); }
    GSYNC();
    { PHASE_IDS(); combine_phase(a, 0, 0, lane, gw, NGW); }
    GSYNC();
    for (int rep = 0; rep < REP_S5; ++rep) { PHASE_IDS(); s5_phase(a, lds, tid); if (REP_S5 > 1) __syncthreads(); }
    GSYNC();
    for (int rep = 0; rep < REP_POST; ++rep) { PHASE_IDS(); s5_post_phase(a, lane, gw, NGW); }
    GSYNC();
    {
        PHASE_IDS();
        pg8::Gemm g{(const bf16_t*)(ws + WS_YG), (const bf16_t*)(ws + WS_WGLU), NLAT, 2048, 1024};
        pg8::StaticOrder S; S.init(NLAT, 2048, G, (int)blockIdx.x);
        EpiGlu E{a.in[I_S5BGLU], (const float*)(ws + WS_MODV) + 9 * 6144, (bf16_t*)(ws + WS_H)};
        pg8::gemm_phase<EpiGlu, pg8::StaticOrder>(lds, g, S, E);
    }
    GSYNC();
    { PHASE_IDS(); router_phase(a, lds, 1, NCTX, tid); }
    GSYNC();
    { PHASE_IDS(); assign_phase(a, lds, 1, NCTX, tid); }
    GSYNC();
    { PHASE_IDS(); moe_gemm1(a, lds, 1, tid, G, vcu); }
    GSYNC();
    { PHASE_IDS(); moe_gemm2(a, lds, 1, tid, G, vcu); }
    GSYNC();
    for (int rep = 0; rep < REP_CMB1; ++rep) { PHASE_IDS(); combine_phase(a, 1, NCTX, lane, gw, NGW); }
#ifdef TS_SEL
    TS_MARK();
    if (blockIdx.x == 0 && threadIdx.x == 0) {
        asm volatile("s_waitcnt vmcnt(0)" ::: "memory"); __threadfence();
        const unsigned long long dt = tsbuf[TS_SEL + 1] - tsbuf[TS_SEL];
        atomicAdd(a.out, (float)dt * 0.001f);
    }
#endif
}

extern "C" void kernel_launch(void* const* d_in, const int* in_sizes, int n_in, void* d_out, int out_size,
                              void* d_ws, size_t ws_size, hipStream_t stream) {
    static int grid_blocks = 0;
    if (!grid_blocks) {
        int dev = 0, cus = 0, per_cu = 0;
        (void)hipGetDevice(&dev);
        (void)hipDeviceGetAttribute(&cus, hipDeviceAttributeMultiprocessorCount, dev);
        (void)hipFuncSetAttribute((const void*)fwd_mega, hipFuncAttributeMaxDynamicSharedMemorySize, LDS_BYTES);
        (void)hipOccupancyMaxActiveBlocksPerMultiprocessor(&per_cu, (const void*)fwd_mega, NTHREADS, LDS_BYTES);
        if (per_cu < 1) { fprintf(stderr, "occupancy query says %d blocks/CU\n", per_cu); }
        grid_blocks = cus < 256 ? cus : 256;
        if (ws_size < WS_END) fprintf(stderr, "kernel_launch: workspace too small: %zu < %zu\n", ws_size, (size_t)WS_END);
    }
    (void)hipMemsetAsync((char*)d_ws + WS_CTL, 0, 32 * 1024, stream);
    Args a{};
    for (int i = 0; i < 29; ++i) a.in[i] = (const float*)d_in[i];
    a.out = (float*)d_out; a.ws = (unsigned char*)d_ws;
    void* kargs[] = {&a};
    hipError_t e = hipLaunchCooperativeKernel((const void*)fwd_mega, dim3(grid_blocks), dim3(NTHREADS), kargs, LDS_BYTES, stream);
    if (e != hipSuccess) fprintf(stderr, "cooperative launch failed: %s (grid %d)\n", hipGetErrorString(e), grid_blocks);
}
```

```cpp
#include <hip/hip_runtime.h>
#include <hip/hip_cooperative_groups.h>
#include <cstdio>
#include <cstdint>
namespace cg = cooperative_groups;

#define LAS __attribute__((address_space(3)))
typedef unsigned short bf16_t;
typedef short bf16x8 __attribute__((ext_vector_type(8)));
typedef float f32x4 __attribute__((ext_vector_type(4)));
typedef unsigned u32x4 __attribute__((ext_vector_type(4)));
typedef unsigned u32x2 __attribute__((ext_vector_type(2)));
typedef float f32x2 __attribute__((ext_vector_type(2)));

constexpr int NTHREADS = 512;
constexpr int LDS_BYTES = 147456;
constexpr int D = 1024, NB = 8, SEQ = 4096, CTXL = 256;
constexpr int NCTX = NB * CTXL;
constexpr int NLAT = NB * SEQ;
constexpr int NTOK = NCTX + NLAT;
constexpr int NE = 32;
constexpr int MPAD = 147456;
constexpr float EPS = 1e-6f;

constexpr size_t MiB = 1u << 20;
constexpr size_t WS_CTL = 0;
constexpr size_t WS_MODV = 1 * MiB;
constexpr size_t WS_LBV = 1 * MiB + 512 * 1024;
constexpr size_t WS_WIN = 2 * MiB;
constexpr size_t WS_WOUT = 12 * MiB;
constexpr size_t WS_WGLU = 14 * MiB;
constexpr size_t WS_W1 = 18 * MiB;
constexpr size_t WS_W2 = 274 * MiB;
constexpr size_t WS_H = 402 * MiB;
constexpr size_t WS_A = 538 * MiB;
constexpr size_t WS_F = 606 * MiB;
constexpr size_t WS_TOKE = 674 * MiB;
constexpr size_t WS_TOKW = 674 * MiB + 640 * 1024;
constexpr size_t WS_TOKS = 674 * MiB + 1280 * 1024;
constexpr size_t WS_SLOTTOK = 256 * 1024;
constexpr size_t WS_BIG = 676 * MiB;
constexpr size_t WS_Q = WS_BIG, WS_V = WS_BIG + 68 * MiB, WS_G = WS_BIG + 136 * MiB;
constexpr size_t WS_LFF = WS_BIG + 204 * MiB, WS_LFB = WS_BIG + 340 * MiB;
constexpr size_t WS_OF = WS_BIG + 476 * MiB, WS_OB = WS_BIG + 612 * MiB;
constexpr size_t WS_OG = WS_BIG + 748 * MiB;
constexpr size_t WS_AG = WS_BIG, WS_ACT = WS_BIG + 288 * MiB, WS_YS = WS_BIG;
constexpr size_t WS_YF = WS_BIG, WS_YB = WS_BIG + 128 * MiB, WS_YG = WS_BIG + 256 * MiB;
constexpr size_t WS_END = WS_BIG + 816 * MiB;
constexpr int CW_CNT = 64;
constexpr int CW_CUR = 256;
constexpr int CW_CNTB = 8192;
constexpr int CW_BAR = 4096;
#ifndef REP_P0
#define REP_P0 1
#endif
#ifndef REP_GLA
#define REP_GLA 1
#endif
#ifndef REP_S5
#define REP_S5 1
#endif
#ifndef REP_P1
#define REP_P1 1
#endif
#ifndef REP_RO
#define REP_RO 1
#endif
#ifndef REP_POST
#define REP_POST 1
#endif
#ifndef REP_CMB1
#define REP_CMB1 1
#endif
#ifndef REP_OUT
#define REP_OUT 1
#endif
#ifndef REP_RT
#define REP_RT 1
#endif
#ifndef REP_AS
#define REP_AS 1
#endif
#ifndef REP_INP
#define REP_INP 1
#endif
#ifndef REP_M1
#define REP_M1 1
#endif
#ifndef REP_M2
#define REP_M2 1
#endif

struct Args {
    const float* in[29];
    float* out;
    unsigned char* ws;
    int stop_after, pad1;
};
enum { I_X = 0, I_C, I_CTX, I_CCTX, I_MODW, I_MODB, I_N1G, I_N2G, I_HGWIN, I_HGLB, I_HGNG, I_HGWOUT, I_S5ARE, I_S5AIM, I_S5LDT,
       I_S5BRE, I_S5BIM, I_S5CRE, I_S5CIM, I_S5D, I_S5WGLU, I_S5BGLU, I_RW, I_RB, I_W1, I_B1, I_W2, I_B2, I_FG };

__device__ __forceinline__ unsigned f2bf(float f) { unsigned u = __builtin_bit_cast(unsigned, f); return (u + 0x7fffu + ((u >> 16) & 1u)) >> 16; }
typedef __bf16 bf16x2_t __attribute__((ext_vector_type(2)));
__device__ __forceinline__ unsigned cvt_pk_bf16(float lo, float hi) { const bf16x2_t v = {(__bf16)lo, (__bf16)hi}; return __builtin_bit_cast(unsigned, v); }
__device__ __forceinline__ unsigned pk2(float lo, float hi) { return cvt_pk_bf16(lo, hi); }
__device__ __forceinline__ float bf2f(unsigned short b) { return __builtin_bit_cast(float, ((unsigned)b) << 16); }
__device__ __forceinline__ float bflo(unsigned w) { return __builtin_bit_cast(float, w << 16); }
__device__ __forceinline__ float bfhi(unsigned w) { return __builtin_bit_cast(float, w & 0xffff0000u); }
#define DPP_F(v, ctrl) __builtin_bit_cast(float, __builtin_amdgcn_update_dpp(0, __builtin_bit_cast(int, (v)), (ctrl), 0xF, 0xF, false))
__device__ __forceinline__ float wave_sum(float v) {
    v += DPP_F(v, 0xB1); v += DPP_F(v, 0x4E); v += DPP_F(v, 0x141); v += DPP_F(v, 0x140);
    v += __builtin_bit_cast(float, __builtin_amdgcn_ds_swizzle(__builtin_bit_cast(int, v), 0x401F));
    return __builtin_bit_cast(float, __builtin_amdgcn_readlane(__builtin_bit_cast(int, v), 0)) + __builtin_bit_cast(float, __builtin_amdgcn_readlane(__builtin_bit_cast(int, v), 32));
}
__device__ __forceinline__ float wave_max(float v) {
#pragma unroll
    for (int o = 1; o < 64; o <<= 1) v = fmaxf(v, __shfl_xor(v, o));
    return v;
}
__device__ __forceinline__ float sigmoid_f(float x) { return __builtin_amdgcn_rcpf(1.0f + __expf(-x)); }
__device__ __forceinline__ float silu_f(float x) { return x * __builtin_amdgcn_rcpf(1.0f + __expf(-x)); }
#define LDS_WAIT() asm volatile("s_waitcnt lgkmcnt(0)" ::: "memory")

namespace pg8 {
constexpr int BM = 256, BK = 64, HALF = 128, HTB = HALF * BK * 2, STAGE_BYTES = 8 * HTB, NXCD = 8, WGM = 8;
__host__ __device__ __forceinline__ int lds_byte(int r, int c) { const int st = (r >> 4) * 2 + (c >> 5), rr = r & 15, cc = c & 31, ob = rr * 64 + cc * 2; return st * 1024 + (ob ^ (((ob >> 9) & 1) << 5)); }
__host__ __device__ __forceinline__ void stage_rc(int b, int& R, int& C) { const int st = b / 1024, sb = b % 1024, swz = sb ^ (((sb >> 9) & 1) << 5); R = (st >> 1) * 16 + swz / 64; C = (st & 1) * 32 + (swz % 64) / 2; }
__host__ __device__ __forceinline__ int perm32(int rho) { const int n = rho >> 4, i = rho & 15; return 8 * (i >> 2) + 4 * n + (i & 3); }
struct Unit { int pm, pn; };
struct Gemm { const bf16_t* A; const bf16_t* Bt; int M, N, K; };
struct StaticOrder {
    int nM, nN, nwg, G, c;
    __device__ void init(int M, int N, int G_, int c_) { nM = M / BM; nN = N / BM; nwg = nM * nN; G = G_; c = c_; }
    __device__ bool next(int i, Unit& u) const {
        const long L = (long)i * G + c; if (L >= nwg) return false;
        int wgid = (int)L; { const int q = nwg / NXCD, r = nwg % NXCD, xcd = wgid % NXCD, off = wgid / NXCD; wgid = (xcd < r ? xcd * (q + 1) : r * (q + 1) + (xcd - r) * q) + off; }
        const int nig = WGM * nN, gid = wgid / nig, fm = gid * WGM, gsz = (nM - fm) < WGM ? (nM - fm) : WGM;
        u.pm = fm + ((wgid % nig) % gsz); u.pn = (wgid % nig) / gsz; return true;
    }
    __device__ void idle(int& nidle, int& rank) const { const int r = nwg % G; nidle = r ? G - r : 0; rank = r ? c - r : -1; }
    __device__ __forceinline__ void a_ready(const Unit&) const {}
    __device__ __forceinline__ void done(const Unit&) const {}
};
struct MoeOrder {
    const LAS int* tile_e; int TT, sh, G, v;
    __device__ bool next(int i, Unit& u) const {
        const bool p2 = (G & (G - 1)) == 0 && G >= 8;
        const int lg = p2 ? (31 - __builtin_clz((unsigned)G)) - 3 : 0, per = p2 ? (1 << lg) : G, x = p2 ? (v >> lg) : 0, j = p2 ? (v & (per - 1)) : v, sh3 = p2 ? 3 : 0;
        const int t0 = (x * TT) >> sh3, t1 = ((x + 1) * TT) >> sh3;
        const int uu = i * per + j, rt = t0 + (uu >> sh), pnl = uu & ((1 << sh) - 1);
        if (rt >= t1) return false;
        u.pm = rt; u.pn = (tile_e[rt] << sh) + pnl; return true;
    }
    __device__ void idle(int& nidle, int& rank) const {
        nidle = 0; rank = -1;
        const bool p2 = (G & (G - 1)) == 0 && G >= 8; if (!p2) return;
        const int lg = (31 - __builtin_clz((unsigned)G)) - 3, per = 1 << lg, x = v >> lg, j = v & (per - 1);
        const int rounds = ((((TT + 7) >> 3) << sh) + per - 1) >> lg;
        for (int xx = 0; xx < 8; ++xx) {
            const int units = ((((xx + 1) * TT) >> 3) - ((xx * TT) >> 3)) << sh; int full = units - (rounds - 1) * per; full = full < 0 ? 0 : full;
            if (xx == x && j >= full) rank = nidle + (j - full);
            nidle += per - full;
        }
    }
    __device__ __forceinline__ void a_ready(const Unit&) const {}
    __device__ __forceinline__ void done(const Unit&) const {}
};

template <class Epi, class Sched, bool GATHER = false, bool ALIGN_EPI = true, bool SP2 = true>
__device__ __forceinline__ void gemm_phase(LAS unsigned char* lds, const Gemm g, const Sched& S, const Epi& E, const LAS unsigned short* rowl = nullptr) {
    int tid_ = threadIdx.x; asm volatile("" : "+v"(tid_));
    const int tid = tid_, wid = __builtin_amdgcn_readfirstlane(tid >> 6), lane = tid & 63, wr = wid >> 2, wc = wid & 3, fr = lane & 15, fq = lane >> 4;
    const int K = g.K, nt = K / BK;
    unsigned voffA[2], voffB[2];
    int Rr[2], Cc2[2];
#pragma unroll
    for (int i = 0; i < 2; ++i) { int R, C; stage_rc(tid * 16 + i * 8192, R, C); voffA[i] = (unsigned)(R * K + C) * 2u; const int Rb = Epi::PERM ? ((R & ~31) + perm32(R & 31)) : R; voffB[i] = (unsigned)(Rb * K + C) * 2u; Rr[i] = R; Cc2[i] = C * 2; }
    unsigned gA0[2] = {0u, 0u}, gA1[2] = {0u, 0u}, nG0[2] = {0u, 0u}, nG1[2] = {0u, 0u};
#define PG8_ROWS(ui_, d0, d1) do { _Pragma("unroll") for (int _i = 0; _i < 2; ++_i) { d0[_i] = (unsigned)rowl[(ui_) * BM + Rr[_i]] * (unsigned)(K * 2) + (unsigned)Cc2[_i]; d1[_i] = (unsigned)rowl[(ui_) * BM + HALF + Rr[_i]] * (unsigned)(K * 2) + (unsigned)Cc2[_i]; } } while (0)
#define PG8_STAGE_A(bufoff, ptr, h, nx) do { if constexpr (GATHER) { unsigned _o[2]; _o[0] = (nx) ? ((h) ? nG1[0] : nG0[0]) : ((h) ? gA1[0] : gA0[0]); _o[1] = (nx) ? ((h) ? nG1[1] : nG0[1]) : ((h) ? gA1[1] : gA0[1]); PG8_STAGE(bufoff, ptr, _o); } \
        else { PG8_STAGE(bufoff, (ptr) + ((h) ? hstep : 0), voffA); } } while (0)
    const size_t kstep = (size_t)(BK * 2);
    const size_t hstep = (size_t)HALF * K * 2;
    const size_t tstep = 2 * hstep;
    const unsigned ldsw = (unsigned)wid * 1024u;
    const int aoff = lds_byte(wr * 64 + fr, fq * 8), boff = lds_byte(wc * 32 + fr, fq * 8);
#define PG8_SA(b, h) (((b) * 2 + (h)) * HTB)
#define PG8_SB(b, h) ((4 + (b) * 2 + (h)) * HTB)
#define PG8_STAGE(bufoff, gbase, voff) do { _Pragma("unroll") for (int _i = 0; _i < 2; ++_i) \
        __builtin_amdgcn_global_load_lds((const unsigned*)((const char*)(gbase) + (voff)[_i]), (LAS unsigned*)(lds + (bufoff) + ldsw + _i * 8192), 16, 0, 0); } while (0)
#define PG8_LDA(dst, b, h) do { _Pragma("unroll") for (int m = 0; m < 4; ++m) _Pragma("unroll") for (int k = 0; k < 2; ++k) dst[m][k] = *(const LAS bf16x8*)(lds + PG8_SA(b, h) + aoff + m * 2048 + k * 1024); } while (0)
#define PG8_LDB(dst, b, h) do { _Pragma("unroll") for (int n = 0; n < 2; ++n) _Pragma("unroll") for (int k = 0; k < 2; ++k) dst[n][k] = *(const LAS bf16x8*)(lds + PG8_SB(b, h) + boff + n * 2048 + k * 1024); } while (0)
#define PG8_MMA(ai, bj, At, Bt) do { __builtin_amdgcn_s_setprio(1); _Pragma("unroll") for (int m = 0; m < 4; ++m) _Pragma("unroll") for (int n = 0; n < 2; ++n) _Pragma("unroll") for (int k = 0; k < 2; ++k) \
        acc[ai][bj][m][n] = __builtin_amdgcn_mfma_f32_16x16x32_bf16(Bt[n][k], At[m][k], acc[ai][bj][m][n], 0, 0, 0); __builtin_amdgcn_s_setprio(0); } while (0)
#define PG8_WAIT_V(n) asm volatile("s_waitcnt vmcnt(" #n ")" ::: "memory")
#define PG8_WAIT_L(n) asm volatile("s_waitcnt lgkmcnt(" #n ")" ::: "memory")
#define PG8_BAR __builtin_amdgcn_s_barrier()
#define PG8_SCHED __builtin_amdgcn_sched_barrier(0)
    Unit cur, nxt; int ui = 0;
    if (!S.next(0, cur)) return;
    f32x4 acc[2][2][4][2];
#pragma unroll
    for (int a = 0; a < 2; ++a)
#pragma unroll
        for (int b = 0; b < 2; ++b)
#pragma unroll
            for (int m = 0; m < 4; ++m)
#pragma unroll
                for (int n = 0; n < 2; ++n) acc[a][b][m][n] = (f32x4){0.f, 0.f, 0.f, 0.f};
    bf16x8 At[4][2], B0[2][2], B1[2][2];
    const char* cA = GATHER ? (const char*)g.A : (const char*)g.A + (size_t)cur.pm * tstep; const char* cB = (const char*)g.Bt + (size_t)cur.pn * tstep;
    S.a_ready(cur);
    if constexpr (GATHER) PG8_ROWS(0, gA0, gA1);
    if constexpr (SP2) {
        PG8_STAGE(PG8_SB(0, 0), cB, voffB); PG8_STAGE(PG8_SB(0, 1), cB + hstep, voffB); PG8_STAGE_A(PG8_SA(0, 0), cA, 0, false); PG8_STAGE_A(PG8_SA(0, 1), cA, 1, false);
        if (wr == 1) PG8_BAR;
        PG8_WAIT_V(2); PG8_BAR;
        PG8_STAGE(PG8_SB(1, 0), cB + kstep, voffB); PG8_STAGE_A(PG8_SA(1, 0), cA + kstep, 0, false); PG8_STAGE(PG8_SB(1, 1), cB + hstep + kstep, voffB);
        PG8_WAIT_V(6); PG8_BAR;
    } else {
        PG8_STAGE(PG8_SB(0, 0), cB, voffB); PG8_STAGE_A(PG8_SA(0, 0), cA, 0, false); PG8_STAGE(PG8_SB(0, 1), cB + hstep, voffB); PG8_STAGE_A(PG8_SA(0, 1), cA, 1, false);
        if (wr == 1) PG8_BAR;
        PG8_WAIT_V(4); PG8_BAR;
        PG8_STAGE(PG8_SB(1, 0), cB + kstep, voffB); PG8_STAGE_A(PG8_SA(1, 0), cA + kstep, 0, false); PG8_STAGE(PG8_SB(1, 1), cB + hstep + kstep, voffB);
        PG8_WAIT_V(6); PG8_BAR;
    }
    for (;;) {
        const bool has_next = S.next(ui + 1, nxt);
        const char* nA = GATHER ? cA : (has_next ? (const char*)g.A + (size_t)nxt.pm * tstep : cA); const char* nB = has_next ? (const char*)g.Bt + (size_t)nxt.pn * tstep : cB;
        if constexpr (GATHER) { if (has_next) PG8_ROWS(ui + 1, nG0, nG1); else { nG0[0] = gA0[0]; nG0[1] = gA0[1]; nG1[0] = gA1[0]; nG1[1] = gA1[1]; } }
        for (int t = 0; t < nt; t += 2) {
            const bool last = (t == nt - 2);
            const char* a1 = cA + (size_t)(t + 1) * kstep;
            const char* a2 = last ? nA : cA + (size_t)(t + 2) * kstep; const char* b2 = last ? nB : cB + (size_t)(t + 2) * kstep;
            const char* a3 = a2 + kstep; const char* b3 = b2 + kstep;
            if (last && has_next) S.a_ready(nxt);
            if constexpr (SP2) {
            PG8_LDB(B0, 0, 0); PG8_LDB(B1, 0, 1); PG8_SCHED; PG8_LDA(At, 0, 0); PG8_STAGE_A(PG8_SA(1, 1), a1, 1, false);
            PG8_WAIT_V(8); PG8_WAIT_L(0); PG8_BAR; PG8_MMA(0, 0, At, B0); PG8_MMA(0, 1, At, B1); PG8_BAR; PG8_SCHED;
            PG8_LDA(At, 0, 1); PG8_STAGE(PG8_SB(0, 0), b2, voffB); PG8_STAGE(PG8_SB(0, 1), b2 + hstep, voffB); PG8_STAGE_A(PG8_SA(0, 0), a2, 0, last);
            PG8_WAIT_V(8); PG8_WAIT_L(0); PG8_BAR; PG8_MMA(1, 0, At, B0); PG8_MMA(1, 1, At, B1); PG8_BAR; PG8_SCHED;
            PG8_LDB(B0, 1, 0); PG8_LDB(B1, 1, 1); PG8_SCHED; PG8_LDA(At, 1, 0); PG8_STAGE_A(PG8_SA(0, 1), a2, 1, last);
            PG8_WAIT_V(8); PG8_WAIT_L(0); PG8_BAR; PG8_MMA(0, 0, At, B0); PG8_MMA(0, 1, At, B1); PG8_BAR; PG8_SCHED;
            PG8_LDA(At, 1, 1); PG8_STAGE(PG8_SB(1, 0), b3, voffB); PG8_STAGE(PG8_SB(1, 1), b3 + hstep, voffB); PG8_STAGE_A(PG8_SA(1, 0), a3, 0, last);
            PG8_WAIT_V(8); PG8_WAIT_L(0); PG8_BAR; PG8_MMA(1, 0, At, B0); PG8_MMA(1, 1, At, B1); PG8_BAR; PG8_SCHED;
            } else {
            PG8_LDB(B0, 0, 0); PG8_SCHED; PG8_LDA(At, 0, 0); PG8_STAGE_A(PG8_SA(1, 1), a1, 1, false);
            PG8_WAIT_L(8); PG8_BAR; PG8_WAIT_L(0); PG8_MMA(0, 0, At, B0); PG8_BAR; PG8_SCHED;
            PG8_LDB(B1, 0, 1); PG8_STAGE(PG8_SB(0, 0), b2, voffB);
            PG8_BAR; PG8_WAIT_L(0); PG8_MMA(0, 1, At, B1); PG8_BAR;
            PG8_LDA(At, 0, 1); PG8_STAGE_A(PG8_SA(0, 0), a2, 0, last);
            PG8_BAR; PG8_WAIT_L(0); PG8_MMA(1, 0, At, B0); PG8_BAR; PG8_SCHED;
            PG8_STAGE(PG8_SB(0, 1), b2 + hstep, voffB);
            PG8_WAIT_V(6); PG8_BAR; PG8_MMA(1, 1, At, B1); PG8_BAR;
            PG8_LDB(B0, 1, 0); PG8_SCHED; PG8_LDA(At, 1, 0); PG8_STAGE_A(PG8_SA(0, 1), a2, 1, last);
            PG8_WAIT_L(8); PG8_BAR; PG8_WAIT_L(0); PG8_MMA(0, 0, At, B0); PG8_BAR; PG8_SCHED;
            PG8_LDB(B1, 1, 1); PG8_STAGE(PG8_SB(1, 0), b3, voffB);
            PG8_BAR; PG8_WAIT_L(0); PG8_MMA(0, 1, At, B1); PG8_BAR;
            PG8_LDA(At, 1, 1); PG8_STAGE_A(PG8_SA(1, 0), a3, 0, last);
            PG8_BAR; PG8_WAIT_L(0); PG8_MMA(1, 0, At, B0); PG8_BAR; PG8_SCHED;
            PG8_STAGE(PG8_SB(1, 1), b3 + hstep, voffB);
            PG8_WAIT_V(6); PG8_BAR; PG8_MMA(1, 1, At, B1); PG8_BAR;
                    }
        }
        if constexpr (ALIGN_EPI) { if (wr == 0) PG8_BAR; }
        E(acc, cur, wr, wc, fr, fq); S.done(cur);
        if (!has_next) break;
#pragma unroll
        for (int a = 0; a < 2; ++a)
#pragma unroll
            for (int b = 0; b < 2; ++b)
#pragma unroll
                for (int m = 0; m < 4; ++m)
#pragma unroll
                    for (int n = 0; n < 2; ++n) acc[a][b][m][n] = (f32x4){0.f, 0.f, 0.f, 0.f};
        cur = nxt; cA = nA; cB = nB; ++ui;
        if constexpr (GATHER) { gA0[0] = nG0[0]; gA0[1] = nG0[1]; gA1[0] = nG1[0]; gA1[1] = nG1[1]; }
        if constexpr (ALIGN_EPI) { if (wr == 1) PG8_BAR; }
    }
    PG8_WAIT_V(0);
    if constexpr (!ALIGN_EPI) { if (wr == 0) PG8_BAR; }
    PG8_BAR;
#undef PG8_SA
#undef PG8_ROWS
#undef PG8_STAGE_A
#undef PG8_SB
#undef PG8_STAGE
#undef PG8_LDA
#undef PG8_LDB
#undef PG8_MMA
#undef PG8_WAIT_V
#undef PG8_WAIT_L
#undef PG8_BAR
#undef PG8_SCHED
}
}
using pg8::Unit;

__device__ __forceinline__ f32x4 ld_bf16x4(const bf16_t* p) { const u32x2 w = *(const u32x2*)p; return (f32x4){bflo(w.x), bfhi(w.x), bflo(w.y), bfhi(w.y)}; }
__device__ __forceinline__ void pin(f32x4& v) { asm volatile("" : "+v"(v)); }
__device__ __forceinline__ void st_bf16x4(bf16_t* p, f32x4 v) { u32x2 w; w.x = pk2(v[0], v[1]); w.y = pk2(v[2], v[3]); *(u32x2*)p = w; }

struct EpiInProj {
    static constexpr bool PERM = true;
    bf16_t *Q, *V, *G; _Float16 *LFF, *LFB; const float* lbv;
    __device__ __forceinline__ void operator()(const f32x4 (&acc)[2][2][4][2], const Unit& u, int wr, int wc, int fr, int fq) const {
        const int seg = u.pn >> 2, cb = (u.pn & 3) * 256 + wc * 32 + 8 * fq, row0 = u.pm * 256 + wr * 64 + fr;
        if (seg == 2 || seg == 3) {
            _Float16* LF = seg == 2 ? LFF : LFB; const float* lbp = lbv + (seg - 2) * D + cb;
            f32x4 lbA0 = *(const f32x4*)lbp, lbA1 = *(const f32x4*)(lbp + 4), lbB0 = *(const f32x4*)(lbp + 128), lbB1 = *(const f32x4*)(lbp + 132);
            pin(lbA0); pin(lbA1); pin(lbB0); pin(lbB1);
#pragma unroll
            for (int bj = 0; bj < 2; ++bj)
#pragma unroll
                for (int ai = 0; ai < 2; ++ai)
#pragma unroll
                    for (int m = 0; m < 4; ++m) {
                        const f32x4 lb0 = bj ? lbB0 : lbA0, lb1 = bj ? lbB1 : lbA1; const f32x4 v0 = acc[ai][bj][m][0], v1 = acc[ai][bj][m][1]; f32x4 o0, o1;
#pragma unroll
                        for (int j = 0; j < 4; ++j) { o0[j] = __logf(lb0[j] + (1.0f - lb0[j]) * sigmoid_f(v0[j])); o1[j] = __logf(lb1[j] + (1.0f - lb1[j]) * sigmoid_f(v1[j])); }
                        u32x4 hw; hw.x = __builtin_bit_cast(unsigned, __builtin_amdgcn_cvt_pkrtz(o0[0], o0[1])); hw.y = __builtin_bit_cast(unsigned, __builtin_amdgcn_cvt_pkrtz(o0[2], o0[3]));
                        hw.z = __builtin_bit_cast(unsigned, __builtin_amdgcn_cvt_pkrtz(o1[0], o1[1])); hw.w = __builtin_bit_cast(unsigned, __builtin_amdgcn_cvt_pkrtz(o1[2], o1[3]));
                        *(u32x4*)(LF + (size_t)(row0 + ai * 128 + m * 16) * D + cb + bj * 128) = hw;
                    }
        } else if (seg == 0) {
#pragma unroll
            for (int bj = 0; bj < 2; ++bj)
#pragma unroll
                for (int ai = 0; ai < 2; ++ai)
#pragma unroll
                    for (int m = 0; m < 4; ++m) {
                        const f32x4 v0 = acc[ai][bj][m][0], v1 = acc[ai][bj][m][1]; f32x4 o0, o1;
#pragma unroll
                        for (int j = 0; j < 4; ++j) { o0[j] = silu_f(v0[j]); o1[j] = silu_f(v1[j]); }
                        *(u32x4*)(Q + (size_t)(row0 + ai * 128 + m * 16) * D + cb + bj * 128) = (u32x4){pk2(o0[0], o0[1]), pk2(o0[2], o0[3]), pk2(o1[0], o1[1]), pk2(o1[2], o1[3])};
                    }
        } else {
            bf16_t* O = seg == 1 ? V : G;
#pragma unroll
            for (int bj = 0; bj < 2; ++bj)
#pragma unroll
                for (int ai = 0; ai < 2; ++ai)
#pragma unroll
                    for (int m = 0; m < 4; ++m) {
                        const f32x4 v0 = acc[ai][bj][m][0], v1 = acc[ai][bj][m][1];
                        *(u32x4*)(O + (size_t)(row0 + ai * 128 + m * 16) * D + cb + bj * 128) = (u32x4){pk2(v0[0], v0[1]), pk2(v0[2], v0[3]), pk2(v1[0], v1[1]), pk2(v1[2], v1[3])};
                    }
        }
    }
};
struct EpiResid {
    static constexpr bool PERM = true;
    const float* x; const float* ctx; const float* modv; bf16_t* H; int gate_off;
    __device__ __forceinline__ void operator()(const f32x4 (&acc)[2][2][4][2], const Unit& u, int wr, int wc, int fr, int fq) const {
        const int rt0 = u.pm * 256; const int mr = rt0 < NCTX ? 8 : ((rt0 - NCTX) >> 12);
        const float* src = rt0 < NCTX ? ctx + (size_t)rt0 * D : x + (size_t)(rt0 - NCTX) * D;
        const int cb = u.pn * 256 + wc * 32 + 8 * fq, rl0 = wr * 64 + fr;
        const float* gp = modv + mr * 6144 + gate_off;
        f32x4 gg[2][2];
#pragma unroll
        for (int bj = 0; bj < 2; ++bj) { gg[bj][0] = *(const f32x4*)(gp + cb + bj * 128); gg[bj][1] = *(const f32x4*)(gp + cb + bj * 128 + 4); }
#pragma unroll
        for (int bj = 0; bj < 2; ++bj) { pin(gg[bj][0]); pin(gg[bj][1]); }
        f32x4 hA0[2], hA1[2], hB0[2], hB1[2];
#define ER_LOAD(k_, d0, d1) do { const int bj_ = (k_) >> 2, ai_ = ((k_) >> 1) & 1, m0_ = ((k_) & 1) * 2; _Pragma("unroll") for (int m = 0; m < 2; ++m) { const float* hp = src + (size_t)(rl0 + ai_ * 128 + (m0_ + m) * 16) * D + cb + bj_ * 128; d0[m] = *(const f32x4*)hp; d1[m] = *(const f32x4*)(hp + 4); } } while (0)
#define ER_STORE(k_, d0, d1) do { const int bj_ = (k_) >> 2, ai_ = ((k_) >> 1) & 1, m0_ = ((k_) & 1) * 2; _Pragma("unroll") for (int m = 0; m < 2; ++m) { \
            const f32x4 o0 = d0[m] + gg[bj_][0] * acc[ai_][bj_][m0_ + m][0], o1 = d1[m] + gg[bj_][1] * acc[ai_][bj_][m0_ + m][1]; \
            *(u32x4*)(H + (size_t)(rt0 + rl0 + ai_ * 128 + (m0_ + m) * 16) * D + cb + bj_ * 128) = (u32x4){pk2(o0[0], o0[1]), pk2(o0[2], o0[3]), pk2(o1[0], o1[1]), pk2(o1[2], o1[3])}; } } while (0)
        ER_LOAD(0, hA0, hA1);
        ER_LOAD(1, hB0, hB1); ER_STORE(0, hA0, hA1);
        ER_LOAD(2, hA0, hA1); ER_STORE(1, hB0, hB1);
        ER_LOAD(3, hB0, hB1); ER_STORE(2, hA0, hA1);
        ER_LOAD(4, hA0, hA1); ER_STORE(3, hB0, hB1);
        ER_LOAD(5, hB0, hB1); ER_STORE(4, hA0, hA1);
        ER_LOAD(6, hA0, hA1); ER_STORE(5, hB0, hB1);
        ER_LOAD(7, hB0, hB1); ER_STORE(6, hA0, hA1);
        ER_STORE(7, hB0, hB1);
#undef ER_LOAD
#undef ER_STORE
    }
};

struct TrItem { const float* src; bf16_t* dst; int N; };
__device__ __forceinline__ void tr_load(const TrItem& t, f32x4 (&v)[16], int lane) {
    const float* p = t.src + (size_t)(2 * (lane >> 4)) * t.N + 4 * (lane & 15);
#pragma unroll
    for (int i = 0; i < 8; ++i) { v[2 * i] = __builtin_nontemporal_load((const f32x4*)(p + (size_t)(8 * i) * t.N)); v[2 * i + 1] = __builtin_nontemporal_load((const f32x4*)(p + (size_t)(8 * i + 1) * t.N)); }
}
__device__ __forceinline__ void tr_finish(const TrItem& t, const f32x4 (&v)[16], LAS unsigned* scr, int lane) {
#pragma unroll
    for (int i = 0; i < 8; ++i) {
        const int kp = 4 * i + (lane >> 4); LAS unsigned* s = scr + kp * 65 + 4 * (lane & 15);
        s[0] = cvt_pk_bf16(v[2 * i][0], v[2 * i + 1][0]); s[1] = cvt_pk_bf16(v[2 * i][1], v[2 * i + 1][1]); s[2] = cvt_pk_bf16(v[2 * i][2], v[2 * i + 1][2]); s[3] = cvt_pk_bf16(v[2 * i][3], v[2 * i + 1][3]);
    }
    LDS_WAIT();
    const int c = lane & 7;
#pragma unroll
    for (int j = 0; j < 8; ++j) {
        const int n = (lane >> 3) + 8 * j; const LAS unsigned* s = scr + (4 * c) * 65 + n;
        __builtin_nontemporal_store((u32x4){s[0], s[65], s[130], s[195]}, (u32x4*)(t.dst + (size_t)n * 1024 + 8 * c));
    }
    LDS_WAIT();
}
__device__ __forceinline__ int ilv_row(int c) { const int bj = c >> 10, r = c & 1023; return (r >> 7) * 256 + bj * 128 + (r & 127); }

__device__ __forceinline__ TrItem moe_item(const Args& a, int r, int layer) {
    TrItem t;
    if (r < 32 * 512) { const int mat = layer * 32 + (r >> 9), sub = r & 511, kb = sub >> 5, nb = sub & 31;
        t.src = a.in[I_W1] + (size_t)mat * 1024 * 2048 + (size_t)(kb * 64) * 2048 + nb * 64; t.dst = (bf16_t*)(a.ws + WS_W1) + (size_t)mat * 2048 * 1024 + (size_t)ilv_row(nb * 64) * 1024 + kb * 64; t.N = 2048; }
    else { r -= 32 * 512; const int mat = layer * 32 + (r >> 8), sub = r & 255, kb = sub >> 4, nb = sub & 15;
        t.src = a.in[I_W2] + (size_t)mat * 1024 * 1024 + (size_t)(kb * 64) * 1024 + nb * 64; t.dst = (bf16_t*)(a.ws + WS_W2) + (size_t)mat * 1024 * 1024 + (size_t)(nb * 64) * 1024 + kb * 64; t.N = 1024; }
    return t;
}
#ifndef TF_N0
#define TF_N0 5696
#endif
constexpr int P0_NWIN = 16 * 80, P0_NWOUT = 16 * 16, P0_NWGLU = 16 * 32, P0_NITEMS = P0_NWIN + P0_NWOUT + P0_NWGLU + TF_N0;
__device__ __forceinline__ TrItem p0_item(const Args& a, int r) {
    TrItem t;
    if (r < P0_NWIN) { const int kb = r / 80, nb = r % 80; t.src = a.in[I_HGWIN] + (size_t)(kb * 64) * 5120 + nb * 64; t.dst = (bf16_t*)(a.ws + WS_WIN) + (size_t)(nb * 64) * 1024 + kb * 64; t.N = 5120; return t; } r -= P0_NWIN;
    if (r < P0_NWOUT) { const int kb = r / 16, nb = r % 16; t.src = a.in[I_HGWOUT] + (size_t)(kb * 64) * 1024 + nb * 64; t.dst = (bf16_t*)(a.ws + WS_WOUT) + (size_t)(nb * 64) * 1024 + kb * 64; t.N = 1024; return t; } r -= P0_NWOUT;
    if (r < P0_NWGLU) { const int kb = r / 32, nb = r % 32; t.src = a.in[I_S5WGLU] + (size_t)(kb * 64) * 2048 + nb * 64; t.dst = (bf16_t*)(a.ws + WS_WGLU) + (size_t)ilv_row(nb * 64) * 1024 + kb * 64; t.N = 2048; return t; } r -= P0_NWGLU;
    return moe_item(a, r, 0);
}
#define TR_LOOP(first, stride, count, ITEM) do { int _it = (first); if (_it < (count)) { f32x4 _va[16], _vb[16]; TrItem _A = ITEM(_it), _B; tr_load(_A, _va, lane); \
        int _i2 = _it + (stride); bool _h2 = _i2 < (count); _B = ITEM(_h2 ? _i2 : _it); tr_load(_B, _vb, lane); tr_finish(_A, _va, scr, lane); \
        while (_h2) { _it = _i2 + (stride); const bool _h1 = _it < (count); _A = ITEM(_h1 ? _it : _i2); tr_load(_A, _va, lane); tr_finish(_B, _vb, scr, lane); if (!_h1) break; \
                      _i2 = _it + (stride); _h2 = _i2 < (count); _B = ITEM(_h2 ? _i2 : _it); tr_load(_B, _vb, lane); tr_finish(_A, _va, scr, lane); } } } while (0)
constexpr int CW_CQ = 32;
constexpr int DQ_L0 = 32 * 512 + 32 * 256, DQ_TOTAL = 2 * DQ_L0;
__device__ __forceinline__ TrItem dq_item(const Args& a, int d) { return d < DQ_L0 ? moe_item(a, d, 0) : moe_item(a, d - DQ_L0, 1); }
#ifndef TF_GG_INP
#define TF_GG_INP 216
#endif
#ifndef TF_GG_OUT
#define TF_GG_OUT 256
#endif
#ifndef TF_KA_INP
#define TF_KA_INP 59
#endif
#ifndef TF_K_INP
#define TF_K_INP 4
#endif
#ifndef TF_KA_OUT
#define TF_KA_OUT 0
#endif
#ifndef TF_K_OUT
#define TF_K_OUT 3
#endif
#ifndef TF_K_M1
#define TF_K_M1 4
#endif
#ifndef TF_K_M2
#define TF_K_M2 4
#endif
__device__ __forceinline__ void tail_fill(const Args& a, LAS unsigned char* lds, int ph, int nA, int rA, int KA, int nB, int rB, int KB, int lo, int hi) {
    unsigned* cq = (unsigned*)(a.ws + WS_CTL) + CW_CQ + ph;
    int base = ph ? (int)__builtin_nontemporal_load(cq) : TF_N0;
    base = base < lo ? lo : base;
    const int shA = (KA > 0 && nA > 0) ? nA * 8 * KA : 0, shB = (KB > 0 && nB > 0) ? nB * 8 * KB : 0;
    int endA = base + shA; endA = endA < hi ? endA : hi; endA = endA < base ? base : endA; int endB = endA + shB; endB = endB < hi ? endB : hi; endB = endB < endA ? endA : endB;
    const bool inA = rA >= 0 && shA > 0, inB = !inA && rB >= 0 && shB > 0;
    if (inA || inB) {
        __syncthreads();
        int t_ = threadIdx.x; asm volatile("" : "+v"(t_)); const int lane = t_ & 63, wave = __builtin_amdgcn_readfirstlane(t_ >> 6);
        LAS unsigned* scr = (LAS unsigned*)(lds + wave * 8320);
        LAS unsigned* jc = (LAS unsigned*)(lds + 8 * 8320);
        if (t_ == 0) *jc = 0u;
        __syncthreads();
        const int first = inA ? base + rA * 8 : endA + rB * 8, gstride = (inA ? nA : nB) * 8, limit = inA ? endA : endB, NJ = 8 * (inA ? KA : KB);
#define TF_GRAB(dst) do { unsigned v_ = 0; if (lane == 0) v_ = __hip_atomic_fetch_add(jc, 1u, __ATOMIC_RELAXED, __HIP_MEMORY_SCOPE_WORKGROUP); const int j_ = (int)__builtin_amdgcn_readfirstlane(v_); \
            dst = (j_ < NJ) ? first + (j_ >> 3) * gstride + (j_ & 7) : limit; } while (0)
        int ia, ib; TF_GRAB(ia);
        if (ia < limit) {
            f32x4 va[16], vb[16]; TrItem A = dq_item(a, ia), B; tr_load(A, va, lane);
            TF_GRAB(ib); bool hb = ib < limit; B = dq_item(a, hb ? ib : ia); tr_load(B, vb, lane); tr_finish(A, va, scr, lane);
            while (hb) {
                TF_GRAB(ia); const bool ha = ia < limit; A = dq_item(a, ha ? ia : ib); tr_load(A, va, lane); tr_finish(B, vb, scr, lane); if (!ha) break;
                TF_GRAB(ib); hb = ib < limit; B = dq_item(a, hb ? ib : ia); tr_load(B, vb, lane); tr_finish(A, va, scr, lane);
            }
        }
#undef TF_GRAB
    }
    if (blockIdx.x == 0 && threadIdx.x == 0) cq[1] = (unsigned)endB;
}
__device__ __forceinline__ void p0_phase(const Args& a, LAS unsigned char* lds, int tid, int gw, int NGW) {
    const int lane = tid & 63, wave = tid >> 6;
    unsigned char* ws = a.ws;
    float* modv = (float*)(ws + WS_MODV);
    if (blockIdx.x < 192) {
        LAS float* SC = (LAS float*)lds;
        LAS float* PART = (LAS float*)(lds + 40960);
        for (int i = tid; i < 9 * 1024; i += NTHREADS) { const int r = i >> 10, k = i & 1023; const float v = r < 8 ? a.in[I_C][r * 1024 + k] : a.in[I_CCTX][k]; SC[i] = silu_f(v); }
        __syncthreads();
        const int layer = blockIdx.x / 96, ng = blockIdx.x % 96;
        const float* W = a.in[I_MODW] + (size_t)layer * 1024 * 6144 + ng * 64 + lane;
        float acc[9];
#pragma unroll
        for (int r = 0; r < 9; ++r) acc[r] = 0.f;
#pragma unroll 8
        for (int kk = 0; kk < 128; ++kk) {
            const int k = wave * 128 + kk; const float w = W[(size_t)k * 6144];
#pragma unroll
            for (int r = 0; r < 9; ++r) acc[r] += SC[r * 1024 + k] * w;
        }
#pragma unroll
        for (int r = 0; r < 9; ++r) PART[(wave * 9 + r) * 64 + lane] = acc[r];
        __syncthreads();
        for (int i = tid; i < 9 * 64; i += NTHREADS) {
            const int r = i >> 6, l = i & 63; float s = a.in[I_MODB][layer * 6144 + ng * 64 + l];
#pragma unroll
            for (int w = 0; w < 8; ++w) s += PART[(w * 9 + r) * 64 + l];
            modv[(size_t)(layer * 9 + r) * 6144 + ng * 64 + l] = s;
        }
        __syncthreads();
    } else if (blockIdx.x == 192) {
        float* lbv = (float*)(ws + WS_LBV);
        for (int i = tid; i < 2048; i += NTHREADS) { const float l0 = a.in[I_HGLB][i], l1 = a.in[I_HGLB][2048 + i]; lbv[i] = 1.0f / (1.0f + __expf(l1 - l0)); }
    }
    LAS unsigned* scr = (LAS unsigned*)(lds + 59392 + wave * 8320);
#define P0_ITEM(i) p0_item(a, (i))
    const int nfast = ((int)gridDim.x > 192) ? ((int)gridDim.x - 192) * 8 : 0, nextra = nfast * 3, n1 = P0_NITEMS - nextra;
    TR_LOOP(gw, NGW, n1, P0_ITEM);
    if (blockIdx.x >= 192) { TR_LOOP(n1 + (gw - 192 * 8), nfast, P0_NITEMS, P0_ITEM); }
#undef P0_ITEM
}

__device__ __forceinline__ const float* hin_row(const Args& a, int row) { return row < NCTX ? a.in[I_CTX] + (size_t)row * D : a.in[I_X] + (size_t)(row - NCTX) * D; }
__device__ __forceinline__ int mod_row(int row) { return row < NCTX ? 8 : ((row - NCTX) >> 12); }
__device__ __forceinline__ float row_rstd(const f32x4 (&v)[4]) {
    float s = 0.f;
#pragma unroll
    for (int j = 0; j < 4; ++j) s += (v[j][0] * v[j][0] + v[j][1] * v[j][1]) + (v[j][2] * v[j][2] + v[j][3] * v[j][3]);
    return __builtin_amdgcn_rsqf(wave_sum(s) * (1.0f / D) + EPS);
}
struct ModVec { f32x4 g[4], sc[4], sh[4]; };
__device__ __forceinline__ void modvec_load(ModVec& m, const float* g, const float* sc, const float* sh, int lane) {
#pragma unroll
    for (int j = 0; j < 4; ++j) { const int c = 4 * lane + 256 * j; m.g[j] = *(const f32x4*)(g + c); m.sc[j] = *(const f32x4*)(sc + c); m.sh[j] = *(const f32x4*)(sh + c); }
}
__device__ __forceinline__ void norm_mod_store(const f32x4 (&v)[4], float rstd, const ModVec& m, bf16_t* orow, int lane) {
#pragma unroll
    for (int j = 0; j < 4; ++j) st_bf16x4(orow + 4 * lane + 256 * j, v[j] * rstd * m.g[j] * (m.sc[j] + 1.0f) + m.sh[j]);
}

__device__ __forceinline__ void p1_phase(const Args& a, int lane, int gw, int NGW) {
    const float* modv = (const float*)(a.ws + WS_MODV);
    bf16_t* A = (bf16_t*)(a.ws + WS_A);
    for (int row0 = gw * 4; row0 < NTOK; row0 += NGW * 4) {
        f32x4 v[4][4];
#pragma unroll
        for (int r = 0; r < 4; ++r) { const float* hr = hin_row(a, row0 + r);
#pragma unroll
            for (int j = 0; j < 4; ++j) v[r][j] = *(const f32x4*)(hr + 4 * lane + 256 * j); }
        const float* mv = modv + (size_t)mod_row(row0) * 6144;
        ModVec m; modvec_load(m, a.in[I_N1G], mv + 1024, mv, lane);
#pragma unroll
        for (int r = 0; r < 4; ++r) { const float rstd = row_rstd(v[r]); norm_mod_store(v[r], rstd, m, A + (size_t)(row0 + r) * D, lane); }
    }
}

__device__ __forceinline__ int gla_row(int n, int t, int b, int dir) {
    const bool isctx = n < 4; const int cn = isctx ? n : n - 4, slen = isctx ? CTXL : SEQ, rbase = isctx ? b * CTXL : NCTX + b * SEQ;
    const int pos = cn * 64 + t; return rbase + (dir ? slen - 1 - pos : pos);
}
__device__ __forceinline__ void gla_phase(const Args& a, LAS unsigned char* lds, int tid) {
    const int lane = tid & 63, wave = tid >> 6, fr = lane & 15, fq = lane >> 4;
    LAS unsigned char* QS = lds;
    LAS unsigned char* KS = lds + 17408;
    LAS unsigned char* QIN = lds + 34816;
    LAS unsigned char* KOT = lds + 52224;
    LAS unsigned char* VT = lds + 70656;
    LAS unsigned char* ST0 = lds + 79872;
    LAS unsigned char* PPW = lds + 114688 + wave * 2304;
    LAS float* GT0 = (LAS float*)(lds + 133120);
    LAS float* BL = (LAS float*)(lds + 141312);
    const bf16_t* Qg = (const bf16_t*)(a.ws + WS_Q); const bf16_t* Vg = (const bf16_t*)(a.ws + WS_V);
    for (int item = blockIdx.x; item < 256; item += gridDim.x) {
        const int vs = item & 1, dir = (item >> 1) & 1, h = (item >> 2) & 7, b = item >> 5;
        const _Float16* LF = (const _Float16*)(a.ws + (dir ? WS_LFB : WS_LFF)); bf16_t* Og = (bf16_t*)(a.ws + (dir ? WS_OB : WS_OF));
        f32x4 Sacc[4];
#pragma unroll
        for (int i = 0; i < 4; ++i) Sacc[i] = (f32x4){0.f, 0.f, 0.f, 0.f};
        for (int i = tid; i < 2 * 17408 / 4; i += NTHREADS) ((LAS unsigned*)ST0)[i] = 0u;
        const int kc2 = (tid & 63) * 2, tg = tid >> 6, chq = h * 128 + kc2;
        const int vt_t = tid & 63, vt_v8 = (tid >> 6) * 8;
        unsigned lf2[8], q2[8]; u32x4 vv;
#define GLA_LOAD(n_) do { const unsigned o0_ = (unsigned)(gla_row(n_, tg * 8, b, dir) * D + chq) * 2u; const unsigned os_ = dir ? (unsigned)(-2 * D) : (unsigned)(2 * D); \
            _Pragma("unroll") for (int i = 0; i < 8; ++i) { const unsigned o = o0_ + (unsigned)i * os_; lf2[i] = *(const unsigned*)((const char*)LF + o); q2[i] = *(const unsigned*)((const char*)Qg + o); } \
            vv = *(const u32x4*)((const char*)Vg + (unsigned)(gla_row(n_, vt_t, b, dir) * D + h * 128 + vs * 64 + vt_v8) * 2u); } while (0)
        float fa[8], fb[8], bca[8], bcb[8];
#define GLA_CUMSUM(par_) do { float csa = 0.f, csb = 0.f; _Pragma("unroll") for (int i = 0; i < 8; ++i) { typedef _Float16 h2 __attribute__((ext_vector_type(2))); const h2 hv = __builtin_bit_cast(h2, lf2[i]); \
            const float la = (float)hv[0], lb_ = (float)hv[1]; fa[i] = __expf(la); fb[i] = __expf(lb_); csa += la; csb += lb_; bca[i] = csa; bcb[i] = csb; } \
            *(LAS f32x2*)(GT0 + (par_) * 1024 + tg * 128 + kc2) = (f32x2){csa, csb}; } while (0)
        GLA_LOAD(0);
        GLA_CUMSUM(0);
        __syncthreads();
        for (int n = 0; n < 68; ++n) {
            const int par = n & 1;
            LAS unsigned char* STc = ST0 + par * 17408; LAS unsigned char* STn = ST0 + (par ^ 1) * 17408;
            { const unsigned w[4] = {vv.x, vv.y, vv.z, vv.w};
#pragma unroll
              for (int i = 0; i < 4; ++i) { *(LAS bf16_t*)(VT + (vt_v8 + 2 * i) * 144 + vt_t * 2) = (bf16_t)(w[i] & 0xffffu); *(LAS bf16_t*)(VT + (vt_v8 + 2 * i + 1) * 144 + vt_t * 2) = (bf16_t)(w[i] >> 16); } }
#define GLA_OSTORE(n_) do { const u32x4 od = *(const LAS u32x4*)(PPW + (lane >> 2) * 144 + (lane & 3) * 16); \
                *(u32x4*)(Og + (size_t)gla_row(n_, (wave >> 1) * 16 + (lane >> 2), b, dir) * D + h * 128 + vs * 64 + (wave & 1) * 32 + (lane & 3) * 8) = od; } while (0)
            if (n > 0) GLA_OSTORE(n - 1);
            f32x2 pre = (f32x2){0.f, 0.f}, bref = (f32x2){0.f, 0.f}, blast = (f32x2){0.f, 0.f};
#pragma unroll
            for (int g8 = 0; g8 < 8; ++g8) { const f32x2 gv = *(const LAS f32x2*)(GT0 + par * 1024 + g8 * 128 + kc2); if (g8 < tg) pre += gv; if (g8 < 4) bref += gv; blast += gv; }
            const float era = __expf(bref.x), erb = __expf(bref.y), ela = __expf(blast.x - bref.x), elb = __expf(blast.y - bref.y);
            float e1a = __expf(pre.x - bref.x), e1b = __expf(pre.y - bref.y);
            unsigned kota[4], kotb[4];
#pragma unroll
            for (int i = 0; i < 8; ++i) {
                const int t = tg * 8 + i;
                const float qa = bflo(q2[i]), qb = bfhi(q2[i]);
                e1a *= fa[i]; e1b *= fb[i];
                const float ka = 1.0f - fa[i], kb = 1.0f - fb[i];
                const float e2a = __builtin_amdgcn_rcpf(e1a), e2b = __builtin_amdgcn_rcpf(e1b);
                const float qsa = qa * e1a, qsb = qb * e1b, ksa = ka * e2a, ksb = kb * e2b;
                *(LAS unsigned*)(QS + t * 272 + kc2 * 2) = cvt_pk_bf16(qsa, qsb);
                *(LAS unsigned*)(KS + t * 272 + kc2 * 2) = cvt_pk_bf16(ksa, ksb);
                *(LAS unsigned*)(QIN + t * 272 + kc2 * 2) = cvt_pk_bf16(qsa * era, qsb * erb);
                const unsigned ko = cvt_pk_bf16(ksa * ela, ksb * elb);
                if (i & 1) { kota[i >> 1] |= ko << 16; kotb[i >> 1] |= ko & 0xffff0000u; } else { kota[i >> 1] = ko & 0xffffu; kotb[i >> 1] = ko >> 16; }
            }
            { const int rot = ((kc2 >> 4) + tg) & 7;
              *(LAS u32x4*)(KOT + kc2 * 144 + rot * 16) = (u32x4){kota[0], kota[1], kota[2], kota[3]};
              *(LAS u32x4*)(KOT + (kc2 + 1) * 144 + rot * 16) = (u32x4){kotb[0], kotb[1], kotb[2], kotb[3]}; }
            if (tg == 0) *(LAS f32x2*)(BL + kc2) = (f32x2){__expf(blast.x), __expf(blast.y)};
            if (n + 1 < 68) GLA_LOAD(n + 1);
            __syncthreads();
            const int tt = wave >> 1;
            bf16x8 aq[4];
#pragma unroll
            for (int kk = 0; kk < 4; ++kk) aq[kk] = *(const LAS bf16x8*)(QS + (tt * 16 + fr) * 272 + (kk * 32 + fq * 8) * 2);
#pragma unroll
            for (int st = 0; st < 4; ++st) {
                f32x4 acc = (f32x4){0.f, 0.f, 0.f, 0.f};
                if (st <= tt) {
#pragma unroll
                    for (int kk = 0; kk < 4; ++kk) {
                        const bf16x8 bv = *(const LAS bf16x8*)(KS + (st * 16 + fr) * 272 + (kk * 32 + fq * 8) * 2);
                        acc = __builtin_amdgcn_mfma_f32_16x16x32_bf16(bv, aq[kk], acc, 0, 0, 0);
                    }
                }
                { const int s0 = st * 16 + fq * 4, tg_ = tt * 16 + fr;
                  *(LAS u32x2*)(PPW + fr * 144 + s0 * 2) = (u32x2){cvt_pk_bf16(s0 <= tg_ ? acc[0] : 0.f, s0 + 1 <= tg_ ? acc[1] : 0.f), cvt_pk_bf16(s0 + 2 <= tg_ ? acc[2] : 0.f, s0 + 3 <= tg_ ? acc[3] : 0.f)}; }
            }
            LDS_WAIT();
            unsigned ow[2][2];
            bf16x8 ap[2], ai[4];
#pragma unroll
            for (int kk = 0; kk < 2; ++kk) ap[kk] = *(const LAS bf16x8*)(PPW + fr * 144 + (kk * 32 + fq * 8) * 2);
#pragma unroll
            for (int kk = 0; kk < 4; ++kk) ai[kk] = *(const LAS bf16x8*)(QIN + (tt * 16 + fr) * 272 + (kk * 32 + fq * 8) * 2);
#pragma unroll
            for (int vti = 0; vti < 2; ++vti) {
                const int vt = 2 * (wave & 1) + vti; f32x4 acc = (f32x4){0.f, 0.f, 0.f, 0.f};
#pragma unroll
                for (int kk = 0; kk < 2; ++kk) {
                    const bf16x8 bv = *(const LAS bf16x8*)(VT + (vt * 16 + fr) * 144 + (kk * 32 + fq * 8) * 2);
                    acc = __builtin_amdgcn_mfma_f32_16x16x32_bf16(bv, ap[kk], acc, 0, 0, 0);
                }
#pragma unroll
                for (int kk = 0; kk < 4; ++kk) {
                    const bf16x8 bv = *(const LAS bf16x8*)(STc + (vt * 16 + fr) * 272 + (kk * 32 + fq * 8) * 2);
                    acc = __builtin_amdgcn_mfma_f32_16x16x32_bf16(bv, ai[kk], acc, 0, 0, 0);
                }
                ow[vti][0] = cvt_pk_bf16(acc[0], acc[1]); ow[vti][1] = cvt_pk_bf16(acc[2], acc[3]);
            }
#pragma unroll
            for (int vti = 0; vti < 2; ++vti) *(LAS u32x2*)(PPW + fr * 144 + (vti * 16 + fq * 4) * 2) = (u32x2){ow[vti][0], ow[vti][1]};
            bf16x8 ak[2]; const f32x4 blv = *(const LAS f32x4*)(BL + wave * 16 + fq * 4);
#pragma unroll
            for (int kk = 0; kk < 2; ++kk) ak[kk] = *(const LAS bf16x8*)(KOT + (wave * 16 + fr) * 144 + (((kk * 4 + fq) + wave) & 7) * 16);
#pragma unroll
            for (int vt = 0; vt < 4; ++vt) {
                Sacc[vt] *= blv;
#pragma unroll
                for (int kk = 0; kk < 2; ++kk) {
                    const bf16x8 bv = *(const LAS bf16x8*)(VT + (vt * 16 + fr) * 144 + (kk * 32 + fq * 8) * 2);
                    Sacc[vt] = __builtin_amdgcn_mfma_f32_16x16x32_bf16(ak[kk], bv, Sacc[vt], 0, 0, 0);
                }
                *(LAS u32x2*)(STn + (vt * 16 + fr) * 272 + (wave * 16 + fq * 4) * 2) = (u32x2){pk2(Sacc[vt][0], Sacc[vt][1]), pk2(Sacc[vt][2], Sacc[vt][3])};
            }
            if (n + 1 < 68) GLA_CUMSUM(par ^ 1);
            __syncthreads();
        }
        GLA_OSTORE(67);
    }
}
#undef GLA_OSTORE
#undef GLA_CUMSUM
#undef GLA_LOAD
__device__ __forceinline__ void gla_readout_phase(const Args& a, int lane, int gw, int NGW) {
    const bf16_t* OF = (const bf16_t*)(a.ws + WS_OF); const bf16_t* OB = (const bf16_t*)(a.ws + WS_OB);
    const bf16_t* G = (const bf16_t*)(a.ws + WS_G); bf16_t* OG = (bf16_t*)(a.ws + WS_OG);
    f32x4 ng[4];
#pragma unroll
    for (int j = 0; j < 4; ++j) ng[j] = *(const f32x4*)(a.in[I_HGNG] + 16 * lane + 4 * j);
    for (int row0 = gw * 4; row0 < NTOK; row0 += NGW * 4) {
        u32x4 of[4][2], ob[4][2], gg[4][2];
#pragma unroll
        for (int r = 0; r < 4; ++r) { const size_t o = (size_t)(row0 + r) * D + 16 * lane;
            of[r][0] = *(const u32x4*)(OF + o); of[r][1] = *(const u32x4*)(OF + o + 8); ob[r][0] = *(const u32x4*)(OB + o); ob[r][1] = *(const u32x4*)(OB + o + 8);
            gg[r][0] = *(const u32x4*)(G + o); gg[r][1] = *(const u32x4*)(G + o + 8); }
#pragma unroll
        for (int r = 0; r < 4; ++r) {
            float v[16]; float s = 0.f;
#pragma unroll
            for (int q = 0; q < 8; ++q) { const unsigned wf = of[r][q >> 2][q & 3], wb = ob[r][q >> 2][q & 3]; v[2 * q] = bflo(wf) + bflo(wb); v[2 * q + 1] = bfhi(wf) + bfhi(wb); s += v[2 * q] * v[2 * q] + v[2 * q + 1] * v[2 * q + 1]; }
            s += __shfl_xor(s, 1); s += __shfl_xor(s, 2); s += __shfl_xor(s, 4);
            const float rstd = 1.0f / sqrtf(s * (1.0f / 128.0f) + EPS);
            unsigned ow[8];
#pragma unroll
            for (int q = 0; q < 8; ++q) { const unsigned wg = gg[r][q >> 2][q & 3];
                ow[q] = pk2(v[2 * q] * rstd * ng[q >> 1][(2 * q) & 3] * silu_f(bflo(wg)), v[2 * q + 1] * rstd * ng[q >> 1][(2 * q + 1) & 3] * silu_f(bfhi(wg))); }
            const size_t o = (size_t)(row0 + r) * D + 16 * lane;
            *(u32x4*)(OG + o) = (u32x4){ow[0], ow[1], ow[2], ow[3]}; *(u32x4*)(OG + o + 8) = (u32x4){ow[4], ow[5], ow[6], ow[7]};
        }
    }
}

struct EpiMoe1 {
    static constexpr bool PERM = true;
    const float* b1; bf16_t* ACT;
    __device__ __forceinline__ void operator()(const f32x4 (&acc)[2][2][4][2], const Unit& u, int wr, int wc, int fr, int fq) const {
        const int e = u.pn >> 3, pnl = u.pn & 7, cb = pnl * 128 + wc * 32 + 8 * fq, row0 = u.pm * 256 + wr * 64 + fr;
        const float* bg = b1 + (size_t)e * 2048;
        f32x4 bg0 = *(const f32x4*)(bg + cb), bg1 = *(const f32x4*)(bg + cb + 4), bl0 = *(const f32x4*)(bg + 1024 + cb), bl1 = *(const f32x4*)(bg + 1024 + cb + 4);
        pin(bg0); pin(bg1); pin(bl0); pin(bl1);
#pragma unroll
        for (int ai = 0; ai < 2; ++ai)
#pragma unroll
            for (int m = 0; m < 4; ++m) {
                f32x4 o[2];
#pragma unroll
                for (int n = 0; n < 2; ++n) {
                    const f32x4 zg = acc[ai][0][m][n] + (n ? bg1 : bg0), zl = acc[ai][1][m][n] + (n ? bl1 : bl0);
#pragma unroll
                    for (int j = 0; j < 4; ++j) { const float g_ = fminf(zg[j], 7.0f), l_ = fminf(fmaxf(zl[j], -7.0f), 7.0f); o[n][j] = g_ * sigmoid_f(1.702f * g_) * (l_ + 1.0f); }
                }
                *(u32x4*)(ACT + (size_t)(row0 + ai * 128 + m * 16) * D + cb) = (u32x4){pk2(o[0][0], o[0][1]), pk2(o[0][2], o[0][3]), pk2(o[1][0], o[1][1]), pk2(o[1][2], o[1][3])};
            }
    }
};
struct EpiMoe2 {
    static constexpr bool PERM = true;
    const float* b2; bf16_t* YS;
    __device__ __forceinline__ void operator()(const f32x4 (&acc)[2][2][4][2], const Unit& u, int wr, int wc, int fr, int fq) const {
        const int e = u.pn >> 2, pnl = u.pn & 3, cb = pnl * 256 + wc * 32 + 8 * fq, row0 = u.pm * 256 + wr * 64 + fr;
        const float* bb = b2 + (size_t)e * 1024;
        f32x4 bvv[2][2];
#pragma unroll
        for (int bj = 0; bj < 2; ++bj) { bvv[bj][0] = *(const f32x4*)(bb + cb + bj * 128); bvv[bj][1] = *(const f32x4*)(bb + cb + bj * 128 + 4); }
#pragma unroll
        for (int bj = 0; bj < 2; ++bj) { pin(bvv[bj][0]); pin(bvv[bj][1]); }
#pragma unroll
        for (int bj = 0; bj < 2; ++bj) {
            const int c = cb + bj * 128; const f32x4 bv0 = bvv[bj][0], bv1 = bvv[bj][1];
#pragma unroll
            for (int ai = 0; ai < 2; ++ai)
#pragma unroll
                for (int m = 0; m < 4; ++m) {
                    const f32x4 v0 = acc[ai][bj][m][0] + bv0, v1 = acc[ai][bj][m][1] + bv1;
                    *(u32x4*)(YS + (size_t)(row0 + ai * 128 + m * 16) * D + c) = (u32x4){pk2(v0[0], v0[1]), pk2(v0[2], v0[3]), pk2(v1[0], v1[1]), pk2(v1[2], v1[3])};
                }
        }
    }
};

__device__ __forceinline__ void router_phase(const Args& a, LAS unsigned char* lds, int layer, int row_lo, int tid) {
    const int lane = tid & 63, wave = tid >> 6, fr = lane & 15, fq = lane >> 4;
    const bf16_t* H = (const bf16_t*)(a.ws + WS_H); bf16_t* F = (bf16_t*)(a.ws + WS_F);
    const float* modv = (const float*)(a.ws + WS_MODV) + (size_t)layer * 9 * 6144;
    int* TOKE = (int*)(a.ws + WS_TOKE); float* TOKW = (float*)(a.ws + WS_TOKW);
    unsigned* cntb = (unsigned*)(a.ws + WS_CTL) + CW_CNTB + layer * 8192;
    LAS unsigned char* FH = lds;
    LAS unsigned char* FL = lds + 16 * 2064;
    LAS float* PART0 = (LAS float*)(lds + 2 * 16 * 2064);
    LAS int* hist = (LAS int*)(lds + 2 * 16 * 2064 + 32768);
    LAS float* G2 = (LAS float*)(lds + 2 * 16 * 2064 + 32768 + 256);
    LAS float* MS0 = (LAS float*)(lds + 2 * 16 * 2064 + 32768 + 256 + 4096);
    if (tid < 32) hist[tid] = 0;
    const float* n2g = a.in[I_N2G] + layer * D; const float* rw = a.in[I_RW] + (size_t)layer * D * NE; const float* rb = a.in[I_RB] + layer * NE;
    const float* rwp = rw + (size_t)(wave * 128 + fq * 8) * NE + fr;
    bf16x8 rwH[2][4], rwL[2][4];
#pragma unroll
    for (int kk = 0; kk < 4; ++kk) {
#pragma unroll
        for (int et = 0; et < 2; ++et)
#pragma unroll
            for (int j = 0; j < 8; ++j) {
                const float w = rwp[kk * 32 * NE + j * NE + et * 16];
                const unsigned h = f2bf(w); const float lo = w - bf2f((unsigned short)h);
                rwH[et][kk][j] = (short)h; rwL[et][kk][j] = (short)f2bf(lo);
            }
        if (kk & 1) asm volatile("" ::: "memory");
    }
    const int ngroups = (NTOK - row_lo) >> 4;
    u32x2 vvp[2][4]; f32x4 msv;
    if (tid < 256) *(LAS f32x4*)(G2 + 4 * tid) = *(const f32x4*)(n2g + 4 * tid);
#define RT_LOAD(gi_) do { const int gl_ = (gi_) < ngroups ? (gi_) : ngroups - 1;        \
        msv = *(const f32x4*)(modv + (size_t)mod_row(row_lo + gl_ * 16) * 6144 + (tid < 256 ? 4096 + 4 * tid : 3072 + 4 * (tid - 256))); \
        _Pragma("unroll") for (int rr = 0; rr < 2; ++rr) _Pragma("unroll") for (int j = 0; j < 4; ++j) \
        vvp[rr][j] = *(const u32x2*)(H + (size_t)(row_lo + gl_ * 16 + 2 * wave + rr) * D + 4 * lane + 256 * j); } while (0)
#define RT_PUTMS(par_) do { f32x4 o_ = msv; if (tid < 256) o_ = *(const LAS f32x4*)(G2 + 4 * tid) * (msv + 1.0f); *(LAS f32x4*)(MS0 + (par_) * 2048 + 4 * tid) = o_; } while (0)
    const float rbv = rb[lane & 31];
    RT_LOAD((int)blockIdx.x);
    int pend_i = 0; float pend_w = 0.f; long pend_o = -1; int gpar = 0;
    __syncthreads();
    RT_PUTMS(0);
    __syncthreads();
    for (int gi = blockIdx.x; gi < ngroups; gi += gridDim.x, gpar ^= 1) {
        const int row0 = row_lo + gi * 16;
        LAS float* PART = PART0 + gpar * 4096;
#pragma unroll
        for (int rr = 0; rr < 2; ++rr) {
            const int rl = 2 * wave + rr, row = row0 + rl; f32x4 v[4];
#pragma unroll
            for (int j = 0; j < 4; ++j) { const u32x2 w = vvp[rr][j]; v[j] = (f32x4){bflo(w.x), bfhi(w.x), bflo(w.y), bfhi(w.y)}; }
            const float rstd = row_rstd(v);
#pragma unroll
            for (int j = 0; j < 4; ++j) {
                const int c = 4 * lane + 256 * j;
                const f32x4 f = v[j] * rstd * *(const LAS f32x4*)(MS0 + gpar * 2048 + c) + *(const LAS f32x4*)(MS0 + gpar * 2048 + 1024 + c);
                { const unsigned h01 = cvt_pk_bf16(f[0], f[1]), h23 = cvt_pk_bf16(f[2], f[3]);
                  *(u32x2*)(F + (size_t)row * D + c) = (u32x2){h01, h23};
                  *(LAS u32x2*)(FH + rl * 2064 + c * 2) = (u32x2){h01, h23};
                  *(LAS u32x2*)(FL + rl * 2064 + c * 2) = (u32x2){cvt_pk_bf16(f[0] - bflo(h01), f[1] - bfhi(h01)), cvt_pk_bf16(f[2] - bflo(h23), f[3] - bfhi(h23))}; }
            }
        }
        if (pend_o >= 0) { TOKE[pend_o] = pend_i; TOKW[pend_o] = pend_w; pend_o = -1; }
        RT_LOAD(gi + (int)gridDim.x);
        __syncthreads();
        f32x4 acc0 = (f32x4){0.f, 0.f, 0.f, 0.f}, acc1 = (f32x4){0.f, 0.f, 0.f, 0.f};
        bf16x8 aH[4], aL[4];
#pragma unroll
        for (int kk = 0; kk < 4; ++kk) { aH[kk] = *(const LAS bf16x8*)(FH + fr * 2064 + (wave * 128 + kk * 32 + fq * 8) * 2); aL[kk] = *(const LAS bf16x8*)(FL + fr * 2064 + (wave * 128 + kk * 32 + fq * 8) * 2); }
#pragma unroll
        for (int kk = 0; kk < 4; ++kk) {
            acc0 = __builtin_amdgcn_mfma_f32_16x16x32_bf16(aL[kk], rwH[0][kk], acc0, 0, 0, 0); acc1 = __builtin_amdgcn_mfma_f32_16x16x32_bf16(aL[kk], rwH[1][kk], acc1, 0, 0, 0);
            acc0 = __builtin_amdgcn_mfma_f32_16x16x32_bf16(aH[kk], rwL[0][kk], acc0, 0, 0, 0); acc1 = __builtin_amdgcn_mfma_f32_16x16x32_bf16(aH[kk], rwL[1][kk], acc1, 0, 0, 0);
            acc0 = __builtin_amdgcn_mfma_f32_16x16x32_bf16(aH[kk], rwH[0][kk], acc0, 0, 0, 0); acc1 = __builtin_amdgcn_mfma_f32_16x16x32_bf16(aH[kk], rwH[1][kk], acc1, 0, 0, 0);
        }
#pragma unroll
        for (int j = 0; j < 4; ++j) { PART[(wave * 16 + fq * 4 + j) * 32 + fr] = acc0[j]; PART[(wave * 16 + fq * 4 + j) * 32 + 16 + fr] = acc1[j]; }
        RT_PUTMS(gpar ^ 1);
        __syncthreads();
        {
            const int half = lane >> 5, e = lane & 31, rl = 2 * wave + half, row = row0 + rl;
            float lg = rbv;
#pragma unroll
            for (int w = 0; w < 8; ++w) lg += PART[(w * 16 + rl) * 32 + e];
            float sv[4]; int si[4];
#pragma unroll
            for (int r = 0; r < 4; ++r) {
                float m = lg;
                m = fmaxf(m, __builtin_bit_cast(float, __builtin_amdgcn_update_dpp(0, __builtin_bit_cast(int, m), 0xB1, 0xF, 0xF, false)));
                m = fmaxf(m, __builtin_bit_cast(float, __builtin_amdgcn_update_dpp(0, __builtin_bit_cast(int, m), 0x4E, 0xF, 0xF, false)));
                m = fmaxf(m, __builtin_bit_cast(float, __builtin_amdgcn_update_dpp(0, __builtin_bit_cast(int, m), 0x141, 0xF, 0xF, false)));
                m = fmaxf(m, __builtin_bit_cast(float, __builtin_amdgcn_update_dpp(0, __builtin_bit_cast(int, m), 0x140, 0xF, 0xF, false)));
                m = fmaxf(m, __builtin_bit_cast(float, __builtin_amdgcn_ds_swizzle(__builtin_bit_cast(int, m), 0x401F)));
                const unsigned long long bal = __ballot(lg == m); const unsigned mine = (unsigned)(bal >> (32 * half));
                const int idx = __ffs((int)mine) - 1;
                sv[r] = m; si[r] = idx; if (e == idx) lg = -3.0e38f;
            }
            const float e1 = __expf(sv[1] - sv[0]), e2 = __expf(sv[2] - sv[0]), e3 = __expf(sv[3] - sv[0]); const float inv = __builtin_amdgcn_rcpf(1.0f + e1 + e2 + e3);
            if (e < 4) {
                const int myi = e == 0 ? si[0] : (e == 1 ? si[1] : (e == 2 ? si[2] : si[3]));
                const float myw = (e == 0 ? 1.0f : (e == 1 ? e1 : (e == 2 ? e2 : e3))) * inv;
                pend_i = myi; pend_w = myw; pend_o = (long)row * 4 + e;
                atomicAdd((int*)hist + myi, 1);
            }
        }
    }
    if (pend_o >= 0) { TOKE[pend_o] = pend_i; TOKW[pend_o] = pend_w; }
    __syncthreads();
    if (tid < 32) cntb[(size_t)blockIdx.x * 32 + tid] = (unsigned)hist[tid];
}
#undef RT_LOAD
#undef RT_PUTMS
__device__ __forceinline__ void assign_phase(const Args& a, LAS unsigned char* lds, int layer, int row_lo, int tid) {
    const int lane = tid & 63, wave = tid >> 6;
    const unsigned* cntb = (const unsigned*)(a.ws + WS_CTL) + CW_CNTB + layer * 8192; unsigned* gcnt = (unsigned*)(a.ws + WS_CTL) + CW_CNT + layer * 64;
    const bf16_t* F = (const bf16_t*)(a.ws + WS_F); bf16_t* AG = (bf16_t*)(a.ws + WS_AG);
    const int* TOKE = (const int*)(a.ws + WS_TOKE); int* TOKS = (int*)(a.ws + WS_TOKS);
    LAS int* off = (LAS int*)lds; LAS int* cnt = (LAS int*)(lds + 256); LAS int* base = (LAS int*)(lds + 512); LAS int* cur = (LAS int*)(lds + 768);
    LAS int* pa = (LAS int*)(lds + 1024); LAS int* pl = (LAS int*)(lds + 1024 + 2048);
    {
        const int e = tid & 31, part = tid >> 5; int s_all = 0, s_lt = 0;
        for (int bb = part; bb < (int)gridDim.x; bb += 16) { const int c = (int)cntb[(size_t)bb * 32 + e]; s_all += c; if (bb < (int)blockIdx.x) s_lt += c; }
        pa[part * 32 + e] = s_all; pl[part * 32 + e] = s_lt;
    }
    __syncthreads();
    if (tid < 32) { int s_all = 0, s_lt = 0; for (int p = 0; p < 16; ++p) { s_all += pa[p * 32 + tid]; s_lt += pl[p * 32 + tid]; } cnt[tid] = s_all; base[tid] = s_lt; cur[tid] = 0; if (blockIdx.x == 0) gcnt[tid] = (unsigned)s_all; }
    __syncthreads();
    if (tid == 0) { int o = 0; for (int e = 0; e < 32; ++e) { off[e] = o; o += ((cnt[e] + 255) >> 8) << 8; } }
    __syncthreads();
    if (tid < 32) base[tid] += off[tid];
    __syncthreads();
    const int gw = blockIdx.x * 8 + wave, NGW = gridDim.x * 8;
    int* SLOTTOK = (int*)(a.ws + WS_SLOTTOK);
    for (int idx = blockIdx.x * NTHREADS + tid; idx < 32 * 256; idx += gridDim.x * NTHREADS) {
        const int e = idx >> 8, c = cnt[e], r = c + (idx & 255), padded = ((c + 255) >> 8) << 8;
        if (r < padded) SLOTTOK[off[e] + r] = 0;
    }
    const int ngroups = (NTOK - row_lo) >> 4;
    for (int gi = blockIdx.x; gi < ngroups; gi += gridDim.x) {
        const int r0 = row_lo + gi * 16 + 2 * wave;
        if (lane < 8) { const int e = TOKE[(size_t)r0 * 4 + lane]; const int pos = atomicAdd((int*)cur + e, 1); const int slot = base[e] + pos; TOKS[(size_t)r0 * 4 + lane] = slot; SLOTTOK[slot] = r0 + (lane >> 2); }
    }
    (void)gw; (void)NGW; (void)F; (void)AG;
    if (layer == 0) { __syncthreads(); tail_fill(a, lds, 2, (int)gridDim.x, (int)blockIdx.x, DQ_L0, 0, -1, 0, 0, DQ_L0); }
}
__device__ __forceinline__ int moe_tiles(const Args& a, LAS unsigned char* lds, int layer, int tid) {
    const unsigned* gcnt = (const unsigned*)(a.ws + WS_CTL) + CW_CNT + layer * 64;
    LAS int* tbl = (LAS int*)(lds + 131072 + 1024);
    if (tid < 64) {
        const int e = tid & 31, nt = tid < 32 ? (((int)gcnt[e] + 255) >> 8) : 0;
        int incl = nt;
#pragma unroll
        for (int o = 1; o < 32; o <<= 1) { const int v = __shfl_up(incl, o); if (tid >= o) incl += v; }
        if (tid < 32) { const int start = incl - nt; for (int k = 0; k < nt; ++k) tbl[start + k] = e; }
        if (tid == 31) tbl[1000] = incl;
    }
    __syncthreads();
    return tbl[1000];
}
__device__ __forceinline__ void combine_phase(const Args& a, int layer, int row_lo, int lane, int gw, int NGW) {
    bf16_t* H = (bf16_t*)(a.ws + WS_H); const bf16_t* YS = (const bf16_t*)(a.ws + WS_YS);
    const int* TOKS = (const int*)(a.ws + WS_TOKS); const float* TOKW = (const float*)(a.ws + WS_TOKW);
    const float* modv = (const float*)(a.ws + WS_MODV);
    const int npairs = (NTOK - row_lo) >> 1, p0 = (int)(((long)gw * npairs) / NGW), p1 = (int)(((long)(gw + 1) * npairs) / NGW);
    int mr_cur = -1; f32x4 g2v[4]; ModVec m;
    if (layer != 0) {
#pragma unroll
        for (int j = 0; j < 4; ++j) m.g[j] = *(const f32x4*)(a.in[I_FG] + 4 * lane + 256 * j);
    }
    for (int pp = p0; pp < p1; ++pp) {
        const int row0 = row_lo + 2 * pp;
        const int mr = mod_row(row0);
        u32x4 sl[2]; f32x4 wv[2];
#pragma unroll
        for (int r = 0; r < 2; ++r) { sl[r] = *(const u32x4*)(TOKS + (size_t)(row0 + r) * 4); wv[r] = *(const f32x4*)(TOKW + (size_t)(row0 + r) * 4); }
        u32x2 ys[2][4][4]; f32x4 hv[2][4];
#pragma unroll
        for (int r = 0; r < 2; ++r)
#pragma unroll
            for (int j = 0; j < 4; ++j) {
                hv[r][j] = ld_bf16x4(H + (size_t)(row0 + r) * D + 4 * lane + 256 * j);
#pragma unroll
                for (int k = 0; k < 4; ++k) ys[r][k][j] = *(const u32x2*)(YS + (size_t)sl[r][k] * D + 4 * lane + 256 * j);
            }
        if (mr != mr_cur) {
            mr_cur = mr;
            const float* g2 = modv + (size_t)(layer * 9 + mr) * 6144 + 5120;
#pragma unroll
            for (int j = 0; j < 4; ++j) g2v[j] = *(const f32x4*)(g2 + 4 * lane + 256 * j);
            if (layer == 0) { const float* mv = modv + (size_t)(9 + mr) * 6144; modvec_load(m, a.in[I_N1G] + D, mv + 1024, mv, lane); }
        }
#pragma unroll
        for (int r = 0; r < 2; ++r) {
            const int row = row0 + r; f32x4 v[4];
#pragma unroll
            for (int j = 0; j < 4; ++j) {
                const int c = 4 * lane + 256 * j; f32x4 y = (f32x4){0.f, 0.f, 0.f, 0.f};
#pragma unroll
                for (int k = 0; k < 4; ++k) { const u32x2 w = ys[r][k][j]; y += (f32x4){bflo(w.x), bfhi(w.x), bflo(w.y), bfhi(w.y)} * wv[r][k]; }
                v[j] = hv[r][j] + g2v[j] * y;
                if (layer == 0) st_bf16x4(H + (size_t)row * D + c, v[j]);
            }
            const float rstd = row_rstd(v);
            if (layer == 0) {
                int orow = row;
                if (row >= NCTX) { const int li = row - NCTX, b = li >> 12, t = li & 4095; orow = NCTX + b * SEQ + (t & 63) * 64 + (t >> 6); }
                norm_mod_store(v, rstd, m, (bf16_t*)(a.ws + WS_A) + (size_t)orow * D, lane);
            } else {
#pragma unroll
                for (int j = 0; j < 4; ++j) { const int c = 4 * lane + 256 * j; *(f32x4*)(a.out + (size_t)(row - NCTX) * D + c) = v[j] * rstd * m.g[j]; }
            }
        }
    }
}
__device__ __forceinline__ void moe_gemm1(const Args& a, LAS unsigned char* lds, int layer, int tid, int G, int vcu) {
    unsigned char* ws = a.ws;
    const int TT = moe_tiles(a, lds, layer, tid);
    const LAS int* tbl = (const LAS int*)(lds + 131072 + 1024);
    pg8::Gemm g{(const bf16_t*)(ws + WS_F), (const bf16_t*)(ws + WS_W1) + (size_t)layer * 32 * 2048 * 1024, MPAD, 32 * 2048, 1024};
    pg8::MoeOrder S{tbl, TT, 3, G, vcu};
    EpiMoe1 E{a.in[I_B1] + (size_t)layer * 32 * 2048, (bf16_t*)(ws + WS_ACT)};
    LAS unsigned short* rowl = (LAS unsigned short*)(lds + 136192);
    { const int* slottok = (const int*)(ws + WS_SLOTTOK); pg8::Unit uu; int t2 = threadIdx.x; asm volatile("" : "+v"(t2)); const int tid = t2;
      int pmv[11], slv[11];
      _Pragma("unroll") for (int k = 0; k < 11; ++k) { const int ii = 2 * k + (tid >> 8); const bool ok = ii < 21 && S.next(ii, uu); pmv[k] = ok ? uu.pm : -1; }
      _Pragma("unroll") for (int k = 0; k < 11; ++k) slv[k] = slottok[(pmv[k] < 0 ? 0 : pmv[k]) * 256 + (tid & 255)];
      _Pragma("unroll") for (int k = 0; k < 11; ++k) if (pmv[k] >= 0) rowl[(2 * k + (tid >> 8)) * 256 + (tid & 255)] = (unsigned short)slv[k]; }
    __syncthreads();
    pg8::gemm_phase<EpiMoe1, pg8::MoeOrder, true>(lds, g, S, E, rowl);
    if (layer == 0) { int ni, rk; S.idle(ni, rk); tail_fill(a, lds, 3, 0, -1, 0, ni, rk, TF_K_M1, DQ_L0, DQ_TOTAL); }
}
__device__ __forceinline__ void moe_gemm2(const Args& a, LAS unsigned char* lds, int layer, int tid, int G, int vcu) {
    unsigned char* ws = a.ws;
    const int TT = moe_tiles(a, lds, layer, tid);
    const LAS int* tbl = (const LAS int*)(lds + 131072 + 1024);
    pg8::Gemm g{(const bf16_t*)(ws + WS_ACT), (const bf16_t*)(ws + WS_W2) + (size_t)layer * 32 * 1024 * 1024, MPAD, 32 * 1024, 1024};
    pg8::MoeOrder S{tbl, TT, 2, G, vcu};
    EpiMoe2 E{a.in[I_B2] + (size_t)layer * 32 * 1024, (bf16_t*)(ws + WS_YS)};
    pg8::gemm_phase<EpiMoe2, pg8::MoeOrder>(lds, g, S, E);
    if (layer == 0) { int ni, rk; S.idle(ni, rk); tail_fill(a, lds, 4, 0, -1, 0, ni, rk, TF_K_M2, DQ_L0, DQ_TOTAL); }
}


__device__ __forceinline__ void s5_disc(const Args& a, int d, int g, int p, float& ab_re, float& ab_im, float& co_re, float& co_im) {
    const float lam_re = fminf(a.in[I_S5ARE][(d * 64 + g) * 64 + p], -1e-4f), lam_im = a.in[I_S5AIM][(d * 64 + g) * 64 + p];
    const float dt = expf(a.in[I_S5LDT][d * 64 + g]);
    const float mag = expf(lam_re * dt), ang = lam_im * dt;
    ab_re = mag * cosf(ang); ab_im = mag * sinf(ang);
    const float den = lam_re * lam_re + lam_im * lam_im;
    co_re = ((ab_re - 1.0f) * lam_re + ab_im * lam_im) / den;
    co_im = (ab_im * lam_re - (ab_re - 1.0f) * lam_im) / den;
}
#define S5_PD 4
__device__ __forceinline__ void s5_phase(const Args& a, LAS unsigned char* lds, int tid) {
    const int lane = tid & 63, wave = tid >> 6, fr = lane & 15, fq = lane >> 4;
    if (wave >= 4) {
        LAS unsigned* scr = (LAS unsigned*)(lds + 104448 + (wave - 4) * 8320);
        const int cw = blockIdx.x * 4 + (wave - 4), NCW = gridDim.x * 4;
#define L1_ITEM(i) moe_item(a, (i), 1)
        int cqb = (int)__builtin_nontemporal_load((const unsigned*)(a.ws + WS_CTL) + CW_CQ + 5); cqb = cqb < DQ_L0 ? DQ_L0 : cqb;
#define DQ_ITEM(i) dq_item(a, (i))
        TR_LOOP(cqb + cw, NCW, DQ_TOTAL, DQ_ITEM);
#undef DQ_ITEM
#undef L1_ITEM
        return;
    }
    LAS unsigned char* wl = lds + wave * 26112;
    const bf16_t* A1 = (const bf16_t*)(a.ws + WS_A);
    for (int item = blockIdx.x; item < 256; item += gridDim.x) {
        const int b = item >> 5, dir = (item >> 4) & 1, g = (item & 15) * 4 + wave;
        bf16_t* Y = (bf16_t*)(a.ws + (dir ? WS_YB : WS_YF));
        float ab_re, ab_im, cr_, ci_;
        s5_disc(a, dir, g, lane, ab_re, ab_im, cr_, ci_);
        bf16x8 Bd[4], Cf[4];
        {
            f32x4 cre[4], cim[4];
#pragma unroll
            for (int kk = 0; kk < 4; ++kk) { const size_t o = ((size_t)(dir * 64 + g) * 16 + fr) * 64 + kk * 16 + fq * 4; cre[kk] = *(const f32x4*)(a.in[I_S5CRE] + o); cim[kk] = *(const f32x4*)(a.in[I_S5CIM] + o); }
#pragma unroll
            for (int kk = 0; kk < 4; ++kk)
#pragma unroll
                for (int j = 0; j < 8; ++j) Cf[kk][j] = (short)f2bf((j & 1) ? -cim[kk][j >> 1] : cre[kk][j >> 1]);
            {
                const int c31 = lane & 31, h5 = lane >> 5;
                f32x4 br0[2], br1[2], bi0[2], bi1[2];
#pragma unroll
                for (int sh = 0; sh < 2; ++sh) {
                    const int pp = sh * 32 + c31; const size_t o = (size_t)(g * 64 + pp) * 16 + h5 * 8;
                    br0[sh] = *(const f32x4*)(a.in[I_S5BRE] + o); br1[sh] = *(const f32x4*)(a.in[I_S5BRE] + o + 4); bi0[sh] = *(const f32x4*)(a.in[I_S5BIM] + o); bi1[sh] = *(const f32x4*)(a.in[I_S5BIM] + o + 4);
                }
#pragma unroll
                for (int sh = 0; sh < 2; ++sh) {
                    const int pp = sh * 32 + c31; const float qr = __shfl(cr_, pp), qi = __shfl(ci_, pp);
#pragma unroll
                    for (int j = 0; j < 8; ++j) {
                        const float br = j < 4 ? br0[sh][j & 3] : br1[sh][j & 3], bi = j < 4 ? bi0[sh][j & 3] : bi1[sh][j & 3];
                        Bd[sh][j] = (short)f2bf(qr * br - qi * bi); Bd[2 + sh][j] = (short)f2bf(qr * bi + qi * br);
                    }
                }
            }
        }
#define S5_POS(n_, t_) ((((n_) < 8) ? (n_) : (n_) - 8) * 32 + (t_))
#define S5_ROW(n_, t_) ((((n_) < 8) ? b * CTXL : NCTX + b * SEQ) + (dir ? (((n_) < 8) ? CTXL : SEQ) - 1 - S5_POS(n_, t_) : S5_POS(n_, t_)))
#define S5_LOADU(d0, n_) do { const int nl_ = (n_) < 136 ? (n_) : 135; d0 = *(const bf16x8*)(A1 + (size_t)S5_ROW(nl_, lane & 31) * D + g * 16 + (lane >> 5) * 8); } while (0)
        LAS float* BUF = (LAS float*)wl; LAS unsigned* HW = (LAS unsigned*)(wl + 17408); const LAS unsigned char* HP = wl + 17408;
        bf16x8 uu[S5_PD];
        for (int i_ = 0; i_ < S5_PD; ++i_) S5_LOADU(uu[i_], i_);
        f32x2 s = (f32x2){0.f, 0.f};
        const f32x2 abr = (f32x2){ab_re, ab_re}, abi = (f32x2){-ab_im, ab_im};
        bf16_t* yp = Y + (size_t)(b * SEQ + (dir ? SEQ - 1 - fq * 4 : fq * 4)) * D + g * 16 + fr;
        const long ystep = dir ? -(long)D : (long)D;
        unsigned yw[4] = {0u, 0u, 0u, 0u};
#define S5_YSTORE() do { yp[0] = (bf16_t)(yw[0] & 0xffffu); yp[ystep] = (bf16_t)(yw[0] >> 16); yp[2 * ystep] = (bf16_t)(yw[1] & 0xffffu); yp[3 * ystep] = (bf16_t)(yw[1] >> 16); \
            yp[16 * ystep] = (bf16_t)(yw[2] & 0xffffu); yp[17 * ystep] = (bf16_t)(yw[2] >> 16); yp[18 * ystep] = (bf16_t)(yw[3] & 0xffffu); yp[19 * ystep] = (bf16_t)(yw[3] >> 16); yp += 32 * ystep; } while (0)
        for (int n2 = 0; n2 < 136; n2 += S5_PD)
#pragma unroll
        for (int hh = 0; hh < S5_PD; ++hh) {
            const int n = n2 + hh;
            typedef float f32x16 __attribute__((ext_vector_type(16)));
            f32x16 xr[2], xi[2];
            {
                f32x16 z; for (int r = 0; r < 16; ++r) z[r] = 0.f;
                xr[0] = __builtin_amdgcn_mfma_f32_32x32x16_bf16(uu[hh], Bd[0], z, 0, 0, 0); xr[1] = __builtin_amdgcn_mfma_f32_32x32x16_bf16(uu[hh], Bd[1], z, 0, 0, 0);
                xi[0] = __builtin_amdgcn_mfma_f32_32x32x16_bf16(uu[hh], Bd[2], z, 0, 0, 0); xi[1] = __builtin_amdgcn_mfma_f32_32x32x16_bf16(uu[hh], Bd[3], z, 0, 0, 0);
#pragma unroll
                for (int r = 0; r < 16; ++r) {
                    const auto pr = __builtin_amdgcn_permlane32_swap(__float_as_uint(xr[0][r]), __float_as_uint(xr[1][r]), false, false); xr[0][r] = __uint_as_float(pr[0]); xr[1][r] = __uint_as_float(pr[1]);
                    const auto pi = __builtin_amdgcn_permlane32_swap(__float_as_uint(xi[0][r]), __float_as_uint(xi[1][r]), false, false); xi[0][r] = __uint_as_float(pi[0]); xi[1][r] = __uint_as_float(pi[1]);
                }
            }
            if (n >= 9) S5_YSTORE();
            S5_LOADU(uu[hh], n + S5_PD);
            {
                const bool hist = n >= 8;
                unsigned hw[32];
#pragma unroll
                for (int j = 0; j < 32; ++j) { const int hs = (j >> 2) & 1, r = (j & 3) + 4 * (j >> 3); const f32x2 bu = (f32x2){xr[hs][r], xi[hs][r]};
                    const f32x2 t1 = abr * s + bu; s = abi * (f32x2){s.y, s.x} + t1; hw[j] = cvt_pk_bf16(s.x, s.y); }
                if (hist) {
#pragma unroll
                    for (int j = 0; j < 32; ++j) HW[j * 68 + lane] = hw[j];
                }
            }
            LDS_WAIT();
            if (n >= 8) {
                f32x4 y0 = (f32x4){0.f, 0.f, 0.f, 0.f}, y1 = (f32x4){0.f, 0.f, 0.f, 0.f};
                bf16x8 ha[2][4];
#pragma unroll
                for (int hf = 0; hf < 2; ++hf)
#pragma unroll
                    for (int kk = 0; kk < 4; ++kk) ha[hf][kk] = *(const LAS bf16x8*)(HP + (hf * 16 + fr) * 272 + (kk * 32 + fq * 8) * 2);
                asm volatile("" :: "v"(ha[0][0]), "v"(ha[0][1]), "v"(ha[0][2]), "v"(ha[0][3]), "v"(ha[1][0]), "v"(ha[1][1]), "v"(ha[1][2]), "v"(ha[1][3]));
#pragma unroll
                for (int kk = 0; kk < 4; ++kk) { y0 = __builtin_amdgcn_mfma_f32_16x16x32_bf16(ha[0][kk], Cf[kk], y0, 0, 0, 0); y1 = __builtin_amdgcn_mfma_f32_16x16x32_bf16(ha[1][kk], Cf[kk], y1, 0, 0, 0); }
                yw[0] = cvt_pk_bf16(y0[0], y0[1]); yw[1] = cvt_pk_bf16(y0[2], y0[3]); yw[2] = cvt_pk_bf16(y1[0], y1[1]); yw[3] = cvt_pk_bf16(y1[2], y1[3]);
                LDS_WAIT();
            }
        }
        S5_YSTORE();
#undef S5_YSTORE
#undef S5_POS
#undef S5_ROW
#undef S5_LOADU
    }
}
__device__ __forceinline__ float gelu_tanh_f(float x) { const float z = 0.7978845608f * (x + 0.044715f * x * x * x); return x * (1.0f - __builtin_amdgcn_rcpf(1.0f + __expf(2.0f * z))); }
__device__ __forceinline__ void s5_post_phase(const Args& a, int lane, int gw, int NGW) {
    const bf16_t* YF = (const bf16_t*)(a.ws + WS_YF); const bf16_t* YB = (const bf16_t*)(a.ws + WS_YB);
    const bf16_t* A1 = (const bf16_t*)(a.ws + WS_A); bf16_t* YG = (bf16_t*)(a.ws + WS_YG);
    f32x4 dk[4];
#pragma unroll
    for (int j = 0; j < 4; ++j) dk[j] = *(const f32x4*)(a.in[I_S5D] + 4 * lane + 256 * j);
    for (int tok0 = gw * 4; tok0 < NLAT; tok0 += NGW * 4) {
        u32x2 yf[4][4], yb[4][4], uu[4][4];
#pragma unroll
        for (int r = 0; r < 4; ++r) { const int tok = tok0 + r, b = tok >> 12, t = tok & 4095, src = b * SEQ + (t & 63) * 64 + (t >> 6);
#pragma unroll
            for (int j = 0; j < 4; ++j) { const int c = 4 * lane + 256 * j; yf[r][j] = *(const u32x2*)(YF + (size_t)src * D + c); yb[r][j] = *(const u32x2*)(YB + (size_t)src * D + c); uu[r][j] = *(const u32x2*)(A1 + (size_t)(NCTX + src) * D + c); } }
#pragma unroll
        for (int r = 0; r < 4; ++r)
#pragma unroll
            for (int j = 0; j < 4; ++j) {
                const u32x2 f = yf[r][j], bk = yb[r][j], uw = uu[r][j];
                const f32x4 y = (f32x4){bflo(f.x) + bflo(bk.x), bfhi(f.x) + bfhi(bk.x), bflo(f.y) + bflo(bk.y), bfhi(f.y) + bfhi(bk.y)} + dk[j] * (f32x4){bflo(uw.x), bfhi(uw.x), bflo(uw.y), bfhi(uw.y)};
                f32x4 o;
#pragma unroll
                for (int i = 0; i < 4; ++i) o[i] = gelu_tanh_f(y[i]);
                st_bf16x4(YG + (size_t)(tok0 + r) * D + 4 * lane + 256 * j, o);
            }
    }
}
struct EpiGlu {
    static constexpr bool PERM = true;
    const float* bglu; const float* modv1; bf16_t* H;
    __device__ __forceinline__ void operator()(const f32x4 (&acc)[2][2][4][2], const Unit& u, int wr, int wc, int fr, int fq) const {
        const int rt0 = u.pm * 256, bidx = rt0 >> 12, cb = u.pn * 128 + wc * 32 + 8 * fq, rl0 = wr * 64 + fr;
        const float* gp = modv1 + bidx * 6144 + 2048;
        f32x4 ba0 = *(const f32x4*)(bglu + cb), ba1 = *(const f32x4*)(bglu + cb + 4), bb0 = *(const f32x4*)(bglu + 1024 + cb), bb1 = *(const f32x4*)(bglu + 1024 + cb + 4);
        f32x4 gv0 = *(const f32x4*)(gp + cb), gv1 = *(const f32x4*)(gp + cb + 4);
        pin(ba0); pin(ba1); pin(bb0); pin(bb1); pin(gv0); pin(gv1);
        u32x4 hws[2][4];
#pragma unroll
        for (int ai = 0; ai < 2; ++ai)
#pragma unroll
            for (int m = 0; m < 4; ++m) hws[ai][m] = *(const u32x4*)(H + (size_t)(NCTX + rt0 + rl0 + ai * 128 + m * 16) * D + cb);
#pragma unroll
        for (int ai = 0; ai < 2; ++ai)
#pragma unroll
            for (int m = 0; m < 4; ++m) {
                bf16_t* hp = H + (size_t)(NCTX + rt0 + rl0 + ai * 128 + m * 16) * D + cb;
                const u32x4 hw = hws[ai][m]; const f32x4 h0 = (f32x4){bflo(hw.x), bfhi(hw.x), bflo(hw.y), bfhi(hw.y)}, h1 = (f32x4){bflo(hw.z), bfhi(hw.z), bflo(hw.w), bfhi(hw.w)};
                const f32x4 za0 = acc[ai][0][m][0] + ba0, za1 = acc[ai][0][m][1] + ba1, zb0 = acc[ai][1][m][0] + bb0, zb1 = acc[ai][1][m][1] + bb1; f32x4 o0, o1;
#pragma unroll
                for (int j = 0; j < 4; ++j) { o0[j] = za0[j] * sigmoid_f(zb0[j]); o1[j] = za1[j] * sigmoid_f(zb1[j]); }
                const f32x4 r0 = h0 + gv0 * o0, r1 = h1 + gv1 * o1;
                *(u32x4*)hp = (u32x4){pk2(r0[0], r0[1]), pk2(r0[2], r0[3]), pk2(r1[0], r1[1]), pk2(r1[2], r1[3])};
            }
    }
};

#define XB_TMO      128
#define XB_XCNT(j)  (256  + 64 * (j))
#define XB_XSUB(j)  (1280 + 64 * (j))
#define XB_XGEN(j)  (2304 + 64 * (j))
#define XB_TOP      3328
#define XB_TOPGEN   3392
#define XCD_BAR_WORDS 3456
#define XB_SPIN_CAP (1u << 18)
__device__ __forceinline__ unsigned xb_ld(unsigned* p)              { return __hip_atomic_load(p, __ATOMIC_RELAXED, __HIP_MEMORY_SCOPE_AGENT); }
__device__ __forceinline__ unsigned xb_add(unsigned* p, unsigned v) { return __hip_atomic_fetch_add(p, v, __ATOMIC_RELAXED, __HIP_MEMORY_SCOPE_AGENT); }
__device__ __forceinline__ unsigned xb_xcc_id() { return (unsigned)__builtin_amdgcn_s_getreg((3 << 11) | 20) & 0xFu; }
#define XB_SPIN(cond, bar) do { unsigned _sp = 0; while (cond) { __builtin_amdgcn_s_sleep(1); \
    if ((++_sp & 255u) == 0u) { if (xb_ld(&(bar)[XB_TMO])) break; if (_sp > XB_SPIN_CAP) { atomicAdd(&(bar)[XB_TMO], 1u); break; } } } } while (0)
struct XcdBarrier { unsigned* bar; unsigned x; volatile LAS unsigned* st; };
__device__ __forceinline__ XcdBarrier xcd_barrier_post(unsigned* bar, volatile LAS unsigned* st) {
    XcdBarrier b; b.bar = bar; b.x = xb_xcc_id(); b.st = st;
    if (threadIdx.x == 0) (void)xb_add(&bar[XB_XCNT(b.x)], 1u);
    return b;
}
__device__ __forceinline__ void xcd_barrier_complete(unsigned* bar, unsigned x, unsigned& nloc, unsigned& nx) {
    const unsigned G = gridDim.x * gridDim.y * gridDim.z;
    unsigned sum, cnt, mine, sp = 0u;
    for (;;) {
        sum = 0u; cnt = 0u; mine = 0u;
#pragma unroll
        for (unsigned j = 0; j < 16; ++j) { const unsigned c = xb_ld(&bar[XB_XCNT(j)]); sum += c; cnt += (c > 0u) ? 1u : 0u; mine = (j == x) ? c : mine; }
        if (sum == G) break;
        __builtin_amdgcn_s_sleep(1);
        if ((++sp & 255u) == 0u) { if (xb_ld(&bar[XB_TMO])) break; if (sp > XB_SPIN_CAP) { atomicAdd(&bar[XB_TMO], 1u); break; } }
    }
    nloc = mine > 0u ? mine : 1u; nx = cnt > 0u ? cnt : 1u;
}
__device__ __forceinline__ void xcd_barrier(const XcdBarrier& b) {
    asm volatile("s_waitcnt vmcnt(0)" ::: "memory");
    __syncthreads();
    if (threadIdx.x == 0) {
        unsigned* bar = b.bar;
        __builtin_amdgcn_s_waitcnt(0);
        unsigned nloc = b.st[0], nx = b.st[1];
        if (nloc == 0u) { xcd_barrier_complete(bar, b.x, nloc, nx); b.st[0] = nloc; b.st[1] = nx; }
        const unsigned old = xb_add(&bar[XB_XSUB(b.x)], 1u);
        const unsigned gen = old / nloc;
        if (old + 1u == (gen + 1u) * nloc) {
            __builtin_amdgcn_fence(__ATOMIC_RELEASE, "agent");
            asm volatile("s_waitcnt vmcnt(0)" ::: "memory");
            const unsigned og = xb_add(&bar[XB_TOP], 1u);
            const unsigned tg = og / nx;
            if (og + 1u == (tg + 1u) * nx) xb_add(&bar[XB_TOPGEN], 1u);
            else XB_SPIN(xb_ld(&bar[XB_TOPGEN]) == tg, bar);
            __builtin_amdgcn_fence(__ATOMIC_ACQUIRE, "agent");
            xb_add(&bar[XB_XGEN(b.x)], 1u);
            asm volatile("s_waitcnt vmcnt(0)" ::: "memory");
        } else {
            XB_SPIN(xb_ld(&bar[XB_XGEN(b.x)]) == gen, bar);
            __builtin_amdgcn_fence(__ATOMIC_ACQUIRE, "agent");
            asm volatile("s_waitcnt vmcnt(0)" ::: "memory");
        }
    }
    __syncthreads();
}

__device__ __forceinline__ int opaque_tid() { int t = threadIdx.x; asm volatile("" : "+v"(t)); return t; }
#define PHASE_IDS() const int tid = opaque_tid(); const int lane = tid & 63, wave = tid >> 6; const int G = gridDim.x, gw = blockIdx.x * 8 + wave, NGW = G * 8; \
    const int vcu = (G % 8 == 0) ? (int)(blockIdx.x % 8) * (G / 8) + (int)(blockIdx.x / 8) : (int)blockIdx.x; (void)lane; (void)wave; (void)gw; (void)NGW; (void)vcu; (void)G
__global__ void __launch_bounds__(NTHREADS, 2) fwd_mega(Args a) {
    extern __shared__ __attribute__((aligned(16))) unsigned char lds_raw[];
    LAS unsigned char* lds = (LAS unsigned char*)lds_raw;
    cg::grid_group grid = cg::this_grid();
    unsigned char* ws = a.ws;
    if (threadIdx.x < 2) ((LAS unsigned*)(lds + LDS_BYTES - 16))[threadIdx.x] = 0u;
    __syncthreads();
    const XcdBarrier xbar = xcd_barrier_post((unsigned*)(ws + WS_CTL) + CW_BAR, (volatile LAS unsigned*)(lds + LDS_BYTES - 16));
#ifdef TS_SEL
    volatile LAS unsigned long long* tsbuf = (volatile LAS unsigned long long*)(lds + LDS_BYTES - 16 - 256);
    int tsn = 0;
#define TS_MARK() do { if (blockIdx.x == 0 && threadIdx.x == 0) tsbuf[tsn] = __builtin_amdgcn_s_memrealtime(); ++tsn; } while (0)
#else
#define TS_MARK() do { } while (0)
#endif
    TS_MARK();
#define GSYNC() do { xcd_barrier(xbar); TS_MARK(); } while (0)

    for (int rep = 0; rep < REP_P0; ++rep) { PHASE_IDS(); p0_phase(a, lds, tid, gw, NGW); if (REP_P0 > 1) __syncthreads(); }
    if (a.pad1 != 0) grid.sync();
    GSYNC();
    for (int rep = 0; rep < REP_P1; ++rep) { PHASE_IDS(); p1_phase(a, lane, gw, NGW); }
    GSYNC();
    {
        PHASE_IDS();
        pg8::Gemm g{(const bf16_t*)(ws + WS_A), (const bf16_t*)(ws + WS_WIN), NTOK, 5120, 1024};
        const int Gg = (G == 256) ? TF_GG_INP : G;
        pg8::StaticOrder S; S.init(NTOK, 5120, Gg, (int)blockIdx.x);
        EpiInProj E{(bf16_t*)(ws + WS_Q), (bf16_t*)(ws + WS_V), (bf16_t*)(ws + WS_G), (_Float16*)(ws + WS_LFF), (_Float16*)(ws + WS_LFB), (const float*)(ws + WS_LBV)};
        if ((int)blockIdx.x < Gg) for (int rep = 0; rep < REP_INP; ++rep) pg8::gemm_phase<EpiInProj, pg8::StaticOrder>(lds, g, S, E);
        { int ni, rk; S.idle(ni, rk); if ((int)blockIdx.x >= Gg) rk = -1; tail_fill(a, lds, 0, G - Gg, (int)blockIdx.x - Gg, TF_KA_INP, ni, rk, TF_K_INP, 0, DQ_TOTAL); }
    }
    GSYNC();
    for (int rep = 0; rep < REP_GLA; ++rep) { PHASE_IDS(); gla_phase(a, lds, tid); if (REP_GLA > 1) __syncthreads(); }
    GSYNC();
    for (int rep = 0; rep < REP_RO; ++rep) { PHASE_IDS(); gla_readout_phase(a, lane, gw, NGW); }
    GSYNC();
    {
        PHASE_IDS();
        pg8::Gemm g{(const bf16_t*)(ws + WS_OG), (const bf16_t*)(ws + WS_WOUT), NTOK, 1024, 1024};
        const int Gg = (G == 256) ? TF_GG_OUT : G;
        pg8::StaticOrder S; S.init(NTOK, 1024, Gg, (int)blockIdx.x);
        EpiResid E{a.in[I_X], a.in[I_CTX], (const float*)(ws + WS_MODV), (bf16_t*)(ws + WS_H), 2048};
        if ((int)blockIdx.x < Gg) for (int rep = 0; rep < REP_OUT; ++rep) pg8::gemm_phase<EpiResid, pg8::StaticOrder>(lds, g, S, E);
        { int ni, rk; S.idle(ni, rk); if ((int)blockIdx.x >= Gg) rk = -1; tail_fill(a, lds, 1, G - Gg, (int)blockIdx.x - Gg, TF_KA_OUT, ni, rk, TF_K_OUT, 0, DQ_TOTAL); }
    }
    GSYNC();
    for (int rep = 0; rep < REP_RT; ++rep) { PHASE_IDS(); router_phase(a, lds, 0, 0, tid); if (REP_RT > 1) __syncthreads(); }
    GSYNC();
    for (int rep = 0; rep < REP_AS; ++rep) { PHASE_IDS(); assign_phase(a, lds, 0, 0, tid); if (REP_AS > 1) __syncthreads(); }
    GSYNC();
    for (int rep = 0; rep < REP_M1; ++rep) { PHASE_IDS(); moe_gemm1(a, lds, 0, tid, G, vcu); }
    GSYNC();
    for (int rep = 0; rep < REP_M2; ++rep) { PHASE_IDS(); moe_gemm2(a, lds, 0, tid, G, vcu); }
    GSYNC();
    { PHASE_IDS(); combine_phase(a, 0, 0, lane, gw, NGW); }
    GSYNC();
#ifdef TS_CQ
    if (blockIdx.x == 0 && threadIdx.x == 0) tsbuf[30] = __hip_atomic_load((unsigned*)(ws + WS_CTL) + CW_CQ + TS_CQ, __ATOMIC_RELAXED, __HIP_MEMORY_SCOPE_AGENT);
#endif
    for (int rep = 0; rep < REP_S5; ++rep) { PHASE_IDS(); s5_phase(a, lds, tid); if (REP_S5 > 1) __syncthreads(); }
    GSYNC();
    for (int rep = 0; rep < REP_POST; ++rep) { PHASE_IDS(); s5_post_phase(a, lane, gw, NGW); }
    GSYNC();
    {
        PHASE_IDS();
        pg8::Gemm g{(const bf16_t*)(ws + WS_YG), (const bf16_t*)(ws + WS_WGLU), NLAT, 2048, 1024};
        pg8::StaticOrder S; S.init(NLAT, 2048, G, (int)blockIdx.x);
        EpiGlu E{a.in[I_S5BGLU], (const float*)(ws + WS_MODV) + 9 * 6144, (bf16_t*)(ws + WS_H)};
        pg8::gemm_phase<EpiGlu, pg8::StaticOrder>(lds, g, S, E);
    }
    GSYNC();
    { PHASE_IDS(); router_phase(a, lds, 1, NCTX, tid); }
    GSYNC();
    { PHASE_IDS(); assign_phase(a, lds, 1, NCTX, tid); }
    GSYNC();
    { PHASE_IDS(); moe_gemm1(a, lds, 1, tid, G, vcu); }
    GSYNC();
    { PHASE_IDS(); moe_gemm2(a, lds, 1, tid, G, vcu); }
    GSYNC();
    for (int rep = 0; rep < REP_CMB1; ++rep) { PHASE_IDS(); combine_phase(a, 1, NCTX, lane, gw, NGW); }
#ifdef TS_SEL
    TS_MARK();
    __syncthreads();
    if (blockIdx.x == 0 && threadIdx.x == 0) {
        asm volatile("s_waitcnt vmcnt(0)" ::: "memory"); __threadfence();
#ifdef TS_CQ
        const unsigned long long dt = tsbuf[30];
#else
        const unsigned long long dt = tsbuf[TS_SEL + 1] - tsbuf[TS_SEL];
#endif
#ifdef TS_SET
        a.out[0] = (float)dt * 0.001f;
#else
        atomicAdd(a.out, (float)dt * 0.001f);
#endif
    }
#endif
}

extern "C" void kernel_launch(void* const* d_in, const int* in_sizes, int n_in, void* d_out, int out_size,
                              void* d_ws, size_t ws_size, hipStream_t stream) {
    static int grid_blocks = 0;
    if (!grid_blocks) {
        int dev = 0, cus = 0, per_cu = 0;
        (void)hipGetDevice(&dev);
        (void)hipDeviceGetAttribute(&cus, hipDeviceAttributeMultiprocessorCount, dev);
        (void)hipFuncSetAttribute((const void*)fwd_mega, hipFuncAttributeMaxDynamicSharedMemorySize, LDS_BYTES);
        (void)hipOccupancyMaxActiveBlocksPerMultiprocessor(&per_cu, (const void*)fwd_mega, NTHREADS, LDS_BYTES);
        if (per_cu < 1) { fprintf(stderr, "occupancy query says %d blocks/CU\n", per_cu); }
        grid_blocks = cus < 256 ? cus : 256;
        if (ws_size < WS_END) fprintf(stderr, "kernel_launch: workspace too small: %zu < %zu\n", ws_size, (size_t)WS_END);
    }
    (void)hipMemsetAsync((char*)d_ws + WS_CTL, 0, 32 * 1024, stream);
    Args a{};
    for (int i = 0; i < 29; ++i) a.in[i] = (const float*)d_in[i];
    a.out = (float*)d_out; a.ws = (unsigned char*)d_ws;
    void* kargs[] = {&a};
    hipError_t e = hipLaunchCooperativeKernel((const void*)fwd_mega, dim3(grid_blocks), dim3(NTHREADS), kargs, LDS_BYTES, stream);
    if (e != hipSuccess) fprintf(stderr, "cooperative launch failed: %s (grid %d)\n", hipGetErrorString(e), grid_blocks);
}
```
